# Optimizing an MI355X kernel written in HIP

```python
import jax, jax.numpy as jnp
from jax import lax
import numpy as np

D_MODEL = 1024
BATCH = 16
SEQ = 4096
DEPTH = 1

MEM_LEN = 256
HEAD_DIM = 64
CONV_CH = D_MODEL // 4
ATTN_HEADS = (3 * D_MODEL // 4) // HEAD_DIM
ATTN_WIDTH = ATTN_HEADS * HEAD_DIM
MIX_WIDTH = CONV_CH + ATTN_WIDTH
IN_WIDTH = 2 * CONV_CH + 3 * ATTN_WIDTH
CONV_KERNEL = 31
DILATED_BRANCHES = ((128, 1), (512, 4), (2048, 16))
ROPE_THETA = 10000.0
MEM_HEADS = 4
MEM_HEAD_DIM = D_MODEL // MEM_HEADS
N_GROUPS = 4
EXPERTS_PER_GROUP = 8
N_EXPERTS = N_GROUPS * EXPERTS_PER_GROUP
TOP_K = 2
EXPERT_FF = D_MODEL // 2
DISPATCH_BLOCK = 256
NORM_EPS = 1e-6
LN_EPS = 1e-5

kernel_name = 'hybrid_conv_dilated_attn_hmoe_encoder'


def rms_norm(t, g):
    tf = t.astype(jnp.float32)
    y = tf * lax.rsqrt(jnp.mean(tf * tf, axis=-1, keepdims=True) + NORM_EPS)
    return (y * g.astype(jnp.float32)).astype(t.dtype)


def layer_norm(t, g, b):
    tf = t.astype(jnp.float32)
    mu = jnp.mean(tf, axis=-1, keepdims=True)
    var = jnp.mean(jnp.square(tf - mu), axis=-1, keepdims=True)
    y = (tf - mu) * lax.rsqrt(var + LN_EPS)
    return (y * g.astype(jnp.float32) + b.astype(jnp.float32)).astype(t.dtype)


def rotary(t, positions):
    half = t.shape[-1] // 2
    inv = 1.0 / (ROPE_THETA ** (jnp.arange(half, dtype=jnp.float32) * (2.0 / t.shape[-1])))
    ang = positions.astype(jnp.float32)[:, None] * inv[None, :]
    cos, sin = jnp.cos(ang), jnp.sin(ang)
    t1, t2 = t[..., :half], t[..., half:]
    return jnp.concatenate([t1 * cos - t2 * sin, t1 * sin + t2 * cos], axis=-1)


def conformer_conv(conv_in, dw_w, dw_b, ln_g, ln_b):
    a, gate = conv_in[..., :CONV_CH], conv_in[..., CONV_CH:]
    c = a * jax.nn.sigmoid(gate)
    pad = CONV_KERNEL // 2
    c = lax.conv_general_dilated(
        c, dw_w.reshape(CONV_KERNEL, 1, CONV_CH).astype(c.dtype),
        window_strides=(1,), padding=[(pad, pad)],
        dimension_numbers=('NWC', 'WIO', 'NWC'),
        feature_group_count=CONV_CH) + dw_b.astype(c.dtype)
    c = layer_norm(c, ln_g, ln_b)
    return jax.nn.silu(c)


def dilated_branch(q, k, v, window, dilation):
    B_, H, S_, Dh = q.shape
    half = window // (2 * dilation)
    blk = half
    L = S_ // dilation
    nb = -(-L // blk)
    Lp = nb * blk
    pad = Lp - L

    def to_sub(t):
        return t.reshape(B_, H, L, dilation, Dh).transpose(0, 1, 3, 2, 4)

    qs, ks, vs = to_sub(q), to_sub(k), to_sub(v)
    qs = jnp.pad(qs, ((0, 0), (0, 0), (0, 0), (0, pad), (0, 0)))
    kp = jnp.pad(ks, ((0, 0), (0, 0), (0, 0), (blk, pad + blk), (0, 0)))
    vp = jnp.pad(vs, ((0, 0), (0, 0), (0, 0), (blk, pad + blk), (0, 0)))
    qb = qs.reshape(B_, H, dilation, nb, blk, Dh)
    kb = kp.reshape(B_, H, dilation, nb + 2, blk, Dh)
    vb = vp.reshape(B_, H, dilation, nb + 2, blk, Dh)
    kw = jnp.concatenate([kb[:, :, :, :-2], kb[:, :, :, 1:-1], kb[:, :, :, 2:]], axis=-2)
    vw = jnp.concatenate([vb[:, :, :, :-2], vb[:, :, :, 1:-1], vb[:, :, :, 2:]], axis=-2)

    qi = np.arange(nb)[:, None] * blk + np.arange(blk)[None, :]
    ki = np.arange(nb)[:, None] * blk - blk + np.arange(3 * blk)[None, :]
    valid = ((np.abs(qi[:, :, None] - ki[:, None, :]) <= half)
             & (ki[:, None, :] >= 0) & (ki[:, None, :] < L))

    s = jnp.einsum('bhrnqd,bhrnkd->bhrnqk', qb, kw) * (HEAD_DIM ** -0.5)
    s = jnp.where(jnp.asarray(valid), s, -jnp.inf)
    m = jnp.max(s, axis=-1)
    p = jnp.exp(s - m[..., None])
    den = jnp.sum(p, axis=-1)
    num = jnp.einsum('bhrnqk,bhrnkd->bhrnqd', p, vw)

    def back(t):
        tail = tuple(t.shape[5:])
        t = t.reshape((B_, H, dilation, Lp) + tail)[:, :, :, :L]
        perm = (0, 1, 3, 2) + tuple(range(4, 4 + len(tail)))
        return t.transpose(perm).reshape((B_, H, S_) + tail)

    return back(num), back(m), back(den)


def dilated_attention(q, k, v, positions):
    B_, H, S_, Dh = q.shape
    out_dtype = q.dtype
    qf = rotary(q.astype(jnp.float32), positions)
    kf = rotary(k.astype(jnp.float32), positions)
    vf = v.astype(jnp.float32)
    num_acc = den_acc = m_acc = None
    for window, dilation in DILATED_BRANCHES:
        num, m, den = dilated_branch(qf, kf, vf, window, dilation)
        if m_acc is None:
            num_acc, den_acc, m_acc = num, den, m
        else:
            m_new = jnp.maximum(m_acc, m)
            a = jnp.exp(m_acc - m_new)
            b = jnp.exp(m - m_new)
            num_acc = num_acc * a[..., None] + num * b[..., None]
            den_acc = den_acc * a + den * b
            m_acc = m_new
    o = num_acc / den_acc[..., None]
    return o.transpose(0, 2, 1, 3).reshape(B_, S_, H * Dh).astype(out_dtype)


def memory_cross_attention(h, mem_n, w_q, w_k, w_v, w_o):
    B_, S_, D = h.shape
    q = (h @ w_q).reshape(B_, S_, MEM_HEADS, MEM_HEAD_DIM)
    k = (mem_n @ w_k).reshape(B_, -1, MEM_HEADS, MEM_HEAD_DIM)
    v = (mem_n @ w_v).reshape(B_, -1, MEM_HEADS, MEM_HEAD_DIM)
    s = jnp.einsum('bshd,bmhd->bhsm', q, k, preferred_element_type=jnp.float32) * (MEM_HEAD_DIM ** -0.5)
    p = jax.nn.softmax(s, axis=-1).astype(v.dtype)
    o = jnp.einsum('bhsm,bmhd->bshd', p, v).reshape(B_, S_, D)
    return o @ w_o


def hierarchical_moe(h, w_group, b_group, w_router, b_router, w1, w3, w2):
    B_, S_, D = h.shape
    T = B_ * S_
    hf = h.reshape(T, D)
    gl = (hf @ w_group + b_group).astype(jnp.float32)
    gp = jax.nn.softmax(gl, axis=-1)
    _, g_sel = lax.top_k(gl, 1)
    g_idx = g_sel[:, 0]
    tok_idx = jnp.arange(T, dtype=jnp.int32)
    p_g = gp[tok_idx, g_idx]
    el = (hf @ w_router + b_router).astype(jnp.float32).reshape(T, N_GROUPS, EXPERTS_PER_GROUP)
    el_sel = el[tok_idx, g_idx]
    top_v, top_i = lax.top_k(el_sel, TOP_K)
    gates = p_g[:, None] * jax.nn.softmax(top_v, axis=-1)
    expert_ids = g_idx[:, None] * EXPERTS_PER_GROUP + top_i

    A = T * TOP_K
    flat_e = expert_ids.reshape(A).astype(jnp.int32)
    flat_t = jnp.repeat(tok_idx, TOP_K)
    flat_g = gates.reshape(A)
    order = jnp.argsort(flat_e)
    se, st, sg = flat_e[order], flat_t[order], flat_g[order]
    counts = jnp.bincount(flat_e, length=N_EXPERTS).astype(jnp.int32)
    starts = jnp.cumsum(counts) - counts
    pcounts = (counts + DISPATCH_BLOCK - 1) // DISPATCH_BLOCK * DISPATCH_BLOCK
    pstarts = jnp.cumsum(pcounts) - pcounts
    dest = pstarts[se] + jnp.arange(A, dtype=jnp.int32) - starts[se]
    P = (-(-A // DISPATCH_BLOCK) + N_EXPERTS) * DISPATCH_BLOCK
    n_blk = P // DISPATCH_BLOCK
    row_tok = jnp.full((P,), T, dtype=jnp.int32).at[dest].set(st)
    row_gate = jnp.zeros((P,), jnp.float32).at[dest].set(sg)
    blk_e = jnp.minimum(
        jnp.searchsorted(pstarts + pcounts, jnp.arange(n_blk, dtype=jnp.int32) * DISPATCH_BLOCK,
                         side='right'),
        N_EXPERTS - 1).astype(jnp.int32)
    x_rows = jnp.concatenate([hf, jnp.zeros((1, D), hf.dtype)], axis=0)[row_tok]
    x_blocks = x_rows.reshape(n_blk, DISPATCH_BLOCK, D)

    def expert_block(args):
        xb, e = args
        return (jax.nn.silu(xb @ w1[e]) * (xb @ w3[e])) @ w2[e]

    y_rows = lax.map(expert_block, (x_blocks, blk_e)).reshape(P, D)
    y = jax.ops.segment_sum(y_rows * row_gate[:, None].astype(y_rows.dtype), row_tok,
                            num_segments=T + 1)[:T]
    return y.reshape(B_, S_, D)


def setup_inputs(seed: int = 0) -> dict:
    key = jax.random.key(seed)
    ks = jax.random.split(key, 26)
    f32 = jnp.float32
    D = D_MODEL

    def nrm(k, shape, scale):
        return jax.random.normal(k, shape, f32) * scale

    def gain(k, shape):
        return 1.0 + 0.02 * jax.random.normal(k, shape, f32)

    return {
        'x': jax.random.normal(ks[0], (BATCH, SEQ, D), f32),
        'mem': jax.random.normal(ks[1], (BATCH, MEM_LEN, D), f32),
        'positions': jnp.arange(SEQ, dtype=jnp.int32),
        'mix_norm_g': gain(ks[2], (DEPTH, D)),
        'w_in': nrm(ks[3], (DEPTH, D, IN_WIDTH), D ** -0.5),
        'conv_dw_w': nrm(ks[4], (DEPTH, CONV_KERNEL, CONV_CH), CONV_KERNEL ** -0.5),
        'conv_dw_b': nrm(ks[5], (DEPTH, CONV_CH), 0.02),
        'conv_ln_g': gain(ks[6], (DEPTH, CONV_CH)),
        'conv_ln_b': nrm(ks[7], (DEPTH, CONV_CH), 0.02),
        'conv_out_g': gain(ks[8], (DEPTH, CONV_CH)),
        'attn_out_g': gain(ks[9], (DEPTH, ATTN_WIDTH)),
        'w_out': nrm(ks[10], (DEPTH, MIX_WIDTH, D), MIX_WIDTH ** -0.5),
        'xattn_norm_g': gain(ks[11], (DEPTH, D)),
        'mem_norm_g': gain(ks[12], (DEPTH, D)),
        'w_xq': nrm(ks[13], (DEPTH, D, D), D ** -0.5),
        'w_xk': nrm(ks[14], (DEPTH, D, D), D ** -0.5),
        'w_xv': nrm(ks[15], (DEPTH, D, D), D ** -0.5),
        'w_xo': nrm(ks[16], (DEPTH, D, D), D ** -0.5),
        'moe_norm_g': gain(ks[17], (DEPTH, D)),
        'w_group': nrm(ks[18], (DEPTH, D, N_GROUPS), D ** -0.5),
        'b_group': nrm(ks[19], (DEPTH, N_GROUPS), 0.01),
        'w_router': nrm(ks[20], (DEPTH, D, N_EXPERTS), D ** -0.5),
        'b_router': nrm(ks[21], (DEPTH, N_EXPERTS), 0.01),
        'w1': nrm(ks[22], (DEPTH, N_EXPERTS, D, EXPERT_FF), D ** -0.5),
        'w3': nrm(ks[23], (DEPTH, N_EXPERTS, D, EXPERT_FF), D ** -0.5),
        'w2': nrm(ks[24], (DEPTH, N_EXPERTS, EXPERT_FF, D), EXPERT_FF ** -0.5),
        'final_norm_g': gain(ks[25], (D,)),
    }


def reference(x, mem, positions, mix_norm_g, w_in, conv_dw_w, conv_dw_b, conv_ln_g, conv_ln_b,
              conv_out_g, attn_out_g, w_out, xattn_norm_g, mem_norm_g, w_xq, w_xk, w_xv, w_xo,
              moe_norm_g, w_group, b_group, w_router, b_router, w1, w3, w2, final_norm_g):
    B_, S_, _ = x.shape
    for l in range(DEPTH):
        h = rms_norm(x, mix_norm_g[l])
        u = h @ w_in[l]
        conv_in = u[..., :2 * CONV_CH]
        qkv = u[..., 2 * CONV_CH:].reshape(B_, S_, 3, ATTN_HEADS, HEAD_DIM).transpose(2, 0, 3, 1, 4)
        c = conformer_conv(conv_in, conv_dw_w[l], conv_dw_b[l], conv_ln_g[l], conv_ln_b[l])
        a = dilated_attention(qkv[0], qkv[1], qkv[2], positions)
        mixed = jnp.concatenate([rms_norm(c, conv_out_g[l]), rms_norm(a, attn_out_g[l])], axis=-1)
        x = x + mixed @ w_out[l]
        h = rms_norm(x, xattn_norm_g[l])
        m = rms_norm(mem, mem_norm_g[l])
        x = x + memory_cross_attention(h, m, w_xq[l], w_xk[l], w_xv[l], w_xo[l])
        h = rms_norm(x, moe_norm_g[l])
        x = x + hierarchical_moe(h, w_group[l], b_group[l], w_router[l], b_router[l], w1[l], w3[l], w2[l])
    return rms_norm(x, final_norm_g)
```

```cpp
#include <hip/hip_runtime.h>
#include <cstdio>
#include <cstdint>

#define GAS __attribute__((address_space(1)))
#define LAS __attribute__((address_space(3)))
typedef unsigned short bf16_t;
typedef short bf16x8 __attribute__((ext_vector_type(8)));
typedef short s16x4 __attribute__((ext_vector_type(4)));
typedef float f32x4 __attribute__((ext_vector_type(4)));
typedef float f32x2 __attribute__((ext_vector_type(2)));
typedef unsigned u32x4 __attribute__((ext_vector_type(4)));
typedef unsigned u32x2 __attribute__((ext_vector_type(2)));

constexpr int NB = 16, SEQ = 4096, T = NB * SEQ, D = 1024;
constexpr int CCH = 256, NH = 12, HD = 64, AW = NH * HD, INW = 2 * CCH + 3 * AW;
constexpr int MEML = 256, MROWS = NB * MEML, XH = 4, XHD = 256;
constexpr int NE = 32, EPG = 8, NG = 4, FF = 512;
constexpr int CONVK = 31;
constexpr int A_PAD = T * 2 + NE * 256;
constexpr float NORM_EPS = 1e-6f, LN_EPS = 1e-5f;
constexpr float LOG2E = 1.4426950408889634f;

constexpr size_t MiB = 1u << 20;
constexpr size_t WS_CTL = 0, CTL_ZERO_BYTES = 1 * MiB;
constexpr size_t WS_ROPE = 1 * MiB;
constexpr size_t WS_HIST = 2 * MiB;
constexpr size_t WS_SSQA = 4 * MiB;
constexpr size_t WS_SSQ1 = 8 * MiB;
constexpr size_t WS_SSQ2 = 12 * MiB;
constexpr size_t WS_WIN = 16 * MiB, WS_WOUT = 22 * MiB, WS_WXQ = 24 * MiB, WS_WXK = 26 * MiB, WS_WXV = 28 * MiB, WS_WXO = 30 * MiB;
constexpr size_t WS_W13 = 32 * MiB, WS_W2 = 96 * MiB;
constexpr size_t WS_MEMN = 128 * MiB, WS_KX = 136 * MiB, WS_VXT = 144 * MiB;
constexpr size_t WS_TOK = 152 * MiB;
constexpr size_t WS_R1 = 160 * MiB;
constexpr size_t WS_R2 = 288 * MiB;
constexpr size_t WS_Q = 320 * MiB, WS_K = 416 * MiB, WS_V = 512 * MiB;
constexpr size_t WS_XQ = 416 * MiB;
constexpr size_t WS_PM = 544 * MiB;
constexpr size_t WS_HID = 416 * MiB;
constexpr size_t WS_Y = 552 * MiB;
constexpr size_t WS_END = 824 * MiB;
constexpr size_t TK_E = 0;
constexpr size_t TK_GATE = 1 * MiB;
constexpr size_t TK_SLOT = 2 * MiB;
constexpr size_t TK_RS = 3 * MiB;
constexpr size_t TK_ROWTOK = 4 * MiB;
constexpr size_t TK_SLOTRS = 5 * MiB;
constexpr size_t TK_SLOTGATE = 6 * MiB;
constexpr size_t HIST_ETILE = 64 * 1024, HIST_WR = 128 * 1024;

constexpr int CW_BAR = 4096;

constexpr int NWAVES = 8;
constexpr int RING_BYTES = 131072;
constexpr int XCH_OFF = RING_BYTES;
constexpr int LDSCTL_OFF = RING_BYTES + 12288;
constexpr int LDS_BYTES = 147456;

#define LDS_WAIT() asm volatile("s_waitcnt lgkmcnt(0)" ::: "memory")
#define VM_WAIT() asm volatile("s_waitcnt vmcnt(0)" ::: "memory")
__device__ __forceinline__ unsigned f2bf(float f) { unsigned u = __builtin_bit_cast(unsigned, f); return (u + 0x7fffu + ((u >> 16) & 1u)) >> 16; }
__device__ __forceinline__ unsigned pk2(float lo, float hi) { return f2bf(lo) | (f2bf(hi) << 16); }
__device__ __forceinline__ float bf2f(unsigned short b) { return __builtin_bit_cast(float, (unsigned)b << 16); }
__device__ __forceinline__ float bflo(unsigned w) { return __builtin_bit_cast(float, w << 16); }
__device__ __forceinline__ float bfhi(unsigned w) { return __builtin_bit_cast(float, w & 0xffff0000u); }
__device__ __forceinline__ unsigned cvt_pk_bf16(float lo, float hi) { unsigned r; asm volatile("v_cvt_pk_bf16_f32 %0, %1, %2" : "=v"(r) : "v"(lo), "v"(hi)); return r; }
__device__ __forceinline__ float wave_sum(float v) {
#pragma unroll
    for (int o = 1; o < 64; o <<= 1) v += __shfl_xor(v, o);
    return v;
}
#define MK_N_LAUNCHES 13
namespace pg8 {
constexpr int BM = 256, BK = 64, HALF = 128, HTB = HALF * BK * 2  , STAGE_BYTES = 8 * HTB, NXCD = 8, WGM = 8;

__host__ __device__ __forceinline__ int lds_byte(int r, int c) { const int st = (r >> 4) * 2 + (c >> 5), rr = r & 15, cc = c & 31, ob = rr * 64 + cc * 2; return st * 1024 + (ob ^ (((ob >> 9) & 1) << 5)); }
__host__ __device__ __forceinline__ void stage_rc(int b, int& R, int& C) { const int st = b / 1024, sb = b % 1024, swz = sb ^ (((sb >> 9) & 1) << 5); R = (st >> 1) * 16 + swz / 64; C = (st & 1) * 32 + (swz % 64) / 2; }
__host__ __device__ __forceinline__ int perm32(int rho) { const int n = rho >> 4, i = rho & 15; return 8 * (i >> 2) + 4 * n + (i & 3); }

struct Unit { const char* a; const char* b; const int* rows; int pm, pn, x0, x1; };

typedef f32x4 Acc[2][2][4][2];

template <class Epi, class Sched, bool ALIGN_EPI, bool GATHER>
__device__ __forceinline__ void gemm_phase(LAS unsigned char* lds, const int lda, const int ldb, const int K, const Sched& S, const Epi& E) {
    const int tid = threadIdx.x, wid = __builtin_amdgcn_readfirstlane(tid >> 6), lane = tid & 63, wr = wid >> 2, wc = wid & 3, fr = lane & 15, fq = lane >> 4;
    const int nt = K / BK;
    int Rr[2], Cc[2];
    unsigned vA[2][2], vN[2][2], voffB[2];
#pragma unroll
    for (int i = 0; i < 2; ++i) { int R, C; stage_rc(tid * 16 + i * 8192, R, C); Rr[i] = R; Cc[i] = C; const int Rb = Epi::PERM ? ((R & ~31) + perm32(R & 31)) : R;
        voffB[i] = (unsigned)(Rb * ldb + C) * 2u; }
    const size_t kstep = (size_t)(BK * 2);
    const size_t hstepB = (size_t)HALF * ldb * 2, hstepA = (size_t)HALF * lda * 2;
    const unsigned ldsw = (unsigned)wid * 1024u;
    const int aoff = lds_byte(wr * 64 + fr, fq * 8), boff = lds_byte(wc * 32 + fr, fq * 8);
#define PG8_SA(b, h) (((b) * 2 + (h)) * HTB)
#define PG8_SB(b, h) ((4 + (b) * 2 + (h)) * HTB)
#define PG8_STAGE(bufoff, gbase, voff) do { _Pragma("unroll") for (int _i = 0; _i < 2; ++_i) \
        __builtin_amdgcn_global_load_lds((const unsigned*)((const char*)(gbase) + (voff)[_i]), (LAS unsigned*)(lds + (bufoff) + ldsw + _i * 8192), 16, 0, 0); } while (0)
#define PG8_LDA(dst, b, h) do { _Pragma("unroll") for (int m = 0; m < 4; ++m) _Pragma("unroll") for (int k = 0; k < 2; ++k) dst[m][k] = *(const LAS bf16x8*)(lds + PG8_SA(b, h) + aoff + m * 2048 + k * 1024); } while (0)
#define PG8_LDB(dst, b, h) do { _Pragma("unroll") for (int n = 0; n < 2; ++n) _Pragma("unroll") for (int k = 0; k < 2; ++k) dst[n][k] = *(const LAS bf16x8*)(lds + PG8_SB(b, h) + boff + n * 2048 + k * 1024); } while (0)
#define PG8_MMA(ai, bj, At, Bt) do { __builtin_amdgcn_s_setprio(1); _Pragma("unroll") for (int m = 0; m < 4; ++m) _Pragma("unroll") for (int n = 0; n < 2; ++n) _Pragma("unroll") for (int k = 0; k < 2; ++k) \
        acc[ai][bj][m][n] = __builtin_amdgcn_mfma_f32_16x16x32_bf16(Bt[n][k], At[m][k], acc[ai][bj][m][n], 0, 0, 0); __builtin_amdgcn_s_setprio(0); } while (0)
#define PG8_WAIT_V(n) asm volatile("s_waitcnt vmcnt(" #n ")" ::: "memory")
#define PG8_WAIT_L(n) asm volatile("s_waitcnt lgkmcnt(" #n ")" ::: "memory")
#define PG8_BAR __builtin_amdgcn_s_barrier()
#define PG8_SCHED __builtin_amdgcn_sched_barrier(0)
#define PG8_VOFF(dst, u) do { _Pragma("unroll") for (int _h = 0; _h < 2; ++_h) _Pragma("unroll") for (int _i = 0; _i < 2; ++_i) { \
        if constexpr (GATHER) dst[_h][_i] = (unsigned)(u).rows[_h * HALF + Rr[_i]] * (unsigned)(lda * 2) + (unsigned)(Cc[_i] * 2); \
        else dst[_h][_i] = (unsigned)(Rr[_i] * lda + Cc[_i]) * 2u; } } while (0)
#define PG8_STAGE_A(bufoff, gbase, h, vv) do { if constexpr (GATHER) { PG8_STAGE(bufoff, gbase, vv[h]); } else { PG8_STAGE(bufoff, (gbase) + (h) * hstepA, vv[0]); } } while (0)
    Unit cur, nxt; int ui = 0;
    if (!S.next(0, cur)) return;
    Acc acc;
#pragma unroll
    for (int a = 0; a < 2; ++a)
#pragma unroll
        for (int b = 0; b < 2; ++b)
#pragma unroll
            for (int m = 0; m < 4; ++m)
#pragma unroll
                for (int n = 0; n < 2; ++n) acc[a][b][m][n] = (f32x4){0.f, 0.f, 0.f, 0.f};
    bf16x8 At[4][2], B0[2][2], B1[2][2];
    const char* cA = cur.a; const char* cB = cur.b;
    PG8_VOFF(vA, cur);
    if constexpr (GATHER) { asm volatile("s_waitcnt vmcnt(0)" ::: "memory"); }
    PG8_STAGE(PG8_SB(0, 0), cB, voffB); PG8_STAGE(PG8_SB(0, 1), cB + hstepB, voffB); PG8_STAGE_A(PG8_SA(0, 0), cA, 0, vA); PG8_STAGE_A(PG8_SA(0, 1), cA, 1, vA);
    if (wr == 1) PG8_BAR;
    PG8_WAIT_V(2); PG8_BAR;
    PG8_STAGE(PG8_SB(1, 0), cB + kstep, voffB); PG8_STAGE_A(PG8_SA(1, 0), cA + kstep, 0, vA); PG8_STAGE(PG8_SB(1, 1), cB + hstepB + kstep, voffB);
    PG8_WAIT_V(6); PG8_BAR;
    for (;;) {
        const bool has_next = S.next(ui + 1, nxt);
        const char* nA = has_next ? nxt.a : cA; const char* nB = has_next ? nxt.b : cB;
        if constexpr (GATHER) { if (has_next) { PG8_VOFF(vN, nxt); } else {
#pragma unroll
            for (int h = 0; h < 2; ++h) { vN[h][0] = vA[h][0]; vN[h][1] = vA[h][1]; } } }
#pragma nounroll
        for (int t = 0; t < nt; t += 2) {
            const bool last = (t == nt - 2);
            if constexpr (Epi::HAS_MID) { if (t == E.mid_t()) E.mid(acc, cur, wr, wc, fr, fq); }
            const char* a1 = cA + (size_t)(t + 1) * kstep;
            const char* a2 = last ? nA : cA + (size_t)(t + 2) * kstep; const char* b2 = last ? nB : cB + (size_t)(t + 2) * kstep;
            const char* a3 = a2 + kstep; const char* b3 = b2 + kstep;
            unsigned vW[2][2];
#pragma unroll
            for (int h = 0; h < 2; ++h) { vW[h][0] = vA[h][0]; vW[h][1] = vA[h][1]; if constexpr (GATHER) { if (last) { vW[h][0] = vN[h][0]; vW[h][1] = vN[h][1]; } } }
            PG8_LDB(B0, 0, 0); PG8_LDB(B1, 0, 1); PG8_SCHED; PG8_LDA(At, 0, 0); PG8_STAGE_A(PG8_SA(1, 1), a1, 1, vA);
            PG8_WAIT_V(8); PG8_WAIT_L(0); PG8_BAR; PG8_MMA(0, 0, At, B0); PG8_MMA(0, 1, At, B1); PG8_BAR; PG8_SCHED;
            PG8_LDA(At, 0, 1); PG8_STAGE(PG8_SB(0, 0), b2, voffB); PG8_STAGE(PG8_SB(0, 1), b2 + hstepB, voffB); PG8_STAGE_A(PG8_SA(0, 0), a2, 0, vW);
            PG8_WAIT_V(8); PG8_WAIT_L(0); PG8_BAR; PG8_MMA(1, 0, At, B0); PG8_MMA(1, 1, At, B1); PG8_BAR; PG8_SCHED;
            PG8_LDB(B0, 1, 0); PG8_LDB(B1, 1, 1); PG8_SCHED; PG8_LDA(At, 1, 0); PG8_STAGE_A(PG8_SA(0, 1), a2, 1, vW);
            PG8_WAIT_V(8); PG8_WAIT_L(0); PG8_BAR; PG8_MMA(0, 0, At, B0); PG8_MMA(0, 1, At, B1); PG8_BAR; PG8_SCHED;
            PG8_LDA(At, 1, 1); PG8_STAGE(PG8_SB(1, 0), b3, voffB); PG8_STAGE(PG8_SB(1, 1), b3 + hstepB, voffB); PG8_STAGE_A(PG8_SA(1, 0), a3, 0, vW);
            PG8_WAIT_V(8); PG8_WAIT_L(0); PG8_BAR; PG8_MMA(1, 0, At, B0); PG8_MMA(1, 1, At, B1); PG8_BAR; PG8_SCHED;
        }
        if constexpr (ALIGN_EPI) { if (wr == 0) PG8_BAR; }
        E(acc, cur, wr, wc, fr, fq, lds, wid, lane);
        if (!has_next) break;
#pragma unroll
        for (int a = 0; a < 2; ++a)
#pragma unroll
            for (int b = 0; b < 2; ++b)
#pragma unroll
                for (int m = 0; m < 4; ++m)
#pragma unroll
                    for (int n = 0; n < 2; ++n) acc[a][b][m][n] = (f32x4){0.f, 0.f, 0.f, 0.f};
        cur = nxt; cA = nA; cB = nB; ++ui;
        if constexpr (GATHER) {
#pragma unroll
            for (int h = 0; h < 2; ++h) { vA[h][0] = vN[h][0]; vA[h][1] = vN[h][1]; } }
        if constexpr (ALIGN_EPI) { if (wr == 1) PG8_BAR; }
    }
    PG8_WAIT_V(0);
    if constexpr (!ALIGN_EPI) { if (wr == 0) PG8_BAR; }
    PG8_BAR;
#undef PG8_SA
#undef PG8_SB
#undef PG8_STAGE
#undef PG8_LDA
#undef PG8_LDB
#undef PG8_MMA
#undef PG8_WAIT_V
#undef PG8_WAIT_L
#undef PG8_BAR
#undef PG8_SCHED
#undef PG8_VOFF
#undef PG8_STAGE_A
}
}
#define XB_TMO      128
#define XB_XCNT(j)  (256  + 64 * (j))
#define XB_XSUB(j)  (1280 + 64 * (j))
#define XB_XGEN(j)  (2304 + 64 * (j))
#define XB_TOP      3328
#define XB_TOPGEN   3392
#define XCD_BAR_WORDS 3456
#define XB_SPIN_CAP (1u << 18)

__device__ __forceinline__ unsigned xb_ld(unsigned* p)              { return __hip_atomic_load(p, __ATOMIC_RELAXED, __HIP_MEMORY_SCOPE_AGENT); }
__device__ __forceinline__ unsigned xb_add(unsigned* p, unsigned v) { return __hip_atomic_fetch_add(p, v, __ATOMIC_RELAXED, __HIP_MEMORY_SCOPE_AGENT); }
__device__ __forceinline__ unsigned xb_xcc_id() { return (unsigned)__builtin_amdgcn_s_getreg((3 << 11) | 20) & 0xFu; }
#define XB_SPIN(cond, bar) do { unsigned _sp = 0; while (cond) { __builtin_amdgcn_s_sleep(1); \
    if ((++_sp & 255u) == 0u) { if (xb_ld(&(bar)[XB_TMO])) break; if (_sp > XB_SPIN_CAP) { atomicAdd(&(bar)[XB_TMO], 1u); break; } } } } while (0)

struct XcdBarrier {
    unsigned* bar; unsigned x;
    volatile LAS unsigned* st;
};

__device__ __forceinline__ XcdBarrier xcd_barrier_post(unsigned* bar, volatile LAS unsigned* st) {
    XcdBarrier b; b.bar = bar; b.x = xb_xcc_id(); b.st = st;
    if (threadIdx.x == 0) (void)xb_add(&bar[XB_XCNT(b.x)], 1u);
    return b;
}
__device__ __forceinline__ void xcd_barrier_complete(unsigned* bar, unsigned x, unsigned& nloc, unsigned& nx) {
    const unsigned G = gridDim.x * gridDim.y * gridDim.z;
    unsigned sum, cnt, mine, sp = 0u;
    for (;;) {
        sum = 0u; cnt = 0u; mine = 0u;
#pragma unroll
        for (unsigned j = 0; j < 16; ++j) { const unsigned c = xb_ld(&bar[XB_XCNT(j)]); sum += c; cnt += (c > 0u) ? 1u : 0u; mine = (j == x) ? c : mine; }
        if (sum == G) break;
        __builtin_amdgcn_s_sleep(1);
        if ((++sp & 255u) == 0u) { if (xb_ld(&bar[XB_TMO])) break; if (sp > XB_SPIN_CAP) { atomicAdd(&bar[XB_TMO], 1u); break; } }
    }
    nloc = mine > 0u ? mine : 1u; nx = cnt > 0u ? cnt : 1u;
}

__device__ __forceinline__ void xcd_barrier(const XcdBarrier& b) {
    asm volatile("s_waitcnt vmcnt(0)" ::: "memory");
    __syncthreads();
    if (threadIdx.x == 0) {
        unsigned* bar = b.bar;
        __builtin_amdgcn_s_waitcnt(0);
        unsigned nloc = b.st[0], nx = b.st[1];
        if (nloc == 0u) { xcd_barrier_complete(bar, b.x, nloc, nx); b.st[0] = nloc; b.st[1] = nx; }
        const unsigned old = xb_add(&bar[XB_XSUB(b.x)], 1u);
        const unsigned gen = old / nloc;
        if (old + 1u == (gen + 1u) * nloc) {
            __builtin_amdgcn_fence(__ATOMIC_RELEASE, "agent");
            asm volatile("s_waitcnt vmcnt(0)" ::: "memory");
            const unsigned og = xb_add(&bar[XB_TOP], 1u);
            const unsigned tg = og / nx;
            if (og + 1u == (tg + 1u) * nx) xb_add(&bar[XB_TOPGEN], 1u);
            else XB_SPIN(xb_ld(&bar[XB_TOPGEN]) == tg, bar);
            __builtin_amdgcn_fence(__ATOMIC_ACQUIRE, "agent");
            xb_add(&bar[XB_XGEN(b.x)], 1u);
            asm volatile("s_waitcnt vmcnt(0)" ::: "memory");
        } else {
            XB_SPIN(xb_ld(&bar[XB_XGEN(b.x)]) == gen, bar);
            __builtin_amdgcn_fence(__ATOMIC_ACQUIRE, "agent");
            asm volatile("s_waitcnt vmcnt(0)" ::: "memory");
        }
    }
    __syncthreads();
}

namespace pg8 {
#define EPI_NOMID static constexpr bool HAS_MID = false; __device__ __forceinline__ int mid_t() const { return -1; } __device__ __forceinline__ void mid(Acc&, const Unit&, int, int, int, int) const {}
#define RAW_BARRIER() do { asm volatile("s_waitcnt lgkmcnt(0)" ::: "memory"); __builtin_amdgcn_s_barrier(); asm volatile("" ::: "memory"); } while (0)

__device__ __forceinline__ u32x4 pack8(const f32x4& v0, const f32x4& v1) { u32x4 w; w.x = cvt_pk_bf16(v0[0], v0[1]); w.y = cvt_pk_bf16(v0[2], v0[3]); w.z = cvt_pk_bf16(v1[0], v1[1]); w.w = cvt_pk_bf16(v1[2], v1[3]); return w; }

struct GridOrder {
    const char* A; const char* Bt; int lda, ldb, nM, nN, nwg, G, c;
    __device__ __forceinline__ void init(const void* A_, const void* Bt_, int lda_, int ldb_, int M, int N, int G_, int c_) { A = (const char*)A_; Bt = (const char*)Bt_; lda = lda_; ldb = ldb_; nM = M / BM; nN = N / BM; nwg = nM * nN; G = G_; c = c_; }
    __device__ __forceinline__ bool next(int i, Unit& u) const {
        const long L = (long)i * G + c; if (L >= nwg) return false;
        int wgid = (int)L; { const int q = nwg / NXCD, r = nwg % NXCD, xcd = wgid % NXCD, off = wgid / NXCD; wgid = (xcd < r ? xcd * (q + 1) : r * (q + 1) + (xcd - r) * q) + off; }
        const int nig = WGM * nN, gid = wgid / nig, fm = gid * WGM, gsz = (nM - fm) < WGM ? (nM - fm) : WGM;
        u.pm = fm + ((wgid % nig) % gsz); u.pn = (wgid % nig) / gsz; u.x0 = 0; u.x1 = 0; u.rows = nullptr;
        u.a = A + (size_t)u.pm * BM * lda * 2; u.b = Bt + (size_t)u.pn * BM * ldb * 2; return true;
    }
};
struct KvOrder {
    const char* memn; const char* wk; const char* wv; int G, c;
    __device__ __forceinline__ bool next(int i, Unit& u) const {
        const int L = i * G + c; if (L >= 128) return false;
        u.rows = nullptr; u.x1 = 0;
        if (L < 64) { u.pm = L >> 2; u.pn = L & 3; u.x0 = 0; u.a = memn + (size_t)u.pm * BM * D * 2; u.b = wk + (size_t)u.pn * BM * D * 2; }
        else { const int l = L - 64; u.pm = l >> 4; u.pn = l & 15; u.x0 = 1; u.a = wv + (size_t)u.pm * BM * D * 2; u.b = memn + (size_t)u.pn * BM * D * 2; }
        return true;
    }
};
template <int MODE> struct XaOrder {
    const char* A; const char* B; int G, c;
    __device__ __forceinline__ bool next(int i, Unit& u) const {
        const int L = i * G + c; if (L >= NB * XH * 16) return false;
        const int qt = L & 15, bh = L >> 4, b = bh >> 2, h = bh & 3;
        u.pm = b * 16 + qt; u.pn = h; u.x0 = 0; u.x1 = 0; u.rows = nullptr;
        u.a = A + ((size_t)u.pm * BM * D + h * XHD) * 2;
        if (MODE == 0) u.b = B + ((size_t)b * MEML * D + h * XHD) * 2;
        else u.b = B + ((size_t)h * XHD * MROWS + b * MEML) * 2;
        return true;
    }
};
template <int MODE> struct MoeOrder {
    const char* A; const char* W; const int* rowtok; const int* etile; int G, c;
    __device__ __forceinline__ bool next(int i, Unit& u) const {
        const int L = i * G + c; const int ntile = etile[NE];
        if (L >= ntile * 4) return false;
        const int rt = L >> 2, ct = L & 3; int e = 0;
        for (int j = 1; j < NE; ++j) e = (etile[j] <= rt) ? j : e;
        u.pm = rt; u.pn = ct; u.x0 = e; u.x1 = 0;
        if (MODE == 0) { u.a = A; u.rows = rowtok + rt * BM; u.b = W + ((size_t)e * 1024 + ct * BM) * D * 2; }
        else { u.a = A + (size_t)rt * BM * FF * 2; u.rows = nullptr; u.b = W + ((size_t)e * 1024 + ct * BM) * FF * 2; }
        return true;
    }
};

struct EpiU {
    static constexpr bool PERM = true; EPI_NOMID
    bf16_t* Cb; bf16_t* Q; bf16_t* Kb; bf16_t* V; const float* ropec; const float* ropes;
    __device__ __forceinline__ void operator()(Acc& acc, const Unit& u, int wr, int wc, int fr, int fq, LAS unsigned char*, int, int) const {
        const int row0 = u.pm * BM + wr * 64 + fr;
        if (u.pn < 2) {
#pragma unroll
            for (int ai = 0; ai < 2; ++ai)
#pragma unroll
                for (int m = 0; m < 4; ++m) { const int row = row0 + ai * HALF + m * 16; f32x4 o[2];
#pragma unroll
                    for (int n = 0; n < 2; ++n)
#pragma unroll
                        for (int i = 0; i < 4; ++i) { const float a = acc[ai][0][m][n][i], g = acc[ai][1][m][n][i]; o[n][i] = a / (1.f + __expf(-g)); }
                    *(u32x4*)(Cb + (size_t)row * CCH + u.pn * HALF + wc * 32 + fq * 8) = pack8(o[0], o[1]); }
        } else if (u.pn < 8) {
            const int sec = (u.pn - 2) / 3, tt = (u.pn - 2) % 3; bf16_t* dst = sec ? Kb : Q; const float sc = sec ? 1.f : 0.125f * LOG2E;
            const int colb = (4 * tt + wc) * HD + fq * 8;
#pragma unroll
            for (int ai = 0; ai < 2; ++ai)
#pragma unroll
                for (int m = 0; m < 4; ++m) { const int row = row0 + ai * HALF + m * 16; const int s = row & (SEQ - 1); f32x4 o1[2], o2[2];
#pragma unroll
                    for (int n = 0; n < 2; ++n) { const f32x4 cs = *(const f32x4*)(ropec + s * 32 + fq * 8 + n * 4), sn = *(const f32x4*)(ropes + s * 32 + fq * 8 + n * 4);
                        const f32x4 x1 = acc[ai][0][m][n], x2 = acc[ai][1][m][n];
                        o1[n] = (x1 * cs - x2 * sn) * sc; o2[n] = (x1 * sn + x2 * cs) * sc; }
                    bf16_t* p = dst + (size_t)row * AW + colb;
                    *(u32x4*)p = pack8(o1[0], o1[1]); *(u32x4*)(p + 32) = pack8(o2[0], o2[1]); }
        } else {
            const int tt = u.pn - 8;
#pragma unroll
            for (int ai = 0; ai < 2; ++ai)
#pragma unroll
                for (int m = 0; m < 4; ++m) { const int row = row0 + ai * HALF + m * 16;
#pragma unroll
                    for (int bj = 0; bj < 2; ++bj) *(u32x4*)(V + (size_t)row * AW + tt * BM + bj * HALF + wc * 32 + fq * 8) = pack8(acc[ai][bj][m][0], acc[ai][bj][m][1]); }
        }
    }
};
template <bool ROWSCALE> struct EpiPlain {
    static constexpr bool PERM = true; EPI_NOMID
    bf16_t* O0; int ldc0; bf16_t* O1; int ldc1; const float* ssq16;
    __device__ __forceinline__ void operator()(Acc& acc, const Unit& u, int wr, int wc, int fr, int fq, LAS unsigned char*, int, int) const {
        bf16_t* O = u.x0 ? O1 : O0; const int ldc = u.x0 ? ldc1 : ldc0;
        const int row0 = u.pm * BM + wr * 64 + fr, col0 = u.pn * BM + wc * 32 + fq * 8;
#pragma unroll
        for (int ai = 0; ai < 2; ++ai)
#pragma unroll
            for (int m = 0; m < 4; ++m) { const int row = row0 + ai * HALF + m * 16; float rs = 1.f;
                if constexpr (ROWSCALE) { const f32x4* sp = (const f32x4*)(ssq16 + (size_t)row * 16); const f32x4 s0 = sp[0], s1 = sp[1], s2 = sp[2], s3 = sp[3];
                    const f32x4 st = (s0 + s1) + (s2 + s3); rs = 1.0f / sqrtf(((st[0] + st[1]) + (st[2] + st[3])) * (1.0f / D) + NORM_EPS); }
#pragma unroll
                for (int bj = 0; bj < 2; ++bj) *(u32x4*)(O + (size_t)row * ldc + col0 + bj * HALF) = pack8(acc[ai][bj][m][0] * rs, acc[ai][bj][m][1] * rs); }
    }
};
template <bool MID> struct EpiResid {
    static constexpr bool PERM = false, HAS_MID = MID;
    const float* xin; float* xout; bf16_t* XB; float* ssqp; const float* ssqa;
    __device__ __forceinline__ int mid_t() const { return AW / BK; }
    __device__ __forceinline__ void mid(Acc& acc, const Unit& u, int wr, int wc, int fr, int fq) const {
        const int row0 = u.pm * BM + wr * 64 + fr;
#pragma unroll
        for (int ai = 0; ai < 2; ++ai)
#pragma unroll
            for (int m = 0; m < 4; ++m) { const int row = row0 + ai * HALF + m * 16; const f32x4* sp = (const f32x4*)(ssqa + (size_t)row * NH);
                const f32x4 s0 = sp[0], s1 = sp[1], s2 = sp[2]; const f32x4 st = (s0 + s1) + s2;
                const float r = 1.0f / sqrtf(((st[0] + st[1]) + (st[2] + st[3])) * (1.0f / AW) + NORM_EPS);
#pragma unroll
                for (int bj = 0; bj < 2; ++bj)
#pragma unroll
                    for (int n = 0; n < 2; ++n) acc[ai][bj][m][n] = acc[ai][bj][m][n] * r;
                asm volatile("" ::: "memory"); }
    }
    __device__ __forceinline__ void operator()(Acc& acc, const Unit& u, int wr, int wc, int fr, int fq, LAS unsigned char*, int, int) const {
        const int row0 = u.pm * BM + wr * 64 + fr, col0 = u.pn * BM + wc * 32 + fq * 4;
#pragma unroll
        for (int ai = 0; ai < 2; ++ai)
#pragma unroll
            for (int m = 0; m < 4; ++m) { const int row = row0 + ai * HALF + m * 16; float ss = 0.f;
#pragma unroll
                for (int bj = 0; bj < 2; ++bj)
#pragma unroll
                    for (int n = 0; n < 2; ++n) { const size_t o = (size_t)row * D + col0 + bj * HALF + n * 16;
                        const f32x4 v = *(const f32x4*)(xin + o) + acc[ai][bj][m][n];
                        *(f32x4*)(xout + o) = v; u32x2 w; w.x = cvt_pk_bf16(v[0], v[1]); w.y = cvt_pk_bf16(v[2], v[3]); *(u32x2*)(XB + o) = w;
                        ss += (v[0] * v[0] + v[1] * v[1]) + (v[2] * v[2] + v[3] * v[3]); }
                ss += __shfl_xor(ss, 16); ss += __shfl_xor(ss, 32);
                if (fq == 0) ssqp[(size_t)row * 16 + u.pn * 4 + wc] = ss; }
    }
};
struct EpiSoftmax {
    static constexpr bool PERM = true; EPI_NOMID
    bf16_t* PM;
    __device__ __forceinline__ void operator()(Acc& acc, const Unit& u, int wr, int wc, int fr, int fq, LAS unsigned char* lds, int, int) const {
        LAS float* MX = (LAS float*)(lds + XCH_OFF); LAS float* SM = (LAS float*)(lds + XCH_OFF + 4096);
#pragma unroll
        for (int ai = 0; ai < 2; ++ai)
#pragma unroll
            for (int m = 0; m < 4; ++m) { const int rl = ai * HALF + wr * 64 + m * 16 + fr; float mx = -3.0e38f;
#pragma unroll
                for (int bj = 0; bj < 2; ++bj)
#pragma unroll
                    for (int n = 0; n < 2; ++n) { const f32x4 v = acc[ai][bj][m][n]; mx = fmaxf(mx, fmaxf(fmaxf(v[0], v[1]), fmaxf(v[2], v[3]))); }
                mx = fmaxf(mx, __shfl_xor(mx, 16)); mx = fmaxf(mx, __shfl_xor(mx, 32));
                if (fq == 0) MX[rl * 4 + wc] = mx; }
        RAW_BARRIER();
#pragma unroll
        for (int ai = 0; ai < 2; ++ai)
#pragma unroll
            for (int m = 0; m < 4; ++m) { const int rl = ai * HALF + wr * 64 + m * 16 + fr; const f32x4 mm = *(const LAS f32x4*)(MX + rl * 4);
                const float mx = fmaxf(fmaxf(mm[0], mm[1]), fmaxf(mm[2], mm[3])); float ss = 0.f;
#pragma unroll
                for (int bj = 0; bj < 2; ++bj)
#pragma unroll
                    for (int n = 0; n < 2; ++n) { f32x4 v = acc[ai][bj][m][n];
#pragma unroll
                        for (int i = 0; i < 4; ++i) { v[i] = __builtin_amdgcn_exp2f(v[i] - mx); ss += v[i]; }
                        acc[ai][bj][m][n] = v; }
                ss += __shfl_xor(ss, 16); ss += __shfl_xor(ss, 32);
                if (fq == 0) SM[rl * 4 + wc] = ss; }
        RAW_BARRIER();
        const int col0 = u.pn * BM + wc * 32 + fq * 8;
#pragma unroll
        for (int ai = 0; ai < 2; ++ai)
#pragma unroll
            for (int m = 0; m < 4; ++m) { const int rl = ai * HALF + wr * 64 + m * 16 + fr; const f32x4 s4 = *(const LAS f32x4*)(SM + rl * 4);
                const float inv = 1.0f / ((s4[0] + s4[1]) + (s4[2] + s4[3]));
#pragma unroll
                for (int bj = 0; bj < 2; ++bj) *(u32x4*)(PM + (size_t)(u.pm * BM + rl) * D + col0 + bj * HALF) = pack8(acc[ai][bj][m][0] * inv, acc[ai][bj][m][1] * inv); }
    }
};
struct EpiMoe1 {
    static constexpr bool PERM = true; EPI_NOMID
    bf16_t* HID; const float* slot_rs;
    __device__ __forceinline__ void operator()(Acc& acc, const Unit& u, int wr, int wc, int fr, int fq, LAS unsigned char*, int, int) const {
        const int row0 = u.pm * BM + wr * 64 + fr;
#pragma unroll
        for (int ai = 0; ai < 2; ++ai)
#pragma unroll
            for (int m = 0; m < 4; ++m) { const int row = row0 + ai * HALF + m * 16; const float rs = slot_rs[row]; f32x4 o[2];
#pragma unroll
                for (int n = 0; n < 2; ++n)
#pragma unroll
                    for (int i = 0; i < 4; ++i) { const float a = acc[ai][0][m][n][i] * rs, b = acc[ai][1][m][n][i] * rs; o[n][i] = a * b / (1.f + __expf(-a)); }
                *(u32x4*)(HID + (size_t)row * FF + u.pn * HALF + wc * 32 + fq * 8) = pack8(o[0], o[1]); }
    }
};
struct EpiMoe2 {
    static constexpr bool PERM = true; EPI_NOMID
    bf16_t* Y; const float* slot_gate;
    __device__ __forceinline__ void operator()(Acc& acc, const Unit& u, int wr, int wc, int fr, int fq, LAS unsigned char*, int, int) const {
        const int row0 = u.pm * BM + wr * 64 + fr, col0 = u.pn * BM + wc * 32 + fq * 8;
#pragma unroll
        for (int ai = 0; ai < 2; ++ai)
#pragma unroll
            for (int m = 0; m < 4; ++m) { const int row = row0 + ai * HALF + m * 16; const float g = slot_gate[row];
#pragma unroll
                for (int bj = 0; bj < 2; ++bj) *(u32x4*)(Y + (size_t)row * D + col0 + bj * HALF) = pack8(acc[ai][bj][m][0] * g, acc[ai][bj][m][1] * g); }
    }
};
}
struct Frame {
    LAS unsigned char* lds;
    volatile LAS unsigned* MISC;
    unsigned* ctl;
    unsigned char* ws;
    int tid, lane, wave, vcu, G;
};
struct Args { const void* in[27]; float* out; unsigned char* ws; int ph_lo, ph_hi, li, pad; };

__device__ __forceinline__ void tr_item(const float* W, int ldw, int srcrow0, int srccol0, bf16_t* WT, int dpitch, size_t drow0, int dk0, const float* gk, float sc, LAS float* scr, int lane) {
#pragma unroll 8
    for (int i = 0; i < 32; ++i) { const int kk = 2 * i + (lane >> 5); const float g = gk ? gk[kk] * sc : sc;
        scr[kk * 33 + (lane & 31)] = W[(size_t)(srcrow0 + kk) * ldw + srccol0 + (lane & 31)] * g; }
    LDS_WAIT(); asm volatile("" ::: "memory");
    const int c = lane & 7;
#pragma unroll
    for (int j = 0; j < 4; ++j) { const int n = (lane >> 3) + 8 * j; const LAS float* s = scr + (8 * c) * 33 + n;
        u32x4 o; o.x = pk2(s[0 * 33], s[1 * 33]); o.y = pk2(s[2 * 33], s[3 * 33]); o.z = pk2(s[4 * 33], s[5 * 33]); o.w = pk2(s[6 * 33], s[7 * 33]);
        *(u32x4*)(WT + (drow0 + n) * dpitch + dk0 + 8 * c) = o; }
    LDS_WAIT(); asm volatile("" ::: "memory");
}
__device__ __forceinline__ void rms_row_to_bf16(const float* xrow, const float* g, bf16_t* orow, int lane) {
    const f32x4* xr = (const f32x4*)xrow + lane; const f32x4* gr = (const f32x4*)g + lane;
    f32x4 v[4]; float s = 0.f;
#pragma unroll
    for (int j = 0; j < 4; ++j) { v[j] = xr[64 * j]; s += (v[j][0] * v[j][0] + v[j][1] * v[j][1]) + (v[j][2] * v[j][2] + v[j][3] * v[j][3]); }
    const float rs = 1.0f / sqrtf(wave_sum(s) * (1.f / D) + NORM_EPS);
    u32x2* o8 = (u32x2*)orow + lane;
#pragma unroll
    for (int j = 0; j < 4; ++j) { const f32x4 gg = gr[64 * j]; u32x2 w; w.x = pk2(v[j][0] * rs * gg[0], v[j][1] * rs * gg[1]); w.y = pk2(v[j][2] * rs * gg[2], v[j][3] * rs * gg[3]); o8[64 * j] = w; }
}
__device__ __forceinline__ double rope_inv(int d) {
    const int q = d >> 3, r = d & 7;
    double b = 1.0;
    b = (r == 1) ? 0.7498942093324558273 : b; b = (r == 2) ? 0.56234132519034908039 : b; b = (r == 3) ? 0.42169650342858224857 : b; b = (r == 4) ? 0.3162277660168379332 : b;
    b = (r == 5) ? 0.23713737056616552617 : b; b = (r == 6) ? 0.17782794100389228012 : b; b = (r == 7) ? 0.13335214321633240257 : b;
    const double p = (q == 0) ? 1.0 : (q == 1) ? 0.1 : (q == 2) ? 0.01 : 0.001;
    return b * p;
}
__device__ __forceinline__ void sincos_d(double a, double& sn, double& cs) {
    const double k = __builtin_rint(a * 0.63661977236758134308);
    double y = __builtin_fma(-k, 1.57079632679489655800e+00, a); y = __builtin_fma(-k, 6.12323399573676603587e-17, y);
    const double y2 = y * y;
    double s = 1.0 / 6227020800.0; s = s * y2 - 1.0 / 39916800.0; s = s * y2 + 1.0 / 362880.0; s = s * y2 - 1.0 / 5040.0; s = s * y2 + 1.0 / 120.0; s = s * y2 - 1.0 / 6.0; s = s * y2 * y + y;
    double c = 1.0 / 479001600.0; c = c * y2 - 1.0 / 3628800.0; c = c * y2 + 1.0 / 40320.0; c = c * y2 - 1.0 / 720.0; c = c * y2 + 1.0 / 24.0; c = c * y2 - 0.5; c = c * y2 + 1.0;
    const int qd = ((int)k) & 3;
    sn = (qd == 0) ? s : (qd == 1) ? c : (qd == 2) ? -s : -c;
    cs = (qd == 0) ? c : (qd == 1) ? -s : (qd == 2) ? -c : s;
}
__device__ __forceinline__ void p0_prologue(Frame& F, const Args& A) {
    const float* x = (const float*)A.in[0]; const float* mem = (const float*)A.in[1]; const int* positions = (const int*)A.in[2];
    const float* mix_g = (const float*)A.in[3]; const float* w_in = (const float*)A.in[4];
    const float* attn_out_g = (const float*)A.in[10]; const float* w_out = (const float*)A.in[11];
    const float* xattn_g = (const float*)A.in[12]; const float* mem_g = (const float*)A.in[13];
    const float* w_xq = (const float*)A.in[14]; const float* w_xk = (const float*)A.in[15]; const float* w_xv = (const float*)A.in[16]; const float* w_xo = (const float*)A.in[17];
    const float* moe_g = (const float*)A.in[18]; const float* w_group = (const float*)A.in[19]; const float* w_router = (const float*)A.in[21];
    const float* w1 = (const float*)A.in[23]; const float* w3 = (const float*)A.in[24]; const float* w2 = (const float*)A.in[25];
    unsigned char* ws = F.ws;
    LAS float* scr = (LAS float*)(F.lds + F.wave * 16384);
    const int gw = F.vcu * NWAVES + F.wave, NGW = F.G * NWAVES;
    constexpr int I_IN = 16 * 88, I_SQ = 16 * 32, I_13 = NE * 16 * 32, I_2 = NE * 8 * 32;
    constexpr int NITEMS = I_IN + 5 * I_SQ + I_13 + I_2;
    for (int it = gw; it < NITEMS; it += NGW) {
        int r = it;
        if (r < I_IN) { const int kb = r / 88, nb = r % 88, n0 = 32 * nb, tile = n0 >> 8, j = n0 & 255; int src;
            if (tile < 2) src = (j < 128) ? 128 * tile + j : 256 + 128 * tile + (j - 128);
            else if (tile < 8) { const int sec = (tile - 2) / 3, tt = (tile - 2) % 3, jj = j & 127, hh = jj >> 5; src = 512 + 768 * sec + 256 * tt + 64 * hh + ((j < 128) ? 0 : 32); }
            else src = n0;
            tr_item(w_in, INW, 64 * kb, src, (bf16_t*)(ws + WS_WIN), D, (size_t)n0, 64 * kb, nullptr, 1.f, scr, F.lane); continue; }
        r -= I_IN;
        if (r < I_SQ) { const int kb = r / 32, nb = r % 32, dk0 = 64 * kb; const bool at = dk0 < AW;
            tr_item(w_out, D, at ? CCH + dk0 : dk0 - AW, 32 * nb, (bf16_t*)(ws + WS_WOUT), D, (size_t)(32 * nb), dk0, at ? attn_out_g + dk0 : nullptr, 1.f, scr, F.lane); continue; }
        r -= I_SQ;
        if (r < 4 * I_SQ) { const int which = r / I_SQ, r2 = r % I_SQ, kb = r2 / 32, nb = r2 % 32;
            const float* W = which == 0 ? w_xq : which == 1 ? w_xk : which == 2 ? w_xv : w_xo;
            bf16_t* WT = (bf16_t*)(ws + (which == 0 ? WS_WXQ : which == 1 ? WS_WXK : which == 2 ? WS_WXV : WS_WXO));
            tr_item(W, D, 64 * kb, 32 * nb, WT, D, (size_t)(32 * nb), 64 * kb, which == 0 ? xattn_g + 64 * kb : nullptr, which == 0 ? LOG2E / 16.f : 1.f, scr, F.lane); continue; }
        r -= 4 * I_SQ;
        if (r < I_13) { const int e = r / 512, r2 = r % 512, kb = r2 / 32, nb = r2 % 32, n0 = 32 * nb, tt = n0 >> 8, j = n0 & 255;
            const float* W = ((j < 128) ? w1 : w3) + (size_t)e * D * FF;
            tr_item(W, FF, 64 * kb, 128 * tt + (j & 127), (bf16_t*)(ws + WS_W13), D, (size_t)e * 1024 + n0, 64 * kb, moe_g + 64 * kb, 1.f, scr, F.lane); continue; }
        r -= I_13;
        { const int e = r / 256, r2 = r % 256, kb = r2 / 32, nb = r2 % 32;
            tr_item(w2 + (size_t)e * FF * D, D, 64 * kb, 32 * nb, (bf16_t*)(ws + WS_W2), FF, (size_t)e * 1024 + 32 * nb, 64 * kb, nullptr, 1.f, scr, F.lane); }
    }
    { float* WR = (float*)(ws + WS_HIST + HIST_WR);
      for (int i = blockIdx.x * 512 + F.tid; i < D * 36; i += F.G * 512) { const int k = i / 36, o = i % 36;
          WR[i] = (o < 32 ? w_router[k * 32 + o] : w_group[k * 4 + (o - 32)]) * moe_g[k]; } }
    { float* rc = (float*)(ws + WS_ROPE); float* rsn = rc + SEQ * 32;
      for (int i = blockIdx.x * 512 + F.tid; i < SEQ * 32; i += F.G * 512) { const int s = i >> 5, d = i & 31;
          const float inv = (float)rope_inv(d); const float ang = (float)positions[s] * inv; double sn, cs; sincos_d((double)fabsf(ang), sn, cs); if (ang < 0.f) sn = -sn;
          rc[i] = (float)cs; rsn[i] = (float)sn; } }
    for (int m = gw; m < MROWS; m += NGW) rms_row_to_bf16(mem + (size_t)m * D, mem_g, (bf16_t*)(ws + WS_MEMN) + (size_t)m * D, F.lane);
    for (int m = gw; m < T; m += NGW) rms_row_to_bf16(x + (size_t)m * D, mix_g, (bf16_t*)(ws + WS_R1) + (size_t)m * D, F.lane);
}
namespace att {
typedef short v4i16_t __attribute__((ext_vector_type(4)));
constexpr int LDS_V = 65536;
constexpr float NEG = -1.0e30f;
__device__ __forceinline__ int k_off(int row, int c) { return row * 128 + ((c ^ ((row >> 1) & 7)) << 4); }
__device__ __forceinline__ int v_off(int row, int c) { return LDS_V + row * 128 + ((c ^ (((row >> 1) & 3) << 1)) << 4); }

struct Grp { bf16x8 q0, q1; f32x4 o[4]; float m, l; int qsub; };

template <class PosFn>
__device__ __forceinline__ void stage_rows(LAS unsigned char* lds, const bf16_t* Kb, const bf16_t* Vb, int brow0, int hcol, int nrows, int tid, PosFn posfn) {
    for (int idx = tid; idx < nrows * 8; idx += NWAVES * 64) {
        const int j = idx >> 3, c = idx & 7; int pos = posfn(j); pos = pos < 0 ? 0 : (pos > SEQ - 1 ? SEQ - 1 : pos);
        const size_t off = (size_t)(brow0 + pos) * AW + hcol + c * 8;
        const u32x4 kv = *(const u32x4*)(Kb + off); const u32x4 vv = *(const u32x4*)(Vb + off);
        *(LAS u32x4*)(lds + k_off(j, c)) = kv; *(LAS u32x4*)(lds + v_off(j, c)) = vv;
    }
}
__device__ __forceinline__ void pair(Grp& G, LAS unsigned char* lds, int Rb, int ksub0, int L, int lane) {
    const int key = lane & 15, g = lane >> 4;
    f32x4 s[2];
#pragma unroll
    for (int t = 0; t < 2; ++t) { const int row = Rb + 16 * t + key;
        const bf16x8 k0 = *(const LAS bf16x8*)(lds + k_off(row, g)), k1 = *(const LAS bf16x8*)(lds + k_off(row, 4 + g));
        f32x4 z = (f32x4){0.f, 0.f, 0.f, 0.f};
        z = __builtin_amdgcn_mfma_f32_16x16x32_bf16(k0, G.q0, z, 0, 0, 0); s[t] = __builtin_amdgcn_mfma_f32_16x16x32_bf16(k1, G.q1, z, 0, 0, 0); }
    bool valid[2][4]; float mx = NEG;
#pragma unroll
    for (int t = 0; t < 2; ++t)
#pragma unroll
        for (int i = 0; i < 4; ++i) { const int ks = ksub0 + 16 * t + 4 * g + i;
            valid[t][i] = ((unsigned)(ks - G.qsub + 64) <= 128u) && ((unsigned)ks < (unsigned)L);
            mx = fmaxf(mx, valid[t][i] ? s[t][i] : NEG); }
    mx = fmaxf(mx, __shfl_xor(mx, 16)); mx = fmaxf(mx, __shfl_xor(mx, 32));
    const float mn = fmaxf(G.m, mx), alpha = __builtin_amdgcn_exp2f(G.m - mn);
    G.m = mn; float ps = 0.f; float p[2][4];
#pragma unroll
    for (int t = 0; t < 2; ++t)
#pragma unroll
        for (int i = 0; i < 4; ++i) { p[t][i] = valid[t][i] ? __builtin_amdgcn_exp2f(s[t][i] - mn) : 0.f; ps += p[t][i]; }
    G.l = G.l * alpha + ps;
    u32x4 pw; pw.x = cvt_pk_bf16(p[0][0], p[0][1]); pw.y = cvt_pk_bf16(p[0][2], p[0][3]); pw.z = cvt_pk_bf16(p[1][0], p[1][1]); pw.w = cvt_pk_bf16(p[1][2], p[1][3]);
    const bf16x8 pb = __builtin_bit_cast(bf16x8, pw);
    const int q = (lane >> 2) & 3, p2 = lane & 3;
#pragma unroll
    for (int db = 0; db < 4; ++db) { const int c = 2 * db + (p2 >> 1);
        const int r0 = Rb + 4 * g + q, r1 = r0 + 16;
        const s16x4 v0 = __builtin_bit_cast(s16x4, __builtin_amdgcn_ds_read_tr16_b64_v4i16((LAS v4i16_t*)(lds + v_off(r0, c) + 8 * (p2 & 1))));
        const s16x4 v1 = __builtin_bit_cast(s16x4, __builtin_amdgcn_ds_read_tr16_b64_v4i16((LAS v4i16_t*)(lds + v_off(r1, c) + 8 * (p2 & 1))));
        const bf16x8 vf = (bf16x8){v0[0], v0[1], v0[2], v0[3], v1[0], v1[1], v1[2], v1[3]};
        G.o[db] = __builtin_amdgcn_mfma_f32_16x16x32_bf16(vf, pb, G.o[db] * alpha, 0, 0, 0); }
}
__device__ __forceinline__ void grp_init(Grp& G, const bf16_t* Qb, int brow0, int hcol, int c0, int r, int lane) {
    const int a = lane & 15, g = lane >> 4; const bf16_t* qp = Qb + (size_t)(brow0 + c0 + r + 16 * a) * AW + hcol + 8 * g;
    G.q0 = *(const bf16x8*)qp; G.q1 = *(const bf16x8*)(qp + 32);
#pragma unroll
    for (int d = 0; d < 4; ++d) G.o[d] = (f32x4){0.f, 0.f, 0.f, 0.f};
    G.m = NEG; G.l = 0.f; G.qsub = 0;
}
__device__ __forceinline__ void grp_finish(Grp& G, bf16_t* MIX, float* ssqa, int brow0, int h, int c0, int r, int lane) {
    const int a = lane & 15, g = lane >> 4; float l = G.l; l += __shfl_xor(l, 16); l += __shfl_xor(l, 32);
    const float inv = 1.0f / l; const size_t tok = (size_t)(brow0 + c0 + r + 16 * a); float ss = 0.f;
#pragma unroll
    for (int db = 0; db < 4; ++db) { const f32x4 o = G.o[db] * inv; ss += (o[0] * o[0] + o[1] * o[1]) + (o[2] * o[2] + o[3] * o[3]);
        u32x2 w; w.x = cvt_pk_bf16(o[0], o[1]); w.y = cvt_pk_bf16(o[2], o[3]); *(u32x2*)(MIX + tok * D + h * HD + 16 * db + 4 * g) = w; }
    ss += __shfl_xor(ss, 16); ss += __shfl_xor(ss, 32);
    if (g == 0) ssqa[tok * NH + h] = ss;
}
#define ATT_SYNC() do { asm volatile("s_waitcnt vmcnt(0) lgkmcnt(0)" ::: "memory"); __builtin_amdgcn_s_barrier(); asm volatile("" ::: "memory"); } while (0)
__device__ __forceinline__ void attn_unit(LAS unsigned char* lds, const bf16_t* Qb, const bf16_t* Kb, const bf16_t* Vb, bf16_t* MIX, float* ssqa, int b, int h, int c0, int tid, int wave, int lane) {
    const int brow0 = b * SEQ, hcol = h * HD, a = lane & 15;
    Grp G0, G1;
    grp_init(G0, Qb, brow0, hcol, c0, wave, lane); grp_init(G1, Qb, brow0, hcol, c0, wave + 8, lane);
    ATT_SYNC();
    stage_rows(lds, Kb, Vb, brow0, hcol, 384, tid, [&](int j) { return c0 - 64 + j; });
    ATT_SYNC();
    G0.qsub = c0 + wave + 16 * a; G1.qsub = c0 + wave + 8 + 16 * a;
    for (int p = 0; p < 12; ++p) { pair(G0, lds, 32 * p, c0 - 64 + 32 * p, SEQ, lane); pair(G1, lds, 32 * p, c0 - 64 + 32 * p, SEQ, lane); }
    G0.qsub = (c0 >> 2) + (wave >> 2) + 4 * a; G1.qsub = (c0 >> 2) + ((wave + 8) >> 2) + 4 * a;
    for (int st = 0; st < 2; ++st) {
        ATT_SYNC();
        stage_rows(lds, Kb, Vb, brow0, hcol, 384, tid, [&](int j) { const int c = j / 96, jj = j - 96 * c; return 4 * ((c0 >> 2) - 64 + 96 * st + jj) + c; });
        ATT_SYNC();
        const int c = wave & 3;
        for (int p = 0; p < 3; ++p) { const int Rb = 96 * c + 32 * p, ks = (c0 >> 2) - 64 + 96 * st + 32 * p; pair(G0, lds, Rb, ks, SEQ / 4, lane); pair(G1, lds, Rb, ks, SEQ / 4, lane); }
    }
    G0.qsub = (c0 >> 4) + a; G1.qsub = (c0 >> 4) + a;
    for (int st = 0; st < 5; ++st) {
        ATT_SYNC();
        stage_rows(lds, Kb, Vb, brow0, hcol, 512, tid, [&](int j) { const int r = j >> 5, jj = j & 31; return 16 * ((c0 >> 4) - 64 + 32 * st + jj) + r; });
        ATT_SYNC();
        const int ks = (c0 >> 4) - 64 + 32 * st;
        pair(G0, lds, 32 * wave, ks, SEQ / 16, lane); pair(G1, lds, 32 * (wave + 8), ks, SEQ / 16, lane);
    }
    grp_finish(G0, MIX, ssqa, brow0, h, c0, wave, lane); grp_finish(G1, MIX, ssqa, brow0, h, c0, wave + 8, lane);
}
__device__ __forceinline__ void conv_unit(LAS unsigned char* lds, const bf16_t* Cb, bf16_t* MIX, const float* dw_w, const float* dw_b, const float* ln_g, const float* ln_b, const float* out_g,
                                          int b, int s0, int tid, int wave, int lane) {
    LAS bf16_t* CT = (LAS bf16_t*)lds;
    LAS float* CO = (LAS float*)(lds + 49152);
    ATT_SYNC();
    for (int p = tid; p < 94 * 32; p += NWAVES * 64) { const int row = p >> 5, c = p & 31, s = s0 - 15 + row;
        u32x4 v = (u32x4){0u, 0u, 0u, 0u};
        if (s >= 0 && s < SEQ) v = *(const u32x4*)(Cb + (size_t)(b * SEQ + s) * CCH + c * 8);
        *(LAS u32x4*)(CT + row * CCH + c * 8) = v; }
    ATT_SYNC();
    { const int ch = tid & 255, half = tid >> 8; float v[62], w[CONVK];
#pragma unroll
      for (int k = 0; k < CONVK; ++k) w[k] = dw_w[k * CCH + ch];
#pragma unroll
      for (int i = 0; i < 62; ++i) v[i] = bf2f(CT[(32 * half + i) * CCH + ch]);
      const float bias = dw_b[ch];
#pragma unroll
      for (int p = 0; p < 32; ++p) { float acc = bias;
#pragma unroll
          for (int k = 0; k < CONVK; ++k) acc += v[p + k] * w[k];
          CO[(32 * half + p) * CCH + ch] = acc; } }
    ATT_SYNC();
    { const f32x4 g4 = *((const f32x4*)ln_g + lane), b4 = *((const f32x4*)ln_b + lane), og = *((const f32x4*)out_g + lane);
#pragma unroll
      for (int pp = 0; pp < 8; ++pp) { const int p = wave * 8 + pp; const f32x4 xv = *(const LAS f32x4*)(CO + p * CCH + 4 * lane);
          const float mean = wave_sum((xv[0] + xv[1]) + (xv[2] + xv[3])) * (1.f / CCH); const f32x4 dx = xv - mean;
          const float var = wave_sum((dx[0] * dx[0] + dx[1] * dx[1]) + (dx[2] * dx[2] + dx[3] * dx[3])) * (1.f / CCH); const float rstd = 1.0f / sqrtf(var + LN_EPS);
          f32x4 z;
#pragma unroll
          for (int i = 0; i < 4; ++i) { const float y = dx[i] * rstd * g4[i] + b4[i]; z[i] = y / (1.f + __expf(-y)); }
          const float ms = wave_sum((z[0] * z[0] + z[1] * z[1]) + (z[2] * z[2] + z[3] * z[3])) * (1.f / CCH); const float rs = 1.0f / sqrtf(ms + NORM_EPS);
          u32x2 o; o.x = cvt_pk_bf16(z[0] * rs * og[0], z[1] * rs * og[1]); o.y = cvt_pk_bf16(z[2] * rs * og[2], z[3] * rs * og[3]);
          *(u32x2*)(MIX + (size_t)(b * SEQ + s0 + p) * D + AW + 4 * lane) = o; } }
}
}
namespace moe {
#define MOE_SYNC() do { asm volatile("s_waitcnt vmcnt(0) lgkmcnt(0)" ::: "memory"); __builtin_amdgcn_s_barrier(); asm volatile("" ::: "memory"); } while (0)
__device__ __forceinline__ void route_chunk(LAS unsigned char* lds, const float* x2, const float* ssq2, const float* WR, const float* b_router, const float* b_group,
                                            int* tok_e, float* tok_gate, float* tok_rs, int* hist, int chunk, int tid, int wave, int lane) {
    LAS float* XT = (LAS float*)lds;
    LAS float* LG = (LAS float*)(lds + 69632);
    LAS int* HS = (LAS int*)(lds + 69632 + 36864);
    const int tl = (wave & 3) * 64 + lane, oh = wave >> 2;
    float acc[18];
#pragma unroll
    for (int o = 0; o < 18; ++o) acc[o] = 0.f;
    if (tid < 32) HS[tid] = 0;
    for (int kb = 0; kb < 16; ++kb) {
        MOE_SYNC();
#pragma unroll
        for (int i = 0; i < 8; ++i) { const int p = tid + 512 * i, row = p >> 4, c4 = p & 15;
            *(LAS f32x4*)(XT + row * 68 + c4 * 4) = *(const f32x4*)(x2 + (size_t)(chunk * 256 + row) * D + kb * 64 + c4 * 4); }
        MOE_SYNC();
        for (int k4 = 0; k4 < 16; ++k4) { const f32x4 xv = *(const LAS f32x4*)(XT + tl * 68 + k4 * 4);
#pragma unroll
            for (int e = 0; e < 4; ++e) { const float* wrow = WR + (size_t)(kb * 64 + k4 * 4 + e) * 36 + oh * 18;
#pragma unroll
                for (int o = 0; o < 18; ++o) acc[o] += xv[e] * wrow[o]; } }
    }
    const int t = chunk * 256 + tl;
    { const f32x4* sp = (const f32x4*)(ssq2 + (size_t)t * 16); const f32x4 st = (sp[0] + sp[1]) + (sp[2] + sp[3]);
      const float rs = 1.0f / sqrtf(((st[0] + st[1]) + (st[2] + st[3])) * (1.f / D) + NORM_EPS);
      if (oh == 0) tok_rs[t] = rs;
#pragma unroll
      for (int o = 0; o < 18; ++o) { const int og = oh * 18 + o; LG[tl * 36 + og] = acc[o] * rs + (og < 32 ? b_router[og] : b_group[og - 32]); } }
    MOE_SYNC();
    if (wave < 4) { const int tr = wave * 64 + lane, tg = chunk * 256 + tr; const LAS float* lg = LG + tr * 36;
        float gm = lg[32]; int gi = 0;
#pragma unroll
        for (int j = 1; j < 4; ++j) { const float v = lg[32 + j]; if (v > gm) { gm = v; gi = j; } }
        float den = 0.f;
#pragma unroll
        for (int j = 0; j < 4; ++j) den += __expf(lg[32 + j] - gm);
        const float gp = 1.0f / den;
        float v0 = -3.0e38f, v1 = -3.0e38f; int i0 = 0, i1 = 0;
#pragma unroll
        for (int j = 0; j < 8; ++j) { const float v = lg[gi * 8 + j];
            if (v > v0) { v1 = v0; i1 = i0; v0 = v; i0 = j; } else if (v > v1) { v1 = v; i1 = j; } }
        const float dd = __expf(v1 - v0), g0 = gp / (1.f + dd), g1 = gp * dd / (1.f + dd);
        const int e0 = gi * 8 + i0, e1 = gi * 8 + i1;
        __hip_atomic_fetch_add(HS + e0, 1, __ATOMIC_RELAXED, __HIP_MEMORY_SCOPE_WORKGROUP); __hip_atomic_fetch_add(HS + e1, 1, __ATOMIC_RELAXED, __HIP_MEMORY_SCOPE_WORKGROUP);
        tok_e[tg] = e0 | (e1 << 8); tok_gate[2 * tg] = g0; tok_gate[2 * tg + 1] = g1; }
    MOE_SYNC();
    if (tid < 32) hist[chunk * 32 + tid] = HS[tid];
}
__device__ __forceinline__ void slot_chunk(LAS unsigned char* lds, const int* hist, const int* tok_e, const float* tok_gate, const float* tok_rs, int* tok_slot, int* row_tok, float* slot_rs, float* slot_gate, int* etile,
                                           int chunk, int tid, int wave, int lane) {
    LAS int* CNT = (LAS int*)lds; LAS int* BASE = CNT + 32; LAS int* PST = CNT + 64; LAS int* WC = CNT + 128;
    MOE_SYNC();
    if (tid < 32) { int tot = 0, bs = 0; for (int cc = 0; cc < 256; ++cc) { const int hh = hist[cc * 32 + tid]; bs += (cc < chunk) ? hh : 0; tot += hh; } CNT[tid] = tot; BASE[tid] = bs; }
    MOE_SYNC();
    if (tid == 0) { int ps = 0; for (int e = 0; e < 32; ++e) { PST[e] = ps; ps += ((CNT[e] + 255) >> 8) << 8; } PST[32] = ps; }
    MOE_SYNC();
    int ek[2] = {0, 0}, rank[2] = {0, 0}; const int t = chunk * 256 + (wave & 3) * 64 + lane;
    if (wave < 4) { const int ev = tok_e[t]; ek[0] = ev & 255; ek[1] = ev >> 8;
#pragma unroll
        for (int k = 0; k < 2; ++k)
#pragma nounroll
            for (int e = 0; e < 32; ++e) { const unsigned long long m = __ballot(ek[k] == e);
                if (ek[k] == e) rank[k] = __popcll(m & ((1ull << lane) - 1ull));
                if (lane == 0) WC[(k * 4 + wave) * 32 + e] = __popcll(m); } }
    MOE_SYNC();
    if (wave < 4) {
#pragma unroll
        for (int k = 0; k < 2; ++k) { int off = 0;
            for (int kw = 0; kw < k * 4 + wave; ++kw) off += WC[kw * 32 + ek[k]];
            const int slot = PST[ek[k]] + BASE[ek[k]] + off + rank[k];
            row_tok[slot] = t; slot_rs[slot] = tok_rs[t]; slot_gate[slot] = tok_gate[2 * t + k]; tok_slot[2 * t + k] = slot; } }
    if (chunk < 32) { const int e = chunk, c0 = PST[e] + CNT[e], n = PST[e + 1] - c0;
        for (int i = tid; i < n; i += NWAVES * 64) { row_tok[c0 + i] = 0; slot_rs[c0 + i] = 0.f; slot_gate[c0 + i] = 0.f; } }
    if (chunk == 0 && tid <= 32) etile[tid] = PST[tid] >> 8;
}
__device__ __forceinline__ void final_row(float* xo, const bf16_t* Y, const int* tok_slot, const float* g, int t, int lane) {
    const int s0 = tok_slot[2 * t], s1 = tok_slot[2 * t + 1];
    f32x4* xr = (f32x4*)(xo + (size_t)t * D) + lane; const u32x2* y0 = (const u32x2*)(Y + (size_t)s0 * D) + lane; const u32x2* y1 = (const u32x2*)(Y + (size_t)s1 * D) + lane;
    const f32x4* gr = (const f32x4*)g + lane;
    f32x4 v[4]; float s = 0.f;
#pragma unroll
    for (int j = 0; j < 4; ++j) { const f32x4 x = xr[64 * j]; const u32x2 a = y0[64 * j], b = y1[64 * j];
        v[j][0] = x[0] + (bflo(a.x) + bflo(b.x)); v[j][1] = x[1] + (bfhi(a.x) + bfhi(b.x)); v[j][2] = x[2] + (bflo(a.y) + bflo(b.y)); v[j][3] = x[3] + (bfhi(a.y) + bfhi(b.y));
        s += (v[j][0] * v[j][0] + v[j][1] * v[j][1]) + (v[j][2] * v[j][2] + v[j][3] * v[j][3]); }
    const float rs = 1.0f / sqrtf(wave_sum(s) * (1.f / D) + NORM_EPS);
#pragma unroll
    for (int j = 0; j < 4; ++j) xr[64 * j] = v[j] * rs * gr[64 * j];
}
}
#ifndef MK_N_LAUNCHES
#define MK_N_LAUNCHES 1
#endif
constexpr int NPH = 13;
constexpr int N_LAUNCHES = MK_N_LAUNCHES;

template <int LO, int HI>
__global__ void __launch_bounds__(NWAVES * 64, 2) mega_fwd(Args args) {
    extern __shared__ __attribute__((aligned(16))) unsigned char lds_raw[];
    Frame F;
    F.lds = (LAS unsigned char*)lds_raw;
    F.MISC = (volatile LAS unsigned*)(F.lds + LDSCTL_OFF);
    F.tid = threadIdx.x; F.lane = F.tid & 63; F.wave = __builtin_amdgcn_readfirstlane(F.tid >> 6);
    F.G = gridDim.x; { const int bx = blockIdx.x; F.vcu = (F.G % 8 == 0) ? (bx % 8) * (F.G / 8) + bx / 8 : bx; }
    F.ws = args.ws; F.ctl = (unsigned*)(args.ws + WS_CTL);
    for (int u = F.tid; u < (LDS_BYTES - LDSCTL_OFF) / 4; u += NWAVES * 64) ((LAS unsigned*)(F.lds + LDSCTL_OFF))[u] = 0u;
    __syncthreads();
    XcdBarrier bar; bar.bar = F.ctl + CW_BAR; bar.x = 0; bar.st = nullptr;
    if (HI - LO > 1) bar = xcd_barrier_post(F.ctl + CW_BAR, F.MISC + 8);
#define GRID_BAR() do { if (HI - LO > 1) xcd_barrier(bar); } while (0)
#ifndef PH_MASK
#define PH_MASK 0x1fff
#endif
#define IN(k) ((((PH_MASK) >> (k)) & 1) && LO <= (k) && (k) < HI)
#define BOTH(k) (IN(k) && IN((k) + 1))
    unsigned char* const ws = args.ws;
    const int gw = F.vcu * NWAVES + F.wave, NGW = F.G * NWAVES;
#define R1 ((bf16_t*)(ws + WS_R1))
#define R2 ((bf16_t*)(ws + WS_R2))
#define ssqa ((float*)(ws + WS_SSQA))
#define ssq1 ((float*)(ws + WS_SSQ1))
#define ssq2 ((float*)(ws + WS_SSQ2))
#define tok_e ((int*)(ws + WS_TOK + TK_E))
#define tok_gate ((float*)(ws + WS_TOK + TK_GATE))
#define tok_slot ((int*)(ws + WS_TOK + TK_SLOT))
#define tok_rs ((float*)(ws + WS_TOK + TK_RS))
#define row_tok ((int*)(ws + WS_TOK + TK_ROWTOK))
#define slot_rs ((float*)(ws + WS_TOK + TK_SLOTRS))
#define slot_gate ((float*)(ws + WS_TOK + TK_SLOTGATE))
#define hist ((int*)(ws + WS_HIST))
#define etile ((int*)(ws + WS_HIST + HIST_ETILE))
#define WR ((const float*)(ws + WS_HIST + HIST_WR))

    if (IN(0)) { p0_prologue(F, args); if (BOTH(0)) GRID_BAR(); }

    if (IN(1)) {
        { pg8::GridOrder S; S.init(R1, ws + WS_WIN, D, D, T, INW, F.G, (int)blockIdx.x);
          pg8::EpiU E{R2, (bf16_t*)(ws + WS_Q), (bf16_t*)(ws + WS_K), (bf16_t*)(ws + WS_V), (const float*)(ws + WS_ROPE), (const float*)(ws + WS_ROPE) + SEQ * 32};
          pg8::gemm_phase<pg8::EpiU, pg8::GridOrder, true, false>(F.lds, D, D, D, S, E); }
        { pg8::KvOrder S{(const char*)(ws + WS_MEMN), (const char*)(ws + WS_WXK), (const char*)(ws + WS_WXV), F.G, (int)blockIdx.x};
          pg8::EpiPlain<false> E{(bf16_t*)(ws + WS_KX), D, (bf16_t*)(ws + WS_VXT), MROWS, nullptr};
          pg8::gemm_phase<pg8::EpiPlain<false>, pg8::KvOrder, true, false>(F.lds, D, D, D, S, E); }
        if (BOTH(1)) GRID_BAR();
    }

    if (IN(2)) {
        for (int L = F.vcu; L < NB * NH * 16; L += F.G) { const int chunk = L & 15, bh = L >> 4, b = bh / NH, h = bh % NH;
            att::attn_unit(F.lds, (const bf16_t*)(ws + WS_Q), (const bf16_t*)(ws + WS_K), (const bf16_t*)(ws + WS_V), R1, ssqa, b, h, chunk * 256, F.tid, F.wave, F.lane); }
        for (int L = F.vcu; L < NB * 64; L += F.G) { const int b = L >> 6, j = L & 63;
            att::conv_unit(F.lds, R2, R1, (const float*)args.in[5], (const float*)args.in[6], (const float*)args.in[7], (const float*)args.in[8], (const float*)args.in[9], b, j * 64, F.tid, F.wave, F.lane); }
        asm volatile("s_waitcnt vmcnt(0) lgkmcnt(0)" ::: "memory"); __syncthreads();
        if (BOTH(2)) GRID_BAR();
    }

    if (IN(3)) {
        pg8::GridOrder S; S.init(R1, ws + WS_WOUT, D, D, T, D, F.G, (int)blockIdx.x);
        pg8::EpiResid<true> E{(const float*)args.in[0], args.out, R2, ssq1, ssqa};
        pg8::gemm_phase<pg8::EpiResid<true>, pg8::GridOrder, true, false>(F.lds, D, D, D, S, E);
        if (BOTH(3)) GRID_BAR();
    }

    if (IN(4)) {
        pg8::GridOrder S; S.init(R2, ws + WS_WXQ, D, D, T, D, F.G, (int)blockIdx.x);
        pg8::EpiPlain<true> E{(bf16_t*)(ws + WS_XQ), D, nullptr, 0, ssq1};
        pg8::gemm_phase<pg8::EpiPlain<true>, pg8::GridOrder, true, false>(F.lds, D, D, D, S, E);
        if (BOTH(4)) GRID_BAR();
    }

    if (IN(5)) {
        pg8::XaOrder<0> S{(const char*)(ws + WS_XQ), (const char*)(ws + WS_KX), F.G, F.vcu};
        pg8::EpiSoftmax E{(bf16_t*)(ws + WS_PM)};
        pg8::gemm_phase<pg8::EpiSoftmax, pg8::XaOrder<0>, true, false>(F.lds, D, D, XHD, S, E);
        if (BOTH(5)) GRID_BAR();
    }

    if (IN(6)) {
        pg8::XaOrder<1> S{(const char*)(ws + WS_PM), (const char*)(ws + WS_VXT), F.G, F.vcu};
        pg8::EpiPlain<false> E{R1, D, nullptr, 0, nullptr};
        pg8::gemm_phase<pg8::EpiPlain<false>, pg8::XaOrder<1>, true, false>(F.lds, D, MROWS, MEML, S, E);
        if (BOTH(6)) GRID_BAR();
    }

    if (IN(7)) {
        pg8::GridOrder S; S.init(R1, ws + WS_WXO, D, D, T, D, F.G, (int)blockIdx.x);
        pg8::EpiResid<false> E{args.out, args.out, R2, ssq2, nullptr};
        pg8::gemm_phase<pg8::EpiResid<false>, pg8::GridOrder, true, false>(F.lds, D, D, D, S, E);
        if (BOTH(7)) GRID_BAR();
    }

    if (IN(8)) {
        for (int c = blockIdx.x; c < T / 256; c += F.G)
            moe::route_chunk(F.lds, args.out, ssq2, WR, (const float*)args.in[22], (const float*)args.in[20], tok_e, tok_gate, tok_rs, hist, c, F.tid, F.wave, F.lane);
        asm volatile("s_waitcnt vmcnt(0) lgkmcnt(0)" ::: "memory"); __syncthreads();
        if (BOTH(8)) GRID_BAR();
    }

    if (IN(9)) {
        for (int c = blockIdx.x; c < T / 256; c += F.G)
            moe::slot_chunk(F.lds, hist, tok_e, tok_gate, tok_rs, tok_slot, row_tok, slot_rs, slot_gate, etile, c, F.tid, F.wave, F.lane);
        asm volatile("s_waitcnt vmcnt(0) lgkmcnt(0)" ::: "memory"); __syncthreads();
        if (BOTH(9)) GRID_BAR();
    }

    if (IN(10)) {
        pg8::MoeOrder<0> S{(const char*)R2, (const char*)(ws + WS_W13), row_tok, etile, F.G, (int)blockIdx.x};
        pg8::EpiMoe1 E{(bf16_t*)(ws + WS_HID), slot_rs};
        pg8::gemm_phase<pg8::EpiMoe1, pg8::MoeOrder<0>, true, true>(F.lds, D, D, D, S, E);
        if (BOTH(10)) GRID_BAR();
    }

    if (IN(11)) {
        pg8::MoeOrder<1> S{(const char*)(ws + WS_HID), (const char*)(ws + WS_W2), row_tok, etile, F.G, (int)blockIdx.x};
        pg8::EpiMoe2 E{(bf16_t*)(ws + WS_Y), slot_gate};
        pg8::gemm_phase<pg8::EpiMoe2, pg8::MoeOrder<1>, true, false>(F.lds, FF, FF, FF, S, E);
        if (BOTH(11)) GRID_BAR();
    }

    if (IN(12)) {
        for (int t = gw; t < T; t += NGW) moe::final_row(args.out, (const bf16_t*)(ws + WS_Y), tok_slot, (const float*)args.in[26], t, F.lane);
    }
#undef IN
#undef BOTH
}

typedef void (*kern_t)(Args);
template <int... I> struct PhList {};
extern "C" void kernel_launch(void* const* d_in, const int* in_sizes, int n_in, void* d_out, int out_size, void* d_ws, size_t ws_size, hipStream_t stream) {
    static int grid = 0;
#if MK_N_LAUNCHES == 1
    static const kern_t kerns[1] = {mega_fwd<0, NPH>};
#else
    static const kern_t kerns[NPH] = {mega_fwd<0, 1>, mega_fwd<1, 2>, mega_fwd<2, 3>, mega_fwd<3, 4>, mega_fwd<4, 5>, mega_fwd<5, 6>, mega_fwd<6, 7>, mega_fwd<7, 8>, mega_fwd<8, 9>, mega_fwd<9, 10>, mega_fwd<10, 11>, mega_fwd<11, 12>, mega_fwd<12, 13>};
#endif
    if (grid == 0) {
        if (n_in != 27 || in_sizes[0] != T * D || out_size != T * D || ws_size < WS_END) { fprintf(stderr, "kernel_launch: unexpected problem: n_in %d in0 %d out %d ws %zu (need %zu)\n", n_in, n_in > 0 ? in_sizes[0] : -1, out_size, ws_size, (size_t)WS_END); grid = -1; return; }
        int dev = 0, cus = 0, per_cu = 0;
        if (hipGetDevice(&dev) != hipSuccess || hipDeviceGetAttribute(&cus, hipDeviceAttributeMultiprocessorCount, dev) != hipSuccess) { grid = -1; return; }
        for (int li = 0; li < N_LAUNCHES; ++li)
            if (hipFuncSetAttribute((const void*)kerns[li], hipFuncAttributeMaxDynamicSharedMemorySize, LDS_BYTES) != hipSuccess) { fprintf(stderr, "kernel_launch: hipFuncSetAttribute failed\n"); grid = -1; return; }
        if (hipOccupancyMaxActiveBlocksPerMultiprocessor(&per_cu, (const void*)kerns[0], NWAVES * 64, LDS_BYTES) != hipSuccess || per_cu < 1) { fprintf(stderr, "kernel_launch: occupancy query says %d\n", per_cu); }
        (void)hipGetLastError();
        grid = cus;
    }
    if (grid < 0) return;
    if (hipMemsetAsync((char*)d_ws + WS_CTL, 0, CTL_ZERO_BYTES, stream) != hipSuccess) return;
    Args a{};
    for (int i = 0; i < 27; ++i) a.in[i] = d_in[i];
    a.out = (float*)d_out; a.ws = (unsigned char*)d_ws;
    for (int li = 0; li < N_LAUNCHES; ++li) {
        a.ph_lo = 0; a.ph_hi = 0; a.li = li; a.pad = 0;
        hipLaunchKernelGGL(kerns[li], dim3(grid), dim3(NWAVES * 64), LDS_BYTES, stream, a);
        const hipError_t le = hipPeekAtLastError();
        if (le != hipSuccess) { fprintf(stderr, "kernel_launch: launch %d failed: %s\n", li, hipGetErrorName(le)); break; }
    }
}
```

```cpp
#include <hip/hip_runtime.h>
#include <cstdio>
#include <cstdint>

#define GAS __attribute__((address_space(1)))
#define LAS __attribute__((address_space(3)))
typedef unsigned short bf16_t;
typedef short bf16x8 __attribute__((ext_vector_type(8)));
typedef short s16x4 __attribute__((ext_vector_type(4)));
typedef float f32x4 __attribute__((ext_vector_type(4)));
typedef float f32x2 __attribute__((ext_vector_type(2)));
typedef unsigned u32x4 __attribute__((ext_vector_type(4)));
typedef unsigned u32x2 __attribute__((ext_vector_type(2)));

constexpr int NB = 16, SEQ = 4096, T = NB * SEQ, D = 1024;
constexpr int CCH = 256, NH = 12, HD = 64, AW = NH * HD, INW = 2 * CCH + 3 * AW;
constexpr int MEML = 256, MROWS = NB * MEML, XH = 4, XHD = 256;
constexpr int NE = 32, EPG = 8, NG = 4, FF = 512;
constexpr int CONVK = 31;
constexpr int A_PAD = T * 2 + NE * 256;
constexpr float NORM_EPS = 1e-6f, LN_EPS = 1e-5f;
constexpr float LOG2E = 1.4426950408889634f;

constexpr size_t MiB = 1u << 20;
constexpr size_t WS_CTL = 0, CTL_ZERO_BYTES = 1 * MiB;
constexpr size_t WS_ROPE = 1 * MiB;
constexpr size_t WS_HIST = 2 * MiB;
constexpr size_t WS_SSQA = 4 * MiB;
constexpr size_t WS_SSQ1 = 8 * MiB;
constexpr size_t WS_SSQ2 = 12 * MiB;
constexpr size_t WS_WIN = 16 * MiB, WS_WOUT = 22 * MiB, WS_WXQ = 24 * MiB, WS_WXK = 26 * MiB, WS_WXV = 28 * MiB, WS_WXO = 30 * MiB;
constexpr size_t WS_W13 = 32 * MiB, WS_W2 = 96 * MiB;
constexpr size_t WS_MEMN = 128 * MiB, WS_KX = 136 * MiB, WS_VXT = 144 * MiB;
constexpr size_t WS_TOK = 152 * MiB;
constexpr size_t WS_R1 = 160 * MiB;
constexpr size_t WS_R2 = 288 * MiB;
constexpr size_t WS_Q = 320 * MiB, WS_K = 416 * MiB, WS_V = 512 * MiB;
constexpr size_t WS_XQ = 416 * MiB;
constexpr size_t WS_PM = 544 * MiB;
constexpr size_t WS_HID = 416 * MiB;
constexpr size_t WS_Y = 552 * MiB;
constexpr size_t WS_END = 824 * MiB;
constexpr size_t TK_E = 0;
constexpr size_t TK_GATE = 1 * MiB;
constexpr size_t TK_SLOT = 2 * MiB;
constexpr size_t TK_RS = 3 * MiB;
constexpr size_t TK_ROWTOK = 4 * MiB;
constexpr size_t TK_SLOTRS = 5 * MiB;
constexpr size_t TK_SLOTGATE = 6 * MiB;
constexpr size_t HIST_ETILE = 64 * 1024, HIST_WR = 128 * 1024;

constexpr int CW_BAR = 4096;

constexpr int NWAVES = 8;
constexpr int RING_BYTES = 131072;
constexpr int XCH_OFF = RING_BYTES;
constexpr int LDSCTL_OFF = RING_BYTES + 12288;
constexpr int LDS_BYTES = 147456;

#define LDS_WAIT() asm volatile("s_waitcnt lgkmcnt(0)" ::: "memory")
#define VM_WAIT() asm volatile("s_waitcnt vmcnt(0)" ::: "memory")
__device__ __forceinline__ unsigned f2bf(float f) { unsigned u = __builtin_bit_cast(unsigned, f); return (u + 0x7fffu + ((u >> 16) & 1u)) >> 16; }
__device__ __forceinline__ unsigned pk2(float lo, float hi) { return f2bf(lo) | (f2bf(hi) << 16); }
__device__ __forceinline__ float bf2f(unsigned short b) { return __builtin_bit_cast(float, (unsigned)b << 16); }
__device__ __forceinline__ float bflo(unsigned w) { return __builtin_bit_cast(float, w << 16); }
__device__ __forceinline__ float bfhi(unsigned w) { return __builtin_bit_cast(float, w & 0xffff0000u); }
__device__ __forceinline__ unsigned cvt_pk_bf16(float lo, float hi) { unsigned r; asm volatile("v_cvt_pk_bf16_f32 %0, %1, %2" : "=v"(r) : "v"(lo), "v"(hi)); return r; }
__device__ __forceinline__ float wave_sum(float v) {
#pragma unroll
    for (int o = 1; o < 64; o <<= 1) v += __shfl_xor(v, o);
    return v;
}
#define MK_N_LAUNCHES 1
namespace pg8 {
constexpr int BM = 256, BK = 64, HALF = 128, HTB = HALF * BK * 2  , STAGE_BYTES = 8 * HTB, NXCD = 8, WGM = 8;

__host__ __device__ __forceinline__ int lds_byte(int r, int c) { const int st = (r >> 4) * 2 + (c >> 5), rr = r & 15, cc = c & 31, ob = rr * 64 + cc * 2; return st * 1024 + (ob ^ (((ob >> 9) & 1) << 5)); }
__host__ __device__ __forceinline__ void stage_rc(int b, int& R, int& C) { const int st = b / 1024, sb = b % 1024, swz = sb ^ (((sb >> 9) & 1) << 5); R = (st >> 1) * 16 + swz / 64; C = (st & 1) * 32 + (swz % 64) / 2; }
__host__ __device__ __forceinline__ int perm32(int rho) { const int n = rho >> 4, i = rho & 15; return 8 * (i >> 2) + 4 * n + (i & 3); }

struct Unit { const char* a; const char* b; const int* rows; int pm, pn, x0, x1; };

typedef f32x4 Acc[2][2][4][2];

__device__ __forceinline__ const char* uniform_ptr(const char* p) { const unsigned long long v = (unsigned long long)p;
    const unsigned lo = __builtin_amdgcn_readfirstlane((unsigned)v), hi = __builtin_amdgcn_readfirstlane((unsigned)(v >> 32)); return (const char*)(((unsigned long long)hi << 32) | lo); }
__device__ __forceinline__ void glds16_sv(const char* gbase, unsigned voff, unsigned lds_dst) { unsigned keep;
    asm volatile("s_mov_b32 %0, m0\n\ts_mov_b32 m0, %3\n\ts_nop 0\n\tglobal_load_lds_dwordx4 %1, %2\n\ts_mov_b32 m0, %0" : "=&s"(keep) : "v"(voff), "s"(gbase), "s"(lds_dst) : "memory"); }
template <class Epi, class Sched, bool ALIGN_EPI, bool GATHER>
__device__ __forceinline__ void gemm_phase(LAS unsigned char* lds, const int lda, const int ldb, const int K, const Sched& S, const Epi& E) {
    int tid_ = threadIdx.x; asm volatile("" : "+v"(tid_));
    const int tid = tid_, wid = __builtin_amdgcn_readfirstlane(tid >> 6), lane = tid & 63, wr = wid >> 2, wc = wid & 3, fr = lane & 15, fq = lane >> 4;
    const int nt = K / BK;
    int Rr[2], Cc[2];
    unsigned vA[2][2], vN[2][2], voffB[2];
#pragma unroll
    for (int i = 0; i < 2; ++i) { int R, C; stage_rc(tid * 16 + i * 8192, R, C); Rr[i] = R; Cc[i] = C; const int Rb = Epi::PERM ? ((R & ~31) + perm32(R & 31)) : R;
        voffB[i] = (unsigned)(Rb * ldb + C) * 2u; }
    const size_t kstep = (size_t)(BK * 2);
    const size_t hstepB = (size_t)HALF * ldb * 2, hstepA = (size_t)HALF * lda * 2;
    const unsigned ldsw = (unsigned)wid * 1024u, lds0 = (unsigned)(uintptr_t)lds;
    const int aoff = lds_byte(wr * 64 + fr, fq * 8), boff = lds_byte(wc * 32 + fr, fq * 8);
#define PG8_SA(b, h) (((b) * 2 + (h)) * HTB)
#define PG8_SB(b, h) ((4 + (b) * 2 + (h)) * HTB)
#define PG8_STAGE(bufoff, gbase, voff) do { _Pragma("unroll") for (int _i = 0; _i < 2; ++_i) glds16_sv((gbase), (voff)[_i], lds0 + (unsigned)(bufoff) + ldsw + _i * 8192u); } while (0)
#define PG8_LDA(dst, b, h) do { _Pragma("unroll") for (int m = 0; m < 4; ++m) _Pragma("unroll") for (int k = 0; k < 2; ++k) dst[m][k] = *(const LAS bf16x8*)(lds + PG8_SA(b, h) + aoff + m * 2048 + k * 1024); } while (0)
#define PG8_LDB(dst, b, h) do { _Pragma("unroll") for (int n = 0; n < 2; ++n) _Pragma("unroll") for (int k = 0; k < 2; ++k) dst[n][k] = *(const LAS bf16x8*)(lds + PG8_SB(b, h) + boff + n * 2048 + k * 1024); } while (0)
#define PG8_MMA(ai, bj, At, Bt) do { __builtin_amdgcn_s_setprio(1); _Pragma("unroll") for (int m = 0; m < 4; ++m) _Pragma("unroll") for (int n = 0; n < 2; ++n) _Pragma("unroll") for (int k = 0; k < 2; ++k) \
        acc[ai][bj][m][n] = __builtin_amdgcn_mfma_f32_16x16x32_bf16(Bt[n][k], At[m][k], acc[ai][bj][m][n], 0, 0, 0); __builtin_amdgcn_s_setprio(0); } while (0)
#define PG8_WAIT_V(n) asm volatile("s_waitcnt vmcnt(" #n ")" ::: "memory")
#define PG8_WAIT_L(n) asm volatile("s_waitcnt lgkmcnt(" #n ")" ::: "memory")
#define PG8_BAR __builtin_amdgcn_s_barrier()
#define PG8_SCHED __builtin_amdgcn_sched_barrier(0)
#define PG8_VOFF(dst, u) do { _Pragma("unroll") for (int _h = 0; _h < 2; ++_h) _Pragma("unroll") for (int _i = 0; _i < 2; ++_i) { \
        if constexpr (GATHER) dst[_h][_i] = (unsigned)(u).rows[_h * HALF + Rr[_i]] * (unsigned)(lda * 2) + (unsigned)(Cc[_i] * 2); \
        else dst[_h][_i] = (unsigned)(Rr[_i] * lda + Cc[_i]) * 2u; } } while (0)
#define PG8_STAGE_A(bufoff, gbase, h, vv) do { if constexpr (GATHER) { PG8_STAGE(bufoff, gbase, vv[h]); } else { PG8_STAGE(bufoff, (gbase) + (h) * hstepA, vv[0]); } } while (0)
    Unit cur, nxt; int ui = 0;
    if (!S.next(0, cur)) return;
    Acc acc;
#pragma unroll
    for (int a = 0; a < 2; ++a)
#pragma unroll
        for (int b = 0; b < 2; ++b)
#pragma unroll
            for (int m = 0; m < 4; ++m)
#pragma unroll
                for (int n = 0; n < 2; ++n) acc[a][b][m][n] = (f32x4){0.f, 0.f, 0.f, 0.f};
    bf16x8 At[4][2], B0[2][2], B1[2][2];
    const char* cA = uniform_ptr(cur.a); const char* cB = uniform_ptr(cur.b);
    PG8_VOFF(vA, cur);
    if constexpr (GATHER) { asm volatile("s_waitcnt vmcnt(0)" ::: "memory"); }
    PG8_STAGE(PG8_SB(0, 0), cB, voffB); PG8_STAGE(PG8_SB(0, 1), cB + hstepB, voffB); PG8_STAGE_A(PG8_SA(0, 0), cA, 0, vA); PG8_STAGE_A(PG8_SA(0, 1), cA, 1, vA);
    if (wr == 1) PG8_BAR;
    PG8_WAIT_V(2); PG8_BAR;
    PG8_STAGE(PG8_SB(1, 0), cB + kstep, voffB); PG8_STAGE_A(PG8_SA(1, 0), cA + kstep, 0, vA); PG8_STAGE(PG8_SB(1, 1), cB + hstepB + kstep, voffB);
    PG8_WAIT_V(6); PG8_BAR;
    for (;;) {
        const bool has_next = S.next(ui + 1, nxt);
        const char* nA = has_next ? uniform_ptr(nxt.a) : cA; const char* nB = has_next ? uniform_ptr(nxt.b) : cB;
        if constexpr (GATHER) { if (has_next) { PG8_VOFF(vN, nxt); } else {
#pragma unroll
            for (int h = 0; h < 2; ++h) { vN[h][0] = vA[h][0]; vN[h][1] = vA[h][1]; } } }
#pragma nounroll
        for (int t = 0; t < nt; t += 2) {
            const bool last = (t == nt - 2);
            if constexpr (Epi::HAS_MID) { if (t == E.mid_t()) E.mid(acc, cur, wr, wc, fr, fq); }
            const char* a1 = cA + (size_t)(t + 1) * kstep;
            const char* a2 = last ? nA : cA + (size_t)(t + 2) * kstep; const char* b2 = last ? nB : cB + (size_t)(t + 2) * kstep;
            const char* a3 = a2 + kstep; const char* b3 = b2 + kstep;
            unsigned vW[2][2];
#pragma unroll
            for (int h = 0; h < 2; ++h) { vW[h][0] = vA[h][0]; vW[h][1] = vA[h][1]; if constexpr (GATHER) { if (last) { vW[h][0] = vN[h][0]; vW[h][1] = vN[h][1]; } } }
            PG8_LDB(B0, 0, 0); PG8_LDB(B1, 0, 1); PG8_SCHED; PG8_LDA(At, 0, 0); PG8_STAGE_A(PG8_SA(1, 1), a1, 1, vA);
            PG8_WAIT_V(8); PG8_WAIT_L(0); PG8_BAR; PG8_MMA(0, 0, At, B0); PG8_MMA(0, 1, At, B1); PG8_BAR; PG8_SCHED;
            PG8_LDA(At, 0, 1); PG8_STAGE(PG8_SB(0, 0), b2, voffB); PG8_STAGE(PG8_SB(0, 1), b2 + hstepB, voffB); PG8_STAGE_A(PG8_SA(0, 0), a2, 0, vW);
            PG8_WAIT_V(8); PG8_WAIT_L(0); PG8_BAR; PG8_MMA(1, 0, At, B0); PG8_MMA(1, 1, At, B1); PG8_BAR; PG8_SCHED;
            PG8_LDB(B0, 1, 0); PG8_LDB(B1, 1, 1); PG8_SCHED; PG8_LDA(At, 1, 0); PG8_STAGE_A(PG8_SA(0, 1), a2, 1, vW);
            PG8_WAIT_V(8); PG8_WAIT_L(0); PG8_BAR; PG8_MMA(0, 0, At, B0); PG8_MMA(0, 1, At, B1); PG8_BAR; PG8_SCHED;
            PG8_LDA(At, 1, 1); PG8_STAGE(PG8_SB(1, 0), b3, voffB); PG8_STAGE(PG8_SB(1, 1), b3 + hstepB, voffB); PG8_STAGE_A(PG8_SA(1, 0), a3, 0, vW);
            PG8_WAIT_V(8); PG8_WAIT_L(0); PG8_BAR; PG8_MMA(1, 0, At, B0); PG8_MMA(1, 1, At, B1); PG8_BAR; PG8_SCHED;
        }
        if constexpr (ALIGN_EPI) { if (wr == 0) PG8_BAR; }
        E(acc, cur, wr, wc, fr, fq, lds, wid, lane);
        if (!has_next) break;
#pragma unroll
        for (int a = 0; a < 2; ++a)
#pragma unroll
            for (int b = 0; b < 2; ++b)
#pragma unroll
                for (int m = 0; m < 4; ++m)
#pragma unroll
                    for (int n = 0; n < 2; ++n) acc[a][b][m][n] = (f32x4){0.f, 0.f, 0.f, 0.f};
        cur = nxt; cA = nA; cB = nB; ++ui;
        if constexpr (GATHER) {
#pragma unroll
            for (int h = 0; h < 2; ++h) { vA[h][0] = vN[h][0]; vA[h][1] = vN[h][1]; } }
        if constexpr (ALIGN_EPI) { if (wr == 1) PG8_BAR; }
    }
    PG8_WAIT_V(0);
    if constexpr (!ALIGN_EPI) { if (wr == 0) PG8_BAR; }
    PG8_BAR;
#undef PG8_SA
#undef PG8_SB
#undef PG8_STAGE
#undef PG8_LDA
#undef PG8_LDB
#undef PG8_MMA
#undef PG8_WAIT_V
#undef PG8_WAIT_L
#undef PG8_BAR
#undef PG8_SCHED
#undef PG8_VOFF
#undef PG8_STAGE_A
}
}
#define XB_TMO      128
#define XB_XCNT(j)  (256  + 64 * (j))
#define XB_XSUB(j)  (1280 + 64 * (j))
#define XB_XGEN(j)  (2304 + 64 * (j))
#define XB_TOP      3328
#define XB_TOPGEN   3392
#define XCD_BAR_WORDS 3456
#define XB_SPIN_CAP (1u << 18)

__device__ __forceinline__ unsigned xb_ld(unsigned* p)              { return __hip_atomic_load(p, __ATOMIC_RELAXED, __HIP_MEMORY_SCOPE_AGENT); }
__device__ __forceinline__ unsigned xb_add(unsigned* p, unsigned v) { return __hip_atomic_fetch_add(p, v, __ATOMIC_RELAXED, __HIP_MEMORY_SCOPE_AGENT); }
__device__ __forceinline__ unsigned xb_xcc_id() { return (unsigned)__builtin_amdgcn_s_getreg((3 << 11) | 20) & 0xFu; }
#define XB_SPIN(cond, bar) do { unsigned _sp = 0; while (cond) { __builtin_amdgcn_s_sleep(1); \
    if ((++_sp & 255u) == 0u) { if (xb_ld(&(bar)[XB_TMO])) break; if (_sp > XB_SPIN_CAP) { atomicAdd(&(bar)[XB_TMO], 1u); break; } } } } while (0)

struct XcdBarrier {
    unsigned* bar; unsigned x;
    volatile LAS unsigned* st;
};

__device__ __forceinline__ XcdBarrier xcd_barrier_post(unsigned* bar, volatile LAS unsigned* st) {
    XcdBarrier b; b.bar = bar; b.x = xb_xcc_id(); b.st = st;
    if (threadIdx.x == 0) (void)xb_add(&bar[XB_XCNT(b.x)], 1u);
    return b;
}
__device__ __forceinline__ void xcd_barrier_complete(unsigned* bar, unsigned x, unsigned& nloc, unsigned& nx) {
    const unsigned G = gridDim.x * gridDim.y * gridDim.z;
    unsigned sum, cnt, mine, sp = 0u;
    for (;;) {
        sum = 0u; cnt = 0u; mine = 0u;
#pragma unroll
        for (unsigned j = 0; j < 16; ++j) { const unsigned c = xb_ld(&bar[XB_XCNT(j)]); sum += c; cnt += (c > 0u) ? 1u : 0u; mine = (j == x) ? c : mine; }
        if (sum == G) break;
        __builtin_amdgcn_s_sleep(1);
        if ((++sp & 255u) == 0u) { if (xb_ld(&bar[XB_TMO])) break; if (sp > XB_SPIN_CAP) { atomicAdd(&bar[XB_TMO], 1u); break; } }
    }
    nloc = mine > 0u ? mine : 1u; nx = cnt > 0u ? cnt : 1u;
}

__device__ __forceinline__ void xcd_barrier(const XcdBarrier& b) {
    asm volatile("s_waitcnt vmcnt(0)" ::: "memory");
    __syncthreads();
    if (threadIdx.x == 0) {
        unsigned* bar = b.bar;
        __builtin_amdgcn_s_waitcnt(0);
        unsigned nloc = b.st[0], nx = b.st[1];
        if (nloc == 0u) { xcd_barrier_complete(bar, b.x, nloc, nx); b.st[0] = nloc; b.st[1] = nx; }
        const unsigned old = xb_add(&bar[XB_XSUB(b.x)], 1u);
        const unsigned gen = old / nloc;
        if (old + 1u == (gen + 1u) * nloc) {
            __builtin_amdgcn_fence(__ATOMIC_RELEASE, "agent");
            asm volatile("s_waitcnt vmcnt(0)" ::: "memory");
            const unsigned og = xb_add(&bar[XB_TOP], 1u);
            const unsigned tg = og / nx;
            if (og + 1u == (tg + 1u) * nx) xb_add(&bar[XB_TOPGEN], 1u);
            else XB_SPIN(xb_ld(&bar[XB_TOPGEN]) == tg, bar);
            __builtin_amdgcn_fence(__ATOMIC_ACQUIRE, "agent");
            xb_add(&bar[XB_XGEN(b.x)], 1u);
            asm volatile("s_waitcnt vmcnt(0)" ::: "memory");
        } else {
            XB_SPIN(xb_ld(&bar[XB_XGEN(b.x)]) == gen, bar);
            __builtin_amdgcn_fence(__ATOMIC_ACQUIRE, "agent");
            asm volatile("s_waitcnt vmcnt(0)" ::: "memory");
        }
    }
    __syncthreads();
}

namespace pg8 {
#define EPI_NOMID static constexpr bool HAS_MID = false; __device__ __forceinline__ int mid_t() const { return -1; } __device__ __forceinline__ void mid(Acc&, const Unit&, int, int, int, int) const {}
#define RAW_BARRIER() do { asm volatile("s_waitcnt lgkmcnt(0)" ::: "memory"); __builtin_amdgcn_s_barrier(); asm volatile("" ::: "memory"); } while (0)

__device__ __forceinline__ u32x4 pack8(const f32x4& v0, const f32x4& v1) { u32x4 w; w.x = cvt_pk_bf16(v0[0], v0[1]); w.y = cvt_pk_bf16(v0[2], v0[3]); w.z = cvt_pk_bf16(v1[0], v1[1]); w.w = cvt_pk_bf16(v1[2], v1[3]); return w; }

struct GridOrder {
    const char* A; const char* Bt; int lda, ldb, nM, nN, nwg, G, c;
    __device__ __forceinline__ void init(const void* A_, const void* Bt_, int lda_, int ldb_, int M, int N, int G_, int c_) { A = (const char*)A_; Bt = (const char*)Bt_; lda = lda_; ldb = ldb_; nM = M / BM; nN = N / BM; nwg = nM * nN; G = G_; c = c_; }
    __device__ __forceinline__ bool next(int i, Unit& u) const {
        const long L = (long)i * G + c; if (L >= nwg) return false;
        int wgid = (int)L; { const int q = nwg / NXCD, r = nwg % NXCD, xcd = wgid % NXCD, off = wgid / NXCD; wgid = (xcd < r ? xcd * (q + 1) : r * (q + 1) + (xcd - r) * q) + off; }
        const int nig = WGM * nN, gid = wgid / nig, fm = gid * WGM, gsz = (nM - fm) < WGM ? (nM - fm) : WGM;
        u.pm = fm + ((wgid % nig) % gsz); u.pn = (wgid % nig) / gsz; u.x0 = 0; u.x1 = 0; u.rows = nullptr;
        u.a = A + (size_t)u.pm * BM * lda * 2; u.b = Bt + (size_t)u.pn * BM * ldb * 2; return true;
    }
};
struct KvOrder {
    const char* memn; const char* wk; const char* wv; int G, c;
    __device__ __forceinline__ bool next(int i, Unit& u) const {
        const int L = i * G + c; if (L >= 128) return false;
        u.rows = nullptr; u.x1 = 0;
        if (L < 64) { u.pm = L >> 2; u.pn = L & 3; u.x0 = 0; u.a = memn + (size_t)u.pm * BM * D * 2; u.b = wk + (size_t)u.pn * BM * D * 2; }
        else { const int l = L - 64; u.pm = l >> 4; u.pn = l & 15; u.x0 = 1; u.a = wv + (size_t)u.pm * BM * D * 2; u.b = memn + (size_t)u.pn * BM * D * 2; }
        return true;
    }
};
template <int MODE> struct XaOrder {
    const char* A; const char* B; int G, c;
    __device__ __forceinline__ bool next(int i, Unit& u) const {
        const int L = i * G + c; if (L >= NB * XH * 16) return false;
        const int qt = L & 15, bh = L >> 4, b = bh >> 2, h = bh & 3;
        u.pm = b * 16 + qt; u.pn = h; u.x0 = 0; u.x1 = 0; u.rows = nullptr;
        u.a = A + ((size_t)u.pm * BM * D + h * XHD) * 2;
        if (MODE == 0) u.b = B + ((size_t)b * MEML * D + h * XHD) * 2;
        else u.b = B + ((size_t)h * XHD * MROWS + b * MEML) * 2;
        return true;
    }
};
template <int MODE> struct MoeOrder {
    const char* A; const char* W; const int* rowtok; const int* etile; int G, c;
    __device__ __forceinline__ bool next(int i, Unit& u) const {
        const int L = i * G + c; const int ntile = etile[NE];
        if (L >= ntile * 4) return false;
        const int rt = L >> 2, ct = L & 3; int e = 0;
        for (int j = 1; j < NE; ++j) e = (etile[j] <= rt) ? j : e;
        u.pm = rt; u.pn = ct; u.x0 = e; u.x1 = 0;
        if (MODE == 0) { u.a = A; u.rows = rowtok + rt * BM; u.b = W + ((size_t)e * 1024 + ct * BM) * D * 2; }
        else { u.a = A + (size_t)rt * BM * FF * 2; u.rows = nullptr; u.b = W + ((size_t)e * 1024 + ct * BM) * FF * 2; }
        return true;
    }
};

struct EpiU {
    static constexpr bool PERM = true; EPI_NOMID
    bf16_t* Cb; bf16_t* Q; bf16_t* Kb; bf16_t* V; const float* ropec; const float* ropes;
    __device__ __forceinline__ void operator()(Acc& acc, const Unit& u, int wr, int wc, int fr, int fq, LAS unsigned char*, int, int) const {
        const int row0 = u.pm * BM + wr * 64 + fr;
        if (u.pn < 2) {
#pragma unroll
            for (int ai = 0; ai < 2; ++ai)
#pragma unroll
                for (int m = 0; m < 4; ++m) { const int row = row0 + ai * HALF + m * 16; f32x4 o[2];
#pragma unroll
                    for (int n = 0; n < 2; ++n)
#pragma unroll
                        for (int i = 0; i < 4; ++i) { const float a = acc[ai][0][m][n][i], g = acc[ai][1][m][n][i]; o[n][i] = a / (1.f + __expf(-g)); }
                    *(u32x4*)(Cb + (size_t)row * CCH + u.pn * HALF + wc * 32 + fq * 8) = pack8(o[0], o[1]); }
        } else if (u.pn < 8) {
            const int sec = (u.pn - 2) / 3, tt = (u.pn - 2) % 3; bf16_t* dst = sec ? Kb : Q; const float sc = sec ? 1.f : 0.125f * LOG2E;
            const int colb = (4 * tt + wc) * HD + fq * 8;
#pragma unroll
            for (int ai = 0; ai < 2; ++ai)
#pragma unroll
                for (int m = 0; m < 4; ++m) { const int row = row0 + ai * HALF + m * 16; const int s = row & (SEQ - 1); f32x4 o1[2], o2[2];
#pragma unroll
                    for (int n = 0; n < 2; ++n) { const f32x4 cs = *(const f32x4*)(ropec + s * 32 + fq * 8 + n * 4), sn = *(const f32x4*)(ropes + s * 32 + fq * 8 + n * 4);
                        const f32x4 x1 = acc[ai][0][m][n], x2 = acc[ai][1][m][n];
                        o1[n] = (x1 * cs - x2 * sn) * sc; o2[n] = (x1 * sn + x2 * cs) * sc; }
                    bf16_t* p = dst + (size_t)row * AW + colb;
                    *(u32x4*)p = pack8(o1[0], o1[1]); *(u32x4*)(p + 32) = pack8(o2[0], o2[1]); }
        } else {
            const int tt = u.pn - 8;
#pragma unroll
            for (int ai = 0; ai < 2; ++ai)
#pragma unroll
                for (int m = 0; m < 4; ++m) { const int row = row0 + ai * HALF + m * 16;
#pragma unroll
                    for (int bj = 0; bj < 2; ++bj) *(u32x4*)(V + (size_t)row * AW + tt * BM + bj * HALF + wc * 32 + fq * 8) = pack8(acc[ai][bj][m][0], acc[ai][bj][m][1]); }
        }
    }
};
template <bool ROWSCALE> struct EpiPlain {
    static constexpr bool PERM = true; EPI_NOMID
    bf16_t* O0; int ldc0; bf16_t* O1; int ldc1; const float* ssq16;
    __device__ __forceinline__ void operator()(Acc& acc, const Unit& u, int wr, int wc, int fr, int fq, LAS unsigned char*, int, int) const {
        bf16_t* O = u.x0 ? O1 : O0; const int ldc = u.x0 ? ldc1 : ldc0;
        const int row0 = u.pm * BM + wr * 64 + fr, col0 = u.pn * BM + wc * 32 + fq * 8;
#pragma unroll
        for (int ai = 0; ai < 2; ++ai)
#pragma unroll
            for (int m = 0; m < 4; ++m) { const int row = row0 + ai * HALF + m * 16; float rs = 1.f;
                if constexpr (ROWSCALE) { const f32x4* sp = (const f32x4*)(ssq16 + (size_t)row * 16); const f32x4 s0 = sp[0], s1 = sp[1], s2 = sp[2], s3 = sp[3];
                    const f32x4 st = (s0 + s1) + (s2 + s3); rs = 1.0f / sqrtf(((st[0] + st[1]) + (st[2] + st[3])) * (1.0f / D) + NORM_EPS); }
#pragma unroll
                for (int bj = 0; bj < 2; ++bj) *(u32x4*)(O + (size_t)row * ldc + col0 + bj * HALF) = pack8(acc[ai][bj][m][0] * rs, acc[ai][bj][m][1] * rs); }
    }
};
template <bool MID> struct EpiResid {
    static constexpr bool PERM = false, HAS_MID = MID;
    const float* xin; float* xout; bf16_t* XB; float* ssqp; const float* ssqa;
    __device__ __forceinline__ int mid_t() const { return AW / BK; }
    __device__ __forceinline__ void mid(Acc& acc, const Unit& u, int wr, int wc, int fr, int fq) const {
        const int row0 = u.pm * BM + wr * 64 + fr;
#pragma unroll
        for (int ai = 0; ai < 2; ++ai)
#pragma unroll
            for (int m = 0; m < 4; ++m) { const int row = row0 + ai * HALF + m * 16; const f32x4* sp = (const f32x4*)(ssqa + (size_t)row * NH);
                const f32x4 s0 = sp[0], s1 = sp[1], s2 = sp[2]; const f32x4 st = (s0 + s1) + s2;
                const float r = 1.0f / sqrtf(((st[0] + st[1]) + (st[2] + st[3])) * (1.0f / AW) + NORM_EPS);
#pragma unroll
                for (int bj = 0; bj < 2; ++bj)
#pragma unroll
                    for (int n = 0; n < 2; ++n) acc[ai][bj][m][n] = acc[ai][bj][m][n] * r;
                asm volatile("" ::: "memory"); }
    }
    __device__ __forceinline__ void operator()(Acc& acc, const Unit& u, int wr, int wc, int fr, int fq, LAS unsigned char*, int, int) const {
        const int row0 = u.pm * BM + wr * 64 + fr, col0 = u.pn * BM + wc * 32 + fq * 4;
#pragma unroll
        for (int ai = 0; ai < 2; ++ai)
#pragma unroll
            for (int m = 0; m < 4; ++m) { const int row = row0 + ai * HALF + m * 16; float ss = 0.f;
#pragma unroll
                for (int bj = 0; bj < 2; ++bj)
#pragma unroll
                    for (int n = 0; n < 2; ++n) { const size_t o = (size_t)row * D + col0 + bj * HALF + n * 16;
                        const f32x4 v = *(const f32x4*)(xin + o) + acc[ai][bj][m][n];
                        *(f32x4*)(xout + o) = v; u32x2 w; w.x = cvt_pk_bf16(v[0], v[1]); w.y = cvt_pk_bf16(v[2], v[3]); *(u32x2*)(XB + o) = w;
                        ss += (v[0] * v[0] + v[1] * v[1]) + (v[2] * v[2] + v[3] * v[3]); }
                ss += __shfl_xor(ss, 16); ss += __shfl_xor(ss, 32);
                if (fq == 0) ssqp[(size_t)row * 16 + u.pn * 4 + wc] = ss; }
    }
};
struct EpiSoftmax {
    static constexpr bool PERM = true; EPI_NOMID
    bf16_t* PM;
    __device__ __forceinline__ void operator()(Acc& acc, const Unit& u, int wr, int wc, int fr, int fq, LAS unsigned char* lds, int, int) const {
        LAS float* MX = (LAS float*)(lds + XCH_OFF); LAS float* SM = (LAS float*)(lds + XCH_OFF + 4096);
#pragma unroll
        for (int ai = 0; ai < 2; ++ai)
#pragma unroll
            for (int m = 0; m < 4; ++m) { const int rl = ai * HALF + wr * 64 + m * 16 + fr; float mx = -3.0e38f;
#pragma unroll
                for (int bj = 0; bj < 2; ++bj)
#pragma unroll
                    for (int n = 0; n < 2; ++n) { const f32x4 v = acc[ai][bj][m][n]; mx = fmaxf(mx, fmaxf(fmaxf(v[0], v[1]), fmaxf(v[2], v[3]))); }
                mx = fmaxf(mx, __shfl_xor(mx, 16)); mx = fmaxf(mx, __shfl_xor(mx, 32));
                if (fq == 0) MX[rl * 4 + wc] = mx; }
        RAW_BARRIER();
#pragma unroll
        for (int ai = 0; ai < 2; ++ai)
#pragma unroll
            for (int m = 0; m < 4; ++m) { const int rl = ai * HALF + wr * 64 + m * 16 + fr; const f32x4 mm = *(const LAS f32x4*)(MX + rl * 4);
                const float mx = fmaxf(fmaxf(mm[0], mm[1]), fmaxf(mm[2], mm[3])); float ss = 0.f;
#pragma unroll
                for (int bj = 0; bj < 2; ++bj)
#pragma unroll
                    for (int n = 0; n < 2; ++n) { f32x4 v = acc[ai][bj][m][n];
#pragma unroll
                        for (int i = 0; i < 4; ++i) { v[i] = __builtin_amdgcn_exp2f(v[i] - mx); ss += v[i]; }
                        acc[ai][bj][m][n] = v; }
                ss += __shfl_xor(ss, 16); ss += __shfl_xor(ss, 32);
                if (fq == 0) SM[rl * 4 + wc] = ss; }
        RAW_BARRIER();
        const int col0 = u.pn * BM + wc * 32 + fq * 8;
#pragma unroll
        for (int ai = 0; ai < 2; ++ai)
#pragma unroll
            for (int m = 0; m < 4; ++m) { const int rl = ai * HALF + wr * 64 + m * 16 + fr; const f32x4 s4 = *(const LAS f32x4*)(SM + rl * 4);
                const float inv = 1.0f / ((s4[0] + s4[1]) + (s4[2] + s4[3]));
#pragma unroll
                for (int bj = 0; bj < 2; ++bj) *(u32x4*)(PM + (size_t)(u.pm * BM + rl) * D + col0 + bj * HALF) = pack8(acc[ai][bj][m][0] * inv, acc[ai][bj][m][1] * inv); }
    }
};
struct EpiMoe1 {
    static constexpr bool PERM = true; EPI_NOMID
    bf16_t* HID; const float* slot_rs;
    __device__ __forceinline__ void operator()(Acc& acc, const Unit& u, int wr, int wc, int fr, int fq, LAS unsigned char*, int, int) const {
        const int row0 = u.pm * BM + wr * 64 + fr;
#pragma unroll
        for (int ai = 0; ai < 2; ++ai)
#pragma unroll
            for (int m = 0; m < 4; ++m) { const int row = row0 + ai * HALF + m * 16; const float rs = slot_rs[row]; f32x4 o[2];
#pragma unroll
                for (int n = 0; n < 2; ++n)
#pragma unroll
                    for (int i = 0; i < 4; ++i) { const float a = acc[ai][0][m][n][i] * rs, b = acc[ai][1][m][n][i] * rs; o[n][i] = a * b / (1.f + __expf(-a)); }
                *(u32x4*)(HID + (size_t)row * FF + u.pn * HALF + wc * 32 + fq * 8) = pack8(o[0], o[1]); }
    }
};
struct EpiMoe2 {
    static constexpr bool PERM = true; EPI_NOMID
    bf16_t* Y; const float* slot_gate;
    __device__ __forceinline__ void operator()(Acc& acc, const Unit& u, int wr, int wc, int fr, int fq, LAS unsigned char*, int, int) const {
        const int row0 = u.pm * BM + wr * 64 + fr, col0 = u.pn * BM + wc * 32 + fq * 8;
#pragma unroll
        for (int ai = 0; ai < 2; ++ai)
#pragma unroll
            for (int m = 0; m < 4; ++m) { const int row = row0 + ai * HALF + m * 16; const float g = slot_gate[row];
#pragma unroll
                for (int bj = 0; bj < 2; ++bj) *(u32x4*)(Y + (size_t)row * D + col0 + bj * HALF) = pack8(acc[ai][bj][m][0] * g, acc[ai][bj][m][1] * g); }
    }
};
}
struct Frame {
    LAS unsigned char* lds;
    volatile LAS unsigned* MISC;
    unsigned* ctl;
    unsigned char* ws;
    int tid, lane, wave, vcu, G;
};
struct Args { const void* in[27]; float* out; unsigned char* ws; int ph_lo, ph_hi, li, pad; };

__device__ __forceinline__ void tr_item(const float* W, int ldw, int srcrow0, int srccol0, bf16_t* WT, int dpitch, size_t drow0, int dk0, const float* gk, float sc, LAS float* scr, int lane) {
#pragma unroll 8
    for (int i = 0; i < 32; ++i) { const int kk = 2 * i + (lane >> 5); const float g = gk ? gk[kk] * sc : sc;
        scr[kk * 33 + (lane & 31)] = W[(size_t)(srcrow0 + kk) * ldw + srccol0 + (lane & 31)] * g; }
    LDS_WAIT(); asm volatile("" ::: "memory");
    const int c = lane & 7;
#pragma unroll
    for (int j = 0; j < 4; ++j) { const int n = (lane >> 3) + 8 * j; const LAS float* s = scr + (8 * c) * 33 + n;
        u32x4 o; o.x = pk2(s[0 * 33], s[1 * 33]); o.y = pk2(s[2 * 33], s[3 * 33]); o.z = pk2(s[4 * 33], s[5 * 33]); o.w = pk2(s[6 * 33], s[7 * 33]);
        *(u32x4*)(WT + (drow0 + n) * dpitch + dk0 + 8 * c) = o; }
    LDS_WAIT(); asm volatile("" ::: "memory");
}
__device__ __forceinline__ void rms_row_to_bf16(const float* xrow, const float* g, bf16_t* orow, int lane) {
    const f32x4* xr = (const f32x4*)xrow + lane; const f32x4* gr = (const f32x4*)g + lane;
    f32x4 v[4]; float s = 0.f;
#pragma unroll
    for (int j = 0; j < 4; ++j) { v[j] = xr[64 * j]; s += (v[j][0] * v[j][0] + v[j][1] * v[j][1]) + (v[j][2] * v[j][2] + v[j][3] * v[j][3]); }
    const float rs = 1.0f / sqrtf(wave_sum(s) * (1.f / D) + NORM_EPS);
    u32x2* o8 = (u32x2*)orow + lane;
#pragma unroll
    for (int j = 0; j < 4; ++j) { const f32x4 gg = gr[64 * j]; u32x2 w; w.x = pk2(v[j][0] * rs * gg[0], v[j][1] * rs * gg[1]); w.y = pk2(v[j][2] * rs * gg[2], v[j][3] * rs * gg[3]); o8[64 * j] = w; }
}
__device__ __forceinline__ double rope_inv(int d) {
    const int q = d >> 3, r = d & 7;
    double b = 1.0;
    b = (r == 1) ? 0.7498942093324558273 : b; b = (r == 2) ? 0.56234132519034908039 : b; b = (r == 3) ? 0.42169650342858224857 : b; b = (r == 4) ? 0.3162277660168379332 : b;
    b = (r == 5) ? 0.23713737056616552617 : b; b = (r == 6) ? 0.17782794100389228012 : b; b = (r == 7) ? 0.13335214321633240257 : b;
    const double p = (q == 0) ? 1.0 : (q == 1) ? 0.1 : (q == 2) ? 0.01 : 0.001;
    return b * p;
}
__device__ __forceinline__ void sincos_d(double a, double& sn, double& cs) {
    const double k = __builtin_rint(a * 0.63661977236758134308);
    double y = __builtin_fma(-k, 1.57079632679489655800e+00, a); y = __builtin_fma(-k, 6.12323399573676603587e-17, y);
    const double y2 = y * y;
    double s = 1.0 / 6227020800.0; s = s * y2 - 1.0 / 39916800.0; s = s * y2 + 1.0 / 362880.0; s = s * y2 - 1.0 / 5040.0; s = s * y2 + 1.0 / 120.0; s = s * y2 - 1.0 / 6.0; s = s * y2 * y + y;
    double c = 1.0 / 479001600.0; c = c * y2 - 1.0 / 3628800.0; c = c * y2 + 1.0 / 40320.0; c = c * y2 - 1.0 / 720.0; c = c * y2 + 1.0 / 24.0; c = c * y2 - 0.5; c = c * y2 + 1.0;
    const int qd = ((int)k) & 3;
    sn = (qd == 0) ? s : (qd == 1) ? c : (qd == 2) ? -s : -c;
    cs = (qd == 0) ? c : (qd == 1) ? -s : (qd == 2) ? -c : s;
}
typedef const void* gen_cptr;
typedef __attribute__((address_space(4))) const char* cas_cptr;
typedef __attribute__((address_space(4))) const gen_cptr* cas_pptr;
__device__ __forceinline__ const void* karg_ptr(int byte_off) { cas_cptr p = (cas_cptr)__builtin_amdgcn_kernarg_segment_ptr(); asm volatile("" : "+s"(p)); return *(cas_pptr)(p + byte_off); }
__device__ __forceinline__ void p0_prologue(Frame& F) {
    const float* x = (const float*)karg_ptr(8 * 0); const float* mem = (const float*)karg_ptr(8 * 1); const int* positions = (const int*)karg_ptr(8 * 2);
    const float* mix_g = (const float*)karg_ptr(8 * 3); const float* w_in = (const float*)karg_ptr(8 * 4);
    const float* attn_out_g = (const float*)karg_ptr(8 * 10); const float* w_out = (const float*)karg_ptr(8 * 11);
    const float* xattn_g = (const float*)karg_ptr(8 * 12); const float* mem_g = (const float*)karg_ptr(8 * 13);
    const float* w_xq = (const float*)karg_ptr(8 * 14); const float* w_xk = (const float*)karg_ptr(8 * 15); const float* w_xv = (const float*)karg_ptr(8 * 16); const float* w_xo = (const float*)karg_ptr(8 * 17);
    const float* moe_g = (const float*)karg_ptr(8 * 18); const float* w_group = (const float*)karg_ptr(8 * 19); const float* w_router = (const float*)karg_ptr(8 * 21);
    const float* w1 = (const float*)karg_ptr(8 * 23); const float* w3 = (const float*)karg_ptr(8 * 24); const float* w2 = (const float*)karg_ptr(8 * 25);
    unsigned char* ws = F.ws;
    LAS float* scr = (LAS float*)(F.lds + F.wave * 16384);
    const int gw = F.vcu * NWAVES + F.wave, NGW = F.G * NWAVES;
    constexpr int I_IN = 16 * 88, I_SQ = 16 * 32, I_13 = NE * 16 * 32, I_2 = NE * 8 * 32;
    constexpr int NITEMS = I_IN + 5 * I_SQ + I_13 + I_2;
    for (int it = gw; it < NITEMS; it += NGW) {
        int r = it;
        if (r < I_IN) { const int kb = r / 88, nb = r % 88, n0 = 32 * nb, tile = n0 >> 8, j = n0 & 255; int src;
            if (tile < 2) src = (j < 128) ? 128 * tile + j : 256 + 128 * tile + (j - 128);
            else if (tile < 8) { const int sec = (tile - 2) / 3, tt = (tile - 2) % 3, jj = j & 127, hh = jj >> 5; src = 512 + 768 * sec + 256 * tt + 64 * hh + ((j < 128) ? 0 : 32); }
            else src = n0;
            tr_item(w_in, INW, 64 * kb, src, (bf16_t*)(ws + WS_WIN), D, (size_t)n0, 64 * kb, nullptr, 1.f, scr, F.lane); continue; }
        r -= I_IN;
        if (r < I_SQ) { const int kb = r / 32, nb = r % 32, dk0 = 64 * kb; const bool at = dk0 < AW;
            tr_item(w_out, D, at ? CCH + dk0 : dk0 - AW, 32 * nb, (bf16_t*)(ws + WS_WOUT), D, (size_t)(32 * nb), dk0, at ? attn_out_g + dk0 : nullptr, 1.f, scr, F.lane); continue; }
        r -= I_SQ;
        if (r < 4 * I_SQ) { const int which = r / I_SQ, r2 = r % I_SQ, kb = r2 / 32, nb = r2 % 32;
            const float* W = which == 0 ? w_xq : which == 1 ? w_xk : which == 2 ? w_xv : w_xo;
            bf16_t* WT = (bf16_t*)(ws + (which == 0 ? WS_WXQ : which == 1 ? WS_WXK : which == 2 ? WS_WXV : WS_WXO));
            tr_item(W, D, 64 * kb, 32 * nb, WT, D, (size_t)(32 * nb), 64 * kb, which == 0 ? xattn_g + 64 * kb : nullptr, which == 0 ? LOG2E / 16.f : 1.f, scr, F.lane); continue; }
        r -= 4 * I_SQ;
        if (r < I_13) { const int e = r / 512, r2 = r % 512, kb = r2 / 32, nb = r2 % 32, n0 = 32 * nb, tt = n0 >> 8, j = n0 & 255;
            const float* W = ((j < 128) ? w1 : w3) + (size_t)e * D * FF;
            tr_item(W, FF, 64 * kb, 128 * tt + (j & 127), (bf16_t*)(ws + WS_W13), D, (size_t)e * 1024 + n0, 64 * kb, moe_g + 64 * kb, 1.f, scr, F.lane); continue; }
        r -= I_13;
        { const int e = r / 256, r2 = r % 256, kb = r2 / 32, nb = r2 % 32;
            tr_item(w2 + (size_t)e * FF * D, D, 64 * kb, 32 * nb, (bf16_t*)(ws + WS_W2), FF, (size_t)e * 1024 + 32 * nb, 64 * kb, nullptr, 1.f, scr, F.lane); }
    }
    { float* WR = (float*)(ws + WS_HIST + HIST_WR);
      for (int i = blockIdx.x * 512 + F.tid; i < D * 36; i += F.G * 512) { const int k = i / 36, o = i % 36;
          WR[i] = (o < 32 ? w_router[k * 32 + o] : w_group[k * 4 + (o - 32)]) * moe_g[k]; } }
    { float* rc = (float*)(ws + WS_ROPE); float* rsn = rc + SEQ * 32;
      for (int i = blockIdx.x * 512 + F.tid; i < SEQ * 32; i += F.G * 512) { const int s = i >> 5, d = i & 31;
          const float inv = (float)rope_inv(d); const float ang = (float)positions[s] * inv; double sn, cs; sincos_d((double)fabsf(ang), sn, cs); if (ang < 0.f) sn = -sn;
          rc[i] = (float)cs; rsn[i] = (float)sn; } }
    for (int m = gw; m < MROWS; m += NGW) rms_row_to_bf16(mem + (size_t)m * D, mem_g, (bf16_t*)(ws + WS_MEMN) + (size_t)m * D, F.lane);
    for (int m = gw; m < T; m += NGW) rms_row_to_bf16(x + (size_t)m * D, mix_g, (bf16_t*)(ws + WS_R1) + (size_t)m * D, F.lane);
}
namespace att {
typedef short v4i16_t __attribute__((ext_vector_type(4)));
constexpr int LDS_V = 65536;
constexpr float NEG = -1.0e30f;
__device__ __forceinline__ int k_off(int row, int c) { return row * 128 + ((c ^ ((row >> 1) & 7)) << 4); }
__device__ __forceinline__ int v_off(int row, int c) { return LDS_V + row * 128 + ((c ^ (((row >> 1) & 3) << 1)) << 4); }

struct Grp { bf16x8 q0, q1; f32x4 o[4]; float m, l; int qsub; };

template <class PosFn>
__device__ __forceinline__ void stage_rows(LAS unsigned char* lds, const bf16_t* Kb, const bf16_t* Vb, int brow0, int hcol, int nrows, int tid, PosFn posfn) {
    for (int idx = tid; idx < nrows * 8; idx += NWAVES * 64) {
        const int j = idx >> 3, c = idx & 7; int pos = posfn(j); pos = pos < 0 ? 0 : (pos > SEQ - 1 ? SEQ - 1 : pos);
        const size_t off = (size_t)(brow0 + pos) * AW + hcol + c * 8;
        const u32x4 kv = *(const u32x4*)(Kb + off); const u32x4 vv = *(const u32x4*)(Vb + off);
        *(LAS u32x4*)(lds + k_off(j, c)) = kv; *(LAS u32x4*)(lds + v_off(j, c)) = vv;
    }
}
__device__ __forceinline__ void pair(Grp& G, LAS unsigned char* lds, int Rb, int ksub0, int L, int lane) {
    const int key = lane & 15, g = lane >> 4;
    f32x4 s[2];
#pragma unroll
    for (int t = 0; t < 2; ++t) { const int row = Rb + 16 * t + key;
        const bf16x8 k0 = *(const LAS bf16x8*)(lds + k_off(row, g)), k1 = *(const LAS bf16x8*)(lds + k_off(row, 4 + g));
        f32x4 z = (f32x4){0.f, 0.f, 0.f, 0.f};
        z = __builtin_amdgcn_mfma_f32_16x16x32_bf16(k0, G.q0, z, 0, 0, 0); s[t] = __builtin_amdgcn_mfma_f32_16x16x32_bf16(k1, G.q1, z, 0, 0, 0); }
    bool valid[2][4]; float mx = NEG;
#pragma unroll
    for (int t = 0; t < 2; ++t)
#pragma unroll
        for (int i = 0; i < 4; ++i) { const int ks = ksub0 + 16 * t + 4 * g + i;
            valid[t][i] = ((unsigned)(ks - G.qsub + 64) <= 128u) && ((unsigned)ks < (unsigned)L);
            mx = fmaxf(mx, valid[t][i] ? s[t][i] : NEG); }
    mx = fmaxf(mx, __shfl_xor(mx, 16)); mx = fmaxf(mx, __shfl_xor(mx, 32));
    const float mn = fmaxf(G.m, mx), alpha = __builtin_amdgcn_exp2f(G.m - mn);
    G.m = mn; float ps = 0.f; float p[2][4];
#pragma unroll
    for (int t = 0; t < 2; ++t)
#pragma unroll
        for (int i = 0; i < 4; ++i) { p[t][i] = valid[t][i] ? __builtin_amdgcn_exp2f(s[t][i] - mn) : 0.f; ps += p[t][i]; }
    G.l = G.l * alpha + ps;
    u32x4 pw; pw.x = cvt_pk_bf16(p[0][0], p[0][1]); pw.y = cvt_pk_bf16(p[0][2], p[0][3]); pw.z = cvt_pk_bf16(p[1][0], p[1][1]); pw.w = cvt_pk_bf16(p[1][2], p[1][3]);
    const bf16x8 pb = __builtin_bit_cast(bf16x8, pw);
    const int q = (lane >> 2) & 3, p2 = lane & 3;
#pragma unroll
    for (int db = 0; db < 4; ++db) { const int c = 2 * db + (p2 >> 1);
        const int r0 = Rb + 4 * g + q, r1 = r0 + 16;
        const s16x4 v0 = __builtin_bit_cast(s16x4, __builtin_amdgcn_ds_read_tr16_b64_v4i16((LAS v4i16_t*)(lds + v_off(r0, c) + 8 * (p2 & 1))));
        const s16x4 v1 = __builtin_bit_cast(s16x4, __builtin_amdgcn_ds_read_tr16_b64_v4i16((LAS v4i16_t*)(lds + v_off(r1, c) + 8 * (p2 & 1))));
        const bf16x8 vf = (bf16x8){v0[0], v0[1], v0[2], v0[3], v1[0], v1[1], v1[2], v1[3]};
        G.o[db] = __builtin_amdgcn_mfma_f32_16x16x32_bf16(vf, pb, G.o[db] * alpha, 0, 0, 0); }
}
__device__ __forceinline__ void grp_init(Grp& G, const bf16_t* Qb, int brow0, int hcol, int c0, int r, int lane) {
    const int a = lane & 15, g = lane >> 4; const bf16_t* qp = Qb + (size_t)(brow0 + c0 + r + 16 * a) * AW + hcol + 8 * g;
    G.q0 = *(const bf16x8*)qp; G.q1 = *(const bf16x8*)(qp + 32);
#pragma unroll
    for (int d = 0; d < 4; ++d) G.o[d] = (f32x4){0.f, 0.f, 0.f, 0.f};
    G.m = NEG; G.l = 0.f; G.qsub = 0;
}
__device__ __forceinline__ void grp_finish(Grp& G, bf16_t* MIX, float* ssqa, int brow0, int h, int c0, int r, int lane) {
    const int a = lane & 15, g = lane >> 4; float l = G.l; l += __shfl_xor(l, 16); l += __shfl_xor(l, 32);
    const float inv = 1.0f / l; const size_t tok = (size_t)(brow0 + c0 + r + 16 * a); float ss = 0.f;
#pragma unroll
    for (int db = 0; db < 4; ++db) { const f32x4 o = G.o[db] * inv; ss += (o[0] * o[0] + o[1] * o[1]) + (o[2] * o[2] + o[3] * o[3]);
        u32x2 w; w.x = cvt_pk_bf16(o[0], o[1]); w.y = cvt_pk_bf16(o[2], o[3]); *(u32x2*)(MIX + tok * D + h * HD + 16 * db + 4 * g) = w; }
    ss += __shfl_xor(ss, 16); ss += __shfl_xor(ss, 32);
    if (g == 0) ssqa[tok * NH + h] = ss;
}
#define ATT_SYNC() do { asm volatile("s_waitcnt vmcnt(0) lgkmcnt(0)" ::: "memory"); __builtin_amdgcn_s_barrier(); asm volatile("" ::: "memory"); } while (0)
__device__ __forceinline__ void attn_unit(LAS unsigned char* lds, const bf16_t* Qb, const bf16_t* Kb, const bf16_t* Vb, bf16_t* MIX, float* ssqa, int b, int h, int c0, int tid, int wave, int lane) {
    const int brow0 = b * SEQ, hcol = h * HD, a = lane & 15;
    Grp G0, G1;
    grp_init(G0, Qb, brow0, hcol, c0, wave, lane); grp_init(G1, Qb, brow0, hcol, c0, wave + 8, lane);
    ATT_SYNC();
    stage_rows(lds, Kb, Vb, brow0, hcol, 384, tid, [&](int j) { return c0 - 64 + j; });
    ATT_SYNC();
    G0.qsub = c0 + wave + 16 * a; G1.qsub = c0 + wave + 8 + 16 * a;
    for (int p = 0; p < 12; ++p) { pair(G0, lds, 32 * p, c0 - 64 + 32 * p, SEQ, lane); pair(G1, lds, 32 * p, c0 - 64 + 32 * p, SEQ, lane); }
    G0.qsub = (c0 >> 2) + (wave >> 2) + 4 * a; G1.qsub = (c0 >> 2) + ((wave + 8) >> 2) + 4 * a;
    for (int st = 0; st < 2; ++st) {
        ATT_SYNC();
        stage_rows(lds, Kb, Vb, brow0, hcol, 384, tid, [&](int j) { const int c = j / 96, jj = j - 96 * c; return 4 * ((c0 >> 2) - 64 + 96 * st + jj) + c; });
        ATT_SYNC();
        const int c = wave & 3;
        for (int p = 0; p < 3; ++p) { const int Rb = 96 * c + 32 * p, ks = (c0 >> 2) - 64 + 96 * st + 32 * p; pair(G0, lds, Rb, ks, SEQ / 4, lane); pair(G1, lds, Rb, ks, SEQ / 4, lane); }
    }
    G0.qsub = (c0 >> 4) + a; G1.qsub = (c0 >> 4) + a;
    for (int st = 0; st < 5; ++st) {
        ATT_SYNC();
        stage_rows(lds, Kb, Vb, brow0, hcol, 512, tid, [&](int j) { const int r = j >> 5, jj = j & 31; return 16 * ((c0 >> 4) - 64 + 32 * st + jj) + r; });
        ATT_SYNC();
        const int ks = (c0 >> 4) - 64 + 32 * st;
        pair(G0, lds, 32 * wave, ks, SEQ / 16, lane); pair(G1, lds, 32 * (wave + 8), ks, SEQ / 16, lane);
    }
    grp_finish(G0, MIX, ssqa, brow0, h, c0, wave, lane); grp_finish(G1, MIX, ssqa, brow0, h, c0, wave + 8, lane);
}
__device__ __forceinline__ void conv_unit(LAS unsigned char* lds, const bf16_t* Cb, bf16_t* MIX, const float* dw_w, const float* dw_b, const float* ln_g, const float* ln_b, const float* out_g,
                                          int b, int s0, int tid, int wave, int lane) {
    LAS bf16_t* CT = (LAS bf16_t*)lds;
    LAS float* CO = (LAS float*)(lds + 49152);
    ATT_SYNC();
    for (int p = tid; p < 94 * 32; p += NWAVES * 64) { const int row = p >> 5, c = p & 31, s = s0 - 15 + row;
        u32x4 v = (u32x4){0u, 0u, 0u, 0u};
        if (s >= 0 && s < SEQ) v = *(const u32x4*)(Cb + (size_t)(b * SEQ + s) * CCH + c * 8);
        *(LAS u32x4*)(CT + row * CCH + c * 8) = v; }
    ATT_SYNC();
    { const int ch = tid & 255, half = tid >> 8; float v[62], w[CONVK];
#pragma unroll
      for (int k = 0; k < CONVK; ++k) w[k] = dw_w[k * CCH + ch];
#pragma unroll
      for (int i = 0; i < 62; ++i) v[i] = bf2f(CT[(32 * half + i) * CCH + ch]);
      const float bias = dw_b[ch];
#pragma unroll
      for (int p = 0; p < 32; ++p) { float acc = bias;
#pragma unroll
          for (int k = 0; k < CONVK; ++k) acc += v[p + k] * w[k];
          CO[(32 * half + p) * CCH + ch] = acc; } }
    ATT_SYNC();
    { const f32x4 g4 = *((const f32x4*)ln_g + lane), b4 = *((const f32x4*)ln_b + lane), og = *((const f32x4*)out_g + lane);
#pragma unroll
      for (int pp = 0; pp < 8; ++pp) { const int p = wave * 8 + pp; const f32x4 xv = *(const LAS f32x4*)(CO + p * CCH + 4 * lane);
          const float mean = wave_sum((xv[0] + xv[1]) + (xv[2] + xv[3])) * (1.f / CCH); const f32x4 dx = xv - mean;
          const float var = wave_sum((dx[0] * dx[0] + dx[1] * dx[1]) + (dx[2] * dx[2] + dx[3] * dx[3])) * (1.f / CCH); const float rstd = 1.0f / sqrtf(var + LN_EPS);
          f32x4 z;
#pragma unroll
          for (int i = 0; i < 4; ++i) { const float y = dx[i] * rstd * g4[i] + b4[i]; z[i] = y / (1.f + __expf(-y)); }
          const float ms = wave_sum((z[0] * z[0] + z[1] * z[1]) + (z[2] * z[2] + z[3] * z[3])) * (1.f / CCH); const float rs = 1.0f / sqrtf(ms + NORM_EPS);
          u32x2 o; o.x = cvt_pk_bf16(z[0] * rs * og[0], z[1] * rs * og[1]); o.y = cvt_pk_bf16(z[2] * rs * og[2], z[3] * rs * og[3]);
          *(u32x2*)(MIX + (size_t)(b * SEQ + s0 + p) * D + AW + 4 * lane) = o; } }
}
}
namespace moe {
#define MOE_SYNC() do { asm volatile("s_waitcnt vmcnt(0) lgkmcnt(0)" ::: "memory"); __builtin_amdgcn_s_barrier(); asm volatile("" ::: "memory"); } while (0)
__device__ __forceinline__ void route_chunk(LAS unsigned char* lds, const float* x2, const float* ssq2, const float* WR, const float* b_router, const float* b_group,
                                            int* tok_e, float* tok_gate, float* tok_rs, int* hist, int chunk, int tid, int wave, int lane) {
    LAS float* XT = (LAS float*)lds;
    LAS float* LG = (LAS float*)(lds + 69632);
    LAS int* HS = (LAS int*)(lds + 69632 + 36864);
    const int tl = (wave & 3) * 64 + lane, oh = wave >> 2;
    float acc[18];
#pragma unroll
    for (int o = 0; o < 18; ++o) acc[o] = 0.f;
    if (tid < 32) HS[tid] = 0;
    for (int kb = 0; kb < 16; ++kb) {
        MOE_SYNC();
#pragma unroll
        for (int i = 0; i < 8; ++i) { const int p = tid + 512 * i, row = p >> 4, c4 = p & 15;
            *(LAS f32x4*)(XT + row * 68 + c4 * 4) = *(const f32x4*)(x2 + (size_t)(chunk * 256 + row) * D + kb * 64 + c4 * 4); }
        MOE_SYNC();
        for (int k4 = 0; k4 < 16; ++k4) { const f32x4 xv = *(const LAS f32x4*)(XT + tl * 68 + k4 * 4);
#pragma unroll
            for (int e = 0; e < 4; ++e) { const float* wrow = WR + (size_t)(kb * 64 + k4 * 4 + e) * 36 + oh * 18;
#pragma unroll
                for (int o = 0; o < 18; ++o) acc[o] += xv[e] * wrow[o]; } }
    }
    const int t = chunk * 256 + tl;
    { const f32x4* sp = (const f32x4*)(ssq2 + (size_t)t * 16); const f32x4 st = (sp[0] + sp[1]) + (sp[2] + sp[3]);
      const float rs = 1.0f / sqrtf(((st[0] + st[1]) + (st[2] + st[3])) * (1.f / D) + NORM_EPS);
      if (oh == 0) tok_rs[t] = rs;
#pragma unroll
      for (int o = 0; o < 18; ++o) { const int og = oh * 18 + o; LG[tl * 36 + og] = acc[o] * rs + (og < 32 ? b_router[og] : b_group[og - 32]); } }
    MOE_SYNC();
    if (wave < 4) { const int tr = wave * 64 + lane, tg = chunk * 256 + tr; const LAS float* lg = LG + tr * 36;
        float gm = lg[32]; int gi = 0;
#pragma unroll
        for (int j = 1; j < 4; ++j) { const float v = lg[32 + j]; if (v > gm) { gm = v; gi = j; } }
        float den = 0.f;
#pragma unroll
        for (int j = 0; j < 4; ++j) den += __expf(lg[32 + j] - gm);
        const float gp = 1.0f / den;
        float v0 = -3.0e38f, v1 = -3.0e38f; int i0 = 0, i1 = 0;
#pragma unroll
        for (int j = 0; j < 8; ++j) { const float v = lg[gi * 8 + j];
            if (v > v0) { v1 = v0; i1 = i0; v0 = v; i0 = j; } else if (v > v1) { v1 = v; i1 = j; } }
        const float dd = __expf(v1 - v0), g0 = gp / (1.f + dd), g1 = gp * dd / (1.f + dd);
        const int e0 = gi * 8 + i0, e1 = gi * 8 + i1;
        __hip_atomic_fetch_add(HS + e0, 1, __ATOMIC_RELAXED, __HIP_MEMORY_SCOPE_WORKGROUP); __hip_atomic_fetch_add(HS + e1, 1, __ATOMIC_RELAXED, __HIP_MEMORY_SCOPE_WORKGROUP);
        tok_e[tg] = e0 | (e1 << 8); tok_gate[2 * tg] = g0; tok_gate[2 * tg + 1] = g1; }
    MOE_SYNC();
    if (tid < 32) hist[chunk * 32 + tid] = HS[tid];
}
__device__ __forceinline__ void slot_chunk(LAS unsigned char* lds, const int* hist, const int* tok_e, const float* tok_gate, const float* tok_rs, int* tok_slot, int* row_tok, float* slot_rs, float* slot_gate, int* etile,
                                           int chunk, int tid, int wave, int lane) {
    LAS int* CNT = (LAS int*)lds; LAS int* BASE = CNT + 32; LAS int* PST = CNT + 64; LAS int* WC = CNT + 128;
    MOE_SYNC();
    if (tid < 32) { int tot = 0, bs = 0; for (int cc = 0; cc < 256; ++cc) { const int hh = hist[cc * 32 + tid]; bs += (cc < chunk) ? hh : 0; tot += hh; } CNT[tid] = tot; BASE[tid] = bs; }
    MOE_SYNC();
    if (tid == 0) { int ps = 0; for (int e = 0; e < 32; ++e) { PST[e] = ps; ps += ((CNT[e] + 255) >> 8) << 8; } PST[32] = ps; }
    MOE_SYNC();
    int ek[2] = {0, 0}, rank[2] = {0, 0}; const int t = chunk * 256 + (wave & 3) * 64 + lane;
    if (wave < 4) { const int ev = tok_e[t]; ek[0] = ev & 255; ek[1] = ev >> 8;
#pragma unroll
        for (int k = 0; k < 2; ++k)
#pragma nounroll
            for (int e = 0; e < 32; ++e) { const unsigned long long m = __ballot(ek[k] == e);
                if (ek[k] == e) rank[k] = __popcll(m & ((1ull << lane) - 1ull));
                if (lane == 0) WC[(k * 4 + wave) * 32 + e] = __popcll(m); } }
    MOE_SYNC();
    if (wave < 4) {
#pragma unroll
        for (int k = 0; k < 2; ++k) { int off = 0;
            for (int kw = 0; kw < k * 4 + wave; ++kw) off += WC[kw * 32 + ek[k]];
            const int slot = PST[ek[k]] + BASE[ek[k]] + off + rank[k];
            row_tok[slot] = t; slot_rs[slot] = tok_rs[t]; slot_gate[slot] = tok_gate[2 * t + k]; tok_slot[2 * t + k] = slot; } }
    if (chunk < 32) { const int e = chunk, c0 = PST[e] + CNT[e], n = PST[e + 1] - c0;
        for (int i = tid; i < n; i += NWAVES * 64) { row_tok[c0 + i] = 0; slot_rs[c0 + i] = 0.f; slot_gate[c0 + i] = 0.f; } }
    if (chunk == 0 && tid <= 32) etile[tid] = PST[tid] >> 8;
}
__device__ __forceinline__ void final_row(float* xo, const bf16_t* Y, const int* tok_slot, const float* g, int t, int lane) {
    const int s0 = tok_slot[2 * t], s1 = tok_slot[2 * t + 1];
    f32x4* xr = (f32x4*)(xo + (size_t)t * D) + lane; const u32x2* y0 = (const u32x2*)(Y + (size_t)s0 * D) + lane; const u32x2* y1 = (const u32x2*)(Y + (size_t)s1 * D) + lane;
    const f32x4* gr = (const f32x4*)g + lane;
    f32x4 v[4]; float s = 0.f;
#pragma unroll
    for (int j = 0; j < 4; ++j) { const f32x4 x = xr[64 * j]; const u32x2 a = y0[64 * j], b = y1[64 * j];
        v[j][0] = x[0] + (bflo(a.x) + bflo(b.x)); v[j][1] = x[1] + (bfhi(a.x) + bfhi(b.x)); v[j][2] = x[2] + (bflo(a.y) + bflo(b.y)); v[j][3] = x[3] + (bfhi(a.y) + bfhi(b.y));
        s += (v[j][0] * v[j][0] + v[j][1] * v[j][1]) + (v[j][2] * v[j][2] + v[j][3] * v[j][3]); }
    const float rs = 1.0f / sqrtf(wave_sum(s) * (1.f / D) + NORM_EPS);
#pragma unroll
    for (int j = 0; j < 4; ++j) xr[64 * j] = v[j] * rs * gr[64 * j];
}
}
#ifndef MK_N_LAUNCHES
#define MK_N_LAUNCHES 1
#endif
constexpr int NPH = 13;
constexpr int N_LAUNCHES = MK_N_LAUNCHES;

#define ARG_IN(k) karg_ptr(8 * (k))
#define ARG_OUT ((float*)karg_ptr(8 * 27))
#define ARG_WS ((unsigned char*)karg_ptr(8 * 28))
template <int LO, int HI>
__global__ void __launch_bounds__(NWAVES * 64, 2) mega_fwd(Args args) {
    extern __shared__ __attribute__((aligned(16))) unsigned char lds_raw[];
    Frame F;
    F.lds = (LAS unsigned char*)lds_raw;
    F.MISC = (volatile LAS unsigned*)(F.lds + LDSCTL_OFF);
    F.tid = threadIdx.x; F.lane = F.tid & 63; F.wave = __builtin_amdgcn_readfirstlane(F.tid >> 6);
    F.G = gridDim.x; { const int bx = blockIdx.x; F.vcu = (F.G % 8 == 0) ? (bx % 8) * (F.G / 8) + bx / 8 : bx; }
    F.ws = ARG_WS; F.ctl = (unsigned*)(ARG_WS + WS_CTL);
    for (int u = F.tid; u < (LDS_BYTES - LDSCTL_OFF) / 4; u += NWAVES * 64) ((LAS unsigned*)(F.lds + LDSCTL_OFF))[u] = 0u;
    __syncthreads();
    XcdBarrier bar; bar.bar = F.ctl + CW_BAR; bar.x = 0; bar.st = nullptr;
    if (HI - LO > 1) bar = xcd_barrier_post(F.ctl + CW_BAR, F.MISC + 8);
#define GRID_BAR() do { if (HI - LO > 1) xcd_barrier(bar); } while (0)
#ifndef PH_MASK
#define PH_MASK 0x1fff
#endif
#define IN(k) ((((PH_MASK) >> (k)) & 1) && LO <= (k) && (k) < HI)
#define BOTH(k) (IN(k) && IN((k) + 1))
    const int gw = F.vcu * NWAVES + F.wave, NGW = F.G * NWAVES;
#define R1 ((bf16_t*)(ARG_WS + WS_R1))
#define R2 ((bf16_t*)(ARG_WS + WS_R2))
#define ssqa ((float*)(ARG_WS + WS_SSQA))
#define ssq1 ((float*)(ARG_WS + WS_SSQ1))
#define ssq2 ((float*)(ARG_WS + WS_SSQ2))
#define tok_e ((int*)(ARG_WS + WS_TOK + TK_E))
#define tok_gate ((float*)(ARG_WS + WS_TOK + TK_GATE))
#define tok_slot ((int*)(ARG_WS + WS_TOK + TK_SLOT))
#define tok_rs ((float*)(ARG_WS + WS_TOK + TK_RS))
#define row_tok ((int*)(ARG_WS + WS_TOK + TK_ROWTOK))
#define slot_rs ((float*)(ARG_WS + WS_TOK + TK_SLOTRS))
#define slot_gate ((float*)(ARG_WS + WS_TOK + TK_SLOTGATE))
#define hist ((int*)(ARG_WS + WS_HIST))
#define etile ((int*)(ARG_WS + WS_HIST + HIST_ETILE))
#define WR ((const float*)(ARG_WS + WS_HIST + HIST_WR))

    if (IN(0)) { p0_prologue(F); if (BOTH(0)) GRID_BAR(); }

    if (IN(1)) {
        { pg8::GridOrder S; S.init(R1, ARG_WS + WS_WIN, D, D, T, INW, F.G, (int)blockIdx.x);
          pg8::EpiU E{R2, (bf16_t*)(ARG_WS + WS_Q), (bf16_t*)(ARG_WS + WS_K), (bf16_t*)(ARG_WS + WS_V), (const float*)(ARG_WS + WS_ROPE), (const float*)(ARG_WS + WS_ROPE) + SEQ * 32};
          pg8::gemm_phase<pg8::EpiU, pg8::GridOrder, true, false>(F.lds, D, D, D, S, E); }
        { pg8::KvOrder S{(const char*)(ARG_WS + WS_MEMN), (const char*)(ARG_WS + WS_WXK), (const char*)(ARG_WS + WS_WXV), F.G, (int)blockIdx.x};
          pg8::EpiPlain<false> E{(bf16_t*)(ARG_WS + WS_KX), D, (bf16_t*)(ARG_WS + WS_VXT), MROWS, nullptr};
          pg8::gemm_phase<pg8::EpiPlain<false>, pg8::KvOrder, true, false>(F.lds, D, D, D, S, E); }
        if (BOTH(1)) GRID_BAR();
    }

    if (IN(2)) {
        for (int L = F.vcu; L < NB * NH * 16; L += F.G) { const int chunk = L & 15, bh = L >> 4, b = bh / NH, h = bh % NH;
            att::attn_unit(F.lds, (const bf16_t*)(ARG_WS + WS_Q), (const bf16_t*)(ARG_WS + WS_K), (const bf16_t*)(ARG_WS + WS_V), R1, ssqa, b, h, chunk * 256, F.tid, F.wave, F.lane); }
        for (int L = F.vcu; L < NB * 64; L += F.G) { const int b = L >> 6, j = L & 63;
            att::conv_unit(F.lds, R2, R1, (const float*)ARG_IN(5), (const float*)ARG_IN(6), (const float*)ARG_IN(7), (const float*)ARG_IN(8), (const float*)ARG_IN(9), b, j * 64, F.tid, F.wave, F.lane); }
        asm volatile("s_waitcnt vmcnt(0) lgkmcnt(0)" ::: "memory"); __syncthreads();
        if (BOTH(2)) GRID_BAR();
    }

    if (IN(3)) {
        pg8::GridOrder S; S.init(R1, ARG_WS + WS_WOUT, D, D, T, D, F.G, (int)blockIdx.x);
        pg8::EpiResid<true> E{(const float*)ARG_IN(0), ARG_OUT, R2, ssq1, ssqa};
        pg8::gemm_phase<pg8::EpiResid<true>, pg8::GridOrder, true, false>(F.lds, D, D, D, S, E);
        if (BOTH(3)) GRID_BAR();
    }

    if (IN(4)) {
        pg8::GridOrder S; S.init(R2, ARG_WS + WS_WXQ, D, D, T, D, F.G, (int)blockIdx.x);
        pg8::EpiPlain<true> E{(bf16_t*)(ARG_WS + WS_XQ), D, nullptr, 0, ssq1};
        pg8::gemm_phase<pg8::EpiPlain<true>, pg8::GridOrder, true, false>(F.lds, D, D, D, S, E);
        if (BOTH(4)) GRID_BAR();
    }

    if (IN(5)) {
        pg8::XaOrder<0> S{(const char*)(ARG_WS + WS_XQ), (const char*)(ARG_WS + WS_KX), F.G, F.vcu};
        pg8::EpiSoftmax E{(bf16_t*)(ARG_WS + WS_PM)};
        pg8::gemm_phase<pg8::EpiSoftmax, pg8::XaOrder<0>, true, false>(F.lds, D, D, XHD, S, E);
        if (BOTH(5)) GRID_BAR();
    }

    if (IN(6)) {
        pg8::XaOrder<1> S{(const char*)(ARG_WS + WS_PM), (const char*)(ARG_WS + WS_VXT), F.G, F.vcu};
        pg8::EpiPlain<false> E{R1, D, nullptr, 0, nullptr};
        pg8::gemm_phase<pg8::EpiPlain<false>, pg8::XaOrder<1>, true, false>(F.lds, D, MROWS, MEML, S, E);
        if (BOTH(6)) GRID_BAR();
    }

    if (IN(7)) {
        pg8::GridOrder S; S.init(R1, ARG_WS + WS_WXO, D, D, T, D, F.G, (int)blockIdx.x);
        pg8::EpiResid<false> E{ARG_OUT, ARG_OUT, R2, ssq2, nullptr};
        pg8::gemm_phase<pg8::EpiResid<false>, pg8::GridOrder, true, false>(F.lds, D, D, D, S, E);
        if (BOTH(7)) GRID_BAR();
    }

    if (IN(8)) {
        for (int c = blockIdx.x; c < T / 256; c += F.G)
            moe::route_chunk(F.lds, ARG_OUT, ssq2, WR, (const float*)ARG_IN(22), (const float*)ARG_IN(20), tok_e, tok_gate, tok_rs, hist, c, F.tid, F.wave, F.lane);
        asm volatile("s_waitcnt vmcnt(0) lgkmcnt(0)" ::: "memory"); __syncthreads();
        if (BOTH(8)) GRID_BAR();
    }

    if (IN(9)) {
        for (int c = blockIdx.x; c < T / 256; c += F.G)
            moe::slot_chunk(F.lds, hist, tok_e, tok_gate, tok_rs, tok_slot, row_tok, slot_rs, slot_gate, etile, c, F.tid, F.wave, F.lane);
        asm volatile("s_waitcnt vmcnt(0) lgkmcnt(0)" ::: "memory"); __syncthreads();
        if (BOTH(9)) GRID_BAR();
    }

    if (IN(10)) {
        pg8::MoeOrder<0> S{(const char*)R2, (const char*)(ARG_WS + WS_W13), row_tok, etile, F.G, (int)blockIdx.x};
        pg8::EpiMoe1 E{(bf16_t*)(ARG_WS + WS_HID), slot_rs};
        pg8::gemm_phase<pg8::EpiMoe1, pg8::MoeOrder<0>, true, true>(F.lds, D, D, D, S, E);
        if (BOTH(10)) GRID_BAR();
    }

    if (IN(11)) {
        pg8::MoeOrder<1> S{(const char*)(ARG_WS + WS_HID), (const char*)(ARG_WS + WS_W2), row_tok, etile, F.G, (int)blockIdx.x};
        pg8::EpiMoe2 E{(bf16_t*)(ARG_WS + WS_Y), slot_gate};
        pg8::gemm_phase<pg8::EpiMoe2, pg8::MoeOrder<1>, true, false>(F.lds, FF, FF, FF, S, E);
        if (BOTH(11)) GRID_BAR();
    }

    if (IN(12)) {
        for (int t = gw; t < T; t += NGW) moe::final_row(ARG_OUT, (const bf16_t*)(ARG_WS + WS_Y), tok_slot, (const float*)ARG_IN(26), t, F.lane);
    }
#undef IN
#undef BOTH
}

typedef void (*kern_t)(Args);
template <int... I> struct PhList {};
extern "C" void kernel_launch(void* const* d_in, const int* in_sizes, int n_in, void* d_out, int out_size, void* d_ws, size_t ws_size, hipStream_t stream) {
    static int grid = 0;
#if MK_N_LAUNCHES == 1
    static const kern_t kerns[1] = {mega_fwd<0, NPH>};
#else
    static const kern_t kerns[NPH] = {mega_fwd<0, 1>, mega_fwd<1, 2>, mega_fwd<2, 3>, mega_fwd<3, 4>, mega_fwd<4, 5>, mega_fwd<5, 6>, mega_fwd<6, 7>, mega_fwd<7, 8>, mega_fwd<8, 9>, mega_fwd<9, 10>, mega_fwd<10, 11>, mega_fwd<11, 12>, mega_fwd<12, 13>};
#endif
    if (grid == 0) {
        if (n_in != 27 || in_sizes[0] != T * D || out_size != T * D || ws_size < WS_END) { fprintf(stderr, "kernel_launch: unexpected problem: n_in %d in0 %d out %d ARG_WS %zu (need %zu)\n", n_in, n_in > 0 ? in_sizes[0] : -1, out_size, ws_size, (size_t)WS_END); grid = -1; return; }
        int dev = 0, cus = 0, per_cu = 0;
        if (hipGetDevice(&dev) != hipSuccess || hipDeviceGetAttribute(&cus, hipDeviceAttributeMultiprocessorCount, dev) != hipSuccess) { grid = -1; return; }
        for (int li = 0; li < N_LAUNCHES; ++li)
            if (hipFuncSetAttribute((const void*)kerns[li], hipFuncAttributeMaxDynamicSharedMemorySize, LDS_BYTES) != hipSuccess) { fprintf(stderr, "kernel_launch: hipFuncSetAttribute failed\n"); grid = -1; return; }
        if (hipOccupancyMaxActiveBlocksPerMultiprocessor(&per_cu, (const void*)kerns[0], NWAVES * 64, LDS_BYTES) != hipSuccess || per_cu < 1) { fprintf(stderr, "kernel_launch: occupancy query says %d\n", per_cu); }
        (void)hipGetLastError();
        grid = cus;
    }
    if (grid < 0) return;
    if (hipMemsetAsync((char*)d_ws + WS_CTL, 0, CTL_ZERO_BYTES, stream) != hipSuccess) return;
    Args a{};
    for (int i = 0; i < 27; ++i) a.in[i] = d_in[i];
    a.out = (float*)d_out; a.ws = (unsigned char*)d_ws;
    for (int li = 0; li < N_LAUNCHES; ++li) {
        a.ph_lo = 0; a.ph_hi = 0; a.li = li; a.pad = 0;
        hipLaunchKernelGGL(kerns[li], dim3(grid), dim3(NWAVES * 64), LDS_BYTES, stream, a);
        const hipError_t le = hipPeekAtLastError();
        if (le != hipSuccess) { fprintf(stderr, "kernel_launch: launch %d failed: %s\n", li, hipGetErrorName(le)); break; }
    }
}
```

```cpp
#include <hip/hip_runtime.h>
#include <cstdio>
#include <cstdint>

#define GAS __attribute__((address_space(1)))
#define LAS __attribute__((address_space(3)))
typedef unsigned short bf16_t;
typedef short bf16x8 __attribute__((ext_vector_type(8)));
typedef short s16x4 __attribute__((ext_vector_type(4)));
typedef float f32x4 __attribute__((ext_vector_type(4)));
typedef float f32x2 __attribute__((ext_vector_type(2)));
typedef unsigned u32x4 __attribute__((ext_vector_type(4)));
typedef unsigned u32x2 __attribute__((ext_vector_type(2)));

constexpr int NB = 16, SEQ = 4096, T = NB * SEQ, D = 1024;
constexpr int CCH = 256, NH = 12, HD = 64, AW = NH * HD, INW = 2 * CCH + 3 * AW;
constexpr int MEML = 256, MROWS = NB * MEML, XH = 4, XHD = 256;
constexpr int NE = 32, EPG = 8, NG = 4, FF = 512;
constexpr int CONVK = 31;
constexpr int A_PAD = T * 2 + NE * 256;
constexpr float NORM_EPS = 1e-6f, LN_EPS = 1e-5f;
constexpr float LOG2E = 1.4426950408889634f;

constexpr size_t MiB = 1u << 20;
constexpr size_t WS_CTL = 0, CTL_ZERO_BYTES = 1 * MiB;
constexpr size_t WS_ROPE = 1 * MiB;
constexpr size_t WS_HIST = 2 * MiB;
constexpr size_t WS_SSQA = 4 * MiB;
constexpr size_t WS_SSQ1 = 8 * MiB;
constexpr size_t WS_SSQ2 = 12 * MiB;
constexpr size_t WS_WIN = 16 * MiB, WS_WOUT = 22 * MiB, WS_WXQ = 24 * MiB, WS_WXK = 26 * MiB, WS_WXV = 28 * MiB, WS_WXO = 30 * MiB;
constexpr size_t WS_W13 = 32 * MiB, WS_W2 = 96 * MiB;
constexpr size_t WS_MEMN = 128 * MiB, WS_KX = 136 * MiB, WS_VXT = 144 * MiB;
constexpr size_t WS_TOK = 152 * MiB;
constexpr size_t WS_R1 = 160 * MiB;
constexpr size_t WS_R2 = 288 * MiB;
constexpr size_t WS_Q = 320 * MiB, WS_K = 416 * MiB, WS_V = 512 * MiB;
constexpr size_t WS_XQ = 416 * MiB;
constexpr size_t WS_PM = 544 * MiB;
constexpr size_t WS_HID = 416 * MiB;
constexpr size_t WS_Y = 552 * MiB;
constexpr size_t WS_END = 824 * MiB;
constexpr size_t TK_E = 0;
constexpr size_t TK_GATE = 1 * MiB;
constexpr size_t TK_SLOT = 2 * MiB;
constexpr size_t TK_RS = 3 * MiB;
constexpr size_t TK_ROWTOK = 4 * MiB;
constexpr size_t TK_SLOTRS = 5 * MiB;
constexpr size_t TK_SLOTGATE = 6 * MiB;
constexpr size_t HIST_ETILE = 64 * 1024, HIST_WR = 128 * 1024;

constexpr int CW_BAR = 4096;

constexpr int NWAVES = 8;
constexpr int RING_BYTES = 131072;
constexpr int XCH_OFF = RING_BYTES;
constexpr int LDSCTL_OFF = RING_BYTES + 12288;
constexpr int LDS_BYTES = 147456;

#define LDS_WAIT() asm volatile("s_waitcnt lgkmcnt(0)" ::: "memory")
#define VM_WAIT() asm volatile("s_waitcnt vmcnt(0)" ::: "memory")
__device__ __forceinline__ unsigned f2bf(float f) { unsigned u = __builtin_bit_cast(unsigned, f); return (u + 0x7fffu + ((u >> 16) & 1u)) >> 16; }
__device__ __forceinline__ unsigned pk2(float lo, float hi) { return f2bf(lo) | (f2bf(hi) << 16); }
__device__ __forceinline__ float bf2f(unsigned short b) { return __builtin_bit_cast(float, (unsigned)b << 16); }
__device__ __forceinline__ float bflo(unsigned w) { return __builtin_bit_cast(float, w << 16); }
__device__ __forceinline__ float bfhi(unsigned w) { return __builtin_bit_cast(float, w & 0xffff0000u); }
__device__ __forceinline__ unsigned cvt_pk_bf16(float lo, float hi) { unsigned r; asm volatile("v_cvt_pk_bf16_f32 %0, %1, %2" : "=v"(r) : "v"(lo), "v"(hi)); return r; }
__device__ __forceinline__ float wave_sum(float v) {
#pragma unroll
    for (int o = 1; o < 64; o <<= 1) v += __shfl_xor(v, o);
    return v;
}
#define MK_N_LAUNCHES 1
namespace pg8 {
constexpr int BM = 256, BK = 64, HALF = 128, HTB = HALF * BK * 2  , STAGE_BYTES = 8 * HTB, NXCD = 8, WGM = 8;

__host__ __device__ __forceinline__ int lds_byte(int r, int c) { const int st = (r >> 4) * 2 + (c >> 5), rr = r & 15, cc = c & 31, ob = rr * 64 + cc * 2; return st * 1024 + (ob ^ (((ob >> 9) & 1) << 5)); }
__host__ __device__ __forceinline__ void stage_rc(int b, int& R, int& C) { const int st = b / 1024, sb = b % 1024, swz = sb ^ (((sb >> 9) & 1) << 5); R = (st >> 1) * 16 + swz / 64; C = (st & 1) * 32 + (swz % 64) / 2; }
__host__ __device__ __forceinline__ int perm32(int rho) { const int n = rho >> 4, i = rho & 15; return 8 * (i >> 2) + 4 * n + (i & 3); }

struct Unit { const char* a; const char* b; const int* rows; int pm, pn, x0, x1; };

typedef f32x4 Acc[2][2][4][2];

__device__ __forceinline__ const char* uniform_ptr(const char* p) { const unsigned long long v = (unsigned long long)p;
    const unsigned lo = __builtin_amdgcn_readfirstlane((unsigned)v), hi = __builtin_amdgcn_readfirstlane((unsigned)(v >> 32)); return (const char*)(((unsigned long long)hi << 32) | lo); }
__device__ __forceinline__ void glds16_sv(const char* gbase, unsigned voff, unsigned lds_dst) { unsigned keep;
    asm volatile("s_mov_b32 %0, m0\n\ts_mov_b32 m0, %3\n\ts_nop 0\n\tglobal_load_lds_dwordx4 %1, %2\n\ts_mov_b32 m0, %0" : "=&s"(keep) : "v"(voff), "s"(gbase), "s"(lds_dst) : "memory"); }
template <class Epi, class Sched, bool ALIGN_EPI, bool GATHER>
__device__ __forceinline__ void gemm_phase(LAS unsigned char* lds, const int lda, const int ldb, const int K, const Sched& S, const Epi& E) {
    int tid_ = threadIdx.x; asm volatile("" : "+v"(tid_));
    const int tid = tid_, wid = __builtin_amdgcn_readfirstlane(tid >> 6), lane = tid & 63, wr = wid >> 2, wc = wid & 3, fr = lane & 15, fq = lane >> 4;
    const int nt = K / BK;
    int Rr[2], Cc[2];
    unsigned vA[2][2], vN[2][2], voffB[2];
#pragma unroll
    for (int i = 0; i < 2; ++i) { int R, C; stage_rc(tid * 16 + i * 8192, R, C); Rr[i] = R; Cc[i] = C; const int Rb = Epi::PERM ? ((R & ~31) + perm32(R & 31)) : R;
        voffB[i] = (unsigned)(Rb * ldb + C) * 2u; }
    const size_t kstep = (size_t)(BK * 2);
    const size_t hstepB = (size_t)HALF * ldb * 2, hstepA = (size_t)HALF * lda * 2;
    const unsigned ldsw = (unsigned)wid * 1024u, lds0 = (unsigned)(uintptr_t)lds;
    const int aoff = lds_byte(wr * 64 + fr, fq * 8), boff = lds_byte(wc * 32 + fr, fq * 8);
#define PG8_SA(b, h) (((b) * 2 + (h)) * HTB)
#define PG8_SB(b, h) ((4 + (b) * 2 + (h)) * HTB)
#define PG8_STAGE(bufoff, gbase, voff) do { _Pragma("unroll") for (int _i = 0; _i < 2; ++_i) glds16_sv((gbase), (voff)[_i], lds0 + (unsigned)(bufoff) + ldsw + _i * 8192u); } while (0)
#define PG8_LDA(dst, b, h) do { _Pragma("unroll") for (int m = 0; m < 4; ++m) _Pragma("unroll") for (int k = 0; k < 2; ++k) dst[m][k] = *(const LAS bf16x8*)(lds + PG8_SA(b, h) + aoff + m * 2048 + k * 1024); } while (0)
#define PG8_LDB(dst, b, h) do { _Pragma("unroll") for (int n = 0; n < 2; ++n) _Pragma("unroll") for (int k = 0; k < 2; ++k) dst[n][k] = *(const LAS bf16x8*)(lds + PG8_SB(b, h) + boff + n * 2048 + k * 1024); } while (0)
#define PG8_MMA(ai, bj, At, Bt) do { __builtin_amdgcn_s_setprio(1); _Pragma("unroll") for (int m = 0; m < 4; ++m) _Pragma("unroll") for (int n = 0; n < 2; ++n) _Pragma("unroll") for (int k = 0; k < 2; ++k) \
        acc[ai][bj][m][n] = __builtin_amdgcn_mfma_f32_16x16x32_bf16(Bt[n][k], At[m][k], acc[ai][bj][m][n], 0, 0, 0); __builtin_amdgcn_s_setprio(0); } while (0)
#define PG8_WAIT_V(n) asm volatile("s_waitcnt vmcnt(" #n ")" ::: "memory")
#define PG8_WAIT_L(n) asm volatile("s_waitcnt lgkmcnt(" #n ")" ::: "memory")
#define PG8_BAR __builtin_amdgcn_s_barrier()
#define PG8_SCHED __builtin_amdgcn_sched_barrier(0)
#define PG8_VOFF(dst, u) do { _Pragma("unroll") for (int _h = 0; _h < 2; ++_h) _Pragma("unroll") for (int _i = 0; _i < 2; ++_i) { \
        if constexpr (GATHER) dst[_h][_i] = (unsigned)(u).rows[_h * HALF + Rr[_i]] * (unsigned)(lda * 2) + (unsigned)(Cc[_i] * 2); \
        else dst[_h][_i] = (unsigned)(Rr[_i] * lda + Cc[_i]) * 2u; } } while (0)
#define PG8_STAGE_A(bufoff, gbase, h, vv) do { if constexpr (GATHER) { PG8_STAGE(bufoff, gbase, vv[h]); } else { PG8_STAGE(bufoff, (gbase) + (h) * hstepA, vv[0]); } } while (0)
    Unit cur, nxt; int ui = 0;
    if (!S.next(0, cur)) return;
    Acc acc;
#pragma unroll
    for (int a = 0; a < 2; ++a)
#pragma unroll
        for (int b = 0; b < 2; ++b)
#pragma unroll
            for (int m = 0; m < 4; ++m)
#pragma unroll
                for (int n = 0; n < 2; ++n) acc[a][b][m][n] = (f32x4){0.f, 0.f, 0.f, 0.f};
    bf16x8 At[4][2], B0[2][2], B1[2][2];
    const char* cA = uniform_ptr(cur.a); const char* cB = uniform_ptr(cur.b);
    PG8_VOFF(vA, cur);
    if constexpr (GATHER) { asm volatile("s_waitcnt vmcnt(0)" ::: "memory"); }
    PG8_STAGE(PG8_SB(0, 0), cB, voffB); PG8_STAGE(PG8_SB(0, 1), cB + hstepB, voffB); PG8_STAGE_A(PG8_SA(0, 0), cA, 0, vA); PG8_STAGE_A(PG8_SA(0, 1), cA, 1, vA);
    if (wr == 1) PG8_BAR;
    PG8_WAIT_V(2); PG8_BAR;
    PG8_STAGE(PG8_SB(1, 0), cB + kstep, voffB); PG8_STAGE_A(PG8_SA(1, 0), cA + kstep, 0, vA); PG8_STAGE(PG8_SB(1, 1), cB + hstepB + kstep, voffB);
    PG8_WAIT_V(6); PG8_BAR;
    for (;;) {
        const bool has_next = S.next(ui + 1, nxt);
        const char* nA = has_next ? uniform_ptr(nxt.a) : cA; const char* nB = has_next ? uniform_ptr(nxt.b) : cB;
        if constexpr (GATHER) { if (has_next) { PG8_VOFF(vN, nxt); } else {
#pragma unroll
            for (int h = 0; h < 2; ++h) { vN[h][0] = vA[h][0]; vN[h][1] = vA[h][1]; } } }
#pragma nounroll
        for (int t = 0; t < nt; t += 2) {
            const bool last = (t == nt - 2);
            if constexpr (Epi::HAS_MID) { if (t == E.mid_t()) E.mid(acc, cur, wr, wc, fr, fq); }
            const char* a1 = cA + (size_t)(t + 1) * kstep;
            const char* a2 = last ? nA : cA + (size_t)(t + 2) * kstep; const char* b2 = last ? nB : cB + (size_t)(t + 2) * kstep;
            const char* a3 = a2 + kstep; const char* b3 = b2 + kstep;
            unsigned vW[2][2];
#pragma unroll
            for (int h = 0; h < 2; ++h) { vW[h][0] = vA[h][0]; vW[h][1] = vA[h][1]; if constexpr (GATHER) { if (last) { vW[h][0] = vN[h][0]; vW[h][1] = vN[h][1]; } } }
            PG8_LDB(B0, 0, 0); PG8_LDB(B1, 0, 1); PG8_SCHED; PG8_LDA(At, 0, 0); PG8_STAGE_A(PG8_SA(1, 1), a1, 1, vA);
            PG8_WAIT_V(8); PG8_WAIT_L(0); PG8_BAR; PG8_MMA(0, 0, At, B0); PG8_MMA(0, 1, At, B1); PG8_BAR; PG8_SCHED;
            PG8_LDA(At, 0, 1); PG8_STAGE(PG8_SB(0, 0), b2, voffB); PG8_STAGE(PG8_SB(0, 1), b2 + hstepB, voffB); PG8_STAGE_A(PG8_SA(0, 0), a2, 0, vW);
            PG8_WAIT_V(8); PG8_WAIT_L(0); PG8_BAR; PG8_MMA(1, 0, At, B0); PG8_MMA(1, 1, At, B1); PG8_BAR; PG8_SCHED;
            PG8_LDB(B0, 1, 0); PG8_LDB(B1, 1, 1); PG8_SCHED; PG8_LDA(At, 1, 0); PG8_STAGE_A(PG8_SA(0, 1), a2, 1, vW);
            PG8_WAIT_V(8); PG8_WAIT_L(0); PG8_BAR; PG8_MMA(0, 0, At, B0); PG8_MMA(0, 1, At, B1); PG8_BAR; PG8_SCHED;
            PG8_LDA(At, 1, 1); PG8_STAGE(PG8_SB(1, 0), b3, voffB); PG8_STAGE(PG8_SB(1, 1), b3 + hstepB, voffB); PG8_STAGE_A(PG8_SA(1, 0), a3, 0, vW);
            PG8_WAIT_V(8); PG8_WAIT_L(0); PG8_BAR; PG8_MMA(1, 0, At, B0); PG8_MMA(1, 1, At, B1); PG8_BAR; PG8_SCHED;
        }
        if constexpr (ALIGN_EPI) { if (wr == 0) PG8_BAR; }
        E(acc, cur, wr, wc, fr, fq, lds, wid, lane);
        if (!has_next) break;
#pragma unroll
        for (int a = 0; a < 2; ++a)
#pragma unroll
            for (int b = 0; b < 2; ++b)
#pragma unroll
                for (int m = 0; m < 4; ++m)
#pragma unroll
                    for (int n = 0; n < 2; ++n) acc[a][b][m][n] = (f32x4){0.f, 0.f, 0.f, 0.f};
        cur = nxt; cA = nA; cB = nB; ++ui;
        if constexpr (GATHER) {
#pragma unroll
            for (int h = 0; h < 2; ++h) { vA[h][0] = vN[h][0]; vA[h][1] = vN[h][1]; } }
        if constexpr (ALIGN_EPI) { if (wr == 1) PG8_BAR; }
    }
    PG8_WAIT_V(0);
    if constexpr (!ALIGN_EPI) { if (wr == 0) PG8_BAR; }
    PG8_BAR;
#undef PG8_SA
#undef PG8_SB
#undef PG8_STAGE
#undef PG8_LDA
#undef PG8_LDB
#undef PG8_MMA
#undef PG8_WAIT_V
#undef PG8_WAIT_L
#undef PG8_BAR
#undef PG8_SCHED
#undef PG8_VOFF
#undef PG8_STAGE_A
}
}
#define XB_TMO      128
#define XB_XCNT(j)  (256  + 64 * (j))
#define XB_XSUB(j)  (1280 + 64 * (j))
#define XB_XGEN(j)  (2304 + 64 * (j))
#define XB_TOP      3328
#define XB_TOPGEN   3392
#define XCD_BAR_WORDS 3456
#define XB_SPIN_CAP (1u << 18)

__device__ __forceinline__ unsigned xb_ld(unsigned* p)              { return __hip_atomic_load(p, __ATOMIC_RELAXED, __HIP_MEMORY_SCOPE_AGENT); }
__device__ __forceinline__ unsigned xb_add(unsigned* p, unsigned v) { return __hip_atomic_fetch_add(p, v, __ATOMIC_RELAXED, __HIP_MEMORY_SCOPE_AGENT); }
__device__ __forceinline__ unsigned xb_xcc_id() { return (unsigned)__builtin_amdgcn_s_getreg((3 << 11) | 20) & 0xFu; }
#define XB_SPIN(cond, bar) do { unsigned _sp = 0; while (cond) { __builtin_amdgcn_s_sleep(1); \
    if ((++_sp & 255u) == 0u) { if (xb_ld(&(bar)[XB_TMO])) break; if (_sp > XB_SPIN_CAP) { atomicAdd(&(bar)[XB_TMO], 1u); break; } } } } while (0)

struct XcdBarrier {
    unsigned* bar; unsigned x;
    volatile LAS unsigned* st;
};

__device__ __forceinline__ XcdBarrier xcd_barrier_post(unsigned* bar, volatile LAS unsigned* st) {
    XcdBarrier b; b.bar = bar; b.x = xb_xcc_id(); b.st = st;
    if (threadIdx.x == 0) (void)xb_add(&bar[XB_XCNT(b.x)], 1u);
    return b;
}
__device__ __forceinline__ void xcd_barrier_complete(unsigned* bar, unsigned x, unsigned& nloc, unsigned& nx) {
    const unsigned G = gridDim.x * gridDim.y * gridDim.z;
    unsigned sum, cnt, mine, sp = 0u;
    for (;;) {
        sum = 0u; cnt = 0u; mine = 0u;
#pragma unroll
        for (unsigned j = 0; j < 16; ++j) { const unsigned c = xb_ld(&bar[XB_XCNT(j)]); sum += c; cnt += (c > 0u) ? 1u : 0u; mine = (j == x) ? c : mine; }
        if (sum == G) break;
        __builtin_amdgcn_s_sleep(1);
        if ((++sp & 255u) == 0u) { if (xb_ld(&bar[XB_TMO])) break; if (sp > XB_SPIN_CAP) { atomicAdd(&bar[XB_TMO], 1u); break; } }
    }
    nloc = mine > 0u ? mine : 1u; nx = cnt > 0u ? cnt : 1u;
}

__device__ __forceinline__ void xcd_barrier(const XcdBarrier& b) {
    asm volatile("s_waitcnt vmcnt(0)" ::: "memory");
    __syncthreads();
    if (threadIdx.x == 0) {
        unsigned* bar = b.bar;
        __builtin_amdgcn_s_waitcnt(0);
        unsigned nloc = b.st[0], nx = b.st[1];
        if (nloc == 0u) { xcd_barrier_complete(bar, b.x, nloc, nx); b.st[0] = nloc; b.st[1] = nx; }
        const unsigned old = xb_add(&bar[XB_XSUB(b.x)], 1u);
        const unsigned gen = old / nloc;
        if (old + 1u == (gen + 1u) * nloc) {
            __builtin_amdgcn_fence(__ATOMIC_RELEASE, "agent");
            asm volatile("s_waitcnt vmcnt(0)" ::: "memory");
            const unsigned og = xb_add(&bar[XB_TOP], 1u);
            const unsigned tg = og / nx;
            if (og + 1u == (tg + 1u) * nx) xb_add(&bar[XB_TOPGEN], 1u);
            else XB_SPIN(xb_ld(&bar[XB_TOPGEN]) == tg, bar);
            __builtin_amdgcn_fence(__ATOMIC_ACQUIRE, "agent");
            xb_add(&bar[XB_XGEN(b.x)], 1u);
            asm volatile("s_waitcnt vmcnt(0)" ::: "memory");
        } else {
            XB_SPIN(xb_ld(&bar[XB_XGEN(b.x)]) == gen, bar);
            __builtin_amdgcn_fence(__ATOMIC_ACQUIRE, "agent");
            asm volatile("s_waitcnt vmcnt(0)" ::: "memory");
        }
    }
    __syncthreads();
}

namespace pg8 {
#define EPI_NOMID static constexpr bool HAS_MID = false; __device__ __forceinline__ int mid_t() const { return -1; } __device__ __forceinline__ void mid(Acc&, const Unit&, int, int, int, int) const {}
#define RAW_BARRIER() do { asm volatile("s_waitcnt lgkmcnt(0)" ::: "memory"); __builtin_amdgcn_s_barrier(); asm volatile("" ::: "memory"); } while (0)

__device__ __forceinline__ u32x4 pack8(const f32x4& v0, const f32x4& v1) { u32x4 w; w.x = cvt_pk_bf16(v0[0], v0[1]); w.y = cvt_pk_bf16(v0[2], v0[3]); w.z = cvt_pk_bf16(v1[0], v1[1]); w.w = cvt_pk_bf16(v1[2], v1[3]); return w; }

struct GridOrder {
    const char* A; const char* Bt; int lda, ldb, nM, nN, nwg, G, c, dup;
    __device__ __forceinline__ void init(const void* A_, const void* Bt_, int lda_, int ldb_, int M, int N, int G_, int c_) { A = (const char*)A_; Bt = (const char*)Bt_; lda = lda_; ldb = ldb_; nM = M / BM; nN = N / BM; nwg = nM * nN; G = G_; c = c_; dup = 1; }
    __device__ __forceinline__ bool next(int i, Unit& u) const {
        const long L = (long)i * G + c; if (L >= (long)nwg * dup) return false;
        int wgid = (int)(L % nwg); { const int q = nwg / NXCD, r = nwg % NXCD, xcd = wgid % NXCD, off = wgid / NXCD; wgid = (xcd < r ? xcd * (q + 1) : r * (q + 1) + (xcd - r) * q) + off; }
        const int nig = WGM * nN, gid = wgid / nig, fm = gid * WGM, gsz = (nM - fm) < WGM ? (nM - fm) : WGM;
        u.pm = fm + ((wgid % nig) % gsz); u.pn = (wgid % nig) / gsz; u.x0 = 0; u.x1 = 0; u.rows = nullptr;
        u.a = A + (size_t)u.pm * BM * lda * 2; u.b = Bt + (size_t)u.pn * BM * ldb * 2; return true;
    }
};
struct KvOrder {
    const char* memn; const char* wk; const char* wv; int G, c;
    __device__ __forceinline__ bool next(int i, Unit& u) const {
        const int L = i * G + c; if (L >= 128) return false;
        u.rows = nullptr; u.x1 = 0;
        if (L < 64) { u.pm = L >> 2; u.pn = L & 3; u.x0 = 0; u.a = memn + (size_t)u.pm * BM * D * 2; u.b = wk + (size_t)u.pn * BM * D * 2; }
        else { const int l = L - 64; u.pm = l >> 4; u.pn = l & 15; u.x0 = 1; u.a = wv + (size_t)u.pm * BM * D * 2; u.b = memn + (size_t)u.pn * BM * D * 2; }
        return true;
    }
};
template <int MODE> struct XaOrder {
    const char* A; const char* B; int G, c;
    __device__ __forceinline__ bool next(int i, Unit& u) const {
        const int L = i * G + c; if (L >= NB * XH * 16) return false;
        const int qt = L & 15, bh = L >> 4, b = bh >> 2, h = bh & 3;
        u.pm = b * 16 + qt; u.pn = h; u.x0 = 0; u.x1 = 0; u.rows = nullptr;
        u.a = A + ((size_t)u.pm * BM * D + h * XHD) * 2;
        if (MODE == 0) u.b = B + ((size_t)b * MEML * D + h * XHD) * 2;
        else u.b = B + ((size_t)h * XHD * MROWS + b * MEML) * 2;
        return true;
    }
};
template <int MODE> struct MoeOrder {
    const char* A; const char* W; const int* rowtok; const int* etile; int G, c, dup;
    __device__ __forceinline__ bool next(int i, Unit& u) const {
        int L = i * G + c; const int ntile = etile[NE];
        if (L >= ntile * 4 * dup) return false;
        L %= ntile * 4;
        const int rt = L >> 2, ct = L & 3; int e = 0;
        for (int j = 1; j < NE; ++j) e = (etile[j] <= rt) ? j : e;
        u.pm = rt; u.pn = ct; u.x0 = e; u.x1 = 0;
        if (MODE == 0) { u.a = A; u.rows = rowtok + rt * BM; u.b = W + ((size_t)e * 1024 + ct * BM) * D * 2; }
        else { u.a = A + (size_t)rt * BM * FF * 2; u.rows = nullptr; u.b = W + ((size_t)e * 1024 + ct * BM) * FF * 2; }
        return true;
    }
};

struct EpiU {
    static constexpr bool PERM = true; EPI_NOMID
    bf16_t* Cb; bf16_t* Q; bf16_t* Kb; bf16_t* V; const float* ropec; const float* ropes;
    __device__ __forceinline__ void operator()(Acc& acc, const Unit& u, int wr, int wc, int fr, int fq, LAS unsigned char*, int, int) const {
        const int row0 = u.pm * BM + wr * 64 + fr;
        if (u.pn < 2) {
#pragma unroll
            for (int ai = 0; ai < 2; ++ai)
#pragma unroll
                for (int m = 0; m < 4; ++m) { const int row = row0 + ai * HALF + m * 16; f32x4 o[2];
#pragma unroll
                    for (int n = 0; n < 2; ++n)
#pragma unroll
                        for (int i = 0; i < 4; ++i) { const float a = acc[ai][0][m][n][i], g = acc[ai][1][m][n][i]; o[n][i] = a / (1.f + __expf(-g)); }
                    *(u32x4*)(Cb + (size_t)row * CCH + u.pn * HALF + wc * 32 + fq * 8) = pack8(o[0], o[1]); }
        } else if (u.pn < 8) {
            const int sec = (u.pn - 2) / 3, tt = (u.pn - 2) % 3; bf16_t* dst = sec ? Kb : Q; const float sc = sec ? 1.f : 0.125f * LOG2E;
            const int colb = (4 * tt + wc) * HD + fq * 8;
#pragma unroll
            for (int ai = 0; ai < 2; ++ai)
#pragma unroll
                for (int m = 0; m < 4; ++m) { const int row = row0 + ai * HALF + m * 16; const int s = row & (SEQ - 1); f32x4 o1[2], o2[2];
#pragma unroll
                    for (int n = 0; n < 2; ++n) { const f32x4 cs = *(const f32x4*)(ropec + s * 32 + fq * 8 + n * 4), sn = *(const f32x4*)(ropes + s * 32 + fq * 8 + n * 4);
                        const f32x4 x1 = acc[ai][0][m][n], x2 = acc[ai][1][m][n];
                        o1[n] = (x1 * cs - x2 * sn) * sc; o2[n] = (x1 * sn + x2 * cs) * sc; }
                    bf16_t* p = dst + (size_t)row * AW + colb;
                    *(u32x4*)p = pack8(o1[0], o1[1]); *(u32x4*)(p + 32) = pack8(o2[0], o2[1]); }
        } else {
            const int tt = u.pn - 8;
#pragma unroll
            for (int ai = 0; ai < 2; ++ai)
#pragma unroll
                for (int m = 0; m < 4; ++m) { const int row = row0 + ai * HALF + m * 16;
#pragma unroll
                    for (int bj = 0; bj < 2; ++bj) *(u32x4*)(V + (size_t)row * AW + tt * BM + bj * HALF + wc * 32 + fq * 8) = pack8(acc[ai][bj][m][0], acc[ai][bj][m][1]); }
        }
    }
};
template <bool ROWSCALE> struct EpiPlain {
    static constexpr bool PERM = true; EPI_NOMID
    bf16_t* O0; int ldc0; bf16_t* O1; int ldc1; const float* ssq16;
    __device__ __forceinline__ void operator()(Acc& acc, const Unit& u, int wr, int wc, int fr, int fq, LAS unsigned char*, int, int) const {
        bf16_t* O = u.x0 ? O1 : O0; const int ldc = u.x0 ? ldc1 : ldc0;
        const int row0 = u.pm * BM + wr * 64 + fr, col0 = u.pn * BM + wc * 32 + fq * 8;
#pragma unroll
        for (int ai = 0; ai < 2; ++ai)
#pragma unroll
            for (int m = 0; m < 4; ++m) { const int row = row0 + ai * HALF + m * 16; float rs = 1.f;
                if constexpr (ROWSCALE) { const f32x4* sp = (const f32x4*)(ssq16 + (size_t)row * 16); const f32x4 s0 = sp[0], s1 = sp[1], s2 = sp[2], s3 = sp[3];
                    const f32x4 st = (s0 + s1) + (s2 + s3); rs = 1.0f / sqrtf(((st[0] + st[1]) + (st[2] + st[3])) * (1.0f / D) + NORM_EPS); }
#pragma unroll
                for (int bj = 0; bj < 2; ++bj) *(u32x4*)(O + (size_t)row * ldc + col0 + bj * HALF) = pack8(acc[ai][bj][m][0] * rs, acc[ai][bj][m][1] * rs); }
    }
};
template <bool MID> struct EpiResid {
    static constexpr bool PERM = false, HAS_MID = MID;
    const float* xin; float* xout; bf16_t* XB; float* ssqp; const float* ssqa;
    __device__ __forceinline__ int mid_t() const { return AW / BK; }
    __device__ __forceinline__ void mid(Acc& acc, const Unit& u, int wr, int wc, int fr, int fq) const {
        const int row0 = u.pm * BM + wr * 64 + fr;
#pragma unroll
        for (int ai = 0; ai < 2; ++ai)
#pragma unroll
            for (int m = 0; m < 4; ++m) { const int row = row0 + ai * HALF + m * 16; const f32x4* sp = (const f32x4*)(ssqa + (size_t)row * NH);
                const f32x4 s0 = sp[0], s1 = sp[1], s2 = sp[2]; const f32x4 st = (s0 + s1) + s2;
                const float r = 1.0f / sqrtf(((st[0] + st[1]) + (st[2] + st[3])) * (1.0f / AW) + NORM_EPS);
#pragma unroll
                for (int bj = 0; bj < 2; ++bj)
#pragma unroll
                    for (int n = 0; n < 2; ++n) acc[ai][bj][m][n] = acc[ai][bj][m][n] * r;
                asm volatile("" ::: "memory"); }
    }
    __device__ __forceinline__ void operator()(Acc& acc, const Unit& u, int wr, int wc, int fr, int fq, LAS unsigned char*, int, int) const {
        const int row0 = u.pm * BM + wr * 64 + fr, col0 = u.pn * BM + wc * 32 + fq * 4;
#pragma unroll
        for (int ai = 0; ai < 2; ++ai)
#pragma unroll
            for (int m = 0; m < 4; ++m) { const int row = row0 + ai * HALF + m * 16; float ss = 0.f;
#pragma unroll
                for (int bj = 0; bj < 2; ++bj)
#pragma unroll
                    for (int n = 0; n < 2; ++n) { const size_t o = (size_t)row * D + col0 + bj * HALF + n * 16;
                        const f32x4 v = *(const f32x4*)(xin + o) + acc[ai][bj][m][n];
                        *(f32x4*)(xout + o) = v; u32x2 w; w.x = cvt_pk_bf16(v[0], v[1]); w.y = cvt_pk_bf16(v[2], v[3]); *(u32x2*)(XB + o) = w;
                        ss += (v[0] * v[0] + v[1] * v[1]) + (v[2] * v[2] + v[3] * v[3]); }
                ss += __shfl_xor(ss, 16); ss += __shfl_xor(ss, 32);
                if (fq == 0) ssqp[(size_t)row * 16 + u.pn * 4 + wc] = ss; }
    }
};
struct EpiSoftmax {
    static constexpr bool PERM = true; EPI_NOMID
    bf16_t* PM;
    __device__ __forceinline__ void operator()(Acc& acc, const Unit& u, int wr, int wc, int fr, int fq, LAS unsigned char* lds, int, int) const {
        LAS float* MX = (LAS float*)(lds + XCH_OFF); LAS float* SM = (LAS float*)(lds + XCH_OFF + 4096);
#pragma unroll
        for (int ai = 0; ai < 2; ++ai)
#pragma unroll
            for (int m = 0; m < 4; ++m) { const int rl = ai * HALF + wr * 64 + m * 16 + fr; float mx = -3.0e38f;
#pragma unroll
                for (int bj = 0; bj < 2; ++bj)
#pragma unroll
                    for (int n = 0; n < 2; ++n) { const f32x4 v = acc[ai][bj][m][n]; mx = fmaxf(mx, fmaxf(fmaxf(v[0], v[1]), fmaxf(v[2], v[3]))); }
                mx = fmaxf(mx, __shfl_xor(mx, 16)); mx = fmaxf(mx, __shfl_xor(mx, 32));
                if (fq == 0) MX[rl * 4 + wc] = mx; }
        RAW_BARRIER();
#pragma unroll
        for (int ai = 0; ai < 2; ++ai)
#pragma unroll
            for (int m = 0; m < 4; ++m) { const int rl = ai * HALF + wr * 64 + m * 16 + fr; const f32x4 mm = *(const LAS f32x4*)(MX + rl * 4);
                const float mx = fmaxf(fmaxf(mm[0], mm[1]), fmaxf(mm[2], mm[3])); float ss = 0.f;
#pragma unroll
                for (int bj = 0; bj < 2; ++bj)
#pragma unroll
                    for (int n = 0; n < 2; ++n) { f32x4 v = acc[ai][bj][m][n];
#pragma unroll
                        for (int i = 0; i < 4; ++i) { v[i] = __builtin_amdgcn_exp2f(v[i] - mx); ss += v[i]; }
                        acc[ai][bj][m][n] = v; }
                ss += __shfl_xor(ss, 16); ss += __shfl_xor(ss, 32);
                if (fq == 0) SM[rl * 4 + wc] = ss; }
        RAW_BARRIER();
        const int col0 = u.pn * BM + wc * 32 + fq * 8;
#pragma unroll
        for (int ai = 0; ai < 2; ++ai)
#pragma unroll
            for (int m = 0; m < 4; ++m) { const int rl = ai * HALF + wr * 64 + m * 16 + fr; const f32x4 s4 = *(const LAS f32x4*)(SM + rl * 4);
                const float inv = 1.0f / ((s4[0] + s4[1]) + (s4[2] + s4[3]));
#pragma unroll
                for (int bj = 0; bj < 2; ++bj) *(u32x4*)(PM + (size_t)(u.pm * BM + rl) * D + col0 + bj * HALF) = pack8(acc[ai][bj][m][0] * inv, acc[ai][bj][m][1] * inv); }
    }
};
struct EpiMoe1 {
    static constexpr bool PERM = true; EPI_NOMID
    bf16_t* HID; const float* slot_rs;
    __device__ __forceinline__ void operator()(Acc& acc, const Unit& u, int wr, int wc, int fr, int fq, LAS unsigned char*, int, int) const {
        const int row0 = u.pm * BM + wr * 64 + fr;
#pragma unroll
        for (int ai = 0; ai < 2; ++ai)
#pragma unroll
            for (int m = 0; m < 4; ++m) { const int row = row0 + ai * HALF + m * 16; const float rs = slot_rs[row]; f32x4 o[2];
#pragma unroll
                for (int n = 0; n < 2; ++n)
#pragma unroll
                    for (int i = 0; i < 4; ++i) { const float a = acc[ai][0][m][n][i] * rs, b = acc[ai][1][m][n][i] * rs; o[n][i] = a * b / (1.f + __expf(-a)); }
                *(u32x4*)(HID + (size_t)row * FF + u.pn * HALF + wc * 32 + fq * 8) = pack8(o[0], o[1]); }
    }
};
struct EpiMoe2 {
    static constexpr bool PERM = true; EPI_NOMID
    bf16_t* Y; const float* slot_gate;
    __device__ __forceinline__ void operator()(Acc& acc, const Unit& u, int wr, int wc, int fr, int fq, LAS unsigned char*, int, int) const {
        const int row0 = u.pm * BM + wr * 64 + fr, col0 = u.pn * BM + wc * 32 + fq * 8;
#pragma unroll
        for (int ai = 0; ai < 2; ++ai)
#pragma unroll
            for (int m = 0; m < 4; ++m) { const int row = row0 + ai * HALF + m * 16; const float g = slot_gate[row];
#pragma unroll
                for (int bj = 0; bj < 2; ++bj) *(u32x4*)(Y + (size_t)row * D + col0 + bj * HALF) = pack8(acc[ai][bj][m][0] * g, acc[ai][bj][m][1] * g); }
    }
};
}
struct Frame {
    LAS unsigned char* lds;
    volatile LAS unsigned* MISC;
    unsigned* ctl;
    unsigned char* ws;
    int tid, lane, wave, vcu, G;
};
struct Args { const void* in[27]; float* out; unsigned char* ws; int ph_lo, ph_hi, li, pad; };

__device__ __forceinline__ void tr_item(const float* W, int ldw, int srcrow0, int srccol0, bf16_t* WT, int dpitch, size_t drow0, int dk0, const float* gk, float sc, LAS float* scr, int lane) {
#pragma unroll 8
    for (int i = 0; i < 32; ++i) { const int kk = 2 * i + (lane >> 5); const float g = gk ? gk[kk] * sc : sc;
        scr[kk * 33 + (lane & 31)] = W[(size_t)(srcrow0 + kk) * ldw + srccol0 + (lane & 31)] * g; }
    LDS_WAIT(); asm volatile("" ::: "memory");
    const int c = lane & 7;
#pragma unroll
    for (int j = 0; j < 4; ++j) { const int n = (lane >> 3) + 8 * j; const LAS float* s = scr + (8 * c) * 33 + n;
        u32x4 o; o.x = pk2(s[0 * 33], s[1 * 33]); o.y = pk2(s[2 * 33], s[3 * 33]); o.z = pk2(s[4 * 33], s[5 * 33]); o.w = pk2(s[6 * 33], s[7 * 33]);
        *(u32x4*)(WT + (drow0 + n) * dpitch + dk0 + 8 * c) = o; }
    LDS_WAIT(); asm volatile("" ::: "memory");
}
__device__ __forceinline__ void rms_row_to_bf16(const float* xrow, const float* g, bf16_t* orow, int lane) {
    const f32x4* xr = (const f32x4*)xrow + lane; const f32x4* gr = (const f32x4*)g + lane;
    f32x4 v[4]; float s = 0.f;
#pragma unroll
    for (int j = 0; j < 4; ++j) { v[j] = xr[64 * j]; s += (v[j][0] * v[j][0] + v[j][1] * v[j][1]) + (v[j][2] * v[j][2] + v[j][3] * v[j][3]); }
    const float rs = 1.0f / sqrtf(wave_sum(s) * (1.f / D) + NORM_EPS);
    u32x2* o8 = (u32x2*)orow + lane;
#pragma unroll
    for (int j = 0; j < 4; ++j) { const f32x4 gg = gr[64 * j]; u32x2 w; w.x = pk2(v[j][0] * rs * gg[0], v[j][1] * rs * gg[1]); w.y = pk2(v[j][2] * rs * gg[2], v[j][3] * rs * gg[3]); o8[64 * j] = w; }
}
__device__ __forceinline__ double rope_inv(int d) {
    const int q = d >> 3, r = d & 7;
    double b = 1.0;
    b = (r == 1) ? 0.7498942093324558273 : b; b = (r == 2) ? 0.56234132519034908039 : b; b = (r == 3) ? 0.42169650342858224857 : b; b = (r == 4) ? 0.3162277660168379332 : b;
    b = (r == 5) ? 0.23713737056616552617 : b; b = (r == 6) ? 0.17782794100389228012 : b; b = (r == 7) ? 0.13335214321633240257 : b;
    const double p = (q == 0) ? 1.0 : (q == 1) ? 0.1 : (q == 2) ? 0.01 : 0.001;
    return b * p;
}
__device__ __forceinline__ void sincos_d(double a, double& sn, double& cs) {
    const double k = __builtin_rint(a * 0.63661977236758134308);
    double y = __builtin_fma(-k, 1.57079632679489655800e+00, a); y = __builtin_fma(-k, 6.12323399573676603587e-17, y);
    const double y2 = y * y;
    double s = 1.0 / 6227020800.0; s = s * y2 - 1.0 / 39916800.0; s = s * y2 + 1.0 / 362880.0; s = s * y2 - 1.0 / 5040.0; s = s * y2 + 1.0 / 120.0; s = s * y2 - 1.0 / 6.0; s = s * y2 * y + y;
    double c = 1.0 / 479001600.0; c = c * y2 - 1.0 / 3628800.0; c = c * y2 + 1.0 / 40320.0; c = c * y2 - 1.0 / 720.0; c = c * y2 + 1.0 / 24.0; c = c * y2 - 0.5; c = c * y2 + 1.0;
    const int qd = ((int)k) & 3;
    sn = (qd == 0) ? s : (qd == 1) ? c : (qd == 2) ? -s : -c;
    cs = (qd == 0) ? c : (qd == 1) ? -s : (qd == 2) ? -c : s;
}
typedef const void* gen_cptr;
typedef __attribute__((address_space(4))) const char* cas_cptr;
typedef __attribute__((address_space(4))) const gen_cptr* cas_pptr;
__device__ __forceinline__ const void* karg_ptr(int byte_off) { cas_cptr p = (cas_cptr)__builtin_amdgcn_kernarg_segment_ptr(); asm volatile("" : "+s"(p)); return *(cas_pptr)(p + byte_off); }
__device__ __forceinline__ void p0_prologue(Frame& F) {
    const float* x = (const float*)karg_ptr(8 * 0); const float* mem = (const float*)karg_ptr(8 * 1); const int* positions = (const int*)karg_ptr(8 * 2);
    const float* mix_g = (const float*)karg_ptr(8 * 3); const float* w_in = (const float*)karg_ptr(8 * 4);
    const float* attn_out_g = (const float*)karg_ptr(8 * 10); const float* w_out = (const float*)karg_ptr(8 * 11);
    const float* xattn_g = (const float*)karg_ptr(8 * 12); const float* mem_g = (const float*)karg_ptr(8 * 13);
    const float* w_xq = (const float*)karg_ptr(8 * 14); const float* w_xk = (const float*)karg_ptr(8 * 15); const float* w_xv = (const float*)karg_ptr(8 * 16); const float* w_xo = (const float*)karg_ptr(8 * 17);
    const float* moe_g = (const float*)karg_ptr(8 * 18); const float* w_group = (const float*)karg_ptr(8 * 19); const float* w_router = (const float*)karg_ptr(8 * 21);
    const float* w1 = (const float*)karg_ptr(8 * 23); const float* w3 = (const float*)karg_ptr(8 * 24); const float* w2 = (const float*)karg_ptr(8 * 25);
    unsigned char* ws = F.ws;
    LAS float* scr = (LAS float*)(F.lds + F.wave * 16384);
    const int gw = F.vcu * NWAVES + F.wave, NGW = F.G * NWAVES;
    constexpr int I_IN = 16 * 88, I_SQ = 16 * 32, I_13 = NE * 16 * 32, I_2 = NE * 8 * 32;
    constexpr int NITEMS = I_IN + 5 * I_SQ + I_13 + I_2;
    for (int it = gw; it < NITEMS; it += NGW) {
        int r = it;
        if (r < I_IN) { const int kb = r / 88, nb = r % 88, n0 = 32 * nb, tile = n0 >> 8, j = n0 & 255; int src;
            if (tile < 2) src = (j < 128) ? 128 * tile + j : 256 + 128 * tile + (j - 128);
            else if (tile < 8) { const int sec = (tile - 2) / 3, tt = (tile - 2) % 3, jj = j & 127, hh = jj >> 5; src = 512 + 768 * sec + 256 * tt + 64 * hh + ((j < 128) ? 0 : 32); }
            else src = n0;
            tr_item(w_in, INW, 64 * kb, src, (bf16_t*)(ws + WS_WIN), D, (size_t)n0, 64 * kb, nullptr, 1.f, scr, F.lane); continue; }
        r -= I_IN;
        if (r < I_SQ) { const int kb = r / 32, nb = r % 32, dk0 = 64 * kb; const bool at = dk0 < AW;
            tr_item(w_out, D, at ? CCH + dk0 : dk0 - AW, 32 * nb, (bf16_t*)(ws + WS_WOUT), D, (size_t)(32 * nb), dk0, at ? attn_out_g + dk0 : nullptr, 1.f, scr, F.lane); continue; }
        r -= I_SQ;
        if (r < 4 * I_SQ) { const int which = r / I_SQ, r2 = r % I_SQ, kb = r2 / 32, nb = r2 % 32;
            const float* W = which == 0 ? w_xq : which == 1 ? w_xk : which == 2 ? w_xv : w_xo;
            bf16_t* WT = (bf16_t*)(ws + (which == 0 ? WS_WXQ : which == 1 ? WS_WXK : which == 2 ? WS_WXV : WS_WXO));
            tr_item(W, D, 64 * kb, 32 * nb, WT, D, (size_t)(32 * nb), 64 * kb, which == 0 ? xattn_g + 64 * kb : nullptr, which == 0 ? LOG2E / 16.f : 1.f, scr, F.lane); continue; }
        r -= 4 * I_SQ;
        if (r < I_13) { const int e = r / 512, r2 = r % 512, kb = r2 / 32, nb = r2 % 32, n0 = 32 * nb, tt = n0 >> 8, j = n0 & 255;
            const float* W = ((j < 128) ? w1 : w3) + (size_t)e * D * FF;
            tr_item(W, FF, 64 * kb, 128 * tt + (j & 127), (bf16_t*)(ws + WS_W13), D, (size_t)e * 1024 + n0, 64 * kb, moe_g + 64 * kb, 1.f, scr, F.lane); continue; }
        r -= I_13;
        { const int e = r / 256, r2 = r % 256, kb = r2 / 32, nb = r2 % 32;
            tr_item(w2 + (size_t)e * FF * D, D, 64 * kb, 32 * nb, (bf16_t*)(ws + WS_W2), FF, (size_t)e * 1024 + 32 * nb, 64 * kb, nullptr, 1.f, scr, F.lane); }
    }
    { bf16_t* WRF = (bf16_t*)(ws + WS_HIST + HIST_WR);
      for (int i = blockIdx.x * 512 + F.tid; i < 4 * 8 * 3 * 2 * 64 * 8; i += F.G * 512) {
          const int j = i & 7, ln = (i >> 3) & 63, part = (i >> 9) & 1, blk = i >> 10, nt = blk % 3, s = (blk / 3) & 7, kc = blk / 24;
          const int k = 256 * kc + 32 * s + 8 * (ln >> 4) + j, o = 16 * nt + (ln & 15);
          float v = 0.f; if (o < 32) v = w_router[k * 32 + o] * moe_g[k]; else if (o < 36) v = w_group[k * 4 + (o - 32)] * moe_g[k];
          const unsigned hb = f2bf(v); const float hf = __builtin_bit_cast(float, hb << 16);
          WRF[i] = (bf16_t)(part ? f2bf(v - hf) : hb); } }
    { float* rc = (float*)(ws + WS_ROPE); float* rsn = rc + SEQ * 32;
      for (int i = blockIdx.x * 512 + F.tid; i < SEQ * 32; i += F.G * 512) { const int s = i >> 5, d = i & 31;
          const float inv = (float)rope_inv(d); const float ang = (float)positions[s] * inv; double sn, cs; sincos_d((double)fabsf(ang), sn, cs); if (ang < 0.f) sn = -sn;
          rc[i] = (float)cs; rsn[i] = (float)sn; } }
    for (int m = gw; m < MROWS; m += NGW) rms_row_to_bf16(mem + (size_t)m * D, mem_g, (bf16_t*)(ws + WS_MEMN) + (size_t)m * D, F.lane);
    for (int m = gw; m < T; m += NGW) rms_row_to_bf16(x + (size_t)m * D, mix_g, (bf16_t*)(ws + WS_R1) + (size_t)m * D, F.lane);
}
namespace att {
typedef short v4i16_t __attribute__((ext_vector_type(4)));
constexpr int LDS_V = 65536;
constexpr float NEG = -1.0e30f;
__device__ __forceinline__ int k_off(int row, int c) { return row * 128 + ((c ^ ((row >> 1) & 7)) << 4); }
__device__ __forceinline__ int v_off(int row, int c) { return LDS_V + row * 128 + ((c ^ (((row >> 1) & 3) << 1)) << 4); }

struct Grp { bf16x8 q0, q1; f32x4 o[4]; float m, l; int qsub; };

template <class PosFn>
__device__ __forceinline__ void stage_rows(LAS unsigned char* lds, const bf16_t* Kb, const bf16_t* Vb, int brow0, int hcol, int nrows, int tid, PosFn posfn) {
    for (int idx = tid; idx < nrows * 8; idx += NWAVES * 64) {
        const int j = idx >> 3, c = idx & 7; int pos = posfn(j); pos = pos < 0 ? 0 : (pos > SEQ - 1 ? SEQ - 1 : pos);
        const size_t off = (size_t)(brow0 + pos) * AW + hcol + c * 8;
        const u32x4 kv = *(const u32x4*)(Kb + off); const u32x4 vv = *(const u32x4*)(Vb + off);
        *(LAS u32x4*)(lds + k_off(j, c)) = kv; *(LAS u32x4*)(lds + v_off(j, c)) = vv;
    }
}
__device__ __forceinline__ void pair(Grp& G, LAS unsigned char* lds, int Rb, int ksub0, int L, int lane) {
    const int key = lane & 15, g = lane >> 4;
    f32x4 s[2];
#pragma unroll
    for (int t = 0; t < 2; ++t) { const int row = Rb + 16 * t + key;
        const bf16x8 k0 = *(const LAS bf16x8*)(lds + k_off(row, g)), k1 = *(const LAS bf16x8*)(lds + k_off(row, 4 + g));
        f32x4 z = (f32x4){0.f, 0.f, 0.f, 0.f};
        z = __builtin_amdgcn_mfma_f32_16x16x32_bf16(k0, G.q0, z, 0, 0, 0); s[t] = __builtin_amdgcn_mfma_f32_16x16x32_bf16(k1, G.q1, z, 0, 0, 0); }
    bool valid[2][4]; float mx = NEG;
#pragma unroll
    for (int t = 0; t < 2; ++t)
#pragma unroll
        for (int i = 0; i < 4; ++i) { const int ks = ksub0 + 16 * t + 4 * g + i;
            valid[t][i] = ((unsigned)(ks - G.qsub + 64) <= 128u) && ((unsigned)ks < (unsigned)L);
            mx = fmaxf(mx, valid[t][i] ? s[t][i] : NEG); }
    mx = fmaxf(mx, __shfl_xor(mx, 16)); mx = fmaxf(mx, __shfl_xor(mx, 32));
    const float mn = fmaxf(G.m, mx), alpha = __builtin_amdgcn_exp2f(G.m - mn);
    G.m = mn; float ps = 0.f; float p[2][4];
#pragma unroll
    for (int t = 0; t < 2; ++t)
#pragma unroll
        for (int i = 0; i < 4; ++i) { p[t][i] = valid[t][i] ? __builtin_amdgcn_exp2f(s[t][i] - mn) : 0.f; ps += p[t][i]; }
    G.l = G.l * alpha + ps;
    u32x4 pw; pw.x = cvt_pk_bf16(p[0][0], p[0][1]); pw.y = cvt_pk_bf16(p[0][2], p[0][3]); pw.z = cvt_pk_bf16(p[1][0], p[1][1]); pw.w = cvt_pk_bf16(p[1][2], p[1][3]);
    const bf16x8 pb = __builtin_bit_cast(bf16x8, pw);
    const int q = (lane >> 2) & 3, p2 = lane & 3;
#pragma unroll
    for (int db = 0; db < 4; ++db) { const int c = 2 * db + (p2 >> 1);
        const int r0 = Rb + 4 * g + q, r1 = r0 + 16;
        const s16x4 v0 = __builtin_bit_cast(s16x4, __builtin_amdgcn_ds_read_tr16_b64_v4i16((LAS v4i16_t*)(lds + v_off(r0, c) + 8 * (p2 & 1))));
        const s16x4 v1 = __builtin_bit_cast(s16x4, __builtin_amdgcn_ds_read_tr16_b64_v4i16((LAS v4i16_t*)(lds + v_off(r1, c) + 8 * (p2 & 1))));
        const bf16x8 vf = (bf16x8){v0[0], v0[1], v0[2], v0[3], v1[0], v1[1], v1[2], v1[3]};
        G.o[db] = __builtin_amdgcn_mfma_f32_16x16x32_bf16(vf, pb, G.o[db] * alpha, 0, 0, 0); }
}
__device__ __forceinline__ void grp_init(Grp& G, const bf16_t* Qb, int brow0, int hcol, int c0, int r, int lane) {
    const int a = lane & 15, g = lane >> 4; const bf16_t* qp = Qb + (size_t)(brow0 + c0 + r + 16 * a) * AW + hcol + 8 * g;
    G.q0 = *(const bf16x8*)qp; G.q1 = *(const bf16x8*)(qp + 32);
#pragma unroll
    for (int d = 0; d < 4; ++d) G.o[d] = (f32x4){0.f, 0.f, 0.f, 0.f};
    G.m = NEG; G.l = 0.f; G.qsub = 0;
}
__device__ __forceinline__ void grp_finish(Grp& G, bf16_t* MIX, float* ssqa, int brow0, int h, int c0, int r, int lane) {
    const int a = lane & 15, g = lane >> 4; float l = G.l; l += __shfl_xor(l, 16); l += __shfl_xor(l, 32);
    const float inv = 1.0f / l; const size_t tok = (size_t)(brow0 + c0 + r + 16 * a); float ss = 0.f;
#pragma unroll
    for (int db = 0; db < 4; ++db) { const f32x4 o = G.o[db] * inv; ss += (o[0] * o[0] + o[1] * o[1]) + (o[2] * o[2] + o[3] * o[3]);
        u32x2 w; w.x = cvt_pk_bf16(o[0], o[1]); w.y = cvt_pk_bf16(o[2], o[3]); *(u32x2*)(MIX + tok * D + h * HD + 16 * db + 4 * g) = w; }
    ss += __shfl_xor(ss, 16); ss += __shfl_xor(ss, 32);
    if (g == 0) ssqa[tok * NH + h] = ss;
}
#define ATT_SYNC() do { asm volatile("s_waitcnt vmcnt(0) lgkmcnt(0)" ::: "memory"); __builtin_amdgcn_s_barrier(); asm volatile("" ::: "memory"); } while (0)
__device__ __forceinline__ void attn_unit(LAS unsigned char* lds, const bf16_t* Qb, const bf16_t* Kb, const bf16_t* Vb, bf16_t* MIX, float* ssqa, int b, int h, int c0, int tid, int wave, int lane) {
    const int brow0 = b * SEQ, hcol = h * HD, a = lane & 15;
    Grp G0, G1;
    grp_init(G0, Qb, brow0, hcol, c0, wave, lane); grp_init(G1, Qb, brow0, hcol, c0, wave + 8, lane);
    ATT_SYNC();
    stage_rows(lds, Kb, Vb, brow0, hcol, 384, tid, [&](int j) { return c0 - 64 + j; });
    ATT_SYNC();
    G0.qsub = c0 + wave + 16 * a; G1.qsub = c0 + wave + 8 + 16 * a;
    for (int p = 0; p < 12; ++p) { pair(G0, lds, 32 * p, c0 - 64 + 32 * p, SEQ, lane); pair(G1, lds, 32 * p, c0 - 64 + 32 * p, SEQ, lane); }
    G0.qsub = (c0 >> 2) + (wave >> 2) + 4 * a; G1.qsub = (c0 >> 2) + ((wave + 8) >> 2) + 4 * a;
    for (int st = 0; st < 2; ++st) {
        ATT_SYNC();
        stage_rows(lds, Kb, Vb, brow0, hcol, 384, tid, [&](int j) { const int c = j / 96, jj = j - 96 * c; return 4 * ((c0 >> 2) - 64 + 96 * st + jj) + c; });
        ATT_SYNC();
        const int c = wave & 3;
        for (int p = 0; p < 3; ++p) { const int Rb = 96 * c + 32 * p, ks = (c0 >> 2) - 64 + 96 * st + 32 * p; pair(G0, lds, Rb, ks, SEQ / 4, lane); pair(G1, lds, Rb, ks, SEQ / 4, lane); }
    }
    G0.qsub = (c0 >> 4) + a; G1.qsub = (c0 >> 4) + a;
    for (int st = 0; st < 5; ++st) {
        ATT_SYNC();
        stage_rows(lds, Kb, Vb, brow0, hcol, 512, tid, [&](int j) { const int r = j >> 5, jj = j & 31; return 16 * ((c0 >> 4) - 64 + 32 * st + jj) + r; });
        ATT_SYNC();
        const int ks = (c0 >> 4) - 64 + 32 * st;
        pair(G0, lds, 32 * wave, ks, SEQ / 16, lane); pair(G1, lds, 32 * (wave + 8), ks, SEQ / 16, lane);
    }
    grp_finish(G0, MIX, ssqa, brow0, h, c0, wave, lane); grp_finish(G1, MIX, ssqa, brow0, h, c0, wave + 8, lane);
}
__device__ __forceinline__ void conv_unit(LAS unsigned char* lds, const bf16_t* Cb, bf16_t* MIX, const float* dw_w, const float* dw_b, const float* ln_g, const float* ln_b, const float* out_g,
                                          int b, int s0, int tid, int wave, int lane) {
    LAS bf16_t* CT = (LAS bf16_t*)lds;
    LAS float* CO = (LAS float*)(lds + 49152);
    ATT_SYNC();
    for (int p = tid; p < 94 * 32; p += NWAVES * 64) { const int row = p >> 5, c = p & 31, s = s0 - 15 + row;
        u32x4 v = (u32x4){0u, 0u, 0u, 0u};
        if (s >= 0 && s < SEQ) v = *(const u32x4*)(Cb + (size_t)(b * SEQ + s) * CCH + c * 8);
        *(LAS u32x4*)(CT + row * CCH + c * 8) = v; }
    ATT_SYNC();
    { const int ch = tid & 255, half = tid >> 8; float v[62], w[CONVK];
#pragma unroll
      for (int k = 0; k < CONVK; ++k) w[k] = dw_w[k * CCH + ch];
#pragma unroll
      for (int i = 0; i < 62; ++i) v[i] = bf2f(CT[(32 * half + i) * CCH + ch]);
      const float bias = dw_b[ch];
#pragma unroll
      for (int p = 0; p < 32; ++p) { float acc = bias;
#pragma unroll
          for (int k = 0; k < CONVK; ++k) acc += v[p + k] * w[k];
          CO[(32 * half + p) * CCH + ch] = acc; } }
    ATT_SYNC();
    { const f32x4 g4 = *((const f32x4*)ln_g + lane), b4 = *((const f32x4*)ln_b + lane), og = *((const f32x4*)out_g + lane);
#pragma unroll
      for (int pp = 0; pp < 8; ++pp) { const int p = wave * 8 + pp; const f32x4 xv = *(const LAS f32x4*)(CO + p * CCH + 4 * lane);
          const float mean = wave_sum((xv[0] + xv[1]) + (xv[2] + xv[3])) * (1.f / CCH); const f32x4 dx = xv - mean;
          const float var = wave_sum((dx[0] * dx[0] + dx[1] * dx[1]) + (dx[2] * dx[2] + dx[3] * dx[3])) * (1.f / CCH); const float rstd = 1.0f / sqrtf(var + LN_EPS);
          f32x4 z;
#pragma unroll
          for (int i = 0; i < 4; ++i) { const float y = dx[i] * rstd * g4[i] + b4[i]; z[i] = y / (1.f + __expf(-y)); }
          const float ms = wave_sum((z[0] * z[0] + z[1] * z[1]) + (z[2] * z[2] + z[3] * z[3])) * (1.f / CCH); const float rs = 1.0f / sqrtf(ms + NORM_EPS);
          u32x2 o; o.x = cvt_pk_bf16(z[0] * rs * og[0], z[1] * rs * og[1]); o.y = cvt_pk_bf16(z[2] * rs * og[2], z[3] * rs * og[3]);
          *(u32x2*)(MIX + (size_t)(b * SEQ + s0 + p) * D + AW + 4 * lane) = o; } }
}
}
namespace moe {
#define MOE_SYNC() do { asm volatile("s_waitcnt vmcnt(0) lgkmcnt(0)" ::: "memory"); __builtin_amdgcn_s_barrier(); asm volatile("" ::: "memory"); } while (0)
__device__ __forceinline__ void split_hi_lo(const f32x4& a, const f32x4& b, bf16x8& hi, bf16x8& lo) {
    u32x4 h, l; float r[8];
    h.x = cvt_pk_bf16(a[0], a[1]); h.y = cvt_pk_bf16(a[2], a[3]); h.z = cvt_pk_bf16(b[0], b[1]); h.w = cvt_pk_bf16(b[2], b[3]);
    r[0] = a[0] - bflo(h.x); r[1] = a[1] - bfhi(h.x); r[2] = a[2] - bflo(h.y); r[3] = a[3] - bfhi(h.y);
    r[4] = b[0] - bflo(h.z); r[5] = b[1] - bfhi(h.z); r[6] = b[2] - bflo(h.w); r[7] = b[3] - bfhi(h.w);
    l.x = cvt_pk_bf16(r[0], r[1]); l.y = cvt_pk_bf16(r[2], r[3]); l.z = cvt_pk_bf16(r[4], r[5]); l.w = cvt_pk_bf16(r[6], r[7]);
    hi = __builtin_bit_cast(bf16x8, h); lo = __builtin_bit_cast(bf16x8, l);
}
__device__ __forceinline__ void route_chunk(LAS unsigned char* lds, const float* x2, const float* ssq2, const bf16_t* WRF, const float* b_router, const float* b_group,
                                            int* tok_e, float* tok_gate, float* tok_rs, int* hist, int chunk, int tid, int wave, int lane) {
    LAS unsigned char* WB = lds;
    LAS float* LG = (LAS float*)(lds + 49152);
    LAS int* HS = (LAS int*)(lds + 49152 + 36864);
    const int tk = lane & 15, g = lane >> 4;
    f32x4 acc[2][3];
#pragma unroll
    for (int gi = 0; gi < 2; ++gi)
#pragma unroll
        for (int nt = 0; nt < 3; ++nt) acc[gi][nt] = (f32x4){0.f, 0.f, 0.f, 0.f};
    if (tid < 32) HS[tid] = 0;
    const float* xb = x2 + (size_t)(chunk * 256 + wave * 32 + tk) * D + 8 * g;
#pragma nounroll
    for (int kc = 0; kc < 4; ++kc) {
        MOE_SYNC();
#pragma unroll
        for (int i = 0; i < 6; ++i) { const int p = tid + 512 * i; *(LAS u32x4*)(WB + p * 16) = *(const u32x4*)((const char*)WRF + (size_t)kc * 49152 + p * 16); }
        MOE_SYNC();
#pragma unroll
        for (int gi = 0; gi < 2; ++gi) {
            f32x4 xa[8], xc[8];
#pragma unroll
            for (int s = 0; s < 8; ++s) { const float* xp = xb + (size_t)gi * 16 * D + kc * 256 + s * 32; xa[s] = *(const f32x4*)xp; xc[s] = *(const f32x4*)(xp + 4); }
#pragma unroll
            for (int s = 0; s < 8; ++s) { bf16x8 ah, al; split_hi_lo(xa[s], xc[s], ah, al);
#pragma unroll
                for (int nt = 0; nt < 3; ++nt) { const LAS unsigned char* bp = WB + ((s * 3 + nt) * 2) * 1024 + lane * 16;
                    const bf16x8 bh = *(const LAS bf16x8*)bp, bl = *(const LAS bf16x8*)(bp + 1024);
                    acc[gi][nt] = __builtin_amdgcn_mfma_f32_16x16x32_bf16(ah, bh, acc[gi][nt], 0, 0, 0);
                    acc[gi][nt] = __builtin_amdgcn_mfma_f32_16x16x32_bf16(ah, bl, acc[gi][nt], 0, 0, 0);
                    acc[gi][nt] = __builtin_amdgcn_mfma_f32_16x16x32_bf16(al, bh, acc[gi][nt], 0, 0, 0); } }
        }
    }
#pragma unroll
    for (int gi = 0; gi < 2; ++gi)
#pragma unroll
        for (int nt = 0; nt < 3; ++nt) { const int o = 16 * nt + tk;
            if (o < 36) {
#pragma unroll
                for (int r = 0; r < 4; ++r) LG[(wave * 32 + gi * 16 + 4 * g + r) * 36 + o] = acc[gi][nt][r]; } }
    MOE_SYNC();
    if (wave < 4) { const int tr = wave * 64 + lane, tg = chunk * 256 + tr; const LAS float* lg = LG + tr * 36;
        const f32x4* sp = (const f32x4*)(ssq2 + (size_t)tg * 16); const f32x4 st = (sp[0] + sp[1]) + (sp[2] + sp[3]);
        const float rs = 1.0f / sqrtf(((st[0] + st[1]) + (st[2] + st[3])) * (1.f / D) + NORM_EPS);
        tok_rs[tg] = rs;
        float gl[4];
#pragma unroll
        for (int j = 0; j < 4; ++j) gl[j] = lg[32 + j] * rs + b_group[j];
        float gm = gl[0]; int gi = 0;
#pragma unroll
        for (int j = 1; j < 4; ++j) { if (gl[j] > gm) { gm = gl[j]; gi = j; } }
        float den = 0.f;
#pragma unroll
        for (int j = 0; j < 4; ++j) den += __expf(gl[j] - gm);
        const float gp = 1.0f / den;
        float v0 = -3.0e38f, v1 = -3.0e38f; int i0 = 0, i1 = 0;
#pragma unroll
        for (int j = 0; j < 8; ++j) { const float v = lg[gi * 8 + j] * rs + b_router[gi * 8 + j];
            if (v > v0) { v1 = v0; i1 = i0; v0 = v; i0 = j; } else if (v > v1) { v1 = v; i1 = j; } }
        const float dd = __expf(v1 - v0), g0 = gp / (1.f + dd), g1 = gp * dd / (1.f + dd);
        const int e0 = gi * 8 + i0, e1 = gi * 8 + i1;
        __hip_atomic_fetch_add(HS + e0, 1, __ATOMIC_RELAXED, __HIP_MEMORY_SCOPE_WORKGROUP); __hip_atomic_fetch_add(HS + e1, 1, __ATOMIC_RELAXED, __HIP_MEMORY_SCOPE_WORKGROUP);
        tok_e[tg] = e0 | (e1 << 8); tok_gate[2 * tg] = g0; tok_gate[2 * tg + 1] = g1; }
    MOE_SYNC();
    if (tid < 32) hist[chunk * 32 + tid] = HS[tid];
}
__device__ __forceinline__ void slot_chunk(LAS unsigned char* lds, const int* hist, const int* tok_e, const float* tok_gate, const float* tok_rs, int* tok_slot, int* row_tok, float* slot_rs, float* slot_gate, int* etile,
                                           int chunk, int tid, int wave, int lane) {
    LAS int* CNT = (LAS int*)lds; LAS int* BASE = CNT + 32; LAS int* PST = CNT + 64; LAS int* WC = CNT + 128;
    MOE_SYNC();
    if (tid < 32) { int tot = 0, bs = 0; for (int cc = 0; cc < 256; ++cc) { const int hh = hist[cc * 32 + tid]; bs += (cc < chunk) ? hh : 0; tot += hh; } CNT[tid] = tot; BASE[tid] = bs; }
    MOE_SYNC();
    if (tid == 0) { int ps = 0; for (int e = 0; e < 32; ++e) { PST[e] = ps; ps += ((CNT[e] + 255) >> 8) << 8; } PST[32] = ps; }
    MOE_SYNC();
    int ek[2] = {0, 0}, rank[2] = {0, 0}; const int t = chunk * 256 + (wave & 3) * 64 + lane;
    if (wave < 4) { const int ev = tok_e[t]; ek[0] = ev & 255; ek[1] = ev >> 8;
#pragma unroll
        for (int k = 0; k < 2; ++k)
#pragma nounroll
            for (int e = 0; e < 32; ++e) { const unsigned long long m = __ballot(ek[k] == e);
                if (ek[k] == e) rank[k] = __popcll(m & ((1ull << lane) - 1ull));
                if (lane == 0) WC[(k * 4 + wave) * 32 + e] = __popcll(m); } }
    MOE_SYNC();
    if (wave < 4) {
#pragma unroll
        for (int k = 0; k < 2; ++k) { int off = 0;
            for (int kw = 0; kw < k * 4 + wave; ++kw) off += WC[kw * 32 + ek[k]];
            const int slot = PST[ek[k]] + BASE[ek[k]] + off + rank[k];
            row_tok[slot] = t; slot_rs[slot] = tok_rs[t]; slot_gate[slot] = tok_gate[2 * t + k]; tok_slot[2 * t + k] = slot; } }
    if (chunk < 32) { const int e = chunk, c0 = PST[e] + CNT[e], n = PST[e + 1] - c0;
        for (int i = tid; i < n; i += NWAVES * 64) { row_tok[c0 + i] = 0; slot_rs[c0 + i] = 0.f; slot_gate[c0 + i] = 0.f; } }
    if (chunk == 0 && tid <= 32) etile[tid] = PST[tid] >> 8;
}
__device__ __forceinline__ void final_row(float* xo, const bf16_t* Y, const int* tok_slot, const float* g, int t, int lane) {
    const int s0 = tok_slot[2 * t], s1 = tok_slot[2 * t + 1];
    f32x4* xr = (f32x4*)(xo + (size_t)t * D) + lane; const u32x2* y0 = (const u32x2*)(Y + (size_t)s0 * D) + lane; const u32x2* y1 = (const u32x2*)(Y + (size_t)s1 * D) + lane;
    const f32x4* gr = (const f32x4*)g + lane;
    f32x4 v[4]; float s = 0.f;
#pragma unroll
    for (int j = 0; j < 4; ++j) { const f32x4 x = xr[64 * j]; const u32x2 a = y0[64 * j], b = y1[64 * j];
        v[j][0] = x[0] + (bflo(a.x) + bflo(b.x)); v[j][1] = x[1] + (bfhi(a.x) + bfhi(b.x)); v[j][2] = x[2] + (bflo(a.y) + bflo(b.y)); v[j][3] = x[3] + (bfhi(a.y) + bfhi(b.y));
        s += (v[j][0] * v[j][0] + v[j][1] * v[j][1]) + (v[j][2] * v[j][2] + v[j][3] * v[j][3]); }
    const float rs = 1.0f / sqrtf(wave_sum(s) * (1.f / D) + NORM_EPS);
#pragma unroll
    for (int j = 0; j < 4; ++j) xr[64 * j] = v[j] * rs * gr[64 * j];
}
}
#ifndef MK_N_LAUNCHES
#define MK_N_LAUNCHES 1
#endif
constexpr int NPH = 13;
constexpr int N_LAUNCHES = MK_N_LAUNCHES;

#define ARG_IN(k) karg_ptr(8 * (k))
#define ARG_OUT ((float*)karg_ptr(8 * 27))
#define ARG_WS ((unsigned char*)karg_ptr(8 * 28))
template <int LO, int HI>
__global__ void __launch_bounds__(NWAVES * 64, 2) mega_fwd(Args args) {
    extern __shared__ __attribute__((aligned(16))) unsigned char lds_raw[];
    Frame F;
    F.lds = (LAS unsigned char*)lds_raw;
    F.MISC = (volatile LAS unsigned*)(F.lds + LDSCTL_OFF);
    F.tid = threadIdx.x; F.lane = F.tid & 63; F.wave = __builtin_amdgcn_readfirstlane(F.tid >> 6);
    F.G = gridDim.x; { const int bx = blockIdx.x; F.vcu = (F.G % 8 == 0) ? (bx % 8) * (F.G / 8) + bx / 8 : bx; }
    F.ws = ARG_WS; F.ctl = (unsigned*)(ARG_WS + WS_CTL);
    for (int u = F.tid; u < (LDS_BYTES - LDSCTL_OFF) / 4; u += NWAVES * 64) ((LAS unsigned*)(F.lds + LDSCTL_OFF))[u] = 0u;
    __syncthreads();
    XcdBarrier bar; bar.bar = F.ctl + CW_BAR; bar.x = 0; bar.st = nullptr;
    if (HI - LO > 1) bar = xcd_barrier_post(F.ctl + CW_BAR, F.MISC + 8);
#define GRID_BAR() do { if (HI - LO > 1) xcd_barrier(bar); } while (0)
#ifndef PH_MASK
#define PH_MASK 0x1fff
#endif
#define IN(k) ((((PH_MASK) >> (k)) & 1) && LO <= (k) && (k) < HI)
#define BOTH(k) (IN(k) && IN((k) + 1))
#ifndef DUP_PHASE
#define DUP_PHASE -1
#endif
#define DUPF(k) ((k) == DUP_PHASE ? 2 : 1)
    const int gw = F.vcu * NWAVES + F.wave, NGW = F.G * NWAVES;
#define R1 ((bf16_t*)(ARG_WS + WS_R1))
#define R2 ((bf16_t*)(ARG_WS + WS_R2))
#define ssqa ((float*)(ARG_WS + WS_SSQA))
#define ssq1 ((float*)(ARG_WS + WS_SSQ1))
#define ssq2 ((float*)(ARG_WS + WS_SSQ2))
#define tok_e ((int*)(ARG_WS + WS_TOK + TK_E))
#define tok_gate ((float*)(ARG_WS + WS_TOK + TK_GATE))
#define tok_slot ((int*)(ARG_WS + WS_TOK + TK_SLOT))
#define tok_rs ((float*)(ARG_WS + WS_TOK + TK_RS))
#define row_tok ((int*)(ARG_WS + WS_TOK + TK_ROWTOK))
#define slot_rs ((float*)(ARG_WS + WS_TOK + TK_SLOTRS))
#define slot_gate ((float*)(ARG_WS + WS_TOK + TK_SLOTGATE))
#define hist ((int*)(ARG_WS + WS_HIST))
#define etile ((int*)(ARG_WS + WS_HIST + HIST_ETILE))
#define WR ((const bf16_t*)(ARG_WS + WS_HIST + HIST_WR))

    if (IN(0)) { p0_prologue(F); if (BOTH(0)) GRID_BAR(); }

    if (IN(1)) {
        { pg8::GridOrder S; S.init(R1, ARG_WS + WS_WIN, D, D, T, INW, F.G, (int)blockIdx.x); S.dup = DUPF(1);
          pg8::EpiU E{R2, (bf16_t*)(ARG_WS + WS_Q), (bf16_t*)(ARG_WS + WS_K), (bf16_t*)(ARG_WS + WS_V), (const float*)(ARG_WS + WS_ROPE), (const float*)(ARG_WS + WS_ROPE) + SEQ * 32};
          pg8::gemm_phase<pg8::EpiU, pg8::GridOrder, true, false>(F.lds, D, D, D, S, E); }
        { pg8::KvOrder S{(const char*)(ARG_WS + WS_MEMN), (const char*)(ARG_WS + WS_WXK), (const char*)(ARG_WS + WS_WXV), F.G, (int)blockIdx.x};
          pg8::EpiPlain<false> E{(bf16_t*)(ARG_WS + WS_KX), D, (bf16_t*)(ARG_WS + WS_VXT), MROWS, nullptr};
          pg8::gemm_phase<pg8::EpiPlain<false>, pg8::KvOrder, true, false>(F.lds, D, D, D, S, E); }
        if (BOTH(1)) GRID_BAR();
    }

    if (IN(2)) {
        for (int L0 = F.vcu; L0 < NB * NH * 16 * DUPF(2); L0 += F.G) { const int L = L0 % (NB * NH * 16); const int chunk = L & 15, bh = L >> 4, b = bh / NH, h = bh % NH;
            att::attn_unit(F.lds, (const bf16_t*)(ARG_WS + WS_Q), (const bf16_t*)(ARG_WS + WS_K), (const bf16_t*)(ARG_WS + WS_V), R1, ssqa, b, h, chunk * 256, F.tid, F.wave, F.lane); }
        for (int L = F.vcu; L < NB * 64; L += F.G) { const int b = L >> 6, j = L & 63;
            att::conv_unit(F.lds, R2, R1, (const float*)ARG_IN(5), (const float*)ARG_IN(6), (const float*)ARG_IN(7), (const float*)ARG_IN(8), (const float*)ARG_IN(9), b, j * 64, F.tid, F.wave, F.lane); }
        asm volatile("s_waitcnt vmcnt(0) lgkmcnt(0)" ::: "memory"); __syncthreads();
        if (BOTH(2)) GRID_BAR();
    }

    if (IN(3)) {
        pg8::GridOrder S; S.init(R1, ARG_WS + WS_WOUT, D, D, T, D, F.G, (int)blockIdx.x); S.dup = DUPF(3);
        pg8::EpiResid<true> E{(const float*)ARG_IN(0), ARG_OUT, R2, ssq1, ssqa};
        pg8::gemm_phase<pg8::EpiResid<true>, pg8::GridOrder, true, false>(F.lds, D, D, D, S, E);
        if (BOTH(3)) GRID_BAR();
    }

    if (IN(4)) {
        pg8::GridOrder S; S.init(R2, ARG_WS + WS_WXQ, D, D, T, D, F.G, (int)blockIdx.x); S.dup = DUPF(4);
        pg8::EpiPlain<true> E{(bf16_t*)(ARG_WS + WS_XQ), D, nullptr, 0, ssq1};
        pg8::gemm_phase<pg8::EpiPlain<true>, pg8::GridOrder, true, false>(F.lds, D, D, D, S, E);
        if (BOTH(4)) GRID_BAR();
    }

    if (IN(5)) {
        pg8::XaOrder<0> S{(const char*)(ARG_WS + WS_XQ), (const char*)(ARG_WS + WS_KX), F.G, F.vcu};
        pg8::EpiSoftmax E{(bf16_t*)(ARG_WS + WS_PM)};
        pg8::gemm_phase<pg8::EpiSoftmax, pg8::XaOrder<0>, true, false>(F.lds, D, D, XHD, S, E);
        if (BOTH(5)) GRID_BAR();
    }

    if (IN(6)) {
        pg8::XaOrder<1> S{(const char*)(ARG_WS + WS_PM), (const char*)(ARG_WS + WS_VXT), F.G, F.vcu};
        pg8::EpiPlain<false> E{R1, D, nullptr, 0, nullptr};
        pg8::gemm_phase<pg8::EpiPlain<false>, pg8::XaOrder<1>, true, false>(F.lds, D, MROWS, MEML, S, E);
        if (BOTH(6)) GRID_BAR();
    }

    if (IN(7)) {
        pg8::GridOrder S; S.init(R1, ARG_WS + WS_WXO, D, D, T, D, F.G, (int)blockIdx.x);
        pg8::EpiResid<false> E{ARG_OUT, ARG_OUT, R2, ssq2, nullptr};
        pg8::gemm_phase<pg8::EpiResid<false>, pg8::GridOrder, true, false>(F.lds, D, D, D, S, E);
        if (BOTH(7)) GRID_BAR();
    }

    if (IN(8)) {
        for (int c0_ = blockIdx.x; c0_ < (T / 256) * DUPF(8); c0_ += F.G) { const int c = c0_ % (T / 256);
            moe::route_chunk(F.lds, ARG_OUT, ssq2, WR, (const float*)ARG_IN(22), (const float*)ARG_IN(20), tok_e, tok_gate, tok_rs, hist, c, F.tid, F.wave, F.lane); }
        asm volatile("s_waitcnt vmcnt(0) lgkmcnt(0)" ::: "memory"); __syncthreads();
        if (BOTH(8)) GRID_BAR();
    }

    if (IN(9)) {
        for (int c = blockIdx.x; c < T / 256; c += F.G)
            moe::slot_chunk(F.lds, hist, tok_e, tok_gate, tok_rs, tok_slot, row_tok, slot_rs, slot_gate, etile, c, F.tid, F.wave, F.lane);
        asm volatile("s_waitcnt vmcnt(0) lgkmcnt(0)" ::: "memory"); __syncthreads();
        if (BOTH(9)) GRID_BAR();
    }

    if (IN(10)) {
        pg8::MoeOrder<0> S{(const char*)R2, (const char*)(ARG_WS + WS_W13), row_tok, etile, F.G, (int)blockIdx.x, DUPF(10)};
        pg8::EpiMoe1 E{(bf16_t*)(ARG_WS + WS_HID), slot_rs};
        pg8::gemm_phase<pg8::EpiMoe1, pg8::MoeOrder<0>, true, true>(F.lds, D, D, D, S, E);
        if (BOTH(10)) GRID_BAR();
    }

    if (IN(11)) {
        pg8::MoeOrder<1> S{(const char*)(ARG_WS + WS_HID), (const char*)(ARG_WS + WS_W2), row_tok, etile, F.G, (int)blockIdx.x, DUPF(11)};
        pg8::EpiMoe2 E{(bf16_t*)(ARG_WS + WS_Y), slot_gate};
        pg8::gemm_phase<pg8::EpiMoe2, pg8::MoeOrder<1>, true, false>(F.lds, FF, FF, FF, S, E);
        if (BOTH(11)) GRID_BAR();
    }

    if (IN(12)) {
        for (int t = gw; t < T; t += NGW) moe::final_row(ARG_OUT, (const bf16_t*)(ARG_WS + WS_Y), tok_slot, (const float*)ARG_IN(26), t, F.lane);
    }
#undef IN
#undef BOTH
}

typedef void (*kern_t)(Args);
template <int... I> struct PhList {};
extern "C" void kernel_launch(void* const* d_in, const int* in_sizes, int n_in, void* d_out, int out_size, void* d_ws, size_t ws_size, hipStream_t stream) {
    static int grid = 0;
#if MK_N_LAUNCHES == 1
    static const kern_t kerns[1] = {mega_fwd<0, NPH>};
#else
    static const kern_t kerns[NPH] = {mega_fwd<0, 1>, mega_fwd<1, 2>, mega_fwd<2, 3>, mega_fwd<3, 4>, mega_fwd<4, 5>, mega_fwd<5, 6>, mega_fwd<6, 7>, mega_fwd<7, 8>, mega_fwd<8, 9>, mega_fwd<9, 10>, mega_fwd<10, 11>, mega_fwd<11, 12>, mega_fwd<12, 13>};
#endif
    if (grid == 0) {
        if (n_in != 27 || in_sizes[0] != T * D || out_size != T * D || ws_size < WS_END) { fprintf(stderr, "kernel_launch: unexpected problem: n_in %d in0 %d out %d ARG_WS %zu (need %zu)\n", n_in, n_in > 0 ? in_sizes[0] : -1, out_size, ws_size, (size_t)WS_END); grid = -1; return; }
        int dev = 0, cus = 0, per_cu = 0;
        if (hipGetDevice(&dev) != hipSuccess || hipDeviceGetAttribute(&cus, hipDeviceAttributeMultiprocessorCount, dev) != hipSuccess) { grid = -1; return; }
        for (int li = 0; li < N_LAUNCHES; ++li)
            if (hipFuncSetAttribute((const void*)kerns[li], hipFuncAttributeMaxDynamicSharedMemorySize, LDS_BYTES) != hipSuccess) { fprintf(stderr, "kernel_launch: hipFuncSetAttribute failed\n"); grid = -1; return; }
        if (hipOccupancyMaxActiveBlocksPerMultiprocessor(&per_cu, (const void*)kerns[0], NWAVES * 64, LDS_BYTES) != hipSuccess || per_cu < 1) { fprintf(stderr, "kernel_launch: occupancy query says %d\n", per_cu); }
        (void)hipGetLastError();
        grid = cus;
    }
    if (grid < 0) return;
    if (hipMemsetAsync((char*)d_ws + WS_CTL, 0, CTL_ZERO_BYTES, stream) != hipSuccess) return;
    Args a{};
    for (int i = 0; i < 27; ++i) a.in[i] = d_in[i];
    a.out = (float*)d_out; a.ws = (unsigned char*)d_ws;
    for (int li = 0; li < N_LAUNCHES; ++li) {
        a.ph_lo = 0; a.ph_hi = 0; a.li = li; a.pad = 0;
        hipLaunchKernelGGL(kerns[li], dim3(grid), dim3(NWAVES * 64), LDS_BYTES, stream, a);
        const hipError_t le = hipPeekAtLastError();
        if (le != hipSuccess) { fprintf(stderr, "kernel_launch: launch %d failed: %s\n", li, hipGetErrorName(le)); break; }
    }
}
```

```cpp
#include <hip/hip_runtime.h>
#include <cstdio>
#include <cstdint>

#define GAS __attribute__((address_space(1)))
#define LAS __attribute__((address_space(3)))
typedef unsigned short bf16_t;
typedef short bf16x8 __attribute__((ext_vector_type(8)));
typedef short s16x4 __attribute__((ext_vector_type(4)));
typedef float f32x4 __attribute__((ext_vector_type(4)));
typedef float f32x2 __attribute__((ext_vector_type(2)));
typedef unsigned u32x4 __attribute__((ext_vector_type(4)));
typedef unsigned u32x2 __attribute__((ext_vector_type(2)));

constexpr int NB = 16, SEQ = 4096, T = NB * SEQ, D = 1024;
constexpr int CCH = 256, NH = 12, HD = 64, AW = NH * HD, INW = 2 * CCH + 3 * AW;
constexpr int MEML = 256, MROWS = NB * MEML, XH = 4, XHD = 256;
constexpr int NE = 32, EPG = 8, NG = 4, FF = 512;
constexpr int CONVK = 31;
constexpr int A_PAD = T * 2 + NE * 256;
constexpr float NORM_EPS = 1e-6f, LN_EPS = 1e-5f;
constexpr float LOG2E = 1.4426950408889634f;

constexpr size_t MiB = 1u << 20;
constexpr size_t WS_CTL = 0, CTL_ZERO_BYTES = 1 * MiB;
constexpr size_t WS_ROPE = 1 * MiB;
constexpr size_t WS_HIST = 2 * MiB;
constexpr size_t WS_SSQA = 4 * MiB;
constexpr size_t WS_SSQ1 = 8 * MiB;
constexpr size_t WS_SSQ2 = 12 * MiB;
constexpr size_t WS_WIN = 16 * MiB, WS_WOUT = 22 * MiB, WS_WXQ = 24 * MiB, WS_WXK = 26 * MiB, WS_WXV = 28 * MiB, WS_WXO = 30 * MiB;
constexpr size_t WS_W13 = 32 * MiB, WS_W2 = 96 * MiB;
constexpr size_t WS_MEMN = 128 * MiB, WS_KX = 136 * MiB, WS_VXT = 144 * MiB;
constexpr size_t WS_TOK = 152 * MiB;
constexpr size_t WS_R1 = 160 * MiB;
constexpr size_t WS_R2 = 288 * MiB;
constexpr size_t WS_Q = 320 * MiB, WS_K = 416 * MiB, WS_V = 512 * MiB;
constexpr size_t WS_XQ = 416 * MiB;
constexpr size_t WS_PM = 544 * MiB;
constexpr size_t WS_HID = 416 * MiB;
constexpr size_t WS_Y = 552 * MiB;
constexpr size_t WS_END = 824 * MiB;
constexpr size_t TK_E = 0;
constexpr size_t TK_GATE = 1 * MiB;
constexpr size_t TK_SLOT = 2 * MiB;
constexpr size_t TK_RS = 3 * MiB;
constexpr size_t TK_ROWTOK = 4 * MiB;
constexpr size_t TK_SLOTRS = 5 * MiB;
constexpr size_t TK_SLOTGATE = 6 * MiB;
constexpr size_t HIST_ETILE = 64 * 1024, HIST_WR = 128 * 1024;

constexpr int CW_BAR = 4096;

constexpr int NWAVES = 8;
constexpr int RING_BYTES = 131072;
constexpr int XCH_OFF = RING_BYTES;
constexpr int LDSCTL_OFF = RING_BYTES + 12288;
constexpr int LDS_BYTES = 147456;

#define LDS_WAIT() asm volatile("s_waitcnt lgkmcnt(0)" ::: "memory")
#define VM_WAIT() asm volatile("s_waitcnt vmcnt(0)" ::: "memory")
__device__ __forceinline__ unsigned f2bf(float f) { unsigned u = __builtin_bit_cast(unsigned, f); return (u + 0x7fffu + ((u >> 16) & 1u)) >> 16; }
__device__ __forceinline__ unsigned pk2(float lo, float hi) { return f2bf(lo) | (f2bf(hi) << 16); }
__device__ __forceinline__ float bf2f(unsigned short b) { return __builtin_bit_cast(float, (unsigned)b << 16); }
__device__ __forceinline__ float bflo(unsigned w) { return __builtin_bit_cast(float, w << 16); }
__device__ __forceinline__ float bfhi(unsigned w) { return __builtin_bit_cast(float, w & 0xffff0000u); }
__device__ __forceinline__ unsigned cvt_pk_bf16(float lo, float hi) { unsigned r; asm volatile("v_cvt_pk_bf16_f32 %0, %1, %2" : "=v"(r) : "v"(lo), "v"(hi)); return r; }
__device__ __forceinline__ float wave_sum(float v) {
#pragma unroll
    for (int o = 1; o < 64; o <<= 1) v += __shfl_xor(v, o);
    return v;
}
__device__ __forceinline__ int lane_id() { return (int)__builtin_amdgcn_mbcnt_hi(~0u, __builtin_amdgcn_mbcnt_lo(~0u, 0u)); }
#define MK_N_LAUNCHES 1
namespace pg8 {
constexpr int BM = 256, BK = 64, HALF = 128, HTB = HALF * BK * 2  , STAGE_BYTES = 8 * HTB, NXCD = 8, WGM = 8;

__host__ __device__ __forceinline__ int lds_byte(int r, int c) { const int st = (r >> 4) * 2 + (c >> 5), rr = r & 15, cc = c & 31, ob = rr * 64 + cc * 2; return st * 1024 + (ob ^ (((ob >> 9) & 1) << 5)); }
__host__ __device__ __forceinline__ void stage_rc(int b, int& R, int& C) { const int st = b / 1024, sb = b % 1024, swz = sb ^ (((sb >> 9) & 1) << 5); R = (st >> 1) * 16 + swz / 64; C = (st & 1) * 32 + (swz % 64) / 2; }
__host__ __device__ __forceinline__ int perm32(int rho) { const int n = rho >> 4, i = rho & 15; return 8 * (i >> 2) + 4 * n + (i & 3); }

struct Unit { const char* a; const char* b; const int* rows; int pm, pn, x0, x1; };

typedef f32x4 Acc[2][2][4][2];

__device__ __forceinline__ const char* uniform_ptr(const char* p) { const unsigned long long v = (unsigned long long)p;
    const unsigned lo = __builtin_amdgcn_readfirstlane((unsigned)v), hi = __builtin_amdgcn_readfirstlane((unsigned)(v >> 32)); return (const char*)(((unsigned long long)hi << 32) | lo); }
__device__ __forceinline__ void glds16_sv(const char* gbase, unsigned voff, unsigned lds_dst) { unsigned keep;
    asm volatile("s_mov_b32 %0, m0\n\ts_mov_b32 m0, %3\n\ts_nop 0\n\tglobal_load_lds_dwordx4 %1, %2\n\ts_mov_b32 m0, %0" : "=&s"(keep) : "v"(voff), "s"(gbase), "s"(lds_dst) : "memory"); }
template <class Epi, class Sched, bool ALIGN_EPI, bool GATHER>
__device__ __forceinline__ void gemm_phase(LAS unsigned char* lds, const int wave_, const int lda, const int ldb, const int K, const Sched& S, const Epi& E) {
    int lane_ = lane_id(); asm volatile("" : "+v"(lane_));
    const int wid = __builtin_amdgcn_readfirstlane(wave_), tid = wid * 64 + lane_, lane = tid & 63, wr = wid >> 2, wc = wid & 3, fr = lane & 15, fq = lane >> 4;
    const int nt = K / BK;
    int Rr[2], Cc[2];
    unsigned vA[2][2], vN[2][2], voffB[2];
#pragma unroll
    for (int i = 0; i < 2; ++i) { int R, C; stage_rc(tid * 16 + i * 8192, R, C); Rr[i] = R; Cc[i] = C; const int Rb = Epi::PERM ? ((R & ~31) + perm32(R & 31)) : R;
        voffB[i] = (unsigned)(Rb * ldb + C) * 2u; }
    const size_t kstep = (size_t)(BK * 2);
    const size_t hstepB = (size_t)HALF * ldb * 2, hstepA = (size_t)HALF * lda * 2;
    const unsigned ldsw = (unsigned)wid * 1024u, lds0 = (unsigned)(uintptr_t)lds;
    const int aoff = lds_byte(wr * 64 + fr, fq * 8), boff = lds_byte(wc * 32 + fr, fq * 8);
#define PG8_SA(b, h) (((b) * 2 + (h)) * HTB)
#define PG8_SB(b, h) ((4 + (b) * 2 + (h)) * HTB)
#define PG8_STAGE(bufoff, gbase, voff) do { _Pragma("unroll") for (int _i = 0; _i < 2; ++_i) glds16_sv((gbase), (voff)[_i], lds0 + (unsigned)(bufoff) + ldsw + _i * 8192u); } while (0)
#define PG8_LDA(dst, b, h) do { _Pragma("unroll") for (int m = 0; m < 4; ++m) _Pragma("unroll") for (int k = 0; k < 2; ++k) dst[m][k] = *(const LAS bf16x8*)(lds + PG8_SA(b, h) + aoff + m * 2048 + k * 1024); } while (0)
#define PG8_LDB(dst, b, h) do { _Pragma("unroll") for (int n = 0; n < 2; ++n) _Pragma("unroll") for (int k = 0; k < 2; ++k) dst[n][k] = *(const LAS bf16x8*)(lds + PG8_SB(b, h) + boff + n * 2048 + k * 1024); } while (0)
#define PG8_MMA(ai, bj, At, Bt) do { __builtin_amdgcn_s_setprio(1); _Pragma("unroll") for (int m = 0; m < 4; ++m) _Pragma("unroll") for (int n = 0; n < 2; ++n) _Pragma("unroll") for (int k = 0; k < 2; ++k) \
        acc[ai][bj][m][n] = __builtin_amdgcn_mfma_f32_16x16x32_bf16(Bt[n][k], At[m][k], acc[ai][bj][m][n], 0, 0, 0); __builtin_amdgcn_s_setprio(0); } while (0)
#define PG8_WAIT_V(n) asm volatile("s_waitcnt vmcnt(" #n ")" ::: "memory")
#define PG8_WAIT_L(n) asm volatile("s_waitcnt lgkmcnt(" #n ")" ::: "memory")
#define PG8_BAR __builtin_amdgcn_s_barrier()
#define PG8_SCHED __builtin_amdgcn_sched_barrier(0)
#define PG8_VOFF(dst, u) do { _Pragma("unroll") for (int _h = 0; _h < 2; ++_h) _Pragma("unroll") for (int _i = 0; _i < 2; ++_i) { \
        if constexpr (GATHER) dst[_h][_i] = (unsigned)(u).rows[_h * HALF + Rr[_i]] * (unsigned)(lda * 2) + (unsigned)(Cc[_i] * 2); \
        else dst[_h][_i] = (unsigned)(Rr[_i] * lda + Cc[_i]) * 2u; } } while (0)
#define PG8_STAGE_A(bufoff, gbase, h, vv) do { if constexpr (GATHER) { PG8_STAGE(bufoff, gbase, vv[h]); } else { PG8_STAGE(bufoff, (gbase) + (h) * hstepA, vv[0]); } } while (0)
    Unit cur, nxt; int ui = 0;
    if (!S.next(0, cur)) return;
    Acc acc;
#pragma unroll
    for (int a = 0; a < 2; ++a)
#pragma unroll
        for (int b = 0; b < 2; ++b)
#pragma unroll
            for (int m = 0; m < 4; ++m)
#pragma unroll
                for (int n = 0; n < 2; ++n) acc[a][b][m][n] = (f32x4){0.f, 0.f, 0.f, 0.f};
    bf16x8 At[4][2], B0[2][2], B1[2][2];
    const char* cA = uniform_ptr(cur.a); const char* cB = uniform_ptr(cur.b);
    PG8_VOFF(vA, cur);
    if constexpr (GATHER) { asm volatile("s_waitcnt vmcnt(0)" ::: "memory"); }
    PG8_STAGE(PG8_SB(0, 0), cB, voffB); PG8_STAGE(PG8_SB(0, 1), cB + hstepB, voffB); PG8_STAGE_A(PG8_SA(0, 0), cA, 0, vA); PG8_STAGE_A(PG8_SA(0, 1), cA, 1, vA);
    if (wr == 1) PG8_BAR;
    PG8_WAIT_V(2); PG8_BAR;
    PG8_STAGE(PG8_SB(1, 0), cB + kstep, voffB); PG8_STAGE_A(PG8_SA(1, 0), cA + kstep, 0, vA); PG8_STAGE(PG8_SB(1, 1), cB + hstepB + kstep, voffB);
    PG8_WAIT_V(6); PG8_BAR;
    for (;;) {
        const bool has_next = S.next(ui + 1, nxt);
        const char* nA = has_next ? uniform_ptr(nxt.a) : cA; const char* nB = has_next ? uniform_ptr(nxt.b) : cB;
        if constexpr (GATHER) { if (has_next) { PG8_VOFF(vN, nxt); } else {
#pragma unroll
            for (int h = 0; h < 2; ++h) { vN[h][0] = vA[h][0]; vN[h][1] = vA[h][1]; } } }
#pragma nounroll
        for (int t = 0; t < nt; t += 2) {
            const bool last = (t == nt - 2);
            if constexpr (Epi::HAS_MID) { if (t == E.mid_t()) E.mid(acc, cur, wr, wc, fr, fq); }
            const char* a1 = cA + (size_t)(t + 1) * kstep;
            const char* a2 = last ? nA : cA + (size_t)(t + 2) * kstep; const char* b2 = last ? nB : cB + (size_t)(t + 2) * kstep;
            const char* a3 = a2 + kstep; const char* b3 = b2 + kstep;
            unsigned vW[2][2];
#pragma unroll
            for (int h = 0; h < 2; ++h) { vW[h][0] = vA[h][0]; vW[h][1] = vA[h][1]; if constexpr (GATHER) { if (last) { vW[h][0] = vN[h][0]; vW[h][1] = vN[h][1]; } } }
            PG8_LDB(B0, 0, 0); PG8_LDB(B1, 0, 1); PG8_SCHED; PG8_LDA(At, 0, 0); PG8_STAGE_A(PG8_SA(1, 1), a1, 1, vA);
            PG8_WAIT_V(8); PG8_WAIT_L(0); PG8_BAR; PG8_MMA(0, 0, At, B0); PG8_MMA(0, 1, At, B1); PG8_BAR; PG8_SCHED;
            PG8_LDA(At, 0, 1); PG8_STAGE(PG8_SB(0, 0), b2, voffB); PG8_STAGE(PG8_SB(0, 1), b2 + hstepB, voffB); PG8_STAGE_A(PG8_SA(0, 0), a2, 0, vW);
            PG8_WAIT_V(8); PG8_WAIT_L(0); PG8_BAR; PG8_MMA(1, 0, At, B0); PG8_MMA(1, 1, At, B1); PG8_BAR; PG8_SCHED;
            PG8_LDB(B0, 1, 0); PG8_LDB(B1, 1, 1); PG8_SCHED; PG8_LDA(At, 1, 0); PG8_STAGE_A(PG8_SA(0, 1), a2, 1, vW);
            PG8_WAIT_V(8); PG8_WAIT_L(0); PG8_BAR; PG8_MMA(0, 0, At, B0); PG8_MMA(0, 1, At, B1); PG8_BAR; PG8_SCHED;
            PG8_LDA(At, 1, 1); PG8_STAGE(PG8_SB(1, 0), b3, voffB); PG8_STAGE(PG8_SB(1, 1), b3 + hstepB, voffB); PG8_STAGE_A(PG8_SA(1, 0), a3, 0, vW);
            PG8_WAIT_V(8); PG8_WAIT_L(0); PG8_BAR; PG8_MMA(1, 0, At, B0); PG8_MMA(1, 1, At, B1); PG8_BAR; PG8_SCHED;
        }
        if constexpr (ALIGN_EPI) { if (wr == 0) PG8_BAR; }
        E(acc, cur, wr, wc, fr, fq, lds, wid, lane);
        if (!has_next) break;
#pragma unroll
        for (int a = 0; a < 2; ++a)
#pragma unroll
            for (int b = 0; b < 2; ++b)
#pragma unroll
                for (int m = 0; m < 4; ++m)
#pragma unroll
                    for (int n = 0; n < 2; ++n) acc[a][b][m][n] = (f32x4){0.f, 0.f, 0.f, 0.f};
        cur = nxt; cA = nA; cB = nB; ++ui;
        if constexpr (GATHER) {
#pragma unroll
            for (int h = 0; h < 2; ++h) { vA[h][0] = vN[h][0]; vA[h][1] = vN[h][1]; } }
        if constexpr (ALIGN_EPI) { if (wr == 1) PG8_BAR; }
    }
    PG8_WAIT_V(0);
    if constexpr (!ALIGN_EPI) { if (wr == 0) PG8_BAR; }
    PG8_BAR;
#undef PG8_SA
#undef PG8_SB
#undef PG8_STAGE
#undef PG8_LDA
#undef PG8_LDB
#undef PG8_MMA
#undef PG8_WAIT_V
#undef PG8_WAIT_L
#undef PG8_BAR
#undef PG8_SCHED
#undef PG8_VOFF
#undef PG8_STAGE_A
}
}
#define XB_TMO      128
#define XB_XCNT(j)  (256  + 64 * (j))
#define XB_XSUB(j)  (1280 + 64 * (j))
#define XB_XGEN(j)  (2304 + 64 * (j))
#define XB_TOP      3328
#define XB_TOPGEN   3392
#define XCD_BAR_WORDS 3456
#define XB_SPIN_CAP (1u << 18)

__device__ __forceinline__ unsigned xb_ld(unsigned* p)              { return __hip_atomic_load(p, __ATOMIC_RELAXED, __HIP_MEMORY_SCOPE_AGENT); }
__device__ __forceinline__ unsigned xb_add(unsigned* p, unsigned v) { return __hip_atomic_fetch_add(p, v, __ATOMIC_RELAXED, __HIP_MEMORY_SCOPE_AGENT); }
__device__ __forceinline__ unsigned xb_xcc_id() { return (unsigned)__builtin_amdgcn_s_getreg((3 << 11) | 20) & 0xFu; }
#define XB_SPIN(cond, bar) do { unsigned _sp = 0; while (cond) { __builtin_amdgcn_s_sleep(1); \
    if ((++_sp & 255u) == 0u) { if (xb_ld(&(bar)[XB_TMO])) break; if (_sp > XB_SPIN_CAP) { atomicAdd(&(bar)[XB_TMO], 1u); break; } } } } while (0)

struct XcdBarrier {
    unsigned* bar; unsigned x;
    volatile LAS unsigned* st;
};

__device__ __forceinline__ XcdBarrier xcd_barrier_post(unsigned* bar, volatile LAS unsigned* st) {
    XcdBarrier b; b.bar = bar; b.x = xb_xcc_id(); b.st = st;
    if (threadIdx.x == 0) (void)xb_add(&bar[XB_XCNT(b.x)], 1u);
    return b;
}
__device__ __forceinline__ void xcd_barrier_complete(unsigned* bar, unsigned x, unsigned& nloc, unsigned& nx) {
    const unsigned G = gridDim.x * gridDim.y * gridDim.z;
    unsigned sum, cnt, mine, sp = 0u;
    for (;;) {
        sum = 0u; cnt = 0u; mine = 0u;
#pragma unroll
        for (unsigned j = 0; j < 16; ++j) { const unsigned c = xb_ld(&bar[XB_XCNT(j)]); sum += c; cnt += (c > 0u) ? 1u : 0u; mine = (j == x) ? c : mine; }
        if (sum == G) break;
        __builtin_amdgcn_s_sleep(1);
        if ((++sp & 255u) == 0u) { if (xb_ld(&bar[XB_TMO])) break; if (sp > XB_SPIN_CAP) { atomicAdd(&bar[XB_TMO], 1u); break; } }
    }
    nloc = mine > 0u ? mine : 1u; nx = cnt > 0u ? cnt : 1u;
}

__device__ __forceinline__ void xcd_barrier(const XcdBarrier& b) {
    asm volatile("s_waitcnt vmcnt(0)" ::: "memory");
    __syncthreads();
    if (threadIdx.x == 0) {
        unsigned* bar = b.bar;
        __builtin_amdgcn_s_waitcnt(0);
        unsigned nloc = b.st[0], nx = b.st[1];
        if (nloc == 0u) { xcd_barrier_complete(bar, b.x, nloc, nx); b.st[0] = nloc; b.st[1] = nx; }
        const unsigned old = xb_add(&bar[XB_XSUB(b.x)], 1u);
        const unsigned gen = old / nloc;
        if (old + 1u == (gen + 1u) * nloc) {
            __builtin_amdgcn_fence(__ATOMIC_RELEASE, "agent");
            asm volatile("s_waitcnt vmcnt(0)" ::: "memory");
            const unsigned og = xb_add(&bar[XB_TOP], 1u);
            const unsigned tg = og / nx;
            if (og + 1u == (tg + 1u) * nx) xb_add(&bar[XB_TOPGEN], 1u);
            else XB_SPIN(xb_ld(&bar[XB_TOPGEN]) == tg, bar);
            __builtin_amdgcn_fence(__ATOMIC_ACQUIRE, "agent");
            xb_add(&bar[XB_XGEN(b.x)], 1u);
            asm volatile("s_waitcnt vmcnt(0)" ::: "memory");
        } else {
            XB_SPIN(xb_ld(&bar[XB_XGEN(b.x)]) == gen, bar);
            __builtin_amdgcn_fence(__ATOMIC_ACQUIRE, "agent");
            asm volatile("s_waitcnt vmcnt(0)" ::: "memory");
        }
    }
    __syncthreads();
}

namespace pg8 {
#define EPI_NOMID static constexpr bool HAS_MID = false; __device__ __forceinline__ int mid_t() const { return -1; } __device__ __forceinline__ void mid(Acc&, const Unit&, int, int, int, int) const {}
#define RAW_BARRIER() do { asm volatile("s_waitcnt lgkmcnt(0)" ::: "memory"); __builtin_amdgcn_s_barrier(); asm volatile("" ::: "memory"); } while (0)

__device__ __forceinline__ u32x4 pack8(const f32x4& v0, const f32x4& v1) { u32x4 w; w.x = cvt_pk_bf16(v0[0], v0[1]); w.y = cvt_pk_bf16(v0[2], v0[3]); w.z = cvt_pk_bf16(v1[0], v1[1]); w.w = cvt_pk_bf16(v1[2], v1[3]); return w; }

struct GridOrder {
    const char* A; const char* Bt; int lda, ldb, nM, nN, nwg, G, c, dup;
    __device__ __forceinline__ void init(const void* A_, const void* Bt_, int lda_, int ldb_, int M, int N, int G_, int c_) { A = (const char*)A_; Bt = (const char*)Bt_; lda = lda_; ldb = ldb_; nM = M / BM; nN = N / BM; nwg = nM * nN; G = G_; c = c_; dup = 1; }
    __device__ __forceinline__ bool next(int i, Unit& u) const {
        const long L = (long)i * G + c; if (L >= (long)nwg * dup) return false;
        int wgid = (int)(L % nwg); { const int q = nwg / NXCD, r = nwg % NXCD, xcd = wgid % NXCD, off = wgid / NXCD; wgid = (xcd < r ? xcd * (q + 1) : r * (q + 1) + (xcd - r) * q) + off; }
        const int nig = WGM * nN, gid = wgid / nig, fm = gid * WGM, gsz = (nM - fm) < WGM ? (nM - fm) : WGM;
        u.pm = fm + ((wgid % nig) % gsz); u.pn = (wgid % nig) / gsz; u.x0 = 0; u.x1 = 0; u.rows = nullptr;
        u.a = A + (size_t)u.pm * BM * lda * 2; u.b = Bt + (size_t)u.pn * BM * ldb * 2; return true;
    }
};
struct KvOrder {
    const char* memn; const char* wk; const char* wv; int G, c;
    __device__ __forceinline__ bool next(int i, Unit& u) const {
        const int L = i * G + c; if (L >= 128) return false;
        u.rows = nullptr; u.x1 = 0;
        if (L < 64) { u.pm = L >> 2; u.pn = L & 3; u.x0 = 0; u.a = memn + (size_t)u.pm * BM * D * 2; u.b = wk + (size_t)u.pn * BM * D * 2; }
        else { const int l = L - 64; u.pm = l >> 4; u.pn = l & 15; u.x0 = 1; u.a = wv + (size_t)u.pm * BM * D * 2; u.b = memn + (size_t)u.pn * BM * D * 2; }
        return true;
    }
};
template <int MODE> struct XaOrder {
    const char* A; const char* B; int G, c;
    __device__ __forceinline__ bool next(int i, Unit& u) const {
        const int L = i * G + c; if (L >= NB * XH * 16) return false;
        const int qt = L & 15, bh = L >> 4, b = bh >> 2, h = bh & 3;
        u.pm = b * 16 + qt; u.pn = h; u.x0 = 0; u.x1 = 0; u.rows = nullptr;
        u.a = A + ((size_t)u.pm * BM * D + h * XHD) * 2;
        if (MODE == 0) u.b = B + ((size_t)b * MEML * D + h * XHD) * 2;
        else u.b = B + ((size_t)h * XHD * MROWS + b * MEML) * 2;
        return true;
    }
};
template <int MODE> struct MoeOrder {
    const char* A; const char* W; const int* rowtok; const int* etile; int G, c, dup;
    __device__ __forceinline__ bool next(int i, Unit& u) const {
        int L = i * G + c; const int ntile = etile[NE];
        if (L >= ntile * 4 * dup) return false;
        L %= ntile * 4;
        const int rt = L >> 2, ct = L & 3; int e = 0;
        for (int j = 1; j < NE; ++j) e = (etile[j] <= rt) ? j : e;
        u.pm = rt; u.pn = ct; u.x0 = e; u.x1 = 0;
        if (MODE == 0) { u.a = A; u.rows = rowtok + rt * BM; u.b = W + ((size_t)e * 1024 + ct * BM) * D * 2; }
        else { u.a = A + (size_t)rt * BM * FF * 2; u.rows = nullptr; u.b = W + ((size_t)e * 1024 + ct * BM) * FF * 2; }
        return true;
    }
};

struct EpiU {
    static constexpr bool PERM = true; EPI_NOMID
    bf16_t* Cb; bf16_t* Q; bf16_t* Kb; bf16_t* V; const float* ropec; const float* ropes;
    __device__ __forceinline__ void operator()(Acc& acc, const Unit& u, int wr, int wc, int fr, int fq, LAS unsigned char*, int, int) const {
        const int row0 = u.pm * BM + wr * 64 + fr;
        if (u.pn < 2) {
#pragma unroll
            for (int ai = 0; ai < 2; ++ai)
#pragma unroll
                for (int m = 0; m < 4; ++m) { const int row = row0 + ai * HALF + m * 16; f32x4 o[2];
#pragma unroll
                    for (int n = 0; n < 2; ++n)
#pragma unroll
                        for (int i = 0; i < 4; ++i) { const float a = acc[ai][0][m][n][i], g = acc[ai][1][m][n][i]; o[n][i] = a / (1.f + __expf(-g)); }
                    *(u32x4*)(Cb + (size_t)row * CCH + u.pn * HALF + wc * 32 + fq * 8) = pack8(o[0], o[1]); }
        } else if (u.pn < 8) {
            const int sec = (u.pn - 2) / 3, tt = (u.pn - 2) % 3; bf16_t* dst = sec ? Kb : Q; const float sc = sec ? 1.f : 0.125f * LOG2E;
            const int colb = (4 * tt + wc) * HD + fq * 8;
#pragma unroll
            for (int ai = 0; ai < 2; ++ai)
#pragma unroll
                for (int m = 0; m < 4; ++m) { const int row = row0 + ai * HALF + m * 16; const int s = row & (SEQ - 1); f32x4 o1[2], o2[2];
#pragma unroll
                    for (int n = 0; n < 2; ++n) { const f32x4 cs = *(const f32x4*)(ropec + s * 32 + fq * 8 + n * 4), sn = *(const f32x4*)(ropes + s * 32 + fq * 8 + n * 4);
                        const f32x4 x1 = acc[ai][0][m][n], x2 = acc[ai][1][m][n];
                        o1[n] = (x1 * cs - x2 * sn) * sc; o2[n] = (x1 * sn + x2 * cs) * sc; }
                    bf16_t* p = dst + (size_t)row * AW + colb;
                    *(u32x4*)p = pack8(o1[0], o1[1]); *(u32x4*)(p + 32) = pack8(o2[0], o2[1]); }
        } else {
            const int tt = u.pn - 8;
#pragma unroll
            for (int ai = 0; ai < 2; ++ai)
#pragma unroll
                for (int m = 0; m < 4; ++m) { const int row = row0 + ai * HALF + m * 16;
#pragma unroll
                    for (int bj = 0; bj < 2; ++bj) *(u32x4*)(V + (size_t)row * AW + tt * BM + bj * HALF + wc * 32 + fq * 8) = pack8(acc[ai][bj][m][0], acc[ai][bj][m][1]); }
        }
    }
};
template <bool ROWSCALE> struct EpiPlain {
    static constexpr bool PERM = true; EPI_NOMID
    bf16_t* O0; int ldc0; bf16_t* O1; int ldc1; const float* ssq16;
    __device__ __forceinline__ void operator()(Acc& acc, const Unit& u, int wr, int wc, int fr, int fq, LAS unsigned char*, int, int) const {
        bf16_t* O = u.x0 ? O1 : O0; const int ldc = u.x0 ? ldc1 : ldc0;
        const int row0 = u.pm * BM + wr * 64 + fr, col0 = u.pn * BM + wc * 32 + fq * 8;
#pragma unroll
        for (int ai = 0; ai < 2; ++ai)
#pragma unroll
            for (int m = 0; m < 4; ++m) { const int row = row0 + ai * HALF + m * 16; float rs = 1.f;
                if constexpr (ROWSCALE) { const f32x4* sp = (const f32x4*)(ssq16 + (size_t)row * 16); const f32x4 s0 = sp[0], s1 = sp[1], s2 = sp[2], s3 = sp[3];
                    const f32x4 st = (s0 + s1) + (s2 + s3); rs = 1.0f / sqrtf(((st[0] + st[1]) + (st[2] + st[3])) * (1.0f / D) + NORM_EPS); }
#pragma unroll
                for (int bj = 0; bj < 2; ++bj) *(u32x4*)(O + (size_t)row * ldc + col0 + bj * HALF) = pack8(acc[ai][bj][m][0] * rs, acc[ai][bj][m][1] * rs); }
    }
};
template <bool MID> struct EpiResid {
    static constexpr bool PERM = false, HAS_MID = MID;
    const float* xin; float* xout; bf16_t* XB; float* ssqp; const float* ssqa;
    __device__ __forceinline__ int mid_t() const { return AW / BK; }
    __device__ __forceinline__ void mid(Acc& acc, const Unit& u, int wr, int wc, int fr, int fq) const {
        const int row0 = u.pm * BM + wr * 64 + fr;
#pragma unroll
        for (int ai = 0; ai < 2; ++ai)
#pragma unroll
            for (int m = 0; m < 4; ++m) { const int row = row0 + ai * HALF + m * 16; const f32x4* sp = (const f32x4*)(ssqa + (size_t)row * NH);
                const f32x4 s0 = sp[0], s1 = sp[1], s2 = sp[2]; const f32x4 st = (s0 + s1) + s2;
                const float r = 1.0f / sqrtf(((st[0] + st[1]) + (st[2] + st[3])) * (1.0f / AW) + NORM_EPS);
#pragma unroll
                for (int bj = 0; bj < 2; ++bj)
#pragma unroll
                    for (int n = 0; n < 2; ++n) acc[ai][bj][m][n] = acc[ai][bj][m][n] * r;
                asm volatile("" ::: "memory"); }
    }
    __device__ __forceinline__ void operator()(Acc& acc, const Unit& u, int wr, int wc, int fr, int fq, LAS unsigned char*, int, int) const {
        const int row0 = u.pm * BM + wr * 64 + fr, col0 = u.pn * BM + wc * 32 + fq * 4;
#pragma unroll
        for (int ai = 0; ai < 2; ++ai)
#pragma unroll
            for (int m = 0; m < 4; ++m) { const int row = row0 + ai * HALF + m * 16; float ss = 0.f;
#pragma unroll
                for (int bj = 0; bj < 2; ++bj)
#pragma unroll
                    for (int n = 0; n < 2; ++n) { const size_t o = (size_t)row * D + col0 + bj * HALF + n * 16;
                        const f32x4 v = *(const f32x4*)(xin + o) + acc[ai][bj][m][n];
                        *(f32x4*)(xout + o) = v; u32x2 w; w.x = cvt_pk_bf16(v[0], v[1]); w.y = cvt_pk_bf16(v[2], v[3]); *(u32x2*)(XB + o) = w;
                        ss += (v[0] * v[0] + v[1] * v[1]) + (v[2] * v[2] + v[3] * v[3]); }
                ss += __shfl_xor(ss, 16); ss += __shfl_xor(ss, 32);
                if (fq == 0) ssqp[(size_t)row * 16 + u.pn * 4 + wc] = ss; }
    }
};
struct EpiSoftmax {
    static constexpr bool PERM = true; EPI_NOMID
    bf16_t* PM;
    __device__ __forceinline__ void operator()(Acc& acc, const Unit& u, int wr, int wc, int fr, int fq, LAS unsigned char* lds, int, int) const {
        LAS float* MX = (LAS float*)(lds + XCH_OFF); LAS float* SM = (LAS float*)(lds + XCH_OFF + 4096);
#pragma unroll
        for (int ai = 0; ai < 2; ++ai)
#pragma unroll
            for (int m = 0; m < 4; ++m) { const int rl = ai * HALF + wr * 64 + m * 16 + fr; float mx = -3.0e38f;
#pragma unroll
                for (int bj = 0; bj < 2; ++bj)
#pragma unroll
                    for (int n = 0; n < 2; ++n) { const f32x4 v = acc[ai][bj][m][n]; mx = fmaxf(mx, fmaxf(fmaxf(v[0], v[1]), fmaxf(v[2], v[3]))); }
                mx = fmaxf(mx, __shfl_xor(mx, 16)); mx = fmaxf(mx, __shfl_xor(mx, 32));
                if (fq == 0) MX[rl * 4 + wc] = mx; }
        RAW_BARRIER();
#pragma unroll
        for (int ai = 0; ai < 2; ++ai)
#pragma unroll
            for (int m = 0; m < 4; ++m) { const int rl = ai * HALF + wr * 64 + m * 16 + fr; const f32x4 mm = *(const LAS f32x4*)(MX + rl * 4);
                const float mx = fmaxf(fmaxf(mm[0], mm[1]), fmaxf(mm[2], mm[3])); float ss = 0.f;
#pragma unroll
                for (int bj = 0; bj < 2; ++bj)
#pragma unroll
                    for (int n = 0; n < 2; ++n) { f32x4 v = acc[ai][bj][m][n];
#pragma unroll
                        for (int i = 0; i < 4; ++i) { v[i] = __builtin_amdgcn_exp2f(v[i] - mx); ss += v[i]; }
                        acc[ai][bj][m][n] = v; }
                ss += __shfl_xor(ss, 16); ss += __shfl_xor(ss, 32);
                if (fq == 0) SM[rl * 4 + wc] = ss; }
        RAW_BARRIER();
        const int col0 = u.pn * BM + wc * 32 + fq * 8;
#pragma unroll
        for (int ai = 0; ai < 2; ++ai)
#pragma unroll
            for (int m = 0; m < 4; ++m) { const int rl = ai * HALF + wr * 64 + m * 16 + fr; const f32x4 s4 = *(const LAS f32x4*)(SM + rl * 4);
                const float inv = 1.0f / ((s4[0] + s4[1]) + (s4[2] + s4[3]));
#pragma unroll
                for (int bj = 0; bj < 2; ++bj) *(u32x4*)(PM + (size_t)(u.pm * BM + rl) * D + col0 + bj * HALF) = pack8(acc[ai][bj][m][0] * inv, acc[ai][bj][m][1] * inv); }
    }
};
struct EpiMoe1 {
    static constexpr bool PERM = true; EPI_NOMID
    bf16_t* HID; const float* slot_rs;
    __device__ __forceinline__ void operator()(Acc& acc, const Unit& u, int wr, int wc, int fr, int fq, LAS unsigned char*, int, int) const {
        const int row0 = u.pm * BM + wr * 64 + fr;
#pragma unroll
        for (int ai = 0; ai < 2; ++ai)
#pragma unroll
            for (int m = 0; m < 4; ++m) { const int row = row0 + ai * HALF + m * 16; const float rs = slot_rs[row]; f32x4 o[2];
#pragma unroll
                for (int n = 0; n < 2; ++n)
#pragma unroll
                    for (int i = 0; i < 4; ++i) { const float a = acc[ai][0][m][n][i] * rs, b = acc[ai][1][m][n][i] * rs; o[n][i] = a * b / (1.f + __expf(-a)); }
                *(u32x4*)(HID + (size_t)row * FF + u.pn * HALF + wc * 32 + fq * 8) = pack8(o[0], o[1]); }
    }
};
struct EpiMoe2 {
    static constexpr bool PERM = true; EPI_NOMID
    bf16_t* Y; const float* slot_gate;
    __device__ __forceinline__ void operator()(Acc& acc, const Unit& u, int wr, int wc, int fr, int fq, LAS unsigned char*, int, int) const {
        const int row0 = u.pm * BM + wr * 64 + fr, col0 = u.pn * BM + wc * 32 + fq * 8;
#pragma unroll
        for (int ai = 0; ai < 2; ++ai)
#pragma unroll
            for (int m = 0; m < 4; ++m) { const int row = row0 + ai * HALF + m * 16; const float g = slot_gate[row];
#pragma unroll
                for (int bj = 0; bj < 2; ++bj) *(u32x4*)(Y + (size_t)row * D + col0 + bj * HALF) = pack8(acc[ai][bj][m][0] * g, acc[ai][bj][m][1] * g); }
    }
};
}
struct Frame {
    LAS unsigned char* lds;
    volatile LAS unsigned* MISC;
    unsigned* ctl;
    unsigned char* ws;
    int wave, vcu, G;
};
struct Args { const void* in[27]; float* out; unsigned char* ws; int ph_lo, ph_hi, li, pad; };

__device__ __forceinline__ void tr_item(const float* W, int ldw, int srcrow0, int srccol0, bf16_t* WT, int dpitch, size_t drow0, int dk0, const float* gk, float sc, LAS float* scr, int lane) {
#pragma unroll 8
    for (int i = 0; i < 32; ++i) { const int kk = 2 * i + (lane >> 5); const float g = gk ? gk[kk] * sc : sc;
        scr[kk * 33 + (lane & 31)] = W[(size_t)(srcrow0 + kk) * ldw + srccol0 + (lane & 31)] * g; }
    LDS_WAIT(); asm volatile("" ::: "memory");
    const int c = lane & 7;
#pragma unroll
    for (int j = 0; j < 4; ++j) { const int n = (lane >> 3) + 8 * j; const LAS float* s = scr + (8 * c) * 33 + n;
        u32x4 o; o.x = pk2(s[0 * 33], s[1 * 33]); o.y = pk2(s[2 * 33], s[3 * 33]); o.z = pk2(s[4 * 33], s[5 * 33]); o.w = pk2(s[6 * 33], s[7 * 33]);
        *(u32x4*)(WT + (drow0 + n) * dpitch + dk0 + 8 * c) = o; }
    LDS_WAIT(); asm volatile("" ::: "memory");
}
__device__ __forceinline__ void rms_row_to_bf16(const float* xrow, const float* g, bf16_t* orow, int lane) {
    const f32x4* xr = (const f32x4*)xrow + lane; const f32x4* gr = (const f32x4*)g + lane;
    f32x4 v[4]; float s = 0.f;
#pragma unroll
    for (int j = 0; j < 4; ++j) { v[j] = xr[64 * j]; s += (v[j][0] * v[j][0] + v[j][1] * v[j][1]) + (v[j][2] * v[j][2] + v[j][3] * v[j][3]); }
    const float rs = 1.0f / sqrtf(wave_sum(s) * (1.f / D) + NORM_EPS);
    u32x2* o8 = (u32x2*)orow + lane;
#pragma unroll
    for (int j = 0; j < 4; ++j) { const f32x4 gg = gr[64 * j]; u32x2 w; w.x = pk2(v[j][0] * rs * gg[0], v[j][1] * rs * gg[1]); w.y = pk2(v[j][2] * rs * gg[2], v[j][3] * rs * gg[3]); o8[64 * j] = w; }
}
__device__ __forceinline__ double rope_inv(int d) {
    const int q = d >> 3, r = d & 7;
    double b = 1.0;
    b = (r == 1) ? 0.7498942093324558273 : b; b = (r == 2) ? 0.56234132519034908039 : b; b = (r == 3) ? 0.42169650342858224857 : b; b = (r == 4) ? 0.3162277660168379332 : b;
    b = (r == 5) ? 0.23713737056616552617 : b; b = (r == 6) ? 0.17782794100389228012 : b; b = (r == 7) ? 0.13335214321633240257 : b;
    const double p = (q == 0) ? 1.0 : (q == 1) ? 0.1 : (q == 2) ? 0.01 : 0.001;
    return b * p;
}
__device__ __forceinline__ void sincos_d(double a, double& sn, double& cs) {
    const double k = __builtin_rint(a * 0.63661977236758134308);
    double y = __builtin_fma(-k, 1.57079632679489655800e+00, a); y = __builtin_fma(-k, 6.12323399573676603587e-17, y);
    const double y2 = y * y;
    double s = 1.0 / 6227020800.0; s = s * y2 - 1.0 / 39916800.0; s = s * y2 + 1.0 / 362880.0; s = s * y2 - 1.0 / 5040.0; s = s * y2 + 1.0 / 120.0; s = s * y2 - 1.0 / 6.0; s = s * y2 * y + y;
    double c = 1.0 / 479001600.0; c = c * y2 - 1.0 / 3628800.0; c = c * y2 + 1.0 / 40320.0; c = c * y2 - 1.0 / 720.0; c = c * y2 + 1.0 / 24.0; c = c * y2 - 0.5; c = c * y2 + 1.0;
    const int qd = ((int)k) & 3;
    sn = (qd == 0) ? s : (qd == 1) ? c : (qd == 2) ? -s : -c;
    cs = (qd == 0) ? c : (qd == 1) ? -s : (qd == 2) ? -c : s;
}
typedef const void* gen_cptr;
typedef __attribute__((address_space(4))) const char* cas_cptr;
typedef __attribute__((address_space(4))) const gen_cptr* cas_pptr;
__device__ __forceinline__ const void* karg_ptr(int byte_off) { cas_cptr p = (cas_cptr)__builtin_amdgcn_kernarg_segment_ptr(); asm volatile("" : "+s"(p)); return *(cas_pptr)(p + byte_off); }
__device__ __forceinline__ void p0_prologue(Frame& F) {
    const int lane = lane_id(), tid = F.wave * 64 + lane;
    const float* x = (const float*)karg_ptr(8 * 0); const float* mem = (const float*)karg_ptr(8 * 1); const int* positions = (const int*)karg_ptr(8 * 2);
    const float* mix_g = (const float*)karg_ptr(8 * 3); const float* w_in = (const float*)karg_ptr(8 * 4);
    const float* attn_out_g = (const float*)karg_ptr(8 * 10); const float* w_out = (const float*)karg_ptr(8 * 11);
    const float* xattn_g = (const float*)karg_ptr(8 * 12); const float* mem_g = (const float*)karg_ptr(8 * 13);
    const float* w_xq = (const float*)karg_ptr(8 * 14); const float* w_xk = (const float*)karg_ptr(8 * 15); const float* w_xv = (const float*)karg_ptr(8 * 16); const float* w_xo = (const float*)karg_ptr(8 * 17);
    const float* moe_g = (const float*)karg_ptr(8 * 18); const float* w_group = (const float*)karg_ptr(8 * 19); const float* w_router = (const float*)karg_ptr(8 * 21);
    const float* w1 = (const float*)karg_ptr(8 * 23); const float* w3 = (const float*)karg_ptr(8 * 24); const float* w2 = (const float*)karg_ptr(8 * 25);
    unsigned char* ws = F.ws;
    LAS float* scr = (LAS float*)(F.lds + F.wave * 16384);
    const int gw = F.vcu * NWAVES + F.wave, NGW = F.G * NWAVES;
    constexpr int I_IN = 16 * 88, I_SQ = 16 * 32, I_13 = NE * 16 * 32, I_2 = NE * 8 * 32;
    constexpr int NITEMS = I_IN + 5 * I_SQ + I_13 + I_2;
    for (int it = gw; it < NITEMS; it += NGW) {
        int r = it;
        if (r < I_IN) { const int kb = r / 88, nb = r % 88, n0 = 32 * nb, tile = n0 >> 8, j = n0 & 255; int src;
            if (tile < 2) src = (j < 128) ? 128 * tile + j : 256 + 128 * tile + (j - 128);
            else if (tile < 8) { const int sec = (tile - 2) / 3, tt = (tile - 2) % 3, jj = j & 127, hh = jj >> 5; src = 512 + 768 * sec + 256 * tt + 64 * hh + ((j < 128) ? 0 : 32); }
            else src = n0;
            tr_item(w_in, INW, 64 * kb, src, (bf16_t*)(ws + WS_WIN), D, (size_t)n0, 64 * kb, nullptr, 1.f, scr, lane); continue; }
        r -= I_IN;
        if (r < I_SQ) { const int kb = r / 32, nb = r % 32, dk0 = 64 * kb; const bool at = dk0 < AW;
            tr_item(w_out, D, at ? CCH + dk0 : dk0 - AW, 32 * nb, (bf16_t*)(ws + WS_WOUT), D, (size_t)(32 * nb), dk0, at ? attn_out_g + dk0 : nullptr, 1.f, scr, lane); continue; }
        r -= I_SQ;
        if (r < 4 * I_SQ) { const int which = r / I_SQ, r2 = r % I_SQ, kb = r2 / 32, nb = r2 % 32;
            const float* W = which == 0 ? w_xq : which == 1 ? w_xk : which == 2 ? w_xv : w_xo;
            bf16_t* WT = (bf16_t*)(ws + (which == 0 ? WS_WXQ : which == 1 ? WS_WXK : which == 2 ? WS_WXV : WS_WXO));
            tr_item(W, D, 64 * kb, 32 * nb, WT, D, (size_t)(32 * nb), 64 * kb, which == 0 ? xattn_g + 64 * kb : nullptr, which == 0 ? LOG2E / 16.f : 1.f, scr, lane); continue; }
        r -= 4 * I_SQ;
        if (r < I_13) { const int e = r / 512, r2 = r % 512, kb = r2 / 32, nb = r2 % 32, n0 = 32 * nb, tt = n0 >> 8, j = n0 & 255;
            const float* W = ((j < 128) ? w1 : w3) + (size_t)e * D * FF;
            tr_item(W, FF, 64 * kb, 128 * tt + (j & 127), (bf16_t*)(ws + WS_W13), D, (size_t)e * 1024 + n0, 64 * kb, moe_g + 64 * kb, 1.f, scr, lane); continue; }
        r -= I_13;
        { const int e = r / 256, r2 = r % 256, kb = r2 / 32, nb = r2 % 32;
            tr_item(w2 + (size_t)e * FF * D, D, 64 * kb, 32 * nb, (bf16_t*)(ws + WS_W2), FF, (size_t)e * 1024 + 32 * nb, 64 * kb, nullptr, 1.f, scr, lane); }
    }
    { bf16_t* WRF = (bf16_t*)(ws + WS_HIST + HIST_WR);
      for (int i = blockIdx.x * 512 + tid; i < 4 * 8 * 3 * 2 * 64 * 8; i += F.G * 512) {
          const int j = i & 7, ln = (i >> 3) & 63, part = (i >> 9) & 1, blk = i >> 10, nt = blk % 3, s = (blk / 3) & 7, kc = blk / 24;
          const int k = 256 * kc + 32 * s + 8 * (ln >> 4) + j, o = 16 * nt + (ln & 15);
          float v = 0.f; if (o < 32) v = w_router[k * 32 + o] * moe_g[k]; else if (o < 36) v = w_group[k * 4 + (o - 32)] * moe_g[k];
          const unsigned hb = f2bf(v); const float hf = __builtin_bit_cast(float, hb << 16);
          WRF[i] = (bf16_t)(part ? f2bf(v - hf) : hb); } }
    { float* rc = (float*)(ws + WS_ROPE); float* rsn = rc + SEQ * 32;
      for (int i = blockIdx.x * 512 + tid; i < SEQ * 32; i += F.G * 512) { const int s = i >> 5, d = i & 31;
          const float inv = (float)rope_inv(d); const float ang = (float)positions[s] * inv; double sn, cs; sincos_d((double)fabsf(ang), sn, cs); if (ang < 0.f) sn = -sn;
          rc[i] = (float)cs; rsn[i] = (float)sn; } }
    for (int m = gw; m < MROWS; m += NGW) rms_row_to_bf16(mem + (size_t)m * D, mem_g, (bf16_t*)(ws + WS_MEMN) + (size_t)m * D, lane);
    for (int m = gw; m < T; m += NGW) rms_row_to_bf16(x + (size_t)m * D, mix_g, (bf16_t*)(ws + WS_R1) + (size_t)m * D, lane);
}
namespace att {
typedef short v4i16_t __attribute__((ext_vector_type(4)));
constexpr int BUFB = 65536, VIMG = 32768;
constexpr float NEG = -1.0e30f, MFLOOR = -1.0e9f;
__device__ __forceinline__ int k_off(int row, int c) { return row * 128 + ((c ^ ((row >> 1) & 7)) << 4); }
__device__ __forceinline__ int v_off(int row, int c) { return VIMG + row * 128 + ((c ^ (((row >> 1) & 3) << 1)) << 4); }

struct Grp { bf16x8 q0, q1; f32x4 o[4]; float m, l; };
struct KV { bf16x8 k[2][2]; bf16x8 v[4]; };

#ifdef ATT_SHFL
__device__ __forceinline__ float xmax16(float v) { return fmaxf(v, __shfl_xor(v, 16)); }
__device__ __forceinline__ float xmax32(float v) { return fmaxf(v, __shfl_xor(v, 32)); }
__device__ __forceinline__ float xsum16(float v) { return v + __shfl_xor(v, 16); }
__device__ __forceinline__ float xsum32(float v) { return v + __shfl_xor(v, 32); }
#else
__device__ __forceinline__ void swap16(float v, float& a, float& b) { a = v; b = v; asm volatile("s_nop 1\n\tv_permlane16_swap_b32 %0, %1" : "+v"(a), "+v"(b)); }
__device__ __forceinline__ void swap32(float v, float& a, float& b) { a = v; b = v; asm volatile("s_nop 1\n\tv_permlane32_swap_b32 %0, %1" : "+v"(a), "+v"(b)); }
__device__ __forceinline__ float xmax16(float v) { float a, b; swap16(v, a, b); return fmaxf(a, b); }
__device__ __forceinline__ float xmax32(float v) { float a, b; swap32(v, a, b); return fmaxf(a, b); }
__device__ __forceinline__ float xsum16(float v) { float a, b; swap16(v, a, b); return a + b; }
__device__ __forceinline__ float xsum32(float v) { float a, b; swap32(v, a, b); return a + b; }
#endif
constexpr int NSTEP_ = 19;
__device__ __forceinline__ int step_pos(int step, int row, int c0) {
    if (step < 3) { const int hh = row >> 7, jj = row & 127; return c0 + 256 * hh - 64 + 128 * step + jj; }
    if (step < 9) { const int s = step - 3, hh = row >> 7, c = (row >> 5) & 3, jj = row & 31; return 4 * ((c0 >> 2) + 64 * hh - 64 + 32 * s + jj) + c; }
    { const int s = step - 9, pb = s >> 1, rh = s & 1, rr = row >> 5, jj = row & 31; return 16 * ((c0 >> 4) - 64 + 32 * pb + jj) + 8 * rh + rr; }
}
__device__ __forceinline__ void stage_issue(unsigned ldsbuf, const char* Kg, const char* Vg, int brow0, int hcol, int c0, int step, int wave, int lane) {
    const bool isV = wave >= 4; const char* gb = pg8::uniform_ptr(isV ? Vg : Kg);
#pragma unroll
    for (int i = 0; i < 8; ++i) { const int blk = (wave & 3) * 8 + i, row = 8 * blk + (lane >> 3), phys = lane & 7;
        const int c = isV ? (phys ^ (((row >> 1) & 3) << 1)) : (phys ^ ((row >> 1) & 7));
        int pos = step_pos(step, row, c0); pos = pos < 0 ? 0 : (pos > SEQ - 1 ? SEQ - 1 : pos);
        const unsigned voff = (unsigned)((brow0 + pos) * AW + hcol + c * 8) * 2u;
        pg8::glds16_sv(gb, voff, ldsbuf + (isV ? (unsigned)VIMG : 0u) + (unsigned)blk * 1024u); __builtin_amdgcn_sched_barrier(0); }
}
struct LaneOff { int kb0; int vb[4]; };
__device__ __forceinline__ void lane_off(LaneOff& o, int lane) {
    const int key = lane & 15, g = lane >> 4, q = (lane >> 2) & 3, p2 = lane & 3;
    o.kb0 = k_off(key, g);
#pragma unroll
    for (int db = 0; db < 4; ++db) o.vb[db] = v_off(4 * g + q, 2 * db + (p2 >> 1)) + 8 * (p2 & 1);
}
__device__ __forceinline__ const LAS unsigned char* row_base(const LAS unsigned char* buf, int Rb) {
    return (const LAS unsigned char*)(uintptr_t)(unsigned)__builtin_amdgcn_readfirstlane((int)((unsigned)(uintptr_t)buf + (unsigned)(Rb * 128))); }
__device__ __forceinline__ void load_k(bf16x8 (&k)[2][2], const LAS unsigned char* buf, int Rb, const LaneOff& lo) {
    const LAS unsigned char* rb = row_base(buf, Rb);
#pragma unroll
    for (int t = 0; t < 2; ++t) { k[t][0] = *(const LAS bf16x8*)(rb + t * 2048 + lo.kb0); k[t][1] = *(const LAS bf16x8*)(rb + t * 2048 + (lo.kb0 ^ 64)); }
}
__device__ __forceinline__ void load_v(bf16x8 (&v)[4], const LAS unsigned char* buf, int Rb, const LaneOff& lo) {
    const LAS unsigned char* rb = row_base(buf, Rb);
#pragma unroll
    for (int db = 0; db < 4; ++db) {
        const s16x4 v0 = __builtin_bit_cast(s16x4, __builtin_amdgcn_ds_read_tr16_b64_v4i16((LAS v4i16_t*)(rb + lo.vb[db])));
        const s16x4 v1 = __builtin_bit_cast(s16x4, __builtin_amdgcn_ds_read_tr16_b64_v4i16((LAS v4i16_t*)(rb + 2048 + lo.vb[db])));
        v[db] = (bf16x8){v0[0], v0[1], v0[2], v0[3], v1[0], v1[1], v1[2], v1[3]}; }
}
__device__ __forceinline__ float fmax_nc(float a, float b) { float r; asm("v_max_f32_e32 %0, %1, %2" : "=v"(r) : "v"(a), "v"(b)); return r; }
__device__ __forceinline__ float fmax3_nc(float a, float b, float c) { float r; asm("v_max3_f32 %0, %1, %2, %3" : "=v"(r) : "v"(a), "v"(b), "v"(c)); return r; }
__device__ __forceinline__ void qk_part(const Grp& G, const bf16x8 (&k)[2][2], f32x4 (&s)[2]) {
#pragma unroll
    for (int t = 0; t < 2; ++t) { f32x4 z = (f32x4){0.f, 0.f, 0.f, 0.f};
        z = __builtin_amdgcn_mfma_f32_16x16x32_bf16(k[t][0], G.q0, z, 0, 0, 0); s[t] = __builtin_amdgcn_mfma_f32_16x16x32_bf16(k[t][1], G.q1, z, 0, 0, 0); }
}
template <bool FULL, bool INR>
__device__ __forceinline__ void sm_part(Grp& G, f32x4 (&s)[2], int ksub0, int qsub, int L, int lane, bf16x8& pb, float& alpha) {
    const int g = lane >> 4;
    if constexpr (!FULL) { const int d0 = ksub0 + 4 * g - qsub + 64, k0 = ksub0 + 4 * g;
#pragma unroll
        for (int t = 0; t < 2; ++t)
#pragma unroll
            for (int i = 0; i < 4; ++i) { bool ok = ((unsigned)(d0 + 16 * t + i) <= 128u); if constexpr (!INR) ok = ok && ((unsigned)(k0 + 16 * t + i) < (unsigned)L); s[t][i] = ok ? s[t][i] : NEG; } }
    float mx = fmax3_nc(fmax3_nc(s[0][0], s[0][1], s[0][2]), fmax3_nc(s[0][3], s[1][0], s[1][1]), fmax3_nc(s[1][2], s[1][3], G.m));
    { float a, b; swap16(mx, a, b); mx = fmax_nc(a, b); swap32(mx, a, b); mx = fmax_nc(a, b); }
    const float mn = mx; alpha = __builtin_amdgcn_exp2f(G.m - mn);
    G.m = mn; float p[2][4]; float ps = 0.f;
#pragma unroll
    for (int t = 0; t < 2; ++t)
#pragma unroll
        for (int i = 0; i < 4; ++i) { const float e = __builtin_amdgcn_exp2f(s[t][i] - mn); p[t][i] = e; ps += e; }
    G.l = G.l * alpha + ps;
    u32x4 pw; pw.x = cvt_pk_bf16(p[0][0], p[0][1]); pw.y = cvt_pk_bf16(p[0][2], p[0][3]); pw.z = cvt_pk_bf16(p[1][0], p[1][1]); pw.w = cvt_pk_bf16(p[1][2], p[1][3]);
    pb = __builtin_bit_cast(bf16x8, pw);
}
__device__ __forceinline__ void pv_part(Grp& G, const bf16x8 (&v)[4], const bf16x8& pb, float alpha) {
#pragma unroll
    for (int db = 0; db < 4; ++db) G.o[db] = __builtin_amdgcn_mfma_f32_16x16x32_bf16(v[db], pb, G.o[db] * alpha, 0, 0, 0);
}
__device__ __forceinline__ void grp_init(Grp& G, const bf16_t* Qb, size_t tok0, int hcol, int lane) {
    const int a = lane & 15, g = lane >> 4; const bf16_t* qp = Qb + (tok0 + 16 * a) * AW + hcol + 8 * g;
    G.q0 = *(const bf16x8*)qp; G.q1 = *(const bf16x8*)(qp + 32);
#pragma unroll
    for (int d = 0; d < 4; ++d) G.o[d] = (f32x4){0.f, 0.f, 0.f, 0.f};
    G.m = MFLOOR; G.l = 0.f;
}
__device__ __forceinline__ void grp_finish(Grp& G, bf16_t* MIX, float* ssqa, size_t tok0, int h, int lane) {
    const int a = lane & 15, g = lane >> 4; float l = G.l; l = xsum16(l); l = xsum32(l);
    const float inv = 1.0f / l; const size_t tok = tok0 + 16 * a; float ss = 0.f;
#pragma unroll
    for (int db = 0; db < 4; ++db) { const f32x4 o = G.o[db] * inv; ss += (o[0] * o[0] + o[1] * o[1]) + (o[2] * o[2] + o[3] * o[3]);
        u32x2 w; w.x = cvt_pk_bf16(o[0], o[1]); w.y = cvt_pk_bf16(o[2], o[3]); *(u32x2*)(MIX + tok * D + h * HD + 16 * db + 4 * g) = w; }
    ss = xsum16(ss); ss = xsum32(ss);
    if (g == 0) ssqa[tok * NH + h] = ss;
}
#define ATT_SYNC() do { asm volatile("s_waitcnt vmcnt(0) lgkmcnt(0)" ::: "memory"); __builtin_amdgcn_s_barrier(); asm volatile("" ::: "memory"); } while (0)
#define ATT_SB() __builtin_amdgcn_sched_barrier(0)
template <bool INR>
__device__ __forceinline__ void pair4(Grp& G0, Grp& G1, Grp& G2, Grp& G3, const LAS unsigned char* buf, int Rb, const LaneOff& lo, int ks0, int qs, int dq, int L, int lane) {
    f32x4 s0[2], s1[2], s2[2], s3[2]; bf16x8 p0, p1, p2, p3; float a0, a1, a2, a3;
    { bf16x8 k[2][2]; load_k(k, buf, Rb, lo); qk_part(G0, k, s0); qk_part(G1, k, s1); qk_part(G2, k, s2); qk_part(G3, k, s3); } ATT_SB();
    bf16x8 v[4]; load_v(v, buf, Rb, lo);
    sm_part<false, INR>(G0, s0, ks0, qs, L, lane, p0, a0); sm_part<false, INR>(G1, s1, ks0, qs + dq, L, lane, p1, a1); ATT_SB();
    sm_part<false, INR>(G2, s2, ks0, qs + 2 * dq, L, lane, p2, a2); sm_part<false, INR>(G3, s3, ks0, qs + 3 * dq, L, lane, p3, a3); ATT_SB();
    pv_part(G0, v, p0, a0); pv_part(G1, v, p1, a1); pv_part(G2, v, p2, a2); pv_part(G3, v, p3, a3); ATT_SB();
}
template <bool FULL, bool INR>
__device__ __forceinline__ void pair2(Grp& GA, Grp& GB, const LAS unsigned char* buf, int RbA, int RbB, const LaneOff& lo, int ks0, int qs, int L, int lane) {
    f32x4 s0[2], s1[2]; bf16x8 p0, p1; float a0, a1;
    { bf16x8 ka[2][2], kb[2][2]; load_k(ka, buf, RbA, lo); load_k(kb, buf, RbB, lo); qk_part(GA, ka, s0); qk_part(GB, kb, s1); } ATT_SB();
    bf16x8 va[4], vb[4]; load_v(va, buf, RbA, lo); load_v(vb, buf, RbB, lo);
    sm_part<FULL, INR>(GA, s0, ks0, qs, L, lane, p0, a0); sm_part<FULL, INR>(GB, s1, ks0, qs, L, lane, p1, a1); ATT_SB();
    pv_part(GA, va, p0, a0); pv_part(GB, vb, p1, a1); ATT_SB();
}
__device__ __forceinline__ void attn_unit(LAS unsigned char* lds, const bf16_t* Qb, const bf16_t* Kb, const bf16_t* Vb, bf16_t* MIX, float* ssqa, int b, int h, int c0, int tid, int wave, int lane_) {
    int lane = lane_; asm volatile("" : "+v"(lane));
    const int brow0 = b * SEQ, hcol = h * HD, half = wave >> 2, w4 = wave & 3, ch = c0 + 256 * half;
    const unsigned lds0 = (unsigned)(uintptr_t)lds;
    const size_t tokb = (size_t)(brow0 + ch + w4);
    Grp G0, G1, G2, G3;
    grp_init(G0, Qb, tokb, hcol, lane); grp_init(G1, Qb, tokb + 4, hcol, lane); grp_init(G2, Qb, tokb + 8, hcol, lane); grp_init(G3, Qb, tokb + 12, hcol, lane);
    ATT_SYNC();
    { int ln = lane; asm volatile("" : "+v"(ln)); stage_issue(lds0, (const char*)Kb, (const char*)Vb, brow0, hcol, c0, 0, wave, ln); }
#pragma nounroll
    for (int step = 0; step < NSTEP_; ++step) {
        ATT_SYNC();
        int ln = lane; asm volatile("" : "+v"(ln));
        if (step + 1 < NSTEP_) stage_issue(lds0 + (unsigned)(((step + 1) & 1) * BUFB), (const char*)Kb, (const char*)Vb, brow0, hcol, c0, step + 1, wave, ln);
        const LAS unsigned char* buf = lds + (step & 1) * BUFB;
        LaneOff lo; lane_off(lo, ln); const int a = ln & 15;
        if (step < 3) {
            const int qs = ch + w4 + 16 * a;
#pragma nounroll
            for (int p = 0; p < 4; ++p) { const int ks0 = ch - 64 + 128 * step + 32 * p;
                if (ks0 + 31 >= 0 && ks0 < SEQ) { const int Rb = 128 * half + 32 * p;
                    if (ks0 >= 0 && ks0 + 32 <= SEQ) pair4<true>(G0, G1, G2, G3, buf, Rb, lo, ks0, qs, 4, SEQ, ln); else pair4<false>(G0, G1, G2, G3, buf, Rb, lo, ks0, qs, 4, SEQ, ln); } }
        } else if (step < 9) {
            const int s = step - 3, ks0 = (ch >> 2) - 64 + 32 * s, qs = (ch >> 2) + 4 * a;
            if (ks0 + 31 >= 0 && ks0 < SEQ / 4) { const int Rb = 128 * half + 32 * w4;
                if (ks0 >= 0 && ks0 + 32 <= SEQ / 4) pair4<true>(G0, G1, G2, G3, buf, Rb, lo, ks0, qs, 1, SEQ / 4, ln); else pair4<false>(G0, G1, G2, G3, buf, Rb, lo, ks0, qs, 1, SEQ / 4, ln); }
        } else {
            const int s = step - 9, pb = s >> 1, rh = s & 1, ks0 = (c0 >> 4) - 64 + 32 * pb, qlo = (ch >> 4), qs = qlo + a;
            if (ks0 + 31 >= 0 && ks0 < SEQ / 16 && ks0 <= qlo + 15 + 64 && ks0 + 31 >= qlo - 64) {
                const int RA = 32 * w4, RB = 32 * (w4 + 4);
                const bool inr = (ks0 >= 0) && (ks0 + 32 <= SEQ / 16), full = inr && (ks0 + 31 - qlo <= 64) && (qlo + 15 - ks0 <= 64);
                if (rh == 0) { if (full) pair2<true, true>(G0, G1, buf, RA, RB, lo, ks0, qs, SEQ / 16, ln); else if (inr) pair2<false, true>(G0, G1, buf, RA, RB, lo, ks0, qs, SEQ / 16, ln); else pair2<false, false>(G0, G1, buf, RA, RB, lo, ks0, qs, SEQ / 16, ln); }
                else { if (full) pair2<true, true>(G2, G3, buf, RA, RB, lo, ks0, qs, SEQ / 16, ln); else if (inr) pair2<false, true>(G2, G3, buf, RA, RB, lo, ks0, qs, SEQ / 16, ln); else pair2<false, false>(G2, G3, buf, RA, RB, lo, ks0, qs, SEQ / 16, ln); }
            }
        }
    }
    { int lf = lane; asm volatile("" : "+v"(lf)); const size_t tf = (size_t)(brow0 + ch + w4);
      grp_finish(G0, MIX, ssqa, tf, h, lf); grp_finish(G1, MIX, ssqa, tf + 4, h, lf); grp_finish(G2, MIX, ssqa, tf + 8, h, lf); grp_finish(G3, MIX, ssqa, tf + 12, h, lf); }
}
__device__ __forceinline__ void conv_unit(LAS unsigned char* lds, const bf16_t* Cb, bf16_t* MIX, const float* dw_w, const float* dw_b, const float* ln_g, const float* ln_b, const float* out_g,
                                          int b, int s0, int tid_, int wave, int lane_) {
    int tid = tid_, lane = lane_; asm volatile("" : "+v"(tid), "+v"(lane));
    LAS bf16_t* CT = (LAS bf16_t*)lds;
    LAS float* CO = (LAS float*)(lds + 49152);
    ATT_SYNC();
    for (int p = tid; p < 94 * 32; p += NWAVES * 64) { const int row = p >> 5, c = p & 31, s = s0 - 15 + row;
        u32x4 v = (u32x4){0u, 0u, 0u, 0u};
        if (s >= 0 && s < SEQ) v = *(const u32x4*)(Cb + (size_t)(b * SEQ + s) * CCH + c * 8);
        *(LAS u32x4*)(CT + row * CCH + c * 8) = v; }
    ATT_SYNC();
    { const int ch = tid & 255, half = tid >> 8; float v[62], w[CONVK];
#pragma unroll
      for (int k = 0; k < CONVK; ++k) w[k] = dw_w[k * CCH + ch];
#pragma unroll
      for (int i = 0; i < 62; ++i) v[i] = bf2f(CT[(32 * half + i) * CCH + ch]);
      const float bias = dw_b[ch];
#pragma unroll
      for (int p = 0; p < 32; ++p) { float acc = bias;
#pragma unroll
          for (int k = 0; k < CONVK; ++k) acc += v[p + k] * w[k];
          CO[(32 * half + p) * CCH + ch] = acc; } }
    ATT_SYNC();
    { const f32x4 g4 = *((const f32x4*)ln_g + lane), b4 = *((const f32x4*)ln_b + lane), og = *((const f32x4*)out_g + lane);
#pragma unroll
      for (int pp = 0; pp < 8; ++pp) { const int p = wave * 8 + pp; const f32x4 xv = *(const LAS f32x4*)(CO + p * CCH + 4 * lane);
          const float mean = wave_sum((xv[0] + xv[1]) + (xv[2] + xv[3])) * (1.f / CCH); const f32x4 dx = xv - mean;
          const float var = wave_sum((dx[0] * dx[0] + dx[1] * dx[1]) + (dx[2] * dx[2] + dx[3] * dx[3])) * (1.f / CCH); const float rstd = 1.0f / sqrtf(var + LN_EPS);
          f32x4 z;
#pragma unroll
          for (int i = 0; i < 4; ++i) { const float y = dx[i] * rstd * g4[i] + b4[i]; z[i] = y / (1.f + __expf(-y)); }
          const float ms = wave_sum((z[0] * z[0] + z[1] * z[1]) + (z[2] * z[2] + z[3] * z[3])) * (1.f / CCH); const float rs = 1.0f / sqrtf(ms + NORM_EPS);
          u32x2 o; o.x = cvt_pk_bf16(z[0] * rs * og[0], z[1] * rs * og[1]); o.y = cvt_pk_bf16(z[2] * rs * og[2], z[3] * rs * og[3]);
          *(u32x2*)(MIX + (size_t)(b * SEQ + s0 + p) * D + AW + 4 * lane) = o; } }
}
}
namespace moe {
#define MOE_SYNC() do { asm volatile("s_waitcnt vmcnt(0) lgkmcnt(0)" ::: "memory"); __builtin_amdgcn_s_barrier(); asm volatile("" ::: "memory"); } while (0)
__device__ __forceinline__ void split_hi_lo(const f32x4& a, const f32x4& b, bf16x8& hi, bf16x8& lo) {
    u32x4 h, l; float r[8];
    h.x = cvt_pk_bf16(a[0], a[1]); h.y = cvt_pk_bf16(a[2], a[3]); h.z = cvt_pk_bf16(b[0], b[1]); h.w = cvt_pk_bf16(b[2], b[3]);
    r[0] = a[0] - bflo(h.x); r[1] = a[1] - bfhi(h.x); r[2] = a[2] - bflo(h.y); r[3] = a[3] - bfhi(h.y);
    r[4] = b[0] - bflo(h.z); r[5] = b[1] - bfhi(h.z); r[6] = b[2] - bflo(h.w); r[7] = b[3] - bfhi(h.w);
    l.x = cvt_pk_bf16(r[0], r[1]); l.y = cvt_pk_bf16(r[2], r[3]); l.z = cvt_pk_bf16(r[4], r[5]); l.w = cvt_pk_bf16(r[6], r[7]);
    hi = __builtin_bit_cast(bf16x8, h); lo = __builtin_bit_cast(bf16x8, l);
}
__device__ __forceinline__ void route_chunk(LAS unsigned char* lds, const float* x2, const float* ssq2, const bf16_t* WRF, const float* b_router, const float* b_group,
                                            int* tok_e, float* tok_gate, float* tok_rs, int* hist, int chunk, int tid, int wave, int lane) {
    LAS unsigned char* WB = lds;
    LAS float* LG = (LAS float*)(lds + 49152);
    LAS int* HS = (LAS int*)(lds + 49152 + 36864);
    const int tk = lane & 15, g = lane >> 4;
    f32x4 acc[2][3];
#pragma unroll
    for (int gi = 0; gi < 2; ++gi)
#pragma unroll
        for (int nt = 0; nt < 3; ++nt) acc[gi][nt] = (f32x4){0.f, 0.f, 0.f, 0.f};
    if (tid < 32) HS[tid] = 0;
    const float* xb = x2 + (size_t)(chunk * 256 + wave * 32 + tk) * D + 8 * g;
#pragma nounroll
    for (int kc = 0; kc < 4; ++kc) {
        MOE_SYNC();
#pragma unroll
        for (int i = 0; i < 6; ++i) { const int p = tid + 512 * i; *(LAS u32x4*)(WB + p * 16) = *(const u32x4*)((const char*)WRF + (size_t)kc * 49152 + p * 16); }
        MOE_SYNC();
#pragma unroll
        for (int gi = 0; gi < 2; ++gi) {
            f32x4 xa[8], xc[8];
#pragma unroll
            for (int s = 0; s < 8; ++s) { const float* xp = xb + (size_t)gi * 16 * D + kc * 256 + s * 32; xa[s] = *(const f32x4*)xp; xc[s] = *(const f32x4*)(xp + 4); }
#pragma unroll
            for (int s = 0; s < 8; ++s) { bf16x8 ah, al; split_hi_lo(xa[s], xc[s], ah, al);
#pragma unroll
                for (int nt = 0; nt < 3; ++nt) { const LAS unsigned char* bp = WB + ((s * 3 + nt) * 2) * 1024 + lane * 16;
                    const bf16x8 bh = *(const LAS bf16x8*)bp, bl = *(const LAS bf16x8*)(bp + 1024);
                    acc[gi][nt] = __builtin_amdgcn_mfma_f32_16x16x32_bf16(ah, bh, acc[gi][nt], 0, 0, 0);
                    acc[gi][nt] = __builtin_amdgcn_mfma_f32_16x16x32_bf16(ah, bl, acc[gi][nt], 0, 0, 0);
                    acc[gi][nt] = __builtin_amdgcn_mfma_f32_16x16x32_bf16(al, bh, acc[gi][nt], 0, 0, 0); } }
        }
    }
#pragma unroll
    for (int gi = 0; gi < 2; ++gi)
#pragma unroll
        for (int nt = 0; nt < 3; ++nt) { const int o = 16 * nt + tk;
            if (o < 36) {
#pragma unroll
                for (int r = 0; r < 4; ++r) LG[(wave * 32 + gi * 16 + 4 * g + r) * 36 + o] = acc[gi][nt][r]; } }
    MOE_SYNC();
    if (wave < 4) { const int tr = wave * 64 + lane, tg = chunk * 256 + tr; const LAS float* lg = LG + tr * 36;
        const f32x4* sp = (const f32x4*)(ssq2 + (size_t)tg * 16); const f32x4 st = (sp[0] + sp[1]) + (sp[2] + sp[3]);
        const float rs = 1.0f / sqrtf(((st[0] + st[1]) + (st[2] + st[3])) * (1.f / D) + NORM_EPS);
        tok_rs[tg] = rs;
        float gl[4];
#pragma unroll
        for (int j = 0; j < 4; ++j) gl[j] = lg[32 + j] * rs + b_group[j];
        float gm = gl[0]; int gi = 0;
#pragma unroll
        for (int j = 1; j < 4; ++j) { if (gl[j] > gm) { gm = gl[j]; gi = j; } }
        float den = 0.f;
#pragma unroll
        for (int j = 0; j < 4; ++j) den += __expf(gl[j] - gm);
        const float gp = 1.0f / den;
        float v0 = -3.0e38f, v1 = -3.0e38f; int i0 = 0, i1 = 0;
#pragma unroll
        for (int j = 0; j < 8; ++j) { const float v = lg[gi * 8 + j] * rs + b_router[gi * 8 + j];
            if (v > v0) { v1 = v0; i1 = i0; v0 = v; i0 = j; } else if (v > v1) { v1 = v; i1 = j; } }
        const float dd = __expf(v1 - v0), g0 = gp / (1.f + dd), g1 = gp * dd / (1.f + dd);
        const int e0 = gi * 8 + i0, e1 = gi * 8 + i1;
        __hip_atomic_fetch_add(HS + e0, 1, __ATOMIC_RELAXED, __HIP_MEMORY_SCOPE_WORKGROUP); __hip_atomic_fetch_add(HS + e1, 1, __ATOMIC_RELAXED, __HIP_MEMORY_SCOPE_WORKGROUP);
        tok_e[tg] = e0 | (e1 << 8); tok_gate[2 * tg] = g0; tok_gate[2 * tg + 1] = g1; }
    MOE_SYNC();
    if (tid < 32) hist[chunk * 32 + tid] = HS[tid];
}
__device__ __forceinline__ void slot_chunk(LAS unsigned char* lds, const int* hist, const int* tok_e, const float* tok_gate, const float* tok_rs, int* tok_slot, int* row_tok, float* slot_rs, float* slot_gate, int* etile,
                                           int chunk, int tid, int wave, int lane) {
    LAS int* CNT = (LAS int*)lds; LAS int* BASE = CNT + 32; LAS int* PST = CNT + 64; LAS int* WC = CNT + 128;
    MOE_SYNC();
    if (tid < 32) { int tot = 0, bs = 0; for (int cc = 0; cc < 256; ++cc) { const int hh = hist[cc * 32 + tid]; bs += (cc < chunk) ? hh : 0; tot += hh; } CNT[tid] = tot; BASE[tid] = bs; }
    MOE_SYNC();
    if (tid == 0) { int ps = 0; for (int e = 0; e < 32; ++e) { PST[e] = ps; ps += ((CNT[e] + 255) >> 8) << 8; } PST[32] = ps; }
    MOE_SYNC();
    int ek[2] = {0, 0}, rank[2] = {0, 0}; const int t = chunk * 256 + (wave & 3) * 64 + lane;
    if (wave < 4) { const int ev = tok_e[t]; ek[0] = ev & 255; ek[1] = ev >> 8;
#pragma unroll
        for (int k = 0; k < 2; ++k)
#pragma nounroll
            for (int e = 0; e < 32; ++e) { const unsigned long long m = __ballot(ek[k] == e);
                if (ek[k] == e) rank[k] = __popcll(m & ((1ull << lane) - 1ull));
                if (lane == 0) WC[(k * 4 + wave) * 32 + e] = __popcll(m); } }
    MOE_SYNC();
    if (wave < 4) {
#pragma unroll
        for (int k = 0; k < 2; ++k) { int off = 0;
            for (int kw = 0; kw < k * 4 + wave; ++kw) off += WC[kw * 32 + ek[k]];
            const int slot = PST[ek[k]] + BASE[ek[k]] + off + rank[k];
            row_tok[slot] = t; slot_rs[slot] = tok_rs[t]; slot_gate[slot] = tok_gate[2 * t + k]; tok_slot[2 * t + k] = slot; } }
    if (chunk < 32) { const int e = chunk, c0 = PST[e] + CNT[e], n = PST[e + 1] - c0;
        for (int i = tid; i < n; i += NWAVES * 64) { row_tok[c0 + i] = 0; slot_rs[c0 + i] = 0.f; slot_gate[c0 + i] = 0.f; } }
    if (chunk == 0 && tid <= 32) etile[tid] = PST[tid] >> 8;
}
__device__ __forceinline__ void final_row(float* xo, const bf16_t* Y, const int* tok_slot, const float* g, int t, int lane) {
    const int s0 = tok_slot[2 * t], s1 = tok_slot[2 * t + 1];
    f32x4* xr = (f32x4*)(xo + (size_t)t * D) + lane; const u32x2* y0 = (const u32x2*)(Y + (size_t)s0 * D) + lane; const u32x2* y1 = (const u32x2*)(Y + (size_t)s1 * D) + lane;
    const f32x4* gr = (const f32x4*)g + lane;
    f32x4 v[4]; float s = 0.f;
#pragma unroll
    for (int j = 0; j < 4; ++j) { const f32x4 x = xr[64 * j]; const u32x2 a = y0[64 * j], b = y1[64 * j];
        v[j][0] = x[0] + (bflo(a.x) + bflo(b.x)); v[j][1] = x[1] + (bfhi(a.x) + bfhi(b.x)); v[j][2] = x[2] + (bflo(a.y) + bflo(b.y)); v[j][3] = x[3] + (bfhi(a.y) + bfhi(b.y));
        s += (v[j][0] * v[j][0] + v[j][1] * v[j][1]) + (v[j][2] * v[j][2] + v[j][3] * v[j][3]); }
    const float rs = 1.0f / sqrtf(wave_sum(s) * (1.f / D) + NORM_EPS);
#pragma unroll
    for (int j = 0; j < 4; ++j) xr[64 * j] = v[j] * rs * gr[64 * j];
}
}
#ifndef MK_N_LAUNCHES
#define MK_N_LAUNCHES 1
#endif
constexpr int NPH = 13;
constexpr int N_LAUNCHES = MK_N_LAUNCHES;

#define ARG_IN(k) karg_ptr(8 * (k))
#define ARG_OUT ((float*)karg_ptr(8 * 27))
#define ARG_WS ((unsigned char*)karg_ptr(8 * 28))
template <int LO, int HI>
__global__ void __launch_bounds__(NWAVES * 64, 2) mega_fwd(Args args) {
    extern __shared__ __attribute__((aligned(16))) unsigned char lds_raw[];
    Frame F;
    F.lds = (LAS unsigned char*)lds_raw;
    F.MISC = (volatile LAS unsigned*)(F.lds + LDSCTL_OFF);
    F.wave = __builtin_amdgcn_readfirstlane((int)threadIdx.x >> 6);
    F.G = gridDim.x; { const int bx = blockIdx.x; F.vcu = (F.G % 8 == 0) ? (bx % 8) * (F.G / 8) + bx / 8 : bx; }
    F.ws = ARG_WS; F.ctl = (unsigned*)(ARG_WS + WS_CTL);
    for (int u = threadIdx.x; u < (LDS_BYTES - LDSCTL_OFF) / 4; u += NWAVES * 64) ((LAS unsigned*)(F.lds + LDSCTL_OFF))[u] = 0u;
    __syncthreads();
    XcdBarrier bar; bar.bar = F.ctl + CW_BAR; bar.x = 0; bar.st = nullptr;
    if (HI - LO > 1) bar = xcd_barrier_post(F.ctl + CW_BAR, F.MISC + 8);
#define GRID_BAR() do { if (HI - LO > 1) xcd_barrier(bar); } while (0)
#ifndef PH_MASK
#define PH_MASK 0x1fff
#endif
#define IN(k) ((((PH_MASK) >> (k)) & 1) && LO <= (k) && (k) < HI)
#define BOTH(k) (IN(k) && IN((k) + 1))
#ifndef DUP_PHASE
#define DUP_PHASE -1
#endif
#define DUPF(k) ((k) == DUP_PHASE ? 2 : 1)
    const int gw = F.vcu * NWAVES + F.wave, NGW = F.G * NWAVES;
#define R1 ((bf16_t*)(ARG_WS + WS_R1))
#define R2 ((bf16_t*)(ARG_WS + WS_R2))
#define ssqa ((float*)(ARG_WS + WS_SSQA))
#define ssq1 ((float*)(ARG_WS + WS_SSQ1))
#define ssq2 ((float*)(ARG_WS + WS_SSQ2))
#define tok_e ((int*)(ARG_WS + WS_TOK + TK_E))
#define tok_gate ((float*)(ARG_WS + WS_TOK + TK_GATE))
#define tok_slot ((int*)(ARG_WS + WS_TOK + TK_SLOT))
#define tok_rs ((float*)(ARG_WS + WS_TOK + TK_RS))
#define row_tok ((int*)(ARG_WS + WS_TOK + TK_ROWTOK))
#define slot_rs ((float*)(ARG_WS + WS_TOK + TK_SLOTRS))
#define slot_gate ((float*)(ARG_WS + WS_TOK + TK_SLOTGATE))
#define hist ((int*)(ARG_WS + WS_HIST))
#define etile ((int*)(ARG_WS + WS_HIST + HIST_ETILE))
#define WR ((const bf16_t*)(ARG_WS + WS_HIST + HIST_WR))

    if (IN(0)) { p0_prologue(F); if (BOTH(0)) GRID_BAR(); }

    if (IN(1)) {
        { pg8::GridOrder S; S.init(R1, ARG_WS + WS_WIN, D, D, T, INW, F.G, (int)blockIdx.x); S.dup = DUPF(1);
          pg8::EpiU E{R2, (bf16_t*)(ARG_WS + WS_Q), (bf16_t*)(ARG_WS + WS_K), (bf16_t*)(ARG_WS + WS_V), (const float*)(ARG_WS + WS_ROPE), (const float*)(ARG_WS + WS_ROPE) + SEQ * 32};
          pg8::gemm_phase<pg8::EpiU, pg8::GridOrder, true, false>(F.lds, F.wave, D, D, D, S, E); }
        { pg8::KvOrder S{(const char*)(ARG_WS + WS_MEMN), (const char*)(ARG_WS + WS_WXK), (const char*)(ARG_WS + WS_WXV), F.G, (int)blockIdx.x};
          pg8::EpiPlain<false> E{(bf16_t*)(ARG_WS + WS_KX), D, (bf16_t*)(ARG_WS + WS_VXT), MROWS, nullptr};
          pg8::gemm_phase<pg8::EpiPlain<false>, pg8::KvOrder, true, false>(F.lds, F.wave, D, D, D, S, E); }
        if (BOTH(1)) GRID_BAR();
    }

    if (IN(2)) {
        for (int L0 = F.vcu; L0 < NB * NH * 8 * DUPF(2); L0 += F.G) { const int L = L0 % (NB * NH * 8); const int chunk = L & 7, bh = L >> 3, b = bh / NH, h = bh % NH;
            att::attn_unit(F.lds, (const bf16_t*)(ARG_WS + WS_Q), (const bf16_t*)(ARG_WS + WS_K), (const bf16_t*)(ARG_WS + WS_V), R1, ssqa, b, h, chunk * 512, F.wave * 64 + lane_id(), F.wave, lane_id()); }
        for (int L = F.vcu; L < NB * 64; L += F.G) { const int b = L >> 6, j = L & 63;
            att::conv_unit(F.lds, R2, R1, (const float*)ARG_IN(5), (const float*)ARG_IN(6), (const float*)ARG_IN(7), (const float*)ARG_IN(8), (const float*)ARG_IN(9), b, j * 64, F.wave * 64 + lane_id(), F.wave, lane_id()); }
        asm volatile("s_waitcnt vmcnt(0) lgkmcnt(0)" ::: "memory"); __syncthreads();
        if (BOTH(2)) GRID_BAR();
    }

    if (IN(3)) {
        pg8::GridOrder S; S.init(R1, ARG_WS + WS_WOUT, D, D, T, D, F.G, (int)blockIdx.x); S.dup = DUPF(3);
        pg8::EpiResid<true> E{(const float*)ARG_IN(0), ARG_OUT, R2, ssq1, ssqa};
        pg8::gemm_phase<pg8::EpiResid<true>, pg8::GridOrder, true, false>(F.lds, F.wave, D, D, D, S, E);
        if (BOTH(3)) GRID_BAR();
    }

    if (IN(4)) {
        pg8::GridOrder S; S.init(R2, ARG_WS + WS_WXQ, D, D, T, D, F.G, (int)blockIdx.x); S.dup = DUPF(4);
        pg8::EpiPlain<true> E{(bf16_t*)(ARG_WS + WS_XQ), D, nullptr, 0, ssq1};
        pg8::gemm_phase<pg8::EpiPlain<true>, pg8::GridOrder, true, false>(F.lds, F.wave, D, D, D, S, E);
        if (BOTH(4)) GRID_BAR();
    }

    if (IN(5)) {
        pg8::XaOrder<0> S{(const char*)(ARG_WS + WS_XQ), (const char*)(ARG_WS + WS_KX), F.G, F.vcu};
        pg8::EpiSoftmax E{(bf16_t*)(ARG_WS + WS_PM)};
        pg8::gemm_phase<pg8::EpiSoftmax, pg8::XaOrder<0>, true, false>(F.lds, F.wave, D, D, XHD, S, E);
        if (BOTH(5)) GRID_BAR();
    }

    if (IN(6)) {
        pg8::XaOrder<1> S{(const char*)(ARG_WS + WS_PM), (const char*)(ARG_WS + WS_VXT), F.G, F.vcu};
        pg8::EpiPlain<false> E{R1, D, nullptr, 0, nullptr};
        pg8::gemm_phase<pg8::EpiPlain<false>, pg8::XaOrder<1>, true, false>(F.lds, F.wave, D, MROWS, MEML, S, E);
        if (BOTH(6)) GRID_BAR();
    }

    if (IN(7)) {
        pg8::GridOrder S; S.init(R1, ARG_WS + WS_WXO, D, D, T, D, F.G, (int)blockIdx.x);
        pg8::EpiResid<false> E{ARG_OUT, ARG_OUT, R2, ssq2, nullptr};
        pg8::gemm_phase<pg8::EpiResid<false>, pg8::GridOrder, true, false>(F.lds, F.wave, D, D, D, S, E);
        if (BOTH(7)) GRID_BAR();
    }

    if (IN(8)) {
        for (int c0_ = blockIdx.x; c0_ < (T / 256) * DUPF(8); c0_ += F.G) { const int c = c0_ % (T / 256);
            moe::route_chunk(F.lds, ARG_OUT, ssq2, WR, (const float*)ARG_IN(22), (const float*)ARG_IN(20), tok_e, tok_gate, tok_rs, hist, c, F.wave * 64 + lane_id(), F.wave, lane_id()); }
        asm volatile("s_waitcnt vmcnt(0) lgkmcnt(0)" ::: "memory"); __syncthreads();
        if (BOTH(8)) GRID_BAR();
    }

    if (IN(9)) {
        for (int c = blockIdx.x; c < T / 256; c += F.G)
            moe::slot_chunk(F.lds, hist, tok_e, tok_gate, tok_rs, tok_slot, row_tok, slot_rs, slot_gate, etile, c, F.wave * 64 + lane_id(), F.wave, lane_id());
        asm volatile("s_waitcnt vmcnt(0) lgkmcnt(0)" ::: "memory"); __syncthreads();
        if (BOTH(9)) GRID_BAR();
    }

    if (IN(10)) {
        pg8::MoeOrder<0> S{(const char*)R2, (const char*)(ARG_WS + WS_W13), row_tok, etile, F.G, (int)blockIdx.x, DUPF(10)};
        pg8::EpiMoe1 E{(bf16_t*)(ARG_WS + WS_HID), slot_rs};
        pg8::gemm_phase<pg8::EpiMoe1, pg8::MoeOrder<0>, true, true>(F.lds, F.wave, D, D, D, S, E);
        if (BOTH(10)) GRID_BAR();
    }

    if (IN(11)) {
        pg8::MoeOrder<1> S{(const char*)(ARG_WS + WS_HID), (const char*)(ARG_WS + WS_W2), row_tok, etile, F.G, (int)blockIdx.x, DUPF(11)};
        pg8::EpiMoe2 E{(bf16_t*)(ARG_WS + WS_Y), slot_gate};
        pg8::gemm_phase<pg8::EpiMoe2, pg8::MoeOrder<1>, true, false>(F.lds, F.wave, FF, FF, FF, S, E);
        if (BOTH(11)) GRID_BAR();
    }

    if (IN(12)) {
        for (int t = gw; t < T; t += NGW) moe::final_row(ARG_OUT, (const bf16_t*)(ARG_WS + WS_Y), tok_slot, (const float*)ARG_IN(26), t, lane_id());
    }
#undef IN
#undef BOTH
}

typedef void (*kern_t)(Args);
template <int... I> struct PhList {};
extern "C" void kernel_launch(void* const* d_in, const int* in_sizes, int n_in, void* d_out, int out_size, void* d_ws, size_t ws_size, hipStream_t stream) {
    static int grid = 0;
#if MK_N_LAUNCHES == 1
    static const kern_t kerns[1] = {mega_fwd<0, NPH>};
#else
    static const kern_t kerns[NPH] = {mega_fwd<0, 1>, mega_fwd<1, 2>, mega_fwd<2, 3>, mega_fwd<3, 4>, mega_fwd<4, 5>, mega_fwd<5, 6>, mega_fwd<6, 7>, mega_fwd<7, 8>, mega_fwd<8, 9>, mega_fwd<9, 10>, mega_fwd<10, 11>, mega_fwd<11, 12>, mega_fwd<12, 13>};
#endif
    if (grid == 0) {
        if (n_in != 27 || in_sizes[0] != T * D || out_size != T * D || ws_size < WS_END) { fprintf(stderr, "kernel_launch: unexpected problem: n_in %d in0 %d out %d ARG_WS %zu (need %zu)\n", n_in, n_in > 0 ? in_sizes[0] : -1, out_size, ws_size, (size_t)WS_END); grid = -1; return; }
        int dev = 0, cus = 0, per_cu = 0;
        if (hipGetDevice(&dev) != hipSuccess || hipDeviceGetAttribute(&cus, hipDeviceAttributeMultiprocessorCount, dev) != hipSuccess) { grid = -1; return; }
        for (int li = 0; li < N_LAUNCHES; ++li)
            if (hipFuncSetAttribute((const void*)kerns[li], hipFuncAttributeMaxDynamicSharedMemorySize, LDS_BYTES) != hipSuccess) { fprintf(stderr, "kernel_launch: hipFuncSetAttribute failed\n"); grid = -1; return; }
        if (hipOccupancyMaxActiveBlocksPerMultiprocessor(&per_cu, (const void*)kerns[0], NWAVES * 64, LDS_BYTES) != hipSuccess || per_cu < 1) { fprintf(stderr, "kernel_launch: occupancy query says %d\n", per_cu); }
        (void)hipGetLastError();
        grid = cus;
    }
    if (grid < 0) return;
    if (hipMemsetAsync((char*)d_ws + WS_CTL, 0, CTL_ZERO_BYTES, stream) != hipSuccess) return;
    Args a{};
    for (int i = 0; i < 27; ++i) a.in[i] = d_in[i];
    a.out = (float*)d_out; a.ws = (unsigned char*)d_ws;
    for (int li = 0; li < N_LAUNCHES; ++li) {
        a.ph_lo = 0; a.ph_hi = 0; a.li = li; a.pad = 0;
        hipLaunchKernelGGL(kerns[li], dim3(grid), dim3(NWAVES * 64), LDS_BYTES, stream, a);
        const hipError_t le = hipPeekAtLastError();
        if (le != hipSuccess) { fprintf(stderr, "kernel_launch: launch %d failed: %s\n", li, hipGetErrorName(le)); break; }
    }
}
```

```cpp
#include <hip/hip_runtime.h>
#include <cstdio>
#include <cstdint>

#define GAS __attribute__((address_space(1)))
#define LAS __attribute__((address_space(3)))
typedef unsigned short bf16_t;
typedef short bf16x8 __attribute__((ext_vector_type(8)));
typedef short s16x4 __attribute__((ext_vector_type(4)));
typedef float f32x4 __attribute__((ext_vector_type(4)));
typedef float f32x2 __attribute__((ext_vector_type(2)));
typedef unsigned u32x4 __attribute__((ext_vector_type(4)));
typedef unsigned u32x2 __attribute__((ext_vector_type(2)));

constexpr int NB = 16, SEQ = 4096, T = NB * SEQ, D = 1024;
constexpr int CCH = 256, NH = 12, HD = 64, AW = NH * HD, INW = 2 * CCH + 3 * AW;
constexpr int MEML = 256, MROWS = NB * MEML, XH = 4, XHD = 256;
constexpr int NE = 32, EPG = 8, NG = 4, FF = 512;
constexpr int CONVK = 31;
constexpr int A_PAD = T * 2 + NE * 256;
constexpr float NORM_EPS = 1e-6f, LN_EPS = 1e-5f;
constexpr float LOG2E = 1.4426950408889634f;

constexpr size_t MiB = 1u << 20;
constexpr size_t WS_CTL = 0, CTL_ZERO_BYTES = 1 * MiB;
constexpr size_t WS_ROPE = 1 * MiB;
constexpr size_t WS_HIST = 2 * MiB;
constexpr size_t WS_SSQA = 4 * MiB;
constexpr size_t WS_SSQ1 = 8 * MiB;
constexpr size_t WS_SSQ2 = 12 * MiB;
constexpr size_t WS_WIN = 16 * MiB, WS_WOUT = 22 * MiB, WS_WXQ = 24 * MiB, WS_WXK = 26 * MiB, WS_WXV = 28 * MiB, WS_WXO = 30 * MiB;
constexpr size_t WS_W13 = 32 * MiB, WS_W2 = 96 * MiB;
constexpr size_t WS_MEMN = 128 * MiB, WS_KX = 136 * MiB, WS_VXT = 144 * MiB;
constexpr size_t WS_TOK = 152 * MiB;
constexpr size_t WS_R1 = 160 * MiB;
constexpr size_t WS_R2 = 288 * MiB;
constexpr size_t WS_Q = 320 * MiB, WS_K = 416 * MiB, WS_V = 512 * MiB;
constexpr size_t WS_XQ = 416 * MiB;
constexpr size_t WS_PM = 544 * MiB;
constexpr size_t WS_HID = 416 * MiB;
constexpr size_t WS_Y = 552 * MiB;
constexpr size_t WS_END = 824 * MiB;
constexpr size_t TK_E = 0;
constexpr size_t TK_GATE = 1 * MiB;
constexpr size_t TK_SLOT = 2 * MiB;
constexpr size_t TK_RS = 3 * MiB;
constexpr size_t TK_ROWTOK = 4 * MiB;
constexpr size_t TK_SLOTRS = 5 * MiB;
constexpr size_t TK_SLOTGATE = 6 * MiB;
constexpr size_t HIST_ETILE = 64 * 1024, HIST_WR = 128 * 1024;

constexpr int CW_BAR = 4096;

constexpr int NWAVES = 8;
constexpr int RING_BYTES = 131072;
constexpr int XCH_OFF = RING_BYTES;
constexpr int LDSCTL_OFF = RING_BYTES + 12288;
constexpr int LDS_BYTES = 147456;

#define LDS_WAIT() asm volatile("s_waitcnt lgkmcnt(0)" ::: "memory")
#define VM_WAIT() asm volatile("s_waitcnt vmcnt(0)" ::: "memory")
__device__ __forceinline__ unsigned f2bf(float f) { unsigned u = __builtin_bit_cast(unsigned, f); return (u + 0x7fffu + ((u >> 16) & 1u)) >> 16; }
__device__ __forceinline__ unsigned pk2(float lo, float hi) { return f2bf(lo) | (f2bf(hi) << 16); }
__device__ __forceinline__ float bf2f(unsigned short b) { return __builtin_bit_cast(float, (unsigned)b << 16); }
__device__ __forceinline__ float bflo(unsigned w) { return __builtin_bit_cast(float, w << 16); }
__device__ __forceinline__ float bfhi(unsigned w) { return __builtin_bit_cast(float, w & 0xffff0000u); }
__device__ __forceinline__ unsigned cvt_pk_bf16(float lo, float hi) { unsigned r; asm volatile("v_cvt_pk_bf16_f32 %0, %1, %2" : "=v"(r) : "v"(lo), "v"(hi)); return r; }
__device__ __forceinline__ float wave_sum(float v) {
#pragma unroll
    for (int o = 1; o < 64; o <<= 1) v += __shfl_xor(v, o);
    return v;
}
__device__ __forceinline__ int lane_id() { return (int)__builtin_amdgcn_mbcnt_hi(~0u, __builtin_amdgcn_mbcnt_lo(~0u, 0u)); }
#define MK_N_LAUNCHES 1
namespace pg8 {
constexpr int BM = 256, BK = 64, HALF = 128, HTB = HALF * BK * 2  , STAGE_BYTES = 8 * HTB, NXCD = 8, WGM = 8;

__host__ __device__ __forceinline__ int lds_byte(int r, int c) { const int st = (r >> 4) * 2 + (c >> 5), rr = r & 15, cc = c & 31, ob = rr * 64 + cc * 2; return st * 1024 + (ob ^ (((ob >> 9) & 1) << 5)); }
__host__ __device__ __forceinline__ void stage_rc(int b, int& R, int& C) { const int st = b / 1024, sb = b % 1024, swz = sb ^ (((sb >> 9) & 1) << 5); R = (st >> 1) * 16 + swz / 64; C = (st & 1) * 32 + (swz % 64) / 2; }
__host__ __device__ __forceinline__ int perm32(int rho) { const int n = rho >> 4, i = rho & 15; return 8 * (i >> 2) + 4 * n + (i & 3); }

struct Unit { const char* a; const char* b; const int* rows; int pm, pn, x0, x1; };

typedef f32x4 Acc[2][2][4][2];

__device__ __forceinline__ const char* uniform_ptr(const char* p) { const unsigned long long v = (unsigned long long)p;
    const unsigned lo = __builtin_amdgcn_readfirstlane((unsigned)v), hi = __builtin_amdgcn_readfirstlane((unsigned)(v >> 32)); return (const char*)(((unsigned long long)hi << 32) | lo); }
__device__ __forceinline__ void glds16_sv(const char* gbase, unsigned voff, unsigned lds_dst) { unsigned keep;
    asm volatile("s_mov_b32 %0, m0\n\ts_mov_b32 m0, %3\n\ts_nop 0\n\tglobal_load_lds_dwordx4 %1, %2\n\ts_mov_b32 m0, %0" : "=&s"(keep) : "v"(voff), "s"(gbase), "s"(lds_dst) : "memory"); }
template <class Epi, class Sched, bool ALIGN_EPI, bool GATHER>
__device__ __forceinline__ void gemm_phase(LAS unsigned char* lds, const int wave_, const int lda, const int ldb, const int K, const Sched& S, const Epi& E) {
    int lane_ = lane_id(); asm volatile("" : "+v"(lane_));
    const int wid = __builtin_amdgcn_readfirstlane(wave_), tid = wid * 64 + lane_, lane = tid & 63, wr = wid >> 2, wc = wid & 3, fr = lane & 15, fq = lane >> 4;
    const int nt = K / BK;
    int Rr[2], Cc[2];
    unsigned vA[2][2], vN[2][2], voffB[2];
#pragma unroll
    for (int i = 0; i < 2; ++i) { int R, C; stage_rc(tid * 16 + i * 8192, R, C); Rr[i] = R; Cc[i] = C; const int Rb = Epi::PERM ? ((R & ~31) + perm32(R & 31)) : R;
        voffB[i] = (unsigned)(Rb * ldb + C) * 2u; }
    const size_t kstep = (size_t)(BK * 2);
    const size_t hstepB = (size_t)HALF * ldb * 2, hstepA = (size_t)HALF * lda * 2;
    const unsigned ldsw = (unsigned)wid * 1024u, lds0 = (unsigned)(uintptr_t)lds;
    const int aoff = lds_byte(wr * 64 + fr, fq * 8), boff = lds_byte(wc * 32 + fr, fq * 8);
#define PG8_SA(b, h) (((b) * 2 + (h)) * HTB)
#define PG8_SB(b, h) ((4 + (b) * 2 + (h)) * HTB)
#define PG8_STAGE(bufoff, gbase, voff) do { _Pragma("unroll") for (int _i = 0; _i < 2; ++_i) glds16_sv((gbase), (voff)[_i], lds0 + (unsigned)(bufoff) + ldsw + _i * 8192u); } while (0)
#define PG8_LDA(dst, b, h) do { _Pragma("unroll") for (int m = 0; m < 4; ++m) _Pragma("unroll") for (int k = 0; k < 2; ++k) dst[m][k] = *(const LAS bf16x8*)(lds + PG8_SA(b, h) + aoff + m * 2048 + k * 1024); } while (0)
#define PG8_LDB(dst, b, h) do { _Pragma("unroll") for (int n = 0; n < 2; ++n) _Pragma("unroll") for (int k = 0; k < 2; ++k) dst[n][k] = *(const LAS bf16x8*)(lds + PG8_SB(b, h) + boff + n * 2048 + k * 1024); } while (0)
#define PG8_MMA(ai, bj, At, Bt) do { __builtin_amdgcn_s_setprio(1); _Pragma("unroll") for (int m = 0; m < 4; ++m) _Pragma("unroll") for (int n = 0; n < 2; ++n) _Pragma("unroll") for (int k = 0; k < 2; ++k) \
        acc[ai][bj][m][n] = __builtin_amdgcn_mfma_f32_16x16x32_bf16(Bt[n][k], At[m][k], acc[ai][bj][m][n], 0, 0, 0); __builtin_amdgcn_s_setprio(0); } while (0)
#define PG8_WAIT_V(n) asm volatile("s_waitcnt vmcnt(" #n ")" ::: "memory")
#define PG8_WAIT_L(n) asm volatile("s_waitcnt lgkmcnt(" #n ")" ::: "memory")
#define PG8_BAR __builtin_amdgcn_s_barrier()
#define PG8_SCHED __builtin_amdgcn_sched_barrier(0)
#define PG8_VOFF(dst, u) do { _Pragma("unroll") for (int _h = 0; _h < 2; ++_h) _Pragma("unroll") for (int _i = 0; _i < 2; ++_i) { \
        if constexpr (GATHER) dst[_h][_i] = (unsigned)(u).rows[_h * HALF + Rr[_i]] * (unsigned)(lda * 2) + (unsigned)(Cc[_i] * 2); \
        else dst[_h][_i] = (unsigned)(Rr[_i] * lda + Cc[_i]) * 2u; } } while (0)
#define PG8_STAGE_A(bufoff, gbase, h, vv) do { if constexpr (GATHER) { PG8_STAGE(bufoff, gbase, vv[h]); } else { PG8_STAGE(bufoff, (gbase) + (h) * hstepA, vv[0]); } } while (0)
    Unit cur, nxt; int ui = 0;
    if (!S.next(0, cur)) return;
    Acc acc;
#pragma unroll
    for (int a = 0; a < 2; ++a)
#pragma unroll
        for (int b = 0; b < 2; ++b)
#pragma unroll
            for (int m = 0; m < 4; ++m)
#pragma unroll
                for (int n = 0; n < 2; ++n) acc[a][b][m][n] = (f32x4){0.f, 0.f, 0.f, 0.f};
    bf16x8 At[4][2], B0[2][2], B1[2][2];
    const char* cA = uniform_ptr(cur.a); const char* cB = uniform_ptr(cur.b);
    PG8_VOFF(vA, cur);
    if constexpr (GATHER) { asm volatile("s_waitcnt vmcnt(0)" ::: "memory"); }
    PG8_STAGE(PG8_SB(0, 0), cB, voffB); PG8_STAGE(PG8_SB(0, 1), cB + hstepB, voffB); PG8_STAGE_A(PG8_SA(0, 0), cA, 0, vA); PG8_STAGE_A(PG8_SA(0, 1), cA, 1, vA);
    if (wr == 1) PG8_BAR;
    PG8_WAIT_V(2); PG8_BAR;
    PG8_STAGE(PG8_SB(1, 0), cB + kstep, voffB); PG8_STAGE_A(PG8_SA(1, 0), cA + kstep, 0, vA); PG8_STAGE(PG8_SB(1, 1), cB + hstepB + kstep, voffB);
    PG8_WAIT_V(6); PG8_BAR;
    for (;;) {
        const bool has_next = S.next(ui + 1, nxt);
        const char* nA = has_next ? uniform_ptr(nxt.a) : cA; const char* nB = has_next ? uniform_ptr(nxt.b) : cB;
        if constexpr (GATHER) { if (has_next) { PG8_VOFF(vN, nxt); } else {
#pragma unroll
            for (int h = 0; h < 2; ++h) { vN[h][0] = vA[h][0]; vN[h][1] = vA[h][1]; } } }
#pragma nounroll
        for (int t = 0; t < nt; t += 2) {
            const bool last = (t == nt - 2);
            if constexpr (Epi::HAS_MID) { if (t == E.mid_t()) E.mid(acc, cur, wr, wc, fr, fq); }
            const char* a1 = cA + (size_t)(t + 1) * kstep;
            const char* a2 = last ? nA : cA + (size_t)(t + 2) * kstep; const char* b2 = last ? nB : cB + (size_t)(t + 2) * kstep;
            const char* a3 = a2 + kstep; const char* b3 = b2 + kstep;
            unsigned vW[2][2];
#pragma unroll
            for (int h = 0; h < 2; ++h) { vW[h][0] = vA[h][0]; vW[h][1] = vA[h][1]; if constexpr (GATHER) { if (last) { vW[h][0] = vN[h][0]; vW[h][1] = vN[h][1]; } } }
            PG8_LDB(B0, 0, 0); PG8_LDB(B1, 0, 1); PG8_SCHED; PG8_LDA(At, 0, 0); PG8_STAGE_A(PG8_SA(1, 1), a1, 1, vA);
            PG8_WAIT_V(8); PG8_WAIT_L(0); PG8_BAR; PG8_MMA(0, 0, At, B0); PG8_MMA(0, 1, At, B1); PG8_BAR; PG8_SCHED;
            PG8_LDA(At, 0, 1); PG8_STAGE(PG8_SB(0, 0), b2, voffB); PG8_STAGE(PG8_SB(0, 1), b2 + hstepB, voffB); PG8_STAGE_A(PG8_SA(0, 0), a2, 0, vW);
            PG8_WAIT_V(8); PG8_WAIT_L(0); PG8_BAR; PG8_MMA(1, 0, At, B0); PG8_MMA(1, 1, At, B1); PG8_BAR; PG8_SCHED;
            PG8_LDB(B0, 1, 0); PG8_LDB(B1, 1, 1); PG8_SCHED; PG8_LDA(At, 1, 0); PG8_STAGE_A(PG8_SA(0, 1), a2, 1, vW);
            PG8_WAIT_V(8); PG8_WAIT_L(0); PG8_BAR; PG8_MMA(0, 0, At, B0); PG8_MMA(0, 1, At, B1); PG8_BAR; PG8_SCHED;
            PG8_LDA(At, 1, 1); PG8_STAGE(PG8_SB(1, 0), b3, voffB); PG8_STAGE(PG8_SB(1, 1), b3 + hstepB, voffB); PG8_STAGE_A(PG8_SA(1, 0), a3, 0, vW);
            PG8_WAIT_V(8); PG8_WAIT_L(0); PG8_BAR; PG8_MMA(1, 0, At, B0); PG8_MMA(1, 1, At, B1); PG8_BAR; PG8_SCHED;
        }
        if constexpr (ALIGN_EPI) { if (wr == 0) PG8_BAR; }
        E(acc, cur, wr, wc, fr, fq, lds, wid, lane);
        if (!has_next) break;
#pragma unroll
        for (int a = 0; a < 2; ++a)
#pragma unroll
            for (int b = 0; b < 2; ++b)
#pragma unroll
                for (int m = 0; m < 4; ++m)
#pragma unroll
                    for (int n = 0; n < 2; ++n) acc[a][b][m][n] = (f32x4){0.f, 0.f, 0.f, 0.f};
        cur = nxt; cA = nA; cB = nB; ++ui;
        if constexpr (GATHER) {
#pragma unroll
            for (int h = 0; h < 2; ++h) { vA[h][0] = vN[h][0]; vA[h][1] = vN[h][1]; } }
        if constexpr (ALIGN_EPI) { if (wr == 1) PG8_BAR; }
    }
    PG8_WAIT_V(0);
    if constexpr (!ALIGN_EPI) { if (wr == 0) PG8_BAR; }
    PG8_BAR;
#undef PG8_SA
#undef PG8_SB
#undef PG8_STAGE
#undef PG8_LDA
#undef PG8_LDB
#undef PG8_MMA
#undef PG8_WAIT_V
#undef PG8_WAIT_L
#undef PG8_BAR
#undef PG8_SCHED
#undef PG8_VOFF
#undef PG8_STAGE_A
}
}
#define XB_TMO      128
#define XB_XCNT(j)  (256  + 64 * (j))
#define XB_XSUB(j)  (1280 + 64 * (j))
#define XB_XGEN(j)  (2304 + 64 * (j))
#define XB_TOP      3328
#define XB_TOPGEN   3392
#define XCD_BAR_WORDS 3456
#define XB_SPIN_CAP (1u << 18)

__device__ __forceinline__ unsigned xb_ld(unsigned* p)              { return __hip_atomic_load(p, __ATOMIC_RELAXED, __HIP_MEMORY_SCOPE_AGENT); }
__device__ __forceinline__ unsigned xb_add(unsigned* p, unsigned v) { return __hip_atomic_fetch_add(p, v, __ATOMIC_RELAXED, __HIP_MEMORY_SCOPE_AGENT); }
__device__ __forceinline__ unsigned xb_xcc_id() { return (unsigned)__builtin_amdgcn_s_getreg((3 << 11) | 20) & 0xFu; }
#define XB_SPIN(cond, bar) do { unsigned _sp = 0; while (cond) { __builtin_amdgcn_s_sleep(1); \
    if ((++_sp & 255u) == 0u) { if (xb_ld(&(bar)[XB_TMO])) break; if (_sp > XB_SPIN_CAP) { atomicAdd(&(bar)[XB_TMO], 1u); break; } } } } while (0)

struct XcdBarrier {
    unsigned* bar; unsigned x;
    volatile LAS unsigned* st;
};

__device__ __forceinline__ XcdBarrier xcd_barrier_post(unsigned* bar, volatile LAS unsigned* st) {
    XcdBarrier b; b.bar = bar; b.x = xb_xcc_id(); b.st = st;
    if (threadIdx.x == 0) (void)xb_add(&bar[XB_XCNT(b.x)], 1u);
    return b;
}
__device__ __forceinline__ void xcd_barrier_complete(unsigned* bar, unsigned x, unsigned& nloc, unsigned& nx) {
    const unsigned G = gridDim.x * gridDim.y * gridDim.z;
    unsigned sum, cnt, mine, sp = 0u;
    for (;;) {
        sum = 0u; cnt = 0u; mine = 0u;
#pragma unroll
        for (unsigned j = 0; j < 16; ++j) { const unsigned c = xb_ld(&bar[XB_XCNT(j)]); sum += c; cnt += (c > 0u) ? 1u : 0u; mine = (j == x) ? c : mine; }
        if (sum == G) break;
        __builtin_amdgcn_s_sleep(1);
        if ((++sp & 255u) == 0u) { if (xb_ld(&bar[XB_TMO])) break; if (sp > XB_SPIN_CAP) { atomicAdd(&bar[XB_TMO], 1u); break; } }
    }
    nloc = mine > 0u ? mine : 1u; nx = cnt > 0u ? cnt : 1u;
}

__device__ __forceinline__ void xcd_barrier(const XcdBarrier& b) {
    asm volatile("s_waitcnt vmcnt(0)" ::: "memory");
    __syncthreads();
    if (threadIdx.x == 0) {
        unsigned* bar = b.bar;
        __builtin_amdgcn_s_waitcnt(0);
        unsigned nloc = b.st[0], nx = b.st[1];
        if (nloc == 0u) { xcd_barrier_complete(bar, b.x, nloc, nx); b.st[0] = nloc; b.st[1] = nx; }
        const unsigned old = xb_add(&bar[XB_XSUB(b.x)], 1u);
        const unsigned gen = old / nloc;
        if (old + 1u == (gen + 1u) * nloc) {
            __builtin_amdgcn_fence(__ATOMIC_RELEASE, "agent");
            asm volatile("s_waitcnt vmcnt(0)" ::: "memory");
            const unsigned og = xb_add(&bar[XB_TOP], 1u);
            const unsigned tg = og / nx;
            if (og + 1u == (tg + 1u) * nx) xb_add(&bar[XB_TOPGEN], 1u);
            else XB_SPIN(xb_ld(&bar[XB_TOPGEN]) == tg, bar);
            __builtin_amdgcn_fence(__ATOMIC_ACQUIRE, "agent");
            xb_add(&bar[XB_XGEN(b.x)], 1u);
            asm volatile("s_waitcnt vmcnt(0)" ::: "memory");
        } else {
            XB_SPIN(xb_ld(&bar[XB_XGEN(b.x)]) == gen, bar);
            __builtin_amdgcn_fence(__ATOMIC_ACQUIRE, "agent");
            asm volatile("s_waitcnt vmcnt(0)" ::: "memory");
        }
    }
    __syncthreads();
}

namespace pg8 {
#define EPI_NOMID static constexpr bool HAS_MID = false; __device__ __forceinline__ int mid_t() const { return -1; } __device__ __forceinline__ void mid(Acc&, const Unit&, int, int, int, int) const {}
#define RAW_BARRIER() do { asm volatile("s_waitcnt lgkmcnt(0)" ::: "memory"); __builtin_amdgcn_s_barrier(); asm volatile("" ::: "memory"); } while (0)

__device__ __forceinline__ u32x4 pack8(const f32x4& v0, const f32x4& v1) { u32x4 w; w.x = cvt_pk_bf16(v0[0], v0[1]); w.y = cvt_pk_bf16(v0[2], v0[3]); w.z = cvt_pk_bf16(v1[0], v1[1]); w.w = cvt_pk_bf16(v1[2], v1[3]); return w; }

struct GridOrder {
    const char* A; const char* Bt; int lda, ldb, nM, nN, nwg, G, c, dup;
    __device__ __forceinline__ void init(const void* A_, const void* Bt_, int lda_, int ldb_, int M, int N, int G_, int c_) { A = (const char*)A_; Bt = (const char*)Bt_; lda = lda_; ldb = ldb_; nM = M / BM; nN = N / BM; nwg = nM * nN; G = G_; c = c_; dup = 1; }
    __device__ __forceinline__ bool next(int i, Unit& u) const {
        const long L = (long)i * G + c; if (L >= (long)nwg * dup) return false;
        int wgid = (int)(L % nwg); { const int q = nwg / NXCD, r = nwg % NXCD, xcd = wgid % NXCD, off = wgid / NXCD; wgid = (xcd < r ? xcd * (q + 1) : r * (q + 1) + (xcd - r) * q) + off; }
        const int nig = WGM * nN, gid = wgid / nig, fm = gid * WGM, gsz = (nM - fm) < WGM ? (nM - fm) : WGM;
        u.pm = fm + ((wgid % nig) % gsz); u.pn = (wgid % nig) / gsz; u.x0 = 0; u.x1 = 0; u.rows = nullptr;
        u.a = A + (size_t)u.pm * BM * lda * 2; u.b = Bt + (size_t)u.pn * BM * ldb * 2; return true;
    }
};
struct KvOrder {
    const char* memn; const char* wk; const char* wv; int G, c;
    __device__ __forceinline__ bool next(int i, Unit& u) const {
        const int L = i * G + c; if (L >= 128) return false;
        u.rows = nullptr; u.x1 = 0;
        if (L < 64) { u.pm = L >> 2; u.pn = L & 3; u.x0 = 0; u.a = memn + (size_t)u.pm * BM * D * 2; u.b = wk + (size_t)u.pn * BM * D * 2; }
        else { const int l = L - 64; u.pm = l >> 4; u.pn = l & 15; u.x0 = 1; u.a = wv + (size_t)u.pm * BM * D * 2; u.b = memn + (size_t)u.pn * BM * D * 2; }
        return true;
    }
};
template <int MODE> struct XaOrder {
    const char* A; const char* B; int G, c;
    __device__ __forceinline__ bool next(int i, Unit& u) const {
        const int L = i * G + c; if (L >= NB * XH * 16) return false;
        const int qt = L & 15, bh = L >> 4, b = bh >> 2, h = bh & 3;
        u.pm = b * 16 + qt; u.pn = h; u.x0 = 0; u.x1 = 0; u.rows = nullptr;
        u.a = A + ((size_t)u.pm * BM * D + h * XHD) * 2;
        if (MODE == 0) u.b = B + ((size_t)b * MEML * D + h * XHD) * 2;
        else u.b = B + ((size_t)h * XHD * MROWS + b * MEML) * 2;
        return true;
    }
};
template <int MODE> struct MoeOrder {
    const char* A; const char* W; const int* rowtok; const int* etile; int G, c, dup;
    __device__ __forceinline__ bool next(int i, Unit& u) const {
        int L = i * G + c; const int ntile = etile[NE];
        if (L >= ntile * 4 * dup) return false;
        L %= ntile * 4;
        const int rt = L >> 2, ct = L & 3; int e = 0;
        for (int j = 1; j < NE; ++j) e = (etile[j] <= rt) ? j : e;
        u.pm = rt; u.pn = ct; u.x0 = e; u.x1 = 0;
        if (MODE == 0) { u.a = A; u.rows = rowtok + rt * BM; u.b = W + ((size_t)e * 1024 + ct * BM) * D * 2; }
        else { u.a = A + (size_t)rt * BM * FF * 2; u.rows = nullptr; u.b = W + ((size_t)e * 1024 + ct * BM) * FF * 2; }
        return true;
    }
};

struct EpiU {
    static constexpr bool PERM = true; EPI_NOMID
    bf16_t* Cb; bf16_t* Q; bf16_t* Kb; bf16_t* V; const float* ropec; const float* ropes;
    __device__ __forceinline__ void operator()(Acc& acc, const Unit& u, int wr, int wc, int fr, int fq, LAS unsigned char*, int, int) const {
        const int row0 = u.pm * BM + wr * 64 + fr;
        if (u.pn < 2) {
#pragma unroll
            for (int ai = 0; ai < 2; ++ai)
#pragma unroll
                for (int m = 0; m < 4; ++m) { const int row = row0 + ai * HALF + m * 16; f32x4 o[2];
#pragma unroll
                    for (int n = 0; n < 2; ++n)
#pragma unroll
                        for (int i = 0; i < 4; ++i) { const float a = acc[ai][0][m][n][i], g = acc[ai][1][m][n][i]; o[n][i] = a / (1.f + __expf(-g)); }
                    *(u32x4*)(Cb + (size_t)row * CCH + u.pn * HALF + wc * 32 + fq * 8) = pack8(o[0], o[1]); }
        } else if (u.pn < 8) {
            const int sec = (u.pn - 2) / 3, tt = (u.pn - 2) % 3; bf16_t* dst = sec ? Kb : Q; const float sc = sec ? 1.f : 0.125f * LOG2E;
            const int colb = (4 * tt + wc) * HD + fq * 8;
#pragma unroll
            for (int ai = 0; ai < 2; ++ai)
#pragma unroll
                for (int m = 0; m < 4; ++m) { const int row = row0 + ai * HALF + m * 16; const int s = row & (SEQ - 1); f32x4 o1[2], o2[2];
#pragma unroll
                    for (int n = 0; n < 2; ++n) { const f32x4 cs = *(const f32x4*)(ropec + s * 32 + fq * 8 + n * 4), sn = *(const f32x4*)(ropes + s * 32 + fq * 8 + n * 4);
                        const f32x4 x1 = acc[ai][0][m][n], x2 = acc[ai][1][m][n];
                        o1[n] = (x1 * cs - x2 * sn) * sc; o2[n] = (x1 * sn + x2 * cs) * sc; }
                    bf16_t* p = dst + (size_t)row * AW + colb;
                    *(u32x4*)p = pack8(o1[0], o1[1]); *(u32x4*)(p + 32) = pack8(o2[0], o2[1]); }
        } else {
            const int tt = u.pn - 8;
#pragma unroll
            for (int ai = 0; ai < 2; ++ai)
#pragma unroll
                for (int m = 0; m < 4; ++m) { const int row = row0 + ai * HALF + m * 16;
#pragma unroll
                    for (int bj = 0; bj < 2; ++bj) *(u32x4*)(V + (size_t)row * AW + tt * BM + bj * HALF + wc * 32 + fq * 8) = pack8(acc[ai][bj][m][0], acc[ai][bj][m][1]); }
        }
    }
};
template <bool ROWSCALE> struct EpiPlain {
    static constexpr bool PERM = true; EPI_NOMID
    bf16_t* O0; int ldc0; bf16_t* O1; int ldc1; const float* ssq16;
    __device__ __forceinline__ void operator()(Acc& acc, const Unit& u, int wr, int wc, int fr, int fq, LAS unsigned char*, int, int) const {
        bf16_t* O = u.x0 ? O1 : O0; const int ldc = u.x0 ? ldc1 : ldc0;
        const int row0 = u.pm * BM + wr * 64 + fr, col0 = u.pn * BM + wc * 32 + fq * 8;
#pragma unroll
        for (int ai = 0; ai < 2; ++ai)
#pragma unroll
            for (int m = 0; m < 4; ++m) { const int row = row0 + ai * HALF + m * 16; float rs = 1.f;
                if constexpr (ROWSCALE) { const f32x4* sp = (const f32x4*)(ssq16 + (size_t)row * 16); const f32x4 s0 = sp[0], s1 = sp[1], s2 = sp[2], s3 = sp[3];
                    const f32x4 st = (s0 + s1) + (s2 + s3); rs = 1.0f / sqrtf(((st[0] + st[1]) + (st[2] + st[3])) * (1.0f / D) + NORM_EPS); }
#pragma unroll
                for (int bj = 0; bj < 2; ++bj) *(u32x4*)(O + (size_t)row * ldc + col0 + bj * HALF) = pack8(acc[ai][bj][m][0] * rs, acc[ai][bj][m][1] * rs); }
    }
};
template <bool MID> struct EpiResid {
    static constexpr bool PERM = false, HAS_MID = MID;
    const float* xin; bf16_t* XB; float* ssqp; const float* ssqa;
    __device__ __forceinline__ int mid_t() const { return AW / BK; }
    __device__ __forceinline__ void mid(Acc& acc, const Unit& u, int wr, int wc, int fr, int fq) const {
        const int row0 = u.pm * BM + wr * 64 + fr;
#pragma unroll
        for (int ai = 0; ai < 2; ++ai)
#pragma unroll
            for (int m = 0; m < 4; ++m) { const int row = row0 + ai * HALF + m * 16; const f32x4* sp = (const f32x4*)(ssqa + (size_t)row * NH);
                const f32x4 s0 = sp[0], s1 = sp[1], s2 = sp[2]; const f32x4 st = (s0 + s1) + s2;
                const float r = 1.0f / sqrtf(((st[0] + st[1]) + (st[2] + st[3])) * (1.0f / AW) + NORM_EPS);
#pragma unroll
                for (int bj = 0; bj < 2; ++bj)
#pragma unroll
                    for (int n = 0; n < 2; ++n) acc[ai][bj][m][n] = acc[ai][bj][m][n] * r;
                asm volatile("" ::: "memory"); }
    }
    __device__ __forceinline__ void operator()(Acc& acc, const Unit& u, int wr, int wc, int fr, int fq, LAS unsigned char*, int, int) const {
        const int row0 = u.pm * BM + wr * 64 + fr, col0 = u.pn * BM + wc * 32 + fq * 4;
#pragma unroll
        for (int ai = 0; ai < 2; ++ai)
#pragma unroll
            for (int m = 0; m < 4; ++m) { const int row = row0 + ai * HALF + m * 16; float ss = 0.f;
#pragma unroll
                for (int bj = 0; bj < 2; ++bj)
#pragma unroll
                    for (int n = 0; n < 2; ++n) { const size_t o = (size_t)row * D + col0 + bj * HALF + n * 16; f32x4 v;
                        if constexpr (MID) v = *(const f32x4*)(xin + o) + acc[ai][bj][m][n];
                        else { const u32x2 xb = *(const u32x2*)(XB + o); v = (f32x4){bflo(xb.x), bfhi(xb.x), bflo(xb.y), bfhi(xb.y)} + acc[ai][bj][m][n]; }
                        u32x2 w; w.x = cvt_pk_bf16(v[0], v[1]); w.y = cvt_pk_bf16(v[2], v[3]); *(u32x2*)(XB + o) = w;
                        ss += (v[0] * v[0] + v[1] * v[1]) + (v[2] * v[2] + v[3] * v[3]); }
                ss += __shfl_xor(ss, 16); ss += __shfl_xor(ss, 32);
                if (fq == 0) ssqp[(size_t)row * 16 + u.pn * 4 + wc] = ss; }
    }
};
struct EpiSoftmax {
    static constexpr bool PERM = true; EPI_NOMID
    bf16_t* PM;
    __device__ __forceinline__ void operator()(Acc& acc, const Unit& u, int wr, int wc, int fr, int fq, LAS unsigned char* lds, int, int) const {
        LAS float* MX = (LAS float*)(lds + XCH_OFF); LAS float* SM = (LAS float*)(lds + XCH_OFF + 4096);
#pragma unroll
        for (int ai = 0; ai < 2; ++ai)
#pragma unroll
            for (int m = 0; m < 4; ++m) { const int rl = ai * HALF + wr * 64 + m * 16 + fr; float mx = -3.0e38f;
#pragma unroll
                for (int bj = 0; bj < 2; ++bj)
#pragma unroll
                    for (int n = 0; n < 2; ++n) { const f32x4 v = acc[ai][bj][m][n]; mx = fmaxf(mx, fmaxf(fmaxf(v[0], v[1]), fmaxf(v[2], v[3]))); }
                mx = fmaxf(mx, __shfl_xor(mx, 16)); mx = fmaxf(mx, __shfl_xor(mx, 32));
                if (fq == 0) MX[rl * 4 + wc] = mx; }
        RAW_BARRIER();
#pragma unroll
        for (int ai = 0; ai < 2; ++ai)
#pragma unroll
            for (int m = 0; m < 4; ++m) { const int rl = ai * HALF + wr * 64 + m * 16 + fr; const f32x4 mm = *(const LAS f32x4*)(MX + rl * 4);
                const float mx = fmaxf(fmaxf(mm[0], mm[1]), fmaxf(mm[2], mm[3])); float ss = 0.f;
#pragma unroll
                for (int bj = 0; bj < 2; ++bj)
#pragma unroll
                    for (int n = 0; n < 2; ++n) { f32x4 v = acc[ai][bj][m][n];
#pragma unroll
                        for (int i = 0; i < 4; ++i) { v[i] = __builtin_amdgcn_exp2f(v[i] - mx); ss += v[i]; }
                        acc[ai][bj][m][n] = v; }
                ss += __shfl_xor(ss, 16); ss += __shfl_xor(ss, 32);
                if (fq == 0) SM[rl * 4 + wc] = ss; }
        RAW_BARRIER();
        const int col0 = u.pn * BM + wc * 32 + fq * 8;
#pragma unroll
        for (int ai = 0; ai < 2; ++ai)
#pragma unroll
            for (int m = 0; m < 4; ++m) { const int rl = ai * HALF + wr * 64 + m * 16 + fr; const f32x4 s4 = *(const LAS f32x4*)(SM + rl * 4);
                const float inv = 1.0f / ((s4[0] + s4[1]) + (s4[2] + s4[3]));
#pragma unroll
                for (int bj = 0; bj < 2; ++bj) *(u32x4*)(PM + (size_t)(u.pm * BM + rl) * D + col0 + bj * HALF) = pack8(acc[ai][bj][m][0] * inv, acc[ai][bj][m][1] * inv); }
    }
};
struct EpiMoe1 {
    static constexpr bool PERM = true; EPI_NOMID
    bf16_t* HID; const float* slot_rs;
    __device__ __forceinline__ void operator()(Acc& acc, const Unit& u, int wr, int wc, int fr, int fq, LAS unsigned char*, int, int) const {
        const int row0 = u.pm * BM + wr * 64 + fr;
#pragma unroll
        for (int ai = 0; ai < 2; ++ai)
#pragma unroll
            for (int m = 0; m < 4; ++m) { const int row = row0 + ai * HALF + m * 16; const float rs = slot_rs[row]; f32x4 o[2];
#pragma unroll
                for (int n = 0; n < 2; ++n)
#pragma unroll
                    for (int i = 0; i < 4; ++i) { const float a = acc[ai][0][m][n][i] * rs, b = acc[ai][1][m][n][i] * rs; o[n][i] = a * b / (1.f + __expf(-a)); }
                *(u32x4*)(HID + (size_t)row * FF + u.pn * HALF + wc * 32 + fq * 8) = pack8(o[0], o[1]); }
    }
};
struct EpiMoe2 {
    static constexpr bool PERM = true; EPI_NOMID
    bf16_t* Y; const float* slot_gate;
    __device__ __forceinline__ void operator()(Acc& acc, const Unit& u, int wr, int wc, int fr, int fq, LAS unsigned char*, int, int) const {
        const int row0 = u.pm * BM + wr * 64 + fr, col0 = u.pn * BM + wc * 32 + fq * 8;
#pragma unroll
        for (int ai = 0; ai < 2; ++ai)
#pragma unroll
            for (int m = 0; m < 4; ++m) { const int row = row0 + ai * HALF + m * 16; const float g = slot_gate[row];
#pragma unroll
                for (int bj = 0; bj < 2; ++bj) *(u32x4*)(Y + (size_t)row * D + col0 + bj * HALF) = pack8(acc[ai][bj][m][0] * g, acc[ai][bj][m][1] * g); }
    }
};
}
struct Frame {
    LAS unsigned char* lds;
    volatile LAS unsigned* MISC;
    unsigned* ctl;
    unsigned char* ws;
    int wave, vcu, G;
};
struct Args { const void* in[27]; float* out; unsigned char* ws; int ph_lo, ph_hi, li, pad; };

__device__ __forceinline__ void tr_item(const float* W, int ldw, int srcrow0, int srccol0, bf16_t* WT, int dpitch, size_t drow0, int dk0, const float* gk, float sc, LAS float* scr, int lane) {
#pragma unroll 8
    for (int i = 0; i < 32; ++i) { const int kk = 2 * i + (lane >> 5); const float g = gk ? gk[kk] * sc : sc;
        scr[kk * 33 + (lane & 31)] = W[(size_t)(srcrow0 + kk) * ldw + srccol0 + (lane & 31)] * g; }
    LDS_WAIT(); asm volatile("" ::: "memory");
    const int c = lane & 7;
#pragma unroll
    for (int j = 0; j < 4; ++j) { const int n = (lane >> 3) + 8 * j; const LAS float* s = scr + (8 * c) * 33 + n;
        u32x4 o; o.x = pk2(s[0 * 33], s[1 * 33]); o.y = pk2(s[2 * 33], s[3 * 33]); o.z = pk2(s[4 * 33], s[5 * 33]); o.w = pk2(s[6 * 33], s[7 * 33]);
        *(u32x4*)(WT + (drow0 + n) * dpitch + dk0 + 8 * c) = o; }
    LDS_WAIT(); asm volatile("" ::: "memory");
}
__device__ __forceinline__ void rms_row_to_bf16(const float* xrow, const float* g, bf16_t* orow, int lane) {
    const f32x4* xr = (const f32x4*)xrow + lane; const f32x4* gr = (const f32x4*)g + lane;
    f32x4 v[4]; float s = 0.f;
#pragma unroll
    for (int j = 0; j < 4; ++j) { v[j] = xr[64 * j]; s += (v[j][0] * v[j][0] + v[j][1] * v[j][1]) + (v[j][2] * v[j][2] + v[j][3] * v[j][3]); }
    const float rs = 1.0f / sqrtf(wave_sum(s) * (1.f / D) + NORM_EPS);
    u32x2* o8 = (u32x2*)orow + lane;
#pragma unroll
    for (int j = 0; j < 4; ++j) { const f32x4 gg = gr[64 * j]; u32x2 w; w.x = pk2(v[j][0] * rs * gg[0], v[j][1] * rs * gg[1]); w.y = pk2(v[j][2] * rs * gg[2], v[j][3] * rs * gg[3]); o8[64 * j] = w; }
}
__device__ __forceinline__ double rope_inv(int d) {
    const int q = d >> 3, r = d & 7;
    double b = 1.0;
    b = (r == 1) ? 0.7498942093324558273 : b; b = (r == 2) ? 0.56234132519034908039 : b; b = (r == 3) ? 0.42169650342858224857 : b; b = (r == 4) ? 0.3162277660168379332 : b;
    b = (r == 5) ? 0.23713737056616552617 : b; b = (r == 6) ? 0.17782794100389228012 : b; b = (r == 7) ? 0.13335214321633240257 : b;
    const double p = (q == 0) ? 1.0 : (q == 1) ? 0.1 : (q == 2) ? 0.01 : 0.001;
    return b * p;
}
__device__ __forceinline__ void sincos_d(double a, double& sn, double& cs) {
    const double k = __builtin_rint(a * 0.63661977236758134308);
    double y = __builtin_fma(-k, 1.57079632679489655800e+00, a); y = __builtin_fma(-k, 6.12323399573676603587e-17, y);
    const double y2 = y * y;
    double s = 1.0 / 6227020800.0; s = s * y2 - 1.0 / 39916800.0; s = s * y2 + 1.0 / 362880.0; s = s * y2 - 1.0 / 5040.0; s = s * y2 + 1.0 / 120.0; s = s * y2 - 1.0 / 6.0; s = s * y2 * y + y;
    double c = 1.0 / 479001600.0; c = c * y2 - 1.0 / 3628800.0; c = c * y2 + 1.0 / 40320.0; c = c * y2 - 1.0 / 720.0; c = c * y2 + 1.0 / 24.0; c = c * y2 - 0.5; c = c * y2 + 1.0;
    const int qd = ((int)k) & 3;
    sn = (qd == 0) ? s : (qd == 1) ? c : (qd == 2) ? -s : -c;
    cs = (qd == 0) ? c : (qd == 1) ? -s : (qd == 2) ? -c : s;
}
typedef const void* gen_cptr;
typedef __attribute__((address_space(4))) const char* cas_cptr;
typedef __attribute__((address_space(4))) const gen_cptr* cas_pptr;
__device__ __forceinline__ const void* karg_ptr(int byte_off) { cas_cptr p = (cas_cptr)__builtin_amdgcn_kernarg_segment_ptr(); asm volatile("" : "+s"(p)); return *(cas_pptr)(p + byte_off); }
__device__ __forceinline__ void p0_prologue(Frame& F) {
    const int lane = lane_id(), tid = F.wave * 64 + lane;
    const float* x = (const float*)karg_ptr(8 * 0); const float* mem = (const float*)karg_ptr(8 * 1); const int* positions = (const int*)karg_ptr(8 * 2);
    const float* mix_g = (const float*)karg_ptr(8 * 3); const float* w_in = (const float*)karg_ptr(8 * 4);
    const float* attn_out_g = (const float*)karg_ptr(8 * 10); const float* w_out = (const float*)karg_ptr(8 * 11);
    const float* xattn_g = (const float*)karg_ptr(8 * 12); const float* mem_g = (const float*)karg_ptr(8 * 13);
    const float* w_xq = (const float*)karg_ptr(8 * 14); const float* w_xk = (const float*)karg_ptr(8 * 15); const float* w_xv = (const float*)karg_ptr(8 * 16); const float* w_xo = (const float*)karg_ptr(8 * 17);
    const float* moe_g = (const float*)karg_ptr(8 * 18); const float* w_group = (const float*)karg_ptr(8 * 19); const float* w_router = (const float*)karg_ptr(8 * 21);
    const float* w1 = (const float*)karg_ptr(8 * 23); const float* w3 = (const float*)karg_ptr(8 * 24); const float* w2 = (const float*)karg_ptr(8 * 25);
    unsigned char* ws = F.ws;
    LAS float* scr = (LAS float*)(F.lds + F.wave * 16384);
    const int gw = F.vcu * NWAVES + F.wave, NGW = F.G * NWAVES;
    constexpr int I_IN = 16 * 88, I_SQ = 16 * 32, I_13 = NE * 16 * 32, I_2 = NE * 8 * 32;
    constexpr int NITEMS = I_IN + 5 * I_SQ + I_13 + I_2;
    for (int it = gw; it < NITEMS; it += NGW) {
        int r = it;
        if (r < I_IN) { const int kb = r / 88, nb = r % 88, n0 = 32 * nb, tile = n0 >> 8, j = n0 & 255; int src;
            if (tile < 2) src = (j < 128) ? 128 * tile + j : 256 + 128 * tile + (j - 128);
            else if (tile < 8) { const int sec = (tile - 2) / 3, tt = (tile - 2) % 3, jj = j & 127, hh = jj >> 5; src = 512 + 768 * sec + 256 * tt + 64 * hh + ((j < 128) ? 0 : 32); }
            else src = n0;
            tr_item(w_in, INW, 64 * kb, src, (bf16_t*)(ws + WS_WIN), D, (size_t)n0, 64 * kb, nullptr, 1.f, scr, lane); continue; }
        r -= I_IN;
        if (r < I_SQ) { const int kb = r / 32, nb = r % 32, dk0 = 64 * kb; const bool at = dk0 < AW;
            tr_item(w_out, D, at ? CCH + dk0 : dk0 - AW, 32 * nb, (bf16_t*)(ws + WS_WOUT), D, (size_t)(32 * nb), dk0, at ? attn_out_g + dk0 : nullptr, 1.f, scr, lane); continue; }
        r -= I_SQ;
        if (r < 4 * I_SQ) { const int which = r / I_SQ, r2 = r % I_SQ, kb = r2 / 32, nb = r2 % 32;
            const float* W = which == 0 ? w_xq : which == 1 ? w_xk : which == 2 ? w_xv : w_xo;
            bf16_t* WT = (bf16_t*)(ws + (which == 0 ? WS_WXQ : which == 1 ? WS_WXK : which == 2 ? WS_WXV : WS_WXO));
            tr_item(W, D, 64 * kb, 32 * nb, WT, D, (size_t)(32 * nb), 64 * kb, which == 0 ? xattn_g + 64 * kb : nullptr, which == 0 ? LOG2E / 16.f : 1.f, scr, lane); continue; }
        r -= 4 * I_SQ;
        if (r < I_13) { const int e = r / 512, r2 = r % 512, kb = r2 / 32, nb = r2 % 32, n0 = 32 * nb, tt = n0 >> 8, j = n0 & 255;
            const float* W = ((j < 128) ? w1 : w3) + (size_t)e * D * FF;
            tr_item(W, FF, 64 * kb, 128 * tt + (j & 127), (bf16_t*)(ws + WS_W13), D, (size_t)e * 1024 + n0, 64 * kb, moe_g + 64 * kb, 1.f, scr, lane); continue; }
        r -= I_13;
        { const int e = r / 256, r2 = r % 256, kb = r2 / 32, nb = r2 % 32;
            tr_item(w2 + (size_t)e * FF * D, D, 64 * kb, 32 * nb, (bf16_t*)(ws + WS_W2), FF, (size_t)e * 1024 + 32 * nb, 64 * kb, nullptr, 1.f, scr, lane); }
    }
    { bf16_t* WRF = (bf16_t*)(ws + WS_HIST + HIST_WR);
      for (int i = blockIdx.x * 512 + tid; i < 4 * 8 * 3 * 2 * 64 * 8; i += F.G * 512) {
          const int j = i & 7, ln = (i >> 3) & 63, part = (i >> 9) & 1, blk = i >> 10, nt = blk % 3, s = (blk / 3) & 7, kc = blk / 24;
          const int k = 256 * kc + 32 * s + 8 * (ln >> 4) + j, o = 16 * nt + (ln & 15);
          float v = 0.f; if (o < 32) v = w_router[k * 32 + o] * moe_g[k]; else if (o < 36) v = w_group[k * 4 + (o - 32)] * moe_g[k];
          const unsigned hb = f2bf(v); const float hf = __builtin_bit_cast(float, hb << 16);
          WRF[i] = (bf16_t)(part ? f2bf(v - hf) : hb); } }
    { float* rc = (float*)(ws + WS_ROPE); float* rsn = rc + SEQ * 32;
      for (int i = blockIdx.x * 512 + tid; i < SEQ * 32; i += F.G * 512) { const int s = i >> 5, d = i & 31;
          const float inv = (float)rope_inv(d); const float ang = (float)positions[s] * inv; double sn, cs; sincos_d((double)fabsf(ang), sn, cs); if (ang < 0.f) sn = -sn;
          rc[i] = (float)cs; rsn[i] = (float)sn; } }
    for (int m = gw; m < MROWS; m += NGW) rms_row_to_bf16(mem + (size_t)m * D, mem_g, (bf16_t*)(ws + WS_MEMN) + (size_t)m * D, lane);
    for (int m = gw; m < T; m += NGW) rms_row_to_bf16(x + (size_t)m * D, mix_g, (bf16_t*)(ws + WS_R1) + (size_t)m * D, lane);
}
namespace att {
typedef short v4i16_t __attribute__((ext_vector_type(4)));
constexpr int BUFB = 65536, VIMG = 32768;
constexpr float NEG = -1.0e30f, MFLOOR = -1.0e9f;
__device__ __forceinline__ int k_off(int row, int c) { return row * 128 + ((c ^ ((row >> 1) & 7)) << 4); }
__device__ __forceinline__ int v_off(int row, int c) { return VIMG + row * 128 + ((c ^ (((row >> 1) & 3) << 1)) << 4); }

struct Grp { bf16x8 q0, q1; f32x4 o[4]; float m, l; };
struct KV { bf16x8 k[2][2]; bf16x8 v[4]; };

#ifdef ATT_SHFL
__device__ __forceinline__ float xmax16(float v) { return fmaxf(v, __shfl_xor(v, 16)); }
__device__ __forceinline__ float xmax32(float v) { return fmaxf(v, __shfl_xor(v, 32)); }
__device__ __forceinline__ float xsum16(float v) { return v + __shfl_xor(v, 16); }
__device__ __forceinline__ float xsum32(float v) { return v + __shfl_xor(v, 32); }
#else
__device__ __forceinline__ void swap16(float v, float& a, float& b) { a = v; b = v; asm volatile("s_nop 1\n\tv_permlane16_swap_b32 %0, %1" : "+v"(a), "+v"(b)); }
__device__ __forceinline__ void swap32(float v, float& a, float& b) { a = v; b = v; asm volatile("s_nop 1\n\tv_permlane32_swap_b32 %0, %1" : "+v"(a), "+v"(b)); }
__device__ __forceinline__ float xmax16(float v) { float a, b; swap16(v, a, b); return fmaxf(a, b); }
__device__ __forceinline__ float xmax32(float v) { float a, b; swap32(v, a, b); return fmaxf(a, b); }
__device__ __forceinline__ float xsum16(float v) { float a, b; swap16(v, a, b); return a + b; }
__device__ __forceinline__ float xsum32(float v) { float a, b; swap32(v, a, b); return a + b; }
#endif
constexpr int NSTEP_ = 19;
__device__ __forceinline__ int step_pos(int step, int row, int c0) {
    if (step < 3) { const int hh = row >> 7, jj = row & 127; return c0 + 256 * hh - 64 + 128 * step + jj; }
    if (step < 9) { const int s = step - 3, hh = row >> 7, c = (row >> 5) & 3, jj = row & 31; return 4 * ((c0 >> 2) + 64 * hh - 64 + 32 * s + jj) + c; }
    { const int s = step - 9, pb = s >> 1, rh = s & 1, rr = row >> 5, jj = row & 31; return 16 * ((c0 >> 4) - 64 + 32 * pb + jj) + 8 * rh + rr; }
}
__device__ __forceinline__ void stage_issue(unsigned ldsbuf, const char* Kg, const char* Vg, int brow0, int hcol, int c0, int step, int wave, int lane) {
    const bool isV = wave >= 4; const char* gb = pg8::uniform_ptr(isV ? Vg : Kg);
#pragma unroll
    for (int i = 0; i < 8; ++i) { const int blk = (wave & 3) * 8 + i, row = 8 * blk + (lane >> 3), phys = lane & 7;
        const int c = isV ? (phys ^ (((row >> 1) & 3) << 1)) : (phys ^ ((row >> 1) & 7));
        int pos = step_pos(step, row, c0); pos = pos < 0 ? 0 : (pos > SEQ - 1 ? SEQ - 1 : pos);
        const unsigned voff = (unsigned)((brow0 + pos) * AW + hcol + c * 8) * 2u;
        pg8::glds16_sv(gb, voff, ldsbuf + (isV ? (unsigned)VIMG : 0u) + (unsigned)blk * 1024u); __builtin_amdgcn_sched_barrier(0); }
}
struct LaneOff { int kb0; int vb[4]; };
__device__ __forceinline__ void lane_off(LaneOff& o, int lane) {
    const int key = lane & 15, g = lane >> 4, q = (lane >> 2) & 3, p2 = lane & 3;
    o.kb0 = k_off(key, g);
#pragma unroll
    for (int db = 0; db < 4; ++db) o.vb[db] = v_off(4 * g + q, 2 * db + (p2 >> 1)) + 8 * (p2 & 1);
}
__device__ __forceinline__ const LAS unsigned char* row_base(const LAS unsigned char* buf, int Rb) {
    return (const LAS unsigned char*)(uintptr_t)(unsigned)__builtin_amdgcn_readfirstlane((int)((unsigned)(uintptr_t)buf + (unsigned)(Rb * 128))); }
__device__ __forceinline__ void load_k(bf16x8 (&k)[2][2], const LAS unsigned char* buf, int Rb, const LaneOff& lo) {
    const LAS unsigned char* rb = row_base(buf, Rb);
#pragma unroll
    for (int t = 0; t < 2; ++t) { k[t][0] = *(const LAS bf16x8*)(rb + t * 2048 + lo.kb0); k[t][1] = *(const LAS bf16x8*)(rb + t * 2048 + (lo.kb0 ^ 64)); }
}
__device__ __forceinline__ void load_v(bf16x8 (&v)[4], const LAS unsigned char* buf, int Rb, const LaneOff& lo) {
    const LAS unsigned char* rb = row_base(buf, Rb);
#pragma unroll
    for (int db = 0; db < 4; ++db) {
        const s16x4 v0 = __builtin_bit_cast(s16x4, __builtin_amdgcn_ds_read_tr16_b64_v4i16((LAS v4i16_t*)(rb + lo.vb[db])));
        const s16x4 v1 = __builtin_bit_cast(s16x4, __builtin_amdgcn_ds_read_tr16_b64_v4i16((LAS v4i16_t*)(rb + 2048 + lo.vb[db])));
        v[db] = (bf16x8){v0[0], v0[1], v0[2], v0[3], v1[0], v1[1], v1[2], v1[3]}; }
}
__device__ __forceinline__ float fmax_nc(float a, float b) { float r; asm("v_max_f32_e32 %0, %1, %2" : "=v"(r) : "v"(a), "v"(b)); return r; }
__device__ __forceinline__ float fmax3_nc(float a, float b, float c) { float r; asm("v_max3_f32 %0, %1, %2, %3" : "=v"(r) : "v"(a), "v"(b), "v"(c)); return r; }
__device__ __forceinline__ void qk_part(const Grp& G, const bf16x8 (&k)[2][2], f32x4 (&s)[2]) {
#pragma unroll
    for (int t = 0; t < 2; ++t) { f32x4 z = (f32x4){0.f, 0.f, 0.f, 0.f};
        z = __builtin_amdgcn_mfma_f32_16x16x32_bf16(k[t][0], G.q0, z, 0, 0, 0); s[t] = __builtin_amdgcn_mfma_f32_16x16x32_bf16(k[t][1], G.q1, z, 0, 0, 0); }
}
template <bool FULL, bool INR>
__device__ __forceinline__ void sm_part(Grp& G, f32x4 (&s)[2], int ksub0, int qsub, int L, int lane, bf16x8& pb, float& alpha) {
    const int g = lane >> 4;
    if constexpr (!FULL) { const int d0 = ksub0 + 4 * g - qsub + 64, k0 = ksub0 + 4 * g;
#pragma unroll
        for (int t = 0; t < 2; ++t)
#pragma unroll
            for (int i = 0; i < 4; ++i) { bool ok = ((unsigned)(d0 + 16 * t + i) <= 128u); if constexpr (!INR) ok = ok && ((unsigned)(k0 + 16 * t + i) < (unsigned)L); s[t][i] = ok ? s[t][i] : NEG; } }
    float mx = fmax3_nc(fmax3_nc(s[0][0], s[0][1], s[0][2]), fmax3_nc(s[0][3], s[1][0], s[1][1]), fmax3_nc(s[1][2], s[1][3], G.m));
    { float a, b; swap16(mx, a, b); mx = fmax_nc(a, b); swap32(mx, a, b); mx = fmax_nc(a, b); }
    const float mn = mx; alpha = __builtin_amdgcn_exp2f(G.m - mn);
    G.m = mn; float p[2][4]; float ps = 0.f;
#pragma unroll
    for (int t = 0; t < 2; ++t)
#pragma unroll
        for (int i = 0; i < 4; ++i) { const float e = __builtin_amdgcn_exp2f(s[t][i] - mn); p[t][i] = e; ps += e; }
    G.l = G.l * alpha + ps;
    u32x4 pw; pw.x = cvt_pk_bf16(p[0][0], p[0][1]); pw.y = cvt_pk_bf16(p[0][2], p[0][3]); pw.z = cvt_pk_bf16(p[1][0], p[1][1]); pw.w = cvt_pk_bf16(p[1][2], p[1][3]);
    pb = __builtin_bit_cast(bf16x8, pw);
}
__device__ __forceinline__ void pv_part(Grp& G, const bf16x8 (&v)[4], const bf16x8& pb, float alpha) {
#pragma unroll
    for (int db = 0; db < 4; ++db) G.o[db] = __builtin_amdgcn_mfma_f32_16x16x32_bf16(v[db], pb, G.o[db] * alpha, 0, 0, 0);
}
__device__ __forceinline__ void grp_init(Grp& G, const bf16_t* Qb, size_t tok0, int hcol, int lane) {
    const int a = lane & 15, g = lane >> 4; const bf16_t* qp = Qb + (tok0 + 16 * a) * AW + hcol + 8 * g;
    G.q0 = *(const bf16x8*)qp; G.q1 = *(const bf16x8*)(qp + 32);
#pragma unroll
    for (int d = 0; d < 4; ++d) G.o[d] = (f32x4){0.f, 0.f, 0.f, 0.f};
    G.m = MFLOOR; G.l = 0.f;
}
__device__ __forceinline__ void grp_finish(Grp& G, bf16_t* MIX, float* ssqa, size_t tok0, int h, int lane) {
    const int a = lane & 15, g = lane >> 4; float l = G.l; l = xsum16(l); l = xsum32(l);
    const float inv = 1.0f / l; const size_t tok = tok0 + 16 * a; float ss = 0.f;
#pragma unroll
    for (int db = 0; db < 4; ++db) { const f32x4 o = G.o[db] * inv; ss += (o[0] * o[0] + o[1] * o[1]) + (o[2] * o[2] + o[3] * o[3]);
        u32x2 w; w.x = cvt_pk_bf16(o[0], o[1]); w.y = cvt_pk_bf16(o[2], o[3]); *(u32x2*)(MIX + tok * D + h * HD + 16 * db + 4 * g) = w; }
    ss = xsum16(ss); ss = xsum32(ss);
    if (g == 0) ssqa[tok * NH + h] = ss;
}
#define ATT_SYNC() do { asm volatile("s_waitcnt vmcnt(0) lgkmcnt(0)" ::: "memory"); __builtin_amdgcn_s_barrier(); asm volatile("" ::: "memory"); } while (0)
#define ATT_SB() __builtin_amdgcn_sched_barrier(0)
template <bool INR>
__device__ __forceinline__ void pair4(Grp& G0, Grp& G1, Grp& G2, Grp& G3, const LAS unsigned char* buf, int Rb, const LaneOff& lo, int ks0, int qs, int dq, int L, int lane) {
    f32x4 s0[2], s1[2], s2[2], s3[2]; bf16x8 p0, p1, p2, p3; float a0, a1, a2, a3;
    { bf16x8 k[2][2]; load_k(k, buf, Rb, lo); qk_part(G0, k, s0); qk_part(G1, k, s1); qk_part(G2, k, s2); qk_part(G3, k, s3); } ATT_SB();
    bf16x8 v[4]; load_v(v, buf, Rb, lo);
    sm_part<false, INR>(G0, s0, ks0, qs, L, lane, p0, a0); sm_part<false, INR>(G1, s1, ks0, qs + dq, L, lane, p1, a1); ATT_SB();
    sm_part<false, INR>(G2, s2, ks0, qs + 2 * dq, L, lane, p2, a2); sm_part<false, INR>(G3, s3, ks0, qs + 3 * dq, L, lane, p3, a3); ATT_SB();
    pv_part(G0, v, p0, a0); pv_part(G1, v, p1, a1); pv_part(G2, v, p2, a2); pv_part(G3, v, p3, a3); ATT_SB();
}
template <bool FULL, bool INR>
__device__ __forceinline__ void pair2(Grp& GA, Grp& GB, const LAS unsigned char* buf, int RbA, int RbB, const LaneOff& lo, int ks0, int qs, int L, int lane) {
    f32x4 s0[2], s1[2]; bf16x8 p0, p1; float a0, a1;
    { bf16x8 ka[2][2], kb[2][2]; load_k(ka, buf, RbA, lo); load_k(kb, buf, RbB, lo); qk_part(GA, ka, s0); qk_part(GB, kb, s1); } ATT_SB();
    bf16x8 va[4], vb[4]; load_v(va, buf, RbA, lo); load_v(vb, buf, RbB, lo);
    sm_part<FULL, INR>(GA, s0, ks0, qs, L, lane, p0, a0); sm_part<FULL, INR>(GB, s1, ks0, qs, L, lane, p1, a1); ATT_SB();
    pv_part(GA, va, p0, a0); pv_part(GB, vb, p1, a1); ATT_SB();
}
__device__ __forceinline__ void attn_unit(LAS unsigned char* lds, const bf16_t* Qb, const bf16_t* Kb, const bf16_t* Vb, bf16_t* MIX, float* ssqa, int b, int h, int c0, int tid, int wave, int lane_) {
    int lane = lane_; asm volatile("" : "+v"(lane));
    const int brow0 = b * SEQ, hcol = h * HD, half = wave >> 2, w4 = wave & 3, ch = c0 + 256 * half;
    const unsigned lds0 = (unsigned)(uintptr_t)lds;
    const size_t tokb = (size_t)(brow0 + ch + w4);
    Grp G0, G1, G2, G3;
    grp_init(G0, Qb, tokb, hcol, lane); grp_init(G1, Qb, tokb + 4, hcol, lane); grp_init(G2, Qb, tokb + 8, hcol, lane); grp_init(G3, Qb, tokb + 12, hcol, lane);
    ATT_SYNC();
    { int ln = lane; asm volatile("" : "+v"(ln)); stage_issue(lds0, (const char*)Kb, (const char*)Vb, brow0, hcol, c0, 0, wave, ln); }
#pragma nounroll
    for (int step = 0; step < NSTEP_; ++step) {
        ATT_SYNC();
        int ln = lane; asm volatile("" : "+v"(ln));
        if (step + 1 < NSTEP_) stage_issue(lds0 + (unsigned)(((step + 1) & 1) * BUFB), (const char*)Kb, (const char*)Vb, brow0, hcol, c0, step + 1, wave, ln);
        const LAS unsigned char* buf = lds + (step & 1) * BUFB;
        LaneOff lo; lane_off(lo, ln); const int a = ln & 15;
        if (step < 3) {
            const int qs = ch + w4 + 16 * a;
#pragma nounroll
            for (int p = 0; p < 4; ++p) { const int ks0 = ch - 64 + 128 * step + 32 * p;
                if (ks0 + 31 >= 0 && ks0 < SEQ) { const int Rb = 128 * half + 32 * p;
                    if (ks0 >= 0 && ks0 + 32 <= SEQ) pair4<true>(G0, G1, G2, G3, buf, Rb, lo, ks0, qs, 4, SEQ, ln); else pair4<false>(G0, G1, G2, G3, buf, Rb, lo, ks0, qs, 4, SEQ, ln); } }
        } else if (step < 9) {
            const int s = step - 3, ks0 = (ch >> 2) - 64 + 32 * s, qs = (ch >> 2) + 4 * a;
            if (ks0 + 31 >= 0 && ks0 < SEQ / 4) { const int Rb = 128 * half + 32 * w4;
                if (ks0 >= 0 && ks0 + 32 <= SEQ / 4) pair4<true>(G0, G1, G2, G3, buf, Rb, lo, ks0, qs, 1, SEQ / 4, ln); else pair4<false>(G0, G1, G2, G3, buf, Rb, lo, ks0, qs, 1, SEQ / 4, ln); }
        } else {
            const int s = step - 9, pb = s >> 1, rh = s & 1, ks0 = (c0 >> 4) - 64 + 32 * pb, qlo = (ch >> 4), qs = qlo + a;
            if (ks0 + 31 >= 0 && ks0 < SEQ / 16 && ks0 <= qlo + 15 + 64 && ks0 + 31 >= qlo - 64) {
                const int RA = 32 * w4, RB = 32 * (w4 + 4);
                const bool inr = (ks0 >= 0) && (ks0 + 32 <= SEQ / 16), full = inr && (ks0 + 31 - qlo <= 64) && (qlo + 15 - ks0 <= 64);
                if (rh == 0) { if (full) pair2<true, true>(G0, G1, buf, RA, RB, lo, ks0, qs, SEQ / 16, ln); else if (inr) pair2<false, true>(G0, G1, buf, RA, RB, lo, ks0, qs, SEQ / 16, ln); else pair2<false, false>(G0, G1, buf, RA, RB, lo, ks0, qs, SEQ / 16, ln); }
                else { if (full) pair2<true, true>(G2, G3, buf, RA, RB, lo, ks0, qs, SEQ / 16, ln); else if (inr) pair2<false, true>(G2, G3, buf, RA, RB, lo, ks0, qs, SEQ / 16, ln); else pair2<false, false>(G2, G3, buf, RA, RB, lo, ks0, qs, SEQ / 16, ln); }
            }
        }
    }
    { int lf = lane; asm volatile("" : "+v"(lf)); const size_t tf = (size_t)(brow0 + ch + w4);
      grp_finish(G0, MIX, ssqa, tf, h, lf); grp_finish(G1, MIX, ssqa, tf + 4, h, lf); grp_finish(G2, MIX, ssqa, tf + 8, h, lf); grp_finish(G3, MIX, ssqa, tf + 12, h, lf); }
}
__device__ __forceinline__ void conv_unit(LAS unsigned char* lds, const bf16_t* Cb, bf16_t* MIX, const float* dw_w, const float* dw_b, const float* ln_g, const float* ln_b, const float* out_g,
                                          int b, int s0, int tid_, int wave, int lane_) {
    int tid = tid_, lane = lane_; asm volatile("" : "+v"(tid), "+v"(lane));
    LAS bf16_t* CT = (LAS bf16_t*)lds;
    LAS float* CO = (LAS float*)(lds + 49152);
    ATT_SYNC();
    for (int p = tid; p < 94 * 32; p += NWAVES * 64) { const int row = p >> 5, c = p & 31, s = s0 - 15 + row;
        u32x4 v = (u32x4){0u, 0u, 0u, 0u};
        if (s >= 0 && s < SEQ) v = *(const u32x4*)(Cb + (size_t)(b * SEQ + s) * CCH + c * 8);
        *(LAS u32x4*)(CT + row * CCH + c * 8) = v; }
    ATT_SYNC();
    { const int ch = tid & 255, half = tid >> 8; float v[62], w[CONVK];
#pragma unroll
      for (int k = 0; k < CONVK; ++k) w[k] = dw_w[k * CCH + ch];
#pragma unroll
      for (int i = 0; i < 62; ++i) v[i] = bf2f(CT[(32 * half + i) * CCH + ch]);
      const float bias = dw_b[ch];
#pragma unroll
      for (int p = 0; p < 32; ++p) { float acc = bias;
#pragma unroll
          for (int k = 0; k < CONVK; ++k) acc += v[p + k] * w[k];
          CO[(32 * half + p) * CCH + ch] = acc; } }
    ATT_SYNC();
    { const f32x4 g4 = *((const f32x4*)ln_g + lane), b4 = *((const f32x4*)ln_b + lane), og = *((const f32x4*)out_g + lane);
#pragma unroll
      for (int pp = 0; pp < 8; ++pp) { const int p = wave * 8 + pp; const f32x4 xv = *(const LAS f32x4*)(CO + p * CCH + 4 * lane);
          const float mean = wave_sum((xv[0] + xv[1]) + (xv[2] + xv[3])) * (1.f / CCH); const f32x4 dx = xv - mean;
          const float var = wave_sum((dx[0] * dx[0] + dx[1] * dx[1]) + (dx[2] * dx[2] + dx[3] * dx[3])) * (1.f / CCH); const float rstd = 1.0f / sqrtf(var + LN_EPS);
          f32x4 z;
#pragma unroll
          for (int i = 0; i < 4; ++i) { const float y = dx[i] * rstd * g4[i] + b4[i]; z[i] = y / (1.f + __expf(-y)); }
          const float ms = wave_sum((z[0] * z[0] + z[1] * z[1]) + (z[2] * z[2] + z[3] * z[3])) * (1.f / CCH); const float rs = 1.0f / sqrtf(ms + NORM_EPS);
          u32x2 o; o.x = cvt_pk_bf16(z[0] * rs * og[0], z[1] * rs * og[1]); o.y = cvt_pk_bf16(z[2] * rs * og[2], z[3] * rs * og[3]);
          *(u32x2*)(MIX + (size_t)(b * SEQ + s0 + p) * D + AW + 4 * lane) = o; } }
}
}
namespace moe {
#define MOE_SYNC() do { asm volatile("s_waitcnt vmcnt(0) lgkmcnt(0)" ::: "memory"); __builtin_amdgcn_s_barrier(); asm volatile("" ::: "memory"); } while (0)
__device__ __forceinline__ void split_hi_lo(const f32x4& a, const f32x4& b, bf16x8& hi, bf16x8& lo) {
    u32x4 h, l; float r[8];
    h.x = cvt_pk_bf16(a[0], a[1]); h.y = cvt_pk_bf16(a[2], a[3]); h.z = cvt_pk_bf16(b[0], b[1]); h.w = cvt_pk_bf16(b[2], b[3]);
    r[0] = a[0] - bflo(h.x); r[1] = a[1] - bfhi(h.x); r[2] = a[2] - bflo(h.y); r[3] = a[3] - bfhi(h.y);
    r[4] = b[0] - bflo(h.z); r[5] = b[1] - bfhi(h.z); r[6] = b[2] - bflo(h.w); r[7] = b[3] - bfhi(h.w);
    l.x = cvt_pk_bf16(r[0], r[1]); l.y = cvt_pk_bf16(r[2], r[3]); l.z = cvt_pk_bf16(r[4], r[5]); l.w = cvt_pk_bf16(r[6], r[7]);
    hi = __builtin_bit_cast(bf16x8, h); lo = __builtin_bit_cast(bf16x8, l);
}
__device__ __forceinline__ void route_chunk(LAS unsigned char* lds, const bf16_t* x2, const float* ssq2, const bf16_t* WRF, const float* b_router, const float* b_group,
                                            int* tok_e, float* tok_gate, float* tok_rs, int* hist, int chunk, int tid, int wave, int lane) {
    LAS unsigned char* WB = lds;
    LAS float* LG = (LAS float*)(lds + 49152);
    LAS int* HS = (LAS int*)(lds + 49152 + 36864);
    const int tk = lane & 15, g = lane >> 4;
    f32x4 acc[2][3];
#pragma unroll
    for (int gi = 0; gi < 2; ++gi)
#pragma unroll
        for (int nt = 0; nt < 3; ++nt) acc[gi][nt] = (f32x4){0.f, 0.f, 0.f, 0.f};
    if (tid < 32) HS[tid] = 0;
    const bf16_t* xb = x2 + (size_t)(chunk * 256 + wave * 32 + tk) * D + 8 * g;
#pragma nounroll
    for (int kc = 0; kc < 4; ++kc) {
        MOE_SYNC();
#pragma unroll
        for (int i = 0; i < 6; ++i) { const int p = tid + 512 * i; *(LAS u32x4*)(WB + p * 16) = *(const u32x4*)((const char*)WRF + (size_t)kc * 49152 + p * 16); }
        MOE_SYNC();
#pragma unroll
        for (int gi = 0; gi < 2; ++gi) {
            bf16x8 xa[8];
#pragma unroll
            for (int s = 0; s < 8; ++s) xa[s] = *(const bf16x8*)(xb + (size_t)gi * 16 * D + kc * 256 + s * 32);
#pragma unroll
            for (int s = 0; s < 8; ++s) {
#pragma unroll
                for (int nt = 0; nt < 3; ++nt) { const LAS unsigned char* bp = WB + ((s * 3 + nt) * 2) * 1024 + lane * 16;
                    const bf16x8 bh = *(const LAS bf16x8*)bp, bl = *(const LAS bf16x8*)(bp + 1024);
                    acc[gi][nt] = __builtin_amdgcn_mfma_f32_16x16x32_bf16(xa[s], bh, acc[gi][nt], 0, 0, 0);
                    acc[gi][nt] = __builtin_amdgcn_mfma_f32_16x16x32_bf16(xa[s], bl, acc[gi][nt], 0, 0, 0); } }
        }
    }
#pragma unroll
    for (int gi = 0; gi < 2; ++gi)
#pragma unroll
        for (int nt = 0; nt < 3; ++nt) { const int o = 16 * nt + tk;
            if (o < 36) {
#pragma unroll
                for (int r = 0; r < 4; ++r) LG[(wave * 32 + gi * 16 + 4 * g + r) * 36 + o] = acc[gi][nt][r]; } }
    MOE_SYNC();
    if (wave < 4) { const int tr = wave * 64 + lane, tg = chunk * 256 + tr; const LAS float* lg = LG + tr * 36;
        const f32x4* sp = (const f32x4*)(ssq2 + (size_t)tg * 16); const f32x4 st = (sp[0] + sp[1]) + (sp[2] + sp[3]);
        const float rs = 1.0f / sqrtf(((st[0] + st[1]) + (st[2] + st[3])) * (1.f / D) + NORM_EPS);
        tok_rs[tg] = rs;
        float gl[4];
#pragma unroll
        for (int j = 0; j < 4; ++j) gl[j] = lg[32 + j] * rs + b_group[j];
        float gm = gl[0]; int gi = 0;
#pragma unroll
        for (int j = 1; j < 4; ++j) { if (gl[j] > gm) { gm = gl[j]; gi = j; } }
        float den = 0.f;
#pragma unroll
        for (int j = 0; j < 4; ++j) den += __expf(gl[j] - gm);
        const float gp = 1.0f / den;
        float v0 = -3.0e38f, v1 = -3.0e38f; int i0 = 0, i1 = 0;
#pragma unroll
        for (int j = 0; j < 8; ++j) { const float v = lg[gi * 8 + j] * rs + b_router[gi * 8 + j];
            if (v > v0) { v1 = v0; i1 = i0; v0 = v; i0 = j; } else if (v > v1) { v1 = v; i1 = j; } }
        const float dd = __expf(v1 - v0), g0 = gp / (1.f + dd), g1 = gp * dd / (1.f + dd);
        const int e0 = gi * 8 + i0, e1 = gi * 8 + i1;
        __hip_atomic_fetch_add(HS + e0, 1, __ATOMIC_RELAXED, __HIP_MEMORY_SCOPE_WORKGROUP); __hip_atomic_fetch_add(HS + e1, 1, __ATOMIC_RELAXED, __HIP_MEMORY_SCOPE_WORKGROUP);
        tok_e[tg] = e0 | (e1 << 8); tok_gate[2 * tg] = g0; tok_gate[2 * tg + 1] = g1; }
    MOE_SYNC();
    if (tid < 32) hist[chunk * 32 + tid] = HS[tid];
}
__device__ __forceinline__ void slot_chunk(LAS unsigned char* lds, const int* hist, const int* tok_e, const float* tok_gate, const float* tok_rs, int* tok_slot, int* row_tok, float* slot_rs, float* slot_gate, int* etile,
                                           int chunk, int tid, int wave, int lane) {
    LAS int* CNT = (LAS int*)lds; LAS int* BASE = CNT + 32; LAS int* PST = CNT + 64; LAS int* WC = CNT + 128;
    MOE_SYNC();
    if (tid < 32) { int tot = 0, bs = 0; for (int cc = 0; cc < 256; ++cc) { const int hh = hist[cc * 32 + tid]; bs += (cc < chunk) ? hh : 0; tot += hh; } CNT[tid] = tot; BASE[tid] = bs; }
    MOE_SYNC();
    if (tid == 0) { int ps = 0; for (int e = 0; e < 32; ++e) { PST[e] = ps; ps += ((CNT[e] + 255) >> 8) << 8; } PST[32] = ps; }
    MOE_SYNC();
    int ek[2] = {0, 0}, rank[2] = {0, 0}; const int t = chunk * 256 + (wave & 3) * 64 + lane;
    if (wave < 4) { const int ev = tok_e[t]; ek[0] = ev & 255; ek[1] = ev >> 8;
#pragma unroll
        for (int k = 0; k < 2; ++k)
#pragma nounroll
            for (int e = 0; e < 32; ++e) { const unsigned long long m = __ballot(ek[k] == e);
                if (ek[k] == e) rank[k] = __popcll(m & ((1ull << lane) - 1ull));
                if (lane == 0) WC[(k * 4 + wave) * 32 + e] = __popcll(m); } }
    MOE_SYNC();
    if (wave < 4) {
#pragma unroll
        for (int k = 0; k < 2; ++k) { int off = 0;
            for (int kw = 0; kw < k * 4 + wave; ++kw) off += WC[kw * 32 + ek[k]];
            const int slot = PST[ek[k]] + BASE[ek[k]] + off + rank[k];
            row_tok[slot] = t; slot_rs[slot] = tok_rs[t]; slot_gate[slot] = tok_gate[2 * t + k]; tok_slot[2 * t + k] = slot; } }
    if (chunk < 32) { const int e = chunk, c0 = PST[e] + CNT[e], n = PST[e + 1] - c0;
        for (int i = tid; i < n; i += NWAVES * 64) { row_tok[c0 + i] = 0; slot_rs[c0 + i] = 0.f; slot_gate[c0 + i] = 0.f; } }
    if (chunk == 0 && tid <= 32) etile[tid] = PST[tid] >> 8;
}
__device__ __forceinline__ void final_row(float* xo, const bf16_t* X2, const bf16_t* Y, const int* tok_slot, const float* g, int t, int lane) {
    const int s0 = tok_slot[2 * t], s1 = tok_slot[2 * t + 1];
    f32x4* xr = (f32x4*)(xo + (size_t)t * D) + lane; const u32x2* x2 = (const u32x2*)(X2 + (size_t)t * D) + lane;
    const u32x2* y0 = (const u32x2*)(Y + (size_t)s0 * D) + lane; const u32x2* y1 = (const u32x2*)(Y + (size_t)s1 * D) + lane;
    const f32x4* gr = (const f32x4*)g + lane;
    f32x4 v[4]; float s = 0.f;
#pragma unroll
    for (int j = 0; j < 4; ++j) { const u32x2 x = x2[64 * j], a = y0[64 * j], b = y1[64 * j];
        v[j][0] = bflo(x.x) + (bflo(a.x) + bflo(b.x)); v[j][1] = bfhi(x.x) + (bfhi(a.x) + bfhi(b.x)); v[j][2] = bflo(x.y) + (bflo(a.y) + bflo(b.y)); v[j][3] = bfhi(x.y) + (bfhi(a.y) + bfhi(b.y));
        s += (v[j][0] * v[j][0] + v[j][1] * v[j][1]) + (v[j][2] * v[j][2] + v[j][3] * v[j][3]); }
    const float rs = 1.0f / sqrtf(wave_sum(s) * (1.f / D) + NORM_EPS);
#pragma unroll
    for (int j = 0; j < 4; ++j) xr[64 * j] = v[j] * rs * gr[64 * j];
}
}
#ifndef MK_N_LAUNCHES
#define MK_N_LAUNCHES 1
#endif
constexpr int NPH = 13;
constexpr int N_LAUNCHES = MK_N_LAUNCHES;

#define ARG_IN(k) karg_ptr(8 * (k))
#define ARG_OUT ((float*)karg_ptr(8 * 27))
#define ARG_WS ((unsigned char*)karg_ptr(8 * 28))
template <int LO, int HI>
__global__ void __launch_bounds__(NWAVES * 64, 2) mega_fwd(Args args) {
    extern __shared__ __attribute__((aligned(16))) unsigned char lds_raw[];
    Frame F;
    F.lds = (LAS unsigned char*)lds_raw;
    F.MISC = (volatile LAS unsigned*)(F.lds + LDSCTL_OFF);
    F.wave = __builtin_amdgcn_readfirstlane((int)threadIdx.x >> 6);
    F.G = gridDim.x; { const int bx = blockIdx.x; F.vcu = (F.G % 8 == 0) ? (bx % 8) * (F.G / 8) + bx / 8 : bx; }
    F.ws = ARG_WS; F.ctl = (unsigned*)(ARG_WS + WS_CTL);
    for (int u = threadIdx.x; u < (LDS_BYTES - LDSCTL_OFF) / 4; u += NWAVES * 64) ((LAS unsigned*)(F.lds + LDSCTL_OFF))[u] = 0u;
    __syncthreads();
    XcdBarrier bar; bar.bar = F.ctl + CW_BAR; bar.x = 0; bar.st = nullptr;
    if (HI - LO > 1) bar = xcd_barrier_post(F.ctl + CW_BAR, F.MISC + 8);
#define GRID_BAR() do { if (HI - LO > 1) xcd_barrier(bar); } while (0)
#ifndef PH_MASK
#define PH_MASK 0x1fff
#endif
#define IN(k) ((((PH_MASK) >> (k)) & 1) && LO <= (k) && (k) < HI)
#define BOTH(k) (IN(k) && IN((k) + 1))
#ifndef DUP_PHASE
#define DUP_PHASE -1
#endif
#define DUPF(k) ((k) == DUP_PHASE ? 2 : 1)
    const int gw = F.vcu * NWAVES + F.wave, NGW = F.G * NWAVES;
#define R1 ((bf16_t*)(ARG_WS + WS_R1))
#define R2 ((bf16_t*)(ARG_WS + WS_R2))
#define ssqa ((float*)(ARG_WS + WS_SSQA))
#define ssq1 ((float*)(ARG_WS + WS_SSQ1))
#define ssq2 ((float*)(ARG_WS + WS_SSQ2))
#define tok_e ((int*)(ARG_WS + WS_TOK + TK_E))
#define tok_gate ((float*)(ARG_WS + WS_TOK + TK_GATE))
#define tok_slot ((int*)(ARG_WS + WS_TOK + TK_SLOT))
#define tok_rs ((float*)(ARG_WS + WS_TOK + TK_RS))
#define row_tok ((int*)(ARG_WS + WS_TOK + TK_ROWTOK))
#define slot_rs ((float*)(ARG_WS + WS_TOK + TK_SLOTRS))
#define slot_gate ((float*)(ARG_WS + WS_TOK + TK_SLOTGATE))
#define hist ((int*)(ARG_WS + WS_HIST))
#define etile ((int*)(ARG_WS + WS_HIST + HIST_ETILE))
#define WR ((const bf16_t*)(ARG_WS + WS_HIST + HIST_WR))

    if (IN(0)) { p0_prologue(F); if (BOTH(0)) GRID_BAR(); }

    if (IN(1)) {
        { pg8::GridOrder S; S.init(R1, ARG_WS + WS_WIN, D, D, T, INW, F.G, (int)blockIdx.x); S.dup = DUPF(1);
          pg8::EpiU E{R2, (bf16_t*)(ARG_WS + WS_Q), (bf16_t*)(ARG_WS + WS_K), (bf16_t*)(ARG_WS + WS_V), (const float*)(ARG_WS + WS_ROPE), (const float*)(ARG_WS + WS_ROPE) + SEQ * 32};
          pg8::gemm_phase<pg8::EpiU, pg8::GridOrder, true, false>(F.lds, F.wave, D, D, D, S, E); }
        { pg8::KvOrder S{(const char*)(ARG_WS + WS_MEMN), (const char*)(ARG_WS + WS_WXK), (const char*)(ARG_WS + WS_WXV), F.G, (int)blockIdx.x};
          pg8::EpiPlain<false> E{(bf16_t*)(ARG_WS + WS_KX), D, (bf16_t*)(ARG_WS + WS_VXT), MROWS, nullptr};
          pg8::gemm_phase<pg8::EpiPlain<false>, pg8::KvOrder, true, false>(F.lds, F.wave, D, D, D, S, E); }
        if (BOTH(1)) GRID_BAR();
    }

    if (IN(2)) {
        for (int L0 = F.vcu; L0 < NB * NH * 8 * DUPF(2); L0 += F.G) { const int L = L0 % (NB * NH * 8); const int chunk = L & 7, bh = L >> 3, b = bh / NH, h = bh % NH;
            att::attn_unit(F.lds, (const bf16_t*)(ARG_WS + WS_Q), (const bf16_t*)(ARG_WS + WS_K), (const bf16_t*)(ARG_WS + WS_V), R1, ssqa, b, h, chunk * 512, F.wave * 64 + lane_id(), F.wave, lane_id()); }
        for (int L = F.vcu; L < NB * 64; L += F.G) { const int b = L >> 6, j = L & 63;
            att::conv_unit(F.lds, R2, R1, (const float*)ARG_IN(5), (const float*)ARG_IN(6), (const float*)ARG_IN(7), (const float*)ARG_IN(8), (const float*)ARG_IN(9), b, j * 64, F.wave * 64 + lane_id(), F.wave, lane_id()); }
        asm volatile("s_waitcnt vmcnt(0) lgkmcnt(0)" ::: "memory"); __syncthreads();
        if (BOTH(2)) GRID_BAR();
    }

    if (IN(3)) {
        pg8::GridOrder S; S.init(R1, ARG_WS + WS_WOUT, D, D, T, D, F.G, (int)blockIdx.x); S.dup = DUPF(3);
        pg8::EpiResid<true> E{(const float*)ARG_IN(0), R2, ssq1, ssqa};
        pg8::gemm_phase<pg8::EpiResid<true>, pg8::GridOrder, true, false>(F.lds, F.wave, D, D, D, S, E);
        if (BOTH(3)) GRID_BAR();
    }

    if (IN(4)) {
        pg8::GridOrder S; S.init(R2, ARG_WS + WS_WXQ, D, D, T, D, F.G, (int)blockIdx.x); S.dup = DUPF(4);
        pg8::EpiPlain<true> E{(bf16_t*)(ARG_WS + WS_XQ), D, nullptr, 0, ssq1};
        pg8::gemm_phase<pg8::EpiPlain<true>, pg8::GridOrder, true, false>(F.lds, F.wave, D, D, D, S, E);
        if (BOTH(4)) GRID_BAR();
    }

    if (IN(5)) {
        pg8::XaOrder<0> S{(const char*)(ARG_WS + WS_XQ), (const char*)(ARG_WS + WS_KX), F.G, F.vcu};
        pg8::EpiSoftmax E{(bf16_t*)(ARG_WS + WS_PM)};
        pg8::gemm_phase<pg8::EpiSoftmax, pg8::XaOrder<0>, true, false>(F.lds, F.wave, D, D, XHD, S, E);
        if (BOTH(5)) GRID_BAR();
    }

    if (IN(6)) {
        pg8::XaOrder<1> S{(const char*)(ARG_WS + WS_PM), (const char*)(ARG_WS + WS_VXT), F.G, F.vcu};
        pg8::EpiPlain<false> E{R1, D, nullptr, 0, nullptr};
        pg8::gemm_phase<pg8::EpiPlain<false>, pg8::XaOrder<1>, true, false>(F.lds, F.wave, D, MROWS, MEML, S, E);
        if (BOTH(6)) GRID_BAR();
    }

    if (IN(7)) {
        pg8::GridOrder S; S.init(R1, ARG_WS + WS_WXO, D, D, T, D, F.G, (int)blockIdx.x);
        pg8::EpiResid<false> E{nullptr, R2, ssq2, nullptr};
        pg8::gemm_phase<pg8::EpiResid<false>, pg8::GridOrder, true, false>(F.lds, F.wave, D, D, D, S, E);
        if (BOTH(7)) GRID_BAR();
    }

    if (IN(8)) {
        for (int c0_ = blockIdx.x; c0_ < (T / 256) * DUPF(8); c0_ += F.G) { const int c = c0_ % (T / 256);
            moe::route_chunk(F.lds, R2, ssq2, WR, (const float*)ARG_IN(22), (const float*)ARG_IN(20), tok_e, tok_gate, tok_rs, hist, c, F.wave * 64 + lane_id(), F.wave, lane_id()); }
        asm volatile("s_waitcnt vmcnt(0) lgkmcnt(0)" ::: "memory"); __syncthreads();
        if (BOTH(8)) GRID_BAR();
    }

    if (IN(9)) {
        for (int c = blockIdx.x; c < T / 256; c += F.G)
            moe::slot_chunk(F.lds, hist, tok_e, tok_gate, tok_rs, tok_slot, row_tok, slot_rs, slot_gate, etile, c, F.wave * 64 + lane_id(), F.wave, lane_id());
        asm volatile("s_waitcnt vmcnt(0) lgkmcnt(0)" ::: "memory"); __syncthreads();
        if (BOTH(9)) GRID_BAR();
    }

    if (IN(10)) {
        pg8::MoeOrder<0> S{(const char*)R2, (const char*)(ARG_WS + WS_W13), row_tok, etile, F.G, (int)blockIdx.x, DUPF(10)};
        pg8::EpiMoe1 E{(bf16_t*)(ARG_WS + WS_HID), slot_rs};
        pg8::gemm_phase<pg8::EpiMoe1, pg8::MoeOrder<0>, true, true>(F.lds, F.wave, D, D, D, S, E);
        if (BOTH(10)) GRID_BAR();
    }

    if (IN(11)) {
        pg8::MoeOrder<1> S{(const char*)(ARG_WS + WS_HID), (const char*)(ARG_WS + WS_W2), row_tok, etile, F.G, (int)blockIdx.x, DUPF(11)};
        pg8::EpiMoe2 E{(bf16_t*)(ARG_WS + WS_Y), slot_gate};
        pg8::gemm_phase<pg8::EpiMoe2, pg8::MoeOrder<1>, true, false>(F.lds, F.wave, FF, FF, FF, S, E);
        if (BOTH(11)) GRID_BAR();
    }

    if (IN(12)) {
        for (int t = gw; t < T; t += NGW) moe::final_row(ARG_OUT, R2, (const bf16_t*)(ARG_WS + WS_Y), tok_slot, (const float*)ARG_IN(26), t, lane_id());
    }
#undef IN
#undef BOTH
}

typedef void (*kern_t)(Args);
template <int... I> struct PhList {};
extern "C" void kernel_launch(void* const* d_in, const int* in_sizes, int n_in, void* d_out, int out_size, void* d_ws, size_t ws_size, hipStream_t stream) {
    static int grid = 0;
#if MK_N_LAUNCHES == 1
    static const kern_t kerns[1] = {mega_fwd<0, NPH>};
#else
    static const kern_t kerns[NPH] = {mega_fwd<0, 1>, mega_fwd<1, 2>, mega_fwd<2, 3>, mega_fwd<3, 4>, mega_fwd<4, 5>, mega_fwd<5, 6>, mega_fwd<6, 7>, mega_fwd<7, 8>, mega_fwd<8, 9>, mega_fwd<9, 10>, mega_fwd<10, 11>, mega_fwd<11, 12>, mega_fwd<12, 13>};
#endif
    if (grid == 0) {
        if (n_in != 27 || in_sizes[0] != T * D || out_size != T * D || ws_size < WS_END) { fprintf(stderr, "kernel_launch: unexpected problem: n_in %d in0 %d out %d ARG_WS %zu (need %zu)\n", n_in, n_in > 0 ? in_sizes[0] : -1, out_size, ws_size, (size_t)WS_END); grid = -1; return; }
        int dev = 0, cus = 0, per_cu = 0;
        if (hipGetDevice(&dev) != hipSuccess || hipDeviceGetAttribute(&cus, hipDeviceAttributeMultiprocessorCount, dev) != hipSuccess) { grid = -1; return; }
        for (int li = 0; li < N_LAUNCHES; ++li)
            if (hipFuncSetAttribute((const void*)kerns[li], hipFuncAttributeMaxDynamicSharedMemorySize, LDS_BYTES) != hipSuccess) { fprintf(stderr, "kernel_launch: hipFuncSetAttribute failed\n"); grid = -1; return; }
        if (hipOccupancyMaxActiveBlocksPerMultiprocessor(&per_cu, (const void*)kerns[0], NWAVES * 64, LDS_BYTES) != hipSuccess || per_cu < 1) { fprintf(stderr, "kernel_launch: occupancy query says %d\n", per_cu); }
        (void)hipGetLastError();
        grid = cus;
    }
    if (grid < 0) return;
    if (hipMemsetAsync((char*)d_ws + WS_CTL, 0, CTL_ZERO_BYTES, stream) != hipSuccess) return;
    Args a{};
    for (int i = 0; i < 27; ++i) a.in[i] = d_in[i];
    a.out = (float*)d_out; a.ws = (unsigned char*)d_ws;
    for (int li = 0; li < N_LAUNCHES; ++li) {
        a.ph_lo = 0; a.ph_hi = 0; a.li = li; a.pad = 0;
        hipLaunchKernelGGL(kerns[li], dim3(grid), dim3(NWAVES * 64), LDS_BYTES, stream, a);
        const hipError_t le = hipPeekAtLastError();
        if (le != hipSuccess) { fprintf(stderr, "kernel_launch: launch %d failed: %s\n", li, hipGetErrorName(le)); break; }
    }
}
```

```cpp
#include <hip/hip_runtime.h>
#include <cstdio>
#include <cstdint>

#define GAS __attribute__((address_space(1)))
#define LAS __attribute__((address_space(3)))
typedef unsigned short bf16_t;
typedef short bf16x8 __attribute__((ext_vector_type(8)));
typedef short s16x4 __attribute__((ext_vector_type(4)));
typedef float f32x4 __attribute__((ext_vector_type(4)));
typedef float f32x2 __attribute__((ext_vector_type(2)));
typedef unsigned u32x4 __attribute__((ext_vector_type(4)));
typedef unsigned u32x2 __attribute__((ext_vector_type(2)));

constexpr int NB = 16, SEQ = 4096, T = NB * SEQ, D = 1024;
constexpr int CCH = 256, NH = 12, HD = 64, AW = NH * HD, INW = 2 * CCH + 3 * AW;
constexpr int MEML = 256, MROWS = NB * MEML, XH = 4, XHD = 256;
constexpr int NE = 32, EPG = 8, NG = 4, FF = 512;
constexpr int CONVK = 31;
constexpr int A_PAD = T * 2 + NE * 256;
constexpr float NORM_EPS = 1e-6f, LN_EPS = 1e-5f;
constexpr float LOG2E = 1.4426950408889634f;

constexpr size_t MiB = 1u << 20;
constexpr size_t WS_CTL = 0, CTL_ZERO_BYTES = 1 * MiB;
constexpr size_t WS_ROPE = 1 * MiB;
constexpr size_t WS_HIST = 2 * MiB;
constexpr size_t WS_SSQA = 4 * MiB;
constexpr size_t WS_SSQ1 = 8 * MiB;
constexpr size_t WS_SSQ2 = 12 * MiB;
constexpr size_t WS_WIN = 16 * MiB, WS_WOUT = 22 * MiB, WS_WXQ = 24 * MiB, WS_WXK = 26 * MiB, WS_WXV = 28 * MiB, WS_WXO = 30 * MiB;
constexpr size_t WS_W13 = 32 * MiB, WS_W2 = 96 * MiB;
constexpr size_t WS_MEMN = 128 * MiB, WS_KX = 136 * MiB, WS_VXT = 144 * MiB;
constexpr size_t WS_TOK = 152 * MiB;
constexpr size_t WS_R1 = 160 * MiB;
constexpr size_t WS_R2 = 288 * MiB;
constexpr size_t WS_Q = 320 * MiB, WS_K = 416 * MiB, WS_V = 512 * MiB;
constexpr size_t WS_XQ = 416 * MiB;
constexpr size_t WS_PM = 544 * MiB;
constexpr size_t WS_HID = 416 * MiB;
constexpr size_t WS_Y = 552 * MiB;
constexpr size_t WS_END = 824 * MiB;
constexpr size_t TK_E = 0;
constexpr size_t TK_GATE = 1 * MiB;
constexpr size_t TK_SLOT = 2 * MiB;
constexpr size_t TK_RS = 3 * MiB;
constexpr size_t TK_ROWTOK = 4 * MiB;
constexpr size_t TK_SLOTRS = 5 * MiB;
constexpr size_t TK_SLOTGATE = 6 * MiB;
constexpr size_t HIST_ETILE = 64 * 1024, HIST_WR = 128 * 1024;

constexpr int CW_BAR = 4096;

constexpr int NWAVES = 8;
constexpr int RING_BYTES = 131072;
constexpr int XCH_OFF = RING_BYTES;
constexpr int LDSCTL_OFF = RING_BYTES + 12288;
constexpr int LDS_BYTES = 147456;

#define LDS_WAIT() asm volatile("s_waitcnt lgkmcnt(0)" ::: "memory")
#define VM_WAIT() asm volatile("s_waitcnt vmcnt(0)" ::: "memory")
__device__ __forceinline__ unsigned f2bf(float f) { unsigned u = __builtin_bit_cast(unsigned, f); return (u + 0x7fffu + ((u >> 16) & 1u)) >> 16; }
__device__ __forceinline__ unsigned pk2(float lo, float hi) { return f2bf(lo) | (f2bf(hi) << 16); }
__device__ __forceinline__ float bf2f(unsigned short b) { return __builtin_bit_cast(float, (unsigned)b << 16); }
__device__ __forceinline__ float bflo(unsigned w) { return __builtin_bit_cast(float, w << 16); }
__device__ __forceinline__ float bfhi(unsigned w) { return __builtin_bit_cast(float, w & 0xffff0000u); }
__device__ __forceinline__ unsigned cvt_pk_bf16(float lo, float hi) { unsigned r; asm volatile("v_cvt_pk_bf16_f32 %0, %1, %2" : "=v"(r) : "v"(lo), "v"(hi)); return r; }
__device__ __forceinline__ float wave_sum(float v) {
#pragma unroll
    for (int o = 1; o < 64; o <<= 1) v += __shfl_xor(v, o);
    return v;
}
__device__ __forceinline__ int lane_id() { return (int)__builtin_amdgcn_mbcnt_hi(~0u, __builtin_amdgcn_mbcnt_lo(~0u, 0u)); }
#define MK_N_LAUNCHES 1
namespace pg8 {
constexpr int BM = 256, BK = 64, HALF = 128, HTB = HALF * BK * 2  , STAGE_BYTES = 8 * HTB, NXCD = 8, WGM = 8;

__host__ __device__ __forceinline__ int lds_byte(int r, int c) { const int st = (r >> 4) * 2 + (c >> 5), rr = r & 15, cc = c & 31, ob = rr * 64 + cc * 2; return st * 1024 + (ob ^ (((ob >> 9) & 1) << 5)); }
__host__ __device__ __forceinline__ void stage_rc(int b, int& R, int& C) { const int st = b / 1024, sb = b % 1024, swz = sb ^ (((sb >> 9) & 1) << 5); R = (st >> 1) * 16 + swz / 64; C = (st & 1) * 32 + (swz % 64) / 2; }
__host__ __device__ __forceinline__ int perm32(int rho) { const int n = rho >> 4, i = rho & 15; return 8 * (i >> 2) + 4 * n + (i & 3); }

struct Unit { const char* a; const char* b; const int* rows; int pm, pn, x0, x1; };

typedef f32x4 Acc[2][2][4][2];

__device__ __forceinline__ const char* uniform_ptr(const char* p) { const unsigned long long v = (unsigned long long)p;
    const unsigned lo = __builtin_amdgcn_readfirstlane((unsigned)v), hi = __builtin_amdgcn_readfirstlane((unsigned)(v >> 32)); return (const char*)(((unsigned long long)hi << 32) | lo); }
__device__ __forceinline__ void glds16_sv(const char* gbase, unsigned voff, unsigned lds_dst) { unsigned keep;
    asm volatile("s_mov_b32 %0, m0\n\ts_mov_b32 m0, %3\n\ts_nop 0\n\tglobal_load_lds_dwordx4 %1, %2\n\ts_mov_b32 m0, %0" : "=&s"(keep) : "v"(voff), "s"(gbase), "s"(lds_dst) : "memory"); }
template <class Epi, class Sched, bool ALIGN_EPI, bool GATHER>
__device__ __forceinline__ void gemm_phase(LAS unsigned char* lds, const int wave_, const int lda, const int ldb, const int K, const Sched& S, const Epi& E) {
    int lane_ = lane_id(); asm volatile("" : "+v"(lane_));
    const int wid = __builtin_amdgcn_readfirstlane(wave_), tid = wid * 64 + lane_, lane = tid & 63, wr = wid >> 2, wc = wid & 3, fr = lane & 15, fq = lane >> 4;
    const int nt = K / BK;
    int Rr[2], Cc[2];
    unsigned vA[2][2], vN[2][2], voffB[2];
#pragma unroll
    for (int i = 0; i < 2; ++i) { int R, C; stage_rc(tid * 16 + i * 8192, R, C); Rr[i] = R; Cc[i] = C; const int Rb = Epi::PERM ? ((R & ~31) + perm32(R & 31)) : R;
        voffB[i] = (unsigned)(Rb * ldb + C) * 2u; }
    const size_t kstep = (size_t)(BK * 2);
    const size_t hstepB = (size_t)HALF * ldb * 2, hstepA = (size_t)HALF * lda * 2;
    const unsigned ldsw = (unsigned)wid * 1024u, lds0 = (unsigned)(uintptr_t)lds;
    const int aoff = lds_byte(wr * 64 + fr, fq * 8), boff = lds_byte(wc * 32 + fr, fq * 8);
#define PG8_SA(b, h) (((b) * 2 + (h)) * HTB)
#define PG8_SB(b, h) ((4 + (b) * 2 + (h)) * HTB)
#define PG8_STAGE(bufoff, gbase, voff) do { _Pragma("unroll") for (int _i = 0; _i < 2; ++_i) glds16_sv((gbase), (voff)[_i], lds0 + (unsigned)(bufoff) + ldsw + _i * 8192u); } while (0)
#define PG8_LDA(dst, b, h) do { _Pragma("unroll") for (int m = 0; m < 4; ++m) _Pragma("unroll") for (int k = 0; k < 2; ++k) dst[m][k] = *(const LAS bf16x8*)(lds + PG8_SA(b, h) + aoff + m * 2048 + k * 1024); } while (0)
#define PG8_LDB(dst, b, h) do { _Pragma("unroll") for (int n = 0; n < 2; ++n) _Pragma("unroll") for (int k = 0; k < 2; ++k) dst[n][k] = *(const LAS bf16x8*)(lds + PG8_SB(b, h) + boff + n * 2048 + k * 1024); } while (0)
#define PG8_MMA(ai, bj, At, Bt) do { __builtin_amdgcn_s_setprio(1); _Pragma("unroll") for (int m = 0; m < 4; ++m) _Pragma("unroll") for (int n = 0; n < 2; ++n) _Pragma("unroll") for (int k = 0; k < 2; ++k) \
        acc[ai][bj][m][n] = __builtin_amdgcn_mfma_f32_16x16x32_bf16(Bt[n][k], At[m][k], acc[ai][bj][m][n], 0, 0, 0); __builtin_amdgcn_s_setprio(0); } while (0)
#define PG8_WAIT_V(n) asm volatile("s_waitcnt vmcnt(" #n ")" ::: "memory")
#define PG8_WAIT_L(n) asm volatile("s_waitcnt lgkmcnt(" #n ")" ::: "memory")
#define PG8_BAR __builtin_amdgcn_s_barrier()
#define PG8_SCHED __builtin_amdgcn_sched_barrier(0)
#define PG8_VOFF(dst, u) do { _Pragma("unroll") for (int _h = 0; _h < 2; ++_h) _Pragma("unroll") for (int _i = 0; _i < 2; ++_i) { \
        if constexpr (GATHER) dst[_h][_i] = (unsigned)(u).rows[_h * HALF + Rr[_i]] * (unsigned)(lda * 2) + (unsigned)(Cc[_i] * 2); \
        else dst[_h][_i] = (unsigned)(Rr[_i] * lda + Cc[_i]) * 2u; } } while (0)
#define PG8_STAGE_A(bufoff, gbase, h, vv) do { if constexpr (GATHER) { PG8_STAGE(bufoff, gbase, vv[h]); } else { PG8_STAGE(bufoff, (gbase) + (h) * hstepA, vv[0]); } } while (0)
    Unit cur, nxt; int ui = 0;
    if (!S.next(0, cur)) return;
    Acc acc;
#pragma unroll
    for (int a = 0; a < 2; ++a)
#pragma unroll
        for (int b = 0; b < 2; ++b)
#pragma unroll
            for (int m = 0; m < 4; ++m)
#pragma unroll
                for (int n = 0; n < 2; ++n) acc[a][b][m][n] = (f32x4){0.f, 0.f, 0.f, 0.f};
    bf16x8 At[4][2], B0[2][2], B1[2][2];
    const char* cA = uniform_ptr(cur.a); const char* cB = uniform_ptr(cur.b);
    PG8_VOFF(vA, cur);
    if constexpr (GATHER) { asm volatile("s_waitcnt vmcnt(0)" ::: "memory"); }
    PG8_STAGE(PG8_SB(0, 0), cB, voffB); PG8_STAGE(PG8_SB(0, 1), cB + hstepB, voffB); PG8_STAGE_A(PG8_SA(0, 0), cA, 0, vA); PG8_STAGE_A(PG8_SA(0, 1), cA, 1, vA);
    if (wr == 1) PG8_BAR;
    PG8_WAIT_V(2); PG8_BAR;
    PG8_STAGE(PG8_SB(1, 0), cB + kstep, voffB); PG8_STAGE_A(PG8_SA(1, 0), cA + kstep, 0, vA); PG8_STAGE(PG8_SB(1, 1), cB + hstepB + kstep, voffB);
    PG8_WAIT_V(6); PG8_BAR;
    for (;;) {
        const bool has_next = S.next(ui + 1, nxt);
        const char* nA = has_next ? uniform_ptr(nxt.a) : cA; const char* nB = has_next ? uniform_ptr(nxt.b) : cB;
        if constexpr (GATHER) { if (has_next) { PG8_VOFF(vN, nxt); } else {
#pragma unroll
            for (int h = 0; h < 2; ++h) { vN[h][0] = vA[h][0]; vN[h][1] = vA[h][1]; } } }
#pragma nounroll
        for (int t = 0; t < nt; t += 2) {
            const bool last = (t == nt - 2);
            if constexpr (Epi::HAS_MID) { if (t == E.mid_t()) E.mid(acc, cur, wr, wc, fr, fq); }
            const char* a1 = cA + (size_t)(t + 1) * kstep;
            const char* a2 = last ? nA : cA + (size_t)(t + 2) * kstep; const char* b2 = last ? nB : cB + (size_t)(t + 2) * kstep;
            const char* a3 = a2 + kstep; const char* b3 = b2 + kstep;
            unsigned vW[2][2];
#pragma unroll
            for (int h = 0; h < 2; ++h) { vW[h][0] = vA[h][0]; vW[h][1] = vA[h][1]; if constexpr (GATHER) { if (last) { vW[h][0] = vN[h][0]; vW[h][1] = vN[h][1]; } } }
            PG8_LDB(B0, 0, 0); PG8_LDB(B1, 0, 1); PG8_SCHED; PG8_LDA(At, 0, 0); PG8_STAGE_A(PG8_SA(1, 1), a1, 1, vA);
            PG8_WAIT_V(8); PG8_WAIT_L(0); PG8_BAR; PG8_MMA(0, 0, At, B0); PG8_MMA(0, 1, At, B1); PG8_BAR; PG8_SCHED;
            PG8_LDA(At, 0, 1); PG8_STAGE(PG8_SB(0, 0), b2, voffB); PG8_STAGE(PG8_SB(0, 1), b2 + hstepB, voffB); PG8_STAGE_A(PG8_SA(0, 0), a2, 0, vW);
            PG8_WAIT_V(8); PG8_WAIT_L(0); PG8_BAR; PG8_MMA(1, 0, At, B0); PG8_MMA(1, 1, At, B1); PG8_BAR; PG8_SCHED;
            PG8_LDB(B0, 1, 0); PG8_LDB(B1, 1, 1); PG8_SCHED; PG8_LDA(At, 1, 0); PG8_STAGE_A(PG8_SA(0, 1), a2, 1, vW);
            PG8_WAIT_V(8); PG8_WAIT_L(0); PG8_BAR; PG8_MMA(0, 0, At, B0); PG8_MMA(0, 1, At, B1); PG8_BAR; PG8_SCHED;
            PG8_LDA(At, 1, 1); PG8_STAGE(PG8_SB(1, 0), b3, voffB); PG8_STAGE(PG8_SB(1, 1), b3 + hstepB, voffB); PG8_STAGE_A(PG8_SA(1, 0), a3, 0, vW);
            PG8_WAIT_V(8); PG8_WAIT_L(0); PG8_BAR; PG8_MMA(1, 0, At, B0); PG8_MMA(1, 1, At, B1); PG8_BAR; PG8_SCHED;
        }
        if constexpr (ALIGN_EPI) { if (wr == 0) PG8_BAR; }
        E(acc, cur, wr, wc, fr, fq, lds, wid, lane);
        if (!has_next) break;
#pragma unroll
        for (int a = 0; a < 2; ++a)
#pragma unroll
            for (int b = 0; b < 2; ++b)
#pragma unroll
                for (int m = 0; m < 4; ++m)
#pragma unroll
                    for (int n = 0; n < 2; ++n) acc[a][b][m][n] = (f32x4){0.f, 0.f, 0.f, 0.f};
        cur = nxt; cA = nA; cB = nB; ++ui;
        if constexpr (GATHER) {
#pragma unroll
            for (int h = 0; h < 2; ++h) { vA[h][0] = vN[h][0]; vA[h][1] = vN[h][1]; } }
        if constexpr (ALIGN_EPI) { if (wr == 1) PG8_BAR; }
    }
    PG8_WAIT_V(0);
    if constexpr (!ALIGN_EPI) { if (wr == 0) PG8_BAR; }
    PG8_BAR;
#undef PG8_SA
#undef PG8_SB
#undef PG8_STAGE
#undef PG8_LDA
#undef PG8_LDB
#undef PG8_MMA
#undef PG8_WAIT_V
#undef PG8_WAIT_L
#undef PG8_BAR
#undef PG8_SCHED
#undef PG8_VOFF
#undef PG8_STAGE_A
}
}
#define XB_TMO      128
#define XB_XCNT(j)  (256  + 64 * (j))
#define XB_XSUB(j)  (1280 + 64 * (j))
#define XB_XGEN(j)  (2304 + 64 * (j))
#define XB_TOP      3328
#define XB_TOPGEN   3392
#define XCD_BAR_WORDS 3456
#define XB_SPIN_CAP (1u << 18)

__device__ __forceinline__ unsigned xb_ld(unsigned* p)              { return __hip_atomic_load(p, __ATOMIC_RELAXED, __HIP_MEMORY_SCOPE_AGENT); }
__device__ __forceinline__ unsigned xb_add(unsigned* p, unsigned v) { return __hip_atomic_fetch_add(p, v, __ATOMIC_RELAXED, __HIP_MEMORY_SCOPE_AGENT); }
__device__ __forceinline__ unsigned xb_xcc_id() { return (unsigned)__builtin_amdgcn_s_getreg((3 << 11) | 20) & 0xFu; }
#define XB_SPIN(cond, bar) do { unsigned _sp = 0; while (cond) { __builtin_amdgcn_s_sleep(1); \
    if ((++_sp & 255u) == 0u) { if (xb_ld(&(bar)[XB_TMO])) break; if (_sp > XB_SPIN_CAP) { atomicAdd(&(bar)[XB_TMO], 1u); break; } } } } while (0)

struct XcdBarrier {
    unsigned* bar; unsigned x;
    volatile LAS unsigned* st;
};

__device__ __forceinline__ XcdBarrier xcd_barrier_post(unsigned* bar, volatile LAS unsigned* st) {
    XcdBarrier b; b.bar = bar; b.x = xb_xcc_id(); b.st = st;
    if (threadIdx.x == 0) (void)xb_add(&bar[XB_XCNT(b.x)], 1u);
    return b;
}
__device__ __forceinline__ void xcd_barrier_complete(unsigned* bar, unsigned x, unsigned& nloc, unsigned& nx) {
    const unsigned G = gridDim.x * gridDim.y * gridDim.z;
    unsigned sum, cnt, mine, sp = 0u;
    for (;;) {
        sum = 0u; cnt = 0u; mine = 0u;
#pragma unroll
        for (unsigned j = 0; j < 16; ++j) { const unsigned c = xb_ld(&bar[XB_XCNT(j)]); sum += c; cnt += (c > 0u) ? 1u : 0u; mine = (j == x) ? c : mine; }
        if (sum == G) break;
        __builtin_amdgcn_s_sleep(1);
        if ((++sp & 255u) == 0u) { if (xb_ld(&bar[XB_TMO])) break; if (sp > XB_SPIN_CAP) { atomicAdd(&bar[XB_TMO], 1u); break; } }
    }
    nloc = mine > 0u ? mine : 1u; nx = cnt > 0u ? cnt : 1u;
}

__device__ __forceinline__ void xcd_barrier(const XcdBarrier& b) {
    asm volatile("s_waitcnt vmcnt(0)" ::: "memory");
    __syncthreads();
    if (threadIdx.x == 0) {
        unsigned* bar = b.bar;
        __builtin_amdgcn_s_waitcnt(0);
        unsigned nloc = b.st[0], nx = b.st[1];
        if (nloc == 0u) { xcd_barrier_complete(bar, b.x, nloc, nx); b.st[0] = nloc; b.st[1] = nx; }
        const unsigned old = xb_add(&bar[XB_XSUB(b.x)], 1u);
        const unsigned gen = old / nloc;
        if (old + 1u == (gen + 1u) * nloc) {
            __builtin_amdgcn_fence(__ATOMIC_RELEASE, "agent");
            asm volatile("s_waitcnt vmcnt(0)" ::: "memory");
            const unsigned og = xb_add(&bar[XB_TOP], 1u);
            const unsigned tg = og / nx;
            if (og + 1u == (tg + 1u) * nx) xb_add(&bar[XB_TOPGEN], 1u);
            else XB_SPIN(xb_ld(&bar[XB_TOPGEN]) == tg, bar);
            __builtin_amdgcn_fence(__ATOMIC_ACQUIRE, "agent");
            xb_add(&bar[XB_XGEN(b.x)], 1u);
            asm volatile("s_waitcnt vmcnt(0)" ::: "memory");
        } else {
            XB_SPIN(xb_ld(&bar[XB_XGEN(b.x)]) == gen, bar);
            __builtin_amdgcn_fence(__ATOMIC_ACQUIRE, "agent");
            asm volatile("s_waitcnt vmcnt(0)" ::: "memory");
        }
    }
    __syncthreads();
}

namespace pg8 {
#define EPI_NOMID static constexpr bool HAS_MID = false; __device__ __forceinline__ int mid_t() const { return -1; } __device__ __forceinline__ void mid(Acc&, const Unit&, int, int, int, int) const {}
#define RAW_BARRIER() do { asm volatile("s_waitcnt lgkmcnt(0)" ::: "memory"); __builtin_amdgcn_s_barrier(); asm volatile("" ::: "memory"); } while (0)

__device__ __forceinline__ u32x4 pack8(const f32x4& v0, const f32x4& v1) { u32x4 w; w.x = cvt_pk_bf16(v0[0], v0[1]); w.y = cvt_pk_bf16(v0[2], v0[3]); w.z = cvt_pk_bf16(v1[0], v1[1]); w.w = cvt_pk_bf16(v1[2], v1[3]); return w; }

struct GridOrder {
    const char* A; const char* Bt; int lda, ldb, nM, nN, nwg, G, c, dup;
    __device__ __forceinline__ void init(const void* A_, const void* Bt_, int lda_, int ldb_, int M, int N, int G_, int c_) { A = (const char*)A_; Bt = (const char*)Bt_; lda = lda_; ldb = ldb_; nM = M / BM; nN = N / BM; nwg = nM * nN; G = G_; c = c_; dup = 1; }
    __device__ __forceinline__ bool next(int i, Unit& u) const {
        const long L = (long)i * G + c; if (L >= (long)nwg * dup) return false;
        int wgid = (int)(L % nwg); { const int q = nwg / NXCD, r = nwg % NXCD, xcd = wgid % NXCD, off = wgid / NXCD; wgid = (xcd < r ? xcd * (q + 1) : r * (q + 1) + (xcd - r) * q) + off; }
        const int nig = WGM * nN, gid = wgid / nig, fm = gid * WGM, gsz = (nM - fm) < WGM ? (nM - fm) : WGM;
        u.pm = fm + ((wgid % nig) % gsz); u.pn = (wgid % nig) / gsz; u.x0 = 0; u.x1 = 0; u.rows = nullptr;
        u.a = A + (size_t)u.pm * BM * lda * 2; u.b = Bt + (size_t)u.pn * BM * ldb * 2; return true;
    }
};
struct KvOrder {
    const char* memn; const char* wk; const char* wv; int G, c;
    __device__ __forceinline__ bool next(int i, Unit& u) const {
        const int L = i * G + c; if (L >= 128) return false;
        u.rows = nullptr; u.x1 = 0;
        if (L < 64) { u.pm = L >> 2; u.pn = L & 3; u.x0 = 0; u.a = memn + (size_t)u.pm * BM * D * 2; u.b = wk + (size_t)u.pn * BM * D * 2; }
        else { const int l = L - 64; u.pm = l >> 4; u.pn = l & 15; u.x0 = 1; u.a = wv + (size_t)u.pm * BM * D * 2; u.b = memn + (size_t)u.pn * BM * D * 2; }
        return true;
    }
};
template <int MODE> struct XaOrder {
    const char* A; const char* B; int G, c, dup;
    __device__ __forceinline__ bool next(int i, Unit& u) const {
        int L = i * G + c; if (L >= NB * XH * 16 * dup) return false;
        L %= NB * XH * 16;
        const int qt = L & 15, bh = L >> 4, b = bh >> 2, h = bh & 3;
        u.pm = b * 16 + qt; u.pn = h; u.x0 = 0; u.x1 = 0; u.rows = nullptr;
        u.a = A + ((size_t)u.pm * BM * D + h * XHD) * 2;
        if (MODE == 0) u.b = B + ((size_t)b * MEML * D + h * XHD) * 2;
        else u.b = B + ((size_t)h * XHD * MROWS + b * MEML) * 2;
        return true;
    }
};
template <int MODE> struct MoeOrder {
    const char* A; const char* W; const int* rowtok; const int* etile; int G, c, dup;
    __device__ __forceinline__ bool next(int i, Unit& u) const {
        int L = i * G + c; const int ntile = etile[NE];
        if (L >= ntile * 4 * dup) return false;
        L %= ntile * 4;
        const int rt = L >> 2, ct = L & 3; int e = 0;
        for (int j = 1; j < NE; ++j) e = (etile[j] <= rt) ? j : e;
        u.pm = rt; u.pn = ct; u.x0 = e; u.x1 = 0;
        if (MODE == 0) { u.a = A; u.rows = rowtok + rt * BM; u.b = W + ((size_t)e * 1024 + ct * BM) * D * 2; }
        else { u.a = A + (size_t)rt * BM * FF * 2; u.rows = nullptr; u.b = W + ((size_t)e * 1024 + ct * BM) * FF * 2; }
        return true;
    }
};

struct EpiU {
    static constexpr bool PERM = true; EPI_NOMID
    bf16_t* Cb; bf16_t* Q; bf16_t* Kb; bf16_t* V; const float* ropec; const float* ropes;
    __device__ __forceinline__ void operator()(Acc& acc, const Unit& u, int wr, int wc, int fr, int fq, LAS unsigned char*, int, int) const {
        const int row0 = u.pm * BM + wr * 64 + fr;
        if (u.pn < 2) {
#pragma unroll
            for (int ai = 0; ai < 2; ++ai)
#pragma unroll
                for (int m = 0; m < 4; ++m) { const int row = row0 + ai * HALF + m * 16; f32x4 o[2];
#pragma unroll
                    for (int n = 0; n < 2; ++n)
#pragma unroll
                        for (int i = 0; i < 4; ++i) { const float a = acc[ai][0][m][n][i], g = acc[ai][1][m][n][i]; o[n][i] = a / (1.f + __expf(-g)); }
                    *(u32x4*)(Cb + (size_t)row * CCH + u.pn * HALF + wc * 32 + fq * 8) = pack8(o[0], o[1]); }
        } else if (u.pn < 8) {
            const int sec = (u.pn - 2) / 3, tt = (u.pn - 2) % 3; bf16_t* dst = sec ? Kb : Q; const float sc = sec ? 1.f : 0.125f * LOG2E;
            const int colb = (4 * tt + wc) * HD + fq * 8;
#pragma unroll
            for (int ai = 0; ai < 2; ++ai)
#pragma unroll
                for (int m = 0; m < 4; ++m) { const int row = row0 + ai * HALF + m * 16; const int s = row & (SEQ - 1); f32x4 o1[2], o2[2];
#pragma unroll
                    for (int n = 0; n < 2; ++n) { const f32x4 cs = *(const f32x4*)(ropec + s * 32 + fq * 8 + n * 4), sn = *(const f32x4*)(ropes + s * 32 + fq * 8 + n * 4);
                        const f32x4 x1 = acc[ai][0][m][n], x2 = acc[ai][1][m][n];
                        o1[n] = (x1 * cs - x2 * sn) * sc; o2[n] = (x1 * sn + x2 * cs) * sc; }
                    bf16_t* p = dst + (size_t)row * AW + colb;
                    *(u32x4*)p = pack8(o1[0], o1[1]); *(u32x4*)(p + 32) = pack8(o2[0], o2[1]); }
        } else {
            const int tt = u.pn - 8;
#pragma unroll
            for (int ai = 0; ai < 2; ++ai)
#pragma unroll
                for (int m = 0; m < 4; ++m) { const int row = row0 + ai * HALF + m * 16;
#pragma unroll
                    for (int bj = 0; bj < 2; ++bj) *(u32x4*)(V + (size_t)row * AW + tt * BM + bj * HALF + wc * 32 + fq * 8) = pack8(acc[ai][bj][m][0], acc[ai][bj][m][1]); }
        }
    }
};
template <bool ROWSCALE> struct EpiPlain {
    static constexpr bool PERM = true; EPI_NOMID
    bf16_t* O0; int ldc0; bf16_t* O1; int ldc1; const float* ssq16;
    __device__ __forceinline__ void operator()(Acc& acc, const Unit& u, int wr, int wc, int fr, int fq, LAS unsigned char*, int, int) const {
        bf16_t* O = u.x0 ? O1 : O0; const int ldc = u.x0 ? ldc1 : ldc0;
        const int row0 = u.pm * BM + wr * 64 + fr, col0 = u.pn * BM + wc * 32 + fq * 8;
#pragma unroll
        for (int ai = 0; ai < 2; ++ai)
#pragma unroll
            for (int m = 0; m < 4; ++m) { const int row = row0 + ai * HALF + m * 16; float rs = 1.f;
                if constexpr (ROWSCALE) { const f32x4* sp = (const f32x4*)(ssq16 + (size_t)row * 16); const f32x4 s0 = sp[0], s1 = sp[1], s2 = sp[2], s3 = sp[3];
                    const f32x4 st = (s0 + s1) + (s2 + s3); rs = 1.0f / sqrtf(((st[0] + st[1]) + (st[2] + st[3])) * (1.0f / D) + NORM_EPS); }
#pragma unroll
                for (int bj = 0; bj < 2; ++bj) *(u32x4*)(O + (size_t)row * ldc + col0 + bj * HALF) = pack8(acc[ai][bj][m][0] * rs, acc[ai][bj][m][1] * rs); }
    }
};
template <bool MID> struct EpiResid {
    static constexpr bool PERM = false, HAS_MID = MID;
    const float* xin; bf16_t* XB; float* ssqp; const float* ssqa;
    __device__ __forceinline__ int mid_t() const { return AW / BK; }
    __device__ __forceinline__ void mid(Acc& acc, const Unit& u, int wr, int wc, int fr, int fq) const {
        const int row0 = u.pm * BM + wr * 64 + fr;
#pragma unroll
        for (int ai = 0; ai < 2; ++ai)
#pragma unroll
            for (int m = 0; m < 4; ++m) { const int row = row0 + ai * HALF + m * 16; const f32x4* sp = (const f32x4*)(ssqa + (size_t)row * NH);
                const f32x4 s0 = sp[0], s1 = sp[1], s2 = sp[2]; const f32x4 st = (s0 + s1) + s2;
                const float r = 1.0f / sqrtf(((st[0] + st[1]) + (st[2] + st[3])) * (1.0f / AW) + NORM_EPS);
#pragma unroll
                for (int bj = 0; bj < 2; ++bj)
#pragma unroll
                    for (int n = 0; n < 2; ++n) acc[ai][bj][m][n] = acc[ai][bj][m][n] * r;
                asm volatile("" ::: "memory"); }
    }
    __device__ __forceinline__ void operator()(Acc& acc, const Unit& u, int wr, int wc, int fr, int fq, LAS unsigned char*, int, int) const {
        const int row0 = u.pm * BM + wr * 64 + fr, col0 = u.pn * BM + wc * 32 + fq * 4;
#pragma unroll
        for (int ai = 0; ai < 2; ++ai)
#pragma unroll
            for (int m = 0; m < 4; ++m) { const int row = row0 + ai * HALF + m * 16; float ss = 0.f;
#pragma unroll
                for (int bj = 0; bj < 2; ++bj)
#pragma unroll
                    for (int n = 0; n < 2; ++n) { const size_t o = (size_t)row * D + col0 + bj * HALF + n * 16; f32x4 v;
                        if constexpr (MID) v = *(const f32x4*)(xin + o) + acc[ai][bj][m][n];
                        else { const u32x2 xb = *(const u32x2*)(XB + o); v = (f32x4){bflo(xb.x), bfhi(xb.x), bflo(xb.y), bfhi(xb.y)} + acc[ai][bj][m][n]; }
                        u32x2 w; w.x = cvt_pk_bf16(v[0], v[1]); w.y = cvt_pk_bf16(v[2], v[3]); *(u32x2*)(XB + o) = w;
                        ss += (v[0] * v[0] + v[1] * v[1]) + (v[2] * v[2] + v[3] * v[3]); }
                ss += __shfl_xor(ss, 16); ss += __shfl_xor(ss, 32);
                if (fq == 0) ssqp[(size_t)row * 16 + u.pn * 4 + wc] = ss; }
    }
};
struct EpiSoftmax {
    static constexpr bool PERM = true; EPI_NOMID
    bf16_t* PM;
    __device__ __forceinline__ void operator()(Acc& acc, const Unit& u, int wr, int wc, int fr, int fq, LAS unsigned char* lds, int, int) const {
        LAS float* MX = (LAS float*)(lds + XCH_OFF); LAS float* SM = (LAS float*)(lds + XCH_OFF + 4096);
#pragma unroll
        for (int ai = 0; ai < 2; ++ai)
#pragma unroll
            for (int m = 0; m < 4; ++m) { const int rl = ai * HALF + wr * 64 + m * 16 + fr; float mx = -3.0e38f;
#pragma unroll
                for (int bj = 0; bj < 2; ++bj)
#pragma unroll
                    for (int n = 0; n < 2; ++n) { const f32x4 v = acc[ai][bj][m][n]; mx = fmaxf(mx, fmaxf(fmaxf(v[0], v[1]), fmaxf(v[2], v[3]))); }
                mx = fmaxf(mx, __shfl_xor(mx, 16)); mx = fmaxf(mx, __shfl_xor(mx, 32));
                if (fq == 0) MX[rl * 4 + wc] = mx; }
        RAW_BARRIER();
#pragma unroll
        for (int ai = 0; ai < 2; ++ai)
#pragma unroll
            for (int m = 0; m < 4; ++m) { const int rl = ai * HALF + wr * 64 + m * 16 + fr; const f32x4 mm = *(const LAS f32x4*)(MX + rl * 4);
                const float mx = fmaxf(fmaxf(mm[0], mm[1]), fmaxf(mm[2], mm[3])); float ss = 0.f;
#pragma unroll
                for (int bj = 0; bj < 2; ++bj)
#pragma unroll
                    for (int n = 0; n < 2; ++n) { f32x4 v = acc[ai][bj][m][n];
#pragma unroll
                        for (int i = 0; i < 4; ++i) { v[i] = __builtin_amdgcn_exp2f(v[i] - mx); ss += v[i]; }
                        acc[ai][bj][m][n] = v; }
                ss += __shfl_xor(ss, 16); ss += __shfl_xor(ss, 32);
                if (fq == 0) SM[rl * 4 + wc] = ss; }
        RAW_BARRIER();
        const int col0 = u.pn * BM + wc * 32 + fq * 8;
#pragma unroll
        for (int ai = 0; ai < 2; ++ai)
#pragma unroll
            for (int m = 0; m < 4; ++m) { const int rl = ai * HALF + wr * 64 + m * 16 + fr; const f32x4 s4 = *(const LAS f32x4*)(SM + rl * 4);
                const float inv = 1.0f / ((s4[0] + s4[1]) + (s4[2] + s4[3]));
#pragma unroll
                for (int bj = 0; bj < 2; ++bj) *(u32x4*)(PM + (size_t)(u.pm * BM + rl) * D + col0 + bj * HALF) = pack8(acc[ai][bj][m][0] * inv, acc[ai][bj][m][1] * inv); }
    }
};
struct EpiMoe1 {
    static constexpr bool PERM = true; EPI_NOMID
    bf16_t* HID; const float* slot_rs;
    __device__ __forceinline__ void operator()(Acc& acc, const Unit& u, int wr, int wc, int fr, int fq, LAS unsigned char*, int, int) const {
        const int row0 = u.pm * BM + wr * 64 + fr;
#pragma unroll
        for (int ai = 0; ai < 2; ++ai)
#pragma unroll
            for (int m = 0; m < 4; ++m) { const int row = row0 + ai * HALF + m * 16; const float rs = slot_rs[row]; f32x4 o[2];
#pragma unroll
                for (int n = 0; n < 2; ++n)
#pragma unroll
                    for (int i = 0; i < 4; ++i) { const float a = acc[ai][0][m][n][i] * rs, b = acc[ai][1][m][n][i] * rs; o[n][i] = a * b / (1.f + __expf(-a)); }
                *(u32x4*)(HID + (size_t)row * FF + u.pn * HALF + wc * 32 + fq * 8) = pack8(o[0], o[1]); }
    }
};
struct EpiMoe2 {
    static constexpr bool PERM = true; EPI_NOMID
    bf16_t* Y; const float* slot_gate;
    __device__ __forceinline__ void operator()(Acc& acc, const Unit& u, int wr, int wc, int fr, int fq, LAS unsigned char*, int, int) const {
        const int row0 = u.pm * BM + wr * 64 + fr, col0 = u.pn * BM + wc * 32 + fq * 8;
#pragma unroll
        for (int ai = 0; ai < 2; ++ai)
#pragma unroll
            for (int m = 0; m < 4; ++m) { const int row = row0 + ai * HALF + m * 16; const float g = slot_gate[row];
#pragma unroll
                for (int bj = 0; bj < 2; ++bj) *(u32x4*)(Y + (size_t)row * D + col0 + bj * HALF) = pack8(acc[ai][bj][m][0] * g, acc[ai][bj][m][1] * g); }
    }
};
}
struct Frame {
    LAS unsigned char* lds;
    volatile LAS unsigned* MISC;
    unsigned* ctl;
    unsigned char* ws;
    int wave, vcu, G;
};
struct Args { const void* in[27]; float* out; unsigned char* ws; int ph_lo, ph_hi, li, pad; };

__device__ __forceinline__ void tr_item(const float* W, int ldw, int srcrow0, int srccol0, bf16_t* WT, int dpitch, size_t drow0, int dk0, const float* gk, float sc, LAS float* scr, int lane) {
    f32x4 v[8]; const int n4 = lane & 7, kq = lane >> 3;
#pragma unroll
    for (int i = 0; i < 8; ++i) v[i] = *(const f32x4*)(W + (size_t)(srcrow0 + kq + 8 * i) * ldw + srccol0 + 4 * n4);
#pragma unroll
    for (int i = 0; i < 8; ++i) { const int kk = kq + 8 * i; const float g = gk ? gk[kk] * sc : sc; LAS float* d = scr + kk * 33 + 4 * n4;
        d[0] = v[i][0] * g; d[1] = v[i][1] * g; d[2] = v[i][2] * g; d[3] = v[i][3] * g; }
    LDS_WAIT(); asm volatile("" ::: "memory");
    const int c = lane & 7;
#pragma unroll
    for (int j = 0; j < 4; ++j) { const int n = (lane >> 3) + 8 * j; const LAS float* s = scr + (8 * c) * 33 + n;
        u32x4 o; o.x = pk2(s[0 * 33], s[1 * 33]); o.y = pk2(s[2 * 33], s[3 * 33]); o.z = pk2(s[4 * 33], s[5 * 33]); o.w = pk2(s[6 * 33], s[7 * 33]);
        *(u32x4*)(WT + (drow0 + n) * dpitch + dk0 + 8 * c) = o; }
    LDS_WAIT(); asm volatile("" ::: "memory");
}
__device__ __forceinline__ void rms_row_to_bf16(const float* xrow, const float* g, bf16_t* orow, int lane) {
    const f32x4* xr = (const f32x4*)xrow + lane; const f32x4* gr = (const f32x4*)g + lane;
    f32x4 v[4]; float s = 0.f;
#pragma unroll
    for (int j = 0; j < 4; ++j) { v[j] = xr[64 * j]; s += (v[j][0] * v[j][0] + v[j][1] * v[j][1]) + (v[j][2] * v[j][2] + v[j][3] * v[j][3]); }
    const float rs = 1.0f / sqrtf(wave_sum(s) * (1.f / D) + NORM_EPS);
    u32x2* o8 = (u32x2*)orow + lane;
#pragma unroll
    for (int j = 0; j < 4; ++j) { const f32x4 gg = gr[64 * j]; u32x2 w; w.x = pk2(v[j][0] * rs * gg[0], v[j][1] * rs * gg[1]); w.y = pk2(v[j][2] * rs * gg[2], v[j][3] * rs * gg[3]); o8[64 * j] = w; }
}
__device__ __forceinline__ void rms_row2_to_bf16(const float* xrow, const float* g, bf16_t* orow, int lane) {
    const f32x4* xr = (const f32x4*)xrow + lane; const f32x4* gr = (const f32x4*)g + lane;
    f32x4 v[2][4]; float s0 = 0.f, s1 = 0.f;
#pragma unroll
    for (int r = 0; r < 2; ++r)
#pragma unroll
        for (int j = 0; j < 4; ++j) v[r][j] = xr[r * 256 + 64 * j];
#pragma unroll
    for (int j = 0; j < 4; ++j) { s0 += (v[0][j][0] * v[0][j][0] + v[0][j][1] * v[0][j][1]) + (v[0][j][2] * v[0][j][2] + v[0][j][3] * v[0][j][3]);
        s1 += (v[1][j][0] * v[1][j][0] + v[1][j][1] * v[1][j][1]) + (v[1][j][2] * v[1][j][2] + v[1][j][3] * v[1][j][3]); }
    const float r0 = 1.0f / sqrtf(wave_sum(s0) * (1.f / D) + NORM_EPS), r1 = 1.0f / sqrtf(wave_sum(s1) * (1.f / D) + NORM_EPS);
    u32x2* o8 = (u32x2*)orow + lane;
#pragma unroll
    for (int j = 0; j < 4; ++j) { const f32x4 gg = gr[64 * j]; u32x2 w;
        w.x = pk2(v[0][j][0] * r0 * gg[0], v[0][j][1] * r0 * gg[1]); w.y = pk2(v[0][j][2] * r0 * gg[2], v[0][j][3] * r0 * gg[3]); o8[64 * j] = w;
        w.x = pk2(v[1][j][0] * r1 * gg[0], v[1][j][1] * r1 * gg[1]); w.y = pk2(v[1][j][2] * r1 * gg[2], v[1][j][3] * r1 * gg[3]); o8[256 + 64 * j] = w; }
}
__device__ __forceinline__ double rope_inv(int d) {
    const int q = d >> 3, r = d & 7;
    double b = 1.0;
    b = (r == 1) ? 0.7498942093324558273 : b; b = (r == 2) ? 0.56234132519034908039 : b; b = (r == 3) ? 0.42169650342858224857 : b; b = (r == 4) ? 0.3162277660168379332 : b;
    b = (r == 5) ? 0.23713737056616552617 : b; b = (r == 6) ? 0.17782794100389228012 : b; b = (r == 7) ? 0.13335214321633240257 : b;
    const double p = (q == 0) ? 1.0 : (q == 1) ? 0.1 : (q == 2) ? 0.01 : 0.001;
    return b * p;
}
__device__ __forceinline__ void sincos_d(double a, double& sn, double& cs) {
    const double k = __builtin_rint(a * 0.63661977236758134308);
    double y = __builtin_fma(-k, 1.57079632679489655800e+00, a); y = __builtin_fma(-k, 6.12323399573676603587e-17, y);
    const double y2 = y * y;
    double s = 1.0 / 6227020800.0; s = s * y2 - 1.0 / 39916800.0; s = s * y2 + 1.0 / 362880.0; s = s * y2 - 1.0 / 5040.0; s = s * y2 + 1.0 / 120.0; s = s * y2 - 1.0 / 6.0; s = s * y2 * y + y;
    double c = 1.0 / 479001600.0; c = c * y2 - 1.0 / 3628800.0; c = c * y2 + 1.0 / 40320.0; c = c * y2 - 1.0 / 720.0; c = c * y2 + 1.0 / 24.0; c = c * y2 - 0.5; c = c * y2 + 1.0;
    const int qd = ((int)k) & 3;
    sn = (qd == 0) ? s : (qd == 1) ? c : (qd == 2) ? -s : -c;
    cs = (qd == 0) ? c : (qd == 1) ? -s : (qd == 2) ? -c : s;
}
typedef const void* gen_cptr;
typedef __attribute__((address_space(4))) const char* cas_cptr;
typedef __attribute__((address_space(4))) const gen_cptr* cas_pptr;
__device__ __forceinline__ const void* karg_ptr(int byte_off) { cas_cptr p = (cas_cptr)__builtin_amdgcn_kernarg_segment_ptr(); asm volatile("" : "+s"(p)); return *(cas_pptr)(p + byte_off); }
__device__ __forceinline__ void p0_prologue(Frame& F) {
    const int lane = lane_id(), tid = F.wave * 64 + lane;
    const float* x = (const float*)karg_ptr(8 * 0); const float* mem = (const float*)karg_ptr(8 * 1); const int* positions = (const int*)karg_ptr(8 * 2);
    const float* mix_g = (const float*)karg_ptr(8 * 3); const float* w_in = (const float*)karg_ptr(8 * 4);
    const float* attn_out_g = (const float*)karg_ptr(8 * 10); const float* w_out = (const float*)karg_ptr(8 * 11);
    const float* xattn_g = (const float*)karg_ptr(8 * 12); const float* mem_g = (const float*)karg_ptr(8 * 13);
    const float* w_xq = (const float*)karg_ptr(8 * 14); const float* w_xk = (const float*)karg_ptr(8 * 15); const float* w_xv = (const float*)karg_ptr(8 * 16); const float* w_xo = (const float*)karg_ptr(8 * 17);
    const float* moe_g = (const float*)karg_ptr(8 * 18); const float* w_group = (const float*)karg_ptr(8 * 19); const float* w_router = (const float*)karg_ptr(8 * 21);
    const float* w1 = (const float*)karg_ptr(8 * 23); const float* w3 = (const float*)karg_ptr(8 * 24); const float* w2 = (const float*)karg_ptr(8 * 25);
    unsigned char* ws = F.ws;
    LAS float* scr = (LAS float*)(F.lds + F.wave * 16384);
    const int gw = F.vcu * NWAVES + F.wave, NGW = F.G * NWAVES;
    constexpr int I_IN = 16 * 88, I_SQ = 16 * 32, I_13 = NE * 16 * 32, I_2 = NE * 8 * 32;
    constexpr int NITEMS = I_IN + 5 * I_SQ + I_13 + I_2;
    for (int it = gw; it < NITEMS; it += NGW) {
        int r = it;
        if (r < I_IN) { const int kb = r / 88, nb = r % 88, n0 = 32 * nb, tile = n0 >> 8, j = n0 & 255; int src;
            if (tile < 2) src = (j < 128) ? 128 * tile + j : 256 + 128 * tile + (j - 128);
            else if (tile < 8) { const int sec = (tile - 2) / 3, tt = (tile - 2) % 3, jj = j & 127, hh = jj >> 5; src = 512 + 768 * sec + 256 * tt + 64 * hh + ((j < 128) ? 0 : 32); }
            else src = n0;
            tr_item(w_in, INW, 64 * kb, src, (bf16_t*)(ws + WS_WIN), D, (size_t)n0, 64 * kb, nullptr, 1.f, scr, lane); continue; }
        r -= I_IN;
        if (r < I_SQ) { const int kb = r / 32, nb = r % 32, dk0 = 64 * kb; const bool at = dk0 < AW;
            tr_item(w_out, D, at ? CCH + dk0 : dk0 - AW, 32 * nb, (bf16_t*)(ws + WS_WOUT), D, (size_t)(32 * nb), dk0, at ? attn_out_g + dk0 : nullptr, 1.f, scr, lane); continue; }
        r -= I_SQ;
        if (r < 4 * I_SQ) { const int which = r / I_SQ, r2 = r % I_SQ, kb = r2 / 32, nb = r2 % 32;
            const float* W = which == 0 ? w_xq : which == 1 ? w_xk : which == 2 ? w_xv : w_xo;
            bf16_t* WT = (bf16_t*)(ws + (which == 0 ? WS_WXQ : which == 1 ? WS_WXK : which == 2 ? WS_WXV : WS_WXO));
            tr_item(W, D, 64 * kb, 32 * nb, WT, D, (size_t)(32 * nb), 64 * kb, which == 0 ? xattn_g + 64 * kb : nullptr, which == 0 ? LOG2E / 16.f : 1.f, scr, lane); continue; }
        r -= 4 * I_SQ;
        if (r < I_13) { const int e = r / 512, r2 = r % 512, kb = r2 / 32, nb = r2 % 32, n0 = 32 * nb, tt = n0 >> 8, j = n0 & 255;
            const float* W = ((j < 128) ? w1 : w3) + (size_t)e * D * FF;
            tr_item(W, FF, 64 * kb, 128 * tt + (j & 127), (bf16_t*)(ws + WS_W13), D, (size_t)e * 1024 + n0, 64 * kb, moe_g + 64 * kb, 1.f, scr, lane); continue; }
        r -= I_13;
        { const int e = r / 256, r2 = r % 256, kb = r2 / 32, nb = r2 % 32;
            tr_item(w2 + (size_t)e * FF * D, D, 64 * kb, 32 * nb, (bf16_t*)(ws + WS_W2), FF, (size_t)e * 1024 + 32 * nb, 64 * kb, nullptr, 1.f, scr, lane); }
    }
    { bf16_t* WRF = (bf16_t*)(ws + WS_HIST + HIST_WR);
      for (int i = blockIdx.x * 512 + tid; i < 4 * 8 * 3 * 2 * 64 * 8; i += F.G * 512) {
          const int j = i & 7, ln = (i >> 3) & 63, part = (i >> 9) & 1, blk = i >> 10, nt = blk % 3, s = (blk / 3) & 7, kc = blk / 24;
          const int k = 256 * kc + 32 * s + 8 * (ln >> 4) + j, o = 16 * nt + (ln & 15);
          float v = 0.f; if (o < 32) v = w_router[k * 32 + o] * moe_g[k]; else if (o < 36) v = w_group[k * 4 + (o - 32)] * moe_g[k];
          const unsigned hb = f2bf(v); const float hf = __builtin_bit_cast(float, hb << 16);
          WRF[i] = (bf16_t)(part ? f2bf(v - hf) : hb); } }
    { float* rc = (float*)(ws + WS_ROPE); float* rsn = rc + SEQ * 32;
      for (int i = blockIdx.x * 512 + tid; i < SEQ * 32; i += F.G * 512) { const int s = i >> 5, d = i & 31;
          const float inv = (float)rope_inv(d); const float ang = (float)positions[s] * inv; double sn, cs; sincos_d((double)fabsf(ang), sn, cs); if (ang < 0.f) sn = -sn;
          rc[i] = (float)cs; rsn[i] = (float)sn; } }
    for (int m = gw; m < MROWS; m += NGW) rms_row_to_bf16(mem + (size_t)m * D, mem_g, (bf16_t*)(ws + WS_MEMN) + (size_t)m * D, lane);
    for (int m = 2 * gw; m < T; m += 2 * NGW) rms_row2_to_bf16(x + (size_t)m * D, mix_g, (bf16_t*)(ws + WS_R1) + (size_t)m * D, lane);
}
namespace att {
typedef short v4i16_t __attribute__((ext_vector_type(4)));
constexpr int BUFB = 65536, VIMG = 32768;
constexpr float NEG = -1.0e30f, MFLOOR = -1.0e9f;
__device__ __forceinline__ int k_off(int row, int c) { return row * 128 + ((c ^ ((row >> 1) & 7)) << 4); }
__device__ __forceinline__ int v_off(int row, int c) { return VIMG + row * 128 + ((c ^ (((row >> 1) & 3) << 1)) << 4); }

struct Grp { bf16x8 q0, q1; f32x4 o[4]; float m, l; };
struct KV { bf16x8 k[2][2]; bf16x8 v[4]; };

#ifdef ATT_SHFL
__device__ __forceinline__ float xmax16(float v) { return fmaxf(v, __shfl_xor(v, 16)); }
__device__ __forceinline__ float xmax32(float v) { return fmaxf(v, __shfl_xor(v, 32)); }
__device__ __forceinline__ float xsum16(float v) { return v + __shfl_xor(v, 16); }
__device__ __forceinline__ float xsum32(float v) { return v + __shfl_xor(v, 32); }
#else
__device__ __forceinline__ void swap16(float v, float& a, float& b) { a = v; b = v; asm volatile("s_nop 1\n\tv_permlane16_swap_b32 %0, %1" : "+v"(a), "+v"(b)); }
__device__ __forceinline__ void swap32(float v, float& a, float& b) { a = v; b = v; asm volatile("s_nop 1\n\tv_permlane32_swap_b32 %0, %1" : "+v"(a), "+v"(b)); }
__device__ __forceinline__ float xmax16(float v) { float a, b; swap16(v, a, b); return fmaxf(a, b); }
__device__ __forceinline__ float xmax32(float v) { float a, b; swap32(v, a, b); return fmaxf(a, b); }
__device__ __forceinline__ float xsum16(float v) { float a, b; swap16(v, a, b); return a + b; }
__device__ __forceinline__ float xsum32(float v) { float a, b; swap32(v, a, b); return a + b; }
#endif
constexpr int NSTEP_ = 19;
__device__ __forceinline__ int step_pos(int step, int row, int c0) {
    if (step < 3) { const int hh = row >> 7, jj = row & 127; return c0 + 256 * hh - 64 + 128 * step + jj; }
    if (step < 9) { const int s = step - 3, hh = row >> 7, c = (row >> 5) & 3, jj = row & 31; return 4 * ((c0 >> 2) + 64 * hh - 64 + 32 * s + jj) + c; }
    { const int s = step - 9, pb = s >> 1, rh = s & 1, rr = row >> 5, jj = row & 31; return 16 * ((c0 >> 4) - 64 + 32 * pb + jj) + 8 * rh + rr; }
}
__device__ __forceinline__ void stage_issue(unsigned ldsbuf, const char* Kg, const char* Vg, int brow0, int hcol, int c0, int step, int wave, int lane) {
    const bool isV = wave >= 4; const char* gb = pg8::uniform_ptr(isV ? Vg : Kg);
#pragma unroll
    for (int i = 0; i < 8; ++i) { const int blk = (wave & 3) * 8 + i, row = 8 * blk + (lane >> 3), phys = lane & 7;
        const int c = isV ? (phys ^ (((row >> 1) & 3) << 1)) : (phys ^ ((row >> 1) & 7));
        int pos = step_pos(step, row, c0); pos = pos < 0 ? 0 : (pos > SEQ - 1 ? SEQ - 1 : pos);
        const unsigned voff = (unsigned)((brow0 + pos) * AW + hcol + c * 8) * 2u;
        pg8::glds16_sv(gb, voff, ldsbuf + (isV ? (unsigned)VIMG : 0u) + (unsigned)blk * 1024u); __builtin_amdgcn_sched_barrier(0); }
}
struct LaneOff { int kb0; int vb[4]; };
__device__ __forceinline__ void lane_off(LaneOff& o, int lane) {
    const int key = lane & 15, g = lane >> 4, q = (lane >> 2) & 3, p2 = lane & 3;
    o.kb0 = k_off(key, g);
#pragma unroll
    for (int db = 0; db < 4; ++db) o.vb[db] = v_off(4 * g + q, 2 * db + (p2 >> 1)) + 8 * (p2 & 1);
}
__device__ __forceinline__ const LAS unsigned char* row_base(const LAS unsigned char* buf, int Rb) {
    return (const LAS unsigned char*)(uintptr_t)(unsigned)__builtin_amdgcn_readfirstlane((int)((unsigned)(uintptr_t)buf + (unsigned)(Rb * 128))); }
__device__ __forceinline__ void load_k(bf16x8 (&k)[2][2], const LAS unsigned char* buf, int Rb, const LaneOff& lo) {
    const LAS unsigned char* rb = row_base(buf, Rb);
#pragma unroll
    for (int t = 0; t < 2; ++t) { k[t][0] = *(const LAS bf16x8*)(rb + t * 2048 + lo.kb0); k[t][1] = *(const LAS bf16x8*)(rb + t * 2048 + (lo.kb0 ^ 64)); }
}
__device__ __forceinline__ void load_v(bf16x8 (&v)[4], const LAS unsigned char* buf, int Rb, const LaneOff& lo) {
    const LAS unsigned char* rb = row_base(buf, Rb);
#pragma unroll
    for (int db = 0; db < 4; ++db) {
        const s16x4 v0 = __builtin_bit_cast(s16x4, __builtin_amdgcn_ds_read_tr16_b64_v4i16((LAS v4i16_t*)(rb + lo.vb[db])));
        const s16x4 v1 = __builtin_bit_cast(s16x4, __builtin_amdgcn_ds_read_tr16_b64_v4i16((LAS v4i16_t*)(rb + 2048 + lo.vb[db])));
        v[db] = (bf16x8){v0[0], v0[1], v0[2], v0[3], v1[0], v1[1], v1[2], v1[3]}; }
}
__device__ __forceinline__ float fmax_nc(float a, float b) { float r; asm("v_max_f32_e32 %0, %1, %2" : "=v"(r) : "v"(a), "v"(b)); return r; }
__device__ __forceinline__ float fmax3_nc(float a, float b, float c) { float r; asm("v_max3_f32 %0, %1, %2, %3" : "=v"(r) : "v"(a), "v"(b), "v"(c)); return r; }
__device__ __forceinline__ void qk_part(const Grp& G, const bf16x8 (&k)[2][2], f32x4 (&s)[2]) {
#pragma unroll
    for (int t = 0; t < 2; ++t) { f32x4 z = (f32x4){0.f, 0.f, 0.f, 0.f};
        z = __builtin_amdgcn_mfma_f32_16x16x32_bf16(k[t][0], G.q0, z, 0, 0, 0); s[t] = __builtin_amdgcn_mfma_f32_16x16x32_bf16(k[t][1], G.q1, z, 0, 0, 0); }
}
template <bool FULL, bool INR>
__device__ __forceinline__ void sm_part(Grp& G, f32x4 (&s)[2], int ksub0, int qsub, int L, int lane, bf16x8& pb, float& alpha) {
    const int g = lane >> 4;
    if constexpr (!FULL) { const int d0 = ksub0 + 4 * g - qsub + 64, k0 = ksub0 + 4 * g;
#pragma unroll
        for (int t = 0; t < 2; ++t)
#pragma unroll
            for (int i = 0; i < 4; ++i) { bool ok = ((unsigned)(d0 + 16 * t + i) <= 128u); if constexpr (!INR) ok = ok && ((unsigned)(k0 + 16 * t + i) < (unsigned)L); s[t][i] = ok ? s[t][i] : NEG; } }
    float mx = fmax3_nc(fmax3_nc(s[0][0], s[0][1], s[0][2]), fmax3_nc(s[0][3], s[1][0], s[1][1]), fmax3_nc(s[1][2], s[1][3], G.m));
    { float a, b; swap16(mx, a, b); mx = fmax_nc(a, b); swap32(mx, a, b); mx = fmax_nc(a, b); }
    const float mn = mx; alpha = __builtin_amdgcn_exp2f(G.m - mn);
    G.m = mn; float p[2][4]; float ps = 0.f;
#pragma unroll
    for (int t = 0; t < 2; ++t)
#pragma unroll
        for (int i = 0; i < 4; ++i) { const float e = __builtin_amdgcn_exp2f(s[t][i] - mn); p[t][i] = e; ps += e; }
    G.l = G.l * alpha + ps;
    u32x4 pw; pw.x = cvt_pk_bf16(p[0][0], p[0][1]); pw.y = cvt_pk_bf16(p[0][2], p[0][3]); pw.z = cvt_pk_bf16(p[1][0], p[1][1]); pw.w = cvt_pk_bf16(p[1][2], p[1][3]);
    pb = __builtin_bit_cast(bf16x8, pw);
}
__device__ __forceinline__ void pv_part(Grp& G, const bf16x8 (&v)[4], const bf16x8& pb, float alpha) {
#pragma unroll
    for (int db = 0; db < 4; ++db) G.o[db] = __builtin_amdgcn_mfma_f32_16x16x32_bf16(v[db], pb, G.o[db] * alpha, 0, 0, 0);
}
__device__ __forceinline__ void grp_init(Grp& G, const bf16_t* Qb, size_t tok0, int hcol, int lane) {
    const int a = lane & 15, g = lane >> 4; const bf16_t* qp = Qb + (tok0 + 16 * a) * AW + hcol + 8 * g;
    G.q0 = *(const bf16x8*)qp; G.q1 = *(const bf16x8*)(qp + 32);
#pragma unroll
    for (int d = 0; d < 4; ++d) G.o[d] = (f32x4){0.f, 0.f, 0.f, 0.f};
    G.m = MFLOOR; G.l = 0.f;
}
__device__ __forceinline__ void grp_finish(Grp& G, bf16_t* MIX, float* ssqa, size_t tok0, int h, int lane) {
    const int a = lane & 15, g = lane >> 4; float l = G.l; l = xsum16(l); l = xsum32(l);
    const float inv = 1.0f / l; const size_t tok = tok0 + 16 * a; float ss = 0.f;
#pragma unroll
    for (int db = 0; db < 4; ++db) { const f32x4 o = G.o[db] * inv; ss += (o[0] * o[0] + o[1] * o[1]) + (o[2] * o[2] + o[3] * o[3]);
        u32x2 w; w.x = cvt_pk_bf16(o[0], o[1]); w.y = cvt_pk_bf16(o[2], o[3]); *(u32x2*)(MIX + tok * D + h * HD + 16 * db + 4 * g) = w; }
    ss = xsum16(ss); ss = xsum32(ss);
    if (g == 0) ssqa[tok * NH + h] = ss;
}
#define ATT_SYNC() do { asm volatile("s_waitcnt vmcnt(0) lgkmcnt(0)" ::: "memory"); __builtin_amdgcn_s_barrier(); asm volatile("" ::: "memory"); } while (0)
#define ATT_SB() __builtin_amdgcn_sched_barrier(0)
template <bool INR>
__device__ __forceinline__ void pair4(Grp& G0, Grp& G1, Grp& G2, Grp& G3, const LAS unsigned char* buf, int Rb, const LaneOff& lo, int ks0, int qs, int dq, int L, int lane) {
    f32x4 s0[2], s1[2], s2[2], s3[2]; bf16x8 p0, p1, p2, p3; float a0, a1, a2, a3;
    { bf16x8 k[2][2]; load_k(k, buf, Rb, lo); qk_part(G0, k, s0); qk_part(G1, k, s1); qk_part(G2, k, s2); qk_part(G3, k, s3); } ATT_SB();
    bf16x8 v[4]; load_v(v, buf, Rb, lo);
    sm_part<false, INR>(G0, s0, ks0, qs, L, lane, p0, a0); sm_part<false, INR>(G1, s1, ks0, qs + dq, L, lane, p1, a1); ATT_SB();
    sm_part<false, INR>(G2, s2, ks0, qs + 2 * dq, L, lane, p2, a2); sm_part<false, INR>(G3, s3, ks0, qs + 3 * dq, L, lane, p3, a3); ATT_SB();
    pv_part(G0, v, p0, a0); pv_part(G1, v, p1, a1); pv_part(G2, v, p2, a2); pv_part(G3, v, p3, a3); ATT_SB();
}
template <bool FULL, bool INR>
__device__ __forceinline__ void pair2(Grp& GA, Grp& GB, const LAS unsigned char* buf, int RbA, int RbB, const LaneOff& lo, int ks0, int qs, int L, int lane) {
    f32x4 s0[2], s1[2]; bf16x8 p0, p1; float a0, a1;
    { bf16x8 ka[2][2], kb[2][2]; load_k(ka, buf, RbA, lo); load_k(kb, buf, RbB, lo); qk_part(GA, ka, s0); qk_part(GB, kb, s1); } ATT_SB();
    bf16x8 va[4], vb[4]; load_v(va, buf, RbA, lo); load_v(vb, buf, RbB, lo);
    sm_part<FULL, INR>(GA, s0, ks0, qs, L, lane, p0, a0); sm_part<FULL, INR>(GB, s1, ks0, qs, L, lane, p1, a1); ATT_SB();
    pv_part(GA, va, p0, a0); pv_part(GB, vb, p1, a1); ATT_SB();
}
__device__ __forceinline__ void attn_unit(LAS unsigned char* lds, const bf16_t* Qb, const bf16_t* Kb, const bf16_t* Vb, bf16_t* MIX, float* ssqa, int b, int h, int c0, int tid, int wave, int lane_) {
    int lane = lane_; asm volatile("" : "+v"(lane));
    const int brow0 = b * SEQ, hcol = h * HD, half = wave >> 2, w4 = wave & 3, ch = c0 + 256 * half;
    const unsigned lds0 = (unsigned)(uintptr_t)lds;
    const size_t tokb = (size_t)(brow0 + ch + w4);
    Grp G0, G1, G2, G3;
    grp_init(G0, Qb, tokb, hcol, lane); grp_init(G1, Qb, tokb + 4, hcol, lane); grp_init(G2, Qb, tokb + 8, hcol, lane); grp_init(G3, Qb, tokb + 12, hcol, lane);
    ATT_SYNC();
    { int ln = lane; asm volatile("" : "+v"(ln)); stage_issue(lds0, (const char*)Kb, (const char*)Vb, brow0, hcol, c0, 0, wave, ln); }
#pragma nounroll
    for (int step = 0; step < NSTEP_; ++step) {
        ATT_SYNC();
        int ln = lane; asm volatile("" : "+v"(ln));
        if (step + 1 < NSTEP_) stage_issue(lds0 + (unsigned)(((step + 1) & 1) * BUFB), (const char*)Kb, (const char*)Vb, brow0, hcol, c0, step + 1, wave, ln);
        const LAS unsigned char* buf = lds + (step & 1) * BUFB;
        LaneOff lo; lane_off(lo, ln); const int a = ln & 15;
        if (step < 3) {
            const int qs = ch + w4 + 16 * a;
#pragma nounroll
            for (int p = 0; p < 4; ++p) { const int ks0 = ch - 64 + 128 * step + 32 * p;
                if (ks0 + 31 >= 0 && ks0 < SEQ) { const int Rb = 128 * half + 32 * p;
                    if (ks0 >= 0 && ks0 + 32 <= SEQ) pair4<true>(G0, G1, G2, G3, buf, Rb, lo, ks0, qs, 4, SEQ, ln); else pair4<false>(G0, G1, G2, G3, buf, Rb, lo, ks0, qs, 4, SEQ, ln); } }
        } else if (step < 9) {
            const int s = step - 3, ks0 = (ch >> 2) - 64 + 32 * s, qs = (ch >> 2) + 4 * a;
            if (ks0 + 31 >= 0 && ks0 < SEQ / 4) { const int Rb = 128 * half + 32 * w4;
                if (ks0 >= 0 && ks0 + 32 <= SEQ / 4) pair4<true>(G0, G1, G2, G3, buf, Rb, lo, ks0, qs, 1, SEQ / 4, ln); else pair4<false>(G0, G1, G2, G3, buf, Rb, lo, ks0, qs, 1, SEQ / 4, ln); }
        } else {
            const int s = step - 9, pb = s >> 1, rh = s & 1, ks0 = (c0 >> 4) - 64 + 32 * pb, qlo = (ch >> 4), qs = qlo + a;
            if (ks0 + 31 >= 0 && ks0 < SEQ / 16 && ks0 <= qlo + 15 + 64 && ks0 + 31 >= qlo - 64) {
                const int RA = 32 * w4, RB = 32 * (w4 + 4);
                const bool inr = (ks0 >= 0) && (ks0 + 32 <= SEQ / 16), full = inr && (ks0 + 31 - qlo <= 64) && (qlo + 15 - ks0 <= 64);
                if (rh == 0) { if (full) pair2<true, true>(G0, G1, buf, RA, RB, lo, ks0, qs, SEQ / 16, ln); else if (inr) pair2<false, true>(G0, G1, buf, RA, RB, lo, ks0, qs, SEQ / 16, ln); else pair2<false, false>(G0, G1, buf, RA, RB, lo, ks0, qs, SEQ / 16, ln); }
                else { if (full) pair2<true, true>(G2, G3, buf, RA, RB, lo, ks0, qs, SEQ / 16, ln); else if (inr) pair2<false, true>(G2, G3, buf, RA, RB, lo, ks0, qs, SEQ / 16, ln); else pair2<false, false>(G2, G3, buf, RA, RB, lo, ks0, qs, SEQ / 16, ln); }
            }
        }
    }
    { int lf = lane; asm volatile("" : "+v"(lf)); const size_t tf = (size_t)(brow0 + ch + w4);
      grp_finish(G0, MIX, ssqa, tf, h, lf); grp_finish(G1, MIX, ssqa, tf + 4, h, lf); grp_finish(G2, MIX, ssqa, tf + 8, h, lf); grp_finish(G3, MIX, ssqa, tf + 12, h, lf); }
}
__device__ __forceinline__ void conv_unit(LAS unsigned char* lds, const bf16_t* Cb, bf16_t* MIX, const float* dw_w, const float* dw_b, const float* ln_g, const float* ln_b, const float* out_g,
                                          int b, int s0, int tid_, int wave, int lane_) {
    int tid = tid_, lane = lane_; asm volatile("" : "+v"(tid), "+v"(lane));
    LAS bf16_t* CT = (LAS bf16_t*)lds;
    LAS float* CO = (LAS float*)(lds + 49152);
    ATT_SYNC();
    for (int p = tid; p < 94 * 32; p += NWAVES * 64) { const int row = p >> 5, c = p & 31, s = s0 - 15 + row;
        u32x4 v = (u32x4){0u, 0u, 0u, 0u};
        if (s >= 0 && s < SEQ) v = *(const u32x4*)(Cb + (size_t)(b * SEQ + s) * CCH + c * 8);
        *(LAS u32x4*)(CT + row * CCH + c * 8) = v; }
    ATT_SYNC();
    { const int ch = tid & 255, half = tid >> 8; float v[62], w[CONVK];
#pragma unroll
      for (int k = 0; k < CONVK; ++k) w[k] = dw_w[k * CCH + ch];
#pragma unroll
      for (int i = 0; i < 62; ++i) v[i] = bf2f(CT[(32 * half + i) * CCH + ch]);
      const float bias = dw_b[ch];
#pragma unroll
      for (int p = 0; p < 32; ++p) { float acc = bias;
#pragma unroll
          for (int k = 0; k < CONVK; ++k) acc += v[p + k] * w[k];
          CO[(32 * half + p) * CCH + ch] = acc; } }
    ATT_SYNC();
    { const f32x4 g4 = *((const f32x4*)ln_g + lane), b4 = *((const f32x4*)ln_b + lane), og = *((const f32x4*)out_g + lane);
#pragma unroll
      for (int pp = 0; pp < 8; ++pp) { const int p = wave * 8 + pp; const f32x4 xv = *(const LAS f32x4*)(CO + p * CCH + 4 * lane);
          const float mean = wave_sum((xv[0] + xv[1]) + (xv[2] + xv[3])) * (1.f / CCH); const f32x4 dx = xv - mean;
          const float var = wave_sum((dx[0] * dx[0] + dx[1] * dx[1]) + (dx[2] * dx[2] + dx[3] * dx[3])) * (1.f / CCH); const float rstd = 1.0f / sqrtf(var + LN_EPS);
          f32x4 z;
#pragma unroll
          for (int i = 0; i < 4; ++i) { const float y = dx[i] * rstd * g4[i] + b4[i]; z[i] = y / (1.f + __expf(-y)); }
          const float ms = wave_sum((z[0] * z[0] + z[1] * z[1]) + (z[2] * z[2] + z[3] * z[3])) * (1.f / CCH); const float rs = 1.0f / sqrtf(ms + NORM_EPS);
          u32x2 o; o.x = cvt_pk_bf16(z[0] * rs * og[0], z[1] * rs * og[1]); o.y = cvt_pk_bf16(z[2] * rs * og[2], z[3] * rs * og[3]);
          *(u32x2*)(MIX + (size_t)(b * SEQ + s0 + p) * D + AW + 4 * lane) = o; } }
}
}
namespace moe {
#define MOE_SYNC() do { asm volatile("s_waitcnt vmcnt(0) lgkmcnt(0)" ::: "memory"); __builtin_amdgcn_s_barrier(); asm volatile("" ::: "memory"); } while (0)
__device__ __forceinline__ void split_hi_lo(const f32x4& a, const f32x4& b, bf16x8& hi, bf16x8& lo) {
    u32x4 h, l; float r[8];
    h.x = cvt_pk_bf16(a[0], a[1]); h.y = cvt_pk_bf16(a[2], a[3]); h.z = cvt_pk_bf16(b[0], b[1]); h.w = cvt_pk_bf16(b[2], b[3]);
    r[0] = a[0] - bflo(h.x); r[1] = a[1] - bfhi(h.x); r[2] = a[2] - bflo(h.y); r[3] = a[3] - bfhi(h.y);
    r[4] = b[0] - bflo(h.z); r[5] = b[1] - bfhi(h.z); r[6] = b[2] - bflo(h.w); r[7] = b[3] - bfhi(h.w);
    l.x = cvt_pk_bf16(r[0], r[1]); l.y = cvt_pk_bf16(r[2], r[3]); l.z = cvt_pk_bf16(r[4], r[5]); l.w = cvt_pk_bf16(r[6], r[7]);
    hi = __builtin_bit_cast(bf16x8, h); lo = __builtin_bit_cast(bf16x8, l);
}
__device__ __forceinline__ void route_chunk(LAS unsigned char* lds, const bf16_t* x2, const float* ssq2, const bf16_t* WRF, const float* b_router, const float* b_group,
                                            int* tok_e, float* tok_gate, float* tok_rs, int* hist, int chunk, int tid, int wave, int lane) {
    LAS unsigned char* WB = lds;
    LAS float* LG = (LAS float*)(lds + 49152);
    LAS int* HS = (LAS int*)(lds + 49152 + 36864);
    const int tk = lane & 15, g = lane >> 4;
    f32x4 acc[2][3];
#pragma unroll
    for (int gi = 0; gi < 2; ++gi)
#pragma unroll
        for (int nt = 0; nt < 3; ++nt) acc[gi][nt] = (f32x4){0.f, 0.f, 0.f, 0.f};
    if (tid < 32) HS[tid] = 0;
    const bf16_t* xb = x2 + (size_t)(chunk * 256 + wave * 32 + tk) * D + 8 * g;
#pragma nounroll
    for (int kc = 0; kc < 4; ++kc) {
        MOE_SYNC();
#pragma unroll
        for (int i = 0; i < 6; ++i) { const int p = tid + 512 * i; *(LAS u32x4*)(WB + p * 16) = *(const u32x4*)((const char*)WRF + (size_t)kc * 49152 + p * 16); }
        MOE_SYNC();
#pragma unroll
        for (int gi = 0; gi < 2; ++gi) {
            bf16x8 xa[8];
#pragma unroll
            for (int s = 0; s < 8; ++s) xa[s] = *(const bf16x8*)(xb + (size_t)gi * 16 * D + kc * 256 + s * 32);
#pragma unroll
            for (int s = 0; s < 8; ++s) {
#pragma unroll
                for (int nt = 0; nt < 3; ++nt) { const LAS unsigned char* bp = WB + ((s * 3 + nt) * 2) * 1024 + lane * 16;
                    const bf16x8 bh = *(const LAS bf16x8*)bp, bl = *(const LAS bf16x8*)(bp + 1024);
                    acc[gi][nt] = __builtin_amdgcn_mfma_f32_16x16x32_bf16(xa[s], bh, acc[gi][nt], 0, 0, 0);
                    acc[gi][nt] = __builtin_amdgcn_mfma_f32_16x16x32_bf16(xa[s], bl, acc[gi][nt], 0, 0, 0); } }
        }
    }
#pragma unroll
    for (int gi = 0; gi < 2; ++gi)
#pragma unroll
        for (int nt = 0; nt < 3; ++nt) { const int o = 16 * nt + tk;
            if (o < 36) {
#pragma unroll
                for (int r = 0; r < 4; ++r) LG[(wave * 32 + gi * 16 + 4 * g + r) * 36 + o] = acc[gi][nt][r]; } }
    MOE_SYNC();
    if (wave < 4) { const int tr = wave * 64 + lane, tg = chunk * 256 + tr; const LAS float* lg = LG + tr * 36;
        const f32x4* sp = (const f32x4*)(ssq2 + (size_t)tg * 16); const f32x4 st = (sp[0] + sp[1]) + (sp[2] + sp[3]);
        const float rs = 1.0f / sqrtf(((st[0] + st[1]) + (st[2] + st[3])) * (1.f / D) + NORM_EPS);
        tok_rs[tg] = rs;
        float gl[4];
#pragma unroll
        for (int j = 0; j < 4; ++j) gl[j] = lg[32 + j] * rs + b_group[j];
        float gm = gl[0]; int gi = 0;
#pragma unroll
        for (int j = 1; j < 4; ++j) { if (gl[j] > gm) { gm = gl[j]; gi = j; } }
        float den = 0.f;
#pragma unroll
        for (int j = 0; j < 4; ++j) den += __expf(gl[j] - gm);
        const float gp = 1.0f / den;
        float v0 = -3.0e38f, v1 = -3.0e38f; int i0 = 0, i1 = 0;
#pragma unroll
        for (int j = 0; j < 8; ++j) { const float v = lg[gi * 8 + j] * rs + b_router[gi * 8 + j];
            if (v > v0) { v1 = v0; i1 = i0; v0 = v; i0 = j; } else if (v > v1) { v1 = v; i1 = j; } }
        const float dd = __expf(v1 - v0), g0 = gp / (1.f + dd), g1 = gp * dd / (1.f + dd);
        const int e0 = gi * 8 + i0, e1 = gi * 8 + i1;
        __hip_atomic_fetch_add(HS + e0, 1, __ATOMIC_RELAXED, __HIP_MEMORY_SCOPE_WORKGROUP); __hip_atomic_fetch_add(HS + e1, 1, __ATOMIC_RELAXED, __HIP_MEMORY_SCOPE_WORKGROUP);
        tok_e[tg] = e0 | (e1 << 8); tok_gate[2 * tg] = g0; tok_gate[2 * tg + 1] = g1; }
    MOE_SYNC();
    if (tid < 32) hist[chunk * 32 + tid] = HS[tid];
}
__device__ __forceinline__ void slot_chunk(LAS unsigned char* lds, const int* hist, const int* tok_e, const float* tok_gate, const float* tok_rs, int* tok_slot, int* row_tok, float* slot_rs, float* slot_gate, int* etile,
                                           int chunk, int tid, int wave, int lane) {
    LAS int* CNT = (LAS int*)lds; LAS int* BASE = CNT + 32; LAS int* PST = CNT + 64; LAS int* WC = CNT + 128;
    MOE_SYNC();
    if (tid < 32) { int tot = 0, bs = 0; for (int cc = 0; cc < 256; ++cc) { const int hh = hist[cc * 32 + tid]; bs += (cc < chunk) ? hh : 0; tot += hh; } CNT[tid] = tot; BASE[tid] = bs; }
    MOE_SYNC();
    if (tid == 0) { int ps = 0; for (int e = 0; e < 32; ++e) { PST[e] = ps; ps += ((CNT[e] + 255) >> 8) << 8; } PST[32] = ps; }
    MOE_SYNC();
    int ek[2] = {0, 0}, rank[2] = {0, 0}; const int t = chunk * 256 + (wave & 3) * 64 + lane;
    if (wave < 4) { const int ev = tok_e[t]; ek[0] = ev & 255; ek[1] = ev >> 8;
#pragma unroll
        for (int k = 0; k < 2; ++k)
#pragma nounroll
            for (int e = 0; e < 32; ++e) { const unsigned long long m = __ballot(ek[k] == e);
                if (ek[k] == e) rank[k] = __popcll(m & ((1ull << lane) - 1ull));
                if (lane == 0) WC[(k * 4 + wave) * 32 + e] = __popcll(m); } }
    MOE_SYNC();
    if (wave < 4) {
#pragma unroll
        for (int k = 0; k < 2; ++k) { int off = 0;
            for (int kw = 0; kw < k * 4 + wave; ++kw) off += WC[kw * 32 + ek[k]];
            const int slot = PST[ek[k]] + BASE[ek[k]] + off + rank[k];
            row_tok[slot] = t; slot_rs[slot] = tok_rs[t]; slot_gate[slot] = tok_gate[2 * t + k]; tok_slot[2 * t + k] = slot; } }
    if (chunk < 32) { const int e = chunk, c0 = PST[e] + CNT[e], n = PST[e + 1] - c0;
        for (int i = tid; i < n; i += NWAVES * 64) { row_tok[c0 + i] = 0; slot_rs[c0 + i] = 0.f; slot_gate[c0 + i] = 0.f; } }
    if (chunk == 0 && tid <= 32) etile[tid] = PST[tid] >> 8;
}
__device__ __forceinline__ void final_row(float* xo, const bf16_t* X2, const bf16_t* Y, const int* tok_slot, const float* g, int t, int lane) {
    const int s0 = tok_slot[2 * t], s1 = tok_slot[2 * t + 1];
    f32x4* xr = (f32x4*)(xo + (size_t)t * D) + lane; const u32x2* x2 = (const u32x2*)(X2 + (size_t)t * D) + lane;
    const u32x2* y0 = (const u32x2*)(Y + (size_t)s0 * D) + lane; const u32x2* y1 = (const u32x2*)(Y + (size_t)s1 * D) + lane;
    const f32x4* gr = (const f32x4*)g + lane;
    f32x4 v[4]; float s = 0.f;
#pragma unroll
    for (int j = 0; j < 4; ++j) { const u32x2 x = x2[64 * j], a = y0[64 * j], b = y1[64 * j];
        v[j][0] = bflo(x.x) + (bflo(a.x) + bflo(b.x)); v[j][1] = bfhi(x.x) + (bfhi(a.x) + bfhi(b.x)); v[j][2] = bflo(x.y) + (bflo(a.y) + bflo(b.y)); v[j][3] = bfhi(x.y) + (bfhi(a.y) + bfhi(b.y));
        s += (v[j][0] * v[j][0] + v[j][1] * v[j][1]) + (v[j][2] * v[j][2] + v[j][3] * v[j][3]); }
    const float rs = 1.0f / sqrtf(wave_sum(s) * (1.f / D) + NORM_EPS);
#pragma unroll
    for (int j = 0; j < 4; ++j) xr[64 * j] = v[j] * rs * gr[64 * j];
}
}
#ifndef MK_N_LAUNCHES
#define MK_N_LAUNCHES 1
#endif
constexpr int NPH = 13;
constexpr int N_LAUNCHES = MK_N_LAUNCHES;

#define ARG_IN(k) karg_ptr(8 * (k))
#define ARG_OUT ((float*)karg_ptr(8 * 27))
#define ARG_WS ((unsigned char*)karg_ptr(8 * 28))
template <int LO, int HI>
__global__ void __launch_bounds__(NWAVES * 64, 2) mega_fwd(Args args) {
    extern __shared__ __attribute__((aligned(16))) unsigned char lds_raw[];
    Frame F;
    F.lds = (LAS unsigned char*)lds_raw;
    F.MISC = (volatile LAS unsigned*)(F.lds + LDSCTL_OFF);
    F.wave = __builtin_amdgcn_readfirstlane((int)threadIdx.x >> 6);
    F.G = gridDim.x; { const int bx = blockIdx.x; F.vcu = (F.G % 8 == 0) ? (bx % 8) * (F.G / 8) + bx / 8 : bx; }
    F.ws = ARG_WS; F.ctl = (unsigned*)(ARG_WS + WS_CTL);
    for (int u = threadIdx.x; u < (LDS_BYTES - LDSCTL_OFF) / 4; u += NWAVES * 64) ((LAS unsigned*)(F.lds + LDSCTL_OFF))[u] = 0u;
    __syncthreads();
    XcdBarrier bar; bar.bar = F.ctl + CW_BAR; bar.x = 0; bar.st = nullptr;
    if (HI - LO > 1) bar = xcd_barrier_post(F.ctl + CW_BAR, F.MISC + 8);
#define GRID_BAR() do { if (HI - LO > 1) xcd_barrier(bar); } while (0)
#ifndef PH_MASK
#define PH_MASK 0x1fff
#endif
#define IN(k) ((((PH_MASK) >> (k)) & 1) && LO <= (k) && (k) < HI)
#define BOTH(k) (IN(k) && IN((k) + 1))
#ifndef DUP_PHASE
#define DUP_PHASE -1
#endif
#define DUPF(k) ((k) == DUP_PHASE ? 2 : 1)
    const int gw = F.vcu * NWAVES + F.wave, NGW = F.G * NWAVES;
#define R1 ((bf16_t*)(ARG_WS + WS_R1))
#define R2 ((bf16_t*)(ARG_WS + WS_R2))
#define ssqa ((float*)(ARG_WS + WS_SSQA))
#define ssq1 ((float*)(ARG_WS + WS_SSQ1))
#define ssq2 ((float*)(ARG_WS + WS_SSQ2))
#define tok_e ((int*)(ARG_WS + WS_TOK + TK_E))
#define tok_gate ((float*)(ARG_WS + WS_TOK + TK_GATE))
#define tok_slot ((int*)(ARG_WS + WS_TOK + TK_SLOT))
#define tok_rs ((float*)(ARG_WS + WS_TOK + TK_RS))
#define row_tok ((int*)(ARG_WS + WS_TOK + TK_ROWTOK))
#define slot_rs ((float*)(ARG_WS + WS_TOK + TK_SLOTRS))
#define slot_gate ((float*)(ARG_WS + WS_TOK + TK_SLOTGATE))
#define hist ((int*)(ARG_WS + WS_HIST))
#define etile ((int*)(ARG_WS + WS_HIST + HIST_ETILE))
#define WR ((const bf16_t*)(ARG_WS + WS_HIST + HIST_WR))

    if (IN(0)) { p0_prologue(F); if (DUPF(0) == 2) { asm volatile("s_waitcnt vmcnt(0)" ::: "memory"); __syncthreads(); p0_prologue(F); } if (BOTH(0)) GRID_BAR(); }

    if (IN(1)) {
        { pg8::GridOrder S; S.init(R1, ARG_WS + WS_WIN, D, D, T, INW, F.G, (int)blockIdx.x); S.dup = DUPF(1);
          pg8::EpiU E{R2, (bf16_t*)(ARG_WS + WS_Q), (bf16_t*)(ARG_WS + WS_K), (bf16_t*)(ARG_WS + WS_V), (const float*)(ARG_WS + WS_ROPE), (const float*)(ARG_WS + WS_ROPE) + SEQ * 32};
          pg8::gemm_phase<pg8::EpiU, pg8::GridOrder, true, false>(F.lds, F.wave, D, D, D, S, E); }
        { pg8::KvOrder S{(const char*)(ARG_WS + WS_MEMN), (const char*)(ARG_WS + WS_WXK), (const char*)(ARG_WS + WS_WXV), F.G, (int)blockIdx.x};
          pg8::EpiPlain<false> E{(bf16_t*)(ARG_WS + WS_KX), D, (bf16_t*)(ARG_WS + WS_VXT), MROWS, nullptr};
          pg8::gemm_phase<pg8::EpiPlain<false>, pg8::KvOrder, true, false>(F.lds, F.wave, D, D, D, S, E); }
        if (BOTH(1)) GRID_BAR();
    }

    if (IN(2)) {
        for (int L0 = F.vcu; L0 < NB * NH * 8 * DUPF(2); L0 += F.G) { const int L = L0 % (NB * NH * 8); const int chunk = L & 7, bh = L >> 3, b = bh / NH, h = bh % NH;
            att::attn_unit(F.lds, (const bf16_t*)(ARG_WS + WS_Q), (const bf16_t*)(ARG_WS + WS_K), (const bf16_t*)(ARG_WS + WS_V), R1, ssqa, b, h, chunk * 512, F.wave * 64 + lane_id(), F.wave, lane_id()); }
        for (int L = F.vcu; L < NB * 64; L += F.G) { const int b = L >> 6, j = L & 63;
            att::conv_unit(F.lds, R2, R1, (const float*)ARG_IN(5), (const float*)ARG_IN(6), (const float*)ARG_IN(7), (const float*)ARG_IN(8), (const float*)ARG_IN(9), b, j * 64, F.wave * 64 + lane_id(), F.wave, lane_id()); }
        asm volatile("s_waitcnt vmcnt(0) lgkmcnt(0)" ::: "memory"); __syncthreads();
        if (BOTH(2)) GRID_BAR();
    }

    if (IN(3)) {
        pg8::GridOrder S; S.init(R1, ARG_WS + WS_WOUT, D, D, T, D, F.G, (int)blockIdx.x); S.dup = DUPF(3);
        pg8::EpiResid<true> E{(const float*)ARG_IN(0), R2, ssq1, ssqa};
        pg8::gemm_phase<pg8::EpiResid<true>, pg8::GridOrder, true, false>(F.lds, F.wave, D, D, D, S, E);
        if (BOTH(3)) GRID_BAR();
    }

    if (IN(4)) {
        pg8::GridOrder S; S.init(R2, ARG_WS + WS_WXQ, D, D, T, D, F.G, (int)blockIdx.x); S.dup = DUPF(4);
        pg8::EpiPlain<true> E{(bf16_t*)(ARG_WS + WS_XQ), D, nullptr, 0, ssq1};
        pg8::gemm_phase<pg8::EpiPlain<true>, pg8::GridOrder, true, false>(F.lds, F.wave, D, D, D, S, E);
        if (BOTH(4)) GRID_BAR();
    }

    if (IN(5)) {
        pg8::XaOrder<0> S{(const char*)(ARG_WS + WS_XQ), (const char*)(ARG_WS + WS_KX), F.G, F.vcu, DUPF(5)};
        pg8::EpiSoftmax E{(bf16_t*)(ARG_WS + WS_PM)};
        pg8::gemm_phase<pg8::EpiSoftmax, pg8::XaOrder<0>, true, false>(F.lds, F.wave, D, D, XHD, S, E);
        if (BOTH(5)) GRID_BAR();
    }

    if (IN(6)) {
        pg8::XaOrder<1> S{(const char*)(ARG_WS + WS_PM), (const char*)(ARG_WS + WS_VXT), F.G, F.vcu, DUPF(6)};
        pg8::EpiPlain<false> E{R1, D, nullptr, 0, nullptr};
        pg8::gemm_phase<pg8::EpiPlain<false>, pg8::XaOrder<1>, true, false>(F.lds, F.wave, D, MROWS, MEML, S, E);
        if (BOTH(6)) GRID_BAR();
    }

    if (IN(7)) {
        pg8::GridOrder S; S.init(R1, ARG_WS + WS_WXO, D, D, T, D, F.G, (int)blockIdx.x); S.dup = 1;
        pg8::EpiResid<false> E{nullptr, R2, ssq2, nullptr};
        pg8::gemm_phase<pg8::EpiResid<false>, pg8::GridOrder, true, false>(F.lds, F.wave, D, D, D, S, E);
        if (BOTH(7)) GRID_BAR();
    }

    if (IN(8)) {
        for (int c0_ = blockIdx.x; c0_ < (T / 256) * DUPF(8); c0_ += F.G) { const int c = c0_ % (T / 256);
            moe::route_chunk(F.lds, R2, ssq2, WR, (const float*)ARG_IN(22), (const float*)ARG_IN(20), tok_e, tok_gate, tok_rs, hist, c, F.wave * 64 + lane_id(), F.wave, lane_id()); }
        asm volatile("s_waitcnt vmcnt(0) lgkmcnt(0)" ::: "memory"); __syncthreads();
        if (BOTH(8)) GRID_BAR();
    }

    if (IN(9)) {
        for (int c1_ = blockIdx.x; c1_ < (T / 256) * DUPF(9); c1_ += F.G) { const int c = c1_ % (T / 256);
            moe::slot_chunk(F.lds, hist, tok_e, tok_gate, tok_rs, tok_slot, row_tok, slot_rs, slot_gate, etile, c, F.wave * 64 + lane_id(), F.wave, lane_id()); }
        asm volatile("s_waitcnt vmcnt(0) lgkmcnt(0)" ::: "memory"); __syncthreads();
        if (BOTH(9)) GRID_BAR();
    }

    if (IN(10)) {
        pg8::MoeOrder<0> S{(const char*)R2, (const char*)(ARG_WS + WS_W13), row_tok, etile, F.G, (int)blockIdx.x, DUPF(10)};
        pg8::EpiMoe1 E{(bf16_t*)(ARG_WS + WS_HID), slot_rs};
        pg8::gemm_phase<pg8::EpiMoe1, pg8::MoeOrder<0>, true, true>(F.lds, F.wave, D, D, D, S, E);
        if (BOTH(10)) GRID_BAR();
    }

    if (IN(11)) {
        pg8::MoeOrder<1> S{(const char*)(ARG_WS + WS_HID), (const char*)(ARG_WS + WS_W2), row_tok, etile, F.G, (int)blockIdx.x, DUPF(11)};
        pg8::EpiMoe2 E{(bf16_t*)(ARG_WS + WS_Y), slot_gate};
        pg8::gemm_phase<pg8::EpiMoe2, pg8::MoeOrder<1>, true, false>(F.lds, F.wave, FF, FF, FF, S, E);
        if (BOTH(11)) GRID_BAR();
    }

    if (IN(12)) {
        for (int t0_ = gw; t0_ < T * DUPF(12); t0_ += NGW) { const int t = t0_ % T; moe::final_row(ARG_OUT, R2, (const bf16_t*)(ARG_WS + WS_Y), tok_slot, (const float*)ARG_IN(26), t, lane_id()); }
    }
#undef IN
#undef BOTH
}

typedef void (*kern_t)(Args);
template <int... I> struct PhList {};
extern "C" void kernel_launch(void* const* d_in, const int* in_sizes, int n_in, void* d_out, int out_size, void* d_ws, size_t ws_size, hipStream_t stream) {
    static int grid = 0;
#if MK_N_LAUNCHES == 1
    static const kern_t kerns[1] = {mega_fwd<0, NPH>};
#else
    static const kern_t kerns[NPH] = {mega_fwd<0, 1>, mega_fwd<1, 2>, mega_fwd<2, 3>, mega_fwd<3, 4>, mega_fwd<4, 5>, mega_fwd<5, 6>, mega_fwd<6, 7>, mega_fwd<7, 8>, mega_fwd<8, 9>, mega_fwd<9, 10>, mega_fwd<10, 11>, mega_fwd<11, 12>, mega_fwd<12, 13>};
#endif
    if (grid == 0) {
        if (n_in != 27 || in_sizes[0] != T * D || out_size != T * D || ws_size < WS_END) { fprintf(stderr, "kernel_launch: unexpected problem: n_in %d in0 %d out %d ARG_WS %zu (need %zu)\n", n_in, n_in > 0 ? in_sizes[0] : -1, out_size, ws_size, (size_t)WS_END); grid = -1; return; }
        int dev = 0, cus = 0, per_cu = 0;
        if (hipGetDevice(&dev) != hipSuccess || hipDeviceGetAttribute(&cus, hipDeviceAttributeMultiprocessorCount, dev) != hipSuccess) { grid = -1; return; }
        for (int li = 0; li < N_LAUNCHES; ++li)
            if (hipFuncSetAttribute((const void*)kerns[li], hipFuncAttributeMaxDynamicSharedMemorySize, LDS_BYTES) != hipSuccess) { fprintf(stderr, "kernel_launch: hipFuncSetAttribute failed\n"); grid = -1; return; }
        if (hipOccupancyMaxActiveBlocksPerMultiprocessor(&per_cu, (const void*)kerns[0], NWAVES * 64, LDS_BYTES) != hipSuccess || per_cu < 1) { fprintf(stderr, "kernel_launch: occupancy query says %d\n", per_cu); }
        (void)hipGetLastError();
        grid = cus;
    }
    if (grid < 0) return;
    if (hipMemsetAsync((char*)d_ws + WS_CTL, 0, CTL_ZERO_BYTES, stream) != hipSuccess) return;
    Args a{};
    for (int i = 0; i < 27; ++i) a.in[i] = d_in[i];
    a.out = (float*)d_out; a.ws = (unsigned char*)d_ws;
    for (int li = 0; li < N_LAUNCHES; ++li) {
        a.ph_lo = 0; a.ph_hi = 0; a.li = li; a.pad = 0;
        hipLaunchKernelGGL(kerns[li], dim3(grid), dim3(NWAVES * 64), LDS_BYTES, stream, a);
        const hipError_t le = hipPeekAtLastError();
        if (le != hipSuccess) { fprintf(stderr, "kernel_launch: launch %d failed: %s\n", li, hipGetErrorName(le)); break; }
    }
}
```

```cpp
#include <hip/hip_runtime.h>
#include <cstdio>
#include <cstdint>

#define GAS __attribute__((address_space(1)))
#define LAS __attribute__((address_space(3)))
typedef unsigned short bf16_t;
typedef short bf16x8 __attribute__((ext_vector_type(8)));
typedef short s16x4 __attribute__((ext_vector_type(4)));
typedef float f32x4 __attribute__((ext_vector_type(4)));
typedef float f32x2 __attribute__((ext_vector_type(2)));
typedef unsigned u32x4 __attribute__((ext_vector_type(4)));
typedef unsigned u32x2 __attribute__((ext_vector_type(2)));

constexpr int NB = 16, SEQ = 4096, T = NB * SEQ, D = 1024;
constexpr int CCH = 256, NH = 12, HD = 64, AW = NH * HD, INW = 2 * CCH + 3 * AW;
constexpr int MEML = 256, MROWS = NB * MEML, XH = 4, XHD = 256;
constexpr int NE = 32, EPG = 8, NG = 4, FF = 512;
constexpr int CONVK = 31;
constexpr int A_PAD = T * 2 + NE * 256;
constexpr float NORM_EPS = 1e-6f, LN_EPS = 1e-5f;
constexpr float LOG2E = 1.4426950408889634f;

constexpr size_t MiB = 1u << 20;
constexpr size_t WS_CTL = 0, CTL_ZERO_BYTES = 1 * MiB;
constexpr size_t WS_ROPE = 1 * MiB;
constexpr size_t WS_HIST = 2 * MiB;
constexpr size_t WS_SSQA = 4 * MiB;
constexpr size_t WS_SSQ1 = 8 * MiB;
constexpr size_t WS_SSQ2 = 12 * MiB;
constexpr size_t WS_WIN = 16 * MiB, WS_WOUT = 22 * MiB, WS_WXQ = 24 * MiB, WS_WXK = 26 * MiB, WS_WXV = 28 * MiB, WS_WXO = 30 * MiB;
constexpr size_t WS_W13 = 32 * MiB, WS_W2 = 96 * MiB;
constexpr size_t WS_MEMN = 128 * MiB, WS_KX = 136 * MiB, WS_VX = 144 * MiB;
constexpr size_t WS_TOK = 152 * MiB;
constexpr size_t WS_R1 = 160 * MiB;
constexpr size_t WS_R2 = 288 * MiB;
constexpr size_t WS_Q = 320 * MiB, WS_K = 416 * MiB, WS_V = 512 * MiB;
constexpr size_t WS_MT = 672 * MiB, WS_NT = 704 * MiB;
constexpr size_t WS_PM = 544 * MiB;
constexpr size_t WS_HID = 416 * MiB;
constexpr size_t WS_Y = 552 * MiB;
constexpr size_t WS_END = 824 * MiB;
constexpr size_t TK_E = 0;
constexpr size_t TK_GATE = 1 * MiB;
constexpr size_t TK_SLOT = 2 * MiB;
constexpr size_t TK_RS = 3 * MiB;
constexpr size_t TK_ROWTOK = 4 * MiB;
constexpr size_t TK_SLOTRS = 5 * MiB;
constexpr size_t TK_SLOTGATE = 6 * MiB;
constexpr size_t HIST_ETILE = 64 * 1024, HIST_WR = 128 * 1024;

constexpr int CW_BAR = 4096;

constexpr int NWAVES = 8;
constexpr int RING_BYTES = 131072;
constexpr int XCH_OFF = RING_BYTES;
constexpr int LDSCTL_OFF = RING_BYTES + 12288;
constexpr int LDS_BYTES = 147456;

#define LDS_WAIT() asm volatile("s_waitcnt lgkmcnt(0)" ::: "memory")
#define VM_WAIT() asm volatile("s_waitcnt vmcnt(0)" ::: "memory")
__device__ __forceinline__ unsigned f2bf(float f) { unsigned u = __builtin_bit_cast(unsigned, f); return (u + 0x7fffu + ((u >> 16) & 1u)) >> 16; }
__device__ __forceinline__ unsigned pk2(float lo, float hi) { return f2bf(lo) | (f2bf(hi) << 16); }
__device__ __forceinline__ float bf2f(unsigned short b) { return __builtin_bit_cast(float, (unsigned)b << 16); }
__device__ __forceinline__ float bflo(unsigned w) { return __builtin_bit_cast(float, w << 16); }
__device__ __forceinline__ float bfhi(unsigned w) { return __builtin_bit_cast(float, w & 0xffff0000u); }
__device__ __forceinline__ unsigned cvt_pk_bf16(float lo, float hi) { unsigned r; asm volatile("v_cvt_pk_bf16_f32 %0, %1, %2" : "=v"(r) : "v"(lo), "v"(hi)); return r; }
__device__ __forceinline__ float wave_sum(float v) {
#pragma unroll
    for (int o = 1; o < 64; o <<= 1) v += __shfl_xor(v, o);
    return v;
}
__device__ __forceinline__ int lane_id() { return (int)__builtin_amdgcn_mbcnt_hi(~0u, __builtin_amdgcn_mbcnt_lo(~0u, 0u)); }
#define MK_N_LAUNCHES 1
namespace pg8 {
constexpr int BM = 256, BK = 64, HALF = 128, HTB = HALF * BK * 2  , STAGE_BYTES = 8 * HTB, NXCD = 8, WGM = 8;

__host__ __device__ __forceinline__ int lds_byte(int r, int c) { const int st = (r >> 4) * 2 + (c >> 5), rr = r & 15, cc = c & 31, ob = rr * 64 + cc * 2; return st * 1024 + (ob ^ (((ob >> 9) & 1) << 5)); }
__host__ __device__ __forceinline__ void stage_rc(int b, int& R, int& C) { const int st = b / 1024, sb = b % 1024, swz = sb ^ (((sb >> 9) & 1) << 5); R = (st >> 1) * 16 + swz / 64; C = (st & 1) * 32 + (swz % 64) / 2; }
__host__ __device__ __forceinline__ int perm32(int rho) { const int n = rho >> 4, i = rho & 15; return 8 * (i >> 2) + 4 * n + (i & 3); }

struct Unit { const char* a; const char* b; const int* rows; int pm, pn, x0, x1; };

typedef f32x4 Acc[2][2][4][2];

__device__ __forceinline__ const char* uniform_ptr(const char* p) { const unsigned long long v = (unsigned long long)p;
    const unsigned lo = __builtin_amdgcn_readfirstlane((unsigned)v), hi = __builtin_amdgcn_readfirstlane((unsigned)(v >> 32)); return (const char*)(((unsigned long long)hi << 32) | lo); }
__device__ __forceinline__ void glds16_sv(const char* gbase, unsigned voff, unsigned lds_dst) { unsigned keep;
    asm volatile("s_mov_b32 %0, m0\n\ts_mov_b32 m0, %3\n\ts_nop 0\n\tglobal_load_lds_dwordx4 %1, %2\n\ts_mov_b32 m0, %0" : "=&s"(keep) : "v"(voff), "s"(gbase), "s"(lds_dst) : "memory"); }
template <class Epi, class Sched, bool ALIGN_EPI, bool GATHER>
__device__ __forceinline__ void gemm_phase(LAS unsigned char* lds, const int wave_, const int lda, const int ldb, const int K, const Sched& S, const Epi& E) {
    int lane_ = lane_id(); asm volatile("" : "+v"(lane_));
    const int wid = __builtin_amdgcn_readfirstlane(wave_), tid = wid * 64 + lane_, lane = tid & 63, wr = wid >> 2, wc = wid & 3, fr = lane & 15, fq = lane >> 4;
    const int nt = K / BK;
    int Rr[2], Cc[2];
    unsigned vA[2][2], vN[2][2], voffB[2];
#pragma unroll
    for (int i = 0; i < 2; ++i) { int R, C; stage_rc(tid * 16 + i * 8192, R, C); Rr[i] = R; Cc[i] = C; const int Rb = Epi::PERM ? ((R & ~31) + perm32(R & 31)) : R;
        voffB[i] = (unsigned)(Rb * ldb + C) * 2u; }
    const size_t kstep = (size_t)(BK * 2);
    const size_t hstepB = (size_t)HALF * ldb * 2, hstepA = (size_t)HALF * lda * 2;
    const unsigned ldsw = (unsigned)wid * 1024u, lds0 = (unsigned)(uintptr_t)lds;
    const int aoff = lds_byte(wr * 64 + fr, fq * 8), boff = lds_byte(wc * 32 + fr, fq * 8);
#define PG8_SA(b, h) (((b) * 2 + (h)) * HTB)
#define PG8_SB(b, h) ((4 + (b) * 2 + (h)) * HTB)
#define PG8_STAGE(bufoff, gbase, voff) do { _Pragma("unroll") for (int _i = 0; _i < 2; ++_i) glds16_sv((gbase), (voff)[_i], lds0 + (unsigned)(bufoff) + ldsw + _i * 8192u); } while (0)
#define PG8_LDA(dst, b, h) do { _Pragma("unroll") for (int m = 0; m < 4; ++m) _Pragma("unroll") for (int k = 0; k < 2; ++k) dst[m][k] = *(const LAS bf16x8*)(lds + PG8_SA(b, h) + aoff + m * 2048 + k * 1024); } while (0)
#define PG8_LDB(dst, b, h) do { _Pragma("unroll") for (int n = 0; n < 2; ++n) _Pragma("unroll") for (int k = 0; k < 2; ++k) dst[n][k] = *(const LAS bf16x8*)(lds + PG8_SB(b, h) + boff + n * 2048 + k * 1024); } while (0)
#define PG8_MMA(ai, bj, At, Bt) do { __builtin_amdgcn_s_setprio(1); _Pragma("unroll") for (int m = 0; m < 4; ++m) _Pragma("unroll") for (int n = 0; n < 2; ++n) _Pragma("unroll") for (int k = 0; k < 2; ++k) \
        acc[ai][bj][m][n] = __builtin_amdgcn_mfma_f32_16x16x32_bf16(Bt[n][k], At[m][k], acc[ai][bj][m][n], 0, 0, 0); __builtin_amdgcn_s_setprio(0); } while (0)
#define PG8_WAIT_V(n) asm volatile("s_waitcnt vmcnt(" #n ")" ::: "memory")
#define PG8_WAIT_L(n) asm volatile("s_waitcnt lgkmcnt(" #n ")" ::: "memory")
#define PG8_BAR __builtin_amdgcn_s_barrier()
#define PG8_SCHED __builtin_amdgcn_sched_barrier(0)
#define PG8_VOFF(dst, u) do { _Pragma("unroll") for (int _h = 0; _h < 2; ++_h) _Pragma("unroll") for (int _i = 0; _i < 2; ++_i) { \
        if constexpr (GATHER) dst[_h][_i] = (unsigned)(u).rows[_h * HALF + Rr[_i]] * (unsigned)(lda * 2) + (unsigned)(Cc[_i] * 2); \
        else dst[_h][_i] = (unsigned)(Rr[_i] * lda + Cc[_i]) * 2u; } } while (0)
#define PG8_STAGE_A(bufoff, gbase, h, vv) do { if constexpr (GATHER) { PG8_STAGE(bufoff, gbase, vv[h]); } else { PG8_STAGE(bufoff, (gbase) + (h) * hstepA, vv[0]); } } while (0)
    Unit cur, nxt; int ui = 0;
    if (!S.next(0, cur)) return;
    Acc acc;
#pragma unroll
    for (int a = 0; a < 2; ++a)
#pragma unroll
        for (int b = 0; b < 2; ++b)
#pragma unroll
            for (int m = 0; m < 4; ++m)
#pragma unroll
                for (int n = 0; n < 2; ++n) acc[a][b][m][n] = (f32x4){0.f, 0.f, 0.f, 0.f};
    bf16x8 At[4][2], B0[2][2], B1[2][2];
    const char* cA = uniform_ptr(cur.a); const char* cB = uniform_ptr(cur.b);
    PG8_VOFF(vA, cur);
    if constexpr (GATHER) { asm volatile("s_waitcnt vmcnt(0)" ::: "memory"); }
    PG8_STAGE(PG8_SB(0, 0), cB, voffB); PG8_STAGE(PG8_SB(0, 1), cB + hstepB, voffB); PG8_STAGE_A(PG8_SA(0, 0), cA, 0, vA); PG8_STAGE_A(PG8_SA(0, 1), cA, 1, vA);
    if (wr == 1) PG8_BAR;
    PG8_WAIT_V(2); PG8_BAR;
    PG8_STAGE(PG8_SB(1, 0), cB + kstep, voffB); PG8_STAGE_A(PG8_SA(1, 0), cA + kstep, 0, vA); PG8_STAGE(PG8_SB(1, 1), cB + hstepB + kstep, voffB);
    PG8_WAIT_V(6); PG8_BAR;
    for (;;) {
        const bool has_next = S.next(ui + 1, nxt);
        const char* nA = has_next ? uniform_ptr(nxt.a) : cA; const char* nB = has_next ? uniform_ptr(nxt.b) : cB;
        if constexpr (GATHER) { if (has_next) { PG8_VOFF(vN, nxt); } else {
#pragma unroll
            for (int h = 0; h < 2; ++h) { vN[h][0] = vA[h][0]; vN[h][1] = vA[h][1]; } } }
#pragma nounroll
        for (int t = 0; t < nt; t += 2) {
            const bool last = (t == nt - 2);
            if constexpr (Epi::HAS_MID) { if (t == E.mid_t()) E.mid(acc, cur, wr, wc, fr, fq); }
            const char* a1 = cA + (size_t)(t + 1) * kstep;
            const char* a2 = last ? nA : cA + (size_t)(t + 2) * kstep; const char* b2 = last ? nB : cB + (size_t)(t + 2) * kstep;
            const char* a3 = a2 + kstep; const char* b3 = b2 + kstep;
            unsigned vW[2][2];
#pragma unroll
            for (int h = 0; h < 2; ++h) { vW[h][0] = vA[h][0]; vW[h][1] = vA[h][1]; if constexpr (GATHER) { if (last) { vW[h][0] = vN[h][0]; vW[h][1] = vN[h][1]; } } }
            PG8_LDB(B0, 0, 0); PG8_LDB(B1, 0, 1); PG8_SCHED; PG8_LDA(At, 0, 0); PG8_STAGE_A(PG8_SA(1, 1), a1, 1, vA);
            PG8_WAIT_V(8); PG8_WAIT_L(0); PG8_BAR; PG8_MMA(0, 0, At, B0); PG8_MMA(0, 1, At, B1); PG8_BAR; PG8_SCHED;
            PG8_LDA(At, 0, 1); PG8_STAGE(PG8_SB(0, 0), b2, voffB); PG8_STAGE(PG8_SB(0, 1), b2 + hstepB, voffB); PG8_STAGE_A(PG8_SA(0, 0), a2, 0, vW);
            PG8_WAIT_V(8); PG8_WAIT_L(0); PG8_BAR; PG8_MMA(1, 0, At, B0); PG8_MMA(1, 1, At, B1); PG8_BAR; PG8_SCHED;
            PG8_LDB(B0, 1, 0); PG8_LDB(B1, 1, 1); PG8_SCHED; PG8_LDA(At, 1, 0); PG8_STAGE_A(PG8_SA(0, 1), a2, 1, vW);
            PG8_WAIT_V(8); PG8_WAIT_L(0); PG8_BAR; PG8_MMA(0, 0, At, B0); PG8_MMA(0, 1, At, B1); PG8_BAR; PG8_SCHED;
            PG8_LDA(At, 1, 1); PG8_STAGE(PG8_SB(1, 0), b3, voffB); PG8_STAGE(PG8_SB(1, 1), b3 + hstepB, voffB); PG8_STAGE_A(PG8_SA(1, 0), a3, 0, vW);
            PG8_WAIT_V(8); PG8_WAIT_L(0); PG8_BAR; PG8_MMA(1, 0, At, B0); PG8_MMA(1, 1, At, B1); PG8_BAR; PG8_SCHED;
        }
        if constexpr (ALIGN_EPI) { if (wr == 0) PG8_BAR; }
        E(acc, cur, wr, wc, fr, fq, lds, wid, lane);
        if (!has_next) break;
#pragma unroll
        for (int a = 0; a < 2; ++a)
#pragma unroll
            for (int b = 0; b < 2; ++b)
#pragma unroll
                for (int m = 0; m < 4; ++m)
#pragma unroll
                    for (int n = 0; n < 2; ++n) acc[a][b][m][n] = (f32x4){0.f, 0.f, 0.f, 0.f};
        cur = nxt; cA = nA; cB = nB; ++ui;
        if constexpr (GATHER) {
#pragma unroll
            for (int h = 0; h < 2; ++h) { vA[h][0] = vN[h][0]; vA[h][1] = vN[h][1]; } }
        if constexpr (ALIGN_EPI) { if (wr == 1) PG8_BAR; }
    }
    PG8_WAIT_V(0);
    if constexpr (!ALIGN_EPI) { if (wr == 0) PG8_BAR; }
    PG8_BAR;
#undef PG8_SA
#undef PG8_SB
#undef PG8_STAGE
#undef PG8_LDA
#undef PG8_LDB
#undef PG8_MMA
#undef PG8_WAIT_V
#undef PG8_WAIT_L
#undef PG8_BAR
#undef PG8_SCHED
#undef PG8_VOFF
#undef PG8_STAGE_A
}
}
#define XB_TMO      128
#define XB_XCNT(j)  (256  + 64 * (j))
#define XB_XSUB(j)  (1280 + 64 * (j))
#define XB_XGEN(j)  (2304 + 64 * (j))
#define XB_TOP      3328
#define XB_TOPGEN   3392
#define XCD_BAR_WORDS 3456
#define XB_SPIN_CAP (1u << 18)

__device__ __forceinline__ unsigned xb_ld(unsigned* p)              { return __hip_atomic_load(p, __ATOMIC_RELAXED, __HIP_MEMORY_SCOPE_AGENT); }
__device__ __forceinline__ unsigned xb_add(unsigned* p, unsigned v) { return __hip_atomic_fetch_add(p, v, __ATOMIC_RELAXED, __HIP_MEMORY_SCOPE_AGENT); }
__device__ __forceinline__ unsigned xb_xcc_id() { return (unsigned)__builtin_amdgcn_s_getreg((3 << 11) | 20) & 0xFu; }
#define XB_SPIN(cond, bar) do { unsigned _sp = 0; while (cond) { __builtin_amdgcn_s_sleep(1); \
    if ((++_sp & 255u) == 0u) { if (xb_ld(&(bar)[XB_TMO])) break; if (_sp > XB_SPIN_CAP) { atomicAdd(&(bar)[XB_TMO], 1u); break; } } } } while (0)

struct XcdBarrier {
    unsigned* bar; unsigned x;
    volatile LAS unsigned* st;
};

__device__ __forceinline__ XcdBarrier xcd_barrier_post(unsigned* bar, volatile LAS unsigned* st) {
    XcdBarrier b; b.bar = bar; b.x = xb_xcc_id(); b.st = st;
    if (threadIdx.x == 0) (void)xb_add(&bar[XB_XCNT(b.x)], 1u);
    return b;
}
__device__ __forceinline__ void xcd_barrier_complete(unsigned* bar, unsigned x, unsigned& nloc, unsigned& nx) {
    const unsigned G = gridDim.x * gridDim.y * gridDim.z;
    unsigned sum, cnt, mine, sp = 0u;
    for (;;) {
        sum = 0u; cnt = 0u; mine = 0u;
#pragma unroll
        for (unsigned j = 0; j < 16; ++j) { const unsigned c = xb_ld(&bar[XB_XCNT(j)]); sum += c; cnt += (c > 0u) ? 1u : 0u; mine = (j == x) ? c : mine; }
        if (sum == G) break;
        __builtin_amdgcn_s_sleep(1);
        if ((++sp & 255u) == 0u) { if (xb_ld(&bar[XB_TMO])) break; if (sp > XB_SPIN_CAP) { atomicAdd(&bar[XB_TMO], 1u); break; } }
    }
    nloc = mine > 0u ? mine : 1u; nx = cnt > 0u ? cnt : 1u;
}

__device__ __forceinline__ void xcd_barrier(const XcdBarrier& b) {
    asm volatile("s_waitcnt vmcnt(0)" ::: "memory");
    __syncthreads();
    if (threadIdx.x == 0) {
        unsigned* bar = b.bar;
        __builtin_amdgcn_s_waitcnt(0);
        unsigned nloc = b.st[0], nx = b.st[1];
        if (nloc == 0u) { xcd_barrier_complete(bar, b.x, nloc, nx); b.st[0] = nloc; b.st[1] = nx; }
        const unsigned old = xb_add(&bar[XB_XSUB(b.x)], 1u);
        const unsigned gen = old / nloc;
        if (old + 1u == (gen + 1u) * nloc) {
            __builtin_amdgcn_fence(__ATOMIC_RELEASE, "agent");
            asm volatile("s_waitcnt vmcnt(0)" ::: "memory");
            const unsigned og = xb_add(&bar[XB_TOP], 1u);
            const unsigned tg = og / nx;
            if (og + 1u == (tg + 1u) * nx) xb_add(&bar[XB_TOPGEN], 1u);
            else XB_SPIN(xb_ld(&bar[XB_TOPGEN]) == tg, bar);
            __builtin_amdgcn_fence(__ATOMIC_ACQUIRE, "agent");
            xb_add(&bar[XB_XGEN(b.x)], 1u);
            asm volatile("s_waitcnt vmcnt(0)" ::: "memory");
        } else {
            XB_SPIN(xb_ld(&bar[XB_XGEN(b.x)]) == gen, bar);
            __builtin_amdgcn_fence(__ATOMIC_ACQUIRE, "agent");
            asm volatile("s_waitcnt vmcnt(0)" ::: "memory");
        }
    }
    __syncthreads();
}

namespace pg8 {
#define EPI_NOMID static constexpr bool HAS_MID = false; __device__ __forceinline__ int mid_t() const { return -1; } __device__ __forceinline__ void mid(Acc&, const Unit&, int, int, int, int) const {}
#define RAW_BARRIER() do { asm volatile("s_waitcnt lgkmcnt(0)" ::: "memory"); __builtin_amdgcn_s_barrier(); asm volatile("" ::: "memory"); } while (0)

__device__ __forceinline__ u32x4 pack8(const f32x4& v0, const f32x4& v1) { u32x4 w; w.x = cvt_pk_bf16(v0[0], v0[1]); w.y = cvt_pk_bf16(v0[2], v0[3]); w.z = cvt_pk_bf16(v1[0], v1[1]); w.w = cvt_pk_bf16(v1[2], v1[3]); return w; }

struct GridOrder {
    const char* A; const char* Bt; int lda, ldb, nM, nN, nwg, G, c, dup;
    __device__ __forceinline__ void init(const void* A_, const void* Bt_, int lda_, int ldb_, int M, int N, int G_, int c_) { A = (const char*)A_; Bt = (const char*)Bt_; lda = lda_; ldb = ldb_; nM = M / BM; nN = N / BM; nwg = nM * nN; G = G_; c = c_; dup = 1; }
    __device__ __forceinline__ bool next(int i, Unit& u) const {
        const long L = (long)i * G + c; if (L >= (long)nwg * dup) return false;
        int wgid = (int)(L % nwg); { const int q = nwg / NXCD, r = nwg % NXCD, xcd = wgid % NXCD, off = wgid / NXCD; wgid = (xcd < r ? xcd * (q + 1) : r * (q + 1) + (xcd - r) * q) + off; }
        const int nig = WGM * nN, gid = wgid / nig, fm = gid * WGM, gsz = (nM - fm) < WGM ? (nM - fm) : WGM;
        u.pm = fm + ((wgid % nig) % gsz); u.pn = (wgid % nig) / gsz; u.x0 = 0; u.x1 = 0; u.rows = nullptr;
        u.a = A + (size_t)u.pm * BM * lda * 2; u.b = Bt + (size_t)u.pn * BM * ldb * 2; return true;
    }
};
struct KvOrder {
    const char* memn; const char* wk; const char* wv; int G, c;
    __device__ __forceinline__ bool next(int i, Unit& u) const {
        const int L = i * G + c; if (L >= 128) return false;
        const int l = L & 63; u.rows = nullptr; u.x1 = 0; u.x0 = L >> 6; u.pm = l >> 2; u.pn = l & 3;
        u.a = memn + (size_t)u.pm * BM * D * 2; u.b = (u.x0 ? wv : wk) + (size_t)u.pn * BM * D * 2;
        return true;
    }
};
struct MnOrder {
    const char* kx; const char* wq2; const char* wxoT; const char* vx; int G, c, dup;
    __device__ __forceinline__ bool next(int i, Unit& u) const {
        int L = i * G + c; if (L >= 512 * dup) return false;
        L &= 511; const int l = L & 255, bh = l >> 2, t4 = l & 3, b = bh >> 2, h = bh & 3; u.rows = nullptr; u.x1 = 0;
        if (L < 256) { u.x0 = 0; u.pm = b * 4 + h; u.pn = t4; u.a = kx + ((size_t)b * MEML * D + h * XHD) * 2; u.b = wq2 + ((size_t)t4 * BM * D + h * XHD) * 2; }
        else { u.x0 = 1; u.pm = b * 4 + t4; u.pn = h; u.a = wxoT + ((size_t)t4 * BM * D + h * XHD) * 2; u.b = vx + ((size_t)b * MEML * D + h * XHD) * 2; }
        return true;
    }
};
struct BatchOrder {
    const char* A; const char* Bt; int nwg, G, c, dup;
    __device__ __forceinline__ bool next(int i, Unit& u) const {
        const long L = (long)i * G + c; if (L >= (long)nwg * dup) return false;
        int wgid = (int)(L % nwg); { const int q = nwg / NXCD, r = nwg % NXCD, xcd = wgid % NXCD, off = wgid / NXCD; wgid = (xcd < r ? xcd * (q + 1) : r * (q + 1) + (xcd - r) * q) + off; }
        const int nN = 4, nM = T / BM, nig = WGM * nN, gid = wgid / nig, fm = gid * WGM, gsz = (nM - fm) < WGM ? (nM - fm) : WGM;
        u.pm = fm + ((wgid % nig) % gsz); u.pn = (wgid % nig) / gsz; u.x0 = 0; u.x1 = 0; u.rows = nullptr;
        u.a = A + (size_t)u.pm * BM * D * 2; u.b = Bt + ((size_t)(u.pm >> 4) * D + u.pn * BM) * D * 2; return true;
    }
};
template <int MODE> struct MoeOrder {
    const char* A; const char* W; const int* rowtok; const int* etile; int G, c, dup;
    __device__ __forceinline__ bool next(int i, Unit& u) const {
        int L = i * G + c; const int ntile = etile[NE];
        if (L >= ntile * 4 * dup) return false;
        L %= ntile * 4;
        const int rt = L >> 2, ct = L & 3; int e = 0;
        for (int j = 1; j < NE; ++j) e = (etile[j] <= rt) ? j : e;
        u.pm = rt; u.pn = ct; u.x0 = e; u.x1 = 0;
        if (MODE == 0) { u.a = A; u.rows = rowtok + rt * BM; u.b = W + ((size_t)e * 1024 + ct * BM) * D * 2; }
        else { u.a = A + (size_t)rt * BM * FF * 2; u.rows = nullptr; u.b = W + ((size_t)e * 1024 + ct * BM) * FF * 2; }
        return true;
    }
};

struct EpiU {
    static constexpr bool PERM = true; EPI_NOMID
    bf16_t* Cb; bf16_t* Q; bf16_t* Kb; bf16_t* V; const float* ropec; const float* ropes;
    __device__ __forceinline__ void operator()(Acc& acc, const Unit& u, int wr, int wc, int fr, int fq, LAS unsigned char*, int, int) const {
        const int row0 = u.pm * BM + wr * 64 + fr;
        if (u.pn < 2) {
#pragma unroll
            for (int ai = 0; ai < 2; ++ai)
#pragma unroll
                for (int m = 0; m < 4; ++m) { const int row = row0 + ai * HALF + m * 16; f32x4 o[2];
#pragma unroll
                    for (int n = 0; n < 2; ++n)
#pragma unroll
                        for (int i = 0; i < 4; ++i) { const float a = acc[ai][0][m][n][i], g = acc[ai][1][m][n][i]; o[n][i] = a / (1.f + __expf(-g)); }
                    *(u32x4*)(Cb + (size_t)row * CCH + u.pn * HALF + wc * 32 + fq * 8) = pack8(o[0], o[1]); }
        } else if (u.pn < 8) {
            const int sec = (u.pn - 2) / 3, tt = (u.pn - 2) % 3; bf16_t* dst = sec ? Kb : Q; const float sc = sec ? 1.f : 0.125f * LOG2E;
            const int colb = (4 * tt + wc) * HD + fq * 8;
#pragma unroll
            for (int ai = 0; ai < 2; ++ai)
#pragma unroll
                for (int m = 0; m < 4; ++m) { const int row = row0 + ai * HALF + m * 16; const int s = row & (SEQ - 1); f32x4 o1[2], o2[2];
#pragma unroll
                    for (int n = 0; n < 2; ++n) { const f32x4 cs = *(const f32x4*)(ropec + s * 32 + fq * 8 + n * 4), sn = *(const f32x4*)(ropes + s * 32 + fq * 8 + n * 4);
                        const f32x4 x1 = acc[ai][0][m][n], x2 = acc[ai][1][m][n];
                        o1[n] = (x1 * cs - x2 * sn) * sc; o2[n] = (x1 * sn + x2 * cs) * sc; }
                    bf16_t* p = dst + (size_t)row * AW + colb;
                    *(u32x4*)p = pack8(o1[0], o1[1]); *(u32x4*)(p + 32) = pack8(o2[0], o2[1]); }
        } else {
            const int tt = u.pn - 8;
#pragma unroll
            for (int ai = 0; ai < 2; ++ai)
#pragma unroll
                for (int m = 0; m < 4; ++m) { const int row = row0 + ai * HALF + m * 16;
#pragma unroll
                    for (int bj = 0; bj < 2; ++bj) *(u32x4*)(V + (size_t)row * AW + tt * BM + bj * HALF + wc * 32 + fq * 8) = pack8(acc[ai][bj][m][0], acc[ai][bj][m][1]); }
        }
    }
};
template <bool ROWSCALE> struct EpiPlain {
    static constexpr bool PERM = true; EPI_NOMID
    bf16_t* O0; int ldc0; bf16_t* O1; int ldc1; const float* ssq16;
    __device__ __forceinline__ void operator()(Acc& acc, const Unit& u, int wr, int wc, int fr, int fq, LAS unsigned char*, int, int) const {
        bf16_t* O = u.x0 ? O1 : O0; const int ldc = u.x0 ? ldc1 : ldc0;
        const int row0 = u.pm * BM + wr * 64 + fr, col0 = u.pn * BM + wc * 32 + fq * 8;
#pragma unroll
        for (int ai = 0; ai < 2; ++ai)
#pragma unroll
            for (int m = 0; m < 4; ++m) { const int row = row0 + ai * HALF + m * 16; float rs = 1.f;
                if constexpr (ROWSCALE) { const f32x4* sp = (const f32x4*)(ssq16 + (size_t)row * 16); const f32x4 s0 = sp[0], s1 = sp[1], s2 = sp[2], s3 = sp[3];
                    const f32x4 st = (s0 + s1) + (s2 + s3); rs = 1.0f / sqrtf(((st[0] + st[1]) + (st[2] + st[3])) * (1.0f / D) + NORM_EPS); }
#pragma unroll
                for (int bj = 0; bj < 2; ++bj) *(u32x4*)(O + (size_t)row * ldc + col0 + bj * HALF) = pack8(acc[ai][bj][m][0] * rs, acc[ai][bj][m][1] * rs); }
    }
};
template <bool MID> struct EpiResid {
    static constexpr bool PERM = false, HAS_MID = MID;
    const float* xin; bf16_t* XB; float* ssqp; const float* ssqa;
    __device__ __forceinline__ int mid_t() const { return AW / BK; }
    __device__ __forceinline__ void mid(Acc& acc, const Unit& u, int wr, int wc, int fr, int fq) const {
        const int row0 = u.pm * BM + wr * 64 + fr;
#pragma unroll
        for (int ai = 0; ai < 2; ++ai)
#pragma unroll
            for (int m = 0; m < 4; ++m) { const int row = row0 + ai * HALF + m * 16; const f32x4* sp = (const f32x4*)(ssqa + (size_t)row * NH);
                const f32x4 s0 = sp[0], s1 = sp[1], s2 = sp[2]; const f32x4 st = (s0 + s1) + s2;
                const float r = 1.0f / sqrtf(((st[0] + st[1]) + (st[2] + st[3])) * (1.0f / AW) + NORM_EPS);
#pragma unroll
                for (int bj = 0; bj < 2; ++bj)
#pragma unroll
                    for (int n = 0; n < 2; ++n) acc[ai][bj][m][n] = acc[ai][bj][m][n] * r;
                asm volatile("" ::: "memory"); }
    }
    __device__ __forceinline__ void operator()(Acc& acc, const Unit& u, int wr, int wc, int fr, int fq, LAS unsigned char*, int, int) const {
        const int row0 = u.pm * BM + wr * 64 + fr, col0 = u.pn * BM + wc * 32 + fq * 4;
#pragma unroll
        for (int ai = 0; ai < 2; ++ai)
#pragma unroll
            for (int m = 0; m < 4; ++m) { const int row = row0 + ai * HALF + m * 16; float ss = 0.f;
#pragma unroll
                for (int bj = 0; bj < 2; ++bj)
#pragma unroll
                    for (int n = 0; n < 2; ++n) { const size_t o = (size_t)row * D + col0 + bj * HALF + n * 16; f32x4 v;
                        if constexpr (MID) v = *(const f32x4*)(xin + o) + acc[ai][bj][m][n];
                        else { const u32x2 xb = *(const u32x2*)(XB + o); v = (f32x4){bflo(xb.x), bfhi(xb.x), bflo(xb.y), bfhi(xb.y)} + acc[ai][bj][m][n]; }
                        u32x2 w; w.x = cvt_pk_bf16(v[0], v[1]); w.y = cvt_pk_bf16(v[2], v[3]); *(u32x2*)(XB + o) = w;
                        ss += (v[0] * v[0] + v[1] * v[1]) + (v[2] * v[2] + v[3] * v[3]); }
                ss += __shfl_xor(ss, 16); ss += __shfl_xor(ss, 32);
                if (fq == 0) ssqp[(size_t)row * 16 + u.pn * 4 + wc] = ss; }
    }
};
struct EpiSoftmax {
    static constexpr bool PERM = true; EPI_NOMID
    bf16_t* PM; const float* ssq16;
    __device__ __forceinline__ void operator()(Acc& acc, const Unit& u, int wr, int wc, int fr, int fq, LAS unsigned char* lds, int, int) const {
        LAS float* MX = (LAS float*)(lds + XCH_OFF); LAS float* SM = (LAS float*)(lds + XCH_OFF + 4096);
#pragma unroll
        for (int ai = 0; ai < 2; ++ai)
#pragma unroll
            for (int m = 0; m < 4; ++m) { const int rl = ai * HALF + wr * 64 + m * 16 + fr; float mx = -3.0e38f;
                const f32x4* sp = (const f32x4*)(ssq16 + (size_t)(u.pm * BM + rl) * 16); const f32x4 st = (sp[0] + sp[1]) + (sp[2] + sp[3]);
                const float rs = 1.0f / sqrtf(((st[0] + st[1]) + (st[2] + st[3])) * (1.0f / D) + NORM_EPS);
#pragma unroll
                for (int bj = 0; bj < 2; ++bj)
#pragma unroll
                    for (int n = 0; n < 2; ++n) { const f32x4 v = acc[ai][bj][m][n] * rs; acc[ai][bj][m][n] = v; mx = fmaxf(mx, fmaxf(fmaxf(v[0], v[1]), fmaxf(v[2], v[3]))); }
                mx = fmaxf(mx, __shfl_xor(mx, 16)); mx = fmaxf(mx, __shfl_xor(mx, 32));
                if (fq == 0) MX[rl * 4 + wc] = mx; }
        RAW_BARRIER();
#pragma unroll
        for (int ai = 0; ai < 2; ++ai)
#pragma unroll
            for (int m = 0; m < 4; ++m) { const int rl = ai * HALF + wr * 64 + m * 16 + fr; const f32x4 mm = *(const LAS f32x4*)(MX + rl * 4);
                const float mx = fmaxf(fmaxf(mm[0], mm[1]), fmaxf(mm[2], mm[3])); float ss = 0.f;
#pragma unroll
                for (int bj = 0; bj < 2; ++bj)
#pragma unroll
                    for (int n = 0; n < 2; ++n) { f32x4 v = acc[ai][bj][m][n];
#pragma unroll
                        for (int i = 0; i < 4; ++i) { v[i] = __builtin_amdgcn_exp2f(v[i] - mx); ss += v[i]; }
                        acc[ai][bj][m][n] = v; }
                ss += __shfl_xor(ss, 16); ss += __shfl_xor(ss, 32);
                if (fq == 0) SM[rl * 4 + wc] = ss; }
        RAW_BARRIER();
        const int col0 = u.pn * BM + wc * 32 + fq * 8;
#pragma unroll
        for (int ai = 0; ai < 2; ++ai)
#pragma unroll
            for (int m = 0; m < 4; ++m) { const int rl = ai * HALF + wr * 64 + m * 16 + fr; const f32x4 s4 = *(const LAS f32x4*)(SM + rl * 4);
                const float inv = 1.0f / ((s4[0] + s4[1]) + (s4[2] + s4[3]));
#pragma unroll
                for (int bj = 0; bj < 2; ++bj) *(u32x4*)(PM + (size_t)(u.pm * BM + rl) * D + col0 + bj * HALF) = pack8(acc[ai][bj][m][0] * inv, acc[ai][bj][m][1] * inv); }
    }
};
struct EpiMoe1 {
    static constexpr bool PERM = true; EPI_NOMID
    bf16_t* HID; const float* slot_rs;
    __device__ __forceinline__ void operator()(Acc& acc, const Unit& u, int wr, int wc, int fr, int fq, LAS unsigned char*, int, int) const {
        const int row0 = u.pm * BM + wr * 64 + fr;
#pragma unroll
        for (int ai = 0; ai < 2; ++ai)
#pragma unroll
            for (int m = 0; m < 4; ++m) { const int row = row0 + ai * HALF + m * 16; const float rs = slot_rs[row]; f32x4 o[2];
#pragma unroll
                for (int n = 0; n < 2; ++n)
#pragma unroll
                    for (int i = 0; i < 4; ++i) { const float a = acc[ai][0][m][n][i] * rs, b = acc[ai][1][m][n][i] * rs; o[n][i] = a * b / (1.f + __expf(-a)); }
                *(u32x4*)(HID + (size_t)row * FF + u.pn * HALF + wc * 32 + fq * 8) = pack8(o[0], o[1]); }
    }
};
struct EpiMoe2 {
    static constexpr bool PERM = true; EPI_NOMID
    bf16_t* Y; const float* slot_gate;
    __device__ __forceinline__ void operator()(Acc& acc, const Unit& u, int wr, int wc, int fr, int fq, LAS unsigned char*, int, int) const {
        const int row0 = u.pm * BM + wr * 64 + fr, col0 = u.pn * BM + wc * 32 + fq * 8;
#pragma unroll
        for (int ai = 0; ai < 2; ++ai)
#pragma unroll
            for (int m = 0; m < 4; ++m) { const int row = row0 + ai * HALF + m * 16; const float g = slot_gate[row];
#pragma unroll
                for (int bj = 0; bj < 2; ++bj) *(u32x4*)(Y + (size_t)row * D + col0 + bj * HALF) = pack8(acc[ai][bj][m][0] * g, acc[ai][bj][m][1] * g); }
    }
};
}
struct Frame {
    LAS unsigned char* lds;
    volatile LAS unsigned* MISC;
    unsigned* ctl;
    unsigned char* ws;
    int wave, vcu, G;
};
struct Args { const void* in[27]; float* out; unsigned char* ws; int ph_lo, ph_hi, li, pad; };

__device__ __forceinline__ void tr_item(const float* W, int ldw, int srcrow0, int srccol0, bf16_t* WT, int dpitch, size_t drow0, int dk0, const float* gk, float sc, LAS float* scr, int lane) {
    f32x4 v[8]; const int n4 = lane & 7, kq = lane >> 3;
#pragma unroll
    for (int i = 0; i < 8; ++i) v[i] = *(const f32x4*)(W + (size_t)(srcrow0 + kq + 8 * i) * ldw + srccol0 + 4 * n4);
#pragma unroll
    for (int i = 0; i < 8; ++i) { const int kk = kq + 8 * i; const float g = gk ? gk[kk] * sc : sc; LAS float* d = scr + kk * 33 + 4 * n4;
        d[0] = v[i][0] * g; d[1] = v[i][1] * g; d[2] = v[i][2] * g; d[3] = v[i][3] * g; }
    LDS_WAIT(); asm volatile("" ::: "memory");
    const int c = lane & 7;
#pragma unroll
    for (int j = 0; j < 4; ++j) { const int n = (lane >> 3) + 8 * j; const LAS float* s = scr + (8 * c) * 33 + n;
        u32x4 o; o.x = pk2(s[0 * 33], s[1 * 33]); o.y = pk2(s[2 * 33], s[3 * 33]); o.z = pk2(s[4 * 33], s[5 * 33]); o.w = pk2(s[6 * 33], s[7 * 33]);
        *(u32x4*)(WT + (drow0 + n) * dpitch + dk0 + 8 * c) = o; }
    LDS_WAIT(); asm volatile("" ::: "memory");
}
__device__ __forceinline__ void rms_row_to_bf16(const float* xrow, const float* g, bf16_t* orow, int lane) {
    const f32x4* xr = (const f32x4*)xrow + lane; const f32x4* gr = (const f32x4*)g + lane;
    f32x4 v[4]; float s = 0.f;
#pragma unroll
    for (int j = 0; j < 4; ++j) { v[j] = xr[64 * j]; s += (v[j][0] * v[j][0] + v[j][1] * v[j][1]) + (v[j][2] * v[j][2] + v[j][3] * v[j][3]); }
    const float rs = 1.0f / sqrtf(wave_sum(s) * (1.f / D) + NORM_EPS);
    u32x2* o8 = (u32x2*)orow + lane;
#pragma unroll
    for (int j = 0; j < 4; ++j) { const f32x4 gg = gr[64 * j]; u32x2 w; w.x = pk2(v[j][0] * rs * gg[0], v[j][1] * rs * gg[1]); w.y = pk2(v[j][2] * rs * gg[2], v[j][3] * rs * gg[3]); o8[64 * j] = w; }
}
__device__ __forceinline__ void rms_row2_to_bf16(const float* xrow, const float* g, bf16_t* orow, int lane) {
    const f32x4* xr = (const f32x4*)xrow + lane; const f32x4* gr = (const f32x4*)g + lane;
    f32x4 v[2][4]; float s0 = 0.f, s1 = 0.f;
#pragma unroll
    for (int r = 0; r < 2; ++r)
#pragma unroll
        for (int j = 0; j < 4; ++j) v[r][j] = xr[r * 256 + 64 * j];
#pragma unroll
    for (int j = 0; j < 4; ++j) { s0 += (v[0][j][0] * v[0][j][0] + v[0][j][1] * v[0][j][1]) + (v[0][j][2] * v[0][j][2] + v[0][j][3] * v[0][j][3]);
        s1 += (v[1][j][0] * v[1][j][0] + v[1][j][1] * v[1][j][1]) + (v[1][j][2] * v[1][j][2] + v[1][j][3] * v[1][j][3]); }
    const float r0 = 1.0f / sqrtf(wave_sum(s0) * (1.f / D) + NORM_EPS), r1 = 1.0f / sqrtf(wave_sum(s1) * (1.f / D) + NORM_EPS);
    u32x2* o8 = (u32x2*)orow + lane;
#pragma unroll
    for (int j = 0; j < 4; ++j) { const f32x4 gg = gr[64 * j]; u32x2 w;
        w.x = pk2(v[0][j][0] * r0 * gg[0], v[0][j][1] * r0 * gg[1]); w.y = pk2(v[0][j][2] * r0 * gg[2], v[0][j][3] * r0 * gg[3]); o8[64 * j] = w;
        w.x = pk2(v[1][j][0] * r1 * gg[0], v[1][j][1] * r1 * gg[1]); w.y = pk2(v[1][j][2] * r1 * gg[2], v[1][j][3] * r1 * gg[3]); o8[256 + 64 * j] = w; }
}
__device__ __forceinline__ double rope_inv(int d) {
    const int q = d >> 3, r = d & 7;
    double b = 1.0;
    b = (r == 1) ? 0.7498942093324558273 : b; b = (r == 2) ? 0.56234132519034908039 : b; b = (r == 3) ? 0.42169650342858224857 : b; b = (r == 4) ? 0.3162277660168379332 : b;
    b = (r == 5) ? 0.23713737056616552617 : b; b = (r == 6) ? 0.17782794100389228012 : b; b = (r == 7) ? 0.13335214321633240257 : b;
    const double p = (q == 0) ? 1.0 : (q == 1) ? 0.1 : (q == 2) ? 0.01 : 0.001;
    return b * p;
}
__device__ __forceinline__ void sincos_d(double a, double& sn, double& cs) {
    const double k = __builtin_rint(a * 0.63661977236758134308);
    double y = __builtin_fma(-k, 1.57079632679489655800e+00, a); y = __builtin_fma(-k, 6.12323399573676603587e-17, y);
    const double y2 = y * y;
    double s = 1.0 / 6227020800.0; s = s * y2 - 1.0 / 39916800.0; s = s * y2 + 1.0 / 362880.0; s = s * y2 - 1.0 / 5040.0; s = s * y2 + 1.0 / 120.0; s = s * y2 - 1.0 / 6.0; s = s * y2 * y + y;
    double c = 1.0 / 479001600.0; c = c * y2 - 1.0 / 3628800.0; c = c * y2 + 1.0 / 40320.0; c = c * y2 - 1.0 / 720.0; c = c * y2 + 1.0 / 24.0; c = c * y2 - 0.5; c = c * y2 + 1.0;
    const int qd = ((int)k) & 3;
    sn = (qd == 0) ? s : (qd == 1) ? c : (qd == 2) ? -s : -c;
    cs = (qd == 0) ? c : (qd == 1) ? -s : (qd == 2) ? -c : s;
}
typedef const void* gen_cptr;
typedef __attribute__((address_space(4))) const char* cas_cptr;
typedef __attribute__((address_space(4))) const gen_cptr* cas_pptr;
__device__ __forceinline__ const void* karg_ptr(int byte_off) { cas_cptr p = (cas_cptr)__builtin_amdgcn_kernarg_segment_ptr(); asm volatile("" : "+s"(p)); return *(cas_pptr)(p + byte_off); }
__device__ __forceinline__ void p0_prologue(Frame& F) {
    const int lane = lane_id(), tid = F.wave * 64 + lane;
    const float* x = (const float*)karg_ptr(8 * 0); const float* mem = (const float*)karg_ptr(8 * 1); const int* positions = (const int*)karg_ptr(8 * 2);
    const float* mix_g = (const float*)karg_ptr(8 * 3); const float* w_in = (const float*)karg_ptr(8 * 4);
    const float* attn_out_g = (const float*)karg_ptr(8 * 10); const float* w_out = (const float*)karg_ptr(8 * 11);
    const float* xattn_g = (const float*)karg_ptr(8 * 12); const float* mem_g = (const float*)karg_ptr(8 * 13);
    const float* w_xq = (const float*)karg_ptr(8 * 14); const float* w_xk = (const float*)karg_ptr(8 * 15); const float* w_xv = (const float*)karg_ptr(8 * 16); const float* w_xo = (const float*)karg_ptr(8 * 17);
    const float* moe_g = (const float*)karg_ptr(8 * 18); const float* w_group = (const float*)karg_ptr(8 * 19); const float* w_router = (const float*)karg_ptr(8 * 21);
    const float* w1 = (const float*)karg_ptr(8 * 23); const float* w3 = (const float*)karg_ptr(8 * 24); const float* w2 = (const float*)karg_ptr(8 * 25);
    unsigned char* ws = F.ws;
    LAS float* scr = (LAS float*)(F.lds + F.wave * 16384);
    const int gw = F.vcu * NWAVES + F.wave, NGW = F.G * NWAVES;
    constexpr int I_IN = 16 * 88, I_SQ = 16 * 32, I_13 = NE * 16 * 32, I_2 = NE * 8 * 32;
    constexpr int NITEMS = I_IN + 5 * I_SQ + I_13 + I_2;
    for (int it = gw; it < NITEMS; it += NGW) {
        int r = it;
        if (r < I_IN) { const int kb = r / 88, nb = r % 88, n0 = 32 * nb, tile = n0 >> 8, j = n0 & 255; int src;
            if (tile < 2) src = (j < 128) ? 128 * tile + j : 256 + 128 * tile + (j - 128);
            else if (tile < 8) { const int sec = (tile - 2) / 3, tt = (tile - 2) % 3, jj = j & 127, hh = jj >> 5; src = 512 + 768 * sec + 256 * tt + 64 * hh + ((j < 128) ? 0 : 32); }
            else src = n0;
            tr_item(w_in, INW, 64 * kb, src, (bf16_t*)(ws + WS_WIN), D, (size_t)n0, 64 * kb, nullptr, 1.f, scr, lane); continue; }
        r -= I_IN;
        if (r < I_SQ) { const int kb = r / 32, nb = r % 32, dk0 = 64 * kb; const bool at = dk0 < AW;
            tr_item(w_out, D, at ? CCH + dk0 : dk0 - AW, 32 * nb, (bf16_t*)(ws + WS_WOUT), D, (size_t)(32 * nb), dk0, at ? attn_out_g + dk0 : nullptr, 1.f, scr, lane); continue; }
        r -= I_SQ;
        if (r < 4 * I_SQ) { const int which = r / I_SQ, r2 = r % I_SQ, kb = r2 / 32, nb = r2 % 32;
            if (which == 0) {
                bf16_t* WQ2 = (bf16_t*)(ws + WS_WXQ); const int n4 = lane & 7, kq = lane >> 3;
#pragma unroll
                for (int i = 0; i < 8; ++i) { const int k = 64 * kb + kq + 8 * i; const f32x4 v = *(const f32x4*)(w_xq + (size_t)k * D + 32 * nb + 4 * n4); const float g = xattn_g[k] * (LOG2E / 16.f);
                    u32x2 o; o.x = pk2(v[0] * g, v[1] * g); o.y = pk2(v[2] * g, v[3] * g); *(u32x2*)(WQ2 + (size_t)k * D + 32 * nb + 4 * n4) = o; }
                continue; }
            const float* W = which == 1 ? w_xk : which == 2 ? w_xv : w_xo;
            bf16_t* WT = (bf16_t*)(ws + (which == 1 ? WS_WXK : which == 2 ? WS_WXV : WS_WXO));
            tr_item(W, D, 64 * kb, 32 * nb, WT, D, (size_t)(32 * nb), 64 * kb, nullptr, 1.f, scr, lane); continue; }
        r -= 4 * I_SQ;
        if (r < I_13) { const int e = r / 512, r2 = r % 512, kb = r2 / 32, nb = r2 % 32, n0 = 32 * nb, tt = n0 >> 8, j = n0 & 255;
            const float* W = ((j < 128) ? w1 : w3) + (size_t)e * D * FF;
            tr_item(W, FF, 64 * kb, 128 * tt + (j & 127), (bf16_t*)(ws + WS_W13), D, (size_t)e * 1024 + n0, 64 * kb, moe_g + 64 * kb, 1.f, scr, lane); continue; }
        r -= I_13;
        { const int e = r / 256, r2 = r % 256, kb = r2 / 32, nb = r2 % 32;
            tr_item(w2 + (size_t)e * FF * D, D, 64 * kb, 32 * nb, (bf16_t*)(ws + WS_W2), FF, (size_t)e * 1024 + 32 * nb, 64 * kb, nullptr, 1.f, scr, lane); }
    }
    { bf16_t* WRF = (bf16_t*)(ws + WS_HIST + HIST_WR);
      for (int i = blockIdx.x * 512 + tid; i < 4 * 8 * 3 * 2 * 64 * 8; i += F.G * 512) {
          const int j = i & 7, ln = (i >> 3) & 63, part = (i >> 9) & 1, blk = i >> 10, nt = blk % 3, s = (blk / 3) & 7, kc = blk / 24;
          const int k = 256 * kc + 32 * s + 8 * (ln >> 4) + j, o = 16 * nt + (ln & 15);
          float v = 0.f; if (o < 32) v = w_router[k * 32 + o] * moe_g[k]; else if (o < 36) v = w_group[k * 4 + (o - 32)] * moe_g[k];
          const unsigned hb = f2bf(v); const float hf = __builtin_bit_cast(float, hb << 16);
          WRF[i] = (bf16_t)(part ? f2bf(v - hf) : hb); } }
    { float* rc = (float*)(ws + WS_ROPE); float* rsn = rc + SEQ * 32;
      for (int i = blockIdx.x * 512 + tid; i < SEQ * 32; i += F.G * 512) { const int s = i >> 5, d = i & 31;
          const float inv = (float)rope_inv(d); const float ang = (float)positions[s] * inv; double sn, cs; sincos_d((double)fabsf(ang), sn, cs); if (ang < 0.f) sn = -sn;
          rc[i] = (float)cs; rsn[i] = (float)sn; } }
    for (int m = gw; m < MROWS; m += NGW) rms_row_to_bf16(mem + (size_t)m * D, mem_g, (bf16_t*)(ws + WS_MEMN) + (size_t)m * D, lane);
    for (int m = 2 * gw; m < T; m += 2 * NGW) rms_row2_to_bf16(x + (size_t)m * D, mix_g, (bf16_t*)(ws + WS_R1) + (size_t)m * D, lane);
}
namespace att {
typedef short v4i16_t __attribute__((ext_vector_type(4)));
constexpr int BUFB = 65536, VIMG = 32768;
constexpr float NEG = -1.0e30f, MFLOOR = -1.0e9f;
__device__ __forceinline__ int k_off(int row, int c) { return row * 128 + ((c ^ ((row >> 1) & 7)) << 4); }
__device__ __forceinline__ int v_off(int row, int c) { return VIMG + row * 128 + ((c ^ (((row >> 1) & 3) << 1)) << 4); }

struct Grp { bf16x8 q0, q1; f32x4 o[4]; float m, l; };
struct KV { bf16x8 k[2][2]; bf16x8 v[4]; };

#ifdef ATT_SHFL
__device__ __forceinline__ float xmax16(float v) { return fmaxf(v, __shfl_xor(v, 16)); }
__device__ __forceinline__ float xmax32(float v) { return fmaxf(v, __shfl_xor(v, 32)); }
__device__ __forceinline__ float xsum16(float v) { return v + __shfl_xor(v, 16); }
__device__ __forceinline__ float xsum32(float v) { return v + __shfl_xor(v, 32); }
#else
__device__ __forceinline__ void swap16(float v, float& a, float& b) { a = v; b = v; asm volatile("s_nop 1\n\tv_permlane16_swap_b32 %0, %1" : "+v"(a), "+v"(b)); }
__device__ __forceinline__ void swap32(float v, float& a, float& b) { a = v; b = v; asm volatile("s_nop 1\n\tv_permlane32_swap_b32 %0, %1" : "+v"(a), "+v"(b)); }
__device__ __forceinline__ float xmax16(float v) { float a, b; swap16(v, a, b); return fmaxf(a, b); }
__device__ __forceinline__ float xmax32(float v) { float a, b; swap32(v, a, b); return fmaxf(a, b); }
__device__ __forceinline__ float xsum16(float v) { float a, b; swap16(v, a, b); return a + b; }
__device__ __forceinline__ float xsum32(float v) { float a, b; swap32(v, a, b); return a + b; }
#endif
constexpr int NSTEP_ = 19;
__device__ __forceinline__ int step_pos(int step, int row, int c0) {
    if (step < 3) { const int hh = row >> 7, jj = row & 127; return c0 + 256 * hh - 64 + 128 * step + jj; }
    if (step < 9) { const int s = step - 3, hh = row >> 7, c = (row >> 5) & 3, jj = row & 31; return 4 * ((c0 >> 2) + 64 * hh - 64 + 32 * s + jj) + c; }
    { const int s = step - 9, pb = s >> 1, rh = s & 1, rr = row >> 5, jj = row & 31; return 16 * ((c0 >> 4) - 64 + 32 * pb + jj) + 8 * rh + rr; }
}
__device__ __forceinline__ void stage_issue(unsigned ldsbuf, const char* Kg, const char* Vg, int brow0, int hcol, int c0, int step, int wave, int lane) {
    const bool isV = wave >= 4; const char* gb = pg8::uniform_ptr(isV ? Vg : Kg);
#pragma unroll
    for (int i = 0; i < 8; ++i) { const int blk = (wave & 3) * 8 + i, row = 8 * blk + (lane >> 3), phys = lane & 7;
        const int c = isV ? (phys ^ (((row >> 1) & 3) << 1)) : (phys ^ ((row >> 1) & 7));
        int pos = step_pos(step, row, c0); pos = pos < 0 ? 0 : (pos > SEQ - 1 ? SEQ - 1 : pos);
        const unsigned voff = (unsigned)((brow0 + pos) * AW + hcol + c * 8) * 2u;
        pg8::glds16_sv(gb, voff, ldsbuf + (isV ? (unsigned)VIMG : 0u) + (unsigned)blk * 1024u); __builtin_amdgcn_sched_barrier(0); }
}
struct LaneOff { int kb0; int vb[4]; };
__device__ __forceinline__ void lane_off(LaneOff& o, int lane) {
    const int key = lane & 15, g = lane >> 4, q = (lane >> 2) & 3, p2 = lane & 3;
    o.kb0 = k_off(key, g);
#pragma unroll
    for (int db = 0; db < 4; ++db) o.vb[db] = v_off(4 * g + q, 2 * db + (p2 >> 1)) + 8 * (p2 & 1);
}
__device__ __forceinline__ const LAS unsigned char* row_base(const LAS unsigned char* buf, int Rb) {
    return (const LAS unsigned char*)(uintptr_t)(unsigned)__builtin_amdgcn_readfirstlane((int)((unsigned)(uintptr_t)buf + (unsigned)(Rb * 128))); }
__device__ __forceinline__ void load_k(bf16x8 (&k)[2][2], const LAS unsigned char* buf, int Rb, const LaneOff& lo) {
    const LAS unsigned char* rb = row_base(buf, Rb);
#pragma unroll
    for (int t = 0; t < 2; ++t) { k[t][0] = *(const LAS bf16x8*)(rb + t * 2048 + lo.kb0); k[t][1] = *(const LAS bf16x8*)(rb + t * 2048 + (lo.kb0 ^ 64)); }
}
__device__ __forceinline__ void load_v(bf16x8 (&v)[4], const LAS unsigned char* buf, int Rb, const LaneOff& lo) {
    const LAS unsigned char* rb = row_base(buf, Rb);
#pragma unroll
    for (int db = 0; db < 4; ++db) {
        const s16x4 v0 = __builtin_bit_cast(s16x4, __builtin_amdgcn_ds_read_tr16_b64_v4i16((LAS v4i16_t*)(rb + lo.vb[db])));
        const s16x4 v1 = __builtin_bit_cast(s16x4, __builtin_amdgcn_ds_read_tr16_b64_v4i16((LAS v4i16_t*)(rb + 2048 + lo.vb[db])));
        v[db] = (bf16x8){v0[0], v0[1], v0[2], v0[3], v1[0], v1[1], v1[2], v1[3]}; }
}
__device__ __forceinline__ float fmax_nc(float a, float b) { float r; asm("v_max_f32_e32 %0, %1, %2" : "=v"(r) : "v"(a), "v"(b)); return r; }
__device__ __forceinline__ float fmax3_nc(float a, float b, float c) { float r; asm("v_max3_f32 %0, %1, %2, %3" : "=v"(r) : "v"(a), "v"(b), "v"(c)); return r; }
__device__ __forceinline__ void qk_part(const Grp& G, const bf16x8 (&k)[2][2], f32x4 (&s)[2]) {
#pragma unroll
    for (int t = 0; t < 2; ++t) { f32x4 z = (f32x4){0.f, 0.f, 0.f, 0.f};
        z = __builtin_amdgcn_mfma_f32_16x16x32_bf16(k[t][0], G.q0, z, 0, 0, 0); s[t] = __builtin_amdgcn_mfma_f32_16x16x32_bf16(k[t][1], G.q1, z, 0, 0, 0); }
}
template <bool FULL, bool INR>
__device__ __forceinline__ void sm_part(Grp& G, f32x4 (&s)[2], int ksub0, int qsub, int L, int lane, bf16x8& pb, float& alpha) {
    const int g = lane >> 4;
    if constexpr (!FULL) { const int d0 = ksub0 + 4 * g - qsub + 64, k0 = ksub0 + 4 * g;
#pragma unroll
        for (int t = 0; t < 2; ++t)
#pragma unroll
            for (int i = 0; i < 4; ++i) { bool ok = ((unsigned)(d0 + 16 * t + i) <= 128u); if constexpr (!INR) ok = ok && ((unsigned)(k0 + 16 * t + i) < (unsigned)L); s[t][i] = ok ? s[t][i] : NEG; } }
    float mx = fmax3_nc(fmax3_nc(s[0][0], s[0][1], s[0][2]), fmax3_nc(s[0][3], s[1][0], s[1][1]), fmax3_nc(s[1][2], s[1][3], G.m));
    { float a, b; swap16(mx, a, b); mx = fmax_nc(a, b); swap32(mx, a, b); mx = fmax_nc(a, b); }
    const float mn = mx; alpha = __builtin_amdgcn_exp2f(G.m - mn);
    G.m = mn; float p[2][4]; float ps = 0.f;
#pragma unroll
    for (int t = 0; t < 2; ++t)
#pragma unroll
        for (int i = 0; i < 4; ++i) { const float e = __builtin_amdgcn_exp2f(s[t][i] - mn); p[t][i] = e; ps += e; }
    G.l = G.l * alpha + ps;
    u32x4 pw; pw.x = cvt_pk_bf16(p[0][0], p[0][1]); pw.y = cvt_pk_bf16(p[0][2], p[0][3]); pw.z = cvt_pk_bf16(p[1][0], p[1][1]); pw.w = cvt_pk_bf16(p[1][2], p[1][3]);
    pb = __builtin_bit_cast(bf16x8, pw);
}
__device__ __forceinline__ void pv_part(Grp& G, const bf16x8 (&v)[4], const bf16x8& pb, float alpha) {
#pragma unroll
    for (int db = 0; db < 4; ++db) G.o[db] = __builtin_amdgcn_mfma_f32_16x16x32_bf16(v[db], pb, G.o[db] * alpha, 0, 0, 0);
}
__device__ __forceinline__ void grp_init(Grp& G, const bf16_t* Qb, size_t tok0, int hcol, int lane) {
    const int a = lane & 15, g = lane >> 4; const bf16_t* qp = Qb + (tok0 + 16 * a) * AW + hcol + 8 * g;
    G.q0 = *(const bf16x8*)qp; G.q1 = *(const bf16x8*)(qp + 32);
#pragma unroll
    for (int d = 0; d < 4; ++d) G.o[d] = (f32x4){0.f, 0.f, 0.f, 0.f};
    G.m = MFLOOR; G.l = 0.f;
}
__device__ __forceinline__ void grp_finish(Grp& G, bf16_t* MIX, float* ssqa, size_t tok0, int h, int lane) {
    const int a = lane & 15, g = lane >> 4; float l = G.l; l = xsum16(l); l = xsum32(l);
    const float inv = 1.0f / l; const size_t tok = tok0 + 16 * a; float ss = 0.f;
#pragma unroll
    for (int db = 0; db < 4; ++db) { const f32x4 o = G.o[db] * inv; ss += (o[0] * o[0] + o[1] * o[1]) + (o[2] * o[2] + o[3] * o[3]);
        u32x2 w; w.x = cvt_pk_bf16(o[0], o[1]); w.y = cvt_pk_bf16(o[2], o[3]); *(u32x2*)(MIX + tok * D + h * HD + 16 * db + 4 * g) = w; }
    ss = xsum16(ss); ss = xsum32(ss);
    if (g == 0) ssqa[tok * NH + h] = ss;
}
#define ATT_SYNC() do { asm volatile("s_waitcnt vmcnt(0) lgkmcnt(0)" ::: "memory"); __builtin_amdgcn_s_barrier(); asm volatile("" ::: "memory"); } while (0)
#define ATT_SB() __builtin_amdgcn_sched_barrier(0)
template <bool INR>
__device__ __forceinline__ void pair4(Grp& G0, Grp& G1, Grp& G2, Grp& G3, const LAS unsigned char* buf, int Rb, const LaneOff& lo, int ks0, int qs, int dq, int L, int lane) {
    f32x4 s0[2], s1[2], s2[2], s3[2]; bf16x8 p0, p1, p2, p3; float a0, a1, a2, a3;
    { bf16x8 k[2][2]; load_k(k, buf, Rb, lo); qk_part(G0, k, s0); qk_part(G1, k, s1); qk_part(G2, k, s2); qk_part(G3, k, s3); } ATT_SB();
    bf16x8 v[4]; load_v(v, buf, Rb, lo);
    sm_part<false, INR>(G0, s0, ks0, qs, L, lane, p0, a0); sm_part<false, INR>(G1, s1, ks0, qs + dq, L, lane, p1, a1); ATT_SB();
    sm_part<false, INR>(G2, s2, ks0, qs + 2 * dq, L, lane, p2, a2); sm_part<false, INR>(G3, s3, ks0, qs + 3 * dq, L, lane, p3, a3); ATT_SB();
    pv_part(G0, v, p0, a0); pv_part(G1, v, p1, a1); pv_part(G2, v, p2, a2); pv_part(G3, v, p3, a3); ATT_SB();
}
template <bool FULL, bool INR>
__device__ __forceinline__ void pair2(Grp& GA, Grp& GB, const LAS unsigned char* buf, int RbA, int RbB, const LaneOff& lo, int ks0, int qs, int L, int lane) {
    f32x4 s0[2], s1[2]; bf16x8 p0, p1; float a0, a1;
    { bf16x8 ka[2][2], kb[2][2]; load_k(ka, buf, RbA, lo); load_k(kb, buf, RbB, lo); qk_part(GA, ka, s0); qk_part(GB, kb, s1); } ATT_SB();
    bf16x8 va[4], vb[4]; load_v(va, buf, RbA, lo); load_v(vb, buf, RbB, lo);
    sm_part<FULL, INR>(GA, s0, ks0, qs, L, lane, p0, a0); sm_part<FULL, INR>(GB, s1, ks0, qs, L, lane, p1, a1); ATT_SB();
    pv_part(GA, va, p0, a0); pv_part(GB, vb, p1, a1); ATT_SB();
}
__device__ __forceinline__ void attn_unit(LAS unsigned char* lds, const bf16_t* Qb, const bf16_t* Kb, const bf16_t* Vb, bf16_t* MIX, float* ssqa, int b, int h, int c0, int tid, int wave, int lane_) {
    int lane = lane_; asm volatile("" : "+v"(lane));
    const int brow0 = b * SEQ, hcol = h * HD, half = wave >> 2, w4 = wave & 3, ch = c0 + 256 * half;
    const unsigned lds0 = (unsigned)(uintptr_t)lds;
    const size_t tokb = (size_t)(brow0 + ch + w4);
    Grp G0, G1, G2, G3;
    grp_init(G0, Qb, tokb, hcol, lane); grp_init(G1, Qb, tokb + 4, hcol, lane); grp_init(G2, Qb, tokb + 8, hcol, lane); grp_init(G3, Qb, tokb + 12, hcol, lane);
    ATT_SYNC();
    { int ln = lane; asm volatile("" : "+v"(ln)); stage_issue(lds0, (const char*)Kb, (const char*)Vb, brow0, hcol, c0, 0, wave, ln); }
#pragma nounroll
    for (int step = 0; step < NSTEP_; ++step) {
        ATT_SYNC();
        int ln = lane; asm volatile("" : "+v"(ln));
        if (step + 1 < NSTEP_) stage_issue(lds0 + (unsigned)(((step + 1) & 1) * BUFB), (const char*)Kb, (const char*)Vb, brow0, hcol, c0, step + 1, wave, ln);
        const LAS unsigned char* buf = lds + (step & 1) * BUFB;
        LaneOff lo; lane_off(lo, ln); const int a = ln & 15;
        if (step < 3) {
            const int qs = ch + w4 + 16 * a;
#pragma nounroll
            for (int p = 0; p < 4; ++p) { const int ks0 = ch - 64 + 128 * step + 32 * p;
                if (ks0 + 31 >= 0 && ks0 < SEQ) { const int Rb = 128 * half + 32 * p;
                    if (ks0 >= 0 && ks0 + 32 <= SEQ) pair4<true>(G0, G1, G2, G3, buf, Rb, lo, ks0, qs, 4, SEQ, ln); else pair4<false>(G0, G1, G2, G3, buf, Rb, lo, ks0, qs, 4, SEQ, ln); } }
        } else if (step < 9) {
            const int s = step - 3, ks0 = (ch >> 2) - 64 + 32 * s, qs = (ch >> 2) + 4 * a;
            if (ks0 + 31 >= 0 && ks0 < SEQ / 4) { const int Rb = 128 * half + 32 * w4;
                if (ks0 >= 0 && ks0 + 32 <= SEQ / 4) pair4<true>(G0, G1, G2, G3, buf, Rb, lo, ks0, qs, 1, SEQ / 4, ln); else pair4<false>(G0, G1, G2, G3, buf, Rb, lo, ks0, qs, 1, SEQ / 4, ln); }
        } else {
            const int s = step - 9, pb = s >> 1, rh = s & 1, ks0 = (c0 >> 4) - 64 + 32 * pb, qlo = (ch >> 4), qs = qlo + a;
            if (ks0 + 31 >= 0 && ks0 < SEQ / 16 && ks0 <= qlo + 15 + 64 && ks0 + 31 >= qlo - 64) {
                const int RA = 32 * w4, RB = 32 * (w4 + 4);
                const bool inr = (ks0 >= 0) && (ks0 + 32 <= SEQ / 16), full = inr && (ks0 + 31 - qlo <= 64) && (qlo + 15 - ks0 <= 64);
                if (rh == 0) { if (full) pair2<true, true>(G0, G1, buf, RA, RB, lo, ks0, qs, SEQ / 16, ln); else if (inr) pair2<false, true>(G0, G1, buf, RA, RB, lo, ks0, qs, SEQ / 16, ln); else pair2<false, false>(G0, G1, buf, RA, RB, lo, ks0, qs, SEQ / 16, ln); }
                else { if (full) pair2<true, true>(G2, G3, buf, RA, RB, lo, ks0, qs, SEQ / 16, ln); else if (inr) pair2<false, true>(G2, G3, buf, RA, RB, lo, ks0, qs, SEQ / 16, ln); else pair2<false, false>(G2, G3, buf, RA, RB, lo, ks0, qs, SEQ / 16, ln); }
            }
        }
    }
    { int lf = lane; asm volatile("" : "+v"(lf)); const size_t tf = (size_t)(brow0 + ch + w4);
      grp_finish(G0, MIX, ssqa, tf, h, lf); grp_finish(G1, MIX, ssqa, tf + 4, h, lf); grp_finish(G2, MIX, ssqa, tf + 8, h, lf); grp_finish(G3, MIX, ssqa, tf + 12, h, lf); }
}
__device__ __forceinline__ void conv_unit(LAS unsigned char* lds, const bf16_t* Cb, bf16_t* MIX, const float* dw_w, const float* dw_b, const float* ln_g, const float* ln_b, const float* out_g,
                                          int b, int s0, int tid_, int wave, int lane_) {
    int tid = tid_, lane = lane_; asm volatile("" : "+v"(tid), "+v"(lane));
    LAS bf16_t* CT = (LAS bf16_t*)lds;
    LAS float* CO = (LAS float*)(lds + 49152);
    ATT_SYNC();
    for (int p = tid; p < 94 * 32; p += NWAVES * 64) { const int row = p >> 5, c = p & 31, s = s0 - 15 + row;
        u32x4 v = (u32x4){0u, 0u, 0u, 0u};
        if (s >= 0 && s < SEQ) v = *(const u32x4*)(Cb + (size_t)(b * SEQ + s) * CCH + c * 8);
        *(LAS u32x4*)(CT + row * CCH + c * 8) = v; }
    ATT_SYNC();
    { const int ch = tid & 255, half = tid >> 8; float v[62], w[CONVK];
#pragma unroll
      for (int k = 0; k < CONVK; ++k) w[k] = dw_w[k * CCH + ch];
#pragma unroll
      for (int i = 0; i < 62; ++i) v[i] = bf2f(CT[(32 * half + i) * CCH + ch]);
      const float bias = dw_b[ch];
#pragma unroll
      for (int p = 0; p < 32; ++p) { float acc = bias;
#pragma unroll
          for (int k = 0; k < CONVK; ++k) acc += v[p + k] * w[k];
          CO[(32 * half + p) * CCH + ch] = acc; } }
    ATT_SYNC();
    { const f32x4 g4 = *((const f32x4*)ln_g + lane), b4 = *((const f32x4*)ln_b + lane), og = *((const f32x4*)out_g + lane);
#pragma unroll
      for (int pp = 0; pp < 8; ++pp) { const int p = wave * 8 + pp; const f32x4 xv = *(const LAS f32x4*)(CO + p * CCH + 4 * lane);
          const float mean = wave_sum((xv[0] + xv[1]) + (xv[2] + xv[3])) * (1.f / CCH); const f32x4 dx = xv - mean;
          const float var = wave_sum((dx[0] * dx[0] + dx[1] * dx[1]) + (dx[2] * dx[2] + dx[3] * dx[3])) * (1.f / CCH); const float rstd = 1.0f / sqrtf(var + LN_EPS);
          f32x4 z;
#pragma unroll
          for (int i = 0; i < 4; ++i) { const float y = dx[i] * rstd * g4[i] + b4[i]; z[i] = y / (1.f + __expf(-y)); }
          const float ms = wave_sum((z[0] * z[0] + z[1] * z[1]) + (z[2] * z[2] + z[3] * z[3])) * (1.f / CCH); const float rs = 1.0f / sqrtf(ms + NORM_EPS);
          u32x2 o; o.x = cvt_pk_bf16(z[0] * rs * og[0], z[1] * rs * og[1]); o.y = cvt_pk_bf16(z[2] * rs * og[2], z[3] * rs * og[3]);
          *(u32x2*)(MIX + (size_t)(b * SEQ + s0 + p) * D + AW + 4 * lane) = o; } }
}
}
namespace moe {
#define MOE_SYNC() do { asm volatile("s_waitcnt vmcnt(0) lgkmcnt(0)" ::: "memory"); __builtin_amdgcn_s_barrier(); asm volatile("" ::: "memory"); } while (0)
__device__ __forceinline__ void split_hi_lo(const f32x4& a, const f32x4& b, bf16x8& hi, bf16x8& lo) {
    u32x4 h, l; float r[8];
    h.x = cvt_pk_bf16(a[0], a[1]); h.y = cvt_pk_bf16(a[2], a[3]); h.z = cvt_pk_bf16(b[0], b[1]); h.w = cvt_pk_bf16(b[2], b[3]);
    r[0] = a[0] - bflo(h.x); r[1] = a[1] - bfhi(h.x); r[2] = a[2] - bflo(h.y); r[3] = a[3] - bfhi(h.y);
    r[4] = b[0] - bflo(h.z); r[5] = b[1] - bfhi(h.z); r[6] = b[2] - bflo(h.w); r[7] = b[3] - bfhi(h.w);
    l.x = cvt_pk_bf16(r[0], r[1]); l.y = cvt_pk_bf16(r[2], r[3]); l.z = cvt_pk_bf16(r[4], r[5]); l.w = cvt_pk_bf16(r[6], r[7]);
    hi = __builtin_bit_cast(bf16x8, h); lo = __builtin_bit_cast(bf16x8, l);
}
__device__ __forceinline__ void route_chunk(LAS unsigned char* lds, const bf16_t* x2, const float* ssq2, const bf16_t* WRF, const float* b_router, const float* b_group,
                                            int* tok_e, float* tok_gate, float* tok_rs, int* hist, int chunk, int tid, int wave, int lane) {
    LAS unsigned char* WB = lds;
    LAS float* LG = (LAS float*)(lds + 49152);
    LAS int* HS = (LAS int*)(lds + 49152 + 36864);
    const int tk = lane & 15, g = lane >> 4;
    f32x4 acc[2][3];
#pragma unroll
    for (int gi = 0; gi < 2; ++gi)
#pragma unroll
        for (int nt = 0; nt < 3; ++nt) acc[gi][nt] = (f32x4){0.f, 0.f, 0.f, 0.f};
    if (tid < 32) HS[tid] = 0;
    const bf16_t* xb = x2 + (size_t)(chunk * 256 + wave * 32 + tk) * D + 8 * g;
#pragma nounroll
    for (int kc = 0; kc < 4; ++kc) {
        MOE_SYNC();
#pragma unroll
        for (int i = 0; i < 6; ++i) { const int p = tid + 512 * i; *(LAS u32x4*)(WB + p * 16) = *(const u32x4*)((const char*)WRF + (size_t)kc * 49152 + p * 16); }
        MOE_SYNC();
#pragma unroll
        for (int gi = 0; gi < 2; ++gi) {
            bf16x8 xa[8];
#pragma unroll
            for (int s = 0; s < 8; ++s) xa[s] = *(const bf16x8*)(xb + (size_t)gi * 16 * D + kc * 256 + s * 32);
#pragma unroll
            for (int s = 0; s < 8; ++s) {
#pragma unroll
                for (int nt = 0; nt < 3; ++nt) { const LAS unsigned char* bp = WB + ((s * 3 + nt) * 2) * 1024 + lane * 16;
                    const bf16x8 bh = *(const LAS bf16x8*)bp, bl = *(const LAS bf16x8*)(bp + 1024);
                    acc[gi][nt] = __builtin_amdgcn_mfma_f32_16x16x32_bf16(xa[s], bh, acc[gi][nt], 0, 0, 0);
                    acc[gi][nt] = __builtin_amdgcn_mfma_f32_16x16x32_bf16(xa[s], bl, acc[gi][nt], 0, 0, 0); } }
        }
    }
#pragma unroll
    for (int gi = 0; gi < 2; ++gi)
#pragma unroll
        for (int nt = 0; nt < 3; ++nt) { const int o = 16 * nt + tk;
            if (o < 36) {
#pragma unroll
                for (int r = 0; r < 4; ++r) LG[(wave * 32 + gi * 16 + 4 * g + r) * 36 + o] = acc[gi][nt][r]; } }
    MOE_SYNC();
    if (wave < 4) { const int tr = wave * 64 + lane, tg = chunk * 256 + tr; const LAS float* lg = LG + tr * 36;
        const f32x4* sp = (const f32x4*)(ssq2 + (size_t)tg * 16); const f32x4 st = (sp[0] + sp[1]) + (sp[2] + sp[3]);
        const float rs = 1.0f / sqrtf(((st[0] + st[1]) + (st[2] + st[3])) * (1.f / D) + NORM_EPS);
        tok_rs[tg] = rs;
        float gl[4];
#pragma unroll
        for (int j = 0; j < 4; ++j) gl[j] = lg[32 + j] * rs + b_group[j];
        float gm = gl[0]; int gi = 0;
#pragma unroll
        for (int j = 1; j < 4; ++j) { if (gl[j] > gm) { gm = gl[j]; gi = j; } }
        float den = 0.f;
#pragma unroll
        for (int j = 0; j < 4; ++j) den += __expf(gl[j] - gm);
        const float gp = 1.0f / den;
        float v0 = -3.0e38f, v1 = -3.0e38f; int i0 = 0, i1 = 0;
#pragma unroll
        for (int j = 0; j < 8; ++j) { const float v = lg[gi * 8 + j] * rs + b_router[gi * 8 + j];
            if (v > v0) { v1 = v0; i1 = i0; v0 = v; i0 = j; } else if (v > v1) { v1 = v; i1 = j; } }
        const float dd = __expf(v1 - v0), g0 = gp / (1.f + dd), g1 = gp * dd / (1.f + dd);
        const int e0 = gi * 8 + i0, e1 = gi * 8 + i1;
        __hip_atomic_fetch_add(HS + e0, 1, __ATOMIC_RELAXED, __HIP_MEMORY_SCOPE_WORKGROUP); __hip_atomic_fetch_add(HS + e1, 1, __ATOMIC_RELAXED, __HIP_MEMORY_SCOPE_WORKGROUP);
        tok_e[tg] = e0 | (e1 << 8); tok_gate[2 * tg] = g0; tok_gate[2 * tg + 1] = g1; }
    MOE_SYNC();
    if (tid < 32) hist[chunk * 32 + tid] = HS[tid];
}
__device__ __forceinline__ void slot_chunk(LAS unsigned char* lds, const int* hist, const int* tok_e, const float* tok_gate, const float* tok_rs, int* tok_slot, int* row_tok, float* slot_rs, float* slot_gate, int* etile,
                                           int chunk, int tid, int wave, int lane) {
    LAS int* CNT = (LAS int*)lds; LAS int* BASE = CNT + 32; LAS int* PST = CNT + 64; LAS int* WC = CNT + 128;
    MOE_SYNC();
    if (tid < 32) { int tot = 0, bs = 0; for (int cc = 0; cc < 256; ++cc) { const int hh = hist[cc * 32 + tid]; bs += (cc < chunk) ? hh : 0; tot += hh; } CNT[tid] = tot; BASE[tid] = bs; }
    MOE_SYNC();
    if (tid == 0) { int ps = 0; for (int e = 0; e < 32; ++e) { PST[e] = ps; ps += ((CNT[e] + 255) >> 8) << 8; } PST[32] = ps; }
    MOE_SYNC();
    int ek[2] = {0, 0}, rank[2] = {0, 0}; const int t = chunk * 256 + (wave & 3) * 64 + lane;
    if (wave < 4) { const int ev = tok_e[t]; ek[0] = ev & 255; ek[1] = ev >> 8;
#pragma unroll
        for (int k = 0; k < 2; ++k)
#pragma nounroll
            for (int e = 0; e < 32; ++e) { const unsigned long long m = __ballot(ek[k] == e);
                if (ek[k] == e) rank[k] = __popcll(m & ((1ull << lane) - 1ull));
                if (lane == 0) WC[(k * 4 + wave) * 32 + e] = __popcll(m); } }
    MOE_SYNC();
    if (wave < 4) {
#pragma unroll
        for (int k = 0; k < 2; ++k) { int off = 0;
            for (int kw = 0; kw < k * 4 + wave; ++kw) off += WC[kw * 32 + ek[k]];
            const int slot = PST[ek[k]] + BASE[ek[k]] + off + rank[k];
            row_tok[slot] = t; slot_rs[slot] = tok_rs[t]; slot_gate[slot] = tok_gate[2 * t + k]; tok_slot[2 * t + k] = slot; } }
    if (chunk < 32) { const int e = chunk, c0 = PST[e] + CNT[e], n = PST[e + 1] - c0;
        for (int i = tid; i < n; i += NWAVES * 64) { row_tok[c0 + i] = 0; slot_rs[c0 + i] = 0.f; slot_gate[c0 + i] = 0.f; } }
    if (chunk == 0 && tid <= 32) etile[tid] = PST[tid] >> 8;
}
__device__ __forceinline__ void final_row(float* xo, const bf16_t* X2, const bf16_t* Y, const int* tok_slot, const float* g, int t, int lane) {
    const int s0 = tok_slot[2 * t], s1 = tok_slot[2 * t + 1];
    f32x4* xr = (f32x4*)(xo + (size_t)t * D) + lane; const u32x2* x2 = (const u32x2*)(X2 + (size_t)t * D) + lane;
    const u32x2* y0 = (const u32x2*)(Y + (size_t)s0 * D) + lane; const u32x2* y1 = (const u32x2*)(Y + (size_t)s1 * D) + lane;
    const f32x4* gr = (const f32x4*)g + lane;
    f32x4 v[4]; float s = 0.f;
#pragma unroll
    for (int j = 0; j < 4; ++j) { const u32x2 x = x2[64 * j], a = y0[64 * j], b = y1[64 * j];
        v[j][0] = bflo(x.x) + (bflo(a.x) + bflo(b.x)); v[j][1] = bfhi(x.x) + (bfhi(a.x) + bfhi(b.x)); v[j][2] = bflo(x.y) + (bflo(a.y) + bflo(b.y)); v[j][3] = bfhi(x.y) + (bfhi(a.y) + bfhi(b.y));
        s += (v[j][0] * v[j][0] + v[j][1] * v[j][1]) + (v[j][2] * v[j][2] + v[j][3] * v[j][3]); }
    const float rs = 1.0f / sqrtf(wave_sum(s) * (1.f / D) + NORM_EPS);
#pragma unroll
    for (int j = 0; j < 4; ++j) xr[64 * j] = v[j] * rs * gr[64 * j];
}
}
#ifndef MK_N_LAUNCHES
#define MK_N_LAUNCHES 1
#endif
constexpr int NPH = 11;
constexpr int N_LAUNCHES = MK_N_LAUNCHES;

#define ARG_IN(k) karg_ptr(8 * (k))
#define ARG_OUT ((float*)karg_ptr(8 * 27))
#define ARG_WS ((unsigned char*)karg_ptr(8 * 28))
template <int LO, int HI>
__global__ void __launch_bounds__(NWAVES * 64, 2) mega_fwd(Args args) {
    extern __shared__ __attribute__((aligned(16))) unsigned char lds_raw[];
    Frame F;
    F.lds = (LAS unsigned char*)lds_raw;
    F.MISC = (volatile LAS unsigned*)(F.lds + LDSCTL_OFF);
    F.wave = __builtin_amdgcn_readfirstlane((int)threadIdx.x >> 6);
    F.G = gridDim.x; { const int bx = blockIdx.x; F.vcu = (F.G % 8 == 0) ? (bx % 8) * (F.G / 8) + bx / 8 : bx; }
    F.ws = ARG_WS; F.ctl = (unsigned*)(ARG_WS + WS_CTL);
    for (int u = threadIdx.x; u < (LDS_BYTES - LDSCTL_OFF) / 4; u += NWAVES * 64) ((LAS unsigned*)(F.lds + LDSCTL_OFF))[u] = 0u;
    __syncthreads();
    XcdBarrier bar; bar.bar = F.ctl + CW_BAR; bar.x = 0; bar.st = nullptr;
    if (HI - LO > 1) bar = xcd_barrier_post(F.ctl + CW_BAR, F.MISC + 8);
#define GRID_BAR() do { if (HI - LO > 1) xcd_barrier(bar); } while (0)
#ifndef PH_MASK
#define PH_MASK 0x7ff
#endif
#define IN(k) ((((PH_MASK) >> (k)) & 1) && LO <= (k) && (k) < HI)
#define BOTH(k) (IN(k) && IN((k) + 1))
#ifndef DUP_PHASE
#define DUP_PHASE -1
#endif
#define DUPF(k) ((k) == DUP_PHASE ? 2 : 1)
    const int gw = F.vcu * NWAVES + F.wave, NGW = F.G * NWAVES;
#define R1 ((bf16_t*)(ARG_WS + WS_R1))
#define R2 ((bf16_t*)(ARG_WS + WS_R2))
#define ssqa ((float*)(ARG_WS + WS_SSQA))
#define ssq1 ((float*)(ARG_WS + WS_SSQ1))
#define ssq2 ((float*)(ARG_WS + WS_SSQ2))
#define tok_e ((int*)(ARG_WS + WS_TOK + TK_E))
#define tok_gate ((float*)(ARG_WS + WS_TOK + TK_GATE))
#define tok_slot ((int*)(ARG_WS + WS_TOK + TK_SLOT))
#define tok_rs ((float*)(ARG_WS + WS_TOK + TK_RS))
#define row_tok ((int*)(ARG_WS + WS_TOK + TK_ROWTOK))
#define slot_rs ((float*)(ARG_WS + WS_TOK + TK_SLOTRS))
#define slot_gate ((float*)(ARG_WS + WS_TOK + TK_SLOTGATE))
#define hist ((int*)(ARG_WS + WS_HIST))
#define etile ((int*)(ARG_WS + WS_HIST + HIST_ETILE))
#define WR ((const bf16_t*)(ARG_WS + WS_HIST + HIST_WR))

    if (IN(0)) { p0_prologue(F); if (DUPF(0) == 2) { asm volatile("s_waitcnt vmcnt(0)" ::: "memory"); __syncthreads(); p0_prologue(F); } if (BOTH(0)) GRID_BAR(); }

    if (IN(1)) {
        { pg8::GridOrder S; S.init(R1, ARG_WS + WS_WIN, D, D, T, INW, F.G, (int)blockIdx.x); S.dup = DUPF(1);
          pg8::EpiU E{R2, (bf16_t*)(ARG_WS + WS_Q), (bf16_t*)(ARG_WS + WS_K), (bf16_t*)(ARG_WS + WS_V), (const float*)(ARG_WS + WS_ROPE), (const float*)(ARG_WS + WS_ROPE) + SEQ * 32};
          pg8::gemm_phase<pg8::EpiU, pg8::GridOrder, false, false>(F.lds, F.wave, D, D, D, S, E); }
        { pg8::KvOrder S{(const char*)(ARG_WS + WS_MEMN), (const char*)(ARG_WS + WS_WXK), (const char*)(ARG_WS + WS_WXV), F.G, (int)blockIdx.x};
          pg8::EpiPlain<false> E{(bf16_t*)(ARG_WS + WS_KX), D, (bf16_t*)(ARG_WS + WS_VX), D, nullptr};
          pg8::gemm_phase<pg8::EpiPlain<false>, pg8::KvOrder, true, false>(F.lds, F.wave, D, D, D, S, E); }
        if (BOTH(1)) GRID_BAR();
    }

    if (IN(2)) {
        { pg8::MnOrder S{(const char*)(ARG_WS + WS_KX), (const char*)(ARG_WS + WS_WXQ), (const char*)(ARG_WS + WS_WXO), (const char*)(ARG_WS + WS_VX), F.G, F.vcu, 1};
          pg8::EpiPlain<false> E{(bf16_t*)(ARG_WS + WS_MT), D, (bf16_t*)(ARG_WS + WS_NT), D, nullptr};
          pg8::gemm_phase<pg8::EpiPlain<false>, pg8::MnOrder, true, false>(F.lds, F.wave, D, D, XHD, S, E); }
        for (int L0 = F.vcu; L0 < NB * NH * 8 * DUPF(2); L0 += F.G) { const int L = L0 % (NB * NH * 8); const int chunk = L & 7, bh = L >> 3, b = bh / NH, h = bh % NH;
            att::attn_unit(F.lds, (const bf16_t*)(ARG_WS + WS_Q), (const bf16_t*)(ARG_WS + WS_K), (const bf16_t*)(ARG_WS + WS_V), R1, ssqa, b, h, chunk * 512, F.wave * 64 + lane_id(), F.wave, lane_id()); }
        for (int L = F.vcu; L < NB * 64; L += F.G) { const int b = L >> 6, j = L & 63;
            att::conv_unit(F.lds, R2, R1, (const float*)ARG_IN(5), (const float*)ARG_IN(6), (const float*)ARG_IN(7), (const float*)ARG_IN(8), (const float*)ARG_IN(9), b, j * 64, F.wave * 64 + lane_id(), F.wave, lane_id()); }
        asm volatile("s_waitcnt vmcnt(0) lgkmcnt(0)" ::: "memory"); __syncthreads();
        if (BOTH(2)) GRID_BAR();
    }

    if (IN(3)) {
        pg8::GridOrder S; S.init(R1, ARG_WS + WS_WOUT, D, D, T, D, F.G, (int)blockIdx.x); S.dup = DUPF(3);
        pg8::EpiResid<true> E{(const float*)ARG_IN(0), R2, ssq1, ssqa};
        pg8::gemm_phase<pg8::EpiResid<true>, pg8::GridOrder, true, false>(F.lds, F.wave, D, D, D, S, E);
        if (BOTH(3)) GRID_BAR();
    }

    if (IN(4)) {
        pg8::BatchOrder S{(const char*)R2, (const char*)(ARG_WS + WS_MT), (T / 256) * 4, F.G, (int)blockIdx.x, DUPF(4)};
        pg8::EpiSoftmax E{(bf16_t*)(ARG_WS + WS_PM), ssq1};
        pg8::gemm_phase<pg8::EpiSoftmax, pg8::BatchOrder, true, false>(F.lds, F.wave, D, D, D, S, E);
        if (BOTH(4)) GRID_BAR();
    }

    if (IN(5)) {
        pg8::BatchOrder S{(const char*)(ARG_WS + WS_PM), (const char*)(ARG_WS + WS_NT), (T / 256) * 4, F.G, (int)blockIdx.x, 1};
        pg8::EpiResid<false> E{nullptr, R2, ssq2, nullptr};
        pg8::gemm_phase<pg8::EpiResid<false>, pg8::BatchOrder, true, false>(F.lds, F.wave, D, D, D, S, E);
        if (BOTH(5)) GRID_BAR();
    }

    if (IN(6)) {
        for (int c0_ = blockIdx.x; c0_ < (T / 256) * DUPF(6); c0_ += F.G) { const int c = c0_ % (T / 256);
            moe::route_chunk(F.lds, R2, ssq2, WR, (const float*)ARG_IN(22), (const float*)ARG_IN(20), tok_e, tok_gate, tok_rs, hist, c, F.wave * 64 + lane_id(), F.wave, lane_id()); }
        asm volatile("s_waitcnt vmcnt(0) lgkmcnt(0)" ::: "memory"); __syncthreads();
        if (BOTH(6)) GRID_BAR();
    }

    if (IN(7)) {
        for (int c1_ = blockIdx.x; c1_ < (T / 256) * DUPF(7); c1_ += F.G) { const int c = c1_ % (T / 256);
            moe::slot_chunk(F.lds, hist, tok_e, tok_gate, tok_rs, tok_slot, row_tok, slot_rs, slot_gate, etile, c, F.wave * 64 + lane_id(), F.wave, lane_id()); }
        asm volatile("s_waitcnt vmcnt(0) lgkmcnt(0)" ::: "memory"); __syncthreads();
        if (BOTH(7)) GRID_BAR();
    }

    if (IN(8)) {
        pg8::MoeOrder<0> S{(const char*)R2, (const char*)(ARG_WS + WS_W13), row_tok, etile, F.G, (int)blockIdx.x, DUPF(8)};
        pg8::EpiMoe1 E{(bf16_t*)(ARG_WS + WS_HID), slot_rs};
        pg8::gemm_phase<pg8::EpiMoe1, pg8::MoeOrder<0>, true, true>(F.lds, F.wave, D, D, D, S, E);
        if (BOTH(8)) GRID_BAR();
    }

    if (IN(9)) {
        pg8::MoeOrder<1> S{(const char*)(ARG_WS + WS_HID), (const char*)(ARG_WS + WS_W2), row_tok, etile, F.G, (int)blockIdx.x, DUPF(9)};
        pg8::EpiMoe2 E{(bf16_t*)(ARG_WS + WS_Y), slot_gate};
        pg8::gemm_phase<pg8::EpiMoe2, pg8::MoeOrder<1>, true, false>(F.lds, F.wave, FF, FF, FF, S, E);
        if (BOTH(9)) GRID_BAR();
    }

    if (IN(10)) {
        for (int t0_ = gw; t0_ < T * DUPF(10); t0_ += NGW) { const int t = t0_ % T; moe::final_row(ARG_OUT, R2, (const bf16_t*)(ARG_WS + WS_Y), tok_slot, (const float*)ARG_IN(26), t, lane_id()); }
    }
#undef IN
#undef BOTH
}

typedef void (*kern_t)(Args);
template <int... I> struct PhList {};
extern "C" void kernel_launch(void* const* d_in, const int* in_sizes, int n_in, void* d_out, int out_size, void* d_ws, size_t ws_size, hipStream_t stream) {
    static int grid = 0;
#if MK_N_LAUNCHES == 1
    static const kern_t kerns[1] = {mega_fwd<0, NPH>};
#else
    static const kern_t kerns[NPH] = {mega_fwd<0, 1>, mega_fwd<1, 2>, mega_fwd<2, 3>, mega_fwd<3, 4>, mega_fwd<4, 5>, mega_fwd<5, 6>, mega_fwd<6, 7>, mega_fwd<7, 8>, mega_fwd<8, 9>, mega_fwd<9, 10>, mega_fwd<10, 11>};
#endif
    if (grid == 0) {
        if (n_in != 27 || in_sizes[0] != T * D || out_size != T * D || ws_size < WS_END) { fprintf(stderr, "kernel_launch: unexpected problem: n_in %d in0 %d out %d ARG_WS %zu (need %zu)\n", n_in, n_in > 0 ? in_sizes[0] : -1, out_size, ws_size, (size_t)WS_END); grid = -1; return; }
        int dev = 0, cus = 0, per_cu = 0;
        if (hipGetDevice(&dev) != hipSuccess || hipDeviceGetAttribute(&cus, hipDeviceAttributeMultiprocessorCount, dev) != hipSuccess) { grid = -1; return; }
        for (int li = 0; li < N_LAUNCHES; ++li)
            if (hipFuncSetAttribute((const void*)kerns[li], hipFuncAttributeMaxDynamicSharedMemorySize, LDS_BYTES) != hipSuccess) { fprintf(stderr, "kernel_launch: hipFuncSetAttribute failed\n"); grid = -1; return; }
        if (hipOccupancyMaxActiveBlocksPerMultiprocessor(&per_cu, (const void*)kerns[0], NWAVES * 64, LDS_BYTES) != hipSuccess || per_cu < 1) { fprintf(stderr, "kernel_launch: occupancy query says %d\n", per_cu); }
        (void)hipGetLastError();
        grid = cus;
    }
    if (grid < 0) return;
    if (hipMemsetAsync((char*)d_ws + WS_CTL, 0, CTL_ZERO_BYTES, stream) != hipSuccess) return;
    Args a{};
    for (int i = 0; i < 27; ++i) a.in[i] = d_in[i];
    a.out = (float*)d_out; a.ws = (unsigned char*)d_ws;
    for (int li = 0; li < N_LAUNCHES; ++li) {
        a.ph_lo = 0; a.ph_hi = 0; a.li = li; a.pad = 0;
        hipLaunchKernelGGL(kerns[li], dim3(grid), dim3(NWAVES * 64), LDS_BYTES, stream, a);
        const hipError_t le = hipPeekAtLastError();
        if (le != hipSuccess) { fprintf(stderr, "kernel_launch: launch %d failed: %s\n", li, hipGetErrorName(le)); break; }
    }
}
```

```cpp
#include <hip/hip_runtime.h>
#include <cstdio>
#include <cstdint>

#define GAS __attribute__((address_space(1)))
#define LAS __attribute__((address_space(3)))
typedef unsigned short bf16_t;
typedef short bf16x8 __attribute__((ext_vector_type(8)));
typedef short s16x4 __attribute__((ext_vector_type(4)));
typedef float f32x4 __attribute__((ext_vector_type(4)));
typedef float f32x2 __attribute__((ext_vector_type(2)));
typedef unsigned u32x4 __attribute__((ext_vector_type(4)));
typedef unsigned u32x2 __attribute__((ext_vector_type(2)));

constexpr int NB = 16, SEQ = 4096, T = NB * SEQ, D = 1024;
constexpr int CCH = 256, NH = 12, HD = 64, AW = NH * HD, INW = 2 * CCH + 3 * AW;
constexpr int MEML = 256, MROWS = NB * MEML, XH = 4, XHD = 256;
constexpr int NE = 32, EPG = 8, NG = 4, FF = 512;
constexpr int CONVK = 31;
constexpr int A_PAD = T * 2 + NE * 256;
constexpr float NORM_EPS = 1e-6f, LN_EPS = 1e-5f;
constexpr float LOG2E = 1.4426950408889634f;

constexpr size_t MiB = 1u << 20;
constexpr size_t WS_CTL = 0, CTL_ZERO_BYTES = 1 * MiB;
constexpr size_t WS_ROPE = 1 * MiB;
constexpr size_t WS_HIST = 2 * MiB;
constexpr size_t WS_SSQA = 4 * MiB;
constexpr size_t WS_SSQ1 = 8 * MiB;
constexpr size_t WS_SSQ2 = 12 * MiB;
constexpr size_t WS_WIN = 16 * MiB, WS_WOUT = 22 * MiB, WS_WXQ = 24 * MiB, WS_WXK = 26 * MiB, WS_WXV = 28 * MiB, WS_WXO = 30 * MiB;
constexpr size_t WS_W13 = 32 * MiB, WS_W2 = 96 * MiB;
constexpr size_t WS_MEMN = 128 * MiB, WS_KX = 136 * MiB, WS_VX = 144 * MiB;
constexpr size_t WS_TOK = 152 * MiB;
constexpr size_t WS_R1 = 160 * MiB;
constexpr size_t WS_R2 = 288 * MiB;
constexpr size_t WS_Q = 320 * MiB, WS_K = 416 * MiB, WS_V = 512 * MiB;
constexpr size_t WS_MT = 672 * MiB, WS_NT = 704 * MiB;
constexpr size_t WS_PM = 544 * MiB;
constexpr size_t WS_HID = 416 * MiB;
constexpr size_t WS_Y = 552 * MiB;
constexpr size_t WS_END = 824 * MiB;
constexpr size_t TK_E = 0;
constexpr size_t TK_GATE = 1 * MiB;
constexpr size_t TK_SLOT = 2 * MiB;
constexpr size_t TK_RS = 3 * MiB;
constexpr size_t TK_ROWTOK = 4 * MiB;
constexpr size_t TK_SLOTRS = 5 * MiB;
constexpr size_t TK_SLOTGATE = 6 * MiB;
constexpr size_t HIST_ETILE = 64 * 1024, HIST_WR = 128 * 1024;

constexpr int CW_BAR = 4096;

constexpr int NWAVES = 8;
constexpr int RING_BYTES = 131072;
constexpr int XCH_OFF = RING_BYTES;
constexpr int LDSCTL_OFF = RING_BYTES + 12288;
constexpr int LDS_BYTES = 147456;

#define LDS_WAIT() asm volatile("s_waitcnt lgkmcnt(0)" ::: "memory")
#define VM_WAIT() asm volatile("s_waitcnt vmcnt(0)" ::: "memory")
__device__ __forceinline__ unsigned f2bf(float f) { unsigned u = __builtin_bit_cast(unsigned, f); return (u + 0x7fffu + ((u >> 16) & 1u)) >> 16; }
__device__ __forceinline__ unsigned pk2(float lo, float hi) { return f2bf(lo) | (f2bf(hi) << 16); }
__device__ __forceinline__ float bf2f(unsigned short b) { return __builtin_bit_cast(float, (unsigned)b << 16); }
__device__ __forceinline__ float bflo(unsigned w) { return __builtin_bit_cast(float, w << 16); }
__device__ __forceinline__ float bfhi(unsigned w) { return __builtin_bit_cast(float, w & 0xffff0000u); }
__device__ __forceinline__ unsigned cvt_pk_bf16(float lo, float hi) { unsigned r; asm volatile("v_cvt_pk_bf16_f32 %0, %1, %2" : "=v"(r) : "v"(lo), "v"(hi)); return r; }
__device__ __forceinline__ float wave_sum(float v) {
#pragma unroll
    for (int o = 1; o < 64; o <<= 1) v += __shfl_xor(v, o);
    return v;
}
__device__ __forceinline__ int lane_id() { return (int)__builtin_amdgcn_mbcnt_hi(~0u, __builtin_amdgcn_mbcnt_lo(~0u, 0u)); }
#define MK_N_LAUNCHES 1
namespace pg8 {
constexpr int BM = 256, BK = 64, HALF = 128, HTB = HALF * BK * 2  , STAGE_BYTES = 8 * HTB, NXCD = 8, WGM = 8;

__host__ __device__ __forceinline__ int lds_byte(int r, int c) { const int st = (r >> 4) * 2 + (c >> 5), rr = r & 15, cc = c & 31, ob = rr * 64 + cc * 2; return st * 1024 + (ob ^ (((ob >> 9) & 1) << 5)); }
__host__ __device__ __forceinline__ void stage_rc(int b, int& R, int& C) { const int st = b / 1024, sb = b % 1024, swz = sb ^ (((sb >> 9) & 1) << 5); R = (st >> 1) * 16 + swz / 64; C = (st & 1) * 32 + (swz % 64) / 2; }
__host__ __device__ __forceinline__ int perm32(int rho) { const int n = rho >> 4, i = rho & 15; return 8 * (i >> 2) + 4 * n + (i & 3); }

struct Unit { const char* a; const char* b; const int* rows; int pm, pn, x0, x1; };

typedef f32x4 Acc[2][2][4][2];

__device__ __forceinline__ const char* uniform_ptr(const char* p) { const unsigned long long v = (unsigned long long)p;
    const unsigned lo = __builtin_amdgcn_readfirstlane((unsigned)v), hi = __builtin_amdgcn_readfirstlane((unsigned)(v >> 32)); return (const char*)(((unsigned long long)hi << 32) | lo); }
__device__ __forceinline__ void glds16_sv(const char* gbase, unsigned voff, unsigned lds_dst) { unsigned keep;
    asm volatile("s_mov_b32 %0, m0\n\ts_mov_b32 m0, %3\n\ts_nop 0\n\tglobal_load_lds_dwordx4 %1, %2\n\ts_mov_b32 m0, %0" : "=&s"(keep) : "v"(voff), "s"(gbase), "s"(lds_dst) : "memory"); }
template <class Epi, class Sched, bool ALIGN_EPI, bool GATHER>
__device__ __forceinline__ void gemm_phase(LAS unsigned char* lds, const int wave_, const int lda, const int ldb, const int K, const Sched& S, const Epi& E) {
    int lane_ = lane_id(); asm volatile("" : "+v"(lane_));
    const int wid = __builtin_amdgcn_readfirstlane(wave_), tid = wid * 64 + lane_, lane = tid & 63, wr = wid >> 2, wc = wid & 3, fr = lane & 15, fq = lane >> 4;
    const int nt = K / BK;
    int Rr[2], Cc[2];
    unsigned vA[2][2], vN[2][2], voffB[2];
#pragma unroll
    for (int i = 0; i < 2; ++i) { int R, C; stage_rc(tid * 16 + i * 8192, R, C); Rr[i] = R; Cc[i] = C; const int Rb = Epi::PERM ? ((R & ~31) + perm32(R & 31)) : R;
        voffB[i] = (unsigned)(Rb * ldb + C) * 2u; }
    const size_t kstep = (size_t)(BK * 2);
    const size_t hstepB = (size_t)HALF * ldb * 2, hstepA = (size_t)HALF * lda * 2;
    const unsigned ldsw = (unsigned)wid * 1024u, lds0 = (unsigned)(uintptr_t)lds;
    const int aoff = lds_byte(wr * 64 + fr, fq * 8), boff = lds_byte(wc * 32 + fr, fq * 8);
#define PG8_SA(b, h) (((b) * 2 + (h)) * HTB)
#define PG8_SB(b, h) ((4 + (b) * 2 + (h)) * HTB)
#define PG8_STAGE(bufoff, gbase, voff) do { _Pragma("unroll") for (int _i = 0; _i < 2; ++_i) glds16_sv((gbase), (voff)[_i], lds0 + (unsigned)(bufoff) + ldsw + _i * 8192u); } while (0)
#define PG8_LDA(dst, b, h) do { _Pragma("unroll") for (int m = 0; m < 4; ++m) _Pragma("unroll") for (int k = 0; k < 2; ++k) dst[m][k] = *(const LAS bf16x8*)(lds + PG8_SA(b, h) + aoff + m * 2048 + k * 1024); } while (0)
#define PG8_LDB(dst, b, h) do { _Pragma("unroll") for (int n = 0; n < 2; ++n) _Pragma("unroll") for (int k = 0; k < 2; ++k) dst[n][k] = *(const LAS bf16x8*)(lds + PG8_SB(b, h) + boff + n * 2048 + k * 1024); } while (0)
#define PG8_MMA(ai, bj, At, Bt) do { __builtin_amdgcn_s_setprio(1); _Pragma("unroll") for (int m = 0; m < 4; ++m) _Pragma("unroll") for (int n = 0; n < 2; ++n) _Pragma("unroll") for (int k = 0; k < 2; ++k) \
        acc[ai][bj][m][n] = __builtin_amdgcn_mfma_f32_16x16x32_bf16(Bt[n][k], At[m][k], acc[ai][bj][m][n], 0, 0, 0); __builtin_amdgcn_s_setprio(0); } while (0)
#define PG8_WAIT_V(n) asm volatile("s_waitcnt vmcnt(" #n ")" ::: "memory")
#define PG8_WAIT_L(n) asm volatile("s_waitcnt lgkmcnt(" #n ")" ::: "memory")
#define PG8_BAR __builtin_amdgcn_s_barrier()
#define PG8_SCHED __builtin_amdgcn_sched_barrier(0)
#define PG8_VOFF(dst, u) do { _Pragma("unroll") for (int _h = 0; _h < 2; ++_h) _Pragma("unroll") for (int _i = 0; _i < 2; ++_i) { \
        if constexpr (GATHER) dst[_h][_i] = (unsigned)(u).rows[_h * HALF + Rr[_i]] * (unsigned)(lda * 2) + (unsigned)(Cc[_i] * 2); \
        else dst[_h][_i] = (unsigned)(Rr[_i] * lda + Cc[_i]) * 2u; } } while (0)
#define PG8_STAGE_A(bufoff, gbase, h, vv) do { if constexpr (GATHER) { PG8_STAGE(bufoff, gbase, vv[h]); } else { PG8_STAGE(bufoff, (gbase) + (h) * hstepA, vv[0]); } } while (0)
    Unit cur, nxt; int ui = 0;
    if (!S.next(0, cur)) return;
    Acc acc;
#pragma unroll
    for (int a = 0; a < 2; ++a)
#pragma unroll
        for (int b = 0; b < 2; ++b)
#pragma unroll
            for (int m = 0; m < 4; ++m)
#pragma unroll
                for (int n = 0; n < 2; ++n) acc[a][b][m][n] = (f32x4){0.f, 0.f, 0.f, 0.f};
    bf16x8 At[4][2], B0[2][2], B1[2][2];
    const char* cA = uniform_ptr(cur.a); const char* cB = uniform_ptr(cur.b);
    PG8_VOFF(vA, cur);
    if constexpr (GATHER) { asm volatile("s_waitcnt vmcnt(0)" ::: "memory"); }
    PG8_STAGE(PG8_SB(0, 0), cB, voffB); PG8_STAGE(PG8_SB(0, 1), cB + hstepB, voffB); PG8_STAGE_A(PG8_SA(0, 0), cA, 0, vA); PG8_STAGE_A(PG8_SA(0, 1), cA, 1, vA);
    if (wr == 1) PG8_BAR;
    PG8_WAIT_V(2); PG8_BAR;
    PG8_STAGE(PG8_SB(1, 0), cB + kstep, voffB); PG8_STAGE_A(PG8_SA(1, 0), cA + kstep, 0, vA); PG8_STAGE(PG8_SB(1, 1), cB + hstepB + kstep, voffB);
    PG8_WAIT_V(6); PG8_BAR;
    for (;;) {
        const bool has_next = S.next(ui + 1, nxt);
        const char* nA = has_next ? uniform_ptr(nxt.a) : cA; const char* nB = has_next ? uniform_ptr(nxt.b) : cB;
        if constexpr (GATHER) { if (has_next) { PG8_VOFF(vN, nxt); } else {
#pragma unroll
            for (int h = 0; h < 2; ++h) { vN[h][0] = vA[h][0]; vN[h][1] = vA[h][1]; } } }
#pragma nounroll
        for (int t = 0; t < nt; t += 2) {
            const bool last = (t == nt - 2);
            if constexpr (Epi::HAS_MID) { if (t == E.mid_t()) E.mid(acc, cur, wr, wc, fr, fq); }
            const char* a1 = cA + (size_t)(t + 1) * kstep;
            const char* a2 = last ? nA : cA + (size_t)(t + 2) * kstep; const char* b2 = last ? nB : cB + (size_t)(t + 2) * kstep;
            const char* a3 = a2 + kstep; const char* b3 = b2 + kstep;
            unsigned vW[2][2];
#pragma unroll
            for (int h = 0; h < 2; ++h) { vW[h][0] = vA[h][0]; vW[h][1] = vA[h][1]; if constexpr (GATHER) { if (last) { vW[h][0] = vN[h][0]; vW[h][1] = vN[h][1]; } } }
            PG8_LDB(B0, 0, 0); PG8_LDB(B1, 0, 1); PG8_SCHED; PG8_LDA(At, 0, 0); PG8_STAGE_A(PG8_SA(1, 1), a1, 1, vA);
            PG8_WAIT_V(8); PG8_WAIT_L(0); PG8_BAR; PG8_MMA(0, 0, At, B0); PG8_MMA(0, 1, At, B1); PG8_BAR; PG8_SCHED;
            PG8_LDA(At, 0, 1); PG8_STAGE(PG8_SB(0, 0), b2, voffB); PG8_STAGE(PG8_SB(0, 1), b2 + hstepB, voffB); PG8_STAGE_A(PG8_SA(0, 0), a2, 0, vW);
            PG8_WAIT_V(8); PG8_WAIT_L(0); PG8_BAR; PG8_MMA(1, 0, At, B0); PG8_MMA(1, 1, At, B1); PG8_BAR; PG8_SCHED;
            PG8_LDB(B0, 1, 0); PG8_LDB(B1, 1, 1); PG8_SCHED; PG8_LDA(At, 1, 0); PG8_STAGE_A(PG8_SA(0, 1), a2, 1, vW);
            PG8_WAIT_V(8); PG8_WAIT_L(0); PG8_BAR; PG8_MMA(0, 0, At, B0); PG8_MMA(0, 1, At, B1); PG8_BAR; PG8_SCHED;
            PG8_LDA(At, 1, 1); PG8_STAGE(PG8_SB(1, 0), b3, voffB); PG8_STAGE(PG8_SB(1, 1), b3 + hstepB, voffB); PG8_STAGE_A(PG8_SA(1, 0), a3, 0, vW);
            PG8_WAIT_V(8); PG8_WAIT_L(0); PG8_BAR; PG8_MMA(1, 0, At, B0); PG8_MMA(1, 1, At, B1); PG8_BAR; PG8_SCHED;
        }
        if constexpr (ALIGN_EPI) { if (wr == 0) PG8_BAR; }
        E(acc, cur, wr, wc, fr, fq, lds, wid, lane);
        if (!has_next) break;
#pragma unroll
        for (int a = 0; a < 2; ++a)
#pragma unroll
            for (int b = 0; b < 2; ++b)
#pragma unroll
                for (int m = 0; m < 4; ++m)
#pragma unroll
                    for (int n = 0; n < 2; ++n) acc[a][b][m][n] = (f32x4){0.f, 0.f, 0.f, 0.f};
        cur = nxt; cA = nA; cB = nB; ++ui;
        if constexpr (GATHER) {
#pragma unroll
            for (int h = 0; h < 2; ++h) { vA[h][0] = vN[h][0]; vA[h][1] = vN[h][1]; } }
        if constexpr (ALIGN_EPI) { if (wr == 1) PG8_BAR; }
    }
    PG8_WAIT_V(0);
    if constexpr (!ALIGN_EPI) { if (wr == 0) PG8_BAR; }
    PG8_BAR;
#undef PG8_SA
#undef PG8_SB
#undef PG8_STAGE
#undef PG8_LDA
#undef PG8_LDB
#undef PG8_MMA
#undef PG8_WAIT_V
#undef PG8_WAIT_L
#undef PG8_BAR
#undef PG8_SCHED
#undef PG8_VOFF
#undef PG8_STAGE_A
}
}
#define XB_TMO      128
#define XB_XCNT(j)  (256  + 64 * (j))
#define XB_XSUB(j)  (1280 + 64 * (j))
#define XB_XGEN(j)  (2304 + 64 * (j))
#define XB_TOP      3328
#define XB_TOPGEN   3392
#define XCD_BAR_WORDS 3456
#define XB_SPIN_CAP (1u << 18)

__device__ __forceinline__ unsigned xb_ld(unsigned* p)              { return __hip_atomic_load(p, __ATOMIC_RELAXED, __HIP_MEMORY_SCOPE_AGENT); }
__device__ __forceinline__ unsigned xb_add(unsigned* p, unsigned v) { return __hip_atomic_fetch_add(p, v, __ATOMIC_RELAXED, __HIP_MEMORY_SCOPE_AGENT); }
__device__ __forceinline__ unsigned xb_xcc_id() { return (unsigned)__builtin_amdgcn_s_getreg((3 << 11) | 20) & 0xFu; }
#define XB_SPIN(cond, bar) do { unsigned _sp = 0; while (cond) { __builtin_amdgcn_s_sleep(1); \
    if ((++_sp & 255u) == 0u) { if (xb_ld(&(bar)[XB_TMO])) break; if (_sp > XB_SPIN_CAP) { atomicAdd(&(bar)[XB_TMO], 1u); break; } } } } while (0)

struct XcdBarrier {
    unsigned* bar; unsigned x;
    volatile LAS unsigned* st;
};

__device__ __forceinline__ XcdBarrier xcd_barrier_post(unsigned* bar, volatile LAS unsigned* st) {
    XcdBarrier b; b.bar = bar; b.x = xb_xcc_id(); b.st = st;
    if (threadIdx.x == 0) (void)xb_add(&bar[XB_XCNT(b.x)], 1u);
    return b;
}
__device__ __forceinline__ void xcd_barrier_complete(unsigned* bar, unsigned x, unsigned& nloc, unsigned& nx) {
    const unsigned G = gridDim.x * gridDim.y * gridDim.z;
    unsigned sum, cnt, mine, sp = 0u;
    for (;;) {
        sum = 0u; cnt = 0u; mine = 0u;
#pragma unroll
        for (unsigned j = 0; j < 16; ++j) { const unsigned c = xb_ld(&bar[XB_XCNT(j)]); sum += c; cnt += (c > 0u) ? 1u : 0u; mine = (j == x) ? c : mine; }
        if (sum == G) break;
        __builtin_amdgcn_s_sleep(1);
        if ((++sp & 255u) == 0u) { if (xb_ld(&bar[XB_TMO])) break; if (sp > XB_SPIN_CAP) { atomicAdd(&bar[XB_TMO], 1u); break; } }
    }
    nloc = mine > 0u ? mine : 1u; nx = cnt > 0u ? cnt : 1u;
}

__device__ __forceinline__ void xcd_barrier(const XcdBarrier& b) {
    asm volatile("s_waitcnt vmcnt(0)" ::: "memory");
    __syncthreads();
    if (threadIdx.x == 0) {
        unsigned* bar = b.bar;
        __builtin_amdgcn_s_waitcnt(0);
        unsigned nloc = b.st[0], nx = b.st[1];
        if (nloc == 0u) { xcd_barrier_complete(bar, b.x, nloc, nx); b.st[0] = nloc; b.st[1] = nx; }
        const unsigned old = xb_add(&bar[XB_XSUB(b.x)], 1u);
        const unsigned gen = old / nloc;
        if (old + 1u == (gen + 1u) * nloc) {
            __builtin_amdgcn_fence(__ATOMIC_RELEASE, "agent");
            asm volatile("s_waitcnt vmcnt(0)" ::: "memory");
            const unsigned og = xb_add(&bar[XB_TOP], 1u);
            const unsigned tg = og / nx;
            if (og + 1u == (tg + 1u) * nx) xb_add(&bar[XB_TOPGEN], 1u);
            else XB_SPIN(xb_ld(&bar[XB_TOPGEN]) == tg, bar);
            __builtin_amdgcn_fence(__ATOMIC_ACQUIRE, "agent");
            xb_add(&bar[XB_XGEN(b.x)], 1u);
            asm volatile("s_waitcnt vmcnt(0)" ::: "memory");
        } else {
            XB_SPIN(xb_ld(&bar[XB_XGEN(b.x)]) == gen, bar);
            __builtin_amdgcn_fence(__ATOMIC_ACQUIRE, "agent");
            asm volatile("s_waitcnt vmcnt(0)" ::: "memory");
        }
    }
    __syncthreads();
}

namespace pg8 {
#define EPI_NOMID static constexpr bool HAS_MID = false; __device__ __forceinline__ int mid_t() const { return -1; } __device__ __forceinline__ void mid(Acc&, const Unit&, int, int, int, int) const {}
#define RAW_BARRIER() do { asm volatile("s_waitcnt lgkmcnt(0)" ::: "memory"); __builtin_amdgcn_s_barrier(); asm volatile("" ::: "memory"); } while (0)

__device__ __forceinline__ u32x4 pack8(const f32x4& v0, const f32x4& v1) { u32x4 w; w.x = cvt_pk_bf16(v0[0], v0[1]); w.y = cvt_pk_bf16(v0[2], v0[3]); w.z = cvt_pk_bf16(v1[0], v1[1]); w.w = cvt_pk_bf16(v1[2], v1[3]); return w; }

struct GridOrder {
    const char* A; const char* Bt; int lda, ldb, nM, nN, nwg, G, c, dup;
    __device__ __forceinline__ void init(const void* A_, const void* Bt_, int lda_, int ldb_, int M, int N, int G_, int c_) { A = (const char*)A_; Bt = (const char*)Bt_; lda = lda_; ldb = ldb_; nM = M / BM; nN = N / BM; nwg = nM * nN; G = G_; c = c_; dup = 1; }
    __device__ __forceinline__ bool next(int i, Unit& u) const {
        const long L = (long)i * G + c; if (L >= (long)nwg * dup) return false;
        int wgid = (int)(L % nwg); { const int q = nwg / NXCD, r = nwg % NXCD, xcd = wgid % NXCD, off = wgid / NXCD; wgid = (xcd < r ? xcd * (q + 1) : r * (q + 1) + (xcd - r) * q) + off; }
        const int nig = WGM * nN, gid = wgid / nig, fm = gid * WGM, gsz = (nM - fm) < WGM ? (nM - fm) : WGM;
        u.pm = fm + ((wgid % nig) % gsz); u.pn = (wgid % nig) / gsz; u.x0 = 0; u.x1 = 0; u.rows = nullptr;
        u.a = A + (size_t)u.pm * BM * lda * 2; u.b = Bt + (size_t)u.pn * BM * ldb * 2; return true;
    }
};
struct KvOrder {
    const char* memn; const char* wk; const char* wv; int G, c;
    __device__ __forceinline__ bool next(int i, Unit& u) const {
        const int L = i * G + c; if (L >= 128) return false;
        const int l = L & 63; u.rows = nullptr; u.x1 = 0; u.x0 = L >> 6; u.pm = l >> 2; u.pn = l & 3;
        u.a = memn + (size_t)u.pm * BM * D * 2; u.b = (u.x0 ? wv : wk) + (size_t)u.pn * BM * D * 2;
        return true;
    }
};
struct MnOrder {
    const char* kx; const char* wq2; const char* wxoT; const char* vx; int G, c, dup;
    __device__ __forceinline__ bool next(int i, Unit& u) const {
        int L = i * G + c; if (L >= 512 * dup) return false;
        L &= 511; const int l = L & 255, bh = l >> 2, t4 = l & 3, b = bh >> 2, h = bh & 3; u.rows = nullptr; u.x1 = 0;
        if (L < 256) { u.x0 = 0; u.pm = b * 4 + h; u.pn = t4; u.a = kx + ((size_t)b * MEML * D + h * XHD) * 2; u.b = wq2 + ((size_t)t4 * BM * D + h * XHD) * 2; }
        else { u.x0 = 1; u.pm = b * 4 + t4; u.pn = h; u.a = wxoT + ((size_t)t4 * BM * D + h * XHD) * 2; u.b = vx + ((size_t)b * MEML * D + h * XHD) * 2; }
        return true;
    }
};
struct BatchOrder {
    const char* A; const char* Bt; int nwg, G, c, dup;
    __device__ __forceinline__ bool next(int i, Unit& u) const {
        const long L = (long)i * G + c; if (L >= (long)nwg * dup) return false;
        int wgid = (int)(L % nwg); { const int q = nwg / NXCD, r = nwg % NXCD, xcd = wgid % NXCD, off = wgid / NXCD; wgid = (xcd < r ? xcd * (q + 1) : r * (q + 1) + (xcd - r) * q) + off; }
        const int nN = 4, nM = T / BM, nig = WGM * nN, gid = wgid / nig, fm = gid * WGM, gsz = (nM - fm) < WGM ? (nM - fm) : WGM;
        u.pm = fm + ((wgid % nig) % gsz); u.pn = (wgid % nig) / gsz; u.x0 = 0; u.x1 = 0; u.rows = nullptr;
        u.a = A + (size_t)u.pm * BM * D * 2; u.b = Bt + ((size_t)(u.pm >> 4) * D + u.pn * BM) * D * 2; return true;
    }
};
template <int MODE> struct MoeOrder {
    const char* A; const char* W; const int* rowtok; const int* etile; int G, c, dup;
    __device__ __forceinline__ bool next(int i, Unit& u) const {
        int L = i * G + c; const int ntile = etile[NE];
        if (L >= ntile * 4 * dup) return false;
        L %= ntile * 4;
        const int rt = L >> 2, ct = L & 3; int e = 0;
        for (int j = 1; j < NE; ++j) e = (etile[j] <= rt) ? j : e;
        u.pm = rt; u.pn = ct; u.x0 = e; u.x1 = 0;
        if (MODE == 0) { u.a = A; u.rows = rowtok + rt * BM; u.b = W + ((size_t)e * 1024 + ct * BM) * D * 2; }
        else { u.a = A + (size_t)rt * BM * FF * 2; u.rows = nullptr; u.b = W + ((size_t)e * 1024 + ct * BM) * FF * 2; }
        return true;
    }
};

struct EpiU {
    static constexpr bool PERM = true; EPI_NOMID
    bf16_t* Cb; bf16_t* Q; bf16_t* Kb; bf16_t* V; const float* ropec; const float* ropes;
    __device__ __forceinline__ void operator()(Acc& acc, const Unit& u, int wr, int wc, int fr, int fq, LAS unsigned char*, int, int) const {
        const int row0 = u.pm * BM + wr * 64 + fr;
        if (u.pn < 2) {
#pragma unroll
            for (int ai = 0; ai < 2; ++ai)
#pragma unroll
                for (int m = 0; m < 4; ++m) { const int row = row0 + ai * HALF + m * 16; f32x4 o[2];
#pragma unroll
                    for (int n = 0; n < 2; ++n)
#pragma unroll
                        for (int i = 0; i < 4; ++i) { const float a = acc[ai][0][m][n][i], g = acc[ai][1][m][n][i]; o[n][i] = a / (1.f + __expf(-g)); }
                    *(u32x4*)(Cb + (size_t)row * CCH + u.pn * HALF + wc * 32 + fq * 8) = pack8(o[0], o[1]); }
        } else if (u.pn < 8) {
            const int sec = (u.pn - 2) / 3, tt = (u.pn - 2) % 3; bf16_t* dst = sec ? Kb : Q; const float sc = sec ? 1.f : 0.125f * LOG2E;
            const int hd = 4 * tt + wc;
#pragma unroll
            for (int ai = 0; ai < 2; ++ai)
#pragma unroll
                for (int m = 0; m < 4; ++m) { const int row = row0 + ai * HALF + m * 16; const int s = row & (SEQ - 1); f32x4 o1[2], o2[2];
#pragma unroll
                    for (int n = 0; n < 2; ++n) { const f32x4 cs = *(const f32x4*)(ropec + s * 32 + fq * 8 + n * 4), sn = *(const f32x4*)(ropes + s * 32 + fq * 8 + n * 4);
                        const f32x4 x1 = acc[ai][0][m][n], x2 = acc[ai][1][m][n];
                        o1[n] = (x1 * cs - x2 * sn) * sc; o2[n] = (x1 * sn + x2 * cs) * sc; }
                    bf16_t* p = dst + ((size_t)((row >> 12) * NH + hd) * SEQ + s) * HD + fq * 8;
                    *(u32x4*)p = pack8(o1[0], o1[1]); *(u32x4*)(p + 32) = pack8(o2[0], o2[1]); }
        } else {
            const int tt = u.pn - 8;
#pragma unroll
            for (int ai = 0; ai < 2; ++ai)
#pragma unroll
                for (int m = 0; m < 4; ++m) { const int row = row0 + ai * HALF + m * 16;
#pragma unroll
                    for (int bj = 0; bj < 2; ++bj) { const int col = tt * BM + bj * HALF + wc * 32 + fq * 8;
                        *(u32x4*)(V + ((size_t)((row >> 12) * NH + (col >> 6)) * SEQ + (row & (SEQ - 1))) * HD + (col & 63)) = pack8(acc[ai][bj][m][0], acc[ai][bj][m][1]); } }
        }
    }
};
template <bool ROWSCALE> struct EpiPlain {
    static constexpr bool PERM = true; EPI_NOMID
    bf16_t* O0; int ldc0; bf16_t* O1; int ldc1; const float* ssq16;
    __device__ __forceinline__ void operator()(Acc& acc, const Unit& u, int wr, int wc, int fr, int fq, LAS unsigned char*, int, int) const {
        bf16_t* O = u.x0 ? O1 : O0; const int ldc = u.x0 ? ldc1 : ldc0;
        const int row0 = u.pm * BM + wr * 64 + fr, col0 = u.pn * BM + wc * 32 + fq * 8;
#pragma unroll
        for (int ai = 0; ai < 2; ++ai)
#pragma unroll
            for (int m = 0; m < 4; ++m) { const int row = row0 + ai * HALF + m * 16; float rs = 1.f;
                if constexpr (ROWSCALE) { const f32x4* sp = (const f32x4*)(ssq16 + (size_t)row * 16); const f32x4 s0 = sp[0], s1 = sp[1], s2 = sp[2], s3 = sp[3];
                    const f32x4 st = (s0 + s1) + (s2 + s3); rs = 1.0f / sqrtf(((st[0] + st[1]) + (st[2] + st[3])) * (1.0f / D) + NORM_EPS); }
#pragma unroll
                for (int bj = 0; bj < 2; ++bj) *(u32x4*)(O + (size_t)row * ldc + col0 + bj * HALF) = pack8(acc[ai][bj][m][0] * rs, acc[ai][bj][m][1] * rs); }
    }
};
template <bool MID> struct EpiResid {
    static constexpr bool PERM = false, HAS_MID = MID;
    const float* xin; bf16_t* XB; float* ssqp; const float* ssqa;
    __device__ __forceinline__ int mid_t() const { return AW / BK; }
    __device__ __forceinline__ void mid(Acc& acc, const Unit& u, int wr, int wc, int fr, int fq) const {
        const int row0 = u.pm * BM + wr * 64 + fr;
#pragma unroll
        for (int ai = 0; ai < 2; ++ai)
#pragma unroll
            for (int m = 0; m < 4; ++m) { const int row = row0 + ai * HALF + m * 16; const f32x4* sp = (const f32x4*)(ssqa + (size_t)row * NH);
                const f32x4 s0 = sp[0], s1 = sp[1], s2 = sp[2]; const f32x4 st = (s0 + s1) + s2;
                const float r = 1.0f / sqrtf(((st[0] + st[1]) + (st[2] + st[3])) * (1.0f / AW) + NORM_EPS);
#pragma unroll
                for (int bj = 0; bj < 2; ++bj)
#pragma unroll
                    for (int n = 0; n < 2; ++n) acc[ai][bj][m][n] = acc[ai][bj][m][n] * r;
                asm volatile("" ::: "memory"); }
    }
    __device__ __forceinline__ void operator()(Acc& acc, const Unit& u, int wr, int wc, int fr, int fq, LAS unsigned char*, int, int) const {
        const int row0 = u.pm * BM + wr * 64 + fr, col0 = u.pn * BM + wc * 32 + fq * 4;
#pragma unroll
        for (int ai = 0; ai < 2; ++ai)
#pragma unroll
            for (int m = 0; m < 4; ++m) { const int row = row0 + ai * HALF + m * 16; float ss = 0.f;
#pragma unroll
                for (int bj = 0; bj < 2; ++bj)
#pragma unroll
                    for (int n = 0; n < 2; ++n) { const size_t o = (size_t)row * D + col0 + bj * HALF + n * 16; f32x4 v;
                        if constexpr (MID) v = *(const f32x4*)(xin + o) + acc[ai][bj][m][n];
                        else { const u32x2 xb = *(const u32x2*)(XB + o); v = (f32x4){bflo(xb.x), bfhi(xb.x), bflo(xb.y), bfhi(xb.y)} + acc[ai][bj][m][n]; }
                        u32x2 w; w.x = cvt_pk_bf16(v[0], v[1]); w.y = cvt_pk_bf16(v[2], v[3]); *(u32x2*)(XB + o) = w;
                        ss += (v[0] * v[0] + v[1] * v[1]) + (v[2] * v[2] + v[3] * v[3]); }
                ss += __shfl_xor(ss, 16); ss += __shfl_xor(ss, 32);
                if (fq == 0) ssqp[(size_t)row * 16 + u.pn * 4 + wc] = ss; }
    }
};
struct EpiSoftmax {
    static constexpr bool PERM = true; EPI_NOMID
    bf16_t* PM; const float* ssq16;
    __device__ __forceinline__ void operator()(Acc& acc, const Unit& u, int wr, int wc, int fr, int fq, LAS unsigned char* lds, int, int) const {
        LAS float* MX = (LAS float*)(lds + XCH_OFF); LAS float* SM = (LAS float*)(lds + XCH_OFF + 4096);
#pragma unroll
        for (int ai = 0; ai < 2; ++ai)
#pragma unroll
            for (int m = 0; m < 4; ++m) { const int rl = ai * HALF + wr * 64 + m * 16 + fr; float mx = -3.0e38f;
                const f32x4* sp = (const f32x4*)(ssq16 + (size_t)(u.pm * BM + rl) * 16); const f32x4 st = (sp[0] + sp[1]) + (sp[2] + sp[3]);
                const float rs = 1.0f / sqrtf(((st[0] + st[1]) + (st[2] + st[3])) * (1.0f / D) + NORM_EPS);
#pragma unroll
                for (int bj = 0; bj < 2; ++bj)
#pragma unroll
                    for (int n = 0; n < 2; ++n) { const f32x4 v = acc[ai][bj][m][n] * rs; acc[ai][bj][m][n] = v; mx = fmaxf(mx, fmaxf(fmaxf(v[0], v[1]), fmaxf(v[2], v[3]))); }
                mx = fmaxf(mx, __shfl_xor(mx, 16)); mx = fmaxf(mx, __shfl_xor(mx, 32));
                if (fq == 0) MX[rl * 4 + wc] = mx; }
        RAW_BARRIER();
#pragma unroll
        for (int ai = 0; ai < 2; ++ai)
#pragma unroll
            for (int m = 0; m < 4; ++m) { const int rl = ai * HALF + wr * 64 + m * 16 + fr; const f32x4 mm = *(const LAS f32x4*)(MX + rl * 4);
                const float mx = fmaxf(fmaxf(mm[0], mm[1]), fmaxf(mm[2], mm[3])); float ss = 0.f;
#pragma unroll
                for (int bj = 0; bj < 2; ++bj)
#pragma unroll
                    for (int n = 0; n < 2; ++n) { f32x4 v = acc[ai][bj][m][n];
#pragma unroll
                        for (int i = 0; i < 4; ++i) { v[i] = __builtin_amdgcn_exp2f(v[i] - mx); ss += v[i]; }
                        acc[ai][bj][m][n] = v; }
                ss += __shfl_xor(ss, 16); ss += __shfl_xor(ss, 32);
                if (fq == 0) SM[rl * 4 + wc] = ss; }
        RAW_BARRIER();
        const int col0 = u.pn * BM + wc * 32 + fq * 8;
#pragma unroll
        for (int ai = 0; ai < 2; ++ai)
#pragma unroll
            for (int m = 0; m < 4; ++m) { const int rl = ai * HALF + wr * 64 + m * 16 + fr; const f32x4 s4 = *(const LAS f32x4*)(SM + rl * 4);
                const float inv = 1.0f / ((s4[0] + s4[1]) + (s4[2] + s4[3]));
#pragma unroll
                for (int bj = 0; bj < 2; ++bj) *(u32x4*)(PM + (size_t)(u.pm * BM + rl) * D + col0 + bj * HALF) = pack8(acc[ai][bj][m][0] * inv, acc[ai][bj][m][1] * inv); }
    }
};
struct EpiMoe1 {
    static constexpr bool PERM = true; EPI_NOMID
    bf16_t* HID; const float* slot_rs;
    __device__ __forceinline__ void operator()(Acc& acc, const Unit& u, int wr, int wc, int fr, int fq, LAS unsigned char*, int, int) const {
        const int row0 = u.pm * BM + wr * 64 + fr;
#pragma unroll
        for (int ai = 0; ai < 2; ++ai)
#pragma unroll
            for (int m = 0; m < 4; ++m) { const int row = row0 + ai * HALF + m * 16; const float rs = slot_rs[row]; f32x4 o[2];
#pragma unroll
                for (int n = 0; n < 2; ++n)
#pragma unroll
                    for (int i = 0; i < 4; ++i) { const float a = acc[ai][0][m][n][i] * rs, b = acc[ai][1][m][n][i] * rs; o[n][i] = a * b / (1.f + __expf(-a)); }
                *(u32x4*)(HID + (size_t)row * FF + u.pn * HALF + wc * 32 + fq * 8) = pack8(o[0], o[1]); }
    }
};
struct EpiMoe2 {
    static constexpr bool PERM = true; EPI_NOMID
    bf16_t* Y; const float* slot_gate;
    __device__ __forceinline__ void operator()(Acc& acc, const Unit& u, int wr, int wc, int fr, int fq, LAS unsigned char*, int, int) const {
        const int row0 = u.pm * BM + wr * 64 + fr, col0 = u.pn * BM + wc * 32 + fq * 8;
#pragma unroll
        for (int ai = 0; ai < 2; ++ai)
#pragma unroll
            for (int m = 0; m < 4; ++m) { const int row = row0 + ai * HALF + m * 16; const float g = slot_gate[row];
#pragma unroll
                for (int bj = 0; bj < 2; ++bj) *(u32x4*)(Y + (size_t)row * D + col0 + bj * HALF) = pack8(acc[ai][bj][m][0] * g, acc[ai][bj][m][1] * g); }
    }
};
}
struct Frame {
    LAS unsigned char* lds;
    volatile LAS unsigned* MISC;
    unsigned* ctl;
    unsigned char* ws;
    int wave, vcu, G;
};
struct Args { const void* in[27]; float* out; unsigned char* ws; int ph_lo, ph_hi, li, pad; };

__device__ __forceinline__ void tr_item(const float* W, int ldw, int srcrow0, int srccol0, bf16_t* WT, int dpitch, size_t drow0, int dk0, const float* gk, float sc, LAS float* scr, int lane) {
    f32x4 v[8]; const int n4 = lane & 7, kq = lane >> 3;
#pragma unroll
    for (int i = 0; i < 8; ++i) v[i] = *(const f32x4*)(W + (size_t)(srcrow0 + kq + 8 * i) * ldw + srccol0 + 4 * n4);
#pragma unroll
    for (int i = 0; i < 8; ++i) { const int kk = kq + 8 * i; const float g = gk ? gk[kk] * sc : sc; LAS float* d = scr + kk * 33 + 4 * n4;
        d[0] = v[i][0] * g; d[1] = v[i][1] * g; d[2] = v[i][2] * g; d[3] = v[i][3] * g; }
    LDS_WAIT(); asm volatile("" ::: "memory");
    const int c = lane & 7;
#pragma unroll
    for (int j = 0; j < 4; ++j) { const int n = (lane >> 3) + 8 * j; const LAS float* s = scr + (8 * c) * 33 + n;
        u32x4 o; o.x = pk2(s[0 * 33], s[1 * 33]); o.y = pk2(s[2 * 33], s[3 * 33]); o.z = pk2(s[4 * 33], s[5 * 33]); o.w = pk2(s[6 * 33], s[7 * 33]);
        *(u32x4*)(WT + (drow0 + n) * dpitch + dk0 + 8 * c) = o; }
    LDS_WAIT(); asm volatile("" ::: "memory");
}
__device__ __forceinline__ void rms_row_to_bf16(const float* xrow, const float* g, bf16_t* orow, int lane) {
    const f32x4* xr = (const f32x4*)xrow + lane; const f32x4* gr = (const f32x4*)g + lane;
    f32x4 v[4]; float s = 0.f;
#pragma unroll
    for (int j = 0; j < 4; ++j) { v[j] = xr[64 * j]; s += (v[j][0] * v[j][0] + v[j][1] * v[j][1]) + (v[j][2] * v[j][2] + v[j][3] * v[j][3]); }
    const float rs = 1.0f / sqrtf(wave_sum(s) * (1.f / D) + NORM_EPS);
    u32x2* o8 = (u32x2*)orow + lane;
#pragma unroll
    for (int j = 0; j < 4; ++j) { const f32x4 gg = gr[64 * j]; u32x2 w; w.x = pk2(v[j][0] * rs * gg[0], v[j][1] * rs * gg[1]); w.y = pk2(v[j][2] * rs * gg[2], v[j][3] * rs * gg[3]); o8[64 * j] = w; }
}
__device__ __forceinline__ void rms_row2_to_bf16(const float* xrow, const float* g, bf16_t* orow, int lane) {
    const f32x4* xr = (const f32x4*)xrow + lane; const f32x4* gr = (const f32x4*)g + lane;
    f32x4 v[2][4]; float s0 = 0.f, s1 = 0.f;
#pragma unroll
    for (int r = 0; r < 2; ++r)
#pragma unroll
        for (int j = 0; j < 4; ++j) v[r][j] = xr[r * 256 + 64 * j];
#pragma unroll
    for (int j = 0; j < 4; ++j) { s0 += (v[0][j][0] * v[0][j][0] + v[0][j][1] * v[0][j][1]) + (v[0][j][2] * v[0][j][2] + v[0][j][3] * v[0][j][3]);
        s1 += (v[1][j][0] * v[1][j][0] + v[1][j][1] * v[1][j][1]) + (v[1][j][2] * v[1][j][2] + v[1][j][3] * v[1][j][3]); }
    const float r0 = 1.0f / sqrtf(wave_sum(s0) * (1.f / D) + NORM_EPS), r1 = 1.0f / sqrtf(wave_sum(s1) * (1.f / D) + NORM_EPS);
    u32x2* o8 = (u32x2*)orow + lane;
#pragma unroll
    for (int j = 0; j < 4; ++j) { const f32x4 gg = gr[64 * j]; u32x2 w;
        w.x = pk2(v[0][j][0] * r0 * gg[0], v[0][j][1] * r0 * gg[1]); w.y = pk2(v[0][j][2] * r0 * gg[2], v[0][j][3] * r0 * gg[3]); o8[64 * j] = w;
        w.x = pk2(v[1][j][0] * r1 * gg[0], v[1][j][1] * r1 * gg[1]); w.y = pk2(v[1][j][2] * r1 * gg[2], v[1][j][3] * r1 * gg[3]); o8[256 + 64 * j] = w; }
}
__device__ __forceinline__ double rope_inv(int d) {
    const int q = d >> 3, r = d & 7;
    double b = 1.0;
    b = (r == 1) ? 0.7498942093324558273 : b; b = (r == 2) ? 0.56234132519034908039 : b; b = (r == 3) ? 0.42169650342858224857 : b; b = (r == 4) ? 0.3162277660168379332 : b;
    b = (r == 5) ? 0.23713737056616552617 : b; b = (r == 6) ? 0.17782794100389228012 : b; b = (r == 7) ? 0.13335214321633240257 : b;
    const double p = (q == 0) ? 1.0 : (q == 1) ? 0.1 : (q == 2) ? 0.01 : 0.001;
    return b * p;
}
__device__ __forceinline__ void sincos_d(double a, double& sn, double& cs) {
    const double k = __builtin_rint(a * 0.63661977236758134308);
    double y = __builtin_fma(-k, 1.57079632679489655800e+00, a); y = __builtin_fma(-k, 6.12323399573676603587e-17, y);
    const double y2 = y * y;
    double s = 1.0 / 6227020800.0; s = s * y2 - 1.0 / 39916800.0; s = s * y2 + 1.0 / 362880.0; s = s * y2 - 1.0 / 5040.0; s = s * y2 + 1.0 / 120.0; s = s * y2 - 1.0 / 6.0; s = s * y2 * y + y;
    double c = 1.0 / 479001600.0; c = c * y2 - 1.0 / 3628800.0; c = c * y2 + 1.0 / 40320.0; c = c * y2 - 1.0 / 720.0; c = c * y2 + 1.0 / 24.0; c = c * y2 - 0.5; c = c * y2 + 1.0;
    const int qd = ((int)k) & 3;
    sn = (qd == 0) ? s : (qd == 1) ? c : (qd == 2) ? -s : -c;
    cs = (qd == 0) ? c : (qd == 1) ? -s : (qd == 2) ? -c : s;
}
typedef const void* gen_cptr;
typedef __attribute__((address_space(4))) const char* cas_cptr;
typedef __attribute__((address_space(4))) const gen_cptr* cas_pptr;
__device__ __forceinline__ const void* karg_ptr(int byte_off) { cas_cptr p = (cas_cptr)__builtin_amdgcn_kernarg_segment_ptr(); asm volatile("" : "+s"(p)); return *(cas_pptr)(p + byte_off); }
__device__ __forceinline__ void p0_prologue(Frame& F) {
    const int lane = lane_id(), tid = F.wave * 64 + lane;
    const float* x = (const float*)karg_ptr(8 * 0); const float* mem = (const float*)karg_ptr(8 * 1); const int* positions = (const int*)karg_ptr(8 * 2);
    const float* mix_g = (const float*)karg_ptr(8 * 3); const float* w_in = (const float*)karg_ptr(8 * 4);
    const float* attn_out_g = (const float*)karg_ptr(8 * 10); const float* w_out = (const float*)karg_ptr(8 * 11);
    const float* xattn_g = (const float*)karg_ptr(8 * 12); const float* mem_g = (const float*)karg_ptr(8 * 13);
    const float* w_xq = (const float*)karg_ptr(8 * 14); const float* w_xk = (const float*)karg_ptr(8 * 15); const float* w_xv = (const float*)karg_ptr(8 * 16); const float* w_xo = (const float*)karg_ptr(8 * 17);
    const float* moe_g = (const float*)karg_ptr(8 * 18); const float* w_group = (const float*)karg_ptr(8 * 19); const float* w_router = (const float*)karg_ptr(8 * 21);
    const float* w1 = (const float*)karg_ptr(8 * 23); const float* w3 = (const float*)karg_ptr(8 * 24); const float* w2 = (const float*)karg_ptr(8 * 25);
    unsigned char* ws = F.ws;
    LAS float* scr = (LAS float*)(F.lds + F.wave * 16384);
    const int gw = F.vcu * NWAVES + F.wave, NGW = F.G * NWAVES;
    constexpr int I_IN = 16 * 88, I_SQ = 16 * 32, I_13 = NE * 16 * 32, I_2 = NE * 8 * 32;
    constexpr int NITEMS = I_IN + 5 * I_SQ + I_13 + I_2;
    for (int it = gw; it < NITEMS; it += NGW) {
        int r = it;
        if (r < I_IN) { const int kb = r / 88, nb = r % 88, n0 = 32 * nb, tile = n0 >> 8, j = n0 & 255; int src;
            if (tile < 2) src = (j < 128) ? 128 * tile + j : 256 + 128 * tile + (j - 128);
            else if (tile < 8) { const int sec = (tile - 2) / 3, tt = (tile - 2) % 3, jj = j & 127, hh = jj >> 5; src = 512 + 768 * sec + 256 * tt + 64 * hh + ((j < 128) ? 0 : 32); }
            else src = n0;
            tr_item(w_in, INW, 64 * kb, src, (bf16_t*)(ws + WS_WIN), D, (size_t)n0, 64 * kb, nullptr, 1.f, scr, lane); continue; }
        r -= I_IN;
        if (r < I_SQ) { const int kb = r / 32, nb = r % 32, dk0 = 64 * kb; const bool at = dk0 < AW;
            tr_item(w_out, D, at ? CCH + dk0 : dk0 - AW, 32 * nb, (bf16_t*)(ws + WS_WOUT), D, (size_t)(32 * nb), dk0, at ? attn_out_g + dk0 : nullptr, 1.f, scr, lane); continue; }
        r -= I_SQ;
        if (r < 4 * I_SQ) { const int which = r / I_SQ, r2 = r % I_SQ, kb = r2 / 32, nb = r2 % 32;
            if (which == 0) {
                bf16_t* WQ2 = (bf16_t*)(ws + WS_WXQ); const int n4 = lane & 7, kq = lane >> 3;
#pragma unroll
                for (int i = 0; i < 8; ++i) { const int k = 64 * kb + kq + 8 * i; const f32x4 v = *(const f32x4*)(w_xq + (size_t)k * D + 32 * nb + 4 * n4); const float g = xattn_g[k] * (LOG2E / 16.f);
                    u32x2 o; o.x = pk2(v[0] * g, v[1] * g); o.y = pk2(v[2] * g, v[3] * g); *(u32x2*)(WQ2 + (size_t)k * D + 32 * nb + 4 * n4) = o; }
                continue; }
            const float* W = which == 1 ? w_xk : which == 2 ? w_xv : w_xo;
            bf16_t* WT = (bf16_t*)(ws + (which == 1 ? WS_WXK : which == 2 ? WS_WXV : WS_WXO));
            tr_item(W, D, 64 * kb, 32 * nb, WT, D, (size_t)(32 * nb), 64 * kb, nullptr, 1.f, scr, lane); continue; }
        r -= 4 * I_SQ;
        if (r < I_13) { const int e = r / 512, r2 = r % 512, kb = r2 / 32, nb = r2 % 32, n0 = 32 * nb, tt = n0 >> 8, j = n0 & 255;
            const float* W = ((j < 128) ? w1 : w3) + (size_t)e * D * FF;
            tr_item(W, FF, 64 * kb, 128 * tt + (j & 127), (bf16_t*)(ws + WS_W13), D, (size_t)e * 1024 + n0, 64 * kb, moe_g + 64 * kb, 1.f, scr, lane); continue; }
        r -= I_13;
        { const int e = r / 256, r2 = r % 256, kb = r2 / 32, nb = r2 % 32;
            tr_item(w2 + (size_t)e * FF * D, D, 64 * kb, 32 * nb, (bf16_t*)(ws + WS_W2), FF, (size_t)e * 1024 + 32 * nb, 64 * kb, nullptr, 1.f, scr, lane); }
    }
    { bf16_t* WRF = (bf16_t*)(ws + WS_HIST + HIST_WR);
      for (int i = blockIdx.x * 512 + tid; i < 4 * 8 * 3 * 2 * 64 * 8; i += F.G * 512) {
          const int j = i & 7, ln = (i >> 3) & 63, part = (i >> 9) & 1, blk = i >> 10, nt = blk % 3, s = (blk / 3) & 7, kc = blk / 24;
          const int k = 256 * kc + 32 * s + 8 * (ln >> 4) + j, o = 16 * nt + (ln & 15);
          float v = 0.f; if (o < 32) v = w_router[k * 32 + o] * moe_g[k]; else if (o < 36) v = w_group[k * 4 + (o - 32)] * moe_g[k];
          const unsigned hb = f2bf(v); const float hf = __builtin_bit_cast(float, hb << 16);
          WRF[i] = (bf16_t)(part ? f2bf(v - hf) : hb); } }
    { float* rc = (float*)(ws + WS_ROPE); float* rsn = rc + SEQ * 32;
      for (int i = blockIdx.x * 512 + tid; i < SEQ * 32; i += F.G * 512) { const int s = i >> 5, d = i & 31;
          const float inv = (float)rope_inv(d); const float ang = (float)positions[s] * inv; double sn, cs; sincos_d((double)fabsf(ang), sn, cs); if (ang < 0.f) sn = -sn;
          rc[i] = (float)cs; rsn[i] = (float)sn; } }
    for (int m = gw; m < MROWS; m += NGW) rms_row_to_bf16(mem + (size_t)m * D, mem_g, (bf16_t*)(ws + WS_MEMN) + (size_t)m * D, lane);
    for (int m = 2 * gw; m < T; m += 2 * NGW) rms_row2_to_bf16(x + (size_t)m * D, mix_g, (bf16_t*)(ws + WS_R1) + (size_t)m * D, lane);
}
#ifndef D16_REP
#define D16_REP 1
#endif
namespace att {
typedef short v4i16_t __attribute__((ext_vector_type(4)));
constexpr int BUFB = 65536, VIMG = 32768;
constexpr float NEG = -1.0e30f, MFLOOR = -1.0e9f;
__device__ __forceinline__ int k_off(int row, int c) { return row * 128 + ((c ^ ((row >> 1) & 7)) << 4); }
__device__ __forceinline__ int v_off(int row, int c) { return VIMG + row * 128 + ((c ^ (((row >> 1) & 3) << 1)) << 4); }

struct Grp { bf16x8 q0, q1; f32x4 o[4]; float m, l; };
struct KV { bf16x8 k[2][2]; bf16x8 v[4]; };

#ifdef ATT_SHFL
__device__ __forceinline__ float xmax16(float v) { return fmaxf(v, __shfl_xor(v, 16)); }
__device__ __forceinline__ float xmax32(float v) { return fmaxf(v, __shfl_xor(v, 32)); }
__device__ __forceinline__ float xsum16(float v) { return v + __shfl_xor(v, 16); }
__device__ __forceinline__ float xsum32(float v) { return v + __shfl_xor(v, 32); }
#else
__device__ __forceinline__ void swap16(float v, float& a, float& b) { a = v; b = v; asm volatile("s_nop 1\n\tv_permlane16_swap_b32 %0, %1" : "+v"(a), "+v"(b)); }
__device__ __forceinline__ void swap32(float v, float& a, float& b) { a = v; b = v; asm volatile("s_nop 1\n\tv_permlane32_swap_b32 %0, %1" : "+v"(a), "+v"(b)); }
__device__ __forceinline__ float xmax16(float v) { float a, b; swap16(v, a, b); return fmaxf(a, b); }
__device__ __forceinline__ float xmax32(float v) { float a, b; swap32(v, a, b); return fmaxf(a, b); }
__device__ __forceinline__ float xsum16(float v) { float a, b; swap16(v, a, b); return a + b; }
__device__ __forceinline__ float xsum32(float v) { float a, b; swap32(v, a, b); return a + b; }
#endif
constexpr int NSTEP_ = 9;
__device__ __forceinline__ int step_id(int s) { return (s >= 6) ? s : ((s & 1) ? 3 + (s >> 1) : (s >> 1)); }
__device__ __forceinline__ int step_pos(int step, int row, int c0) {
    if (step == 99) return 16 * row + c0;
    if (step < 3) { const int hh = row >> 7, jj = row & 127; return c0 + 256 * hh - 64 + 128 * step + jj; }
    if (step < 9) { const int s = step - 3, hh = row >> 7, c = (row >> 5) & 3, jj = row & 31; return 4 * ((c0 >> 2) + 64 * hh - 64 + 32 * s + jj) + c; }
    { const int s = step - 9, pb = s >> 1, rh = s & 1, rr = row >> 5, jj = row & 31; return 16 * ((c0 >> 4) - 64 + 32 * pb + jj) + 8 * rh + rr; }
}
__device__ __forceinline__ void stage_issue(unsigned ldsbuf, const char* Kg, const char* Vg, int hrow0, int c0, int step, int wave, int lane) {
    const bool isV = wave >= 4; const char* gb = pg8::uniform_ptr(isV ? Vg : Kg);
#pragma unroll
    for (int i = 0; i < 8; ++i) { const int blk = (wave & 3) * 8 + i, row = 8 * blk + (lane >> 3), phys = lane & 7;
        const int c = isV ? (phys ^ (((row >> 1) & 3) << 1)) : (phys ^ ((row >> 1) & 7));
        int pos = step_pos(step, row, c0); pos = pos < 0 ? 0 : (pos > SEQ - 1 ? SEQ - 1 : pos);
        const unsigned voff = (unsigned)((hrow0 + pos) * HD + c * 8) * 2u;
        pg8::glds16_sv(gb, voff, ldsbuf + (isV ? (unsigned)VIMG : 0u) + (unsigned)blk * 1024u); __builtin_amdgcn_sched_barrier(0); }
}
struct LaneOff { int kb0; int vb[4]; };
__device__ __forceinline__ void lane_off(LaneOff& o, int lane) {
    const int key = lane & 15, g = lane >> 4, q = (lane >> 2) & 3, p2 = lane & 3;
    o.kb0 = k_off(key, g);
#pragma unroll
    for (int db = 0; db < 4; ++db) o.vb[db] = v_off(4 * g + q, 2 * db + (p2 >> 1)) + 8 * (p2 & 1);
}
__device__ __forceinline__ const LAS unsigned char* row_base(const LAS unsigned char* buf, int Rb) {
    return (const LAS unsigned char*)(uintptr_t)(unsigned)__builtin_amdgcn_readfirstlane((int)((unsigned)(uintptr_t)buf + (unsigned)(Rb * 128))); }
__device__ __forceinline__ void load_k(bf16x8 (&k)[2][2], const LAS unsigned char* buf, int Rb, const LaneOff& lo) {
    const LAS unsigned char* rb = row_base(buf, Rb);
#pragma unroll
    for (int t = 0; t < 2; ++t) { k[t][0] = *(const LAS bf16x8*)(rb + t * 2048 + lo.kb0); k[t][1] = *(const LAS bf16x8*)(rb + t * 2048 + (lo.kb0 ^ 64)); }
}
__device__ __forceinline__ void load_v(bf16x8 (&v)[4], const LAS unsigned char* buf, int Rb, const LaneOff& lo) {
    const LAS unsigned char* rb = row_base(buf, Rb);
#pragma unroll
    for (int db = 0; db < 4; ++db) {
        const s16x4 v0 = __builtin_bit_cast(s16x4, __builtin_amdgcn_ds_read_tr16_b64_v4i16((LAS v4i16_t*)(rb + lo.vb[db])));
        const s16x4 v1 = __builtin_bit_cast(s16x4, __builtin_amdgcn_ds_read_tr16_b64_v4i16((LAS v4i16_t*)(rb + 2048 + lo.vb[db])));
        v[db] = (bf16x8){v0[0], v0[1], v0[2], v0[3], v1[0], v1[1], v1[2], v1[3]}; }
}
__device__ __forceinline__ float fmax_nc(float a, float b) { float r; asm("v_max_f32_e32 %0, %1, %2" : "=v"(r) : "v"(a), "v"(b)); return r; }
__device__ __forceinline__ float fmax3_nc(float a, float b, float c) { float r; asm("v_max3_f32 %0, %1, %2, %3" : "=v"(r) : "v"(a), "v"(b), "v"(c)); return r; }
__device__ __forceinline__ void qk_part(const Grp& G, const bf16x8 (&k)[2][2], f32x4 (&s)[2]) {
#pragma unroll
    for (int t = 0; t < 2; ++t) { f32x4 z = (f32x4){0.f, 0.f, 0.f, 0.f};
        z = __builtin_amdgcn_mfma_f32_16x16x32_bf16(k[t][0], G.q0, z, 0, 0, 0); s[t] = __builtin_amdgcn_mfma_f32_16x16x32_bf16(k[t][1], G.q1, z, 0, 0, 0); }
}
template <bool FULL, bool INR>
__device__ __forceinline__ void sm_part(Grp& G, f32x4 (&s)[2], int ksub0, int qsub, int L, int lane, bf16x8& pb, float& alpha) {
    const int g = lane >> 4;
    if constexpr (!FULL) { const int d0 = ksub0 + 4 * g - qsub + 64, k0 = ksub0 + 4 * g;
#pragma unroll
        for (int t = 0; t < 2; ++t)
#pragma unroll
            for (int i = 0; i < 4; ++i) { bool ok = ((unsigned)(d0 + 16 * t + i) <= 128u); if constexpr (!INR) ok = ok && ((unsigned)(k0 + 16 * t + i) < (unsigned)L); s[t][i] = ok ? s[t][i] : NEG; } }
    float mx = fmax3_nc(fmax3_nc(s[0][0], s[0][1], s[0][2]), fmax3_nc(s[0][3], s[1][0], s[1][1]), fmax3_nc(s[1][2], s[1][3], G.m));
    { float a, b; swap16(mx, a, b); mx = fmax_nc(a, b); swap32(mx, a, b); mx = fmax_nc(a, b); }
    const float mn = mx; alpha = __builtin_amdgcn_exp2f(G.m - mn);
    G.m = mn; float p[2][4]; float ps = 0.f;
#pragma unroll
    for (int t = 0; t < 2; ++t)
#pragma unroll
        for (int i = 0; i < 4; ++i) { const float e = __builtin_amdgcn_exp2f(s[t][i] - mn); p[t][i] = e; ps += e; }
    G.l = G.l * alpha + ps;
    u32x4 pw; pw.x = cvt_pk_bf16(p[0][0], p[0][1]); pw.y = cvt_pk_bf16(p[0][2], p[0][3]); pw.z = cvt_pk_bf16(p[1][0], p[1][1]); pw.w = cvt_pk_bf16(p[1][2], p[1][3]);
    pb = __builtin_bit_cast(bf16x8, pw);
}
__device__ __forceinline__ void pv_part(Grp& G, const bf16x8 (&v)[4], const bf16x8& pb, float alpha) {
#pragma unroll
    for (int db = 0; db < 4; ++db) G.o[db] = __builtin_amdgcn_mfma_f32_16x16x32_bf16(v[db], pb, G.o[db] * alpha, 0, 0, 0);
}
__device__ __forceinline__ void grp_init(Grp& G, const bf16_t* Qb, size_t qrow0, int lane) {
    const int a = lane & 15, g = lane >> 4; const bf16_t* qp = Qb + (qrow0 + 16 * a) * HD + 8 * g;
    G.q0 = *(const bf16x8*)qp; G.q1 = *(const bf16x8*)(qp + 32);
#pragma unroll
    for (int d = 0; d < 4; ++d) G.o[d] = (f32x4){0.f, 0.f, 0.f, 0.f};
    G.m = MFLOOR; G.l = 0.f;
}
__device__ __forceinline__ void grp_init_state(Grp& G, const bf16_t* Qb, const bf16_t* MIX, const float* ml, size_t tok0, size_t qrow0, int h, int lane) {
    const int a = lane & 15, g = lane >> 4; const size_t tok = tok0 + 16 * a; const bf16_t* qp = Qb + (qrow0 + 16 * a) * HD + 8 * g;
    G.q0 = *(const bf16x8*)qp; G.q1 = *(const bf16x8*)(qp + 32);
    const f32x2 st = *(const f32x2*)(ml + (tok * NH + h) * 2);
    G.m = st[0]; G.l = st[1] * 0.25f;
#pragma unroll
    for (int db = 0; db < 4; ++db) { const u32x2 w = *(const u32x2*)(MIX + tok * D + h * HD + 16 * db + 4 * g);
        G.o[db] = (f32x4){bflo(w.x), bfhi(w.x), bflo(w.y), bfhi(w.y)} * st[1]; }
}
__device__ __forceinline__ void grp_finish(Grp& G, bf16_t* MIX, float* ssqa, size_t tok0, int h, int lane) {
    const int a = lane & 15, g = lane >> 4; float l = G.l; l = xsum16(l); l = xsum32(l);
    const float inv = 1.0f / l; const size_t tok = tok0 + 16 * a; float ss = 0.f;
#pragma unroll
    for (int db = 0; db < 4; ++db) { const f32x4 o = G.o[db] * inv; ss += (o[0] * o[0] + o[1] * o[1]) + (o[2] * o[2] + o[3] * o[3]);
        u32x2 w; w.x = cvt_pk_bf16(o[0], o[1]); w.y = cvt_pk_bf16(o[2], o[3]); *(u32x2*)(MIX + tok * D + h * HD + 16 * db + 4 * g) = w; }
    ss = xsum16(ss); ss = xsum32(ss);
    if (g == 0) ssqa[tok * NH + h] = ss;
}
#define ATT_SYNC() do { asm volatile("s_waitcnt vmcnt(0) lgkmcnt(0)" ::: "memory"); __builtin_amdgcn_s_barrier(); asm volatile("" ::: "memory"); } while (0)
#define ATT_SB() __builtin_amdgcn_sched_barrier(0)
template <bool INR>
__device__ __forceinline__ void pair4(Grp& G0, Grp& G1, Grp& G2, Grp& G3, const LAS unsigned char* buf, int Rb, const LaneOff& lo, int ks0, int qs, int dq, int L, int lane) {
    f32x4 s0[2], s1[2], s2[2], s3[2]; bf16x8 p0, p1, p2, p3; float a0, a1, a2, a3;
    { bf16x8 k[2][2]; load_k(k, buf, Rb, lo); qk_part(G0, k, s0); qk_part(G1, k, s1); qk_part(G2, k, s2); qk_part(G3, k, s3); } ATT_SB();
    bf16x8 v[4]; load_v(v, buf, Rb, lo);
    sm_part<false, INR>(G0, s0, ks0, qs, L, lane, p0, a0); sm_part<false, INR>(G1, s1, ks0, qs + dq, L, lane, p1, a1); ATT_SB();
    sm_part<false, INR>(G2, s2, ks0, qs + 2 * dq, L, lane, p2, a2); sm_part<false, INR>(G3, s3, ks0, qs + 3 * dq, L, lane, p3, a3); ATT_SB();
    pv_part(G0, v, p0, a0); pv_part(G1, v, p1, a1); pv_part(G2, v, p2, a2); pv_part(G3, v, p3, a3); ATT_SB();
}
template <bool FULL, bool INR>
__device__ __forceinline__ void pair2(Grp& GA, Grp& GB, const LAS unsigned char* buf, int RbA, int RbB, const LaneOff& lo, int ks0, int qs, int L, int lane) {
    f32x4 s0[2], s1[2]; bf16x8 p0, p1; float a0, a1;
    { bf16x8 ka[2][2], kb[2][2]; load_k(ka, buf, RbA, lo); load_k(kb, buf, RbB, lo); qk_part(GA, ka, s0); qk_part(GB, kb, s1); } ATT_SB();
    bf16x8 va[4], vb[4]; load_v(va, buf, RbA, lo); load_v(vb, buf, RbB, lo);
    sm_part<FULL, INR>(GA, s0, ks0, qs, L, lane, p0, a0); sm_part<FULL, INR>(GB, s1, ks0, qs, L, lane, p1, a1); ATT_SB();
    pv_part(GA, va, p0, a0); pv_part(GB, vb, p1, a1); ATT_SB();
}
__device__ __forceinline__ void attn_unit(LAS unsigned char* lds, const bf16_t* Qb, const bf16_t* Kb, const bf16_t* Vb, bf16_t* MIX, float* ssqa, const float* ml, int b, int h, int c0, int tid, int wave, int lane_) {
    int lane = lane_; asm volatile("" : "+v"(lane));
    const int brow0 = b * SEQ, hrow0 = (b * NH + h) * SEQ, half = wave >> 2, w4 = wave & 3, ch = c0 + 256 * half;
    const unsigned lds0 = (unsigned)(uintptr_t)lds;
    const size_t tokb = (size_t)(brow0 + ch + w4);
    Grp G0, G1, G2, G3;
    const size_t qb0 = (size_t)(hrow0 + ch + w4);
    grp_init_state(G0, Qb, MIX, ml, tokb, qb0, h, lane); grp_init_state(G1, Qb, MIX, ml, tokb + 4, qb0 + 4, h, lane); grp_init_state(G2, Qb, MIX, ml, tokb + 8, qb0 + 8, h, lane); grp_init_state(G3, Qb, MIX, ml, tokb + 12, qb0 + 12, h, lane);
    ATT_SYNC();
    { int ln = lane; asm volatile("" : "+v"(ln)); stage_issue(lds0, (const char*)Kb, (const char*)Vb, hrow0, c0, step_id(0), wave, ln); }
#pragma nounroll
    for (int sx = 0; sx < NSTEP_; ++sx) { const int step = step_id(sx);
        ATT_SYNC();
        int ln = lane; asm volatile("" : "+v"(ln));
        if (sx + 1 < NSTEP_) stage_issue(lds0 + (unsigned)(((sx + 1) & 1) * BUFB), (const char*)Kb, (const char*)Vb, hrow0, c0, step_id(sx + 1), wave, ln);
        const LAS unsigned char* buf = lds + (sx & 1) * BUFB;
        LaneOff lo; lane_off(lo, ln); const int a = ln & 15;
#pragma nounroll
        for (int rep_ = 0; rep_ < D16_REP; ++rep_)
        if (step < 3) {
            const int qs = ch + w4 + 16 * a;
#pragma nounroll
            for (int p = 0; p < 4; ++p) { const int ks0 = ch - 64 + 128 * step + 32 * p;
                if (ks0 + 31 >= 0 && ks0 < SEQ) { const int Rb = 128 * half + 32 * p;
                    if (ks0 >= 0 && ks0 + 32 <= SEQ) pair4<true>(G0, G1, G2, G3, buf, Rb, lo, ks0, qs, 4, SEQ, ln); else pair4<false>(G0, G1, G2, G3, buf, Rb, lo, ks0, qs, 4, SEQ, ln); } }
        } else {
            const int s = step - 3, ks0 = (ch >> 2) - 64 + 32 * s, qs = (ch >> 2) + 4 * a;
            if (ks0 + 31 >= 0 && ks0 < SEQ / 4) { const int Rb = 128 * half + 32 * w4;
                if (ks0 >= 0 && ks0 + 32 <= SEQ / 4) pair4<true>(G0, G1, G2, G3, buf, Rb, lo, ks0, qs, 1, SEQ / 4, ln); else pair4<false>(G0, G1, G2, G3, buf, Rb, lo, ks0, qs, 1, SEQ / 4, ln); }
        }
    }
    { int lf = lane; asm volatile("" : "+v"(lf)); const size_t tf = (size_t)(brow0 + ch + w4);
      grp_finish(G0, MIX, ssqa, tf, h, lf); grp_finish(G1, MIX, ssqa, tf + 4, h, lf); grp_finish(G2, MIX, ssqa, tf + 8, h, lf); grp_finish(G3, MIX, ssqa, tf + 12, h, lf); }
}
template <bool FULL>
__device__ __forceinline__ void pair2s(Grp& GA, Grp& GB, const LAS unsigned char* buf, int Rb, const LaneOff& lo, int ks0, int qs, int lane) {
    f32x4 s0[2], s1[2]; bf16x8 p0, p1; float a0, a1;
    { bf16x8 k[2][2]; load_k(k, buf, Rb, lo); qk_part(GA, k, s0); qk_part(GB, k, s1); } ATT_SB();
    bf16x8 v[4]; load_v(v, buf, Rb, lo);
    sm_part<FULL, true>(GA, s0, ks0, qs, SEQ / 16, lane, p0, a0); sm_part<FULL, true>(GB, s1, ks0, qs + 16, SEQ / 16, lane, p1, a1); ATT_SB();
    pv_part(GA, v, p0, a0); pv_part(GB, v, p1, a1); ATT_SB();
}
__device__ __forceinline__ void grp_finish_state(Grp& G, bf16_t* MIX, float* ml, size_t tok0, int h, int lane) {
    const int a = lane & 15, g = lane >> 4; float l = G.l; l = xsum16(l); l = xsum32(l);
    const float inv = 1.0f / l; const size_t tok = tok0 + 16 * a;
#pragma unroll
    for (int db = 0; db < 4; ++db) { const f32x4 o = G.o[db] * inv;
        u32x2 w; w.x = cvt_pk_bf16(o[0], o[1]); w.y = cvt_pk_bf16(o[2], o[3]); *(u32x2*)(MIX + tok * D + h * HD + 16 * db + 4 * g) = w; }
    if (g == 0) *(f32x2*)(ml + (tok * NH + h) * 2) = (f32x2){G.m, l};
}
__device__ __forceinline__ void d16_phase(LAS unsigned char* lds, const bf16_t* Qb, const bf16_t* Kb, const bf16_t* Vb, bf16_t* MIX, float* ml, int vcu, int G_, int dup, int wave, int lane_) {
    constexpr int NT = NB * NH * 16;
    const unsigned lds0 = (unsigned)(uintptr_t)lds;
    ATT_SYNC();
    if (vcu < NT * dup) { int ln = lane_; asm volatile("" : "+v"(ln)); const int L = vcu % NT, r = L & 15, bh = L >> 4;
        stage_issue(lds0, (const char*)Kb, (const char*)Vb, bh * SEQ, r, 99, wave, ln); }
    int it = 0;
#pragma nounroll
    for (int L0 = vcu; L0 < NT * dup; L0 += G_, ++it) {
        const int L = L0 % NT, r = L & 15, bh = L >> 4, b = bh / NH, h = bh % NH, brow0 = b * SEQ, hcol = h * HD;
        ATT_SYNC();
        int ln = lane_; asm volatile("" : "+v"(ln));
        if (L0 + G_ < NT * dup) { const int Ln = (L0 + G_) % NT, rn = Ln & 15, bhn = Ln >> 4;
            stage_issue(lds0 + (unsigned)(((it + 1) & 1) * BUFB), (const char*)Kb, (const char*)Vb, bhn * SEQ, rn, 99, wave, ln); }
        const LAS unsigned char* buf = lds + (it & 1) * BUFB;
        LaneOff lo; lane_off(lo, ln); const int a = ln & 15;
        Grp GA, GB; const size_t tokA = (size_t)(brow0 + r + 16 * (32 * wave));
        { const size_t qA = (size_t)(bh * SEQ + r + 16 * (32 * wave)); grp_init(GA, Qb, qA, ln); grp_init(GB, Qb, qA + 256, ln); }
        const int qs = 32 * wave + a;
#pragma nounroll
        for (int p5 = 0; p5 < 5 * D16_REP; ++p5) { const int p = p5 % 5; const int ks0 = 32 * wave - 64 + 32 * p;
            if (ks0 >= 0 && ks0 < SEQ / 16) {
                const bool full = (ks0 + 31 - 32 * wave <= 64) && (32 * wave + 15 - ks0 <= 64) && (ks0 + 31 - (32 * wave + 16) <= 64) && (32 * wave + 31 - ks0 <= 64);
                if (full) pair2s<true>(GA, GB, buf, ks0, lo, ks0, qs, ln); else pair2s<false>(GA, GB, buf, ks0, lo, ks0, qs, ln); } }
        grp_finish_state(GA, MIX, ml, tokA, h, ln); grp_finish_state(GB, MIX, ml, tokA + 256, h, ln);
    }
}
__device__ __forceinline__ void conv_unit(LAS unsigned char* lds, const bf16_t* Cb, bf16_t* MIX, const float* dw_w, const float* dw_b, const float* ln_g, const float* ln_b, const float* out_g,
                                          int b, int s0, int tid_, int wave, int lane_) {
    int tid = tid_, lane = lane_; asm volatile("" : "+v"(tid), "+v"(lane));
    LAS bf16_t* CT = (LAS bf16_t*)lds;
    LAS float* CO = (LAS float*)(lds + 49152);
    ATT_SYNC();
    for (int p = tid; p < 94 * 32; p += NWAVES * 64) { const int row = p >> 5, c = p & 31, s = s0 - 15 + row;
        u32x4 v = (u32x4){0u, 0u, 0u, 0u};
        if (s >= 0 && s < SEQ) v = *(const u32x4*)(Cb + (size_t)(b * SEQ + s) * CCH + c * 8);
        *(LAS u32x4*)(CT + row * CCH + c * 8) = v; }
    ATT_SYNC();
    { const int ch = tid & 255, half = tid >> 8; float v[62], w[CONVK];
#pragma unroll
      for (int k = 0; k < CONVK; ++k) w[k] = dw_w[k * CCH + ch];
#pragma unroll
      for (int i = 0; i < 62; ++i) v[i] = bf2f(CT[(32 * half + i) * CCH + ch]);
      const float bias = dw_b[ch];
#pragma unroll
      for (int p = 0; p < 32; ++p) { float acc = bias;
#pragma unroll
          for (int k = 0; k < CONVK; ++k) acc += v[p + k] * w[k];
          CO[(32 * half + p) * CCH + ch] = acc; } }
    ATT_SYNC();
    { const f32x4 g4 = *((const f32x4*)ln_g + lane), b4 = *((const f32x4*)ln_b + lane), og = *((const f32x4*)out_g + lane);
#pragma unroll
      for (int pp = 0; pp < 8; ++pp) { const int p = wave * 8 + pp; const f32x4 xv = *(const LAS f32x4*)(CO + p * CCH + 4 * lane);
          const float mean = wave_sum((xv[0] + xv[1]) + (xv[2] + xv[3])) * (1.f / CCH); const f32x4 dx = xv - mean;
          const float var = wave_sum((dx[0] * dx[0] + dx[1] * dx[1]) + (dx[2] * dx[2] + dx[3] * dx[3])) * (1.f / CCH); const float rstd = 1.0f / sqrtf(var + LN_EPS);
          f32x4 z;
#pragma unroll
          for (int i = 0; i < 4; ++i) { const float y = dx[i] * rstd * g4[i] + b4[i]; z[i] = y / (1.f + __expf(-y)); }
          const float ms = wave_sum((z[0] * z[0] + z[1] * z[1]) + (z[2] * z[2] + z[3] * z[3])) * (1.f / CCH); const float rs = 1.0f / sqrtf(ms + NORM_EPS);
          u32x2 o; o.x = cvt_pk_bf16(z[0] * rs * og[0], z[1] * rs * og[1]); o.y = cvt_pk_bf16(z[2] * rs * og[2], z[3] * rs * og[3]);
          *(u32x2*)(MIX + (size_t)(b * SEQ + s0 + p) * D + AW + 4 * lane) = o; } }
}
}
namespace moe {
#define MOE_SYNC() do { asm volatile("s_waitcnt vmcnt(0) lgkmcnt(0)" ::: "memory"); __builtin_amdgcn_s_barrier(); asm volatile("" ::: "memory"); } while (0)
__device__ __forceinline__ void split_hi_lo(const f32x4& a, const f32x4& b, bf16x8& hi, bf16x8& lo) {
    u32x4 h, l; float r[8];
    h.x = cvt_pk_bf16(a[0], a[1]); h.y = cvt_pk_bf16(a[2], a[3]); h.z = cvt_pk_bf16(b[0], b[1]); h.w = cvt_pk_bf16(b[2], b[3]);
    r[0] = a[0] - bflo(h.x); r[1] = a[1] - bfhi(h.x); r[2] = a[2] - bflo(h.y); r[3] = a[3] - bfhi(h.y);
    r[4] = b[0] - bflo(h.z); r[5] = b[1] - bfhi(h.z); r[6] = b[2] - bflo(h.w); r[7] = b[3] - bfhi(h.w);
    l.x = cvt_pk_bf16(r[0], r[1]); l.y = cvt_pk_bf16(r[2], r[3]); l.z = cvt_pk_bf16(r[4], r[5]); l.w = cvt_pk_bf16(r[6], r[7]);
    hi = __builtin_bit_cast(bf16x8, h); lo = __builtin_bit_cast(bf16x8, l);
}
__device__ __forceinline__ void route_chunk(LAS unsigned char* lds, const bf16_t* x2, const float* ssq2, const bf16_t* WRF, const float* b_router, const float* b_group,
                                            int* tok_e, float* tok_gate, float* tok_rs, int* hist, int chunk, int tid, int wave, int lane) {
    LAS unsigned char* WB = lds;
    LAS float* LG = (LAS float*)(lds + 49152);
    LAS int* HS = (LAS int*)(lds + 49152 + 36864);
    const int tk = lane & 15, g = lane >> 4;
    f32x4 acc[2][3];
#pragma unroll
    for (int gi = 0; gi < 2; ++gi)
#pragma unroll
        for (int nt = 0; nt < 3; ++nt) acc[gi][nt] = (f32x4){0.f, 0.f, 0.f, 0.f};
    if (tid < 32) HS[tid] = 0;
    const bf16_t* xb = x2 + (size_t)(chunk * 256 + wave * 32 + tk) * D + 8 * g;
#pragma nounroll
    for (int kc = 0; kc < 4; ++kc) {
        MOE_SYNC();
#pragma unroll
        for (int i = 0; i < 6; ++i) { const int p = tid + 512 * i; *(LAS u32x4*)(WB + p * 16) = *(const u32x4*)((const char*)WRF + (size_t)kc * 49152 + p * 16); }
        MOE_SYNC();
#pragma unroll
        for (int gi = 0; gi < 2; ++gi) {
            bf16x8 xa[8];
#pragma unroll
            for (int s = 0; s < 8; ++s) xa[s] = *(const bf16x8*)(xb + (size_t)gi * 16 * D + kc * 256 + s * 32);
#pragma unroll
            for (int s = 0; s < 8; ++s) {
#pragma unroll
                for (int nt = 0; nt < 3; ++nt) { const LAS unsigned char* bp = WB + ((s * 3 + nt) * 2) * 1024 + lane * 16;
                    const bf16x8 bh = *(const LAS bf16x8*)bp, bl = *(const LAS bf16x8*)(bp + 1024);
                    acc[gi][nt] = __builtin_amdgcn_mfma_f32_16x16x32_bf16(xa[s], bh, acc[gi][nt], 0, 0, 0);
                    acc[gi][nt] = __builtin_amdgcn_mfma_f32_16x16x32_bf16(xa[s], bl, acc[gi][nt], 0, 0, 0); } }
        }
    }
#pragma unroll
    for (int gi = 0; gi < 2; ++gi)
#pragma unroll
        for (int nt = 0; nt < 3; ++nt) { const int o = 16 * nt + tk;
            if (o < 36) {
#pragma unroll
                for (int r = 0; r < 4; ++r) LG[(wave * 32 + gi * 16 + 4 * g + r) * 36 + o] = acc[gi][nt][r]; } }
    MOE_SYNC();
    if (wave < 4) { const int tr = wave * 64 + lane, tg = chunk * 256 + tr; const LAS float* lg = LG + tr * 36;
        const f32x4* sp = (const f32x4*)(ssq2 + (size_t)tg * 16); const f32x4 st = (sp[0] + sp[1]) + (sp[2] + sp[3]);
        const float rs = 1.0f / sqrtf(((st[0] + st[1]) + (st[2] + st[3])) * (1.f / D) + NORM_EPS);
        tok_rs[tg] = rs;
        float gl[4];
#pragma unroll
        for (int j = 0; j < 4; ++j) gl[j] = lg[32 + j] * rs + b_group[j];
        float gm = gl[0]; int gi = 0;
#pragma unroll
        for (int j = 1; j < 4; ++j) { if (gl[j] > gm) { gm = gl[j]; gi = j; } }
        float den = 0.f;
#pragma unroll
        for (int j = 0; j < 4; ++j) den += __expf(gl[j] - gm);
        const float gp = 1.0f / den;
        float v0 = -3.0e38f, v1 = -3.0e38f; int i0 = 0, i1 = 0;
#pragma unroll
        for (int j = 0; j < 8; ++j) { const float v = lg[gi * 8 + j] * rs + b_router[gi * 8 + j];
            if (v > v0) { v1 = v0; i1 = i0; v0 = v; i0 = j; } else if (v > v1) { v1 = v; i1 = j; } }
        const float dd = __expf(v1 - v0), g0 = gp / (1.f + dd), g1 = gp * dd / (1.f + dd);
        const int e0 = gi * 8 + i0, e1 = gi * 8 + i1;
        __hip_atomic_fetch_add(HS + e0, 1, __ATOMIC_RELAXED, __HIP_MEMORY_SCOPE_WORKGROUP); __hip_atomic_fetch_add(HS + e1, 1, __ATOMIC_RELAXED, __HIP_MEMORY_SCOPE_WORKGROUP);
        tok_e[tg] = e0 | (e1 << 8); tok_gate[2 * tg] = g0; tok_gate[2 * tg + 1] = g1; }
    MOE_SYNC();
    if (tid < 32) hist[chunk * 32 + tid] = HS[tid];
}
__device__ __forceinline__ void slot_chunk(LAS unsigned char* lds, const int* hist, const int* tok_e, const float* tok_gate, const float* tok_rs, int* tok_slot, int* row_tok, float* slot_rs, float* slot_gate, int* etile,
                                           int chunk, int tid, int wave, int lane) {
    LAS int* CNT = (LAS int*)lds; LAS int* BASE = CNT + 32; LAS int* PST = CNT + 64; LAS int* WC = CNT + 128;
    MOE_SYNC();
    if (tid < 32) { int tot = 0, bs = 0; for (int cc = 0; cc < 256; ++cc) { const int hh = hist[cc * 32 + tid]; bs += (cc < chunk) ? hh : 0; tot += hh; } CNT[tid] = tot; BASE[tid] = bs; }
    MOE_SYNC();
    if (tid == 0) { int ps = 0; for (int e = 0; e < 32; ++e) { PST[e] = ps; ps += ((CNT[e] + 255) >> 8) << 8; } PST[32] = ps; }
    MOE_SYNC();
    int ek[2] = {0, 0}, rank[2] = {0, 0}; const int t = chunk * 256 + (wave & 3) * 64 + lane;
    if (wave < 4) { const int ev = tok_e[t]; ek[0] = ev & 255; ek[1] = ev >> 8;
#pragma unroll
        for (int k = 0; k < 2; ++k)
#pragma nounroll
            for (int e = 0; e < 32; ++e) { const unsigned long long m = __ballot(ek[k] == e);
                if (ek[k] == e) rank[k] = __popcll(m & ((1ull << lane) - 1ull));
                if (lane == 0) WC[(k * 4 + wave) * 32 + e] = __popcll(m); } }
    MOE_SYNC();
    if (wave < 4) {
#pragma unroll
        for (int k = 0; k < 2; ++k) { int off = 0;
            for (int kw = 0; kw < k * 4 + wave; ++kw) off += WC[kw * 32 + ek[k]];
            const int slot = PST[ek[k]] + BASE[ek[k]] + off + rank[k];
            row_tok[slot] = t; slot_rs[slot] = tok_rs[t]; slot_gate[slot] = tok_gate[2 * t + k]; tok_slot[2 * t + k] = slot; } }
    if (chunk < 32) { const int e = chunk, c0 = PST[e] + CNT[e], n = PST[e + 1] - c0;
        for (int i = tid; i < n; i += NWAVES * 64) { row_tok[c0 + i] = 0; slot_rs[c0 + i] = 0.f; slot_gate[c0 + i] = 0.f; } }
    if (chunk == 0 && tid <= 32) etile[tid] = PST[tid] >> 8;
}
__device__ __forceinline__ void final_row(float* xo, const bf16_t* X2, const bf16_t* Y, const int* tok_slot, const float* g, int t, int lane) {
    const int s0 = tok_slot[2 * t], s1 = tok_slot[2 * t + 1];
    f32x4* xr = (f32x4*)(xo + (size_t)t * D) + lane; const u32x2* x2 = (const u32x2*)(X2 + (size_t)t * D) + lane;
    const u32x2* y0 = (const u32x2*)(Y + (size_t)s0 * D) + lane; const u32x2* y1 = (const u32x2*)(Y + (size_t)s1 * D) + lane;
    const f32x4* gr = (const f32x4*)g + lane;
    f32x4 v[4]; float s = 0.f;
#pragma unroll
    for (int j = 0; j < 4; ++j) { const u32x2 x = x2[64 * j], a = y0[64 * j], b = y1[64 * j];
        v[j][0] = bflo(x.x) + (bflo(a.x) + bflo(b.x)); v[j][1] = bfhi(x.x) + (bfhi(a.x) + bfhi(b.x)); v[j][2] = bflo(x.y) + (bflo(a.y) + bflo(b.y)); v[j][3] = bfhi(x.y) + (bfhi(a.y) + bfhi(b.y));
        s += (v[j][0] * v[j][0] + v[j][1] * v[j][1]) + (v[j][2] * v[j][2] + v[j][3] * v[j][3]); }
    const float rs = 1.0f / sqrtf(wave_sum(s) * (1.f / D) + NORM_EPS);
#pragma unroll
    for (int j = 0; j < 4; ++j) xr[64 * j] = v[j] * rs * gr[64 * j];
}
}
#ifndef MK_N_LAUNCHES
#define MK_N_LAUNCHES 1
#endif
constexpr int NPH = 11;
constexpr int N_LAUNCHES = MK_N_LAUNCHES;

#define ARG_IN(k) karg_ptr(8 * (k))
#define ARG_OUT ((float*)karg_ptr(8 * 27))
#define ARG_WS ((unsigned char*)karg_ptr(8 * 28))
template <int LO, int HI>
__global__ void __launch_bounds__(NWAVES * 64, 2) mega_fwd(Args args) {
    extern __shared__ __attribute__((aligned(16))) unsigned char lds_raw[];
    Frame F;
    F.lds = (LAS unsigned char*)lds_raw;
    F.MISC = (volatile LAS unsigned*)(F.lds + LDSCTL_OFF);
    F.wave = __builtin_amdgcn_readfirstlane((int)threadIdx.x >> 6);
    F.G = gridDim.x; { const int bx = blockIdx.x; F.vcu = (F.G % 8 == 0) ? (bx % 8) * (F.G / 8) + bx / 8 : bx; }
    F.ws = ARG_WS; F.ctl = (unsigned*)(ARG_WS + WS_CTL);
    for (int u = threadIdx.x; u < (LDS_BYTES - LDSCTL_OFF) / 4; u += NWAVES * 64) ((LAS unsigned*)(F.lds + LDSCTL_OFF))[u] = 0u;
    __syncthreads();
    XcdBarrier bar; bar.bar = F.ctl + CW_BAR; bar.x = 0; bar.st = nullptr;
    if (HI - LO > 1) bar = xcd_barrier_post(F.ctl + CW_BAR, F.MISC + 8);
#define GRID_BAR() do { if (HI - LO > 1) xcd_barrier(bar); } while (0)
#ifndef PH_MASK
#define PH_MASK 0x7ff
#endif
#define IN(k) ((((PH_MASK) >> (k)) & 1) && LO <= (k) && (k) < HI)
#define BOTH(k) (IN(k) && IN((k) + 1))
#ifndef DUP_PHASE
#define DUP_PHASE -1
#endif
#define DUPF(k) ((k) == DUP_PHASE ? 2 : 1)
    const int gw = F.vcu * NWAVES + F.wave, NGW = F.G * NWAVES;
#define R1 ((bf16_t*)(ARG_WS + WS_R1))
#define R2 ((bf16_t*)(ARG_WS + WS_R2))
#define ssqa ((float*)(ARG_WS + WS_SSQA))
#define ssq1 ((float*)(ARG_WS + WS_SSQ1))
#define ssq2 ((float*)(ARG_WS + WS_SSQ2))
#define tok_e ((int*)(ARG_WS + WS_TOK + TK_E))
#define tok_gate ((float*)(ARG_WS + WS_TOK + TK_GATE))
#define tok_slot ((int*)(ARG_WS + WS_TOK + TK_SLOT))
#define tok_rs ((float*)(ARG_WS + WS_TOK + TK_RS))
#define row_tok ((int*)(ARG_WS + WS_TOK + TK_ROWTOK))
#define slot_rs ((float*)(ARG_WS + WS_TOK + TK_SLOTRS))
#define slot_gate ((float*)(ARG_WS + WS_TOK + TK_SLOTGATE))
#define hist ((int*)(ARG_WS + WS_HIST))
#define etile ((int*)(ARG_WS + WS_HIST + HIST_ETILE))
#define WR ((const bf16_t*)(ARG_WS + WS_HIST + HIST_WR))

    if (IN(0)) { p0_prologue(F); if (DUPF(0) == 2) { asm volatile("s_waitcnt vmcnt(0)" ::: "memory"); __syncthreads(); p0_prologue(F); } if (BOTH(0)) GRID_BAR(); }

    if (IN(1)) {
        { pg8::GridOrder S; S.init(R1, ARG_WS + WS_WIN, D, D, T, INW, F.G, (int)blockIdx.x); S.dup = DUPF(1);
          pg8::EpiU E{R2, (bf16_t*)(ARG_WS + WS_Q), (bf16_t*)(ARG_WS + WS_K), (bf16_t*)(ARG_WS + WS_V), (const float*)(ARG_WS + WS_ROPE), (const float*)(ARG_WS + WS_ROPE) + SEQ * 32};
          pg8::gemm_phase<pg8::EpiU, pg8::GridOrder, false, false>(F.lds, F.wave, D, D, D, S, E); }
        { pg8::KvOrder S{(const char*)(ARG_WS + WS_MEMN), (const char*)(ARG_WS + WS_WXK), (const char*)(ARG_WS + WS_WXV), F.G, (int)blockIdx.x};
          pg8::EpiPlain<false> E{(bf16_t*)(ARG_WS + WS_KX), D, (bf16_t*)(ARG_WS + WS_VX), D, nullptr};
          pg8::gemm_phase<pg8::EpiPlain<false>, pg8::KvOrder, true, false>(F.lds, F.wave, D, D, D, S, E); }
        if (BOTH(1)) GRID_BAR();
    }

    if (IN(2)) {
        { pg8::MnOrder S{(const char*)(ARG_WS + WS_KX), (const char*)(ARG_WS + WS_WXQ), (const char*)(ARG_WS + WS_WXO), (const char*)(ARG_WS + WS_VX), F.G, F.vcu, 1};
          pg8::EpiPlain<false> E{(bf16_t*)(ARG_WS + WS_MT), D, (bf16_t*)(ARG_WS + WS_NT), D, nullptr};
          pg8::gemm_phase<pg8::EpiPlain<false>, pg8::MnOrder, true, false>(F.lds, F.wave, D, D, XHD, S, E); }
        att::d16_phase(F.lds, (const bf16_t*)(ARG_WS + WS_Q), (const bf16_t*)(ARG_WS + WS_K), (const bf16_t*)(ARG_WS + WS_V), R1, (float*)(ARG_WS + WS_SSQ1), F.vcu, F.G, DUPF(20), F.wave, lane_id());
        asm volatile("s_waitcnt vmcnt(0) lgkmcnt(0)" ::: "memory"); __syncthreads();
        GRID_BAR();
        for (int L0 = F.vcu; L0 < NB * NH * 8; L0 += F.G) { const int L = L0 % (NB * NH * 8); const int chunk = L & 7, bh = L >> 3, b = bh / NH, h = bh % NH;
            att::attn_unit(F.lds, (const bf16_t*)(ARG_WS + WS_Q), (const bf16_t*)(ARG_WS + WS_K), (const bf16_t*)(ARG_WS + WS_V), R1, ssqa, (const float*)(ARG_WS + WS_SSQ1), b, h, chunk * 512, F.wave * 64 + lane_id(), F.wave, lane_id()); }
        for (int L = F.vcu; L < NB * 64; L += F.G) { const int b = L >> 6, j = L & 63;
            att::conv_unit(F.lds, R2, R1, (const float*)ARG_IN(5), (const float*)ARG_IN(6), (const float*)ARG_IN(7), (const float*)ARG_IN(8), (const float*)ARG_IN(9), b, j * 64, F.wave * 64 + lane_id(), F.wave, lane_id()); }
        asm volatile("s_waitcnt vmcnt(0) lgkmcnt(0)" ::: "memory"); __syncthreads();
        if (BOTH(2)) GRID_BAR();
    }

    if (IN(3)) {
        pg8::GridOrder S; S.init(R1, ARG_WS + WS_WOUT, D, D, T, D, F.G, (int)blockIdx.x); S.dup = DUPF(3);
        pg8::EpiResid<true> E{(const float*)ARG_IN(0), R2, ssq1, ssqa};
        pg8::gemm_phase<pg8::EpiResid<true>, pg8::GridOrder, true, false>(F.lds, F.wave, D, D, D, S, E);
        if (BOTH(3)) GRID_BAR();
    }

    if (IN(4)) {
        pg8::BatchOrder S{(const char*)R2, (const char*)(ARG_WS + WS_MT), (T / 256) * 4, F.G, (int)blockIdx.x, DUPF(4)};
        pg8::EpiSoftmax E{(bf16_t*)(ARG_WS + WS_PM), ssq1};
        pg8::gemm_phase<pg8::EpiSoftmax, pg8::BatchOrder, true, false>(F.lds, F.wave, D, D, D, S, E);
        if (BOTH(4)) GRID_BAR();
    }

    if (IN(5)) {
        pg8::BatchOrder S{(const char*)(ARG_WS + WS_PM), (const char*)(ARG_WS + WS_NT), (T / 256) * 4, F.G, (int)blockIdx.x, 1};
        pg8::EpiResid<false> E{nullptr, R2, ssq2, nullptr};
        pg8::gemm_phase<pg8::EpiResid<false>, pg8::BatchOrder, true, false>(F.lds, F.wave, D, D, D, S, E);
        if (BOTH(5)) GRID_BAR();
    }

    if (IN(6)) {
        for (int c0_ = blockIdx.x; c0_ < (T / 256) * DUPF(6); c0_ += F.G) { const int c = c0_ % (T / 256);
            moe::route_chunk(F.lds, R2, ssq2, WR, (const float*)ARG_IN(22), (const float*)ARG_IN(20), tok_e, tok_gate, tok_rs, hist, c, F.wave * 64 + lane_id(), F.wave, lane_id()); }
        asm volatile("s_waitcnt vmcnt(0) lgkmcnt(0)" ::: "memory"); __syncthreads();
        if (BOTH(6)) GRID_BAR();
    }

    if (IN(7)) {
        for (int c1_ = blockIdx.x; c1_ < (T / 256) * DUPF(7); c1_ += F.G) { const int c = c1_ % (T / 256);
            moe::slot_chunk(F.lds, hist, tok_e, tok_gate, tok_rs, tok_slot, row_tok, slot_rs, slot_gate, etile, c, F.wave * 64 + lane_id(), F.wave, lane_id()); }
        asm volatile("s_waitcnt vmcnt(0) lgkmcnt(0)" ::: "memory"); __syncthreads();
        if (BOTH(7)) GRID_BAR();
    }

    if (IN(8)) {
        pg8::MoeOrder<0> S{(const char*)R2, (const char*)(ARG_WS + WS_W13), row_tok, etile, F.G, (int)blockIdx.x, DUPF(8)};
        pg8::EpiMoe1 E{(bf16_t*)(ARG_WS + WS_HID), slot_rs};
        pg8::gemm_phase<pg8::EpiMoe1, pg8::MoeOrder<0>, true, true>(F.lds, F.wave, D, D, D, S, E);
        if (BOTH(8)) GRID_BAR();
    }

    if (IN(9)) {
        pg8::MoeOrder<1> S{(const char*)(ARG_WS + WS_HID), (const char*)(ARG_WS + WS_W2), row_tok, etile, F.G, (int)blockIdx.x, DUPF(9)};
        pg8::EpiMoe2 E{(bf16_t*)(ARG_WS + WS_Y), slot_gate};
        pg8::gemm_phase<pg8::EpiMoe2, pg8::MoeOrder<1>, true, false>(F.lds, F.wave, FF, FF, FF, S, E);
        if (BOTH(9)) GRID_BAR();
    }

    if (IN(10)) {
        for (int t0_ = gw; t0_ < T * DUPF(10); t0_ += NGW) { const int t = t0_ % T; moe::final_row(ARG_OUT, R2, (const bf16_t*)(ARG_WS + WS_Y), tok_slot, (const float*)ARG_IN(26), t, lane_id()); }
    }
#undef IN
#undef BOTH
}

typedef void (*kern_t)(Args);
template <int... I> struct PhList {};
extern "C" void kernel_launch(void* const* d_in, const int* in_sizes, int n_in, void* d_out, int out_size, void* d_ws, size_t ws_size, hipStream_t stream) {
    static int grid = 0;
#if MK_N_LAUNCHES == 1
    static const kern_t kerns[1] = {mega_fwd<0, NPH>};
#else
    static const kern_t kerns[NPH] = {mega_fwd<0, 1>, mega_fwd<1, 2>, mega_fwd<2, 3>, mega_fwd<3, 4>, mega_fwd<4, 5>, mega_fwd<5, 6>, mega_fwd<6, 7>, mega_fwd<7, 8>, mega_fwd<8, 9>, mega_fwd<9, 10>, mega_fwd<10, 11>};
#endif
    if (grid == 0) {
        if (n_in != 27 || in_sizes[0] != T * D || out_size != T * D || ws_size < WS_END) { fprintf(stderr, "kernel_launch: unexpected problem: n_in %d in0 %d out %d ARG_WS %zu (need %zu)\n", n_in, n_in > 0 ? in_sizes[0] : -1, out_size, ws_size, (size_t)WS_END); grid = -1; return; }
        int dev = 0, cus = 0, per_cu = 0;
        if (hipGetDevice(&dev) != hipSuccess || hipDeviceGetAttribute(&cus, hipDeviceAttributeMultiprocessorCount, dev) != hipSuccess) { grid = -1; return; }
        for (int li = 0; li < N_LAUNCHES; ++li)
            if (hipFuncSetAttribute((const void*)kerns[li], hipFuncAttributeMaxDynamicSharedMemorySize, LDS_BYTES) != hipSuccess) { fprintf(stderr, "kernel_launch: hipFuncSetAttribute failed\n"); grid = -1; return; }
        if (hipOccupancyMaxActiveBlocksPerMultiprocessor(&per_cu, (const void*)kerns[0], NWAVES * 64, LDS_BYTES) != hipSuccess || per_cu < 1) { fprintf(stderr, "kernel_launch: occupancy query says %d\n", per_cu); }
        (void)hipGetLastError();
        grid = cus;
    }
    if (grid < 0) return;
    if (hipMemsetAsync((char*)d_ws + WS_CTL, 0, CTL_ZERO_BYTES, stream) != hipSuccess) return;
    Args a{};
    for (int i = 0; i < 27; ++i) a.in[i] = d_in[i];
    a.out = (float*)d_out; a.ws = (unsigned char*)d_ws;
    for (int li = 0; li < N_LAUNCHES; ++li) {
        a.ph_lo = 0; a.ph_hi = 0; a.li = li; a.pad = 0;
        hipLaunchKernelGGL(kerns[li], dim3(grid), dim3(NWAVES * 64), LDS_BYTES, stream, a);
        const hipError_t le = hipPeekAtLastError();
        if (le != hipSuccess) { fprintf(stderr, "kernel_launch: launch %d failed: %s\n", li, hipGetErrorName(le)); break; }
    }
}
```

```cpp
#include <hip/hip_runtime.h>
#include <cstdio>
#include <cstdint>

#define GAS __attribute__((address_space(1)))
#define LAS __attribute__((address_space(3)))
typedef unsigned short bf16_t;
typedef short bf16x8 __attribute__((ext_vector_type(8)));
typedef short s16x4 __attribute__((ext_vector_type(4)));
typedef float f32x4 __attribute__((ext_vector_type(4)));
typedef float f32x2 __attribute__((ext_vector_type(2)));
typedef unsigned u32x4 __attribute__((ext_vector_type(4)));
typedef unsigned u32x2 __attribute__((ext_vector_type(2)));

constexpr int NB = 16, SEQ = 4096, T = NB * SEQ, D = 1024;
constexpr int CCH = 256, NH = 12, HD = 64, AW = NH * HD, INW = 2 * CCH + 3 * AW;
constexpr int MEML = 256, MROWS = NB * MEML, XH = 4, XHD = 256;
constexpr int NE = 32, EPG = 8, NG = 4, FF = 512;
constexpr int CONVK = 31;
constexpr int A_PAD = T * 2 + NE * 256;
constexpr float NORM_EPS = 1e-6f, LN_EPS = 1e-5f;
constexpr float LOG2E = 1.4426950408889634f;

constexpr size_t MiB = 1u << 20;
constexpr size_t WS_CTL = 0, CTL_ZERO_BYTES = 1 * MiB;
constexpr size_t WS_ROPE = 1 * MiB;
constexpr size_t WS_HIST = 2 * MiB;
constexpr size_t WS_SSQA = 4 * MiB;
constexpr size_t WS_SSQ1 = 8 * MiB;
constexpr size_t WS_SSQ2 = 12 * MiB;
constexpr size_t WS_WIN = 16 * MiB, WS_WOUT = 22 * MiB, WS_WXQ = 24 * MiB, WS_WXK = 26 * MiB, WS_WXV = 28 * MiB, WS_WXO = 30 * MiB;
constexpr size_t WS_W13 = 32 * MiB, WS_W2 = 96 * MiB;
constexpr size_t WS_MEMN = 128 * MiB, WS_KX = 136 * MiB, WS_VX = 144 * MiB;
constexpr size_t WS_TOK = 152 * MiB;
constexpr size_t WS_R1 = 160 * MiB;
constexpr size_t WS_R2 = 288 * MiB;
constexpr size_t WS_Q = 320 * MiB, WS_K = 416 * MiB, WS_V = 512 * MiB;
constexpr size_t WS_MT = 672 * MiB, WS_NT = 704 * MiB;
constexpr size_t WS_PM = 544 * MiB;
constexpr size_t WS_HID = 416 * MiB;
constexpr size_t WS_Y = 552 * MiB;
constexpr size_t WS_END = 824 * MiB;
constexpr size_t TK_E = 0;
constexpr size_t TK_GATE = 1 * MiB;
constexpr size_t TK_SLOT = 2 * MiB;
constexpr size_t TK_RS = 3 * MiB;
constexpr size_t TK_ROWTOK = 4 * MiB;
constexpr size_t TK_SLOTRS = 5 * MiB;
constexpr size_t TK_SLOTGATE = 6 * MiB;
constexpr size_t HIST_ETILE = 64 * 1024, HIST_WR = 128 * 1024;

constexpr int CW_BAR = 4096;

constexpr int NWAVES = 8;
constexpr int RING_BYTES = 131072;
constexpr int XCH_OFF = RING_BYTES;
constexpr int LDSCTL_OFF = RING_BYTES + 12288;
constexpr int LDS_BYTES = 147456;

#define LDS_WAIT() asm volatile("s_waitcnt lgkmcnt(0)" ::: "memory")
#define VM_WAIT() asm volatile("s_waitcnt vmcnt(0)" ::: "memory")
__device__ __forceinline__ unsigned f2bf(float f) { unsigned u = __builtin_bit_cast(unsigned, f); return (u + 0x7fffu + ((u >> 16) & 1u)) >> 16; }
__device__ __forceinline__ unsigned pk2(float lo, float hi) { return f2bf(lo) | (f2bf(hi) << 16); }
__device__ __forceinline__ float bf2f(unsigned short b) { return __builtin_bit_cast(float, (unsigned)b << 16); }
__device__ __forceinline__ float bflo(unsigned w) { return __builtin_bit_cast(float, w << 16); }
__device__ __forceinline__ float bfhi(unsigned w) { return __builtin_bit_cast(float, w & 0xffff0000u); }
typedef __bf16 bf16x2_t __attribute__((ext_vector_type(2)));
__device__ __forceinline__ unsigned cvt_pk_bf16(float lo, float hi) { const f32x2 v = {lo, hi}; return __builtin_bit_cast(unsigned, __builtin_convertvector(v, bf16x2_t)); }
__device__ __forceinline__ float wave_sum(float v) {
#pragma unroll
    for (int o = 1; o < 64; o <<= 1) v += __shfl_xor(v, o);
    return v;
}
__device__ __forceinline__ int lane_id() { return (int)__builtin_amdgcn_mbcnt_hi(~0u, __builtin_amdgcn_mbcnt_lo(~0u, 0u)); }
#define MK_N_LAUNCHES 1
namespace pg8 {
constexpr int BM = 256, BK = 64, HALF = 128, HTB = HALF * BK * 2  , STAGE_BYTES = 8 * HTB, NXCD = 8, WGM = 8;

__host__ __device__ __forceinline__ int lds_byte(int r, int c) { const int st = (r >> 4) * 2 + (c >> 5), rr = r & 15, cc = c & 31, ob = rr * 64 + cc * 2; return st * 1024 + (ob ^ (((ob >> 9) & 1) << 5)); }
__host__ __device__ __forceinline__ void stage_rc(int b, int& R, int& C) { const int st = b / 1024, sb = b % 1024, swz = sb ^ (((sb >> 9) & 1) << 5); R = (st >> 1) * 16 + swz / 64; C = (st & 1) * 32 + (swz % 64) / 2; }
__host__ __device__ __forceinline__ int perm32(int rho) { const int n = rho >> 4, i = rho & 15; return 8 * (i >> 2) + 4 * n + (i & 3); }

struct Unit { const char* a; const char* b; const int* rows; int pm, pn, x0, x1; };

typedef f32x4 Acc[2][2][4][2];

__device__ __forceinline__ const char* uniform_ptr(const char* p) { const unsigned long long v = (unsigned long long)p;
    const unsigned lo = __builtin_amdgcn_readfirstlane((unsigned)v), hi = __builtin_amdgcn_readfirstlane((unsigned)(v >> 32)); return (const char*)(((unsigned long long)hi << 32) | lo); }
__device__ __forceinline__ void glds16_sv(const char* gbase, unsigned voff, unsigned lds_dst) { unsigned keep;
    asm volatile("s_mov_b32 %0, m0\n\ts_mov_b32 m0, %3\n\ts_nop 2\n\tglobal_load_lds_dwordx4 %1, %2\n\ts_mov_b32 m0, %0" : "=&s"(keep) : "v"(voff), "s"(gbase), "s"(lds_dst) : "memory"); }
template <class Epi, class Sched, bool ALIGN_EPI, bool GATHER>
__device__ __forceinline__ void gemm_phase(LAS unsigned char* lds, const int wave_, const int lda, const int ldb, const int K, const Sched& S, const Epi& E) {
    int lane_ = lane_id(); asm volatile("" : "+v"(lane_));
    const int wid = __builtin_amdgcn_readfirstlane(wave_), tid = wid * 64 + lane_, lane = tid & 63, wr = wid >> 2, wc = wid & 3, fr = lane & 15, fq = lane >> 4;
    const int nt = K / BK;
    int Rr[2], Cc[2];
    unsigned vA[2][2], vN[2][2], voffB[2];
#pragma unroll
    for (int i = 0; i < 2; ++i) { int R, C; stage_rc(tid * 16 + i * 8192, R, C); Rr[i] = R; Cc[i] = C; const int Rb = Epi::PERM ? ((R & ~31) + perm32(R & 31)) : R;
        voffB[i] = (unsigned)(Rb * ldb + C) * 2u; }
    const size_t kstep = (size_t)(BK * 2);
    const size_t hstepB = (size_t)HALF * ldb * 2, hstepA = (size_t)HALF * lda * 2;
    const unsigned ldsw = (unsigned)wid * 1024u, lds0 = (unsigned)(uintptr_t)lds;
    const int aoff = lds_byte(wr * 64 + fr, fq * 8), boff = lds_byte(wc * 32 + fr, fq * 8);
#define PG8_SA(b, h) (((b) * 2 + (h)) * HTB)
#define PG8_SB(b, h) ((4 + (b) * 2 + (h)) * HTB)
#define PG8_STAGE(bufoff, gbase, voff) do { _Pragma("unroll") for (int _i = 0; _i < 2; ++_i) glds16_sv((gbase), (voff)[_i], lds0 + (unsigned)(bufoff) + ldsw + _i * 8192u); } while (0)
#define PG8_LDA(dst, b, h) do { _Pragma("unroll") for (int m = 0; m < 4; ++m) _Pragma("unroll") for (int k = 0; k < 2; ++k) dst[m][k] = *(const LAS bf16x8*)(lds + PG8_SA(b, h) + aoff + m * 2048 + k * 1024); } while (0)
#define PG8_LDB(dst, b, h) do { _Pragma("unroll") for (int n = 0; n < 2; ++n) _Pragma("unroll") for (int k = 0; k < 2; ++k) dst[n][k] = *(const LAS bf16x8*)(lds + PG8_SB(b, h) + boff + n * 2048 + k * 1024); } while (0)
#define PG8_MMA(ai, bj, At, Bt) do { __builtin_amdgcn_s_setprio(1); _Pragma("unroll") for (int m = 0; m < 4; ++m) _Pragma("unroll") for (int n = 0; n < 2; ++n) _Pragma("unroll") for (int k = 0; k < 2; ++k) \
        acc[ai][bj][m][n] = __builtin_amdgcn_mfma_f32_16x16x32_bf16(Bt[n][k], At[m][k], acc[ai][bj][m][n], 0, 0, 0); __builtin_amdgcn_s_setprio(0); } while (0)
#define PG8_WAIT_V(n) asm volatile("s_waitcnt vmcnt(" #n ")" ::: "memory")
#define PG8_WAIT_L(n) asm volatile("s_waitcnt lgkmcnt(" #n ")" ::: "memory")
#define PG8_BAR __builtin_amdgcn_s_barrier()
#define PG8_SCHED __builtin_amdgcn_sched_barrier(0)
#define PG8_VOFF(dst, u) do { _Pragma("unroll") for (int _h = 0; _h < 2; ++_h) _Pragma("unroll") for (int _i = 0; _i < 2; ++_i) { \
        if constexpr (GATHER) dst[_h][_i] = (unsigned)(u).rows[_h * HALF + Rr[_i]] * (unsigned)(lda * 2) + (unsigned)(Cc[_i] * 2); \
        else dst[_h][_i] = (unsigned)(Rr[_i] * lda + Cc[_i]) * 2u; } } while (0)
#define PG8_STAGE_A(bufoff, gbase, h, vv) do { if constexpr (GATHER) { PG8_STAGE(bufoff, gbase, vv[h]); } else { PG8_STAGE(bufoff, (gbase) + (h) * hstepA, vv[0]); } } while (0)
    Unit cur, nxt; int ui = 0;
    if (!S.next(0, cur)) return;
    Acc acc;
#pragma unroll
    for (int a = 0; a < 2; ++a)
#pragma unroll
        for (int b = 0; b < 2; ++b)
#pragma unroll
            for (int m = 0; m < 4; ++m)
#pragma unroll
                for (int n = 0; n < 2; ++n) acc[a][b][m][n] = (f32x4){0.f, 0.f, 0.f, 0.f};
    bf16x8 At[4][2], B0[2][2], B1[2][2];
    const char* cA = uniform_ptr(cur.a); const char* cB = uniform_ptr(cur.b);
    PG8_VOFF(vA, cur);
    if constexpr (GATHER) { asm volatile("s_waitcnt vmcnt(0)" ::: "memory"); }
    PG8_STAGE(PG8_SB(0, 0), cB, voffB); PG8_STAGE(PG8_SB(0, 1), cB + hstepB, voffB); PG8_STAGE_A(PG8_SA(0, 0), cA, 0, vA); PG8_STAGE_A(PG8_SA(0, 1), cA, 1, vA);
    if (wr == 1) PG8_BAR;
    PG8_WAIT_V(2); PG8_BAR;
    PG8_STAGE(PG8_SB(1, 0), cB + kstep, voffB); PG8_STAGE_A(PG8_SA(1, 0), cA + kstep, 0, vA); PG8_STAGE(PG8_SB(1, 1), cB + hstepB + kstep, voffB);
    PG8_WAIT_V(6); PG8_BAR;
    for (;;) {
        const bool has_next = S.next(ui + 1, nxt);
        const char* nA = has_next ? uniform_ptr(nxt.a) : cA; const char* nB = has_next ? uniform_ptr(nxt.b) : cB;
        if constexpr (GATHER) { if (has_next) { PG8_VOFF(vN, nxt); } else {
#pragma unroll
            for (int h = 0; h < 2; ++h) { vN[h][0] = vA[h][0]; vN[h][1] = vA[h][1]; } } }
#pragma nounroll
        for (int t = 0; t < nt; t += 2) {
            const bool last = (t == nt - 2);
            if constexpr (Epi::HAS_MID) { if (t == E.mid_t()) E.mid(acc, cur, wr, wc, fr, fq); }
            const char* a1 = cA + (size_t)(t + 1) * kstep;
            const char* a2 = last ? nA : cA + (size_t)(t + 2) * kstep; const char* b2 = last ? nB : cB + (size_t)(t + 2) * kstep;
            const char* a3 = a2 + kstep; const char* b3 = b2 + kstep;
            unsigned vW[2][2];
#pragma unroll
            for (int h = 0; h < 2; ++h) { vW[h][0] = vA[h][0]; vW[h][1] = vA[h][1]; if constexpr (GATHER) { if (last) { vW[h][0] = vN[h][0]; vW[h][1] = vN[h][1]; } } }
            PG8_LDB(B0, 0, 0); PG8_LDB(B1, 0, 1); PG8_SCHED; PG8_LDA(At, 0, 0); PG8_STAGE_A(PG8_SA(1, 1), a1, 1, vA);
            PG8_WAIT_V(8); PG8_WAIT_L(0); PG8_BAR; PG8_MMA(0, 0, At, B0); PG8_MMA(0, 1, At, B1); PG8_BAR; PG8_SCHED;
            PG8_LDA(At, 0, 1); PG8_STAGE(PG8_SB(0, 0), b2, voffB); PG8_STAGE(PG8_SB(0, 1), b2 + hstepB, voffB); PG8_STAGE_A(PG8_SA(0, 0), a2, 0, vW);
            PG8_WAIT_V(8); PG8_WAIT_L(0); PG8_BAR; PG8_MMA(1, 0, At, B0); PG8_MMA(1, 1, At, B1); PG8_BAR; PG8_SCHED;
            PG8_LDB(B0, 1, 0); PG8_LDB(B1, 1, 1); PG8_SCHED; PG8_LDA(At, 1, 0); PG8_STAGE_A(PG8_SA(0, 1), a2, 1, vW);
            PG8_WAIT_V(8); PG8_WAIT_L(0); PG8_BAR; PG8_MMA(0, 0, At, B0); PG8_MMA(0, 1, At, B1); PG8_BAR; PG8_SCHED;
            PG8_LDA(At, 1, 1); PG8_STAGE(PG8_SB(1, 0), b3, voffB); PG8_STAGE(PG8_SB(1, 1), b3 + hstepB, voffB); PG8_STAGE_A(PG8_SA(1, 0), a3, 0, vW);
            PG8_WAIT_V(8); PG8_WAIT_L(0); PG8_BAR; PG8_MMA(1, 0, At, B0); PG8_MMA(1, 1, At, B1); PG8_BAR; PG8_SCHED;
        }
        if constexpr (ALIGN_EPI) { if (wr == 0) PG8_BAR; }
        E(acc, cur, wr, wc, fr, fq, lds, wid, lane);
        if (!has_next) break;
#pragma unroll
        for (int a = 0; a < 2; ++a)
#pragma unroll
            for (int b = 0; b < 2; ++b)
#pragma unroll
                for (int m = 0; m < 4; ++m)
#pragma unroll
                    for (int n = 0; n < 2; ++n) acc[a][b][m][n] = (f32x4){0.f, 0.f, 0.f, 0.f};
        cur = nxt; cA = nA; cB = nB; ++ui;
        if constexpr (GATHER) {
#pragma unroll
            for (int h = 0; h < 2; ++h) { vA[h][0] = vN[h][0]; vA[h][1] = vN[h][1]; } }
        if constexpr (ALIGN_EPI) { if (wr == 1) PG8_BAR; }
    }
    PG8_WAIT_V(0);
    if constexpr (!ALIGN_EPI) { if (wr == 0) PG8_BAR; }
    PG8_BAR;
#undef PG8_SA
#undef PG8_SB
#undef PG8_STAGE
#undef PG8_LDA
#undef PG8_LDB
#undef PG8_MMA
#undef PG8_WAIT_V
#undef PG8_WAIT_L
#undef PG8_BAR
#undef PG8_SCHED
#undef PG8_VOFF
#undef PG8_STAGE_A
}
}
#define XB_TMO      128
#define XB_XCNT(j)  (256  + 64 * (j))
#define XB_XSUB(j)  (1280 + 64 * (j))
#define XB_XGEN(j)  (2304 + 64 * (j))
#define XB_TOP      3328
#define XB_TOPGEN   3392
#define XCD_BAR_WORDS 3456
#define XB_SPIN_CAP (1u << 18)

__device__ __forceinline__ unsigned xb_ld(unsigned* p)              { return __hip_atomic_load(p, __ATOMIC_RELAXED, __HIP_MEMORY_SCOPE_AGENT); }
__device__ __forceinline__ unsigned xb_add(unsigned* p, unsigned v) { return __hip_atomic_fetch_add(p, v, __ATOMIC_RELAXED, __HIP_MEMORY_SCOPE_AGENT); }
__device__ __forceinline__ unsigned xb_xcc_id() { return (unsigned)__builtin_amdgcn_s_getreg((3 << 11) | 20) & 0xFu; }
#define XB_SPIN(cond, bar) do { unsigned _sp = 0; while (cond) { __builtin_amdgcn_s_sleep(1); \
    if ((++_sp & 255u) == 0u) { if (xb_ld(&(bar)[XB_TMO])) break; if (_sp > XB_SPIN_CAP) { atomicAdd(&(bar)[XB_TMO], 1u); break; } } } } while (0)

struct XcdBarrier {
    unsigned* bar; unsigned x;
    volatile LAS unsigned* st;
};

__device__ __forceinline__ XcdBarrier xcd_barrier_post(unsigned* bar, volatile LAS unsigned* st) {
    XcdBarrier b; b.bar = bar; b.x = xb_xcc_id(); b.st = st;
    if (threadIdx.x == 0) (void)xb_add(&bar[XB_XCNT(b.x)], 1u);
    return b;
}
__device__ __forceinline__ void xcd_barrier_complete(unsigned* bar, unsigned x, unsigned& nloc, unsigned& nx) {
    const unsigned G = gridDim.x * gridDim.y * gridDim.z;
    unsigned sum, cnt, mine, sp = 0u;
    for (;;) {
        sum = 0u; cnt = 0u; mine = 0u;
#pragma unroll
        for (unsigned j = 0; j < 16; ++j) { const unsigned c = xb_ld(&bar[XB_XCNT(j)]); sum += c; cnt += (c > 0u) ? 1u : 0u; mine = (j == x) ? c : mine; }
        if (sum == G) break;
        __builtin_amdgcn_s_sleep(1);
        if ((++sp & 255u) == 0u) { if (xb_ld(&bar[XB_TMO])) break; if (sp > XB_SPIN_CAP) { atomicAdd(&bar[XB_TMO], 1u); break; } }
    }
    nloc = mine > 0u ? mine : 1u; nx = cnt > 0u ? cnt : 1u;
}

__device__ __forceinline__ void xcd_barrier(const XcdBarrier& b) {
    asm volatile("s_waitcnt vmcnt(0)" ::: "memory");
    __syncthreads();
    if (threadIdx.x == 0) {
        unsigned* bar = b.bar;
        __builtin_amdgcn_s_waitcnt(0);
        unsigned nloc = b.st[0], nx = b.st[1];
        if (nloc == 0u) { xcd_barrier_complete(bar, b.x, nloc, nx); b.st[0] = nloc; b.st[1] = nx; }
        const unsigned old = xb_add(&bar[XB_XSUB(b.x)], 1u);
        const unsigned gen = old / nloc;
        if (old + 1u == (gen + 1u) * nloc) {
            __builtin_amdgcn_fence(__ATOMIC_RELEASE, "agent");
            asm volatile("s_waitcnt vmcnt(0)" ::: "memory");
            const unsigned og = xb_add(&bar[XB_TOP], 1u);
            const unsigned tg = og / nx;
            if (og + 1u == (tg + 1u) * nx) xb_add(&bar[XB_TOPGEN], 1u);
            else XB_SPIN(xb_ld(&bar[XB_TOPGEN]) == tg, bar);
            __builtin_amdgcn_fence(__ATOMIC_ACQUIRE, "agent");
            xb_add(&bar[XB_XGEN(b.x)], 1u);
            asm volatile("s_waitcnt vmcnt(0)" ::: "memory");
        } else {
            XB_SPIN(xb_ld(&bar[XB_XGEN(b.x)]) == gen, bar);
            __builtin_amdgcn_fence(__ATOMIC_ACQUIRE, "agent");
            asm volatile("s_waitcnt vmcnt(0)" ::: "memory");
        }
    }
    __syncthreads();
}

namespace pg8 {
#define EPI_NOMID static constexpr bool HAS_MID = false; __device__ __forceinline__ int mid_t() const { return -1; } __device__ __forceinline__ void mid(Acc&, const Unit&, int, int, int, int) const {}
#define RAW_BARRIER() do { asm volatile("s_waitcnt lgkmcnt(0)" ::: "memory"); __builtin_amdgcn_s_barrier(); asm volatile("" ::: "memory"); } while (0)

__device__ __forceinline__ u32x4 pack8(const f32x4& v0, const f32x4& v1) { u32x4 w; w.x = cvt_pk_bf16(v0[0], v0[1]); w.y = cvt_pk_bf16(v0[2], v0[3]); w.z = cvt_pk_bf16(v1[0], v1[1]); w.w = cvt_pk_bf16(v1[2], v1[3]); return w; }

struct GridOrder {
    const char* A; const char* Bt; int lda, ldb, nM, nN, nwg, G, c, dup;
    __device__ __forceinline__ void init(const void* A_, const void* Bt_, int lda_, int ldb_, int M, int N, int G_, int c_) { A = (const char*)A_; Bt = (const char*)Bt_; lda = lda_; ldb = ldb_; nM = M / BM; nN = N / BM; nwg = nM * nN; G = G_; c = c_; dup = 1; }
    __device__ __forceinline__ bool next(int i, Unit& u) const {
        const long L = (long)i * G + c; if (L >= (long)nwg * dup) return false;
        int wgid = (int)(L % nwg); { const int q = nwg / NXCD, r = nwg % NXCD, xcd = wgid % NXCD, off = wgid / NXCD; wgid = (xcd < r ? xcd * (q + 1) : r * (q + 1) + (xcd - r) * q) + off; }
        const int nig = WGM * nN, gid = wgid / nig, fm = gid * WGM, gsz = (nM - fm) < WGM ? (nM - fm) : WGM;
        u.pm = fm + ((wgid % nig) % gsz); u.pn = (wgid % nig) / gsz; u.x0 = 0; u.x1 = 0; u.rows = nullptr;
        u.a = A + (size_t)u.pm * BM * lda * 2; u.b = Bt + (size_t)u.pn * BM * ldb * 2; return true;
    }
};
struct KvOrder {
    const char* memn; const char* wk; const char* wv; int G, c;
    __device__ __forceinline__ bool next(int i, Unit& u) const {
        const int L = i * G + c; if (L >= 128) return false;
        const int l = L & 63; u.rows = nullptr; u.x1 = 0; u.x0 = L >> 6; u.pm = l >> 2; u.pn = l & 3;
        u.a = memn + (size_t)u.pm * BM * D * 2; u.b = (u.x0 ? wv : wk) + (size_t)u.pn * BM * D * 2;
        return true;
    }
};
struct MnOrder {
    const char* kx; const char* wq2; const char* wxoT; const char* vx; int G, c, dup;
    __device__ __forceinline__ bool next(int i, Unit& u) const {
        int L = i * G + c; if (L >= 512 * dup) return false;
        L &= 511; const int l = L & 255, bh = l >> 2, t4 = l & 3, b = bh >> 2, h = bh & 3; u.rows = nullptr; u.x1 = 0;
        if (L < 256) { u.x0 = 0; u.pm = b * 4 + h; u.pn = t4; u.a = kx + ((size_t)b * MEML * D + h * XHD) * 2; u.b = wq2 + ((size_t)t4 * BM * D + h * XHD) * 2; }
        else { u.x0 = 1; u.pm = b * 4 + t4; u.pn = h; u.a = wxoT + ((size_t)t4 * BM * D + h * XHD) * 2; u.b = vx + ((size_t)b * MEML * D + h * XHD) * 2; }
        return true;
    }
};
struct BatchOrder {
    const char* A; const char* Bt; int nwg, G, c, dup;
    __device__ __forceinline__ bool next(int i, Unit& u) const {
        const long L = (long)i * G + c; if (L >= (long)nwg * dup) return false;
        int wgid = (int)(L % nwg); { const int q = nwg / NXCD, r = nwg % NXCD, xcd = wgid % NXCD, off = wgid / NXCD; wgid = (xcd < r ? xcd * (q + 1) : r * (q + 1) + (xcd - r) * q) + off; }
        const int nN = 4, nM = T / BM, nig = WGM * nN, gid = wgid / nig, fm = gid * WGM, gsz = (nM - fm) < WGM ? (nM - fm) : WGM;
        u.pm = fm + ((wgid % nig) % gsz); u.pn = (wgid % nig) / gsz; u.x0 = 0; u.x1 = 0; u.rows = nullptr;
        u.a = A + (size_t)u.pm * BM * D * 2; u.b = Bt + ((size_t)(u.pm >> 4) * D + u.pn * BM) * D * 2; return true;
    }
};
template <int MODE> struct MoeOrder {
    const char* A; const char* W; const int* rowtok; const int* etile; int G, c, dup;
    __device__ __forceinline__ bool next(int i, Unit& u) const {
        int L = i * G + c; const int ntile = etile[NE];
        if (L >= ntile * 4 * dup) return false;
        L %= ntile * 4;
        const int rt = L >> 2, ct = L & 3; int e = 0;
        for (int j = 1; j < NE; ++j) e = (etile[j] <= rt) ? j : e;
        u.pm = rt; u.pn = ct; u.x0 = e; u.x1 = 0;
        if (MODE == 0) { u.a = A; u.rows = rowtok + rt * BM; u.b = W + ((size_t)e * 1024 + ct * BM) * D * 2; }
        else { u.a = A + (size_t)rt * BM * FF * 2; u.rows = nullptr; u.b = W + ((size_t)e * 1024 + ct * BM) * FF * 2; }
        return true;
    }
};

struct EpiU {
    static constexpr bool PERM = true; EPI_NOMID
    bf16_t* Cb; bf16_t* Q; bf16_t* Kb; bf16_t* V; const float* ropec; const float* ropes;
    __device__ __forceinline__ void operator()(Acc& acc, const Unit& u, int wr, int wc, int fr, int fq, LAS unsigned char*, int, int) const {
        const int row0 = u.pm * BM + wr * 64 + fr;
        if (u.pn < 2) {
#pragma unroll
            for (int ai = 0; ai < 2; ++ai)
#pragma unroll
                for (int m = 0; m < 4; ++m) { const int row = row0 + ai * HALF + m * 16; f32x4 o[2];
#pragma unroll
                    for (int n = 0; n < 2; ++n)
#pragma unroll
                        for (int i = 0; i < 4; ++i) { const float a = acc[ai][0][m][n][i], g = acc[ai][1][m][n][i]; o[n][i] = a / (1.f + __expf(-g)); }
                    *(u32x4*)(Cb + (size_t)row * CCH + u.pn * HALF + wc * 32 + fq * 8) = pack8(o[0], o[1]); }
        } else if (u.pn < 8) {
            const int sec = (u.pn - 2) / 3, tt = (u.pn - 2) % 3; bf16_t* dst = sec ? Kb : Q; const float sc = sec ? 1.f : 0.125f * LOG2E;
            const int hd = 4 * tt + wc;
#pragma unroll
            for (int ai = 0; ai < 2; ++ai)
#pragma unroll
                for (int m = 0; m < 4; ++m) { const int row = row0 + ai * HALF + m * 16; const int s = row & (SEQ - 1); f32x4 o1[2], o2[2];
#pragma unroll
                    for (int n = 0; n < 2; ++n) { const f32x4 cs = *(const f32x4*)(ropec + s * 32 + fq * 8 + n * 4), sn = *(const f32x4*)(ropes + s * 32 + fq * 8 + n * 4);
                        const f32x4 x1 = acc[ai][0][m][n], x2 = acc[ai][1][m][n];
                        o1[n] = (x1 * cs - x2 * sn) * sc; o2[n] = (x1 * sn + x2 * cs) * sc; }
                    bf16_t* p = dst + ((size_t)((row >> 12) * NH + hd) * SEQ + s) * HD + fq * 8;
                    *(u32x4*)p = pack8(o1[0], o1[1]); *(u32x4*)(p + 32) = pack8(o2[0], o2[1]); }
        } else {
            const int tt = u.pn - 8;
#pragma unroll
            for (int ai = 0; ai < 2; ++ai)
#pragma unroll
                for (int m = 0; m < 4; ++m) { const int row = row0 + ai * HALF + m * 16;
#pragma unroll
                    for (int bj = 0; bj < 2; ++bj) { const int col = tt * BM + bj * HALF + wc * 32 + fq * 8;
                        *(u32x4*)(V + ((size_t)((row >> 12) * NH + (col >> 6)) * SEQ + (row & (SEQ - 1))) * HD + (col & 63)) = pack8(acc[ai][bj][m][0], acc[ai][bj][m][1]); } }
        }
    }
};
template <bool ROWSCALE> struct EpiPlain {
    static constexpr bool PERM = true; EPI_NOMID
    bf16_t* O0; int ldc0; bf16_t* O1; int ldc1; const float* ssq16;
    __device__ __forceinline__ void operator()(Acc& acc, const Unit& u, int wr, int wc, int fr, int fq, LAS unsigned char*, int, int) const {
        bf16_t* O = u.x0 ? O1 : O0; const int ldc = u.x0 ? ldc1 : ldc0;
        const int row0 = u.pm * BM + wr * 64 + fr, col0 = u.pn * BM + wc * 32 + fq * 8;
#pragma unroll
        for (int ai = 0; ai < 2; ++ai)
#pragma unroll
            for (int m = 0; m < 4; ++m) { const int row = row0 + ai * HALF + m * 16; float rs = 1.f;
                if constexpr (ROWSCALE) { const f32x4* sp = (const f32x4*)(ssq16 + (size_t)row * 16); const f32x4 s0 = sp[0], s1 = sp[1], s2 = sp[2], s3 = sp[3];
                    const f32x4 st = (s0 + s1) + (s2 + s3); rs = 1.0f / sqrtf(((st[0] + st[1]) + (st[2] + st[3])) * (1.0f / D) + NORM_EPS); }
#pragma unroll
                for (int bj = 0; bj < 2; ++bj) *(u32x4*)(O + (size_t)row * ldc + col0 + bj * HALF) = pack8(acc[ai][bj][m][0] * rs, acc[ai][bj][m][1] * rs); }
    }
};
template <bool MID> struct EpiResid {
    static constexpr bool PERM = false, HAS_MID = MID;
    const float* xin; bf16_t* XB; float* ssqp; const float* ssqa;
    __device__ __forceinline__ int mid_t() const { return AW / BK; }
    __device__ __forceinline__ void mid(Acc& acc, const Unit& u, int wr, int wc, int fr, int fq) const {
        const int row0 = u.pm * BM + wr * 64 + fr;
#pragma unroll
        for (int ai = 0; ai < 2; ++ai)
#pragma unroll
            for (int m = 0; m < 4; ++m) { const int row = row0 + ai * HALF + m * 16; const f32x4* sp = (const f32x4*)(ssqa + (size_t)row * NH);
                const f32x4 s0 = sp[0], s1 = sp[1], s2 = sp[2]; const f32x4 st = (s0 + s1) + s2;
                const float r = 1.0f / sqrtf(((st[0] + st[1]) + (st[2] + st[3])) * (1.0f / AW) + NORM_EPS);
#pragma unroll
                for (int bj = 0; bj < 2; ++bj)
#pragma unroll
                    for (int n = 0; n < 2; ++n) acc[ai][bj][m][n] = acc[ai][bj][m][n] * r;
                asm volatile("" ::: "memory"); }
    }
    __device__ __forceinline__ void operator()(Acc& acc, const Unit& u, int wr, int wc, int fr, int fq, LAS unsigned char*, int, int) const {
        const int row0 = u.pm * BM + wr * 64 + fr, col0 = u.pn * BM + wc * 32 + fq * 4;
#pragma unroll
        for (int ai = 0; ai < 2; ++ai)
#pragma unroll
            for (int m = 0; m < 4; ++m) { const int row = row0 + ai * HALF + m * 16; float ss = 0.f;
#pragma unroll
                for (int bj = 0; bj < 2; ++bj)
#pragma unroll
                    for (int n = 0; n < 2; ++n) { const size_t o = (size_t)row * D + col0 + bj * HALF + n * 16; f32x4 v;
                        if constexpr (MID) v = *(const f32x4*)(xin + o) + acc[ai][bj][m][n];
                        else { const u32x2 xb = *(const u32x2*)(XB + o); v = (f32x4){bflo(xb.x), bfhi(xb.x), bflo(xb.y), bfhi(xb.y)} + acc[ai][bj][m][n]; }
                        u32x2 w; w.x = cvt_pk_bf16(v[0], v[1]); w.y = cvt_pk_bf16(v[2], v[3]); *(u32x2*)(XB + o) = w;
                        ss += (v[0] * v[0] + v[1] * v[1]) + (v[2] * v[2] + v[3] * v[3]); }
                ss += __shfl_xor(ss, 16); ss += __shfl_xor(ss, 32);
                if (fq == 0) ssqp[(size_t)row * 16 + u.pn * 4 + wc] = ss; }
    }
};
struct EpiSoftmax {
    static constexpr bool PERM = true; EPI_NOMID
    bf16_t* PM; const float* ssq16;
    __device__ __forceinline__ void operator()(Acc& acc, const Unit& u, int wr, int wc, int fr, int fq, LAS unsigned char* lds, int, int) const {
        LAS float* MX = (LAS float*)(lds + XCH_OFF); LAS float* SM = (LAS float*)(lds + XCH_OFF + 4096);
#pragma unroll
        for (int ai = 0; ai < 2; ++ai)
#pragma unroll
            for (int m = 0; m < 4; ++m) { const int rl = ai * HALF + wr * 64 + m * 16 + fr; float mx = -3.0e38f;
                const f32x4* sp = (const f32x4*)(ssq16 + (size_t)(u.pm * BM + rl) * 16); const f32x4 st = (sp[0] + sp[1]) + (sp[2] + sp[3]);
                const float rs = 1.0f / sqrtf(((st[0] + st[1]) + (st[2] + st[3])) * (1.0f / D) + NORM_EPS);
#pragma unroll
                for (int bj = 0; bj < 2; ++bj)
#pragma unroll
                    for (int n = 0; n < 2; ++n) { const f32x4 v = acc[ai][bj][m][n] * rs; acc[ai][bj][m][n] = v; mx = fmaxf(mx, fmaxf(fmaxf(v[0], v[1]), fmaxf(v[2], v[3]))); }
                mx = fmaxf(mx, __shfl_xor(mx, 16)); mx = fmaxf(mx, __shfl_xor(mx, 32));
                if (fq == 0) MX[rl * 4 + wc] = mx; }
        RAW_BARRIER();
#pragma unroll
        for (int ai = 0; ai < 2; ++ai)
#pragma unroll
            for (int m = 0; m < 4; ++m) { const int rl = ai * HALF + wr * 64 + m * 16 + fr; const f32x4 mm = *(const LAS f32x4*)(MX + rl * 4);
                const float mx = fmaxf(fmaxf(mm[0], mm[1]), fmaxf(mm[2], mm[3])); float ss = 0.f;
#pragma unroll
                for (int bj = 0; bj < 2; ++bj)
#pragma unroll
                    for (int n = 0; n < 2; ++n) { f32x4 v = acc[ai][bj][m][n];
#pragma unroll
                        for (int i = 0; i < 4; ++i) { v[i] = __builtin_amdgcn_exp2f(v[i] - mx); ss += v[i]; }
                        acc[ai][bj][m][n] = v; }
                ss += __shfl_xor(ss, 16); ss += __shfl_xor(ss, 32);
                if (fq == 0) SM[rl * 4 + wc] = ss; }
        RAW_BARRIER();
        const int col0 = u.pn * BM + wc * 32 + fq * 8;
#pragma unroll
        for (int ai = 0; ai < 2; ++ai)
#pragma unroll
            for (int m = 0; m < 4; ++m) { const int rl = ai * HALF + wr * 64 + m * 16 + fr; const f32x4 s4 = *(const LAS f32x4*)(SM + rl * 4);
                const float inv = 1.0f / ((s4[0] + s4[1]) + (s4[2] + s4[3]));
#pragma unroll
                for (int bj = 0; bj < 2; ++bj) *(u32x4*)(PM + (size_t)(u.pm * BM + rl) * D + col0 + bj * HALF) = pack8(acc[ai][bj][m][0] * inv, acc[ai][bj][m][1] * inv); }
    }
};
struct EpiMoe1 {
    static constexpr bool PERM = true; EPI_NOMID
    bf16_t* HID; const float* slot_rs;
    __device__ __forceinline__ void operator()(Acc& acc, const Unit& u, int wr, int wc, int fr, int fq, LAS unsigned char*, int, int) const {
        const int row0 = u.pm * BM + wr * 64 + fr;
#pragma unroll
        for (int ai = 0; ai < 2; ++ai)
#pragma unroll
            for (int m = 0; m < 4; ++m) { const int row = row0 + ai * HALF + m * 16; const float rs = slot_rs[row]; f32x4 o[2];
#pragma unroll
                for (int n = 0; n < 2; ++n)
#pragma unroll
                    for (int i = 0; i < 4; ++i) { const float a = acc[ai][0][m][n][i] * rs, b = acc[ai][1][m][n][i] * rs; o[n][i] = a * b / (1.f + __expf(-a)); }
                *(u32x4*)(HID + (size_t)row * FF + u.pn * HALF + wc * 32 + fq * 8) = pack8(o[0], o[1]); }
    }
};
struct EpiMoe2 {
    static constexpr bool PERM = true; EPI_NOMID
    bf16_t* Y; const float* slot_gate;
    __device__ __forceinline__ void operator()(Acc& acc, const Unit& u, int wr, int wc, int fr, int fq, LAS unsigned char*, int, int) const {
        const int row0 = u.pm * BM + wr * 64 + fr, col0 = u.pn * BM + wc * 32 + fq * 8;
#pragma unroll
        for (int ai = 0; ai < 2; ++ai)
#pragma unroll
            for (int m = 0; m < 4; ++m) { const int row = row0 + ai * HALF + m * 16; const float g = slot_gate[row];
#pragma unroll
                for (int bj = 0; bj < 2; ++bj) *(u32x4*)(Y + (size_t)row * D + col0 + bj * HALF) = pack8(acc[ai][bj][m][0] * g, acc[ai][bj][m][1] * g); }
    }
};
}
struct Frame {
    LAS unsigned char* lds;
    volatile LAS unsigned* MISC;
    unsigned* ctl;
    unsigned char* ws;
    int wave, vcu, G;
};
struct Args { const void* in[27]; float* out; unsigned char* ws; int ph_lo, ph_hi, li, pad; };

__device__ __forceinline__ void tr_item(const float* W, int ldw, int srcrow0, int srccol0, bf16_t* WT, int dpitch, size_t drow0, int dk0, const float* gk, float sc, LAS float* scr, int lane) {
    f32x4 v[8]; const int n4 = lane & 7, kq = lane >> 3;
#pragma unroll
    for (int i = 0; i < 8; ++i) v[i] = *(const f32x4*)(W + (size_t)(srcrow0 + kq + 8 * i) * ldw + srccol0 + 4 * n4);
#pragma unroll
    for (int i = 0; i < 8; ++i) { const int kk = kq + 8 * i; const float g = gk ? gk[kk] * sc : sc; LAS float* d = scr + kk * 33 + 4 * n4;
        d[0] = v[i][0] * g; d[1] = v[i][1] * g; d[2] = v[i][2] * g; d[3] = v[i][3] * g; }
    LDS_WAIT(); asm volatile("" ::: "memory");
    const int c = lane & 7;
#pragma unroll
    for (int j = 0; j < 4; ++j) { const int n = (lane >> 3) + 8 * j; const LAS float* s = scr + (8 * c) * 33 + n;
        u32x4 o; o.x = pk2(s[0 * 33], s[1 * 33]); o.y = pk2(s[2 * 33], s[3 * 33]); o.z = pk2(s[4 * 33], s[5 * 33]); o.w = pk2(s[6 * 33], s[7 * 33]);
        *(u32x4*)(WT + (drow0 + n) * dpitch + dk0 + 8 * c) = o; }
    LDS_WAIT(); asm volatile("" ::: "memory");
}
__device__ __forceinline__ void rms_row_to_bf16(const float* xrow, const float* g, bf16_t* orow, int lane) {
    const f32x4* xr = (const f32x4*)xrow + lane; const f32x4* gr = (const f32x4*)g + lane;
    f32x4 v[4]; float s = 0.f;
#pragma unroll
    for (int j = 0; j < 4; ++j) { v[j] = xr[64 * j]; s += (v[j][0] * v[j][0] + v[j][1] * v[j][1]) + (v[j][2] * v[j][2] + v[j][3] * v[j][3]); }
    const float rs = 1.0f / sqrtf(wave_sum(s) * (1.f / D) + NORM_EPS);
    u32x2* o8 = (u32x2*)orow + lane;
#pragma unroll
    for (int j = 0; j < 4; ++j) { const f32x4 gg = gr[64 * j]; u32x2 w; w.x = pk2(v[j][0] * rs * gg[0], v[j][1] * rs * gg[1]); w.y = pk2(v[j][2] * rs * gg[2], v[j][3] * rs * gg[3]); o8[64 * j] = w; }
}
__device__ __forceinline__ void rms_row2_to_bf16(const float* xrow, const float* g, bf16_t* orow, int lane) {
    const f32x4* xr = (const f32x4*)xrow + lane; const f32x4* gr = (const f32x4*)g + lane;
    f32x4 v[2][4]; float s0 = 0.f, s1 = 0.f;
#pragma unroll
    for (int r = 0; r < 2; ++r)
#pragma unroll
        for (int j = 0; j < 4; ++j) v[r][j] = xr[r * 256 + 64 * j];
#pragma unroll
    for (int j = 0; j < 4; ++j) { s0 += (v[0][j][0] * v[0][j][0] + v[0][j][1] * v[0][j][1]) + (v[0][j][2] * v[0][j][2] + v[0][j][3] * v[0][j][3]);
        s1 += (v[1][j][0] * v[1][j][0] + v[1][j][1] * v[1][j][1]) + (v[1][j][2] * v[1][j][2] + v[1][j][3] * v[1][j][3]); }
    const float r0 = 1.0f / sqrtf(wave_sum(s0) * (1.f / D) + NORM_EPS), r1 = 1.0f / sqrtf(wave_sum(s1) * (1.f / D) + NORM_EPS);
    u32x2* o8 = (u32x2*)orow + lane;
#pragma unroll
    for (int j = 0; j < 4; ++j) { const f32x4 gg = gr[64 * j]; u32x2 w;
        w.x = pk2(v[0][j][0] * r0 * gg[0], v[0][j][1] * r0 * gg[1]); w.y = pk2(v[0][j][2] * r0 * gg[2], v[0][j][3] * r0 * gg[3]); o8[64 * j] = w;
        w.x = pk2(v[1][j][0] * r1 * gg[0], v[1][j][1] * r1 * gg[1]); w.y = pk2(v[1][j][2] * r1 * gg[2], v[1][j][3] * r1 * gg[3]); o8[256 + 64 * j] = w; }
}
__device__ __forceinline__ double rope_inv(int d) {
    const int q = d >> 3, r = d & 7;
    double b = 1.0;
    b = (r == 1) ? 0.7498942093324558273 : b; b = (r == 2) ? 0.56234132519034908039 : b; b = (r == 3) ? 0.42169650342858224857 : b; b = (r == 4) ? 0.3162277660168379332 : b;
    b = (r == 5) ? 0.23713737056616552617 : b; b = (r == 6) ? 0.17782794100389228012 : b; b = (r == 7) ? 0.13335214321633240257 : b;
    const double p = (q == 0) ? 1.0 : (q == 1) ? 0.1 : (q == 2) ? 0.01 : 0.001;
    return b * p;
}
__device__ __forceinline__ void sincos_d(double a, double& sn, double& cs) {
    const double k = __builtin_rint(a * 0.63661977236758134308);
    double y = __builtin_fma(-k, 1.57079632679489655800e+00, a); y = __builtin_fma(-k, 6.12323399573676603587e-17, y);
    const double y2 = y * y;
    double s = 1.0 / 6227020800.0; s = s * y2 - 1.0 / 39916800.0; s = s * y2 + 1.0 / 362880.0; s = s * y2 - 1.0 / 5040.0; s = s * y2 + 1.0 / 120.0; s = s * y2 - 1.0 / 6.0; s = s * y2 * y + y;
    double c = 1.0 / 479001600.0; c = c * y2 - 1.0 / 3628800.0; c = c * y2 + 1.0 / 40320.0; c = c * y2 - 1.0 / 720.0; c = c * y2 + 1.0 / 24.0; c = c * y2 - 0.5; c = c * y2 + 1.0;
    const int qd = ((int)k) & 3;
    sn = (qd == 0) ? s : (qd == 1) ? c : (qd == 2) ? -s : -c;
    cs = (qd == 0) ? c : (qd == 1) ? -s : (qd == 2) ? -c : s;
}
typedef const void* gen_cptr;
typedef __attribute__((address_space(4))) const char* cas_cptr;
typedef __attribute__((address_space(4))) const gen_cptr* cas_pptr;
__device__ __forceinline__ const void* karg_ptr(int byte_off) { cas_cptr p = (cas_cptr)__builtin_amdgcn_kernarg_segment_ptr(); asm volatile("" : "+s"(p)); return *(cas_pptr)(p + byte_off); }
__device__ __forceinline__ void p0_prologue(Frame& F) {
    const int lane = lane_id(), tid = F.wave * 64 + lane;
    const float* x = (const float*)karg_ptr(8 * 0); const float* mem = (const float*)karg_ptr(8 * 1); const int* positions = (const int*)karg_ptr(8 * 2);
    const float* mix_g = (const float*)karg_ptr(8 * 3); const float* w_in = (const float*)karg_ptr(8 * 4);
    const float* attn_out_g = (const float*)karg_ptr(8 * 10); const float* w_out = (const float*)karg_ptr(8 * 11);
    const float* xattn_g = (const float*)karg_ptr(8 * 12); const float* mem_g = (const float*)karg_ptr(8 * 13);
    const float* w_xq = (const float*)karg_ptr(8 * 14); const float* w_xk = (const float*)karg_ptr(8 * 15); const float* w_xv = (const float*)karg_ptr(8 * 16); const float* w_xo = (const float*)karg_ptr(8 * 17);
    const float* moe_g = (const float*)karg_ptr(8 * 18); const float* w_group = (const float*)karg_ptr(8 * 19); const float* w_router = (const float*)karg_ptr(8 * 21);
    const float* w1 = (const float*)karg_ptr(8 * 23); const float* w3 = (const float*)karg_ptr(8 * 24); const float* w2 = (const float*)karg_ptr(8 * 25);
    unsigned char* ws = F.ws;
    LAS float* scr = (LAS float*)(F.lds + F.wave * 16384);
    const int gw = F.vcu * NWAVES + F.wave, NGW = F.G * NWAVES;
    constexpr int I_IN = 16 * 88, I_SQ = 16 * 32, I_13 = NE * 16 * 32, I_2 = NE * 8 * 32;
    constexpr int NITEMS = I_IN + 5 * I_SQ + I_13 + I_2;
    for (int it = gw; it < NITEMS; it += NGW) {
        int r = it;
        if (r < I_IN) { const int kb = r / 88, nb = r % 88, n0 = 32 * nb, tile = n0 >> 8, j = n0 & 255; int src;
            if (tile < 2) src = (j < 128) ? 128 * tile + j : 256 + 128 * tile + (j - 128);
            else if (tile < 8) { const int sec = (tile - 2) / 3, tt = (tile - 2) % 3, jj = j & 127, hh = jj >> 5; src = 512 + 768 * sec + 256 * tt + 64 * hh + ((j < 128) ? 0 : 32); }
            else src = n0;
            tr_item(w_in, INW, 64 * kb, src, (bf16_t*)(ws + WS_WIN), D, (size_t)n0, 64 * kb, nullptr, 1.f, scr, lane); continue; }
        r -= I_IN;
        if (r < I_SQ) { const int kb = r / 32, nb = r % 32, dk0 = 64 * kb; const bool at = dk0 < AW;
            tr_item(w_out, D, at ? CCH + dk0 : dk0 - AW, 32 * nb, (bf16_t*)(ws + WS_WOUT), D, (size_t)(32 * nb), dk0, at ? attn_out_g + dk0 : nullptr, 1.f, scr, lane); continue; }
        r -= I_SQ;
        if (r < 4 * I_SQ) { const int which = r / I_SQ, r2 = r % I_SQ, kb = r2 / 32, nb = r2 % 32;
            if (which == 0) {
                bf16_t* WQ2 = (bf16_t*)(ws + WS_WXQ); const int n4 = lane & 7, kq = lane >> 3;
#pragma unroll
                for (int i = 0; i < 8; ++i) { const int k = 64 * kb + kq + 8 * i; const f32x4 v = *(const f32x4*)(w_xq + (size_t)k * D + 32 * nb + 4 * n4); const float g = xattn_g[k] * (LOG2E / 16.f);
                    u32x2 o; o.x = pk2(v[0] * g, v[1] * g); o.y = pk2(v[2] * g, v[3] * g); *(u32x2*)(WQ2 + (size_t)k * D + 32 * nb + 4 * n4) = o; }
                continue; }
            const float* W = which == 1 ? w_xk : which == 2 ? w_xv : w_xo;
            bf16_t* WT = (bf16_t*)(ws + (which == 1 ? WS_WXK : which == 2 ? WS_WXV : WS_WXO));
            tr_item(W, D, 64 * kb, 32 * nb, WT, D, (size_t)(32 * nb), 64 * kb, nullptr, 1.f, scr, lane); continue; }
        r -= 4 * I_SQ;
        if (r < I_13) { const int e = r / 512, r2 = r % 512, kb = r2 / 32, nb = r2 % 32, n0 = 32 * nb, tt = n0 >> 8, j = n0 & 255;
            const float* W = ((j < 128) ? w1 : w3) + (size_t)e * D * FF;
            tr_item(W, FF, 64 * kb, 128 * tt + (j & 127), (bf16_t*)(ws + WS_W13), D, (size_t)e * 1024 + n0, 64 * kb, moe_g + 64 * kb, 1.f, scr, lane); continue; }
        r -= I_13;
        { const int e = r / 256, r2 = r % 256, kb = r2 / 32, nb = r2 % 32;
            tr_item(w2 + (size_t)e * FF * D, D, 64 * kb, 32 * nb, (bf16_t*)(ws + WS_W2), FF, (size_t)e * 1024 + 32 * nb, 64 * kb, nullptr, 1.f, scr, lane); }
    }
    { bf16_t* WRF = (bf16_t*)(ws + WS_HIST + HIST_WR);
      for (int i = blockIdx.x * 512 + tid; i < 4 * 8 * 3 * 2 * 64 * 8; i += F.G * 512) {
          const int j = i & 7, ln = (i >> 3) & 63, part = (i >> 9) & 1, blk = i >> 10, nt = blk % 3, s = (blk / 3) & 7, kc = blk / 24;
          const int k = 256 * kc + 32 * s + 8 * (ln >> 4) + j, o = 16 * nt + (ln & 15);
          float v = 0.f; if (o < 32) v = w_router[k * 32 + o] * moe_g[k]; else if (o < 36) v = w_group[k * 4 + (o - 32)] * moe_g[k];
          const unsigned hb = f2bf(v); const float hf = __builtin_bit_cast(float, hb << 16);
          WRF[i] = (bf16_t)(part ? f2bf(v - hf) : hb); } }
    { float* rc = (float*)(ws + WS_ROPE); float* rsn = rc + SEQ * 32;
      for (int i = blockIdx.x * 512 + tid; i < SEQ * 32; i += F.G * 512) { const int s = i >> 5, d = i & 31;
          const float inv = (float)rope_inv(d); const float ang = (float)positions[s] * inv; double sn, cs; sincos_d((double)fabsf(ang), sn, cs); if (ang < 0.f) sn = -sn;
          rc[i] = (float)cs; rsn[i] = (float)sn; } }
    for (int m = gw; m < MROWS; m += NGW) rms_row_to_bf16(mem + (size_t)m * D, mem_g, (bf16_t*)(ws + WS_MEMN) + (size_t)m * D, lane);
    for (int m = 2 * gw; m < T; m += 2 * NGW) rms_row2_to_bf16(x + (size_t)m * D, mix_g, (bf16_t*)(ws + WS_R1) + (size_t)m * D, lane);
}
#ifndef D16_REP
#define D16_REP 1
#endif
namespace att {
typedef short v4i16_t __attribute__((ext_vector_type(4)));
constexpr int BUFB = 65536, VIMG = 32768;
constexpr float NEG = -1.0e30f, MFLOOR = -1.0e9f;
__device__ __forceinline__ int k_off(int row, int c) { return row * 128 + ((c ^ ((row >> 1) & 7)) << 4); }
__device__ __forceinline__ int v_off(int row, int c) { return VIMG + row * 128 + ((c ^ (((row >> 1) & 3) << 1)) << 4); }

struct Grp { bf16x8 q0, q1; f32x4 o[4]; float m, l; };
struct KV { bf16x8 k[2][2]; bf16x8 v[4]; };

#ifdef ATT_SHFL
__device__ __forceinline__ float xmax16(float v) { return fmaxf(v, __shfl_xor(v, 16)); }
__device__ __forceinline__ float xmax32(float v) { return fmaxf(v, __shfl_xor(v, 32)); }
__device__ __forceinline__ float xsum16(float v) { return v + __shfl_xor(v, 16); }
__device__ __forceinline__ float xsum32(float v) { return v + __shfl_xor(v, 32); }
#else
__device__ __forceinline__ void swap16(float v, float& a, float& b) { a = v; b = v; asm volatile("s_nop 1\n\tv_permlane16_swap_b32 %0, %1" : "+v"(a), "+v"(b)); }
__device__ __forceinline__ void swap32(float v, float& a, float& b) { a = v; b = v; asm volatile("s_nop 1\n\tv_permlane32_swap_b32 %0, %1" : "+v"(a), "+v"(b)); }
__device__ __forceinline__ float xmax16(float v) { float a, b; swap16(v, a, b); return fmaxf(a, b); }
__device__ __forceinline__ float xmax32(float v) { float a, b; swap32(v, a, b); return fmaxf(a, b); }
__device__ __forceinline__ float xsum16(float v) { float a, b; swap16(v, a, b); return a + b; }
__device__ __forceinline__ float xsum32(float v) { float a, b; swap32(v, a, b); return a + b; }
#endif
constexpr int NSTEP_ = 9;
__device__ __forceinline__ int step_id(int s) { return (s >= 6) ? s : ((s & 1) ? 3 + (s >> 1) : (s >> 1)); }
__device__ __forceinline__ int step_pos(int step, int row, int c0) {
    if (step == 99) return 16 * row + c0;
    if (step < 3) { const int hh = row >> 7, jj = row & 127; return c0 + 256 * hh - 64 + 128 * step + jj; }
    if (step < 9) { const int s = step - 3, hh = row >> 7, c = (row >> 5) & 3, jj = row & 31; return 4 * ((c0 >> 2) + 64 * hh - 64 + 32 * s + jj) + c; }
    { const int s = step - 9, pb = s >> 1, rh = s & 1, rr = row >> 5, jj = row & 31; return 16 * ((c0 >> 4) - 64 + 32 * pb + jj) + 8 * rh + rr; }
}
__device__ __forceinline__ void stage_issue(unsigned ldsbuf, const char* Kg, const char* Vg, int hrow0, int c0, int step, int wave, int lane) {
    const bool isV = wave >= 4; const char* gb = pg8::uniform_ptr(isV ? Vg : Kg);
#pragma unroll
    for (int i = 0; i < 8; ++i) { const int blk = (wave & 3) * 8 + i, row = 8 * blk + (lane >> 3), phys = lane & 7;
        const int c = isV ? (phys ^ (((row >> 1) & 3) << 1)) : (phys ^ ((row >> 1) & 7));
        int pos = step_pos(step, row, c0); pos = pos < 0 ? 0 : (pos > SEQ - 1 ? SEQ - 1 : pos);
        const unsigned voff = (unsigned)((hrow0 + pos) * HD + c * 8) * 2u;
        pg8::glds16_sv(gb, voff, ldsbuf + (isV ? (unsigned)VIMG : 0u) + (unsigned)blk * 1024u); __builtin_amdgcn_sched_barrier(0); }
}
struct LaneOff { int kb0; int vb[4]; };
__device__ __forceinline__ void lane_off(LaneOff& o, int lane) {
    const int key = lane & 15, g = lane >> 4, q = (lane >> 2) & 3, p2 = lane & 3;
    o.kb0 = k_off(key, g);
#pragma unroll
    for (int db = 0; db < 4; ++db) o.vb[db] = v_off(4 * g + q, 2 * db + (p2 >> 1)) + 8 * (p2 & 1);
}
__device__ __forceinline__ const LAS unsigned char* row_base(const LAS unsigned char* buf, int Rb) {
    return (const LAS unsigned char*)(uintptr_t)(unsigned)__builtin_amdgcn_readfirstlane((int)((unsigned)(uintptr_t)buf + (unsigned)(Rb * 128))); }
__device__ __forceinline__ void load_k(bf16x8 (&k)[2][2], const LAS unsigned char* buf, int Rb, const LaneOff& lo) {
    const LAS unsigned char* rb = row_base(buf, Rb);
#pragma unroll
    for (int t = 0; t < 2; ++t) { k[t][0] = *(const LAS bf16x8*)(rb + t * 2048 + lo.kb0); k[t][1] = *(const LAS bf16x8*)(rb + t * 2048 + (lo.kb0 ^ 64)); }
}
__device__ __forceinline__ void load_v(bf16x8 (&v)[4], const LAS unsigned char* buf, int Rb, const LaneOff& lo) {
    const LAS unsigned char* rb = row_base(buf, Rb);
#pragma unroll
    for (int db = 0; db < 4; ++db) {
        const s16x4 v0 = __builtin_bit_cast(s16x4, __builtin_amdgcn_ds_read_tr16_b64_v4i16((LAS v4i16_t*)(rb + lo.vb[db])));
        const s16x4 v1 = __builtin_bit_cast(s16x4, __builtin_amdgcn_ds_read_tr16_b64_v4i16((LAS v4i16_t*)(rb + 2048 + lo.vb[db])));
        v[db] = (bf16x8){v0[0], v0[1], v0[2], v0[3], v1[0], v1[1], v1[2], v1[3]}; }
}
__device__ __forceinline__ float fmax_nc(float a, float b) { float r; asm("v_max_f32_e32 %0, %1, %2" : "=v"(r) : "v"(a), "v"(b)); return r; }
__device__ __forceinline__ float fmax9_mfma(const f32x4& s0, const f32x4& s1, float m) { float r, t0, t1;
    asm("s_nop 11\n\tv_max3_f32 %1, %3, %4, %5\n\tv_max3_f32 %2, %6, %7, %8\n\tv_max3_f32 %0, %9, %10, %11\n\tv_max3_f32 %0, %0, %1, %2"
        : "=&v"(r), "=&v"(t0), "=&v"(t1) : "v"(s0[0]), "v"(s0[1]), "v"(s0[2]), "v"(s0[3]), "v"(s1[0]), "v"(s1[1]), "v"(s1[2]), "v"(s1[3]), "v"(m));
    return r; }
__device__ __forceinline__ void qk_part(const Grp& G, const bf16x8 (&k)[2][2], f32x4 (&s)[2]) {
#pragma unroll
    for (int t = 0; t < 2; ++t) { f32x4 z = (f32x4){0.f, 0.f, 0.f, 0.f};
        z = __builtin_amdgcn_mfma_f32_16x16x32_bf16(k[t][0], G.q0, z, 0, 0, 0); s[t] = __builtin_amdgcn_mfma_f32_16x16x32_bf16(k[t][1], G.q1, z, 0, 0, 0); }
}
template <bool FULL, bool INR>
__device__ __forceinline__ void sm_part(Grp& G, f32x4 (&s)[2], int ksub0, int qsub, int L, int lane, bf16x8& pb, float& alpha) {
    const int g = lane >> 4;
    if constexpr (!FULL) { const int d0 = ksub0 + 4 * g - qsub + 64, k0 = ksub0 + 4 * g;
#pragma unroll
        for (int t = 0; t < 2; ++t)
#pragma unroll
            for (int i = 0; i < 4; ++i) { bool ok = ((unsigned)(d0 + 16 * t + i) <= 128u); if constexpr (!INR) ok = ok && ((unsigned)(k0 + 16 * t + i) < (unsigned)L); s[t][i] = ok ? s[t][i] : NEG; } }
    float mx = fmax9_mfma(s[0], s[1], G.m);
    { float a, b; swap16(mx, a, b); mx = fmax_nc(a, b); swap32(mx, a, b); mx = fmax_nc(a, b); }
    const float mn = mx; alpha = __builtin_amdgcn_exp2f(G.m - mn);
    G.m = mn; float p[2][4]; float ps = 0.f;
#pragma unroll
    for (int t = 0; t < 2; ++t)
#pragma unroll
        for (int i = 0; i < 4; ++i) { const float e = __builtin_amdgcn_exp2f(s[t][i] - mn); p[t][i] = e; ps += e; }
    G.l = G.l * alpha + ps;
    u32x4 pw; pw.x = cvt_pk_bf16(p[0][0], p[0][1]); pw.y = cvt_pk_bf16(p[0][2], p[0][3]); pw.z = cvt_pk_bf16(p[1][0], p[1][1]); pw.w = cvt_pk_bf16(p[1][2], p[1][3]);
    pb = __builtin_bit_cast(bf16x8, pw);
}
__device__ __forceinline__ void pv_part(Grp& G, const bf16x8 (&v)[4], const bf16x8& pb, float alpha) {
#pragma unroll
    for (int db = 0; db < 4; ++db) G.o[db] = __builtin_amdgcn_mfma_f32_16x16x32_bf16(v[db], pb, G.o[db] * alpha, 0, 0, 0);
}
__device__ __forceinline__ void grp_init(Grp& G, const bf16_t* Qb, size_t qrow0, int lane) {
    const int a = lane & 15, g = lane >> 4; const bf16_t* qp = Qb + (qrow0 + 16 * a) * HD + 8 * g;
    G.q0 = *(const bf16x8*)qp; G.q1 = *(const bf16x8*)(qp + 32);
#pragma unroll
    for (int d = 0; d < 4; ++d) G.o[d] = (f32x4){0.f, 0.f, 0.f, 0.f};
    G.m = MFLOOR; G.l = 0.f;
}
__device__ __forceinline__ void grp_init_state(Grp& G, const bf16_t* Qb, const bf16_t* MIX, const float* ml, size_t tok0, size_t qrow0, int h, int lane) {
    const int a = lane & 15, g = lane >> 4; const size_t tok = tok0 + 16 * a; const bf16_t* qp = Qb + (qrow0 + 16 * a) * HD + 8 * g;
    G.q0 = *(const bf16x8*)qp; G.q1 = *(const bf16x8*)(qp + 32);
    const f32x2 st = *(const f32x2*)(ml + (tok * NH + h) * 2);
    G.m = st[0]; G.l = st[1] * 0.25f;
#pragma unroll
    for (int db = 0; db < 4; ++db) { const u32x2 w = *(const u32x2*)(MIX + tok * D + h * HD + 16 * db + 4 * g);
        G.o[db] = (f32x4){bflo(w.x), bfhi(w.x), bflo(w.y), bfhi(w.y)} * st[1]; }
}
__device__ __forceinline__ void grp_finish(Grp& G, bf16_t* MIX, float* ssqa, size_t tok0, int h, int lane) {
    const int a = lane & 15, g = lane >> 4; float l = G.l; l = xsum16(l); l = xsum32(l);
    const float inv = 1.0f / l; const size_t tok = tok0 + 16 * a; float ss = 0.f;
#pragma unroll
    for (int db = 0; db < 4; ++db) { const f32x4 o = G.o[db] * inv; ss += (o[0] * o[0] + o[1] * o[1]) + (o[2] * o[2] + o[3] * o[3]);
        u32x2 w; w.x = cvt_pk_bf16(o[0], o[1]); w.y = cvt_pk_bf16(o[2], o[3]); *(u32x2*)(MIX + tok * D + h * HD + 16 * db + 4 * g) = w; }
    ss = xsum16(ss); ss = xsum32(ss);
    if (g == 0) ssqa[tok * NH + h] = ss;
}
#define ATT_SYNC() do { asm volatile("s_waitcnt vmcnt(0) lgkmcnt(0)" ::: "memory"); __builtin_amdgcn_s_barrier(); asm volatile("" ::: "memory"); } while (0)
#define ATT_SB() __builtin_amdgcn_sched_barrier(0)
template <bool INR>
__device__ __forceinline__ void pair4(Grp& G0, Grp& G1, Grp& G2, Grp& G3, const LAS unsigned char* buf, int Rb, const LaneOff& lo, int ks0, int qs, int dq, int L, int lane) {
    f32x4 s0[2], s1[2], s2[2], s3[2]; bf16x8 p0, p1, p2, p3; float a0, a1, a2, a3;
    { bf16x8 k[2][2]; load_k(k, buf, Rb, lo); qk_part(G0, k, s0); qk_part(G1, k, s1); qk_part(G2, k, s2); qk_part(G3, k, s3); } ATT_SB();
    bf16x8 v[4]; load_v(v, buf, Rb, lo);
    sm_part<false, INR>(G0, s0, ks0, qs, L, lane, p0, a0); sm_part<false, INR>(G1, s1, ks0, qs + dq, L, lane, p1, a1); ATT_SB();
    sm_part<false, INR>(G2, s2, ks0, qs + 2 * dq, L, lane, p2, a2); sm_part<false, INR>(G3, s3, ks0, qs + 3 * dq, L, lane, p3, a3); ATT_SB();
    pv_part(G0, v, p0, a0); pv_part(G1, v, p1, a1); pv_part(G2, v, p2, a2); pv_part(G3, v, p3, a3); ATT_SB();
}
template <bool FULL, bool INR>
__device__ __forceinline__ void pair2(Grp& GA, Grp& GB, const LAS unsigned char* buf, int RbA, int RbB, const LaneOff& lo, int ks0, int qs, int L, int lane) {
    f32x4 s0[2], s1[2]; bf16x8 p0, p1; float a0, a1;
    { bf16x8 ka[2][2], kb[2][2]; load_k(ka, buf, RbA, lo); load_k(kb, buf, RbB, lo); qk_part(GA, ka, s0); qk_part(GB, kb, s1); } ATT_SB();
    bf16x8 va[4], vb[4]; load_v(va, buf, RbA, lo); load_v(vb, buf, RbB, lo);
    sm_part<FULL, INR>(GA, s0, ks0, qs, L, lane, p0, a0); sm_part<FULL, INR>(GB, s1, ks0, qs, L, lane, p1, a1); ATT_SB();
    pv_part(GA, va, p0, a0); pv_part(GB, vb, p1, a1); ATT_SB();
}
__device__ __forceinline__ void attn_unit(LAS unsigned char* lds, const bf16_t* Qb, const bf16_t* Kb, const bf16_t* Vb, bf16_t* MIX, float* ssqa, const float* ml, int b, int h, int c0, int tid, int wave, int lane_) {
    int lane = lane_; asm volatile("" : "+v"(lane));
    const int brow0 = b * SEQ, hrow0 = (b * NH + h) * SEQ, half = wave >> 2, w4 = wave & 3, ch = c0 + 256 * half;
    const unsigned lds0 = (unsigned)(uintptr_t)lds;
    const size_t tokb = (size_t)(brow0 + ch + w4);
    Grp G0, G1, G2, G3;
    const size_t qb0 = (size_t)(hrow0 + ch + w4);
    grp_init_state(G0, Qb, MIX, ml, tokb, qb0, h, lane); grp_init_state(G1, Qb, MIX, ml, tokb + 4, qb0 + 4, h, lane); grp_init_state(G2, Qb, MIX, ml, tokb + 8, qb0 + 8, h, lane); grp_init_state(G3, Qb, MIX, ml, tokb + 12, qb0 + 12, h, lane);
    ATT_SYNC();
    { int ln = lane; asm volatile("" : "+v"(ln)); stage_issue(lds0, (const char*)Kb, (const char*)Vb, hrow0, c0, step_id(0), wave, ln); }
#pragma nounroll
    for (int sx = 0; sx < NSTEP_; ++sx) { const int step = step_id(sx);
        ATT_SYNC();
        int ln = lane; asm volatile("" : "+v"(ln));
        if (sx + 1 < NSTEP_) stage_issue(lds0 + (unsigned)(((sx + 1) & 1) * BUFB), (const char*)Kb, (const char*)Vb, hrow0, c0, step_id(sx + 1), wave, ln);
        const LAS unsigned char* buf = lds + (sx & 1) * BUFB;
        LaneOff lo; lane_off(lo, ln); const int a = ln & 15;
#pragma nounroll
        for (int rep_ = 0; rep_ < D16_REP; ++rep_)
        if (step < 3) {
            const int qs = ch + w4 + 16 * a;
#pragma nounroll
            for (int p = 0; p < 4; ++p) { const int ks0 = ch - 64 + 128 * step + 32 * p;
                if (ks0 + 31 >= 0 && ks0 < SEQ) { const int Rb = 128 * half + 32 * p;
                    if (ks0 >= 0 && ks0 + 32 <= SEQ) pair4<true>(G0, G1, G2, G3, buf, Rb, lo, ks0, qs, 4, SEQ, ln); else pair4<false>(G0, G1, G2, G3, buf, Rb, lo, ks0, qs, 4, SEQ, ln); } }
        } else {
            const int s = step - 3, ks0 = (ch >> 2) - 64 + 32 * s, qs = (ch >> 2) + 4 * a;
            if (ks0 + 31 >= 0 && ks0 < SEQ / 4) { const int Rb = 128 * half + 32 * w4;
                if (ks0 >= 0 && ks0 + 32 <= SEQ / 4) pair4<true>(G0, G1, G2, G3, buf, Rb, lo, ks0, qs, 1, SEQ / 4, ln); else pair4<false>(G0, G1, G2, G3, buf, Rb, lo, ks0, qs, 1, SEQ / 4, ln); }
        }
    }
    { int lf = lane; asm volatile("" : "+v"(lf)); const size_t tf = (size_t)(brow0 + ch + w4);
      grp_finish(G0, MIX, ssqa, tf, h, lf); grp_finish(G1, MIX, ssqa, tf + 4, h, lf); grp_finish(G2, MIX, ssqa, tf + 8, h, lf); grp_finish(G3, MIX, ssqa, tf + 12, h, lf); }
}
constexpr int NVB = 49152;
__device__ __forceinline__ int vn_off(int row, int c) { return row * 128 + ((c ^ (((row >> 1) & 3) << 1)) << 4); }
template <int DIL>
__device__ __forceinline__ void nat_stage_v(unsigned ldsbuf, const char* Vg, int hrow0, int cres, int sub0, int wave, int lane) {
    constexpr int Ls = SEQ / DIL; const char* gb = pg8::uniform_ptr(Vg);
#pragma unroll
    for (int i = 0; i < 6; ++i) { const int blk = wave * 6 + i, row = 8 * blk + (lane >> 3), phys = lane & 7;
        const int c = phys ^ (((row >> 1) & 3) << 1);
        int sub = sub0 + row; sub = sub < 0 ? 0 : (sub > Ls - 1 ? Ls - 1 : sub);
        const unsigned voff = (unsigned)((hrow0 + cres + DIL * sub) * HD + c * 8) * 2u;
        pg8::glds16_sv(gb, voff, ldsbuf + (unsigned)blk * 1024u); __builtin_amdgcn_sched_barrier(0); }
}
template <int DIL>
__device__ __forceinline__ void nat_load_k1(bf16x8 (&k)[2][2], const bf16_t* Kb, int hrow0, int cres, int ksub, int lane) {
    constexpr int Ls = SEQ / DIL; const int key = lane & 15, g = lane >> 4;
#pragma unroll
    for (int t = 0; t < 2; ++t) { int sub = ksub + 16 * t + key; sub = sub < 0 ? 0 : (sub > Ls - 1 ? Ls - 1 : sub);
        const bf16_t* kp = Kb + (size_t)(hrow0 + cres + DIL * sub) * HD + 8 * g;
        k[t][0] = *(const bf16x8*)kp; k[t][1] = *(const bf16x8*)(kp + 32); }
}
template <bool FULL>
__device__ __forceinline__ void pair2n_post(Grp& GA, Grp& GB, f32x4 (&s0)[2], f32x4 (&s1)[2], const LAS unsigned char* vbuf, int Rb, const int (&vb)[4], int ks0, int qs, int Ls, int lane) {
    bf16x8 p0, p1; float a0, a1;
    bf16x8 v[4]; { const LAS unsigned char* rb = row_base(vbuf, Rb);
#pragma unroll
        for (int db = 0; db < 4; ++db) {
            const s16x4 v0 = __builtin_bit_cast(s16x4, __builtin_amdgcn_ds_read_tr16_b64_v4i16((LAS v4i16_t*)(rb + vb[db])));
            const s16x4 v1 = __builtin_bit_cast(s16x4, __builtin_amdgcn_ds_read_tr16_b64_v4i16((LAS v4i16_t*)(rb + 2048 + vb[db])));
            v[db] = (bf16x8){v0[0], v0[1], v0[2], v0[3], v1[0], v1[1], v1[2], v1[3]}; } }
    sm_part<FULL, true>(GA, s0, ks0, qs, Ls, lane, p0, a0); sm_part<FULL, true>(GB, s1, ks0, qs + 16, Ls, lane, p1, a1); ATT_SB();
    pv_part(GA, v, p0, a0); pv_part(GB, v, p1, a1); ATT_SB();
}
template <bool FULL>
__device__ __forceinline__ void pair2n(Grp& GA, Grp& GB, const bf16x8 (&k)[2][2], const LAS unsigned char* vbuf, int Rb, const int (&vb)[4], int ks0, int qs, int Ls, int lane) {
    f32x4 s0[2], s1[2];
    qk_part(GA, k, s0); qk_part(GB, k, s1); ATT_SB();
    pair2n_post<FULL>(GA, GB, s0, s1, vbuf, Rb, vb, ks0, qs, Ls, lane);
}
template <bool FULL>
__device__ __forceinline__ void pair2s(Grp& GA, Grp& GB, const LAS unsigned char* buf, int Rb, const LaneOff& lo, int ks0, int qs, int lane, const bf16_t* kdir = nullptr) {
    f32x4 s0[2], s1[2]; bf16x8 p0, p1; float a0, a1;
#ifdef D16_KDIRECT
    { bf16x8 k[2][2]; const int key = lane & 15, g = lane >> 4;
#pragma unroll
      for (int t = 0; t < 2; ++t) { const bf16_t* kp = kdir + (size_t)(16 * (ks0 + 16 * t + key)) * HD + 8 * g; k[t][0] = *(const bf16x8*)kp; k[t][1] = *(const bf16x8*)(kp + 32); }
      qk_part(GA, k, s0); qk_part(GB, k, s1); } ATT_SB();
#else
    { bf16x8 k[2][2]; load_k(k, buf, Rb, lo); qk_part(GA, k, s0); qk_part(GB, k, s1); } ATT_SB();
#endif
    bf16x8 v[4]; load_v(v, buf, Rb, lo);
    sm_part<FULL, true>(GA, s0, ks0, qs, SEQ / 16, lane, p0, a0); sm_part<FULL, true>(GB, s1, ks0, qs + 16, SEQ / 16, lane, p1, a1); ATT_SB();
    pv_part(GA, v, p0, a0); pv_part(GB, v, p1, a1); ATT_SB();
}
__device__ __forceinline__ void grp_finish_state(Grp& G, bf16_t* MIX, float* ml, size_t tok0, int h, int lane) {
    const int a = lane & 15, g = lane >> 4; float l = G.l; l = xsum16(l); l = xsum32(l);
    const float inv = 1.0f / l; const size_t tok = tok0 + 16 * a;
#pragma unroll
    for (int db = 0; db < 4; ++db) { const f32x4 o = G.o[db] * inv;
        u32x2 w; w.x = cvt_pk_bf16(o[0], o[1]); w.y = cvt_pk_bf16(o[2], o[3]); *(u32x2*)(MIX + tok * D + h * HD + 16 * db + 4 * g) = w; }
    if (g == 0) *(f32x2*)(ml + (tok * NH + h) * 2) = (f32x2){G.m, l};
}
__device__ __forceinline__ void d16_phase(LAS unsigned char* lds, const bf16_t* Qb, const bf16_t* Kb, const bf16_t* Vb, bf16_t* MIX, float* ml, int vcu, int G_, int dup, int wave, int lane_) {
    constexpr int NT = NB * NH * 16;
    const unsigned lds0 = (unsigned)(uintptr_t)lds;
    ATT_SYNC();
    if (vcu < NT * dup) { int ln = lane_; asm volatile("" : "+v"(ln)); const int L = vcu % NT, r = L & 15, bh = L >> 4;
#ifdef D16_VNAT
        nat_stage_v<16>(lds0 + 32768u, (const char*)Vb, bh * SEQ, r, -64, wave, ln); }
#else
        stage_issue(lds0, (const char*)Kb, (const char*)Vb, bh * SEQ, r, 99, wave, ln); }
#endif
    int it = 0;
#pragma nounroll
    for (int L0 = vcu; L0 < NT * dup; L0 += G_, ++it) {
        const int L = L0 % NT, r = L & 15, bh = L >> 4, b = bh / NH, h = bh % NH, brow0 = b * SEQ, hcol = h * HD;
        ATT_SYNC();
        int ln = lane_; asm volatile("" : "+v"(ln));
        if (L0 + G_ < NT * dup) { const int Ln = (L0 + G_) % NT, rn = Ln & 15, bhn = Ln >> 4;
#ifdef D16_VNAT
            nat_stage_v<16>(lds0 + 32768u + (unsigned)(((it + 1) & 1) * NVB), (const char*)Vb, bhn * SEQ, rn, -64, wave, ln); }
        const LAS unsigned char* buf = lds + (it & 1) * NVB + 64 * 128;
#else
            stage_issue(lds0 + (unsigned)(((it + 1) & 1) * BUFB), (const char*)Kb, (const char*)Vb, bhn * SEQ, rn, 99, wave, ln); }
        const LAS unsigned char* buf = lds + (it & 1) * BUFB;
#endif
        LaneOff lo; lane_off(lo, ln); const int a = ln & 15;
        Grp GA, GB; const size_t tokA = (size_t)(brow0 + r + 16 * (32 * wave));
        { const size_t qA = (size_t)(bh * SEQ + r + 16 * (32 * wave)); grp_init(GA, Qb, qA, ln); grp_init(GB, Qb, qA + 256, ln); }
        const int qs = 32 * wave + a;
#pragma nounroll
        for (int p5 = 0; p5 < 5 * D16_REP; ++p5) { const int p = p5 % 5; const int ks0 = 32 * wave - 64 + 32 * p;
            if (ks0 >= 0 && ks0 < SEQ / 16) {
                const bool full = (ks0 + 31 - 32 * wave <= 64) && (32 * wave + 15 - ks0 <= 64) && (ks0 + 31 - (32 * wave + 16) <= 64) && (32 * wave + 31 - ks0 <= 64);
                const bf16_t* kd = Kb + (size_t)(bh * SEQ + r) * HD;
#ifdef D16_PAIR2N
                { bf16x8 kk[2][2]; const int key = ln & 15, g = ln >> 4, q = (ln >> 2) & 3, p2 = ln & 3; int vb[4];
#pragma unroll
                  for (int db = 0; db < 4; ++db) vb[db] = vn_off(4 * g + q, 2 * db + (p2 >> 1)) + 8 * (p2 & 1);
#pragma unroll
                  for (int t = 0; t < 2; ++t) { const bf16_t* kp = kd + (size_t)(16 * (ks0 + 16 * t + key)) * HD + 8 * g; kk[t][0] = *(const bf16x8*)kp; kk[t][1] = *(const bf16x8*)(kp + 32); }
                  const LAS unsigned char* vbuf = lds + 32768 + (it & 1) * NVB;
                  if (full) pair2n<true>(GA, GB, kk, vbuf, ks0 + 64, vb, ks0, qs, SEQ / 16, ln); else pair2n<false>(GA, GB, kk, vbuf, ks0 + 64, vb, ks0, qs, SEQ / 16, ln); } } }
#else
                if (full) pair2s<true>(GA, GB, buf, ks0, lo, ks0, qs, ln, kd); else pair2s<false>(GA, GB, buf, ks0, lo, ks0, qs, ln, kd); } }
#endif
        grp_finish_state(GA, MIX, ml, tokA, h, ln); grp_finish_state(GB, MIX, ml, tokA + 256, h, ln);
    }
}
template <int DIL>
__device__ __forceinline__ void nat_load_k(bf16x8 (&k)[5][2][2], const bf16_t* Kb, int hrow0, int cres, int ksub_first, int lane) {
    constexpr int Ls = SEQ / DIL; const int key = lane & 15, g = lane >> 4;
#pragma unroll
    for (int p = 0; p < 5; ++p)
#pragma unroll
        for (int t = 0; t < 2; ++t) { int sub = ksub_first + 32 * p + 16 * t + key; sub = sub < 0 ? 0 : (sub > Ls - 1 ? Ls - 1 : sub);
            const bf16_t* kp = Kb + (size_t)(hrow0 + cres + DIL * sub) * HD + 8 * g;
            k[p][t][0] = *(const bf16x8*)kp; k[p][t][1] = *(const bf16x8*)(kp + 32); }
}
template <int DIL, bool FIRST>
__device__ __forceinline__ void nat_init_state(Grp& G, const bf16_t* MIX, const float* ml, size_t tok0, int h, int lane) {
    const int a = lane & 15, g = lane >> 4;
    if constexpr (FIRST) {
#pragma unroll
        for (int d = 0; d < 4; ++d) G.o[d] = (f32x4){0.f, 0.f, 0.f, 0.f};
        G.m = MFLOOR; G.l = 0.f;
    } else { const size_t tok = tok0 + DIL * a; const f32x2 st = *(const f32x2*)(ml + (tok * NH + h) * 2);
        G.m = st[0]; G.l = st[1] * 0.25f;
#pragma unroll
        for (int db = 0; db < 4; ++db) { const u32x2 w = *(const u32x2*)(MIX + tok * D + h * HD + 16 * db + 4 * g);
            G.o[db] = (f32x4){bflo(w.x), bfhi(w.x), bflo(w.y), bfhi(w.y)} * st[1]; } }
}
template <int DIL, bool LAST>
__device__ __forceinline__ void nat_finish(Grp& G, bf16_t* MIX, float* ml, float* ssqa, size_t tok0, int h, int lane) {
    const int a = lane & 15, g = lane >> 4; float l = G.l; l = xsum16(l); l = xsum32(l);
    const float inv = 1.0f / l; const size_t tok = tok0 + DIL * a; float ss = 0.f;
#pragma unroll
    for (int db = 0; db < 4; ++db) { const f32x4 o = G.o[db] * inv; ss += (o[0] * o[0] + o[1] * o[1]) + (o[2] * o[2] + o[3] * o[3]);
        u32x2 w; w.x = cvt_pk_bf16(o[0], o[1]); w.y = cvt_pk_bf16(o[2], o[3]); *(u32x2*)(MIX + tok * D + h * HD + 16 * db + 4 * g) = w; }
    if constexpr (LAST) { ss = xsum16(ss); ss = xsum32(ss); if (g == 0) ssqa[tok * NH + h] = ss; }
    else { if (g == 0) *(f32x2*)(ml + (tok * NH + h) * 2) = (f32x2){G.m, l}; }
}
template <int DIL, bool FIRST, bool LAST>
__device__ __forceinline__ void nat_pass(LAS unsigned char* lds, const bf16_t* Qb, const bf16_t* Kb, const bf16_t* Vb, bf16_t* MIX, float* ml, float* ssqa, int vcu, int G_, int dup, int wave, int lane_) {
    constexpr int Ls = SEQ / DIL, NCH = Ls / 256, NT = NB * NH * 16;
    const unsigned lds0 = (unsigned)(uintptr_t)lds;
    bf16x8 kf[5][2][2], qn[4];
    ATT_SYNC();
    if (vcu < NT * dup) { int ln = lane_; asm volatile("" : "+v"(ln)); const int L = vcu % NT, sub = L & 15, bh = L >> 4, cres = sub / NCH, l0 = 256 * (sub % NCH);
        nat_load_k<DIL>(kf, Kb, bh * SEQ, cres, l0 + 32 * wave - 64, ln);
        { const int a = ln & 15, g = ln >> 4; const bf16_t* qp = Qb + ((size_t)(bh * SEQ + cres + DIL * (l0 + 32 * wave)) + DIL * a) * HD + 8 * g;
          qn[0] = *(const bf16x8*)qp; qn[1] = *(const bf16x8*)(qp + 32); qn[2] = *(const bf16x8*)(qp + 16 * DIL * HD); qn[3] = *(const bf16x8*)(qp + 16 * DIL * HD + 32); }
        nat_stage_v<DIL>(lds0, (const char*)Vb, bh * SEQ, cres, l0 - 64, wave, ln); }
    int it = 0;
#pragma nounroll
    for (int L0 = vcu; L0 < NT * dup; L0 += G_, ++it) {
        const int L = L0 % NT, sub = L & 15, bh = L >> 4, b = bh / NH, h = bh % NH, cres = sub / NCH, l0 = 256 * (sub % NCH);
        ATT_SYNC();
        int ln = lane_; asm volatile("" : "+v"(ln));
        const bool has_next = L0 + G_ < NT * dup; const int Ln = (L0 + G_) % NT, subn = Ln & 15, bhn = Ln >> 4, cresn = subn / NCH, l0n = 256 * (subn % NCH);
        const LAS unsigned char* vbuf = lds + (it & 1) * NVB;
        const int a = ln & 15, g = ln >> 4, q = (ln >> 2) & 3, p2 = ln & 3;
        int vb[4];
#pragma unroll
        for (int db = 0; db < 4; ++db) vb[db] = vn_off(4 * g + q, 2 * db + (p2 >> 1)) + 8 * (p2 & 1);
        Grp GA, GB; const int pos0 = cres + DIL * (l0 + 32 * wave);
        const size_t tokA = (size_t)(b * SEQ + pos0);
        GA.q0 = qn[0]; GA.q1 = qn[1]; GB.q0 = qn[2]; GB.q1 = qn[3];
        nat_init_state<DIL, FIRST>(GA, MIX, ml, tokA, h, ln); nat_init_state<DIL, FIRST>(GB, MIX, ml, tokA + 16 * DIL, h, ln);
        if constexpr (!FIRST) asm volatile("s_waitcnt vmcnt(0)" ::: "memory");
        if (has_next) { nat_stage_v<DIL>(lds0 + (unsigned)(((it + 1) & 1) * NVB), (const char*)Vb, bhn * SEQ, cresn, l0n - 64, wave, ln);
            const bf16_t* qp = Qb + ((size_t)(bhn * SEQ + cresn + DIL * (l0n + 32 * wave)) + DIL * a) * HD + 8 * g;
            qn[0] = *(const bf16x8*)qp; qn[1] = *(const bf16x8*)(qp + 32); qn[2] = *(const bf16x8*)(qp + 16 * DIL * HD); qn[3] = *(const bf16x8*)(qp + 16 * DIL * HD + 32); }
        const int qs = l0 + 32 * wave + a;
#pragma unroll
        for (int p = 0; p < 5; ++p) { const int ks0 = l0 + 32 * wave - 64 + 32 * p; const bool act = (ks0 >= 0 && ks0 < Ls);
            f32x4 s0[2], s1[2];
            if (act) { qk_part(GA, kf[p], s0); qk_part(GB, kf[p], s1); ATT_SB(); }
            if (has_next) nat_load_k1<DIL>(kf[p], Kb, bhn * SEQ, cresn, l0n + 32 * wave - 64 + 32 * p, ln);
            if (act) { const int ql = l0 + 32 * wave; const bool full = (ks0 + 31 - ql <= 64) && (ql + 31 - ks0 <= 64);
                if (full) pair2n_post<true>(GA, GB, s0, s1, vbuf, 32 * wave + 32 * p, vb, ks0, qs, Ls, ln); else pair2n_post<false>(GA, GB, s0, s1, vbuf, 32 * wave + 32 * p, vb, ks0, qs, Ls, ln); } }
        nat_finish<DIL, LAST>(GA, MIX, ml, ssqa, tokA, h, ln); nat_finish<DIL, LAST>(GB, MIX, ml, ssqa, tokA + 16 * DIL, h, ln);
    }
}
__device__ __forceinline__ void conv_unit(LAS unsigned char* lds, const bf16_t* Cb, bf16_t* MIX, const float* dw_w, const float* dw_b, const float* ln_g, const float* ln_b, const float* out_g,
                                          int b, int s0, int tid_, int wave, int lane_) {
    int tid = tid_, lane = lane_; asm volatile("" : "+v"(tid), "+v"(lane));
    LAS bf16_t* CT = (LAS bf16_t*)lds;
    LAS float* CO = (LAS float*)(lds + 49152);
    ATT_SYNC();
    for (int p = tid; p < 94 * 32; p += NWAVES * 64) { const int row = p >> 5, c = p & 31, s = s0 - 15 + row;
        u32x4 v = (u32x4){0u, 0u, 0u, 0u};
        if (s >= 0 && s < SEQ) v = *(const u32x4*)(Cb + (size_t)(b * SEQ + s) * CCH + c * 8);
        *(LAS u32x4*)(CT + row * CCH + c * 8) = v; }
    ATT_SYNC();
    { const int ch = tid & 255, half = tid >> 8; float v[62], w[CONVK];
#pragma unroll
      for (int k = 0; k < CONVK; ++k) w[k] = dw_w[k * CCH + ch];
#pragma unroll
      for (int i = 0; i < 62; ++i) v[i] = bf2f(CT[(32 * half + i) * CCH + ch]);
      const float bias = dw_b[ch];
#pragma unroll
      for (int p = 0; p < 32; ++p) { float acc = bias;
#pragma unroll
          for (int k = 0; k < CONVK; ++k) acc += v[p + k] * w[k];
          CO[(32 * half + p) * CCH + ch] = acc; } }
    ATT_SYNC();
    { const f32x4 g4 = *((const f32x4*)ln_g + lane), b4 = *((const f32x4*)ln_b + lane), og = *((const f32x4*)out_g + lane);
#pragma unroll
      for (int pp = 0; pp < 8; ++pp) { const int p = wave * 8 + pp; const f32x4 xv = *(const LAS f32x4*)(CO + p * CCH + 4 * lane);
          const float mean = wave_sum((xv[0] + xv[1]) + (xv[2] + xv[3])) * (1.f / CCH); const f32x4 dx = xv - mean;
          const float var = wave_sum((dx[0] * dx[0] + dx[1] * dx[1]) + (dx[2] * dx[2] + dx[3] * dx[3])) * (1.f / CCH); const float rstd = 1.0f / sqrtf(var + LN_EPS);
          f32x4 z;
#pragma unroll
          for (int i = 0; i < 4; ++i) { const float y = dx[i] * rstd * g4[i] + b4[i]; z[i] = y / (1.f + __expf(-y)); }
          const float ms = wave_sum((z[0] * z[0] + z[1] * z[1]) + (z[2] * z[2] + z[3] * z[3])) * (1.f / CCH); const float rs = 1.0f / sqrtf(ms + NORM_EPS);
          u32x2 o; o.x = cvt_pk_bf16(z[0] * rs * og[0], z[1] * rs * og[1]); o.y = cvt_pk_bf16(z[2] * rs * og[2], z[3] * rs * og[3]);
          *(u32x2*)(MIX + (size_t)(b * SEQ + s0 + p) * D + AW + 4 * lane) = o; } }
}
}
namespace moe {
#define MOE_SYNC() do { asm volatile("s_waitcnt vmcnt(0) lgkmcnt(0)" ::: "memory"); __builtin_amdgcn_s_barrier(); asm volatile("" ::: "memory"); } while (0)
__device__ __forceinline__ void split_hi_lo(const f32x4& a, const f32x4& b, bf16x8& hi, bf16x8& lo) {
    u32x4 h, l; float r[8];
    h.x = cvt_pk_bf16(a[0], a[1]); h.y = cvt_pk_bf16(a[2], a[3]); h.z = cvt_pk_bf16(b[0], b[1]); h.w = cvt_pk_bf16(b[2], b[3]);
    r[0] = a[0] - bflo(h.x); r[1] = a[1] - bfhi(h.x); r[2] = a[2] - bflo(h.y); r[3] = a[3] - bfhi(h.y);
    r[4] = b[0] - bflo(h.z); r[5] = b[1] - bfhi(h.z); r[6] = b[2] - bflo(h.w); r[7] = b[3] - bfhi(h.w);
    l.x = cvt_pk_bf16(r[0], r[1]); l.y = cvt_pk_bf16(r[2], r[3]); l.z = cvt_pk_bf16(r[4], r[5]); l.w = cvt_pk_bf16(r[6], r[7]);
    hi = __builtin_bit_cast(bf16x8, h); lo = __builtin_bit_cast(bf16x8, l);
}
__device__ __forceinline__ void route_chunk(LAS unsigned char* lds, const bf16_t* x2, const float* ssq2, const bf16_t* WRF, const float* b_router, const float* b_group,
                                            int* tok_e, float* tok_gate, float* tok_rs, int* hist, int chunk, int tid, int wave, int lane) {
    LAS unsigned char* WB = lds;
    LAS float* LG = (LAS float*)(lds + 49152);
    LAS int* HS = (LAS int*)(lds + 49152 + 36864);
    const int tk = lane & 15, g = lane >> 4;
    f32x4 acc[2][3];
#pragma unroll
    for (int gi = 0; gi < 2; ++gi)
#pragma unroll
        for (int nt = 0; nt < 3; ++nt) acc[gi][nt] = (f32x4){0.f, 0.f, 0.f, 0.f};
    if (tid < 32) HS[tid] = 0;
    const bf16_t* xb = x2 + (size_t)(chunk * 256 + wave * 32 + tk) * D + 8 * g;
#pragma nounroll
    for (int kc = 0; kc < 4; ++kc) {
        MOE_SYNC();
#pragma unroll
        for (int i = 0; i < 6; ++i) { const int p = tid + 512 * i; *(LAS u32x4*)(WB + p * 16) = *(const u32x4*)((const char*)WRF + (size_t)kc * 49152 + p * 16); }
        MOE_SYNC();
#pragma unroll
        for (int gi = 0; gi < 2; ++gi) {
            bf16x8 xa[8];
#pragma unroll
            for (int s = 0; s < 8; ++s) xa[s] = *(const bf16x8*)(xb + (size_t)gi * 16 * D + kc * 256 + s * 32);
#pragma unroll
            for (int s = 0; s < 8; ++s) {
#pragma unroll
                for (int nt = 0; nt < 3; ++nt) { const LAS unsigned char* bp = WB + ((s * 3 + nt) * 2) * 1024 + lane * 16;
                    const bf16x8 bh = *(const LAS bf16x8*)bp, bl = *(const LAS bf16x8*)(bp + 1024);
                    acc[gi][nt] = __builtin_amdgcn_mfma_f32_16x16x32_bf16(xa[s], bh, acc[gi][nt], 0, 0, 0);
                    acc[gi][nt] = __builtin_amdgcn_mfma_f32_16x16x32_bf16(xa[s], bl, acc[gi][nt], 0, 0, 0); } }
        }
    }
#pragma unroll
    for (int gi = 0; gi < 2; ++gi)
#pragma unroll
        for (int nt = 0; nt < 3; ++nt) { const int o = 16 * nt + tk;
            if (o < 36) {
#pragma unroll
                for (int r = 0; r < 4; ++r) LG[(wave * 32 + gi * 16 + 4 * g + r) * 36 + o] = acc[gi][nt][r]; } }
    MOE_SYNC();
    if (wave < 4) { const int tr = wave * 64 + lane, tg = chunk * 256 + tr; const LAS float* lg = LG + tr * 36;
        const f32x4* sp = (const f32x4*)(ssq2 + (size_t)tg * 16); const f32x4 st = (sp[0] + sp[1]) + (sp[2] + sp[3]);
        const float rs = 1.0f / sqrtf(((st[0] + st[1]) + (st[2] + st[3])) * (1.f / D) + NORM_EPS);
        tok_rs[tg] = rs;
        float gl[4];
#pragma unroll
        for (int j = 0; j < 4; ++j) gl[j] = lg[32 + j] * rs + b_group[j];
        float gm = gl[0]; int gi = 0;
#pragma unroll
        for (int j = 1; j < 4; ++j) { if (gl[j] > gm) { gm = gl[j]; gi = j; } }
        float den = 0.f;
#pragma unroll
        for (int j = 0; j < 4; ++j) den += __expf(gl[j] - gm);
        const float gp = 1.0f / den;
        float v0 = -3.0e38f, v1 = -3.0e38f; int i0 = 0, i1 = 0;
#pragma unroll
        for (int j = 0; j < 8; ++j) { const float v = lg[gi * 8 + j] * rs + b_router[gi * 8 + j];
            if (v > v0) { v1 = v0; i1 = i0; v0 = v; i0 = j; } else if (v > v1) { v1 = v; i1 = j; } }
        const float dd = __expf(v1 - v0), g0 = gp / (1.f + dd), g1 = gp * dd / (1.f + dd);
        const int e0 = gi * 8 + i0, e1 = gi * 8 + i1;
        __hip_atomic_fetch_add(HS + e0, 1, __ATOMIC_RELAXED, __HIP_MEMORY_SCOPE_WORKGROUP); __hip_atomic_fetch_add(HS + e1, 1, __ATOMIC_RELAXED, __HIP_MEMORY_SCOPE_WORKGROUP);
        tok_e[tg] = e0 | (e1 << 8); tok_gate[2 * tg] = g0; tok_gate[2 * tg + 1] = g1; }
    MOE_SYNC();
    if (tid < 32) hist[chunk * 32 + tid] = HS[tid];
}
__device__ __forceinline__ void slot_chunk(LAS unsigned char* lds, const int* hist, const int* tok_e, const float* tok_gate, const float* tok_rs, int* tok_slot, int* row_tok, float* slot_rs, float* slot_gate, int* etile,
                                           int chunk, int tid, int wave, int lane) {
    LAS int* CNT = (LAS int*)lds; LAS int* BASE = CNT + 32; LAS int* PST = CNT + 64; LAS int* WC = CNT + 128;
    MOE_SYNC();
    if (tid < 32) { int tot = 0, bs = 0; for (int cc = 0; cc < 256; ++cc) { const int hh = hist[cc * 32 + tid]; bs += (cc < chunk) ? hh : 0; tot += hh; } CNT[tid] = tot; BASE[tid] = bs; }
    MOE_SYNC();
    if (tid == 0) { int ps = 0; for (int e = 0; e < 32; ++e) { PST[e] = ps; ps += ((CNT[e] + 255) >> 8) << 8; } PST[32] = ps; }
    MOE_SYNC();
    int ek[2] = {0, 0}, rank[2] = {0, 0}; const int t = chunk * 256 + (wave & 3) * 64 + lane;
    if (wave < 4) { const int ev = tok_e[t]; ek[0] = ev & 255; ek[1] = ev >> 8;
#pragma unroll
        for (int k = 0; k < 2; ++k)
#pragma nounroll
            for (int e = 0; e < 32; ++e) { const unsigned long long m = __ballot(ek[k] == e);
                if (ek[k] == e) rank[k] = __popcll(m & ((1ull << lane) - 1ull));
                if (lane == 0) WC[(k * 4 + wave) * 32 + e] = __popcll(m); } }
    MOE_SYNC();
    if (wave < 4) {
#pragma unroll
        for (int k = 0; k < 2; ++k) { int off = 0;
            for (int kw = 0; kw < k * 4 + wave; ++kw) off += WC[kw * 32 + ek[k]];
            const int slot = PST[ek[k]] + BASE[ek[k]] + off + rank[k];
            row_tok[slot] = t; slot_rs[slot] = tok_rs[t]; slot_gate[slot] = tok_gate[2 * t + k]; tok_slot[2 * t + k] = slot; } }
    if (chunk < 32) { const int e = chunk, c0 = PST[e] + CNT[e], n = PST[e + 1] - c0;
        for (int i = tid; i < n; i += NWAVES * 64) { row_tok[c0 + i] = 0; slot_rs[c0 + i] = 0.f; slot_gate[c0 + i] = 0.f; } }
    if (chunk == 0 && tid <= 32) etile[tid] = PST[tid] >> 8;
}
__device__ __forceinline__ void final_row(float* xo, const bf16_t* X2, const bf16_t* Y, const int* tok_slot, const float* g, int t, int lane) {
    const int s0 = tok_slot[2 * t], s1 = tok_slot[2 * t + 1];
    f32x4* xr = (f32x4*)(xo + (size_t)t * D) + lane; const u32x2* x2 = (const u32x2*)(X2 + (size_t)t * D) + lane;
    const u32x2* y0 = (const u32x2*)(Y + (size_t)s0 * D) + lane; const u32x2* y1 = (const u32x2*)(Y + (size_t)s1 * D) + lane;
    const f32x4* gr = (const f32x4*)g + lane;
    f32x4 v[4]; float s = 0.f;
#pragma unroll
    for (int j = 0; j < 4; ++j) { const u32x2 x = x2[64 * j], a = y0[64 * j], b = y1[64 * j];
        v[j][0] = bflo(x.x) + (bflo(a.x) + bflo(b.x)); v[j][1] = bfhi(x.x) + (bfhi(a.x) + bfhi(b.x)); v[j][2] = bflo(x.y) + (bflo(a.y) + bflo(b.y)); v[j][3] = bfhi(x.y) + (bfhi(a.y) + bfhi(b.y));
        s += (v[j][0] * v[j][0] + v[j][1] * v[j][1]) + (v[j][2] * v[j][2] + v[j][3] * v[j][3]); }
    const float rs = 1.0f / sqrtf(wave_sum(s) * (1.f / D) + NORM_EPS);
#pragma unroll
    for (int j = 0; j < 4; ++j) xr[64 * j] = v[j] * rs * gr[64 * j];
}
}
#ifndef MK_N_LAUNCHES
#define MK_N_LAUNCHES 1
#endif
constexpr int NPH = 11;
constexpr int N_LAUNCHES = MK_N_LAUNCHES;

#define ARG_IN(k) karg_ptr(8 * (k))
#define ARG_OUT ((float*)karg_ptr(8 * 27))
#define ARG_WS ((unsigned char*)karg_ptr(8 * 28))
template <int LO, int HI>
__global__ void __launch_bounds__(NWAVES * 64, 2) mega_fwd(Args args) {
    extern __shared__ __attribute__((aligned(16))) unsigned char lds_raw[];
    Frame F;
    F.lds = (LAS unsigned char*)lds_raw;
    F.MISC = (volatile LAS unsigned*)(F.lds + LDSCTL_OFF);
    F.wave = __builtin_amdgcn_readfirstlane((int)threadIdx.x >> 6);
    F.G = gridDim.x; { const int bx = blockIdx.x; F.vcu = (F.G % 8 == 0) ? (bx % 8) * (F.G / 8) + bx / 8 : bx; }
    F.ws = ARG_WS; F.ctl = (unsigned*)(ARG_WS + WS_CTL);
    for (int u = threadIdx.x; u < (LDS_BYTES - LDSCTL_OFF) / 4; u += NWAVES * 64) ((LAS unsigned*)(F.lds + LDSCTL_OFF))[u] = 0u;
    __syncthreads();
    XcdBarrier bar; bar.bar = F.ctl + CW_BAR; bar.x = 0; bar.st = nullptr;
    if (HI - LO > 1) bar = xcd_barrier_post(F.ctl + CW_BAR, F.MISC + 8);
#define GRID_BAR() do { if (HI - LO > 1) xcd_barrier(bar); } while (0)
#ifndef PH_MASK
#define PH_MASK 0x7ff
#endif
#define IN(k) ((((PH_MASK) >> (k)) & 1) && LO <= (k) && (k) < HI)
#define BOTH(k) (IN(k) && IN((k) + 1))
#ifndef DUP_PHASE
#define DUP_PHASE -1
#endif
#define DUPF(k) ((k) == DUP_PHASE ? 2 : 1)
    const int gw = F.vcu * NWAVES + F.wave, NGW = F.G * NWAVES;
#define R1 ((bf16_t*)(ARG_WS + WS_R1))
#define R2 ((bf16_t*)(ARG_WS + WS_R2))
#define ssqa ((float*)(ARG_WS + WS_SSQA))
#define ssq1 ((float*)(ARG_WS + WS_SSQ1))
#define ssq2 ((float*)(ARG_WS + WS_SSQ2))
#define tok_e ((int*)(ARG_WS + WS_TOK + TK_E))
#define tok_gate ((float*)(ARG_WS + WS_TOK + TK_GATE))
#define tok_slot ((int*)(ARG_WS + WS_TOK + TK_SLOT))
#define tok_rs ((float*)(ARG_WS + WS_TOK + TK_RS))
#define row_tok ((int*)(ARG_WS + WS_TOK + TK_ROWTOK))
#define slot_rs ((float*)(ARG_WS + WS_TOK + TK_SLOTRS))
#define slot_gate ((float*)(ARG_WS + WS_TOK + TK_SLOTGATE))
#define hist ((int*)(ARG_WS + WS_HIST))
#define etile ((int*)(ARG_WS + WS_HIST + HIST_ETILE))
#define WR ((const bf16_t*)(ARG_WS + WS_HIST + HIST_WR))

    if (IN(0)) { p0_prologue(F); if (DUPF(0) == 2) { asm volatile("s_waitcnt vmcnt(0)" ::: "memory"); __syncthreads(); p0_prologue(F); } if (BOTH(0)) GRID_BAR(); }

    if (IN(1)) {
        { pg8::GridOrder S; S.init(R1, ARG_WS + WS_WIN, D, D, T, INW, F.G, (int)blockIdx.x); S.dup = DUPF(1);
          pg8::EpiU E{R2, (bf16_t*)(ARG_WS + WS_Q), (bf16_t*)(ARG_WS + WS_K), (bf16_t*)(ARG_WS + WS_V), (const float*)(ARG_WS + WS_ROPE), (const float*)(ARG_WS + WS_ROPE) + SEQ * 32};
          pg8::gemm_phase<pg8::EpiU, pg8::GridOrder, false, false>(F.lds, F.wave, D, D, D, S, E); }
        { pg8::KvOrder S{(const char*)(ARG_WS + WS_MEMN), (const char*)(ARG_WS + WS_WXK), (const char*)(ARG_WS + WS_WXV), F.G, (int)blockIdx.x};
          pg8::EpiPlain<false> E{(bf16_t*)(ARG_WS + WS_KX), D, (bf16_t*)(ARG_WS + WS_VX), D, nullptr};
          pg8::gemm_phase<pg8::EpiPlain<false>, pg8::KvOrder, true, false>(F.lds, F.wave, D, D, D, S, E); }
        if (BOTH(1)) GRID_BAR();
    }

    if (IN(2)) {
        { pg8::MnOrder S{(const char*)(ARG_WS + WS_KX), (const char*)(ARG_WS + WS_WXQ), (const char*)(ARG_WS + WS_WXO), (const char*)(ARG_WS + WS_VX), F.G, F.vcu, 1};
          pg8::EpiPlain<false> E{(bf16_t*)(ARG_WS + WS_MT), D, (bf16_t*)(ARG_WS + WS_NT), D, nullptr};
          pg8::gemm_phase<pg8::EpiPlain<false>, pg8::MnOrder, true, false>(F.lds, F.wave, D, D, XHD, S, E); }
#define ATT_ARGS F.lds, (const bf16_t*)(ARG_WS + WS_Q), (const bf16_t*)(ARG_WS + WS_K), (const bf16_t*)(ARG_WS + WS_V), R1, (float*)(ARG_WS + WS_SSQ1), ssqa, F.vcu, F.G
#ifdef D16_KDIRECT
        att::d16_phase(F.lds, (const bf16_t*)(ARG_WS + WS_Q), (const bf16_t*)(ARG_WS + WS_K), (const bf16_t*)(ARG_WS + WS_V), R1, (float*)(ARG_WS + WS_SSQ1), F.vcu, F.G, 1, F.wave, lane_id());
#else
        att::nat_pass<16, true, false>(ATT_ARGS, DUPF(20), F.wave, lane_id());
#endif
        asm volatile("s_waitcnt vmcnt(0) lgkmcnt(0)" ::: "memory"); __syncthreads(); GRID_BAR();
#ifdef NAT_BISECT
        for (int L0 = F.vcu; L0 < NB * NH * 8; L0 += F.G) { const int L = L0 % (NB * NH * 8); const int chunk = L & 7, bh = L >> 3, b = bh / NH, h = bh % NH;
            att::attn_unit(F.lds, (const bf16_t*)(ARG_WS + WS_Q), (const bf16_t*)(ARG_WS + WS_K), (const bf16_t*)(ARG_WS + WS_V), R1, ssqa, (const float*)(ARG_WS + WS_SSQ1), b, h, chunk * 512, F.wave * 64 + lane_id(), F.wave, lane_id()); }
#else
        att::nat_pass<4, false, false>(ATT_ARGS, 1, F.wave, lane_id());
        asm volatile("s_waitcnt vmcnt(0) lgkmcnt(0)" ::: "memory"); __syncthreads(); GRID_BAR();
        att::nat_pass<1, false, true>(ATT_ARGS, 1, F.wave, lane_id());
#endif
        for (int L = F.vcu; L < NB * 64; L += F.G) { const int b = L >> 6, j = L & 63;
            att::conv_unit(F.lds, R2, R1, (const float*)ARG_IN(5), (const float*)ARG_IN(6), (const float*)ARG_IN(7), (const float*)ARG_IN(8), (const float*)ARG_IN(9), b, j * 64, F.wave * 64 + lane_id(), F.wave, lane_id()); }
        asm volatile("s_waitcnt vmcnt(0) lgkmcnt(0)" ::: "memory"); __syncthreads();
        if (BOTH(2)) GRID_BAR();
    }

    if (IN(3)) {
        pg8::GridOrder S; S.init(R1, ARG_WS + WS_WOUT, D, D, T, D, F.G, (int)blockIdx.x); S.dup = DUPF(3);
        pg8::EpiResid<true> E{(const float*)ARG_IN(0), R2, ssq1, ssqa};
        pg8::gemm_phase<pg8::EpiResid<true>, pg8::GridOrder, true, false>(F.lds, F.wave, D, D, D, S, E);
        if (BOTH(3)) GRID_BAR();
    }

    if (IN(4)) {
        pg8::BatchOrder S{(const char*)R2, (const char*)(ARG_WS + WS_MT), (T / 256) * 4, F.G, (int)blockIdx.x, DUPF(4)};
        pg8::EpiSoftmax E{(bf16_t*)(ARG_WS + WS_PM), ssq1};
        pg8::gemm_phase<pg8::EpiSoftmax, pg8::BatchOrder, true, false>(F.lds, F.wave, D, D, D, S, E);
        if (BOTH(4)) GRID_BAR();
    }

    if (IN(5)) {
        pg8::BatchOrder S{(const char*)(ARG_WS + WS_PM), (const char*)(ARG_WS + WS_NT), (T / 256) * 4, F.G, (int)blockIdx.x, 1};
        pg8::EpiResid<false> E{nullptr, R2, ssq2, nullptr};
        pg8::gemm_phase<pg8::EpiResid<false>, pg8::BatchOrder, true, false>(F.lds, F.wave, D, D, D, S, E);
        if (BOTH(5)) GRID_BAR();
    }

    if (IN(6)) {
        for (int c0_ = blockIdx.x; c0_ < (T / 256) * DUPF(6); c0_ += F.G) { const int c = c0_ % (T / 256);
            moe::route_chunk(F.lds, R2, ssq2, WR, (const float*)ARG_IN(22), (const float*)ARG_IN(20), tok_e, tok_gate, tok_rs, hist, c, F.wave * 64 + lane_id(), F.wave, lane_id()); }
        asm volatile("s_waitcnt vmcnt(0) lgkmcnt(0)" ::: "memory"); __syncthreads();
        if (BOTH(6)) GRID_BAR();
    }

    if (IN(7)) {
        for (int c1_ = blockIdx.x; c1_ < (T / 256) * DUPF(7); c1_ += F.G) { const int c = c1_ % (T / 256);
            moe::slot_chunk(F.lds, hist, tok_e, tok_gate, tok_rs, tok_slot, row_tok, slot_rs, slot_gate, etile, c, F.wave * 64 + lane_id(), F.wave, lane_id()); }
        asm volatile("s_waitcnt vmcnt(0) lgkmcnt(0)" ::: "memory"); __syncthreads();
        if (BOTH(7)) GRID_BAR();
    }

    if (IN(8)) {
        pg8::MoeOrder<0> S{(const char*)R2, (const char*)(ARG_WS + WS_W13), row_tok, etile, F.G, (int)blockIdx.x, DUPF(8)};
        pg8::EpiMoe1 E{(bf16_t*)(ARG_WS + WS_HID), slot_rs};
        pg8::gemm_phase<pg8::EpiMoe1, pg8::MoeOrder<0>, true, true>(F.lds, F.wave, D, D, D, S, E);
        if (BOTH(8)) GRID_BAR();
    }

    if (IN(9)) {
        pg8::MoeOrder<1> S{(const char*)(ARG_WS + WS_HID), (const char*)(ARG_WS + WS_W2), row_tok, etile, F.G, (int)blockIdx.x, DUPF(9)};
        pg8::EpiMoe2 E{(bf16_t*)(ARG_WS + WS_Y), slot_gate};
        pg8::gemm_phase<pg8::EpiMoe2, pg8::MoeOrder<1>, true, false>(F.lds, F.wave, FF, FF, FF, S, E);
        if (BOTH(9)) GRID_BAR();
    }

    if (IN(10)) {
        for (int t0_ = gw; t0_ < T * DUPF(10); t0_ += NGW) { const int t = t0_ % T; moe::final_row(ARG_OUT, R2, (const bf16_t*)(ARG_WS + WS_Y), tok_slot, (const float*)ARG_IN(26), t, lane_id()); }
    }
#undef IN
#undef BOTH
}

typedef void (*kern_t)(Args);
template <int... I> struct PhList {};
extern "C" void kernel_launch(void* const* d_in, const int* in_sizes, int n_in, void* d_out, int out_size, void* d_ws, size_t ws_size, hipStream_t stream) {
    static int grid = 0;
#if MK_N_LAUNCHES == 1
    static const kern_t kerns[1] = {mega_fwd<0, NPH>};
#else
    static const kern_t kerns[NPH] = {mega_fwd<0, 1>, mega_fwd<1, 2>, mega_fwd<2, 3>, mega_fwd<3, 4>, mega_fwd<4, 5>, mega_fwd<5, 6>, mega_fwd<6, 7>, mega_fwd<7, 8>, mega_fwd<8, 9>, mega_fwd<9, 10>, mega_fwd<10, 11>};
#endif
    if (grid == 0) {
        if (n_in != 27 || in_sizes[0] != T * D || out_size != T * D || ws_size < WS_END) { fprintf(stderr, "kernel_launch: unexpected problem: n_in %d in0 %d out %d ARG_WS %zu (need %zu)\n", n_in, n_in > 0 ? in_sizes[0] : -1, out_size, ws_size, (size_t)WS_END); grid = -1; return; }
        int dev = 0, cus = 0, per_cu = 0;
        if (hipGetDevice(&dev) != hipSuccess || hipDeviceGetAttribute(&cus, hipDeviceAttributeMultiprocessorCount, dev) != hipSuccess) { grid = -1; return; }
        for (int li = 0; li < N_LAUNCHES; ++li)
            if (hipFuncSetAttribute((const void*)kerns[li], hipFuncAttributeMaxDynamicSharedMemorySize, LDS_BYTES) != hipSuccess) { fprintf(stderr, "kernel_launch: hipFuncSetAttribute failed\n"); grid = -1; return; }
        if (hipOccupancyMaxActiveBlocksPerMultiprocessor(&per_cu, (const void*)kerns[0], NWAVES * 64, LDS_BYTES) != hipSuccess || per_cu < 1) { fprintf(stderr, "kernel_launch: occupancy query says %d\n", per_cu); }
        (void)hipGetLastError();
        grid = cus;
    }
    if (grid < 0) return;
    if (hipMemsetAsync((char*)d_ws + WS_CTL, 0, CTL_ZERO_BYTES, stream) != hipSuccess) return;
    Args a{};
    for (int i = 0; i < 27; ++i) a.in[i] = d_in[i];
    a.out = (float*)d_out; a.ws = (unsigned char*)d_ws;
    for (int li = 0; li < N_LAUNCHES; ++li) {
        a.ph_lo = 0; a.ph_hi = 0; a.li = li; a.pad = 0;
        hipLaunchKernelGGL(kerns[li], dim3(grid), dim3(NWAVES * 64), LDS_BYTES, stream, a);
        const hipError_t le = hipPeekAtLastError();
        if (le != hipSuccess) { fprintf(stderr, "kernel_launch: launch %d failed: %s\n", li, hipGetErrorName(le)); break; }
    }
}
```

```cpp
#include <hip/hip_runtime.h>
#include <cstdio>
#include <cstdint>

#define GAS __attribute__((address_space(1)))
#define LAS __attribute__((address_space(3)))
typedef unsigned short bf16_t;
typedef short bf16x8 __attribute__((ext_vector_type(8)));
typedef short s16x4 __attribute__((ext_vector_type(4)));
typedef float f32x4 __attribute__((ext_vector_type(4)));
typedef float f32x2 __attribute__((ext_vector_type(2)));
typedef unsigned u32x4 __attribute__((ext_vector_type(4)));
typedef unsigned u32x2 __attribute__((ext_vector_type(2)));

constexpr int NB = 16, SEQ = 4096, T = NB * SEQ, D = 1024;
constexpr int CCH = 256, NH = 12, HD = 64, AW = NH * HD, INW = 2 * CCH + 3 * AW;
constexpr int MEML = 256, MROWS = NB * MEML, XH = 4, XHD = 256;
constexpr int NE = 32, EPG = 8, NG = 4, FF = 512;
constexpr int CONVK = 31;
constexpr int A_PAD = T * 2 + NE * 256;
constexpr float NORM_EPS = 1e-6f, LN_EPS = 1e-5f;
constexpr float LOG2E = 1.4426950408889634f;

constexpr size_t MiB = 1u << 20;
constexpr size_t WS_CTL = 0, CTL_ZERO_BYTES = 1 * MiB;
constexpr size_t WS_ROPE = 1 * MiB;
constexpr size_t WS_HIST = 2 * MiB;
constexpr size_t WS_SSQA = 4 * MiB;
constexpr size_t WS_SSQ1 = 8 * MiB;
constexpr size_t WS_SSQ2 = 12 * MiB;
constexpr size_t WS_WIN = 16 * MiB, WS_WOUT = 22 * MiB, WS_WXQ = 24 * MiB, WS_WXK = 26 * MiB, WS_WXV = 28 * MiB, WS_WXO = 30 * MiB;
constexpr size_t WS_W13 = 32 * MiB, WS_W2 = 96 * MiB;
constexpr size_t WS_MEMN = 128 * MiB, WS_KX = 136 * MiB, WS_VX = 144 * MiB;
constexpr size_t WS_TOK = 152 * MiB;
constexpr size_t WS_R1 = 160 * MiB;
constexpr size_t WS_R2 = 288 * MiB;
constexpr size_t WS_Q = 320 * MiB, WS_K = 416 * MiB, WS_V = 512 * MiB;
constexpr size_t WS_MT = 672 * MiB, WS_NT = 704 * MiB;
constexpr size_t WS_PM = 544 * MiB;
constexpr size_t WS_HID = 416 * MiB;
constexpr size_t WS_Y = 552 * MiB;
constexpr size_t WS_END = 824 * MiB;
constexpr size_t TK_E = 0;
constexpr size_t TK_GATE = 1 * MiB;
constexpr size_t TK_SLOT = 2 * MiB;
constexpr size_t TK_RS = 3 * MiB;
constexpr size_t TK_ROWTOK = 4 * MiB;
constexpr size_t TK_SLOTRS = 5 * MiB;
constexpr size_t TK_SLOTGATE = 6 * MiB;
constexpr size_t HIST_ETILE = 64 * 1024, HIST_WR = 128 * 1024;

constexpr int CW_BAR = 4096;

constexpr int NWAVES = 8;
constexpr int RING_BYTES = 131072;
constexpr int XCH_OFF = RING_BYTES;
constexpr int LDSCTL_OFF = RING_BYTES + 12288;
constexpr int LDS_BYTES = 147456;

#define LDS_WAIT() asm volatile("s_waitcnt lgkmcnt(0)" ::: "memory")
#define VM_WAIT() asm volatile("s_waitcnt vmcnt(0)" ::: "memory")
__device__ __forceinline__ unsigned f2bf(float f) { unsigned u = __builtin_bit_cast(unsigned, f); return (u + 0x7fffu + ((u >> 16) & 1u)) >> 16; }
__device__ __forceinline__ unsigned pk2(float lo, float hi) { return f2bf(lo) | (f2bf(hi) << 16); }
__device__ __forceinline__ float bf2f(unsigned short b) { return __builtin_bit_cast(float, (unsigned)b << 16); }
__device__ __forceinline__ float bflo(unsigned w) { return __builtin_bit_cast(float, w << 16); }
__device__ __forceinline__ float bfhi(unsigned w) { return __builtin_bit_cast(float, w & 0xffff0000u); }
typedef __bf16 bf16x2_t __attribute__((ext_vector_type(2)));
__device__ __forceinline__ unsigned cvt_pk_bf16(float lo, float hi) { const f32x2 v = {lo, hi}; return __builtin_bit_cast(unsigned, __builtin_convertvector(v, bf16x2_t)); }
__device__ __forceinline__ float wave_sum(float v) {
#pragma unroll
    for (int o = 1; o < 64; o <<= 1) v += __shfl_xor(v, o);
    return v;
}
__device__ __forceinline__ int lane_id() { return (int)__builtin_amdgcn_mbcnt_hi(~0u, __builtin_amdgcn_mbcnt_lo(~0u, 0u)); }
#define MK_N_LAUNCHES 1
namespace pg8 {
constexpr int BM = 256, BK = 64, HALF = 128, HTB = HALF * BK * 2  , STAGE_BYTES = 8 * HTB, NXCD = 8, WGM = 8;

__host__ __device__ __forceinline__ int lds_byte(int r, int c) { const int st = (r >> 4) * 2 + (c >> 5), rr = r & 15, cc = c & 31, ob = rr * 64 + cc * 2; return st * 1024 + (ob ^ (((ob >> 9) & 1) << 5)); }
__host__ __device__ __forceinline__ void stage_rc(int b, int& R, int& C) { const int st = b / 1024, sb = b % 1024, swz = sb ^ (((sb >> 9) & 1) << 5); R = (st >> 1) * 16 + swz / 64; C = (st & 1) * 32 + (swz % 64) / 2; }
__host__ __device__ __forceinline__ int perm32(int rho) { const int n = rho >> 4, i = rho & 15; return 8 * (i >> 2) + 4 * n + (i & 3); }

struct Unit { const char* a; const char* b; const int* rows; int pm, pn, x0, x1; };

typedef f32x4 Acc[2][2][4][2];

__device__ __forceinline__ const char* uniform_ptr(const char* p) { const unsigned long long v = (unsigned long long)p;
    const unsigned lo = __builtin_amdgcn_readfirstlane((unsigned)v), hi = __builtin_amdgcn_readfirstlane((unsigned)(v >> 32)); return (const char*)(((unsigned long long)hi << 32) | lo); }
__device__ __forceinline__ void glds16_sv(const char* gbase, unsigned voff, unsigned lds_dst) { unsigned keep;
    asm volatile("s_mov_b32 %0, m0\n\ts_mov_b32 m0, %3\n\ts_nop 2\n\tglobal_load_lds_dwordx4 %1, %2\n\ts_mov_b32 m0, %0" : "=&s"(keep) : "v"(voff), "s"(gbase), "s"(lds_dst) : "memory"); }
template <class Epi, class Sched, bool ALIGN_EPI, bool GATHER>
__device__ __forceinline__ void gemm_phase(LAS unsigned char* lds, const int wave_, const int lda, const int ldb, const int K, const Sched& S, const Epi& E) {
    int lane_ = lane_id(); asm volatile("" : "+v"(lane_));
    const int wid = __builtin_amdgcn_readfirstlane(wave_), tid = wid * 64 + lane_, lane = tid & 63, wr = wid >> 2, wc = wid & 3, fr = lane & 15, fq = lane >> 4;
    const int nt = K / BK;
    int Rr[2], Cc[2];
    unsigned vA[2][2], vN[2][2], voffB[2];
#pragma unroll
    for (int i = 0; i < 2; ++i) { int R, C; stage_rc(tid * 16 + i * 8192, R, C); Rr[i] = R; Cc[i] = C; const int Rb = Epi::PERM ? ((R & ~31) + perm32(R & 31)) : R;
        voffB[i] = (unsigned)(Rb * ldb + C) * 2u; }
    const size_t kstep = (size_t)(BK * 2);
    const size_t hstepB = (size_t)HALF * ldb * 2, hstepA = (size_t)HALF * lda * 2;
    const unsigned ldsw = (unsigned)wid * 1024u, lds0 = (unsigned)(uintptr_t)lds;
    const int aoff = lds_byte(wr * 64 + fr, fq * 8), boff = lds_byte(wc * 32 + fr, fq * 8);
#define PG8_SA(b, h) (((b) * 2 + (h)) * HTB)
#define PG8_SB(b, h) ((4 + (b) * 2 + (h)) * HTB)
#define PG8_STAGE(bufoff, gbase, voff) do { _Pragma("unroll") for (int _i = 0; _i < 2; ++_i) glds16_sv((gbase), (voff)[_i], lds0 + (unsigned)(bufoff) + ldsw + _i * 8192u); } while (0)
#define PG8_LDA(dst, b, h) do { _Pragma("unroll") for (int m = 0; m < 4; ++m) _Pragma("unroll") for (int k = 0; k < 2; ++k) dst[m][k] = *(const LAS bf16x8*)(lds + PG8_SA(b, h) + aoff + m * 2048 + k * 1024); } while (0)
#define PG8_LDB(dst, b, h) do { _Pragma("unroll") for (int n = 0; n < 2; ++n) _Pragma("unroll") for (int k = 0; k < 2; ++k) dst[n][k] = *(const LAS bf16x8*)(lds + PG8_SB(b, h) + boff + n * 2048 + k * 1024); } while (0)
#define PG8_MMA(ai, bj, At, Bt) do { __builtin_amdgcn_s_setprio(1); _Pragma("unroll") for (int m = 0; m < 4; ++m) _Pragma("unroll") for (int n = 0; n < 2; ++n) _Pragma("unroll") for (int k = 0; k < 2; ++k) \
        acc[ai][bj][m][n] = __builtin_amdgcn_mfma_f32_16x16x32_bf16(Bt[n][k], At[m][k], acc[ai][bj][m][n], 0, 0, 0); __builtin_amdgcn_s_setprio(0); } while (0)
#define PG8_WAIT_V(n) asm volatile("s_waitcnt vmcnt(" #n ")" ::: "memory")
#define PG8_WAIT_L(n) asm volatile("s_waitcnt lgkmcnt(" #n ")" ::: "memory")
#define PG8_BAR __builtin_amdgcn_s_barrier()
#define PG8_SCHED __builtin_amdgcn_sched_barrier(0)
#define PG8_VOFF(dst, u) do { _Pragma("unroll") for (int _h = 0; _h < 2; ++_h) _Pragma("unroll") for (int _i = 0; _i < 2; ++_i) { \
        if constexpr (GATHER) dst[_h][_i] = (unsigned)(u).rows[_h * HALF + Rr[_i]] * (unsigned)(lda * 2) + (unsigned)(Cc[_i] * 2); \
        else dst[_h][_i] = (unsigned)(Rr[_i] * lda + Cc[_i]) * 2u; } } while (0)
#define PG8_STAGE_A(bufoff, gbase, h, vv) do { if constexpr (GATHER) { PG8_STAGE(bufoff, gbase, vv[h]); } else { PG8_STAGE(bufoff, (gbase) + (h) * hstepA, vv[0]); } } while (0)
    Unit cur, nxt; int ui = 0;
    if (!S.next(0, cur)) return;
    Acc acc;
#pragma unroll
    for (int a = 0; a < 2; ++a)
#pragma unroll
        for (int b = 0; b < 2; ++b)
#pragma unroll
            for (int m = 0; m < 4; ++m)
#pragma unroll
                for (int n = 0; n < 2; ++n) acc[a][b][m][n] = (f32x4){0.f, 0.f, 0.f, 0.f};
    bf16x8 At[4][2], B0[2][2], B1[2][2];
    const char* cA = uniform_ptr(cur.a); const char* cB = uniform_ptr(cur.b);
    PG8_VOFF(vA, cur);
    if constexpr (GATHER) { asm volatile("s_waitcnt vmcnt(0)" ::: "memory"); }
    PG8_STAGE(PG8_SB(0, 0), cB, voffB); PG8_STAGE(PG8_SB(0, 1), cB + hstepB, voffB); PG8_STAGE_A(PG8_SA(0, 0), cA, 0, vA); PG8_STAGE_A(PG8_SA(0, 1), cA, 1, vA);
    if (wr == 1) PG8_BAR;
    PG8_WAIT_V(2); PG8_BAR;
    PG8_STAGE(PG8_SB(1, 0), cB + kstep, voffB); PG8_STAGE_A(PG8_SA(1, 0), cA + kstep, 0, vA); PG8_STAGE(PG8_SB(1, 1), cB + hstepB + kstep, voffB);
    PG8_WAIT_V(6); PG8_BAR;
    for (;;) {
        const bool has_next = S.next(ui + 1, nxt);
        const char* nA = has_next ? uniform_ptr(nxt.a) : cA; const char* nB = has_next ? uniform_ptr(nxt.b) : cB;
        if constexpr (GATHER) { if (has_next) { PG8_VOFF(vN, nxt); } else {
#pragma unroll
            for (int h = 0; h < 2; ++h) { vN[h][0] = vA[h][0]; vN[h][1] = vA[h][1]; } } }
#pragma nounroll
        for (int t = 0; t < nt; t += 2) {
            const bool last = (t == nt - 2);
            if constexpr (Epi::HAS_MID) { if (t == E.mid_t()) E.mid(acc, cur, wr, wc, fr, fq); }
            const char* a1 = cA + (size_t)(t + 1) * kstep;
            const char* a2 = last ? nA : cA + (size_t)(t + 2) * kstep; const char* b2 = last ? nB : cB + (size_t)(t + 2) * kstep;
            const char* a3 = a2 + kstep; const char* b3 = b2 + kstep;
            unsigned vW[2][2];
#pragma unroll
            for (int h = 0; h < 2; ++h) { vW[h][0] = vA[h][0]; vW[h][1] = vA[h][1]; if constexpr (GATHER) { if (last) { vW[h][0] = vN[h][0]; vW[h][1] = vN[h][1]; } } }
            PG8_LDB(B0, 0, 0); PG8_LDB(B1, 0, 1); PG8_SCHED; PG8_LDA(At, 0, 0); PG8_STAGE_A(PG8_SA(1, 1), a1, 1, vA);
            PG8_WAIT_V(8); PG8_WAIT_L(0); PG8_BAR; PG8_MMA(0, 0, At, B0); PG8_MMA(0, 1, At, B1); PG8_BAR; PG8_SCHED;
            PG8_LDA(At, 0, 1); PG8_STAGE(PG8_SB(0, 0), b2, voffB); PG8_STAGE(PG8_SB(0, 1), b2 + hstepB, voffB); PG8_STAGE_A(PG8_SA(0, 0), a2, 0, vW);
            PG8_WAIT_V(8); PG8_WAIT_L(0); PG8_BAR; PG8_MMA(1, 0, At, B0); PG8_MMA(1, 1, At, B1); PG8_BAR; PG8_SCHED;
            PG8_LDB(B0, 1, 0); PG8_LDB(B1, 1, 1); PG8_SCHED; PG8_LDA(At, 1, 0); PG8_STAGE_A(PG8_SA(0, 1), a2, 1, vW);
            PG8_WAIT_V(8); PG8_WAIT_L(0); PG8_BAR; PG8_MMA(0, 0, At, B0); PG8_MMA(0, 1, At, B1); PG8_BAR; PG8_SCHED;
            PG8_LDA(At, 1, 1); PG8_STAGE(PG8_SB(1, 0), b3, voffB); PG8_STAGE(PG8_SB(1, 1), b3 + hstepB, voffB); PG8_STAGE_A(PG8_SA(1, 0), a3, 0, vW);
            PG8_WAIT_V(8); PG8_WAIT_L(0); PG8_BAR; PG8_MMA(1, 0, At, B0); PG8_MMA(1, 1, At, B1); PG8_BAR; PG8_SCHED;
        }
        if constexpr (ALIGN_EPI) { if (wr == 0) PG8_BAR; }
        E(acc, cur, wr, wc, fr, fq, lds, wid, lane);
        if (!has_next) break;
#pragma unroll
        for (int a = 0; a < 2; ++a)
#pragma unroll
            for (int b = 0; b < 2; ++b)
#pragma unroll
                for (int m = 0; m < 4; ++m)
#pragma unroll
                    for (int n = 0; n < 2; ++n) acc[a][b][m][n] = (f32x4){0.f, 0.f, 0.f, 0.f};
        cur = nxt; cA = nA; cB = nB; ++ui;
        if constexpr (GATHER) {
#pragma unroll
            for (int h = 0; h < 2; ++h) { vA[h][0] = vN[h][0]; vA[h][1] = vN[h][1]; } }
        if constexpr (ALIGN_EPI) { if (wr == 1) PG8_BAR; }
    }
    PG8_WAIT_V(0);
    if constexpr (!ALIGN_EPI) { if (wr == 0) PG8_BAR; }
    PG8_BAR;
#undef PG8_SA
#undef PG8_SB
#undef PG8_STAGE
#undef PG8_LDA
#undef PG8_LDB
#undef PG8_MMA
#undef PG8_WAIT_V
#undef PG8_WAIT_L
#undef PG8_BAR
#undef PG8_SCHED
#undef PG8_VOFF
#undef PG8_STAGE_A
}
}
#define XB_TMO      128
#define XB_XCNT(j)  (256  + 64 * (j))
#define XB_XSUB(j)  (1280 + 64 * (j))
#define XB_XGEN(j)  (2304 + 64 * (j))
#define XB_TOP      3328
#define XB_TOPGEN   3392
#define XCD_BAR_WORDS 3456
#define XB_SPIN_CAP (1u << 18)

__device__ __forceinline__ unsigned xb_ld(unsigned* p)              { return __hip_atomic_load(p, __ATOMIC_RELAXED, __HIP_MEMORY_SCOPE_AGENT); }
__device__ __forceinline__ unsigned xb_add(unsigned* p, unsigned v) { return __hip_atomic_fetch_add(p, v, __ATOMIC_RELAXED, __HIP_MEMORY_SCOPE_AGENT); }
__device__ __forceinline__ unsigned xb_xcc_id() { return (unsigned)__builtin_amdgcn_s_getreg((3 << 11) | 20) & 0xFu; }
#define XB_SPIN(cond, bar) do { unsigned _sp = 0; while (cond) { __builtin_amdgcn_s_sleep(1); \
    if ((++_sp & 255u) == 0u) { if (xb_ld(&(bar)[XB_TMO])) break; if (_sp > XB_SPIN_CAP) { atomicAdd(&(bar)[XB_TMO], 1u); break; } } } } while (0)

struct XcdBarrier {
    unsigned* bar; unsigned x;
    volatile LAS unsigned* st;
};

__device__ __forceinline__ XcdBarrier xcd_barrier_post(unsigned* bar, volatile LAS unsigned* st) {
    XcdBarrier b; b.bar = bar; b.x = xb_xcc_id(); b.st = st;
    if (threadIdx.x == 0) (void)xb_add(&bar[XB_XCNT(b.x)], 1u);
    return b;
}
__device__ __forceinline__ void xcd_barrier_complete(unsigned* bar, unsigned x, unsigned& nloc, unsigned& nx) {
    const unsigned G = gridDim.x * gridDim.y * gridDim.z;
    unsigned sum, cnt, mine, sp = 0u;
    for (;;) {
        sum = 0u; cnt = 0u; mine = 0u;
#pragma unroll
        for (unsigned j = 0; j < 16; ++j) { const unsigned c = xb_ld(&bar[XB_XCNT(j)]); sum += c; cnt += (c > 0u) ? 1u : 0u; mine = (j == x) ? c : mine; }
        if (sum == G) break;
        __builtin_amdgcn_s_sleep(1);
        if ((++sp & 255u) == 0u) { if (xb_ld(&bar[XB_TMO])) break; if (sp > XB_SPIN_CAP) { atomicAdd(&bar[XB_TMO], 1u); break; } }
    }
    nloc = mine > 0u ? mine : 1u; nx = cnt > 0u ? cnt : 1u;
}

__device__ __forceinline__ void xcd_barrier(const XcdBarrier& b) {
    asm volatile("s_waitcnt vmcnt(0)" ::: "memory");
    __syncthreads();
    if (threadIdx.x == 0) {
        unsigned* bar = b.bar;
        __builtin_amdgcn_s_waitcnt(0);
        unsigned nloc = b.st[0], nx = b.st[1];
        if (nloc == 0u) { xcd_barrier_complete(bar, b.x, nloc, nx); b.st[0] = nloc; b.st[1] = nx; }
        const unsigned old = xb_add(&bar[XB_XSUB(b.x)], 1u);
        const unsigned gen = old / nloc;
        if (old + 1u == (gen + 1u) * nloc) {
            __builtin_amdgcn_fence(__ATOMIC_RELEASE, "agent");
            asm volatile("s_waitcnt vmcnt(0)" ::: "memory");
            const unsigned og = xb_add(&bar[XB_TOP], 1u);
            const unsigned tg = og / nx;
            if (og + 1u == (tg + 1u) * nx) xb_add(&bar[XB_TOPGEN], 1u);
            else XB_SPIN(xb_ld(&bar[XB_TOPGEN]) == tg, bar);
            __builtin_amdgcn_fence(__ATOMIC_ACQUIRE, "agent");
            xb_add(&bar[XB_XGEN(b.x)], 1u);
            asm volatile("s_waitcnt vmcnt(0)" ::: "memory");
        } else {
            XB_SPIN(xb_ld(&bar[XB_XGEN(b.x)]) == gen, bar);
            __builtin_amdgcn_fence(__ATOMIC_ACQUIRE, "agent");
            asm volatile("s_waitcnt vmcnt(0)" ::: "memory");
        }
    }
    __syncthreads();
}

namespace pg8 {
#define EPI_NOMID static constexpr bool HAS_MID = false; __device__ __forceinline__ int mid_t() const { return -1; } __device__ __forceinline__ void mid(Acc&, const Unit&, int, int, int, int) const {}
#define RAW_BARRIER() do { asm volatile("s_waitcnt lgkmcnt(0)" ::: "memory"); __builtin_amdgcn_s_barrier(); asm volatile("" ::: "memory"); } while (0)

__device__ __forceinline__ u32x4 pack8(const f32x4& v0, const f32x4& v1) { u32x4 w; w.x = cvt_pk_bf16(v0[0], v0[1]); w.y = cvt_pk_bf16(v0[2], v0[3]); w.z = cvt_pk_bf16(v1[0], v1[1]); w.w = cvt_pk_bf16(v1[2], v1[3]); return w; }

struct GridOrder {
    const char* A; const char* Bt; int lda, ldb, nM, nN, nwg, G, c, dup;
    __device__ __forceinline__ void init(const void* A_, const void* Bt_, int lda_, int ldb_, int M, int N, int G_, int c_) { A = (const char*)A_; Bt = (const char*)Bt_; lda = lda_; ldb = ldb_; nM = M / BM; nN = N / BM; nwg = nM * nN; G = G_; c = c_; dup = 1; }
    __device__ __forceinline__ bool next(int i, Unit& u) const {
        const long L = (long)i * G + c; if (L >= (long)nwg * dup) return false;
        int wgid = (int)(L % nwg); { const int q = nwg / NXCD, r = nwg % NXCD, xcd = wgid % NXCD, off = wgid / NXCD; wgid = (xcd < r ? xcd * (q + 1) : r * (q + 1) + (xcd - r) * q) + off; }
        const int nig = WGM * nN, gid = wgid / nig, fm = gid * WGM, gsz = (nM - fm) < WGM ? (nM - fm) : WGM;
        u.pm = fm + ((wgid % nig) % gsz); u.pn = (wgid % nig) / gsz; u.x0 = 0; u.x1 = 0; u.rows = nullptr;
        u.a = A + (size_t)u.pm * BM * lda * 2; u.b = Bt + (size_t)u.pn * BM * ldb * 2; return true;
    }
};
struct KvOrder {
    const char* memn; const char* wk; const char* wv; int G, c;
    __device__ __forceinline__ bool next(int i, Unit& u) const {
        const int L = i * G + c; if (L >= 128) return false;
        const int l = L & 63; u.rows = nullptr; u.x1 = 0; u.x0 = L >> 6; u.pm = l >> 2; u.pn = l & 3;
        u.a = memn + (size_t)u.pm * BM * D * 2; u.b = (u.x0 ? wv : wk) + (size_t)u.pn * BM * D * 2;
        return true;
    }
};
struct MnOrder {
    const char* kx; const char* wq2; const char* wxoT; const char* vx; int G, c, dup;
    __device__ __forceinline__ bool next(int i, Unit& u) const {
        int L = i * G + c; if (L >= 512 * dup) return false;
        L &= 511; const int l = L & 255, bh = l >> 2, t4 = l & 3, b = bh >> 2, h = bh & 3; u.rows = nullptr; u.x1 = 0;
        if (L < 256) { u.x0 = 0; u.pm = b * 4 + h; u.pn = t4; u.a = kx + ((size_t)b * MEML * D + h * XHD) * 2; u.b = wq2 + ((size_t)t4 * BM * D + h * XHD) * 2; }
        else { u.x0 = 1; u.pm = b * 4 + t4; u.pn = h; u.a = wxoT + ((size_t)t4 * BM * D + h * XHD) * 2; u.b = vx + ((size_t)b * MEML * D + h * XHD) * 2; }
        return true;
    }
};
struct BatchOrder {
    const char* A; const char* Bt; int nwg, G, c, dup;
    __device__ __forceinline__ bool next(int i, Unit& u) const {
        const long L = (long)i * G + c; if (L >= (long)nwg * dup) return false;
        int wgid = (int)(L % nwg); { const int q = nwg / NXCD, r = nwg % NXCD, xcd = wgid % NXCD, off = wgid / NXCD; wgid = (xcd < r ? xcd * (q + 1) : r * (q + 1) + (xcd - r) * q) + off; }
        const int nN = 4, nM = T / BM, nig = WGM * nN, gid = wgid / nig, fm = gid * WGM, gsz = (nM - fm) < WGM ? (nM - fm) : WGM;
        u.pm = fm + ((wgid % nig) % gsz); u.pn = (wgid % nig) / gsz; u.x0 = 0; u.x1 = 0; u.rows = nullptr;
        u.a = A + (size_t)u.pm * BM * D * 2; u.b = Bt + ((size_t)(u.pm >> 4) * D + u.pn * BM) * D * 2; return true;
    }
};
template <int MODE> struct MoeOrder {
    const char* A; const char* W; const int* rowtok; const int* etile; int G, c, dup;
    __device__ __forceinline__ bool next(int i, Unit& u) const {
        int L = i * G + c; const int ntile = etile[NE];
        if (L >= ntile * 4 * dup) return false;
        L %= ntile * 4;
        const int rt = L >> 2, ct = L & 3; int e = 0;
        for (int j = 1; j < NE; ++j) e = (etile[j] <= rt) ? j : e;
        u.pm = rt; u.pn = ct; u.x0 = e; u.x1 = 0;
        if (MODE == 0) { u.a = A; u.rows = rowtok + rt * BM; u.b = W + ((size_t)e * 1024 + ct * BM) * D * 2; }
        else { u.a = A + (size_t)rt * BM * FF * 2; u.rows = nullptr; u.b = W + ((size_t)e * 1024 + ct * BM) * FF * 2; }
        return true;
    }
};

struct EpiU {
    static constexpr bool PERM = true; EPI_NOMID
    bf16_t* Cb; bf16_t* Q; bf16_t* Kb; bf16_t* V; const float* ropec; const float* ropes;
    __device__ __forceinline__ void operator()(Acc& acc, const Unit& u, int wr, int wc, int fr, int fq, LAS unsigned char*, int, int) const {
        const int row0 = u.pm * BM + wr * 64 + fr;
        if (u.pn < 2) {
#pragma unroll
            for (int ai = 0; ai < 2; ++ai)
#pragma unroll
                for (int m = 0; m < 4; ++m) { const int row = row0 + ai * HALF + m * 16; f32x4 o[2];
#pragma unroll
                    for (int n = 0; n < 2; ++n)
#pragma unroll
                        for (int i = 0; i < 4; ++i) { const float a = acc[ai][0][m][n][i], g = acc[ai][1][m][n][i]; o[n][i] = a / (1.f + __expf(-g)); }
                    *(u32x4*)(Cb + (size_t)row * CCH + u.pn * HALF + wc * 32 + fq * 8) = pack8(o[0], o[1]); }
        } else if (u.pn < 8) {
            const int sec = (u.pn - 2) / 3, tt = (u.pn - 2) % 3; bf16_t* dst = sec ? Kb : Q; const float sc = sec ? 1.f : 0.125f * LOG2E;
            const int hd = 4 * tt + wc;
#pragma unroll
            for (int ai = 0; ai < 2; ++ai)
#pragma unroll
                for (int m = 0; m < 4; ++m) { const int row = row0 + ai * HALF + m * 16; const int s = row & (SEQ - 1); f32x4 o1[2], o2[2];
#pragma unroll
                    for (int n = 0; n < 2; ++n) { const f32x4 cs = *(const f32x4*)(ropec + s * 32 + fq * 8 + n * 4), sn = *(const f32x4*)(ropes + s * 32 + fq * 8 + n * 4);
                        const f32x4 x1 = acc[ai][0][m][n], x2 = acc[ai][1][m][n];
                        o1[n] = (x1 * cs - x2 * sn) * sc; o2[n] = (x1 * sn + x2 * cs) * sc; }
                    bf16_t* p = dst + ((size_t)((row >> 12) * NH + hd) * SEQ + s) * HD + fq * 8;
                    *(u32x4*)p = pack8(o1[0], o1[1]); *(u32x4*)(p + 32) = pack8(o2[0], o2[1]); }
        } else {
            const int tt = u.pn - 8;
#pragma unroll
            for (int ai = 0; ai < 2; ++ai)
#pragma unroll
                for (int m = 0; m < 4; ++m) { const int row = row0 + ai * HALF + m * 16;
#pragma unroll
                    for (int bj = 0; bj < 2; ++bj) { const int col = tt * BM + bj * HALF + wc * 32 + fq * 8;
                        *(u32x4*)(V + ((size_t)((row >> 12) * NH + (col >> 6)) * SEQ + (row & (SEQ - 1))) * HD + (col & 63)) = pack8(acc[ai][bj][m][0], acc[ai][bj][m][1]); } }
        }
    }
};
template <bool ROWSCALE> struct EpiPlain {
    static constexpr bool PERM = true; EPI_NOMID
    bf16_t* O0; int ldc0; bf16_t* O1; int ldc1; const float* ssq16;
    __device__ __forceinline__ void operator()(Acc& acc, const Unit& u, int wr, int wc, int fr, int fq, LAS unsigned char*, int, int) const {
        bf16_t* O = u.x0 ? O1 : O0; const int ldc = u.x0 ? ldc1 : ldc0;
        const int row0 = u.pm * BM + wr * 64 + fr, col0 = u.pn * BM + wc * 32 + fq * 8;
#pragma unroll
        for (int ai = 0; ai < 2; ++ai)
#pragma unroll
            for (int m = 0; m < 4; ++m) { const int row = row0 + ai * HALF + m * 16; float rs = 1.f;
                if constexpr (ROWSCALE) { const f32x4* sp = (const f32x4*)(ssq16 + (size_t)row * 16); const f32x4 s0 = sp[0], s1 = sp[1], s2 = sp[2], s3 = sp[3];
                    const f32x4 st = (s0 + s1) + (s2 + s3); rs = 1.0f / sqrtf(((st[0] + st[1]) + (st[2] + st[3])) * (1.0f / D) + NORM_EPS); }
#pragma unroll
                for (int bj = 0; bj < 2; ++bj) *(u32x4*)(O + (size_t)row * ldc + col0 + bj * HALF) = pack8(acc[ai][bj][m][0] * rs, acc[ai][bj][m][1] * rs); }
    }
};
template <bool MID> struct EpiResid {
    static constexpr bool PERM = false, HAS_MID = MID;
    const float* xin; bf16_t* XB; float* ssqp; const float* ssqa;
    __device__ __forceinline__ int mid_t() const { return AW / BK; }
    __device__ __forceinline__ void mid(Acc& acc, const Unit& u, int wr, int wc, int fr, int fq) const {
        const int row0 = u.pm * BM + wr * 64 + fr;
#pragma unroll
        for (int ai = 0; ai < 2; ++ai)
#pragma unroll
            for (int m = 0; m < 4; ++m) { const int row = row0 + ai * HALF + m * 16; const f32x4* sp = (const f32x4*)(ssqa + (size_t)row * NH);
                const f32x4 s0 = sp[0], s1 = sp[1], s2 = sp[2]; const f32x4 st = (s0 + s1) + s2;
                const float r = 1.0f / sqrtf(((st[0] + st[1]) + (st[2] + st[3])) * (1.0f / AW) + NORM_EPS);
#pragma unroll
                for (int bj = 0; bj < 2; ++bj)
#pragma unroll
                    for (int n = 0; n < 2; ++n) acc[ai][bj][m][n] = acc[ai][bj][m][n] * r;
                asm volatile("" ::: "memory"); }
    }
    __device__ __forceinline__ void operator()(Acc& acc, const Unit& u, int wr, int wc, int fr, int fq, LAS unsigned char*, int, int) const {
        const int row0 = u.pm * BM + wr * 64 + fr, col0 = u.pn * BM + wc * 32 + fq * 4;
#pragma unroll
        for (int ai = 0; ai < 2; ++ai)
#pragma unroll
            for (int m = 0; m < 4; ++m) { const int row = row0 + ai * HALF + m * 16; float ss = 0.f;
#pragma unroll
                for (int bj = 0; bj < 2; ++bj)
#pragma unroll
                    for (int n = 0; n < 2; ++n) { const size_t o = (size_t)row * D + col0 + bj * HALF + n * 16; f32x4 v;
                        if constexpr (MID) v = *(const f32x4*)(xin + o) + acc[ai][bj][m][n];
                        else { const u32x2 xb = *(const u32x2*)(XB + o); v = (f32x4){bflo(xb.x), bfhi(xb.x), bflo(xb.y), bfhi(xb.y)} + acc[ai][bj][m][n]; }
                        u32x2 w; w.x = cvt_pk_bf16(v[0], v[1]); w.y = cvt_pk_bf16(v[2], v[3]); *(u32x2*)(XB + o) = w;
                        ss += (v[0] * v[0] + v[1] * v[1]) + (v[2] * v[2] + v[3] * v[3]); }
                ss += __shfl_xor(ss, 16); ss += __shfl_xor(ss, 32);
                if (fq == 0) ssqp[(size_t)row * 16 + u.pn * 4 + wc] = ss; }
    }
};
struct EpiSoftmax {
    static constexpr bool PERM = true; EPI_NOMID
    bf16_t* PM; const float* ssq16;
    __device__ __forceinline__ void operator()(Acc& acc, const Unit& u, int wr, int wc, int fr, int fq, LAS unsigned char* lds, int, int) const {
        LAS float* MX = (LAS float*)(lds + XCH_OFF); LAS float* SM = (LAS float*)(lds + XCH_OFF + 4096);
#pragma unroll
        for (int ai = 0; ai < 2; ++ai)
#pragma unroll
            for (int m = 0; m < 4; ++m) { const int rl = ai * HALF + wr * 64 + m * 16 + fr; float mx = -3.0e38f;
                const f32x4* sp = (const f32x4*)(ssq16 + (size_t)(u.pm * BM + rl) * 16); const f32x4 st = (sp[0] + sp[1]) + (sp[2] + sp[3]);
                const float rs = 1.0f / sqrtf(((st[0] + st[1]) + (st[2] + st[3])) * (1.0f / D) + NORM_EPS);
#pragma unroll
                for (int bj = 0; bj < 2; ++bj)
#pragma unroll
                    for (int n = 0; n < 2; ++n) { const f32x4 v = acc[ai][bj][m][n] * rs; acc[ai][bj][m][n] = v; mx = fmaxf(mx, fmaxf(fmaxf(v[0], v[1]), fmaxf(v[2], v[3]))); }
                mx = fmaxf(mx, __shfl_xor(mx, 16)); mx = fmaxf(mx, __shfl_xor(mx, 32));
                if (fq == 0) MX[rl * 4 + wc] = mx; }
        RAW_BARRIER();
#pragma unroll
        for (int ai = 0; ai < 2; ++ai)
#pragma unroll
            for (int m = 0; m < 4; ++m) { const int rl = ai * HALF + wr * 64 + m * 16 + fr; const f32x4 mm = *(const LAS f32x4*)(MX + rl * 4);
                const float mx = fmaxf(fmaxf(mm[0], mm[1]), fmaxf(mm[2], mm[3])); float ss = 0.f;
#pragma unroll
                for (int bj = 0; bj < 2; ++bj)
#pragma unroll
                    for (int n = 0; n < 2; ++n) { f32x4 v = acc[ai][bj][m][n];
#pragma unroll
                        for (int i = 0; i < 4; ++i) { v[i] = __builtin_amdgcn_exp2f(v[i] - mx); ss += v[i]; }
                        acc[ai][bj][m][n] = v; }
                ss += __shfl_xor(ss, 16); ss += __shfl_xor(ss, 32);
                if (fq == 0) SM[rl * 4 + wc] = ss; }
        RAW_BARRIER();
        const int col0 = u.pn * BM + wc * 32 + fq * 8;
#pragma unroll
        for (int ai = 0; ai < 2; ++ai)
#pragma unroll
            for (int m = 0; m < 4; ++m) { const int rl = ai * HALF + wr * 64 + m * 16 + fr; const f32x4 s4 = *(const LAS f32x4*)(SM + rl * 4);
                const float inv = 1.0f / ((s4[0] + s4[1]) + (s4[2] + s4[3]));
#pragma unroll
                for (int bj = 0; bj < 2; ++bj) *(u32x4*)(PM + (size_t)(u.pm * BM + rl) * D + col0 + bj * HALF) = pack8(acc[ai][bj][m][0] * inv, acc[ai][bj][m][1] * inv); }
    }
};
struct EpiMoe1 {
    static constexpr bool PERM = true; EPI_NOMID
    bf16_t* HID; const float* slot_rs;
    __device__ __forceinline__ void operator()(Acc& acc, const Unit& u, int wr, int wc, int fr, int fq, LAS unsigned char*, int, int) const {
        const int row0 = u.pm * BM + wr * 64 + fr;
#pragma unroll
        for (int ai = 0; ai < 2; ++ai)
#pragma unroll
            for (int m = 0; m < 4; ++m) { const int row = row0 + ai * HALF + m * 16; const float rs = slot_rs[row]; f32x4 o[2];
#pragma unroll
                for (int n = 0; n < 2; ++n)
#pragma unroll
                    for (int i = 0; i < 4; ++i) { const float a = acc[ai][0][m][n][i] * rs, b = acc[ai][1][m][n][i] * rs; o[n][i] = a * b / (1.f + __expf(-a)); }
                *(u32x4*)(HID + (size_t)row * FF + u.pn * HALF + wc * 32 + fq * 8) = pack8(o[0], o[1]); }
    }
};
struct EpiMoe2 {
    static constexpr bool PERM = true; EPI_NOMID
    bf16_t* Y; const float* slot_gate;
    __device__ __forceinline__ void operator()(Acc& acc, const Unit& u, int wr, int wc, int fr, int fq, LAS unsigned char*, int, int) const {
        const int row0 = u.pm * BM + wr * 64 + fr, col0 = u.pn * BM + wc * 32 + fq * 8;
#pragma unroll
        for (int ai = 0; ai < 2; ++ai)
#pragma unroll
            for (int m = 0; m < 4; ++m) { const int row = row0 + ai * HALF + m * 16; const float g = slot_gate[row];
#pragma unroll
                for (int bj = 0; bj < 2; ++bj) *(u32x4*)(Y + (size_t)row * D + col0 + bj * HALF) = pack8(acc[ai][bj][m][0] * g, acc[ai][bj][m][1] * g); }
    }
};
}
struct Frame {
    LAS unsigned char* lds;
    volatile LAS unsigned* MISC;
    unsigned* ctl;
    unsigned char* ws;
    int wave, vcu, G;
};
struct Args { const void* in[27]; float* out; unsigned char* ws; int ph_lo, ph_hi, li, pad; };

__device__ __forceinline__ void tr_item(const float* W, int ldw, int srcrow0, int srccol0, bf16_t* WT, int dpitch, size_t drow0, int dk0, const float* gk, float sc, LAS float* scr, int lane) {
    f32x4 v[8]; const int n4 = lane & 7, kq = lane >> 3;
#pragma unroll
    for (int i = 0; i < 8; ++i) v[i] = *(const f32x4*)(W + (size_t)(srcrow0 + kq + 8 * i) * ldw + srccol0 + 4 * n4);
#pragma unroll
    for (int i = 0; i < 8; ++i) { const int kk = kq + 8 * i; const float g = gk ? gk[kk] * sc : sc; LAS float* d = scr + kk * 33 + 4 * n4;
        d[0] = v[i][0] * g; d[1] = v[i][1] * g; d[2] = v[i][2] * g; d[3] = v[i][3] * g; }
    LDS_WAIT(); asm volatile("" ::: "memory");
    const int c = lane & 7;
#pragma unroll
    for (int j = 0; j < 4; ++j) { const int n = (lane >> 3) + 8 * j; const LAS float* s = scr + (8 * c) * 33 + n;
        u32x4 o; o.x = pk2(s[0 * 33], s[1 * 33]); o.y = pk2(s[2 * 33], s[3 * 33]); o.z = pk2(s[4 * 33], s[5 * 33]); o.w = pk2(s[6 * 33], s[7 * 33]);
        *(u32x4*)(WT + (drow0 + n) * dpitch + dk0 + 8 * c) = o; }
    LDS_WAIT(); asm volatile("" ::: "memory");
}
__device__ __forceinline__ void rms_row_to_bf16(const float* xrow, const float* g, bf16_t* orow, int lane) {
    const f32x4* xr = (const f32x4*)xrow + lane; const f32x4* gr = (const f32x4*)g + lane;
    f32x4 v[4]; float s = 0.f;
#pragma unroll
    for (int j = 0; j < 4; ++j) { v[j] = xr[64 * j]; s += (v[j][0] * v[j][0] + v[j][1] * v[j][1]) + (v[j][2] * v[j][2] + v[j][3] * v[j][3]); }
    const float rs = 1.0f / sqrtf(wave_sum(s) * (1.f / D) + NORM_EPS);
    u32x2* o8 = (u32x2*)orow + lane;
#pragma unroll
    for (int j = 0; j < 4; ++j) { const f32x4 gg = gr[64 * j]; u32x2 w; w.x = pk2(v[j][0] * rs * gg[0], v[j][1] * rs * gg[1]); w.y = pk2(v[j][2] * rs * gg[2], v[j][3] * rs * gg[3]); o8[64 * j] = w; }
}
__device__ __forceinline__ void rms_row2_to_bf16(const float* xrow, const float* g, bf16_t* orow, int lane) {
    const f32x4* xr = (const f32x4*)xrow + lane; const f32x4* gr = (const f32x4*)g + lane;
    f32x4 v[2][4]; float s0 = 0.f, s1 = 0.f;
#pragma unroll
    for (int r = 0; r < 2; ++r)
#pragma unroll
        for (int j = 0; j < 4; ++j) v[r][j] = xr[r * 256 + 64 * j];
#pragma unroll
    for (int j = 0; j < 4; ++j) { s0 += (v[0][j][0] * v[0][j][0] + v[0][j][1] * v[0][j][1]) + (v[0][j][2] * v[0][j][2] + v[0][j][3] * v[0][j][3]);
        s1 += (v[1][j][0] * v[1][j][0] + v[1][j][1] * v[1][j][1]) + (v[1][j][2] * v[1][j][2] + v[1][j][3] * v[1][j][3]); }
    const float r0 = 1.0f / sqrtf(wave_sum(s0) * (1.f / D) + NORM_EPS), r1 = 1.0f / sqrtf(wave_sum(s1) * (1.f / D) + NORM_EPS);
    u32x2* o8 = (u32x2*)orow + lane;
#pragma unroll
    for (int j = 0; j < 4; ++j) { const f32x4 gg = gr[64 * j]; u32x2 w;
        w.x = pk2(v[0][j][0] * r0 * gg[0], v[0][j][1] * r0 * gg[1]); w.y = pk2(v[0][j][2] * r0 * gg[2], v[0][j][3] * r0 * gg[3]); o8[64 * j] = w;
        w.x = pk2(v[1][j][0] * r1 * gg[0], v[1][j][1] * r1 * gg[1]); w.y = pk2(v[1][j][2] * r1 * gg[2], v[1][j][3] * r1 * gg[3]); o8[256 + 64 * j] = w; }
}
__device__ __forceinline__ double rope_inv(int d) {
    const int q = d >> 3, r = d & 7;
    double b = 1.0;
    b = (r == 1) ? 0.7498942093324558273 : b; b = (r == 2) ? 0.56234132519034908039 : b; b = (r == 3) ? 0.42169650342858224857 : b; b = (r == 4) ? 0.3162277660168379332 : b;
    b = (r == 5) ? 0.23713737056616552617 : b; b = (r == 6) ? 0.17782794100389228012 : b; b = (r == 7) ? 0.13335214321633240257 : b;
    const double p = (q == 0) ? 1.0 : (q == 1) ? 0.1 : (q == 2) ? 0.01 : 0.001;
    return b * p;
}
__device__ __forceinline__ void sincos_d(double a, double& sn, double& cs) {
    const double k = __builtin_rint(a * 0.63661977236758134308);
    double y = __builtin_fma(-k, 1.57079632679489655800e+00, a); y = __builtin_fma(-k, 6.12323399573676603587e-17, y);
    const double y2 = y * y;
    double s = 1.0 / 6227020800.0; s = s * y2 - 1.0 / 39916800.0; s = s * y2 + 1.0 / 362880.0; s = s * y2 - 1.0 / 5040.0; s = s * y2 + 1.0 / 120.0; s = s * y2 - 1.0 / 6.0; s = s * y2 * y + y;
    double c = 1.0 / 479001600.0; c = c * y2 - 1.0 / 3628800.0; c = c * y2 + 1.0 / 40320.0; c = c * y2 - 1.0 / 720.0; c = c * y2 + 1.0 / 24.0; c = c * y2 - 0.5; c = c * y2 + 1.0;
    const int qd = ((int)k) & 3;
    sn = (qd == 0) ? s : (qd == 1) ? c : (qd == 2) ? -s : -c;
    cs = (qd == 0) ? c : (qd == 1) ? -s : (qd == 2) ? -c : s;
}
typedef const void* gen_cptr;
typedef __attribute__((address_space(4))) const char* cas_cptr;
typedef __attribute__((address_space(4))) const gen_cptr* cas_pptr;
__device__ __forceinline__ const void* karg_ptr(int byte_off) { cas_cptr p = (cas_cptr)__builtin_amdgcn_kernarg_segment_ptr(); asm volatile("" : "+s"(p)); return *(cas_pptr)(p + byte_off); }
__device__ __forceinline__ void p0_prologue(Frame& F) {
    const int lane = lane_id(), tid = F.wave * 64 + lane;
    const float* x = (const float*)karg_ptr(8 * 0); const float* mem = (const float*)karg_ptr(8 * 1); const int* positions = (const int*)karg_ptr(8 * 2);
    const float* mix_g = (const float*)karg_ptr(8 * 3); const float* w_in = (const float*)karg_ptr(8 * 4);
    const float* attn_out_g = (const float*)karg_ptr(8 * 10); const float* w_out = (const float*)karg_ptr(8 * 11);
    const float* xattn_g = (const float*)karg_ptr(8 * 12); const float* mem_g = (const float*)karg_ptr(8 * 13);
    const float* w_xq = (const float*)karg_ptr(8 * 14); const float* w_xk = (const float*)karg_ptr(8 * 15); const float* w_xv = (const float*)karg_ptr(8 * 16); const float* w_xo = (const float*)karg_ptr(8 * 17);
    const float* moe_g = (const float*)karg_ptr(8 * 18); const float* w_group = (const float*)karg_ptr(8 * 19); const float* w_router = (const float*)karg_ptr(8 * 21);
    const float* w1 = (const float*)karg_ptr(8 * 23); const float* w3 = (const float*)karg_ptr(8 * 24); const float* w2 = (const float*)karg_ptr(8 * 25);
    unsigned char* ws = F.ws;
    LAS float* scr = (LAS float*)(F.lds + F.wave * 16384);
    const int gw = F.vcu * NWAVES + F.wave, NGW = F.G * NWAVES;
    constexpr int I_IN = 16 * 88, I_SQ = 16 * 32, I_13 = NE * 16 * 32, I_2 = NE * 8 * 32;
    constexpr int NITEMS = I_IN + 5 * I_SQ + I_13 + I_2;
    for (int it = gw; it < NITEMS; it += NGW) {
        int r = it;
        if (r < I_IN) { const int kb = r / 88, nb = r % 88, n0 = 32 * nb, tile = n0 >> 8, j = n0 & 255; int src;
            if (tile < 2) src = (j < 128) ? 128 * tile + j : 256 + 128 * tile + (j - 128);
            else if (tile < 8) { const int sec = (tile - 2) / 3, tt = (tile - 2) % 3, jj = j & 127, hh = jj >> 5; src = 512 + 768 * sec + 256 * tt + 64 * hh + ((j < 128) ? 0 : 32); }
            else src = n0;
            tr_item(w_in, INW, 64 * kb, src, (bf16_t*)(ws + WS_WIN), D, (size_t)n0, 64 * kb, nullptr, 1.f, scr, lane); continue; }
        r -= I_IN;
        if (r < I_SQ) { const int kb = r / 32, nb = r % 32, dk0 = 64 * kb; const bool at = dk0 < AW;
            tr_item(w_out, D, at ? CCH + dk0 : dk0 - AW, 32 * nb, (bf16_t*)(ws + WS_WOUT), D, (size_t)(32 * nb), dk0, at ? attn_out_g + dk0 : nullptr, 1.f, scr, lane); continue; }
        r -= I_SQ;
        if (r < 4 * I_SQ) { const int which = r / I_SQ, r2 = r % I_SQ, kb = r2 / 32, nb = r2 % 32;
            if (which == 0) {
                bf16_t* WQ2 = (bf16_t*)(ws + WS_WXQ); const int n4 = lane & 7, kq = lane >> 3;
#pragma unroll
                for (int i = 0; i < 8; ++i) { const int k = 64 * kb + kq + 8 * i; const f32x4 v = *(const f32x4*)(w_xq + (size_t)k * D + 32 * nb + 4 * n4); const float g = xattn_g[k] * (LOG2E / 16.f);
                    u32x2 o; o.x = pk2(v[0] * g, v[1] * g); o.y = pk2(v[2] * g, v[3] * g); *(u32x2*)(WQ2 + (size_t)k * D + 32 * nb + 4 * n4) = o; }
                continue; }
            const float* W = which == 1 ? w_xk : which == 2 ? w_xv : w_xo;
            bf16_t* WT = (bf16_t*)(ws + (which == 1 ? WS_WXK : which == 2 ? WS_WXV : WS_WXO));
            tr_item(W, D, 64 * kb, 32 * nb, WT, D, (size_t)(32 * nb), 64 * kb, nullptr, 1.f, scr, lane); continue; }
        r -= 4 * I_SQ;
        if (r < I_13) { const int e = r / 512, r2 = r % 512, kb = r2 / 32, nb = r2 % 32, n0 = 32 * nb, tt = n0 >> 8, j = n0 & 255;
            const float* W = ((j < 128) ? w1 : w3) + (size_t)e * D * FF;
            tr_item(W, FF, 64 * kb, 128 * tt + (j & 127), (bf16_t*)(ws + WS_W13), D, (size_t)e * 1024 + n0, 64 * kb, moe_g + 64 * kb, 1.f, scr, lane); continue; }
        r -= I_13;
        { const int e = r / 256, r2 = r % 256, kb = r2 / 32, nb = r2 % 32;
            tr_item(w2 + (size_t)e * FF * D, D, 64 * kb, 32 * nb, (bf16_t*)(ws + WS_W2), FF, (size_t)e * 1024 + 32 * nb, 64 * kb, nullptr, 1.f, scr, lane); }
    }
    { bf16_t* WRF = (bf16_t*)(ws + WS_HIST + HIST_WR);
      for (int i = blockIdx.x * 512 + tid; i < 4 * 8 * 3 * 2 * 64 * 8; i += F.G * 512) {
          const int j = i & 7, ln = (i >> 3) & 63, part = (i >> 9) & 1, blk = i >> 10, nt = blk % 3, s = (blk / 3) & 7, kc = blk / 24;
          const int k = 256 * kc + 32 * s + 8 * (ln >> 4) + j, o = 16 * nt + (ln & 15);
          float v = 0.f; if (o < 32) v = w_router[k * 32 + o] * moe_g[k]; else if (o < 36) v = w_group[k * 4 + (o - 32)] * moe_g[k];
          const unsigned hb = f2bf(v); const float hf = __builtin_bit_cast(float, hb << 16);
          WRF[i] = (bf16_t)(part ? f2bf(v - hf) : hb); } }
    { float* rc = (float*)(ws + WS_ROPE); float* rsn = rc + SEQ * 32;
      for (int i = blockIdx.x * 512 + tid; i < SEQ * 32; i += F.G * 512) { const int s = i >> 5, d = i & 31;
          const float inv = (float)rope_inv(d); const float ang = (float)positions[s] * inv; double sn, cs; sincos_d((double)fabsf(ang), sn, cs); if (ang < 0.f) sn = -sn;
          rc[i] = (float)cs; rsn[i] = (float)sn; } }
    for (int m = gw; m < MROWS; m += NGW) rms_row_to_bf16(mem + (size_t)m * D, mem_g, (bf16_t*)(ws + WS_MEMN) + (size_t)m * D, lane);
    for (int m = 2 * gw; m < T; m += 2 * NGW) rms_row2_to_bf16(x + (size_t)m * D, mix_g, (bf16_t*)(ws + WS_R1) + (size_t)m * D, lane);
}
#ifndef D16_REP
#define D16_REP 1
#endif
namespace att {
typedef short v4i16_t __attribute__((ext_vector_type(4)));
constexpr int BUFB = 65536, VIMG = 32768;
constexpr float NEG = -1.0e30f, MFLOOR = -1.0e9f;
__device__ __forceinline__ int k_off(int row, int c) { return row * 128 + ((c ^ ((row >> 1) & 7)) << 4); }
__device__ __forceinline__ int v_off(int row, int c) { return VIMG + row * 128 + ((c ^ (((row >> 1) & 3) << 1)) << 4); }

struct Grp { bf16x8 q0, q1; f32x4 o[4]; float m, l; };
struct KV { bf16x8 k[2][2]; bf16x8 v[4]; };

#ifdef ATT_SHFL
__device__ __forceinline__ float xmax16(float v) { return fmaxf(v, __shfl_xor(v, 16)); }
__device__ __forceinline__ float xmax32(float v) { return fmaxf(v, __shfl_xor(v, 32)); }
__device__ __forceinline__ float xsum16(float v) { return v + __shfl_xor(v, 16); }
__device__ __forceinline__ float xsum32(float v) { return v + __shfl_xor(v, 32); }
#else
__device__ __forceinline__ void swap16(float v, float& a, float& b) { a = v; b = v; asm volatile("s_nop 1\n\tv_permlane16_swap_b32 %0, %1" : "+v"(a), "+v"(b)); }
__device__ __forceinline__ void swap32(float v, float& a, float& b) { a = v; b = v; asm volatile("s_nop 1\n\tv_permlane32_swap_b32 %0, %1" : "+v"(a), "+v"(b)); }
__device__ __forceinline__ float xmax16(float v) { float a, b; swap16(v, a, b); return fmaxf(a, b); }
__device__ __forceinline__ float xmax32(float v) { float a, b; swap32(v, a, b); return fmaxf(a, b); }
__device__ __forceinline__ float xsum16(float v) { float a, b; swap16(v, a, b); return a + b; }
__device__ __forceinline__ float xsum32(float v) { float a, b; swap32(v, a, b); return a + b; }
#endif
constexpr int NSTEP_ = 9;
__device__ __forceinline__ int step_id(int s) { return (s >= 6) ? s : ((s & 1) ? 3 + (s >> 1) : (s >> 1)); }
__device__ __forceinline__ int step_pos(int step, int row, int c0) {
    if (step == 99) return 16 * row + c0;
    if (step < 3) { const int hh = row >> 7, jj = row & 127; return c0 + 256 * hh - 64 + 128 * step + jj; }
    if (step < 9) { const int s = step - 3, hh = row >> 7, c = (row >> 5) & 3, jj = row & 31; return 4 * ((c0 >> 2) + 64 * hh - 64 + 32 * s + jj) + c; }
    { const int s = step - 9, pb = s >> 1, rh = s & 1, rr = row >> 5, jj = row & 31; return 16 * ((c0 >> 4) - 64 + 32 * pb + jj) + 8 * rh + rr; }
}
__device__ __forceinline__ void stage_issue(unsigned ldsbuf, const char* Kg, const char* Vg, int hrow0, int c0, int step, int wave, int lane) {
    const bool isV = wave >= 4; const char* gb = pg8::uniform_ptr(isV ? Vg : Kg);
#pragma unroll
    for (int i = 0; i < 8; ++i) { const int blk = (wave & 3) * 8 + i, row = 8 * blk + (lane >> 3), phys = lane & 7;
        const int c = isV ? (phys ^ (((row >> 1) & 3) << 1)) : (phys ^ ((row >> 1) & 7));
        int pos = step_pos(step, row, c0); pos = pos < 0 ? 0 : (pos > SEQ - 1 ? SEQ - 1 : pos);
        const unsigned voff = (unsigned)((hrow0 + pos) * HD + c * 8) * 2u;
        pg8::glds16_sv(gb, voff, ldsbuf + (isV ? (unsigned)VIMG : 0u) + (unsigned)blk * 1024u); __builtin_amdgcn_sched_barrier(0); }
}
struct LaneOff { int kb0; int vb[4]; };
__device__ __forceinline__ void lane_off(LaneOff& o, int lane) {
    const int key = lane & 15, g = lane >> 4, q = (lane >> 2) & 3, p2 = lane & 3;
    o.kb0 = k_off(key, g);
#pragma unroll
    for (int db = 0; db < 4; ++db) o.vb[db] = v_off(4 * g + q, 2 * db + (p2 >> 1)) + 8 * (p2 & 1);
}
__device__ __forceinline__ const LAS unsigned char* row_base(const LAS unsigned char* buf, int Rb) {
    return (const LAS unsigned char*)(uintptr_t)(unsigned)__builtin_amdgcn_readfirstlane((int)((unsigned)(uintptr_t)buf + (unsigned)(Rb * 128))); }
__device__ __forceinline__ void load_k(bf16x8 (&k)[2][2], const LAS unsigned char* buf, int Rb, const LaneOff& lo) {
    const LAS unsigned char* rb = row_base(buf, Rb);
#pragma unroll
    for (int t = 0; t < 2; ++t) { k[t][0] = *(const LAS bf16x8*)(rb + t * 2048 + lo.kb0); k[t][1] = *(const LAS bf16x8*)(rb + t * 2048 + (lo.kb0 ^ 64)); }
}
__device__ __forceinline__ void load_v(bf16x8 (&v)[4], const LAS unsigned char* buf, int Rb, const LaneOff& lo) {
    const LAS unsigned char* rb = row_base(buf, Rb);
#pragma unroll
    for (int db = 0; db < 4; ++db) {
        const s16x4 v0 = __builtin_bit_cast(s16x4, __builtin_amdgcn_ds_read_tr16_b64_v4i16((LAS v4i16_t*)(rb + lo.vb[db])));
        const s16x4 v1 = __builtin_bit_cast(s16x4, __builtin_amdgcn_ds_read_tr16_b64_v4i16((LAS v4i16_t*)(rb + 2048 + lo.vb[db])));
        v[db] = (bf16x8){v0[0], v0[1], v0[2], v0[3], v1[0], v1[1], v1[2], v1[3]}; }
}
__device__ __forceinline__ float fmax_nc(float a, float b) { float r; asm("v_max_f32_e32 %0, %1, %2" : "=v"(r) : "v"(a), "v"(b)); return r; }
__device__ __forceinline__ float fmax9_mfma(const f32x4& s0, const f32x4& s1, float m) { float r, t0, t1;
    asm("s_nop 11\n\tv_max3_f32 %1, %3, %4, %5\n\tv_max3_f32 %2, %6, %7, %8\n\tv_max3_f32 %0, %9, %10, %11\n\tv_max3_f32 %0, %0, %1, %2"
        : "=&v"(r), "=&v"(t0), "=&v"(t1) : "v"(s0[0]), "v"(s0[1]), "v"(s0[2]), "v"(s0[3]), "v"(s1[0]), "v"(s1[1]), "v"(s1[2]), "v"(s1[3]), "v"(m));
    return r; }
__device__ __forceinline__ void qk_part(const Grp& G, const bf16x8 (&k)[2][2], f32x4 (&s)[2]) {
#pragma unroll
    for (int t = 0; t < 2; ++t) { f32x4 z = (f32x4){0.f, 0.f, 0.f, 0.f};
        z = __builtin_amdgcn_mfma_f32_16x16x32_bf16(k[t][0], G.q0, z, 0, 0, 0); s[t] = __builtin_amdgcn_mfma_f32_16x16x32_bf16(k[t][1], G.q1, z, 0, 0, 0); }
}
template <bool FULL, bool INR>
__device__ __forceinline__ void sm_part(Grp& G, f32x4 (&s)[2], int ksub0, int qsub, int L, int lane, bf16x8& pb, float& alpha) {
    const int g = lane >> 4;
    if constexpr (!FULL) { const int d0 = ksub0 + 4 * g - qsub + 64, k0 = ksub0 + 4 * g;
#pragma unroll
        for (int t = 0; t < 2; ++t)
#pragma unroll
            for (int i = 0; i < 4; ++i) { bool ok = ((unsigned)(d0 + 16 * t + i) <= 128u); if constexpr (!INR) ok = ok && ((unsigned)(k0 + 16 * t + i) < (unsigned)L); s[t][i] = ok ? s[t][i] : NEG; } }
    float mx = fmax9_mfma(s[0], s[1], G.m);
    { float a, b; swap16(mx, a, b); mx = fmax_nc(a, b); swap32(mx, a, b); mx = fmax_nc(a, b); }
    const float mn = mx; alpha = __builtin_amdgcn_exp2f(G.m - mn);
    G.m = mn; float p[2][4]; float ps = 0.f;
#pragma unroll
    for (int t = 0; t < 2; ++t)
#pragma unroll
        for (int i = 0; i < 4; ++i) { const float e = __builtin_amdgcn_exp2f(s[t][i] - mn); p[t][i] = e; ps += e; }
    G.l = G.l * alpha + ps;
    u32x4 pw; pw.x = cvt_pk_bf16(p[0][0], p[0][1]); pw.y = cvt_pk_bf16(p[0][2], p[0][3]); pw.z = cvt_pk_bf16(p[1][0], p[1][1]); pw.w = cvt_pk_bf16(p[1][2], p[1][3]);
    pb = __builtin_bit_cast(bf16x8, pw);
}
__device__ __forceinline__ void pv_part(Grp& G, const bf16x8 (&v)[4], const bf16x8& pb, float alpha) {
#pragma unroll
    for (int db = 0; db < 4; ++db) G.o[db] = __builtin_amdgcn_mfma_f32_16x16x32_bf16(v[db], pb, G.o[db] * alpha, 0, 0, 0);
}
__device__ __forceinline__ void grp_init(Grp& G, const bf16_t* Qb, size_t qrow0, int lane) {
    const int a = lane & 15, g = lane >> 4; const bf16_t* qp = Qb + (qrow0 + 16 * a) * HD + 8 * g;
    G.q0 = *(const bf16x8*)qp; G.q1 = *(const bf16x8*)(qp + 32);
#pragma unroll
    for (int d = 0; d < 4; ++d) G.o[d] = (f32x4){0.f, 0.f, 0.f, 0.f};
    G.m = MFLOOR; G.l = 0.f;
}
__device__ __forceinline__ void grp_init_state(Grp& G, const bf16_t* Qb, const bf16_t* MIX, const float* ml, size_t tok0, size_t qrow0, int h, int lane) {
    const int a = lane & 15, g = lane >> 4; const size_t tok = tok0 + 16 * a; const bf16_t* qp = Qb + (qrow0 + 16 * a) * HD + 8 * g;
    G.q0 = *(const bf16x8*)qp; G.q1 = *(const bf16x8*)(qp + 32);
    const f32x2 st = *(const f32x2*)(ml + (tok * NH + h) * 2);
    G.m = st[0]; G.l = st[1] * 0.25f;
#pragma unroll
    for (int db = 0; db < 4; ++db) { const u32x2 w = *(const u32x2*)(MIX + tok * D + h * HD + 16 * db + 4 * g);
        G.o[db] = (f32x4){bflo(w.x), bfhi(w.x), bflo(w.y), bfhi(w.y)} * st[1]; }
}
__device__ __forceinline__ void grp_finish(Grp& G, bf16_t* MIX, float* ssqa, size_t tok0, int h, int lane) {
    const int a = lane & 15, g = lane >> 4; float l = G.l; l = xsum16(l); l = xsum32(l);
    const float inv = 1.0f / l; const size_t tok = tok0 + 16 * a; float ss = 0.f;
#pragma unroll
    for (int db = 0; db < 4; ++db) { const f32x4 o = G.o[db] * inv; ss += (o[0] * o[0] + o[1] * o[1]) + (o[2] * o[2] + o[3] * o[3]);
        u32x2 w; w.x = cvt_pk_bf16(o[0], o[1]); w.y = cvt_pk_bf16(o[2], o[3]); *(u32x2*)(MIX + tok * D + h * HD + 16 * db + 4 * g) = w; }
    ss = xsum16(ss); ss = xsum32(ss);
    if (g == 0) ssqa[tok * NH + h] = ss;
}
#define ATT_SYNC() do { asm volatile("s_waitcnt vmcnt(0) lgkmcnt(0)" ::: "memory"); __builtin_amdgcn_s_barrier(); asm volatile("" ::: "memory"); } while (0)
#define ATT_SB() __builtin_amdgcn_sched_barrier(0)
template <bool INR>
__device__ __forceinline__ void pair4(Grp& G0, Grp& G1, Grp& G2, Grp& G3, const LAS unsigned char* buf, int Rb, const LaneOff& lo, int ks0, int qs, int dq, int L, int lane) {
    f32x4 s0[2], s1[2], s2[2], s3[2]; bf16x8 p0, p1, p2, p3; float a0, a1, a2, a3;
    { bf16x8 k[2][2]; load_k(k, buf, Rb, lo); qk_part(G0, k, s0); qk_part(G1, k, s1); qk_part(G2, k, s2); qk_part(G3, k, s3); } ATT_SB();
    bf16x8 v[4]; load_v(v, buf, Rb, lo);
    sm_part<false, INR>(G0, s0, ks0, qs, L, lane, p0, a0); sm_part<false, INR>(G1, s1, ks0, qs + dq, L, lane, p1, a1); ATT_SB();
    sm_part<false, INR>(G2, s2, ks0, qs + 2 * dq, L, lane, p2, a2); sm_part<false, INR>(G3, s3, ks0, qs + 3 * dq, L, lane, p3, a3); ATT_SB();
    pv_part(G0, v, p0, a0); pv_part(G1, v, p1, a1); pv_part(G2, v, p2, a2); pv_part(G3, v, p3, a3); ATT_SB();
}
template <bool FULL, bool INR>
__device__ __forceinline__ void pair2(Grp& GA, Grp& GB, const LAS unsigned char* buf, int RbA, int RbB, const LaneOff& lo, int ks0, int qs, int L, int lane) {
    f32x4 s0[2], s1[2]; bf16x8 p0, p1; float a0, a1;
    { bf16x8 ka[2][2], kb[2][2]; load_k(ka, buf, RbA, lo); load_k(kb, buf, RbB, lo); qk_part(GA, ka, s0); qk_part(GB, kb, s1); } ATT_SB();
    bf16x8 va[4], vb[4]; load_v(va, buf, RbA, lo); load_v(vb, buf, RbB, lo);
    sm_part<FULL, INR>(GA, s0, ks0, qs, L, lane, p0, a0); sm_part<FULL, INR>(GB, s1, ks0, qs, L, lane, p1, a1); ATT_SB();
    pv_part(GA, va, p0, a0); pv_part(GB, vb, p1, a1); ATT_SB();
}
__device__ __forceinline__ void attn_unit(LAS unsigned char* lds, const bf16_t* Qb, const bf16_t* Kb, const bf16_t* Vb, bf16_t* MIX, float* ssqa, const float* ml, int b, int h, int c0, int tid, int wave, int lane_) {
    int lane = lane_; asm volatile("" : "+v"(lane));
    const int brow0 = b * SEQ, hrow0 = (b * NH + h) * SEQ, half = wave >> 2, w4 = wave & 3, ch = c0 + 256 * half;
    const unsigned lds0 = (unsigned)(uintptr_t)lds;
    const size_t tokb = (size_t)(brow0 + ch + w4);
    Grp G0, G1, G2, G3;
    const size_t qb0 = (size_t)(hrow0 + ch + w4);
    grp_init_state(G0, Qb, MIX, ml, tokb, qb0, h, lane); grp_init_state(G1, Qb, MIX, ml, tokb + 4, qb0 + 4, h, lane); grp_init_state(G2, Qb, MIX, ml, tokb + 8, qb0 + 8, h, lane); grp_init_state(G3, Qb, MIX, ml, tokb + 12, qb0 + 12, h, lane);
    ATT_SYNC();
    { int ln = lane; asm volatile("" : "+v"(ln)); stage_issue(lds0, (const char*)Kb, (const char*)Vb, hrow0, c0, step_id(0), wave, ln); }
#pragma nounroll
    for (int sx = 0; sx < NSTEP_; ++sx) { const int step = step_id(sx);
        ATT_SYNC();
        int ln = lane; asm volatile("" : "+v"(ln));
        if (sx + 1 < NSTEP_) stage_issue(lds0 + (unsigned)(((sx + 1) & 1) * BUFB), (const char*)Kb, (const char*)Vb, hrow0, c0, step_id(sx + 1), wave, ln);
        const LAS unsigned char* buf = lds + (sx & 1) * BUFB;
        LaneOff lo; lane_off(lo, ln); const int a = ln & 15;
#pragma nounroll
        for (int rep_ = 0; rep_ < D16_REP; ++rep_)
        if (step < 3) {
            const int qs = ch + w4 + 16 * a;
#pragma nounroll
            for (int p = 0; p < 4; ++p) { const int ks0 = ch - 64 + 128 * step + 32 * p;
                if (ks0 + 31 >= 0 && ks0 < SEQ) { const int Rb = 128 * half + 32 * p;
                    if (ks0 >= 0 && ks0 + 32 <= SEQ) pair4<true>(G0, G1, G2, G3, buf, Rb, lo, ks0, qs, 4, SEQ, ln); else pair4<false>(G0, G1, G2, G3, buf, Rb, lo, ks0, qs, 4, SEQ, ln); } }
        } else {
            const int s = step - 3, ks0 = (ch >> 2) - 64 + 32 * s, qs = (ch >> 2) + 4 * a;
            if (ks0 + 31 >= 0 && ks0 < SEQ / 4) { const int Rb = 128 * half + 32 * w4;
                if (ks0 >= 0 && ks0 + 32 <= SEQ / 4) pair4<true>(G0, G1, G2, G3, buf, Rb, lo, ks0, qs, 1, SEQ / 4, ln); else pair4<false>(G0, G1, G2, G3, buf, Rb, lo, ks0, qs, 1, SEQ / 4, ln); }
        }
    }
    { int lf = lane; asm volatile("" : "+v"(lf)); const size_t tf = (size_t)(brow0 + ch + w4);
      grp_finish(G0, MIX, ssqa, tf, h, lf); grp_finish(G1, MIX, ssqa, tf + 4, h, lf); grp_finish(G2, MIX, ssqa, tf + 8, h, lf); grp_finish(G3, MIX, ssqa, tf + 12, h, lf); }
}
constexpr int NVB = 49152;
__device__ __forceinline__ int vn_off(int row, int c) { return row * 128 + ((c ^ (((row >> 1) & 3) << 1)) << 4); }
template <int DIL>
__device__ __forceinline__ void nat_stage_v(unsigned ldsbuf, const char* Vg, int hrow0, int cres, int sub0, int wave, int lane) {
    constexpr int Ls = SEQ / DIL; const char* gb = pg8::uniform_ptr(Vg);
#pragma unroll
    for (int i = 0; i < 6; ++i) { const int blk = wave * 6 + i, row = 8 * blk + (lane >> 3), phys = lane & 7;
        const int c = phys ^ (((row >> 1) & 3) << 1);
        int sub = sub0 + row; sub = sub < 0 ? 0 : (sub > Ls - 1 ? Ls - 1 : sub);
        const unsigned voff = (unsigned)((hrow0 + cres + DIL * sub) * HD + c * 8) * 2u;
        pg8::glds16_sv(gb, voff, ldsbuf + (unsigned)blk * 1024u); __builtin_amdgcn_sched_barrier(0); }
}
template <int DIL>
__device__ __forceinline__ void nat_load_k1(bf16x8 (&k)[2][2], const bf16_t* Kb, int hrow0, int cres, int ksub, int lane) {
    constexpr int Ls = SEQ / DIL; const int key = lane & 15, g = lane >> 4;
#pragma unroll
    for (int t = 0; t < 2; ++t) { int sub = ksub + 16 * t + key; sub = sub < 0 ? 0 : (sub > Ls - 1 ? Ls - 1 : sub);
        const bf16_t* kp = Kb + (size_t)(hrow0 + cres + DIL * sub) * HD + 8 * g;
        k[t][0] = *(const bf16x8*)kp; k[t][1] = *(const bf16x8*)(kp + 32); }
}
template <bool FULL>
__device__ __forceinline__ void pair2n_post(Grp& GA, Grp& GB, f32x4 (&s0)[2], f32x4 (&s1)[2], const LAS unsigned char* vbuf, int Rb, const int (&vb)[4], int ks0, int qs, int Ls, int lane) {
    bf16x8 p0, p1; float a0, a1;
    bf16x8 v[4]; { const LAS unsigned char* rb = row_base(vbuf, Rb);
#pragma unroll
        for (int db = 0; db < 4; ++db) {
            const s16x4 v0 = __builtin_bit_cast(s16x4, __builtin_amdgcn_ds_read_tr16_b64_v4i16((LAS v4i16_t*)(rb + vb[db])));
            const s16x4 v1 = __builtin_bit_cast(s16x4, __builtin_amdgcn_ds_read_tr16_b64_v4i16((LAS v4i16_t*)(rb + 2048 + vb[db])));
            v[db] = (bf16x8){v0[0], v0[1], v0[2], v0[3], v1[0], v1[1], v1[2], v1[3]}; } }
    sm_part<FULL, true>(GA, s0, ks0, qs, Ls, lane, p0, a0); sm_part<FULL, true>(GB, s1, ks0, qs + 16, Ls, lane, p1, a1); ATT_SB();
    pv_part(GA, v, p0, a0); pv_part(GB, v, p1, a1); ATT_SB();
}
template <bool FULL>
__device__ __forceinline__ void pair2n(Grp& GA, Grp& GB, const bf16x8 (&k)[2][2], const LAS unsigned char* vbuf, int Rb, const int (&vb)[4], int ks0, int qs, int Ls, int lane) {
    f32x4 s0[2], s1[2];
    qk_part(GA, k, s0); qk_part(GB, k, s1); ATT_SB();
    pair2n_post<FULL>(GA, GB, s0, s1, vbuf, Rb, vb, ks0, qs, Ls, lane);
}
template <bool FULL>
__device__ __forceinline__ void pair2s(Grp& GA, Grp& GB, const LAS unsigned char* buf, int Rb, const LaneOff& lo, int ks0, int qs, int lane, const bf16_t* kdir = nullptr) {
    f32x4 s0[2], s1[2]; bf16x8 p0, p1; float a0, a1;
#ifdef D16_KDIRECT
    { bf16x8 k[2][2]; const int key = lane & 15, g = lane >> 4;
#pragma unroll
      for (int t = 0; t < 2; ++t) { const bf16_t* kp = kdir + (size_t)(16 * (ks0 + 16 * t + key)) * HD + 8 * g; k[t][0] = *(const bf16x8*)kp; k[t][1] = *(const bf16x8*)(kp + 32); }
      qk_part(GA, k, s0); qk_part(GB, k, s1); } ATT_SB();
#else
    { bf16x8 k[2][2]; load_k(k, buf, Rb, lo); qk_part(GA, k, s0); qk_part(GB, k, s1); } ATT_SB();
#endif
    bf16x8 v[4]; load_v(v, buf, Rb, lo);
    sm_part<FULL, true>(GA, s0, ks0, qs, SEQ / 16, lane, p0, a0); sm_part<FULL, true>(GB, s1, ks0, qs + 16, SEQ / 16, lane, p1, a1); ATT_SB();
    pv_part(GA, v, p0, a0); pv_part(GB, v, p1, a1); ATT_SB();
}
__device__ __forceinline__ void grp_finish_state(Grp& G, bf16_t* MIX, float* ml, size_t tok0, int h, int lane) {
    const int a = lane & 15, g = lane >> 4; float l = G.l; l = xsum16(l); l = xsum32(l);
    const float inv = 1.0f / l; const size_t tok = tok0 + 16 * a;
#pragma unroll
    for (int db = 0; db < 4; ++db) { const f32x4 o = G.o[db] * inv;
        u32x2 w; w.x = cvt_pk_bf16(o[0], o[1]); w.y = cvt_pk_bf16(o[2], o[3]); *(u32x2*)(MIX + tok * D + h * HD + 16 * db + 4 * g) = w; }
    if (g == 0) *(f32x2*)(ml + (tok * NH + h) * 2) = (f32x2){G.m, l};
}
__device__ __forceinline__ void d16_phase(LAS unsigned char* lds, const bf16_t* Qb, const bf16_t* Kb, const bf16_t* Vb, bf16_t* MIX, float* ml, int vcu, int G_, int dup, int wave, int lane_) {
    constexpr int NT = NB * NH * 16;
    const unsigned lds0 = (unsigned)(uintptr_t)lds;
    ATT_SYNC();
    if (vcu < NT * dup) { int ln = lane_; asm volatile("" : "+v"(ln)); const int L = vcu % NT, r = L & 15, bh = L >> 4;
#ifdef D16_VNAT
        nat_stage_v<16>(lds0 + 32768u, (const char*)Vb, bh * SEQ, r, -64, wave, ln); }
#else
        stage_issue(lds0, (const char*)Kb, (const char*)Vb, bh * SEQ, r, 99, wave, ln); }
#endif
    int it = 0;
#pragma nounroll
    for (int L0 = vcu; L0 < NT * dup; L0 += G_, ++it) {
        const int L = L0 % NT, r = L & 15, bh = L >> 4, b = bh / NH, h = bh % NH, brow0 = b * SEQ, hcol = h * HD;
        ATT_SYNC();
        int ln = lane_; asm volatile("" : "+v"(ln));
        if (L0 + G_ < NT * dup) { const int Ln = (L0 + G_) % NT, rn = Ln & 15, bhn = Ln >> 4;
#ifdef D16_VNAT
            nat_stage_v<16>(lds0 + 32768u + (unsigned)(((it + 1) & 1) * NVB), (const char*)Vb, bhn * SEQ, rn, -64, wave, ln); }
        const LAS unsigned char* buf = lds + (it & 1) * NVB + 64 * 128;
#else
            stage_issue(lds0 + (unsigned)(((it + 1) & 1) * BUFB), (const char*)Kb, (const char*)Vb, bhn * SEQ, rn, 99, wave, ln); }
        const LAS unsigned char* buf = lds + (it & 1) * BUFB;
#endif
        LaneOff lo; lane_off(lo, ln); const int a = ln & 15;
        Grp GA, GB; const size_t tokA = (size_t)(brow0 + r + 16 * (32 * wave));
        { const size_t qA = (size_t)(bh * SEQ + r + 16 * (32 * wave)); grp_init(GA, Qb, qA, ln); grp_init(GB, Qb, qA + 256, ln); }
        const int qs = 32 * wave + a;
#pragma nounroll
        for (int p5 = 0; p5 < 5 * D16_REP; ++p5) { const int p = p5 % 5; const int ks0 = 32 * wave - 64 + 32 * p;
            if (ks0 >= 0 && ks0 < SEQ / 16) {
                const bool full = (ks0 + 31 - 32 * wave <= 64) && (32 * wave + 15 - ks0 <= 64) && (ks0 + 31 - (32 * wave + 16) <= 64) && (32 * wave + 31 - ks0 <= 64);
                const bf16_t* kd = Kb + (size_t)(bh * SEQ + r) * HD;
#ifdef D16_PAIR2N
                { bf16x8 kk[2][2]; const int key = ln & 15, g = ln >> 4, q = (ln >> 2) & 3, p2 = ln & 3; int vb[4];
#pragma unroll
                  for (int db = 0; db < 4; ++db) vb[db] = vn_off(4 * g + q, 2 * db + (p2 >> 1)) + 8 * (p2 & 1);
#pragma unroll
                  for (int t = 0; t < 2; ++t) { const bf16_t* kp = kd + (size_t)(16 * (ks0 + 16 * t + key)) * HD + 8 * g; kk[t][0] = *(const bf16x8*)kp; kk[t][1] = *(const bf16x8*)(kp + 32); }
                  const LAS unsigned char* vbuf = lds + 32768 + (it & 1) * NVB;
                  if (full) pair2n<true>(GA, GB, kk, vbuf, ks0 + 64, vb, ks0, qs, SEQ / 16, ln); else pair2n<false>(GA, GB, kk, vbuf, ks0 + 64, vb, ks0, qs, SEQ / 16, ln); } } }
#else
                if (full) pair2s<true>(GA, GB, buf, ks0, lo, ks0, qs, ln, kd); else pair2s<false>(GA, GB, buf, ks0, lo, ks0, qs, ln, kd); } }
#endif
        grp_finish_state(GA, MIX, ml, tokA, h, ln); grp_finish_state(GB, MIX, ml, tokA + 256, h, ln);
    }
}
template <int DIL>
__device__ __forceinline__ void nat_load_k(bf16x8 (&k)[5][2][2], const bf16_t* Kb, int hrow0, int cres, int ksub_first, int lane) {
    constexpr int Ls = SEQ / DIL; const int key = lane & 15, g = lane >> 4;
#pragma unroll
    for (int p = 0; p < 5; ++p)
#pragma unroll
        for (int t = 0; t < 2; ++t) { int sub = ksub_first + 32 * p + 16 * t + key; sub = sub < 0 ? 0 : (sub > Ls - 1 ? Ls - 1 : sub);
            const bf16_t* kp = Kb + (size_t)(hrow0 + cres + DIL * sub) * HD + 8 * g;
            k[p][t][0] = *(const bf16x8*)kp; k[p][t][1] = *(const bf16x8*)(kp + 32); }
}
template <int DIL, bool FIRST>
__device__ __forceinline__ void nat_init_state(Grp& G, const bf16_t* MIX, const float* ml, size_t tok0, int h, int lane) {
    const int a = lane & 15, g = lane >> 4;
    if constexpr (FIRST) {
#pragma unroll
        for (int d = 0; d < 4; ++d) G.o[d] = (f32x4){0.f, 0.f, 0.f, 0.f};
        G.m = MFLOOR; G.l = 0.f;
    } else { const size_t tok = tok0 + DIL * a; const f32x2 st = *(const f32x2*)(ml + (tok * NH + h) * 2);
        G.m = st[0]; G.l = st[1] * 0.25f;
#pragma unroll
        for (int db = 0; db < 4; ++db) { const u32x2 w = *(const u32x2*)(MIX + tok * D + h * HD + 16 * db + 4 * g);
            G.o[db] = (f32x4){bflo(w.x), bfhi(w.x), bflo(w.y), bfhi(w.y)} * st[1]; } }
}
template <int DIL, bool LAST>
__device__ __forceinline__ void nat_finish(Grp& G, bf16_t* MIX, float* ml, float* ssqa, size_t tok0, int h, int lane) {
    const int a = lane & 15, g = lane >> 4; float l = G.l; l = xsum16(l); l = xsum32(l);
    const float inv = 1.0f / l; const size_t tok = tok0 + DIL * a; float ss = 0.f;
#pragma unroll
    for (int db = 0; db < 4; ++db) { const f32x4 o = G.o[db] * inv; ss += (o[0] * o[0] + o[1] * o[1]) + (o[2] * o[2] + o[3] * o[3]);
        u32x2 w; w.x = cvt_pk_bf16(o[0], o[1]); w.y = cvt_pk_bf16(o[2], o[3]); *(u32x2*)(MIX + tok * D + h * HD + 16 * db + 4 * g) = w; }
    if constexpr (LAST) { ss = xsum16(ss); ss = xsum32(ss); if (g == 0) ssqa[tok * NH + h] = ss; }
    else { if (g == 0) *(f32x2*)(ml + (tok * NH + h) * 2) = (f32x2){G.m, l}; }
}
template <int DIL, bool FIRST, bool LAST>
__device__ __forceinline__ void nat_pass(LAS unsigned char* lds, const bf16_t* Qb, const bf16_t* Kb, const bf16_t* Vb, bf16_t* MIX, float* ml, float* ssqa, int vcu, int G_, int dup, int wave, int lane_) {
    constexpr int Ls = SEQ / DIL, NCH = Ls / 256, NT = NB * NH * 16;
    const unsigned lds0 = (unsigned)(uintptr_t)lds;
    bf16x8 kf[5][2][2], qn[4];
    ATT_SYNC();
    if (vcu < NT * dup) { int ln = lane_; asm volatile("" : "+v"(ln)); const int L = vcu % NT, sub = L & 15, bh = L >> 4, cres = sub / NCH, l0 = 256 * (sub % NCH);
        nat_load_k<DIL>(kf, Kb, bh * SEQ, cres, l0 + 32 * wave - 64, ln);
        { const int a = ln & 15, g = ln >> 4; const bf16_t* qp = Qb + ((size_t)(bh * SEQ + cres + DIL * (l0 + 32 * wave)) + DIL * a) * HD + 8 * g;
          qn[0] = *(const bf16x8*)qp; qn[1] = *(const bf16x8*)(qp + 32); qn[2] = *(const bf16x8*)(qp + 16 * DIL * HD); qn[3] = *(const bf16x8*)(qp + 16 * DIL * HD + 32); }
        nat_stage_v<DIL>(lds0, (const char*)Vb, bh * SEQ, cres, l0 - 64, wave, ln); }
    int it = 0;
#pragma nounroll
    for (int L0 = vcu; L0 < NT * dup; L0 += G_, ++it) {
        const int L = L0 % NT, sub = L & 15, bh = L >> 4, b = bh / NH, h = bh % NH, cres = sub / NCH, l0 = 256 * (sub % NCH);
        asm volatile("s_waitcnt vmcnt(16) lgkmcnt(0)" ::: "memory"); __builtin_amdgcn_s_barrier(); asm volatile("" ::: "memory");
        int ln = lane_; asm volatile("" : "+v"(ln));
        const bool has_next = L0 + G_ < NT * dup; const int Ln = (L0 + G_) % NT, subn = Ln & 15, bhn = Ln >> 4, cresn = subn / NCH, l0n = 256 * (subn % NCH);
        const LAS unsigned char* vbuf = lds + (it & 1) * NVB;
        const int a = ln & 15, g = ln >> 4, q = (ln >> 2) & 3, p2 = ln & 3;
        int vb[4];
#pragma unroll
        for (int db = 0; db < 4; ++db) vb[db] = vn_off(4 * g + q, 2 * db + (p2 >> 1)) + 8 * (p2 & 1);
        Grp GA, GB; const int pos0 = cres + DIL * (l0 + 32 * wave);
        const size_t tokA = (size_t)(b * SEQ + pos0);
        GA.q0 = qn[0]; GA.q1 = qn[1]; GB.q0 = qn[2]; GB.q1 = qn[3];
        nat_init_state<DIL, FIRST>(GA, MIX, ml, tokA, h, ln); nat_init_state<DIL, FIRST>(GB, MIX, ml, tokA + 16 * DIL, h, ln);
        if constexpr (!FIRST) asm volatile("s_waitcnt vmcnt(0)" ::: "memory");
        if (has_next) { nat_stage_v<DIL>(lds0 + (unsigned)(((it + 1) & 1) * NVB), (const char*)Vb, bhn * SEQ, cresn, l0n - 64, wave, ln);
#ifdef NAT_DMA2
            nat_stage_v<DIL>(lds0 + (unsigned)(((it + 1) & 1) * NVB), (const char*)Vb, bhn * SEQ, cresn, l0n - 64, wave, ln);
#endif
            const bf16_t* qp = Qb + ((size_t)(bhn * SEQ + cresn + DIL * (l0n + 32 * wave)) + DIL * a) * HD + 8 * g;
            qn[0] = *(const bf16x8*)qp; qn[1] = *(const bf16x8*)(qp + 32); qn[2] = *(const bf16x8*)(qp + 16 * DIL * HD); qn[3] = *(const bf16x8*)(qp + 16 * DIL * HD + 32); }
        const int qs = l0 + 32 * wave + a;
#pragma unroll
        for (int p = 0; p < 5; ++p) { const int ks0 = l0 + 32 * wave - 64 + 32 * p; const bool act = (ks0 >= 0 && ks0 < Ls);
            f32x4 s0[2], s1[2];
            if (act) { qk_part(GA, kf[p], s0); qk_part(GB, kf[p], s1); ATT_SB(); }
            if (has_next) nat_load_k1<DIL>(kf[p], Kb, bhn * SEQ, cresn, l0n + 32 * wave - 64 + 32 * p, ln);
#ifdef NAT_K2
            if (has_next) { bf16x8 kx[2][2]; nat_load_k1<DIL>(kx, Kb, bhn * SEQ, cresn, l0n + 32 * wave - 64 + 32 * p, ln); asm volatile("" :: "v"(kx[0][0]), "v"(kx[0][1]), "v"(kx[1][0]), "v"(kx[1][1])); }
#endif
            if (act) { const int ql = l0 + 32 * wave; const bool full = (ks0 + 31 - ql <= 64) && (ql + 31 - ks0 <= 64);
#pragma nounroll
                for (int rep_ = 0; rep_ < D16_REP; ++rep_) {
                    f32x4 t0[2] = {s0[0], s0[1]}, t1[2] = {s1[0], s1[1]};
                    if (full) pair2n_post<true>(GA, GB, t0, t1, vbuf, 32 * wave + 32 * p, vb, ks0, qs, Ls, ln); else pair2n_post<false>(GA, GB, t0, t1, vbuf, 32 * wave + 32 * p, vb, ks0, qs, Ls, ln); } } }
        nat_finish<DIL, LAST>(GA, MIX, ml, ssqa, tokA, h, ln); nat_finish<DIL, LAST>(GB, MIX, ml, ssqa, tokA + 16 * DIL, h, ln);
    }
}
__device__ __forceinline__ void conv_unit(LAS unsigned char* lds, const bf16_t* Cb, bf16_t* MIX, const float* dw_w, const float* dw_b, const float* ln_g, const float* ln_b, const float* out_g,
                                          int b, int s0, int tid_, int wave, int lane_) {
    int tid = tid_, lane = lane_; asm volatile("" : "+v"(tid), "+v"(lane));
    LAS bf16_t* CT = (LAS bf16_t*)lds;
    LAS float* CO = (LAS float*)(lds + 49152);
    ATT_SYNC();
    for (int p = tid; p < 94 * 32; p += NWAVES * 64) { const int row = p >> 5, c = p & 31, s = s0 - 15 + row;
        u32x4 v = (u32x4){0u, 0u, 0u, 0u};
        if (s >= 0 && s < SEQ) v = *(const u32x4*)(Cb + (size_t)(b * SEQ + s) * CCH + c * 8);
        *(LAS u32x4*)(CT + row * CCH + c * 8) = v; }
    ATT_SYNC();
    { const int ch = tid & 255, half = tid >> 8; float v[62], w[CONVK];
#pragma unroll
      for (int k = 0; k < CONVK; ++k) w[k] = dw_w[k * CCH + ch];
#pragma unroll
      for (int i = 0; i < 62; ++i) v[i] = bf2f(CT[(32 * half + i) * CCH + ch]);
      const float bias = dw_b[ch];
#pragma unroll
      for (int p = 0; p < 32; ++p) { float acc = bias;
#pragma unroll
          for (int k = 0; k < CONVK; ++k) acc += v[p + k] * w[k];
          CO[(32 * half + p) * CCH + ch] = acc; } }
    ATT_SYNC();
    { const f32x4 g4 = *((const f32x4*)ln_g + lane), b4 = *((const f32x4*)ln_b + lane), og = *((const f32x4*)out_g + lane);
#pragma unroll
      for (int pp = 0; pp < 8; ++pp) { const int p = wave * 8 + pp; const f32x4 xv = *(const LAS f32x4*)(CO + p * CCH + 4 * lane);
          const float mean = wave_sum((xv[0] + xv[1]) + (xv[2] + xv[3])) * (1.f / CCH); const f32x4 dx = xv - mean;
          const float var = wave_sum((dx[0] * dx[0] + dx[1] * dx[1]) + (dx[2] * dx[2] + dx[3] * dx[3])) * (1.f / CCH); const float rstd = 1.0f / sqrtf(var + LN_EPS);
          f32x4 z;
#pragma unroll
          for (int i = 0; i < 4; ++i) { const float y = dx[i] * rstd * g4[i] + b4[i]; z[i] = y / (1.f + __expf(-y)); }
          const float ms = wave_sum((z[0] * z[0] + z[1] * z[1]) + (z[2] * z[2] + z[3] * z[3])) * (1.f / CCH); const float rs = 1.0f / sqrtf(ms + NORM_EPS);
          u32x2 o; o.x = cvt_pk_bf16(z[0] * rs * og[0], z[1] * rs * og[1]); o.y = cvt_pk_bf16(z[2] * rs * og[2], z[3] * rs * og[3]);
          *(u32x2*)(MIX + (size_t)(b * SEQ + s0 + p) * D + AW + 4 * lane) = o; } }
}
}
namespace moe {
#define MOE_SYNC() do { asm volatile("s_waitcnt vmcnt(0) lgkmcnt(0)" ::: "memory"); __builtin_amdgcn_s_barrier(); asm volatile("" ::: "memory"); } while (0)
__device__ __forceinline__ void split_hi_lo(const f32x4& a, const f32x4& b, bf16x8& hi, bf16x8& lo) {
    u32x4 h, l; float r[8];
    h.x = cvt_pk_bf16(a[0], a[1]); h.y = cvt_pk_bf16(a[2], a[3]); h.z = cvt_pk_bf16(b[0], b[1]); h.w = cvt_pk_bf16(b[2], b[3]);
    r[0] = a[0] - bflo(h.x); r[1] = a[1] - bfhi(h.x); r[2] = a[2] - bflo(h.y); r[3] = a[3] - bfhi(h.y);
    r[4] = b[0] - bflo(h.z); r[5] = b[1] - bfhi(h.z); r[6] = b[2] - bflo(h.w); r[7] = b[3] - bfhi(h.w);
    l.x = cvt_pk_bf16(r[0], r[1]); l.y = cvt_pk_bf16(r[2], r[3]); l.z = cvt_pk_bf16(r[4], r[5]); l.w = cvt_pk_bf16(r[6], r[7]);
    hi = __builtin_bit_cast(bf16x8, h); lo = __builtin_bit_cast(bf16x8, l);
}
__device__ __forceinline__ void route_chunk(LAS unsigned char* lds, const bf16_t* x2, const float* ssq2, const bf16_t* WRF, const float* b_router, const float* b_group,
                                            int* tok_e, float* tok_gate, float* tok_rs, int* hist, int chunk, int tid, int wave, int lane) {
    LAS unsigned char* WB = lds;
    LAS float* LG = (LAS float*)(lds + 49152);
    LAS int* HS = (LAS int*)(lds + 49152 + 36864);
    const int tk = lane & 15, g = lane >> 4;
    f32x4 acc[2][3];
#pragma unroll
    for (int gi = 0; gi < 2; ++gi)
#pragma unroll
        for (int nt = 0; nt < 3; ++nt) acc[gi][nt] = (f32x4){0.f, 0.f, 0.f, 0.f};
    if (tid < 32) HS[tid] = 0;
    const bf16_t* xb = x2 + (size_t)(chunk * 256 + wave * 32 + tk) * D + 8 * g;
#pragma nounroll
    for (int kc = 0; kc < 4; ++kc) {
        MOE_SYNC();
#pragma unroll
        for (int i = 0; i < 6; ++i) { const int p = tid + 512 * i; *(LAS u32x4*)(WB + p * 16) = *(const u32x4*)((const char*)WRF + (size_t)kc * 49152 + p * 16); }
        MOE_SYNC();
#pragma unroll
        for (int gi = 0; gi < 2; ++gi) {
            bf16x8 xa[8];
#pragma unroll
            for (int s = 0; s < 8; ++s) xa[s] = *(const bf16x8*)(xb + (size_t)gi * 16 * D + kc * 256 + s * 32);
#pragma unroll
            for (int s = 0; s < 8; ++s) {
#pragma unroll
                for (int nt = 0; nt < 3; ++nt) { const LAS unsigned char* bp = WB + ((s * 3 + nt) * 2) * 1024 + lane * 16;
                    const bf16x8 bh = *(const LAS bf16x8*)bp, bl = *(const LAS bf16x8*)(bp + 1024);
                    acc[gi][nt] = __builtin_amdgcn_mfma_f32_16x16x32_bf16(xa[s], bh, acc[gi][nt], 0, 0, 0);
                    acc[gi][nt] = __builtin_amdgcn_mfma_f32_16x16x32_bf16(xa[s], bl, acc[gi][nt], 0, 0, 0); } }
        }
    }
#pragma unroll
    for (int gi = 0; gi < 2; ++gi)
#pragma unroll
        for (int nt = 0; nt < 3; ++nt) { const int o = 16 * nt + tk;
            if (o < 36) {
#pragma unroll
                for (int r = 0; r < 4; ++r) LG[(wave * 32 + gi * 16 + 4 * g + r) * 36 + o] = acc[gi][nt][r]; } }
    MOE_SYNC();
    if (wave < 4) { const int tr = wave * 64 + lane, tg = chunk * 256 + tr; const LAS float* lg = LG + tr * 36;
        const f32x4* sp = (const f32x4*)(ssq2 + (size_t)tg * 16); const f32x4 st = (sp[0] + sp[1]) + (sp[2] + sp[3]);
        const float rs = 1.0f / sqrtf(((st[0] + st[1]) + (st[2] + st[3])) * (1.f / D) + NORM_EPS);
        tok_rs[tg] = rs;
        float gl[4];
#pragma unroll
        for (int j = 0; j < 4; ++j) gl[j] = lg[32 + j] * rs + b_group[j];
        float gm = gl[0]; int gi = 0;
#pragma unroll
        for (int j = 1; j < 4; ++j) { if (gl[j] > gm) { gm = gl[j]; gi = j; } }
        float den = 0.f;
#pragma unroll
        for (int j = 0; j < 4; ++j) den += __expf(gl[j] - gm);
        const float gp = 1.0f / den;
        float v0 = -3.0e38f, v1 = -3.0e38f; int i0 = 0, i1 = 0;
#pragma unroll
        for (int j = 0; j < 8; ++j) { const float v = lg[gi * 8 + j] * rs + b_router[gi * 8 + j];
            if (v > v0) { v1 = v0; i1 = i0; v0 = v; i0 = j; } else if (v > v1) { v1 = v; i1 = j; } }
        const float dd = __expf(v1 - v0), g0 = gp / (1.f + dd), g1 = gp * dd / (1.f + dd);
        const int e0 = gi * 8 + i0, e1 = gi * 8 + i1;
        __hip_atomic_fetch_add(HS + e0, 1, __ATOMIC_RELAXED, __HIP_MEMORY_SCOPE_WORKGROUP); __hip_atomic_fetch_add(HS + e1, 1, __ATOMIC_RELAXED, __HIP_MEMORY_SCOPE_WORKGROUP);
        tok_e[tg] = e0 | (e1 << 8); tok_gate[2 * tg] = g0; tok_gate[2 * tg + 1] = g1; }
    MOE_SYNC();
    if (tid < 32) hist[chunk * 32 + tid] = HS[tid];
}
__device__ __forceinline__ void slot_chunk(LAS unsigned char* lds, const int* hist, const int* tok_e, const float* tok_gate, const float* tok_rs, int* tok_slot, int* row_tok, float* slot_rs, float* slot_gate, int* etile,
                                           int chunk, int tid, int wave, int lane) {
    LAS int* CNT = (LAS int*)lds; LAS int* BASE = CNT + 32; LAS int* PST = CNT + 64; LAS int* WC = CNT + 128;
    MOE_SYNC();
    if (tid < 32) { int tot = 0, bs = 0; for (int cc = 0; cc < 256; ++cc) { const int hh = hist[cc * 32 + tid]; bs += (cc < chunk) ? hh : 0; tot += hh; } CNT[tid] = tot; BASE[tid] = bs; }
    MOE_SYNC();
    if (tid == 0) { int ps = 0; for (int e = 0; e < 32; ++e) { PST[e] = ps; ps += ((CNT[e] + 255) >> 8) << 8; } PST[32] = ps; }
    MOE_SYNC();
    int ek[2] = {0, 0}, rank[2] = {0, 0}; const int t = chunk * 256 + (wave & 3) * 64 + lane;
    if (wave < 4) { const int ev = tok_e[t]; ek[0] = ev & 255; ek[1] = ev >> 8;
#pragma unroll
        for (int k = 0; k < 2; ++k)
#pragma nounroll
            for (int e = 0; e < 32; ++e) { const unsigned long long m = __ballot(ek[k] == e);
                if (ek[k] == e) rank[k] = __popcll(m & ((1ull << lane) - 1ull));
                if (lane == 0) WC[(k * 4 + wave) * 32 + e] = __popcll(m); } }
    MOE_SYNC();
    if (wave < 4) {
#pragma unroll
        for (int k = 0; k < 2; ++k) { int off = 0;
            for (int kw = 0; kw < k * 4 + wave; ++kw) off += WC[kw * 32 + ek[k]];
            const int slot = PST[ek[k]] + BASE[ek[k]] + off + rank[k];
            row_tok[slot] = t; slot_rs[slot] = tok_rs[t]; slot_gate[slot] = tok_gate[2 * t + k]; tok_slot[2 * t + k] = slot; } }
    if (chunk < 32) { const int e = chunk, c0 = PST[e] + CNT[e], n = PST[e + 1] - c0;
        for (int i = tid; i < n; i += NWAVES * 64) { row_tok[c0 + i] = 0; slot_rs[c0 + i] = 0.f; slot_gate[c0 + i] = 0.f; } }
    if (chunk == 0 && tid <= 32) etile[tid] = PST[tid] >> 8;
}
__device__ __forceinline__ void final_row(float* xo, const bf16_t* X2, const bf16_t* Y, const int* tok_slot, const float* g, int t, int lane) {
    const int s0 = tok_slot[2 * t], s1 = tok_slot[2 * t + 1];
    f32x4* xr = (f32x4*)(xo + (size_t)t * D) + lane; const u32x2* x2 = (const u32x2*)(X2 + (size_t)t * D) + lane;
    const u32x2* y0 = (const u32x2*)(Y + (size_t)s0 * D) + lane; const u32x2* y1 = (const u32x2*)(Y + (size_t)s1 * D) + lane;
    const f32x4* gr = (const f32x4*)g + lane;
    f32x4 v[4]; float s = 0.f;
#pragma unroll
    for (int j = 0; j < 4; ++j) { const u32x2 x = x2[64 * j], a = y0[64 * j], b = y1[64 * j];
        v[j][0] = bflo(x.x) + (bflo(a.x) + bflo(b.x)); v[j][1] = bfhi(x.x) + (bfhi(a.x) + bfhi(b.x)); v[j][2] = bflo(x.y) + (bflo(a.y) + bflo(b.y)); v[j][3] = bfhi(x.y) + (bfhi(a.y) + bfhi(b.y));
        s += (v[j][0] * v[j][0] + v[j][1] * v[j][1]) + (v[j][2] * v[j][2] + v[j][3] * v[j][3]); }
    const float rs = 1.0f / sqrtf(wave_sum(s) * (1.f / D) + NORM_EPS);
#pragma unroll
    for (int j = 0; j < 4; ++j) xr[64 * j] = v[j] * rs * gr[64 * j];
}
}
#ifndef MK_N_LAUNCHES
#define MK_N_LAUNCHES 1
#endif
constexpr int NPH = 11;
constexpr int N_LAUNCHES = MK_N_LAUNCHES;

#define ARG_IN(k) karg_ptr(8 * (k))
#define ARG_OUT ((float*)karg_ptr(8 * 27))
#define ARG_WS ((unsigned char*)karg_ptr(8 * 28))
template <int LO, int HI>
__global__ void __launch_bounds__(NWAVES * 64, 2) mega_fwd(Args args) {
    extern __shared__ __attribute__((aligned(16))) unsigned char lds_raw[];
    Frame F;
    F.lds = (LAS unsigned char*)lds_raw;
    F.MISC = (volatile LAS unsigned*)(F.lds + LDSCTL_OFF);
    F.wave = __builtin_amdgcn_readfirstlane((int)threadIdx.x >> 6);
    F.G = gridDim.x; { const int bx = blockIdx.x; F.vcu = (F.G % 8 == 0) ? (bx % 8) * (F.G / 8) + bx / 8 : bx; }
    F.ws = ARG_WS; F.ctl = (unsigned*)(ARG_WS + WS_CTL);
    for (int u = threadIdx.x; u < (LDS_BYTES - LDSCTL_OFF) / 4; u += NWAVES * 64) ((LAS unsigned*)(F.lds + LDSCTL_OFF))[u] = 0u;
    __syncthreads();
    XcdBarrier bar; bar.bar = F.ctl + CW_BAR; bar.x = 0; bar.st = nullptr;
    if (HI - LO > 1) bar = xcd_barrier_post(F.ctl + CW_BAR, F.MISC + 8);
#define GRID_BAR() do { if (HI - LO > 1) xcd_barrier(bar); } while (0)
#ifndef PH_MASK
#define PH_MASK 0x7ff
#endif
#define IN(k) ((((PH_MASK) >> (k)) & 1) && LO <= (k) && (k) < HI)
#define BOTH(k) (IN(k) && IN((k) + 1))
#ifndef DUP_PHASE
#define DUP_PHASE -1
#endif
#define DUPF(k) ((k) == DUP_PHASE ? 2 : 1)
    const int gw = F.vcu * NWAVES + F.wave, NGW = F.G * NWAVES;
#define R1 ((bf16_t*)(ARG_WS + WS_R1))
#define R2 ((bf16_t*)(ARG_WS + WS_R2))
#define ssqa ((float*)(ARG_WS + WS_SSQA))
#define ssq1 ((float*)(ARG_WS + WS_SSQ1))
#define ssq2 ((float*)(ARG_WS + WS_SSQ2))
#define tok_e ((int*)(ARG_WS + WS_TOK + TK_E))
#define tok_gate ((float*)(ARG_WS + WS_TOK + TK_GATE))
#define tok_slot ((int*)(ARG_WS + WS_TOK + TK_SLOT))
#define tok_rs ((float*)(ARG_WS + WS_TOK + TK_RS))
#define row_tok ((int*)(ARG_WS + WS_TOK + TK_ROWTOK))
#define slot_rs ((float*)(ARG_WS + WS_TOK + TK_SLOTRS))
#define slot_gate ((float*)(ARG_WS + WS_TOK + TK_SLOTGATE))
#define hist ((int*)(ARG_WS + WS_HIST))
#define etile ((int*)(ARG_WS + WS_HIST + HIST_ETILE))
#define WR ((const bf16_t*)(ARG_WS + WS_HIST + HIST_WR))

    if (IN(0)) { p0_prologue(F); if (DUPF(0) == 2) { asm volatile("s_waitcnt vmcnt(0)" ::: "memory"); __syncthreads(); p0_prologue(F); } if (BOTH(0)) GRID_BAR(); }

    if (IN(1)) {
        { pg8::GridOrder S; S.init(R1, ARG_WS + WS_WIN, D, D, T, INW, F.G, (int)blockIdx.x); S.dup = DUPF(1);
          pg8::EpiU E{R2, (bf16_t*)(ARG_WS + WS_Q), (bf16_t*)(ARG_WS + WS_K), (bf16_t*)(ARG_WS + WS_V), (const float*)(ARG_WS + WS_ROPE), (const float*)(ARG_WS + WS_ROPE) + SEQ * 32};
          pg8::gemm_phase<pg8::EpiU, pg8::GridOrder, false, false>(F.lds, F.wave, D, D, D, S, E); }
        { pg8::KvOrder S{(const char*)(ARG_WS + WS_MEMN), (const char*)(ARG_WS + WS_WXK), (const char*)(ARG_WS + WS_WXV), F.G, (int)blockIdx.x};
          pg8::EpiPlain<false> E{(bf16_t*)(ARG_WS + WS_KX), D, (bf16_t*)(ARG_WS + WS_VX), D, nullptr};
          pg8::gemm_phase<pg8::EpiPlain<false>, pg8::KvOrder, true, false>(F.lds, F.wave, D, D, D, S, E); }
        if (BOTH(1)) GRID_BAR();
    }

    if (IN(2)) {
        { pg8::MnOrder S{(const char*)(ARG_WS + WS_KX), (const char*)(ARG_WS + WS_WXQ), (const char*)(ARG_WS + WS_WXO), (const char*)(ARG_WS + WS_VX), F.G, F.vcu, 1};
          pg8::EpiPlain<false> E{(bf16_t*)(ARG_WS + WS_MT), D, (bf16_t*)(ARG_WS + WS_NT), D, nullptr};
          pg8::gemm_phase<pg8::EpiPlain<false>, pg8::MnOrder, true, false>(F.lds, F.wave, D, D, XHD, S, E); }
#define ATT_ARGS F.lds, (const bf16_t*)(ARG_WS + WS_Q), (const bf16_t*)(ARG_WS + WS_K), (const bf16_t*)(ARG_WS + WS_V), R1, (float*)(ARG_WS + WS_SSQ1), ssqa, F.vcu, F.G
#ifdef D16_KDIRECT
        att::d16_phase(F.lds, (const bf16_t*)(ARG_WS + WS_Q), (const bf16_t*)(ARG_WS + WS_K), (const bf16_t*)(ARG_WS + WS_V), R1, (float*)(ARG_WS + WS_SSQ1), F.vcu, F.G, 1, F.wave, lane_id());
#else
        att::nat_pass<16, true, false>(ATT_ARGS, DUPF(20), F.wave, lane_id());
#endif
        asm volatile("s_waitcnt vmcnt(0) lgkmcnt(0)" ::: "memory"); __syncthreads(); GRID_BAR();
#ifdef NAT_BISECT
        for (int L0 = F.vcu; L0 < NB * NH * 8; L0 += F.G) { const int L = L0 % (NB * NH * 8); const int chunk = L & 7, bh = L >> 3, b = bh / NH, h = bh % NH;
            att::attn_unit(F.lds, (const bf16_t*)(ARG_WS + WS_Q), (const bf16_t*)(ARG_WS + WS_K), (const bf16_t*)(ARG_WS + WS_V), R1, ssqa, (const float*)(ARG_WS + WS_SSQ1), b, h, chunk * 512, F.wave * 64 + lane_id(), F.wave, lane_id()); }
#else
        att::nat_pass<4, false, false>(ATT_ARGS, 1, F.wave, lane_id());
        asm volatile("s_waitcnt vmcnt(0) lgkmcnt(0)" ::: "memory"); __syncthreads(); GRID_BAR();
        att::nat_pass<1, false, true>(ATT_ARGS, 1, F.wave, lane_id());
#endif
        for (int L = F.vcu; L < NB * 64; L += F.G) { const int b = L >> 6, j = L & 63;
            att::conv_unit(F.lds, R2, R1, (const float*)ARG_IN(5), (const float*)ARG_IN(6), (const float*)ARG_IN(7), (const float*)ARG_IN(8), (const float*)ARG_IN(9), b, j * 64, F.wave * 64 + lane_id(), F.wave, lane_id()); }
        asm volatile("s_waitcnt vmcnt(0) lgkmcnt(0)" ::: "memory"); __syncthreads();
        if (BOTH(2)) GRID_BAR();
    }

    if (IN(3)) {
        pg8::GridOrder S; S.init(R1, ARG_WS + WS_WOUT, D, D, T, D, F.G, (int)blockIdx.x); S.dup = DUPF(3);
        pg8::EpiResid<true> E{(const float*)ARG_IN(0), R2, ssq1, ssqa};
        pg8::gemm_phase<pg8::EpiResid<true>, pg8::GridOrder, true, false>(F.lds, F.wave, D, D, D, S, E);
        if (BOTH(3)) GRID_BAR();
    }

    if (IN(4)) {
        pg8::BatchOrder S{(const char*)R2, (const char*)(ARG_WS + WS_MT), (T / 256) * 4, F.G, (int)blockIdx.x, DUPF(4)};
        pg8::EpiSoftmax E{(bf16_t*)(ARG_WS + WS_PM), ssq1};
        pg8::gemm_phase<pg8::EpiSoftmax, pg8::BatchOrder, true, false>(F.lds, F.wave, D, D, D, S, E);
        if (BOTH(4)) GRID_BAR();
    }

    if (IN(5)) {
        pg8::BatchOrder S{(const char*)(ARG_WS + WS_PM), (const char*)(ARG_WS + WS_NT), (T / 256) * 4, F.G, (int)blockIdx.x, 1};
        pg8::EpiResid<false> E{nullptr, R2, ssq2, nullptr};
        pg8::gemm_phase<pg8::EpiResid<false>, pg8::BatchOrder, true, false>(F.lds, F.wave, D, D, D, S, E);
        if (BOTH(5)) GRID_BAR();
    }

    if (IN(6)) {
        for (int c0_ = blockIdx.x; c0_ < (T / 256) * DUPF(6); c0_ += F.G) { const int c = c0_ % (T / 256);
            moe::route_chunk(F.lds, R2, ssq2, WR, (const float*)ARG_IN(22), (const float*)ARG_IN(20), tok_e, tok_gate, tok_rs, hist, c, F.wave * 64 + lane_id(), F.wave, lane_id()); }
        asm volatile("s_waitcnt vmcnt(0) lgkmcnt(0)" ::: "memory"); __syncthreads();
        if (BOTH(6)) GRID_BAR();
    }

    if (IN(7)) {
        for (int c1_ = blockIdx.x; c1_ < (T / 256) * DUPF(7); c1_ += F.G) { const int c = c1_ % (T / 256);
            moe::slot_chunk(F.lds, hist, tok_e, tok_gate, tok_rs, tok_slot, row_tok, slot_rs, slot_gate, etile, c, F.wave * 64 + lane_id(), F.wave, lane_id()); }
        asm volatile("s_waitcnt vmcnt(0) lgkmcnt(0)" ::: "memory"); __syncthreads();
        if (BOTH(7)) GRID_BAR();
    }

    if (IN(8)) {
        pg8::MoeOrder<0> S{(const char*)R2, (const char*)(ARG_WS + WS_W13), row_tok, etile, F.G, (int)blockIdx.x, DUPF(8)};
        pg8::EpiMoe1 E{(bf16_t*)(ARG_WS + WS_HID), slot_rs};
        pg8::gemm_phase<pg8::EpiMoe1, pg8::MoeOrder<0>, true, true>(F.lds, F.wave, D, D, D, S, E);
        if (BOTH(8)) GRID_BAR();
    }

    if (IN(9)) {
        pg8::MoeOrder<1> S{(const char*)(ARG_WS + WS_HID), (const char*)(ARG_WS + WS_W2), row_tok, etile, F.G, (int)blockIdx.x, DUPF(9)};
        pg8::EpiMoe2 E{(bf16_t*)(ARG_WS + WS_Y), slot_gate};
        pg8::gemm_phase<pg8::EpiMoe2, pg8::MoeOrder<1>, true, false>(F.lds, F.wave, FF, FF, FF, S, E);
        if (BOTH(9)) GRID_BAR();
    }

    if (IN(10)) {
        for (int t0_ = gw; t0_ < T * DUPF(10); t0_ += NGW) { const int t = t0_ % T; moe::final_row(ARG_OUT, R2, (const bf16_t*)(ARG_WS + WS_Y), tok_slot, (const float*)ARG_IN(26), t, lane_id()); }
    }
#undef IN
#undef BOTH
}

typedef void (*kern_t)(Args);
template <int... I> struct PhList {};
extern "C" void kernel_launch(void* const* d_in, const int* in_sizes, int n_in, void* d_out, int out_size, void* d_ws, size_t ws_size, hipStream_t stream) {
    static int grid = 0;
#if MK_N_LAUNCHES == 1
    static const kern_t kerns[1] = {mega_fwd<0, NPH>};
#else
    static const kern_t kerns[NPH] = {mega_fwd<0, 1>, mega_fwd<1, 2>, mega_fwd<2, 3>, mega_fwd<3, 4>, mega_fwd<4, 5>, mega_fwd<5, 6>, mega_fwd<6, 7>, mega_fwd<7, 8>, mega_fwd<8, 9>, mega_fwd<9, 10>, mega_fwd<10, 11>};
#endif
    if (grid == 0) {
        if (n_in != 27 || in_sizes[0] != T * D || out_size != T * D || ws_size < WS_END) { fprintf(stderr, "kernel_launch: unexpected problem: n_in %d in0 %d out %d ARG_WS %zu (need %zu)\n", n_in, n_in > 0 ? in_sizes[0] : -1, out_size, ws_size, (size_t)WS_END); grid = -1; return; }
        int dev = 0, cus = 0, per_cu = 0;
        if (hipGetDevice(&dev) != hipSuccess || hipDeviceGetAttribute(&cus, hipDeviceAttributeMultiprocessorCount, dev) != hipSuccess) { grid = -1; return; }
        for (int li = 0; li < N_LAUNCHES; ++li)
            if (hipFuncSetAttribute((const void*)kerns[li], hipFuncAttributeMaxDynamicSharedMemorySize, LDS_BYTES) != hipSuccess) { fprintf(stderr, "kernel_launch: hipFuncSetAttribute failed\n"); grid = -1; return; }
        if (hipOccupancyMaxActiveBlocksPerMultiprocessor(&per_cu, (const void*)kerns[0], NWAVES * 64, LDS_BYTES) != hipSuccess || per_cu < 1) { fprintf(stderr, "kernel_launch: occupancy query says %d\n", per_cu); }
        (void)hipGetLastError();
        grid = cus;
    }
    if (grid < 0) return;
    if (hipMemsetAsync((char*)d_ws + WS_CTL, 0, CTL_ZERO_BYTES, stream) != hipSuccess) return;
    Args a{};
    for (int i = 0; i < 27; ++i) a.in[i] = d_in[i];
    a.out = (float*)d_out; a.ws = (unsigned char*)d_ws;
    for (int li = 0; li < N_LAUNCHES; ++li) {
        a.ph_lo = 0; a.ph_hi = 0; a.li = li; a.pad = 0;
        hipLaunchKernelGGL(kerns[li], dim3(grid), dim3(NWAVES * 64), LDS_BYTES, stream, a);
        const hipError_t le = hipPeekAtLastError();
        if (le != hipSuccess) { fprintf(stderr, "kernel_launch: launch %d failed: %s\n", li, hipGetErrorName(le)); break; }
    }
}
```

```cpp
#include <hip/hip_runtime.h>
#include <cstdio>
#include <cstdint>

#define GAS __attribute__((address_space(1)))
#define LAS __attribute__((address_space(3)))
typedef unsigned short bf16_t;
typedef short bf16x8 __attribute__((ext_vector_type(8)));
typedef short s16x4 __attribute__((ext_vector_type(4)));
typedef float f32x4 __attribute__((ext_vector_type(4)));
typedef float f32x2 __attribute__((ext_vector_type(2)));
typedef unsigned u32x4 __attribute__((ext_vector_type(4)));
typedef unsigned u32x2 __attribute__((ext_vector_type(2)));

constexpr int NB = 16, SEQ = 4096, T = NB * SEQ, D = 1024;
constexpr int CCH = 256, NH = 12, HD = 64, AW = NH * HD, INW = 2 * CCH + 3 * AW;
constexpr int MEML = 256, MROWS = NB * MEML, XH = 4, XHD = 256;
constexpr int NE = 32, EPG = 8, NG = 4, FF = 512;
constexpr int CONVK = 31;
constexpr int A_PAD = T * 2 + NE * 256;
constexpr float NORM_EPS = 1e-6f, LN_EPS = 1e-5f;
constexpr float LOG2E = 1.4426950408889634f;

constexpr size_t MiB = 1u << 20;
constexpr size_t WS_CTL = 0, CTL_ZERO_BYTES = 1 * MiB;
constexpr size_t WS_ROPE = 1 * MiB;
constexpr size_t WS_HIST = 2 * MiB;
constexpr size_t WS_SSQA = 4 * MiB;
constexpr size_t WS_SSQ1 = 8 * MiB;
constexpr size_t WS_SSQ2 = 12 * MiB;
constexpr size_t WS_WIN = 16 * MiB, WS_WOUT = 22 * MiB, WS_WXQ = 24 * MiB, WS_WXK = 26 * MiB, WS_WXV = 28 * MiB, WS_WXO = 30 * MiB;
constexpr size_t WS_W13 = 32 * MiB, WS_W2 = 96 * MiB;
constexpr size_t WS_MEMN = 128 * MiB, WS_KX = 136 * MiB, WS_VX = 144 * MiB;
constexpr size_t WS_TOK = 152 * MiB;
constexpr size_t WS_R1 = 160 * MiB;
constexpr size_t WS_R2 = 288 * MiB;
constexpr size_t WS_Q = 320 * MiB, WS_K = 416 * MiB, WS_V = 512 * MiB;
constexpr size_t WS_MT = 672 * MiB, WS_NT = 704 * MiB;
constexpr size_t WS_PM = 544 * MiB;
constexpr size_t WS_HID = 416 * MiB;
constexpr size_t WS_Y = 552 * MiB;
constexpr size_t WS_XB0 = 824 * MiB;
constexpr size_t WS_END = 952 * MiB;
constexpr size_t TK_E = 0;
constexpr size_t TK_GATE = 1 * MiB;
constexpr size_t TK_SLOT = 2 * MiB;
constexpr size_t TK_RS = 3 * MiB;
constexpr size_t TK_ROWTOK = 4 * MiB;
constexpr size_t TK_SLOTRS = 5 * MiB;
constexpr size_t TK_SLOTGATE = 6 * MiB;
constexpr size_t HIST_ETILE = 64 * 1024, HIST_WR = 128 * 1024;

constexpr int CW_BAR = 4096;

constexpr int NWAVES = 8;
constexpr int RING_BYTES = 131072;
constexpr int XCH_OFF = RING_BYTES;
constexpr int XCH_ETILE = XCH_OFF + 8192;
constexpr int XCH_ROWS = XCH_OFF + 8448;
constexpr int LDSCTL_OFF = RING_BYTES + 12288;
constexpr int LDS_BYTES = 147456;

#define LDS_WAIT() asm volatile("s_waitcnt lgkmcnt(0)" ::: "memory")
#define VM_WAIT() asm volatile("s_waitcnt vmcnt(0)" ::: "memory")
__device__ __forceinline__ unsigned f2bf(float f) { unsigned u = __builtin_bit_cast(unsigned, f); return (u + 0x7fffu + ((u >> 16) & 1u)) >> 16; }
__device__ __forceinline__ unsigned pk2(float lo, float hi) { return f2bf(lo) | (f2bf(hi) << 16); }
__device__ __forceinline__ float bf2f(unsigned short b) { return __builtin_bit_cast(float, (unsigned)b << 16); }
__device__ __forceinline__ float bflo(unsigned w) { return __builtin_bit_cast(float, w << 16); }
__device__ __forceinline__ float bfhi(unsigned w) { return __builtin_bit_cast(float, w & 0xffff0000u); }
typedef __bf16 bf16x2_t __attribute__((ext_vector_type(2)));
__device__ __forceinline__ unsigned cvt_pk_bf16(float lo, float hi) { const f32x2 v = {lo, hi}; return __builtin_bit_cast(unsigned, __builtin_convertvector(v, bf16x2_t)); }
__device__ __forceinline__ float wave_sum(float v) {
#pragma unroll
    for (int o = 1; o < 64; o <<= 1) v += __shfl_xor(v, o);
    return v;
}
__device__ __forceinline__ float frcp(float x) { return __builtin_amdgcn_rcpf(x); }
__device__ __forceinline__ float frsq(float x) { return __builtin_amdgcn_rsqf(x); }
__device__ __forceinline__ float lsum16(float v) { float a = v, b = v; asm volatile("s_nop 1\n\tv_permlane16_swap_b32 %0, %1" : "+v"(a), "+v"(b)); return a + b; }
__device__ __forceinline__ float lsum32(float v) { float a = v, b = v; asm volatile("s_nop 1\n\tv_permlane32_swap_b32 %0, %1" : "+v"(a), "+v"(b)); return a + b; }
__device__ __forceinline__ int lane_id() { return (int)__builtin_amdgcn_mbcnt_hi(~0u, __builtin_amdgcn_mbcnt_lo(~0u, 0u)); }
#define MK_N_LAUNCHES 1
#ifndef PG8_8PH
#define PG8_8PH 0
#endif
namespace pg8 {
constexpr int BM = 256, BK = 64, HALF = 128, HTB = HALF * BK * 2  , STAGE_BYTES = 8 * HTB, NXCD = 8, WGM = 8;

__host__ __device__ __forceinline__ int lds_byte(int r, int c) { const int st = (r >> 4) * 2 + (c >> 5), rr = r & 15, cc = c & 31, ob = rr * 64 + cc * 2; return st * 1024 + (ob ^ (((ob >> 9) & 1) << 5)); }
__host__ __device__ __forceinline__ void stage_rc(int b, int& R, int& C) { const int st = b / 1024, sb = b % 1024, swz = sb ^ (((sb >> 9) & 1) << 5); R = (st >> 1) * 16 + swz / 64; C = (st & 1) * 32 + (swz % 64) / 2; }
__host__ __device__ __forceinline__ int perm32(int rho) { const int n = rho >> 4, i = rho & 15; return 8 * (i >> 2) + 4 * n + (i & 3); }

struct Unit { const char* a; const char* b; const int* rows; int pm, pn, x0, x1; };

typedef f32x4 Acc[2][2][4][2];

__device__ __forceinline__ const char* uniform_ptr(const char* p) { const unsigned long long v = (unsigned long long)p;
    const unsigned lo = __builtin_amdgcn_readfirstlane((unsigned)v), hi = __builtin_amdgcn_readfirstlane((unsigned)(v >> 32)); return (const char*)(((unsigned long long)hi << 32) | lo); }
__device__ __forceinline__ void glds16_sv(const char* gbase, unsigned voff, unsigned lds_dst) { unsigned keep;
    asm volatile("s_mov_b32 %0, m0\n\ts_mov_b32 m0, %3\n\ts_nop 2\n\tglobal_load_lds_dwordx4 %1, %2\n\ts_mov_b32 m0, %0" : "=&s"(keep) : "v"(voff), "s"(gbase), "s"(lds_dst) : "memory"); }
template <class Epi, class Sched, bool ALIGN_EPI, bool GATHER>
__device__ __forceinline__ void gemm_phase(LAS unsigned char* lds, const int wave_, const int lda, const int ldb, const int K, const Sched& S, const Epi& E) {
    int lane_ = lane_id(); asm volatile("" : "+v"(lane_));
    const int wid = __builtin_amdgcn_readfirstlane(wave_), tid = wid * 64 + lane_, lane = tid & 63, wr = wid >> 2, wc = wid & 3, fr = lane & 15, fq = lane >> 4;
    const int nt = K / BK;
    int Rr[2], Cc[2];
    unsigned vA[2][2], vN[2][2], voffB[2];
#pragma unroll
    for (int i = 0; i < 2; ++i) { int R, C; stage_rc(tid * 16 + i * 8192, R, C); Rr[i] = R; Cc[i] = C; const int Rb = Epi::PERM ? ((R & ~31) + perm32(R & 31)) : R;
        voffB[i] = (unsigned)(Rb * ldb + C) * 2u; }
    const size_t kstep = (size_t)(BK * 2);
    const size_t hstepB = (size_t)HALF * ldb * 2, hstepA = (size_t)HALF * lda * 2;
    const unsigned ldsw = (unsigned)wid * 1024u, lds0 = (unsigned)(uintptr_t)lds;
    const int aoff = lds_byte(wr * 64 + fr, fq * 8), boff = lds_byte(wc * 32 + fr, fq * 8);
#define PG8_SA(b, h) (((b) * 2 + (h)) * HTB)
#define PG8_SB(b, h) ((4 + (b) * 2 + (h)) * HTB)
#define PG8_STAGE(bufoff, gbase, voff) do { _Pragma("unroll") for (int _i = 0; _i < 2; ++_i) glds16_sv((gbase), (voff)[_i], lds0 + (unsigned)(bufoff) + ldsw + _i * 8192u); } while (0)
#define PG8_LDA(dst, b, h) do { _Pragma("unroll") for (int m = 0; m < 4; ++m) _Pragma("unroll") for (int k = 0; k < 2; ++k) dst[m][k] = *(const LAS bf16x8*)(lds + PG8_SA(b, h) + aoff + m * 2048 + k * 1024); } while (0)
#define PG8_LDB(dst, b, h) do { _Pragma("unroll") for (int n = 0; n < 2; ++n) _Pragma("unroll") for (int k = 0; k < 2; ++k) dst[n][k] = *(const LAS bf16x8*)(lds + PG8_SB(b, h) + boff + n * 2048 + k * 1024); } while (0)
#define PG8_MMA(ai, bj, At, Bt) do { __builtin_amdgcn_s_setprio(1); _Pragma("unroll") for (int m = 0; m < 4; ++m) _Pragma("unroll") for (int n = 0; n < 2; ++n) _Pragma("unroll") for (int k = 0; k < 2; ++k) \
        acc[ai][bj][m][n] = __builtin_amdgcn_mfma_f32_16x16x32_bf16(Bt[n][k], At[m][k], acc[ai][bj][m][n], 0, 0, 0); __builtin_amdgcn_s_setprio(0); } while (0)
#define PG8_MMAQ(ai, bj, At, Bt) PG8_MMA(ai, bj, At, Bt)
#define PG8_WAIT_V(n) asm volatile("s_waitcnt vmcnt(" #n ")" ::: "memory")
#define PG8_WAIT_L(n) asm volatile("s_waitcnt lgkmcnt(" #n ")" ::: "memory")
#define PG8_BAR __builtin_amdgcn_s_barrier()
#define PG8_SCHED __builtin_amdgcn_sched_barrier(0)
#define PG8_VOFF(dst, u) do { _Pragma("unroll") for (int _h = 0; _h < 2; ++_h) _Pragma("unroll") for (int _i = 0; _i < 2; ++_i) { \
        if constexpr (GATHER) dst[_h][_i] = (unsigned)(u).rows[_h * HALF + Rr[_i]] * (unsigned)(lda * 2) + (unsigned)(Cc[_i] * 2); \
        else dst[_h][_i] = (unsigned)(Rr[_i] * lda + Cc[_i]) * 2u; } } while (0)
#define PG8_STAGE_A(bufoff, gbase, h, vv) do { if constexpr (GATHER) { PG8_STAGE(bufoff, gbase, vv[h]); } else { PG8_STAGE(bufoff, (gbase) + (h) * hstepA, vv[0]); } } while (0)
    Unit cur, nxt; int ui = 0;
    if (!S.next(0, cur)) return;
    Acc acc;
#pragma unroll
    for (int a = 0; a < 2; ++a)
#pragma unroll
        for (int b = 0; b < 2; ++b)
#pragma unroll
            for (int m = 0; m < 4; ++m)
#pragma unroll
                for (int n = 0; n < 2; ++n) acc[a][b][m][n] = (f32x4){0.f, 0.f, 0.f, 0.f};
    bf16x8 At[4][2], B0[2][2], B1[2][2];
    const char* cA = uniform_ptr(cur.a); const char* cB = uniform_ptr(cur.b);
    PG8_VOFF(vA, cur);
    if constexpr (GATHER) { asm volatile("s_waitcnt vmcnt(0)" ::: "memory"); }
#if PG8_8PH
    PG8_STAGE(PG8_SB(0, 0), cB, voffB); PG8_STAGE_A(PG8_SA(0, 0), cA, 0, vA); PG8_STAGE(PG8_SB(0, 1), cB + hstepB, voffB); PG8_STAGE_A(PG8_SA(0, 1), cA, 1, vA);
    if (wr == 1) PG8_BAR;
    PG8_WAIT_V(4); PG8_BAR;
    PG8_STAGE(PG8_SB(1, 0), cB + kstep, voffB); PG8_STAGE_A(PG8_SA(1, 0), cA + kstep, 0, vA); PG8_STAGE(PG8_SB(1, 1), cB + hstepB + kstep, voffB);
    PG8_WAIT_V(6); PG8_BAR;
#else
    PG8_STAGE(PG8_SB(0, 0), cB, voffB); PG8_STAGE(PG8_SB(0, 1), cB + hstepB, voffB); PG8_STAGE_A(PG8_SA(0, 0), cA, 0, vA); PG8_STAGE_A(PG8_SA(0, 1), cA, 1, vA);
    if (wr == 1) PG8_BAR;
    PG8_WAIT_V(2); PG8_BAR;
    PG8_STAGE(PG8_SB(1, 0), cB + kstep, voffB); PG8_STAGE_A(PG8_SA(1, 0), cA + kstep, 0, vA); PG8_STAGE(PG8_SB(1, 1), cB + hstepB + kstep, voffB);
    PG8_WAIT_V(6); PG8_BAR;
#endif
    for (;;) {
        const bool has_next = S.next(ui + 1, nxt);
        const char* nA = has_next ? uniform_ptr(nxt.a) : cA; const char* nB = has_next ? uniform_ptr(nxt.b) : cB;
        if constexpr (GATHER) {
            if (has_next && wid == 0) glds16_sv(uniform_ptr((const char*)nxt.rows), (unsigned)lane * 16u, lds0 + (unsigned)XCH_ROWS + (unsigned)((ui + 1) & 1) * 1024u);
#pragma unroll
            for (int h = 0; h < 2; ++h) { vN[h][0] = vA[h][0]; vN[h][1] = vA[h][1]; } }
#pragma nounroll
        for (int t = 0; t < nt; t += 2) {
            const bool last = (t == nt - 2);
            if constexpr (Epi::HAS_MID) { if (t == E.mid_t()) E.mid(acc, cur, wr, wc, fr, fq); }
            const char* a1 = cA + (size_t)(t + 1) * kstep;
            const char* a2 = last ? nA : cA + (size_t)(t + 2) * kstep; const char* b2 = last ? nB : cB + (size_t)(t + 2) * kstep;
            const char* a3 = a2 + kstep; const char* b3 = b2 + kstep;
            unsigned vW[2][2];
            if constexpr (GATHER) { if (last && has_next) { const LAS int* rtab = (const LAS int*)(lds + XCH_ROWS + ((ui + 1) & 1) * 1024);
#pragma unroll
                for (int h = 0; h < 2; ++h)
#pragma unroll
                    for (int i = 0; i < 2; ++i) vN[h][i] = (unsigned)rtab[h * HALF + Rr[i]] * (unsigned)(lda * 2) + (unsigned)(Cc[i] * 2); } }
#pragma unroll
            for (int h = 0; h < 2; ++h) { vW[h][0] = vA[h][0]; vW[h][1] = vA[h][1]; if constexpr (GATHER) { if (last) { vW[h][0] = vN[h][0]; vW[h][1] = vN[h][1]; } } }
#if PG8_8PH
            PG8_LDB(B0, 0, 0); PG8_SCHED; PG8_LDA(At, 0, 0); PG8_STAGE_A(PG8_SA(1, 1), a1, 1, vA);
            PG8_WAIT_L(8); PG8_BAR; PG8_WAIT_L(0); PG8_MMAQ(0, 0, At, B0); PG8_BAR; PG8_SCHED;
            PG8_LDB(B1, 0, 1); PG8_STAGE(PG8_SB(0, 0), b2, voffB);
            PG8_BAR; PG8_WAIT_L(0); PG8_MMAQ(0, 1, At, B1); PG8_BAR;
            PG8_LDA(At, 0, 1); PG8_STAGE_A(PG8_SA(0, 0), a2, 0, vW);
            PG8_BAR; PG8_WAIT_L(0); PG8_MMAQ(1, 0, At, B0); PG8_BAR; PG8_SCHED;
            PG8_STAGE(PG8_SB(0, 1), b2 + hstepB, voffB);
            PG8_WAIT_V(6); PG8_BAR; PG8_MMAQ(1, 1, At, B1); PG8_BAR;
            PG8_LDB(B0, 1, 0); PG8_SCHED; PG8_LDA(At, 1, 0); PG8_STAGE_A(PG8_SA(0, 1), a2, 1, vW);
            PG8_WAIT_L(8); PG8_BAR; PG8_WAIT_L(0); PG8_MMAQ(0, 0, At, B0); PG8_BAR; PG8_SCHED;
            PG8_LDB(B1, 1, 1); PG8_STAGE(PG8_SB(1, 0), b3, voffB);
            PG8_BAR; PG8_WAIT_L(0); PG8_MMAQ(0, 1, At, B1); PG8_BAR;
            PG8_LDA(At, 1, 1); PG8_STAGE_A(PG8_SA(1, 0), a3, 0, vW);
            PG8_BAR; PG8_WAIT_L(0); PG8_MMAQ(1, 0, At, B0); PG8_BAR; PG8_SCHED;
            PG8_STAGE(PG8_SB(1, 1), b3 + hstepB, voffB);
            PG8_WAIT_V(6); PG8_BAR; PG8_MMAQ(1, 1, At, B1); PG8_BAR;
#else
            PG8_LDB(B0, 0, 0); PG8_LDB(B1, 0, 1); PG8_SCHED; PG8_LDA(At, 0, 0); PG8_STAGE_A(PG8_SA(1, 1), a1, 1, vA);
            PG8_WAIT_V(8); PG8_WAIT_L(0); PG8_BAR; PG8_MMA(0, 0, At, B0); PG8_MMA(0, 1, At, B1); PG8_BAR; PG8_SCHED;
            PG8_LDA(At, 0, 1); PG8_STAGE(PG8_SB(0, 0), b2, voffB); PG8_STAGE(PG8_SB(0, 1), b2 + hstepB, voffB); PG8_STAGE_A(PG8_SA(0, 0), a2, 0, vW);
            PG8_WAIT_V(8); PG8_WAIT_L(0); PG8_BAR; PG8_MMA(1, 0, At, B0); PG8_MMA(1, 1, At, B1); PG8_BAR; PG8_SCHED;
            PG8_LDB(B0, 1, 0); PG8_LDB(B1, 1, 1); PG8_SCHED; PG8_LDA(At, 1, 0); PG8_STAGE_A(PG8_SA(0, 1), a2, 1, vW);
            PG8_WAIT_V(8); PG8_WAIT_L(0); PG8_BAR; PG8_MMA(0, 0, At, B0); PG8_MMA(0, 1, At, B1); PG8_BAR; PG8_SCHED;
            PG8_LDA(At, 1, 1); PG8_STAGE(PG8_SB(1, 0), b3, voffB); PG8_STAGE(PG8_SB(1, 1), b3 + hstepB, voffB); PG8_STAGE_A(PG8_SA(1, 0), a3, 0, vW);
            PG8_WAIT_V(8); PG8_WAIT_L(0); PG8_BAR; PG8_MMA(1, 0, At, B0); PG8_MMA(1, 1, At, B1); PG8_BAR; PG8_SCHED;
#endif
        }
        if constexpr (ALIGN_EPI) { if (wr == 0) PG8_BAR; }
        E(acc, cur, wr, wc, fr, fq, lds, wid, lane);
        if (!has_next) break;
#pragma unroll
        for (int a = 0; a < 2; ++a)
#pragma unroll
            for (int b = 0; b < 2; ++b)
#pragma unroll
                for (int m = 0; m < 4; ++m)
#pragma unroll
                    for (int n = 0; n < 2; ++n) acc[a][b][m][n] = (f32x4){0.f, 0.f, 0.f, 0.f};
        cur = nxt; cA = nA; cB = nB; ++ui;
        if constexpr (GATHER) {
#pragma unroll
            for (int h = 0; h < 2; ++h) { vA[h][0] = vN[h][0]; vA[h][1] = vN[h][1]; } }
        if constexpr (ALIGN_EPI) { if (wr == 1) PG8_BAR; }
    }
    PG8_WAIT_V(0);
    if constexpr (!ALIGN_EPI) { if (wr == 0) PG8_BAR; }
    PG8_BAR;
#undef PG8_SA
#undef PG8_SB
#undef PG8_STAGE
#undef PG8_LDA
#undef PG8_LDB
#undef PG8_MMA
#undef PG8_MMAQ
#undef PG8_WAIT_V
#undef PG8_WAIT_L
#undef PG8_BAR
#undef PG8_SCHED
#undef PG8_VOFF
#undef PG8_STAGE_A
}
}
#define XB_TMO      128
#define XB_XCNT(j)  (256  + 64 * (j))
#define XB_XSUB(j)  (1280 + 64 * (j))
#define XB_XGEN(j)  (2304 + 64 * (j))
#define XB_TOP      3328
#define XB_TOPGEN   3392
#define XCD_BAR_WORDS 3456
#define XB_SPIN_CAP (1u << 18)

__device__ __forceinline__ unsigned xb_ld(unsigned* p)              { return __hip_atomic_load(p, __ATOMIC_RELAXED, __HIP_MEMORY_SCOPE_AGENT); }
__device__ __forceinline__ unsigned xb_add(unsigned* p, unsigned v) { return __hip_atomic_fetch_add(p, v, __ATOMIC_RELAXED, __HIP_MEMORY_SCOPE_AGENT); }
__device__ __forceinline__ unsigned xb_xcc_id() { return (unsigned)__builtin_amdgcn_s_getreg((3 << 11) | 20) & 0xFu; }
#define XB_SPIN(cond, bar) do { unsigned _sp = 0; while (cond) { __builtin_amdgcn_s_sleep(1); \
    if ((++_sp & 255u) == 0u) { if (xb_ld(&(bar)[XB_TMO])) break; if (_sp > XB_SPIN_CAP) { atomicAdd(&(bar)[XB_TMO], 1u); break; } } } } while (0)

struct XcdBarrier {
    unsigned* bar; unsigned x;
    volatile LAS unsigned* st;
};

__device__ __forceinline__ XcdBarrier xcd_barrier_post(unsigned* bar, volatile LAS unsigned* st) {
    XcdBarrier b; b.bar = bar; b.x = xb_xcc_id(); b.st = st;
    if (threadIdx.x == 0) (void)xb_add(&bar[XB_XCNT(b.x)], 1u);
    return b;
}
__device__ __forceinline__ void xcd_barrier_complete(unsigned* bar, unsigned x, unsigned& nloc, unsigned& nx) {
    const unsigned G = gridDim.x * gridDim.y * gridDim.z;
    unsigned sum, cnt, mine, sp = 0u;
    for (;;) {
        sum = 0u; cnt = 0u; mine = 0u;
#pragma unroll
        for (unsigned j = 0; j < 16; ++j) { const unsigned c = xb_ld(&bar[XB_XCNT(j)]); sum += c; cnt += (c > 0u) ? 1u : 0u; mine = (j == x) ? c : mine; }
        if (sum == G) break;
        __builtin_amdgcn_s_sleep(1);
        if ((++sp & 255u) == 0u) { if (xb_ld(&bar[XB_TMO])) break; if (sp > XB_SPIN_CAP) { atomicAdd(&bar[XB_TMO], 1u); break; } }
    }
    nloc = mine > 0u ? mine : 1u; nx = cnt > 0u ? cnt : 1u;
}

__device__ __forceinline__ void xcd_barrier(const XcdBarrier& b) {
    asm volatile("s_waitcnt vmcnt(0)" ::: "memory");
    __syncthreads();
    if (threadIdx.x == 0) {
        unsigned* bar = b.bar;
        __builtin_amdgcn_s_waitcnt(0);
        unsigned nloc = b.st[0], nx = b.st[1];
        if (nloc == 0u) { xcd_barrier_complete(bar, b.x, nloc, nx); b.st[0] = nloc; b.st[1] = nx; }
        const unsigned old = xb_add(&bar[XB_XSUB(b.x)], 1u);
        const unsigned gen = old / nloc;
#ifndef XB_FLAT
#define XB_FLAT 1
#endif
#if XB_FLAT
        if (old + 1u == (gen + 1u) * nloc) {
            __builtin_amdgcn_fence(__ATOMIC_RELEASE, "agent");
            asm volatile("s_waitcnt vmcnt(0)" ::: "memory");
            (void)xb_add(&bar[XB_TOP], 1u);
        }
        XB_SPIN(xb_ld(&bar[XB_TOP]) < (gen + 1u) * nx, bar);
        __builtin_amdgcn_fence(__ATOMIC_ACQUIRE, "agent");
        asm volatile("s_waitcnt vmcnt(0)" ::: "memory");
#else
        if (old + 1u == (gen + 1u) * nloc) {
            __builtin_amdgcn_fence(__ATOMIC_RELEASE, "agent");
            asm volatile("s_waitcnt vmcnt(0)" ::: "memory");
            const unsigned og = xb_add(&bar[XB_TOP], 1u);
            const unsigned tg = og / nx;
            if (og + 1u == (tg + 1u) * nx) xb_add(&bar[XB_TOPGEN], 1u);
            else XB_SPIN(xb_ld(&bar[XB_TOPGEN]) == tg, bar);
            __builtin_amdgcn_fence(__ATOMIC_ACQUIRE, "agent");
            xb_add(&bar[XB_XGEN(b.x)], 1u);
            asm volatile("s_waitcnt vmcnt(0)" ::: "memory");
        } else {
            XB_SPIN(xb_ld(&bar[XB_XGEN(b.x)]) == gen, bar);
            __builtin_amdgcn_fence(__ATOMIC_ACQUIRE, "agent");
            asm volatile("s_waitcnt vmcnt(0)" ::: "memory");
        }
#endif
    }
    __syncthreads();
}


namespace pg8 {
#define EPI_NOMID static constexpr bool HAS_MID = false; __device__ __forceinline__ int mid_t() const { return -1; } __device__ __forceinline__ void mid(Acc&, const Unit&, int, int, int, int) const {}
#define RAW_BARRIER() do { asm volatile("s_waitcnt lgkmcnt(0)" ::: "memory"); __builtin_amdgcn_s_barrier(); asm volatile("" ::: "memory"); } while (0)

__device__ __forceinline__ u32x4 pack8(const f32x4& v0, const f32x4& v1) { u32x4 w; w.x = cvt_pk_bf16(v0[0], v0[1]); w.y = cvt_pk_bf16(v0[2], v0[3]); w.z = cvt_pk_bf16(v1[0], v1[1]); w.w = cvt_pk_bf16(v1[2], v1[3]); return w; }

struct GridOrder {
    const char* A; const char* Bt; int lda, ldb, nM, nN, nwg, G, c, dup;
    __device__ __forceinline__ void init(const void* A_, const void* Bt_, int lda_, int ldb_, int M, int N, int G_, int c_) { A = (const char*)A_; Bt = (const char*)Bt_; lda = lda_; ldb = ldb_; nM = M / BM; nN = N / BM; nwg = nM * nN; G = G_; c = c_; dup = 1; }
    __device__ __forceinline__ bool next(int i, Unit& u) const {
        const long L = (long)i * G + c; if (L >= (long)nwg * dup) return false;
        int wgid = (int)(L % nwg); { const int q = nwg / NXCD, r = nwg % NXCD, xcd = wgid % NXCD, off = wgid / NXCD; wgid = (xcd < r ? xcd * (q + 1) : r * (q + 1) + (xcd - r) * q) + off; }
        const int nig = WGM * nN, gid = wgid / nig, fm = gid * WGM, gsz = (nM - fm) < WGM ? (nM - fm) : WGM;
        u.pm = fm + ((wgid % nig) % gsz); u.pn = (wgid % nig) / gsz; u.x0 = 0; u.x1 = 0; u.rows = nullptr;
        u.a = A + (size_t)u.pm * BM * lda * 2; u.b = Bt + (size_t)u.pn * BM * ldb * 2; return true;
    }
};
struct KvOrder {
    const char* memn; const char* wk; const char* wv; int G, c;
    __device__ __forceinline__ bool next(int i, Unit& u) const {
        int L; if (G >= 2) { if (!(c & 1)) return false; L = (c >> 1) + i * (G >> 1); } else L = i * G + c;
        if (L >= 128) return false;
        const int l = L & 63; u.rows = nullptr; u.x1 = 0; u.x0 = L >> 6; u.pm = l >> 2; u.pn = l & 3;
        u.a = memn + (size_t)u.pm * BM * D * 2; u.b = (u.x0 ? wv : wk) + (size_t)u.pn * BM * D * 2;
        return true;
    }
};
struct MnOrder {
    const char* kx; const char* wq2; const char* wxoT; const char* vx; int G, c, dup;
    __device__ __forceinline__ bool next(int i, Unit& u) const {
        int L = i * G + c; if (L >= 512 * dup) return false;
        L &= 511; const int l = L & 255, bh = l >> 2, t4 = l & 3, b = bh >> 2, h = bh & 3; u.rows = nullptr; u.x1 = 0;
        if (L < 256) { u.x0 = 0; u.pm = b * 4 + h; u.pn = t4; u.a = kx + ((size_t)b * MEML * D + h * XHD) * 2; u.b = wq2 + ((size_t)t4 * BM * D + h * XHD) * 2; }
        else { u.x0 = 1; u.pm = b * 4 + t4; u.pn = h; u.a = wxoT + ((size_t)t4 * BM * D + h * XHD) * 2; u.b = vx + ((size_t)b * MEML * D + h * XHD) * 2; }
        return true;
    }
};
struct BatchOrder {
    const char* A; const char* Bt; int nwg, G, c, dup;
    __device__ __forceinline__ bool next(int i, Unit& u) const {
        const long L = (long)i * G + c; if (L >= (long)nwg * dup) return false;
        int wgid = (int)(L % nwg); { const int q = nwg / NXCD, r = nwg % NXCD, xcd = wgid % NXCD, off = wgid / NXCD; wgid = (xcd < r ? xcd * (q + 1) : r * (q + 1) + (xcd - r) * q) + off; }
        const int nN = 4, nM = T / BM, nig = WGM * nN, gid = wgid / nig, fm = gid * WGM, gsz = (nM - fm) < WGM ? (nM - fm) : WGM;
        u.pm = fm + ((wgid % nig) % gsz); u.pn = (wgid % nig) / gsz; u.x0 = 0; u.x1 = 0; u.rows = nullptr;
        u.a = A + (size_t)u.pm * BM * D * 2; u.b = Bt + ((size_t)(u.pm >> 4) * D + u.pn * BM) * D * 2; return true;
    }
};
template <int MODE> struct MoeOrder {
    const char* A; const char* W; const int* rowtok; const LAS int* etile; int G, c, dup;
    __device__ __forceinline__ bool next(int i, Unit& u) const {
        int L = i * G + c; const int ntile = __builtin_amdgcn_readfirstlane(etile[NE]);
        if (L >= ntile * 4 * dup) return false;
        L %= ntile * 4;
        const int rt = L >> 2, ct = L & 3; const int ln = lane_id();
        const int e = __popcll(__ballot(ln >= 1 && ln < NE && etile[ln & (NE - 1)] <= rt));
        u.pm = rt; u.pn = ct; u.x0 = e; u.x1 = 0;
        if (MODE == 0) { u.a = A; u.rows = rowtok + rt * BM; u.b = W + ((size_t)e * 1024 + ct * BM) * D * 2; }
        else { u.a = A + (size_t)rt * BM * FF * 2; u.rows = nullptr; u.b = W + ((size_t)e * 1024 + ct * BM) * FF * 2; }
        return true;
    }
};

struct EpiU {
    static constexpr bool PERM = true; EPI_NOMID
    bf16_t* Cb; bf16_t* Q; bf16_t* Kb; bf16_t* V; const float* ropec; const float* ropes; const float* rs0;
    __device__ __forceinline__ void operator()(Acc& acc, const Unit& u, int wr, int wc, int fr, int fq, LAS unsigned char*, int, int) const {
        const int row0 = u.pm * BM + wr * 64 + fr; float rsv[8];
#pragma unroll
        for (int st = 0; st < 8; ++st) rsv[st] = rs0[row0 + (st >> 2) * HALF + (st & 3) * 16];
        if (u.pn < 2) {
#pragma unroll
            for (int ai = 0; ai < 2; ++ai)
#pragma unroll
                for (int m = 0; m < 4; ++m) { const int row = row0 + ai * HALF + m * 16; f32x4 o[2];
#pragma unroll
                    for (int n = 0; n < 2; ++n)
#pragma unroll
                        for (int i = 0; i < 4; ++i) { const float a = acc[ai][0][m][n][i] * rsv[4 * ai + m], g = acc[ai][1][m][n][i] * rsv[4 * ai + m]; o[n][i] = a * frcp(1.f + __expf(-g)); }
                    *(u32x4*)(Cb + (size_t)row * CCH + u.pn * HALF + wc * 32 + fq * 8) = pack8(o[0], o[1]); }
        } else if (u.pn < 8) {
            const int sec = (u.pn - 2) / 3, tt = (u.pn - 2) % 3; bf16_t* dst = sec ? Kb : Q; const float sc = sec ? 1.f : 0.125f * LOG2E;
            const int hd = 4 * tt + wc;
            constexpr int EPI_PD = 3; f32x4 cs[8][2], sn[8][2];
#define EPIU_LOAD(st) do { const int s_ = (row0 + ((st) >> 2) * HALF + ((st) & 3) * 16) & (SEQ - 1); _Pragma("unroll") for (int n = 0; n < 2; ++n) { \
                cs[st][n] = *(const f32x4*)(ropec + s_ * 32 + fq * 8 + n * 4); sn[st][n] = *(const f32x4*)(ropes + s_ * 32 + fq * 8 + n * 4); } } while (0)
#pragma unroll
            for (int st = 0; st < EPI_PD; ++st) EPIU_LOAD(st);
#pragma unroll
            for (int st = 0; st < 8; ++st) { const int ai = st >> 2, m = st & 3; const int row = row0 + ai * HALF + m * 16; const int s = row & (SEQ - 1); f32x4 o1[2], o2[2];
                if (st + EPI_PD < 8) EPIU_LOAD(st + EPI_PD);
#pragma unroll
                for (int n = 0; n < 2; ++n) { const f32x4 x1 = acc[ai][0][m][n], x2 = acc[ai][1][m][n];
                    o1[n] = (x1 * cs[st][n] - x2 * sn[st][n]) * (sc * rsv[st]); o2[n] = (x1 * sn[st][n] + x2 * cs[st][n]) * (sc * rsv[st]); }
                bf16_t* p = dst + ((size_t)((row >> 12) * NH + hd) * SEQ + s) * HD + fq * 8;
                *(u32x4*)p = pack8(o1[0], o1[1]); *(u32x4*)(p + 32) = pack8(o2[0], o2[1]); }
#undef EPIU_LOAD
        } else {
            const int tt = u.pn - 8;
#pragma unroll
            for (int ai = 0; ai < 2; ++ai)
#pragma unroll
                for (int m = 0; m < 4; ++m) { const int row = row0 + ai * HALF + m * 16;
#pragma unroll
                    for (int bj = 0; bj < 2; ++bj) { const int col = tt * BM + bj * HALF + wc * 32 + fq * 8;
                        *(u32x4*)(V + ((size_t)((row >> 12) * NH + (col >> 6)) * SEQ + (row & (SEQ - 1))) * HD + (col & 63)) = pack8(acc[ai][bj][m][0] * rsv[4 * ai + m], acc[ai][bj][m][1] * rsv[4 * ai + m]); } }
        }
    }
};
template <bool ROWSCALE> struct EpiPlain {
    static constexpr bool PERM = true; EPI_NOMID
    bf16_t* O0; int ldc0; bf16_t* O1; int ldc1; const float* ssq16;
    __device__ __forceinline__ void operator()(Acc& acc, const Unit& u, int wr, int wc, int fr, int fq, LAS unsigned char*, int, int) const {
        bf16_t* O = u.x0 ? O1 : O0; const int ldc = u.x0 ? ldc1 : ldc0;
        const int row0 = u.pm * BM + wr * 64 + fr, col0 = u.pn * BM + wc * 32 + fq * 8;
#pragma unroll
        for (int ai = 0; ai < 2; ++ai)
#pragma unroll
            for (int m = 0; m < 4; ++m) { const int row = row0 + ai * HALF + m * 16; float rs = 1.f;
                if constexpr (ROWSCALE) { const f32x4* sp = (const f32x4*)(ssq16 + (size_t)row * 16); const f32x4 s0 = sp[0], s1 = sp[1], s2 = sp[2], s3 = sp[3];
                    const f32x4 st = (s0 + s1) + (s2 + s3); rs = frsq(((st[0] + st[1]) + (st[2] + st[3])) * (1.0f / D) + NORM_EPS); }
#pragma unroll
                for (int bj = 0; bj < 2; ++bj) *(u32x4*)(O + (size_t)row * ldc + col0 + bj * HALF) = pack8(acc[ai][bj][m][0] * rs, acc[ai][bj][m][1] * rs); }
    }
};
#ifndef RESID_PD
#define RESID_PD 4
#endif
template <bool MID> struct EpiResid {
    static constexpr bool PERM = true, HAS_MID = MID;
    const bf16_t* xsrc; bf16_t* XB; float* ssqp; const float* ssqa;
    __device__ __forceinline__ int mid_t() const { return AW / BK; }
    __device__ __forceinline__ void mid(Acc& acc, const Unit& u, int wr, int wc, int fr, int fq) const {
        const int row0 = u.pm * BM + wr * 64 + fr;
        f32x4 sq[2][4];
#pragma unroll
        for (int ai = 0; ai < 2; ++ai)
#pragma unroll
            for (int m = 0; m < 4; ++m) sq[ai][m] = *(const f32x4*)(ssqa + (size_t)(row0 + ai * HALF + m * 16) * NH + 4 * (fq < 3 ? fq : 2));
#pragma unroll
        for (int ai = 0; ai < 2; ++ai)
#pragma unroll
            for (int m = 0; m < 4; ++m) { const f32x4 st = sq[ai][m]; float t = (st[0] + st[1]) + (st[2] + st[3]); t = fq < 3 ? t : 0.f; t = lsum16(t); t = lsum32(t);
                const float r = frsq(t * (1.0f / AW) + NORM_EPS);
#pragma unroll
                for (int bj = 0; bj < 2; ++bj)
#pragma unroll
                    for (int n = 0; n < 2; ++n) acc[ai][bj][m][n] = acc[ai][bj][m][n] * r; }
    }
    __device__ __forceinline__ void operator()(Acc& acc, const Unit& u, int wr, int wc, int fr, int fq, LAS unsigned char*, int, int) const {
        const int row0 = u.pm * BM + wr * 64 + fr, col0 = u.pn * BM + wc * 32 + fq * 8;
        const bf16_t* src = MID ? xsrc : (const bf16_t*)XB; u32x4 xh[8][2];
#pragma unroll
        for (int st = 0; st < 8; ++st) { const size_t o_ = (size_t)(row0 + (st >> 2) * HALF + (st & 3) * 16) * D + col0;
#pragma unroll
            for (int bj = 0; bj < 2; ++bj) xh[st][bj] = *(const u32x4*)(src + o_ + bj * HALF); }
#pragma unroll
        for (int st = 0; st < 8; ++st) { const int ai = st >> 2, m = st & 3; const int row = row0 + ai * HALF + m * 16; float ss = 0.f;
#pragma unroll
            for (int bj = 0; bj < 2; ++bj) { const size_t o = (size_t)row * D + col0 + bj * HALF; const u32x4 xb = xh[st][bj];
                const f32x4 v0 = (f32x4){bflo(xb.x), bfhi(xb.x), bflo(xb.y), bfhi(xb.y)} + acc[ai][bj][m][0], v1 = (f32x4){bflo(xb.z), bfhi(xb.z), bflo(xb.w), bfhi(xb.w)} + acc[ai][bj][m][1];
                *(u32x4*)(XB + o) = pack8(v0, v1);
                ss += ((v0[0] * v0[0] + v0[1] * v0[1]) + (v0[2] * v0[2] + v0[3] * v0[3])) + ((v1[0] * v1[0] + v1[1] * v1[1]) + (v1[2] * v1[2] + v1[3] * v1[3])); }
            ss = lsum16(ss); ss = lsum32(ss);
            if (fq == 0) ssqp[(size_t)row * 16 + u.pn * 4 + wc] = ss; }
    }
};
struct EpiSoftmax {
    static constexpr bool PERM = true; EPI_NOMID
    bf16_t* PM; const float* ssq16;
    __device__ __forceinline__ void operator()(Acc& acc, const Unit& u, int wr, int wc, int fr, int fq, LAS unsigned char* lds, int, int) const {
        LAS float* MX = (LAS float*)(lds + XCH_OFF); LAS float* SM = (LAS float*)(lds + XCH_OFF + 4096);
        f32x4 sq[2][4];
#pragma unroll
        for (int ai = 0; ai < 2; ++ai)
#pragma unroll
            for (int m = 0; m < 4; ++m) sq[ai][m] = *(const f32x4*)(ssq16 + (size_t)(u.pm * BM + ai * HALF + wr * 64 + m * 16 + fr) * 16 + 4 * fq);
#pragma unroll
        for (int ai = 0; ai < 2; ++ai)
#pragma unroll
            for (int m = 0; m < 4; ++m) { const int rl = ai * HALF + wr * 64 + m * 16 + fr; float mx = -3.0e38f;
                const f32x4 st = sq[ai][m]; float t = (st[0] + st[1]) + (st[2] + st[3]); t = lsum16(t); t = lsum32(t);
                const float rs = frsq(t * (1.0f / D) + NORM_EPS);
#pragma unroll
                for (int bj = 0; bj < 2; ++bj)
#pragma unroll
                    for (int n = 0; n < 2; ++n) { const f32x4 v = acc[ai][bj][m][n] * rs; acc[ai][bj][m][n] = v; mx = fmaxf(mx, fmaxf(fmaxf(v[0], v[1]), fmaxf(v[2], v[3]))); }
                mx = fmaxf(mx, __shfl_xor(mx, 16)); mx = fmaxf(mx, __shfl_xor(mx, 32));
                if (fq == 0) MX[rl * 4 + wc] = mx; }
        RAW_BARRIER();
#pragma unroll
        for (int ai = 0; ai < 2; ++ai)
#pragma unroll
            for (int m = 0; m < 4; ++m) { const int rl = ai * HALF + wr * 64 + m * 16 + fr; const f32x4 mm = *(const LAS f32x4*)(MX + rl * 4);
                const float mx = fmaxf(fmaxf(mm[0], mm[1]), fmaxf(mm[2], mm[3])); float ss = 0.f;
#pragma unroll
                for (int bj = 0; bj < 2; ++bj)
#pragma unroll
                    for (int n = 0; n < 2; ++n) { f32x4 v = acc[ai][bj][m][n];
#pragma unroll
                        for (int i = 0; i < 4; ++i) { v[i] = __builtin_amdgcn_exp2f(v[i] - mx); ss += v[i]; }
                        acc[ai][bj][m][n] = v; }
                ss += __shfl_xor(ss, 16); ss += __shfl_xor(ss, 32);
                if (fq == 0) SM[rl * 4 + wc] = ss; }
        RAW_BARRIER();
        const int col0 = u.pn * BM + wc * 32 + fq * 8;
#pragma unroll
        for (int ai = 0; ai < 2; ++ai)
#pragma unroll
            for (int m = 0; m < 4; ++m) { const int rl = ai * HALF + wr * 64 + m * 16 + fr; const f32x4 s4 = *(const LAS f32x4*)(SM + rl * 4);
                const float inv = frcp((s4[0] + s4[1]) + (s4[2] + s4[3]));
#pragma unroll
                for (int bj = 0; bj < 2; ++bj) *(u32x4*)(PM + (size_t)(u.pm * BM + rl) * D + col0 + bj * HALF) = pack8(acc[ai][bj][m][0] * inv, acc[ai][bj][m][1] * inv); }
    }
};
struct EpiMoe1 {
    static constexpr bool PERM = true; EPI_NOMID
    bf16_t* HID; const float* slot_rs;
    __device__ __forceinline__ void operator()(Acc& acc, const Unit& u, int wr, int wc, int fr, int fq, LAS unsigned char*, int, int) const {
        const int row0 = u.pm * BM + wr * 64 + fr; float rsv[2][4];
#pragma unroll
        for (int ai = 0; ai < 2; ++ai)
#pragma unroll
            for (int m = 0; m < 4; ++m) rsv[ai][m] = slot_rs[row0 + ai * HALF + m * 16];
#pragma unroll
        for (int ai = 0; ai < 2; ++ai)
#pragma unroll
            for (int m = 0; m < 4; ++m) { const int row = row0 + ai * HALF + m * 16; const float rs = rsv[ai][m]; f32x4 o[2];
#pragma unroll
                for (int n = 0; n < 2; ++n)
#pragma unroll
                    for (int i = 0; i < 4; ++i) { const float a = acc[ai][0][m][n][i] * rs, b = acc[ai][1][m][n][i] * rs; o[n][i] = a * b * frcp(1.f + __expf(-a)); }
                *(u32x4*)(HID + (size_t)row * FF + u.pn * HALF + wc * 32 + fq * 8) = pack8(o[0], o[1]); }
    }
};
struct EpiMoe2 {
    static constexpr bool PERM = true; EPI_NOMID
    bf16_t* Y; const float* slot_gate;
    __device__ __forceinline__ void operator()(Acc& acc, const Unit& u, int wr, int wc, int fr, int fq, LAS unsigned char*, int, int) const {
        const int row0 = u.pm * BM + wr * 64 + fr, col0 = u.pn * BM + wc * 32 + fq * 8; float gv[2][4];
#pragma unroll
        for (int ai = 0; ai < 2; ++ai)
#pragma unroll
            for (int m = 0; m < 4; ++m) gv[ai][m] = slot_gate[row0 + ai * HALF + m * 16];
#pragma unroll
        for (int ai = 0; ai < 2; ++ai)
#pragma unroll
            for (int m = 0; m < 4; ++m) { const int row = row0 + ai * HALF + m * 16; const float g = gv[ai][m];
#pragma unroll
                for (int bj = 0; bj < 2; ++bj) *(u32x4*)(Y + (size_t)row * D + col0 + bj * HALF) = pack8(acc[ai][bj][m][0] * g, acc[ai][bj][m][1] * g); }
    }
};
}
struct Frame {
    LAS unsigned char* lds;
    volatile LAS unsigned* MISC;
    unsigned* ctl;
    unsigned char* ws;
    int wave, vcu, G;
};
struct Args { const void* in[27]; float* out; unsigned char* ws; int ph_lo, ph_hi, li, pad; };

__device__ __forceinline__ void tr_item(const float* W, int ldw, int srcrow0, int srccol0, bf16_t* WT, int dpitch, size_t drow0, int dk0, const float* gk, float sc, LAS float* scr, int lane) {
    f32x4 v[8]; const int n4 = lane & 7, kq = lane >> 3;
#pragma unroll
    for (int i = 0; i < 8; ++i) v[i] = *(const f32x4*)(W + (size_t)(srcrow0 + kq + 8 * i) * ldw + srccol0 + 4 * n4);
#pragma unroll
    for (int i = 0; i < 8; ++i) { const int kk = kq + 8 * i; const float g = gk ? gk[kk] * sc : sc; LAS float* d = scr + kk * 33 + 4 * n4;
        d[0] = v[i][0] * g; d[1] = v[i][1] * g; d[2] = v[i][2] * g; d[3] = v[i][3] * g; }
    LDS_WAIT(); asm volatile("" ::: "memory");
    const int c = lane & 7;
#pragma unroll
    for (int j = 0; j < 4; ++j) { const int n = (lane >> 3) + 8 * j; const LAS float* s = scr + (8 * c) * 33 + n;
        u32x4 o; o.x = pk2(s[0 * 33], s[1 * 33]); o.y = pk2(s[2 * 33], s[3 * 33]); o.z = pk2(s[4 * 33], s[5 * 33]); o.w = pk2(s[6 * 33], s[7 * 33]);
        *(u32x4*)(WT + (drow0 + n) * dpitch + dk0 + 8 * c) = o; }
    LDS_WAIT(); asm volatile("" ::: "memory");
}
__device__ __forceinline__ void rms_row_to_bf16(const float* xrow, const float* g, bf16_t* orow, int lane) {
    const f32x4* xr = (const f32x4*)xrow + lane; const f32x4* gr = (const f32x4*)g + lane;
    f32x4 v[4]; float s = 0.f;
#pragma unroll
    for (int j = 0; j < 4; ++j) { v[j] = xr[64 * j]; s += (v[j][0] * v[j][0] + v[j][1] * v[j][1]) + (v[j][2] * v[j][2] + v[j][3] * v[j][3]); }
    const float rs = frsq(wave_sum(s) * (1.f / D) + NORM_EPS);
    u32x2* o8 = (u32x2*)orow + lane;
#pragma unroll
    for (int j = 0; j < 4; ++j) { const f32x4 gg = gr[64 * j]; u32x2 w; w.x = pk2(v[j][0] * rs * gg[0], v[j][1] * rs * gg[1]); w.y = pk2(v[j][2] * rs * gg[2], v[j][3] * rs * gg[3]); o8[64 * j] = w; }
}
__device__ __forceinline__ void x_row2_to_bf16(const float* xrow, bf16_t* orow, float* rs, int lane) {
    f32x4 v[2][2][2]; float ss[2] = {0.f, 0.f};
#pragma unroll
    for (int r = 0; r < 2; ++r)
#pragma unroll
        for (int c = 0; c < 2; ++c) { const float* p = xrow + (size_t)r * D + c * 512 + 8 * lane; v[r][c][0] = *(const f32x4*)p; v[r][c][1] = *(const f32x4*)(p + 4); }
#pragma unroll
    for (int r = 0; r < 2; ++r)
#pragma unroll
        for (int c = 0; c < 2; ++c) { const f32x4 a = v[r][c][0], b = v[r][c][1]; u32x4 w;
            ss[r] += ((a[0] * a[0] + a[1] * a[1]) + (a[2] * a[2] + a[3] * a[3])) + ((b[0] * b[0] + b[1] * b[1]) + (b[2] * b[2] + b[3] * b[3]));
            w.x = pk2(a[0], a[1]); w.y = pk2(a[2], a[3]); w.z = pk2(b[0], b[1]); w.w = pk2(b[2], b[3]);
            *(u32x4*)(orow + (size_t)r * D + c * 512 + 8 * lane) = w; }
    const float r0 = frsq(wave_sum(ss[0]) * (1.f / D) + NORM_EPS), r1 = frsq(wave_sum(ss[1]) * (1.f / D) + NORM_EPS);
    if (lane == 0) *(f32x2*)rs = (f32x2){r0, r1};
}
__device__ __forceinline__ void rms_row2_to_bf16(const float* xrow, const float* g, bf16_t* orow, int lane) {
    f32x4 v[2][2][2]; float ss[2] = {0.f, 0.f};
#pragma unroll
    for (int r = 0; r < 2; ++r)
#pragma unroll
        for (int c = 0; c < 2; ++c) { const float* p = xrow + (size_t)r * D + c * 512 + 8 * lane; v[r][c][0] = *(const f32x4*)p; v[r][c][1] = *(const f32x4*)(p + 4); }
#pragma unroll
    for (int r = 0; r < 2; ++r)
#pragma unroll
        for (int c = 0; c < 2; ++c)
#pragma unroll
            for (int k = 0; k < 2; ++k) { const f32x4 x = v[r][c][k]; ss[r] += (x[0] * x[0] + x[1] * x[1]) + (x[2] * x[2] + x[3] * x[3]); }
    const float r0 = frsq(wave_sum(ss[0]) * (1.f / D) + NORM_EPS), r1 = frsq(wave_sum(ss[1]) * (1.f / D) + NORM_EPS);
#pragma unroll
    for (int c = 0; c < 2; ++c) { const f32x4 g0 = *(const f32x4*)(g + c * 512 + 8 * lane), g1 = *(const f32x4*)(g + c * 512 + 8 * lane + 4);
#pragma unroll
        for (int r = 0; r < 2; ++r) { const float rs = r ? r1 : r0; const f32x4 a = v[r][c][0] * rs * g0, b = v[r][c][1] * rs * g1; u32x4 w;
            w.x = pk2(a[0], a[1]); w.y = pk2(a[2], a[3]); w.z = pk2(b[0], b[1]); w.w = pk2(b[2], b[3]);
            *(u32x4*)(orow + (size_t)r * D + c * 512 + 8 * lane) = w; } }
}
__device__ __forceinline__ double rope_inv(int d) {
    const int q = d >> 3, r = d & 7;
    double b = 1.0;
    b = (r == 1) ? 0.7498942093324558273 : b; b = (r == 2) ? 0.56234132519034908039 : b; b = (r == 3) ? 0.42169650342858224857 : b; b = (r == 4) ? 0.3162277660168379332 : b;
    b = (r == 5) ? 0.23713737056616552617 : b; b = (r == 6) ? 0.17782794100389228012 : b; b = (r == 7) ? 0.13335214321633240257 : b;
    const double p = (q == 0) ? 1.0 : (q == 1) ? 0.1 : (q == 2) ? 0.01 : 0.001;
    return b * p;
}
__device__ __forceinline__ void sincos_d(double a, double& sn, double& cs) {
    const double k = __builtin_rint(a * 0.63661977236758134308);
    double y = __builtin_fma(-k, 1.57079632679489655800e+00, a); y = __builtin_fma(-k, 6.12323399573676603587e-17, y);
    const double y2 = y * y;
    double s = 1.0 / 6227020800.0; s = s * y2 - 1.0 / 39916800.0; s = s * y2 + 1.0 / 362880.0; s = s * y2 - 1.0 / 5040.0; s = s * y2 + 1.0 / 120.0; s = s * y2 - 1.0 / 6.0; s = s * y2 * y + y;
    double c = 1.0 / 479001600.0; c = c * y2 - 1.0 / 3628800.0; c = c * y2 + 1.0 / 40320.0; c = c * y2 - 1.0 / 720.0; c = c * y2 + 1.0 / 24.0; c = c * y2 - 0.5; c = c * y2 + 1.0;
    const int qd = ((int)k) & 3;
    sn = (qd == 0) ? s : (qd == 1) ? c : (qd == 2) ? -s : -c;
    cs = (qd == 0) ? c : (qd == 1) ? -s : (qd == 2) ? -c : s;
}
typedef const void* gen_cptr;
typedef __attribute__((address_space(4))) const char* cas_cptr;
typedef __attribute__((address_space(4))) const gen_cptr* cas_pptr;
__device__ __forceinline__ const void* karg_ptr(int byte_off) { cas_cptr p = (cas_cptr)__builtin_amdgcn_kernarg_segment_ptr(); asm volatile("" : "+s"(p)); return *(cas_pptr)(p + byte_off); }
__device__ __forceinline__ void p0_prologue(Frame& F) {
    const int lane = lane_id(), tid = F.wave * 64 + lane;
    const float* x = (const float*)karg_ptr(8 * 0); const float* mem = (const float*)karg_ptr(8 * 1); const int* positions = (const int*)karg_ptr(8 * 2);
    const float* mix_g = (const float*)karg_ptr(8 * 3); const float* w_in = (const float*)karg_ptr(8 * 4);
    const float* attn_out_g = (const float*)karg_ptr(8 * 10); const float* w_out = (const float*)karg_ptr(8 * 11);
    const float* xattn_g = (const float*)karg_ptr(8 * 12); const float* mem_g = (const float*)karg_ptr(8 * 13);
    const float* w_xq = (const float*)karg_ptr(8 * 14); const float* w_xk = (const float*)karg_ptr(8 * 15); const float* w_xv = (const float*)karg_ptr(8 * 16); const float* w_xo = (const float*)karg_ptr(8 * 17);
    const float* moe_g = (const float*)karg_ptr(8 * 18); const float* w_group = (const float*)karg_ptr(8 * 19); const float* w_router = (const float*)karg_ptr(8 * 21);
    const float* w1 = (const float*)karg_ptr(8 * 23); const float* w3 = (const float*)karg_ptr(8 * 24); const float* w2 = (const float*)karg_ptr(8 * 25);
    unsigned char* ws = F.ws;
    LAS float* scr = (LAS float*)(F.lds + F.wave * 16384);
    const int gw = F.vcu * NWAVES + F.wave, NGW = F.G * NWAVES;
    constexpr int I_IN = 16 * 88, I_SQ = 16 * 32, I_13 = NE * 16 * 32, I_2 = NE * 8 * 32;
    constexpr int NITEMS = I_IN + 5 * I_SQ + I_13 + I_2;
    for (int it = gw; it < NITEMS; it += NGW) {
        int r = it;
        if (r < I_IN) { const int kb = r / 88, nb = r % 88, n0 = 32 * nb, tile = n0 >> 8, j = n0 & 255; int src;
            if (tile < 2) src = (j < 128) ? 128 * tile + j : 256 + 128 * tile + (j - 128);
            else if (tile < 8) { const int sec = (tile - 2) / 3, tt = (tile - 2) % 3, jj = j & 127, hh = jj >> 5; src = 512 + 768 * sec + 256 * tt + 64 * hh + ((j < 128) ? 0 : 32); }
            else src = n0;
            tr_item(w_in, INW, 64 * kb, src, (bf16_t*)(ws + WS_WIN), D, (size_t)n0, 64 * kb, mix_g + 64 * kb, 1.f, scr, lane); continue; }
        r -= I_IN;
        if (r < I_SQ) { const int kb = r / 32, nb = r % 32, dk0 = 64 * kb; const bool at = dk0 < AW;
            tr_item(w_out, D, at ? CCH + dk0 : dk0 - AW, 32 * nb, (bf16_t*)(ws + WS_WOUT), D, (size_t)(32 * nb), dk0, at ? attn_out_g + dk0 : nullptr, 1.f, scr, lane); continue; }
        r -= I_SQ;
        if (r < 4 * I_SQ) { const int which = r / I_SQ, r2 = r % I_SQ, kb = r2 / 32, nb = r2 % 32;
            if (which == 0) {
                bf16_t* WQ2 = (bf16_t*)(ws + WS_WXQ); const int n4 = lane & 7, kq = lane >> 3;
#pragma unroll
                for (int i = 0; i < 8; ++i) { const int k = 64 * kb + kq + 8 * i; const f32x4 v = *(const f32x4*)(w_xq + (size_t)k * D + 32 * nb + 4 * n4); const float g = xattn_g[k] * (LOG2E / 16.f);
                    u32x2 o; o.x = pk2(v[0] * g, v[1] * g); o.y = pk2(v[2] * g, v[3] * g); *(u32x2*)(WQ2 + (size_t)k * D + 32 * nb + 4 * n4) = o; }
                continue; }
            const float* W = which == 1 ? w_xk : which == 2 ? w_xv : w_xo;
            bf16_t* WT = (bf16_t*)(ws + (which == 1 ? WS_WXK : which == 2 ? WS_WXV : WS_WXO));
            tr_item(W, D, 64 * kb, 32 * nb, WT, D, (size_t)(32 * nb), 64 * kb, nullptr, 1.f, scr, lane); continue; }
        r -= 4 * I_SQ;
        if (r < I_13) { const int e = r / 512, r2 = r % 512, kb = r2 / 32, nb = r2 % 32, n0 = 32 * nb, tt = n0 >> 8, j = n0 & 255;
            const float* W = ((j < 128) ? w1 : w3) + (size_t)e * D * FF;
            tr_item(W, FF, 64 * kb, 128 * tt + (j & 127), (bf16_t*)(ws + WS_W13), D, (size_t)e * 1024 + n0, 64 * kb, moe_g + 64 * kb, 1.f, scr, lane); continue; }
        r -= I_13;
        { const int e = r / 256, r2 = r % 256, kb = r2 / 32, nb = r2 % 32;
            tr_item(w2 + (size_t)e * FF * D, D, 64 * kb, 32 * nb, (bf16_t*)(ws + WS_W2), FF, (size_t)e * 1024 + 32 * nb, 64 * kb, nullptr, 1.f, scr, lane); }
    }
    { bf16_t* WRF = (bf16_t*)(ws + WS_HIST + HIST_WR);
      for (int i = blockIdx.x * 512 + tid; i < 4 * 8 * 3 * 2 * 64 * 8; i += F.G * 512) {
          const int j = i & 7, ln = (i >> 3) & 63, part = (i >> 9) & 1, blk = i >> 10, nt = blk % 3, s = (blk / 3) & 7, kc = blk / 24;
          const int k = 256 * kc + 32 * s + 8 * (ln >> 4) + j, o = 16 * nt + (ln & 15);
          float v = 0.f; if (o < 32) v = w_router[k * 32 + o] * moe_g[k]; else if (o < 36) v = w_group[k * 4 + (o - 32)] * moe_g[k];
          const unsigned hb = f2bf(v); const float hf = __builtin_bit_cast(float, hb << 16);
          WRF[i] = (bf16_t)(part ? f2bf(v - hf) : hb); } }
    { float* rc = (float*)(ws + WS_ROPE); float* rsn = rc + SEQ * 32;
      for (int i = blockIdx.x * 512 + tid; i < SEQ * 32; i += F.G * 512) { const int s = i >> 5, d = i & 31;
          const float inv = (float)rope_inv(d); const float ang = (float)positions[s] * inv; double sn, cs; sincos_d((double)fabsf(ang), sn, cs); if (ang < 0.f) sn = -sn;
          rc[i] = (float)cs; rsn[i] = (float)sn; } }
    for (int m = gw; m < MROWS; m += NGW) rms_row_to_bf16(mem + (size_t)m * D, mem_g, (bf16_t*)(ws + WS_MEMN) + (size_t)m * D, lane);
    for (int m = 2 * gw; m < T; m += 2 * NGW) x_row2_to_bf16(x + (size_t)m * D, (bf16_t*)(ws + WS_XB0) + (size_t)m * D, (float*)(ws + WS_SSQ2) + m, lane);
}
#ifndef D16_REP
#define D16_REP 1
#endif
namespace att {
typedef short v4i16_t __attribute__((ext_vector_type(4)));
constexpr float NEG = -1.0e30f, MFLOOR = -1.0e9f;

struct Grp { bf16x8 q0, q1; f32x4 o[4]; float m, l; };

__device__ __forceinline__ void swap16(float v, float& a, float& b) { a = v; b = v; asm volatile("s_nop 1\n\tv_permlane16_swap_b32 %0, %1" : "+v"(a), "+v"(b)); }
__device__ __forceinline__ void swap32(float v, float& a, float& b) { a = v; b = v; asm volatile("s_nop 1\n\tv_permlane32_swap_b32 %0, %1" : "+v"(a), "+v"(b)); }
__device__ __forceinline__ float xmax16(float v) { float a, b; swap16(v, a, b); return fmaxf(a, b); }
__device__ __forceinline__ float xmax32(float v) { float a, b; swap32(v, a, b); return fmaxf(a, b); }
__device__ __forceinline__ float xsum16(float v) { float a, b; swap16(v, a, b); return a + b; }
__device__ __forceinline__ float xsum32(float v) { float a, b; swap32(v, a, b); return a + b; }
__device__ __forceinline__ const LAS unsigned char* row_base(const LAS unsigned char* buf, int Rb) {
    return (const LAS unsigned char*)(uintptr_t)(unsigned)__builtin_amdgcn_readfirstlane((int)((unsigned)(uintptr_t)buf + (unsigned)(Rb * 128))); }
__device__ __forceinline__ float fmax3_nc(float a, float b, float c) { float r; asm("v_max3_f32 %0, %1, %2, %3" : "=v"(r) : "v"(a), "v"(b), "v"(c)); return r; }
__device__ __forceinline__ float fmax_nc(float a, float b) { float r; asm("v_max_f32_e32 %0, %1, %2" : "=v"(r) : "v"(a), "v"(b)); return r; }
__device__ __forceinline__ float fmax9_mfma(const f32x4& s0, const f32x4& s1, float m) { float r, t0, t1;
    asm("s_nop 11\n\tv_max3_f32 %1, %3, %4, %5\n\tv_max3_f32 %2, %6, %7, %8\n\tv_max3_f32 %0, %9, %10, %11\n\tv_max3_f32 %0, %0, %1, %2"
        : "=&v"(r), "=&v"(t0), "=&v"(t1) : "v"(s0[0]), "v"(s0[1]), "v"(s0[2]), "v"(s0[3]), "v"(s1[0]), "v"(s1[1]), "v"(s1[2]), "v"(s1[3]), "v"(m));
    return r; }
__device__ __forceinline__ void qk_part(const Grp& G, const bf16x8 (&k)[2][2], f32x4 (&s)[2]) {
#pragma unroll
    for (int t = 0; t < 2; ++t) { f32x4 z = (f32x4){0.f, 0.f, 0.f, 0.f};
        z = __builtin_amdgcn_mfma_f32_16x16x32_bf16(k[t][0], G.q0, z, 0, 0, 0); s[t] = __builtin_amdgcn_mfma_f32_16x16x32_bf16(k[t][1], G.q1, z, 0, 0, 0); }
}
template <bool FULL, bool INR>
__device__ __forceinline__ void sm_part(Grp& G, f32x4 (&s)[2], int ksub0, int qsub, int L, int lane, bf16x8& pb, float& alpha) {
    const int g = lane >> 4;
    if constexpr (!FULL) { const int d0 = ksub0 + 4 * g - qsub + 64, k0 = ksub0 + 4 * g;
#pragma unroll
        for (int t = 0; t < 2; ++t)
#pragma unroll
            for (int i = 0; i < 4; ++i) { bool ok = ((unsigned)(d0 + 16 * t + i) <= 128u); if constexpr (!INR) ok = ok && ((unsigned)(k0 + 16 * t + i) < (unsigned)L); s[t][i] = ok ? s[t][i] : NEG; } }
    float mx; if constexpr (FULL) mx = fmax9_mfma(s[0], s[1], G.m); else mx = fmax3_nc(fmax3_nc(s[0][0], s[0][1], s[0][2]), fmax3_nc(s[0][3], s[1][0], s[1][1]), fmax3_nc(s[1][2], s[1][3], G.m));
    { float a, b; swap16(mx, a, b); mx = fmax_nc(a, b); swap32(mx, a, b); mx = fmax_nc(a, b); }
    const float mn = mx; alpha = __builtin_amdgcn_exp2f(G.m - mn);
    G.m = mn; float p[2][4]; float ps = 0.f;
#pragma unroll
    for (int t = 0; t < 2; ++t)
#pragma unroll
        for (int i = 0; i < 4; ++i) { const float e = __builtin_amdgcn_exp2f(s[t][i] - mn); p[t][i] = e; ps += e; }
    G.l = G.l * alpha + ps;
    u32x4 pw; pw.x = cvt_pk_bf16(p[0][0], p[0][1]); pw.y = cvt_pk_bf16(p[0][2], p[0][3]); pw.z = cvt_pk_bf16(p[1][0], p[1][1]); pw.w = cvt_pk_bf16(p[1][2], p[1][3]);
    pb = __builtin_bit_cast(bf16x8, pw);
}
__device__ __forceinline__ void pv_part(Grp& G, const bf16x8 (&v)[4], const bf16x8& pb, float alpha) {
#pragma unroll
    for (int db = 0; db < 4; ++db) G.o[db] = __builtin_amdgcn_mfma_f32_16x16x32_bf16(v[db], pb, G.o[db] * alpha, 0, 0, 0);
}
#define ATT_SYNC() do { asm volatile("s_waitcnt vmcnt(0) lgkmcnt(0)" ::: "memory"); __builtin_amdgcn_s_barrier(); asm volatile("" ::: "memory"); } while (0)
#define ATT_SB() __builtin_amdgcn_sched_barrier(0)
constexpr int NVB = 49152;
__device__ __forceinline__ int vn_off(int row, int c) { return row * 128 + ((c ^ (((row >> 1) & 3) << 1)) << 4); }
template <int DIL>
__device__ __forceinline__ void nat_stage_v(unsigned ldsbuf, const char* Vg, int hrow0, int cres, int sub0, int wave, int lane) {
    constexpr int Ls = SEQ / DIL; const char* gb = pg8::uniform_ptr(Vg);
#pragma unroll
    for (int i = 0; i < 6; ++i) { const int blk = wave * 6 + i, row = 8 * blk + (lane >> 3), phys = lane & 7;
        const int c = phys ^ (((row >> 1) & 3) << 1);
        int sub = sub0 + row; sub = sub < 0 ? 0 : (sub > Ls - 1 ? Ls - 1 : sub);
        const unsigned voff = (unsigned)((hrow0 + cres + DIL * sub) * HD + c * 8) * 2u;
        pg8::glds16_sv(gb, voff, ldsbuf + (unsigned)blk * 1024u); __builtin_amdgcn_sched_barrier(0); }
}
template <int DIL>
__device__ __forceinline__ void nat_load_k1(bf16x8 (&k)[2][2], const bf16_t* Kb, int hrow0, int cres, int ksub, int lane) {
    constexpr int Ls = SEQ / DIL; const int key = lane & 15, g = lane >> 4;
#pragma unroll
    for (int t = 0; t < 2; ++t) { int sub = ksub + 16 * t + key; sub = sub < 0 ? 0 : (sub > Ls - 1 ? Ls - 1 : sub);
        const bf16_t* kp = Kb + (size_t)(hrow0 + cres + DIL * sub) * HD + 8 * g;
        k[t][0] = *(const bf16x8*)kp; k[t][1] = *(const bf16x8*)(kp + 32); }
}
template <bool FULL>
__device__ __forceinline__ void pair2n_post(Grp& GA, Grp& GB, f32x4 (&s0)[2], f32x4 (&s1)[2], const LAS unsigned char* vbuf, int Rb, const int (&vb)[4], int ks0, int qs, int Ls, int lane) {
    bf16x8 p0, p1; float a0, a1;
    bf16x8 v[4]; { const LAS unsigned char* rb = row_base(vbuf, Rb);
#pragma unroll
        for (int db = 0; db < 4; ++db) {
            const s16x4 v0 = __builtin_bit_cast(s16x4, __builtin_amdgcn_ds_read_tr16_b64_v4i16((LAS v4i16_t*)(rb + vb[db])));
            const s16x4 v1 = __builtin_bit_cast(s16x4, __builtin_amdgcn_ds_read_tr16_b64_v4i16((LAS v4i16_t*)(rb + 2048 + vb[db])));
            v[db] = (bf16x8){v0[0], v0[1], v0[2], v0[3], v1[0], v1[1], v1[2], v1[3]}; } }
    sm_part<FULL, true>(GA, s0, ks0, qs, Ls, lane, p0, a0); sm_part<FULL, true>(GB, s1, ks0, qs + 16, Ls, lane, p1, a1); ATT_SB();
    pv_part(GA, v, p0, a0); pv_part(GB, v, p1, a1); ATT_SB();
}
template <int DIL>
__device__ __forceinline__ void nat_load_k(bf16x8 (&k)[5][2][2], const bf16_t* Kb, int hrow0, int cres, int ksub_first, int lane) {
    constexpr int Ls = SEQ / DIL; const int key = lane & 15, g = lane >> 4;
#pragma unroll
    for (int p = 0; p < 5; ++p)
#pragma unroll
        for (int t = 0; t < 2; ++t) { int sub = ksub_first + 32 * p + 16 * t + key; sub = sub < 0 ? 0 : (sub > Ls - 1 ? Ls - 1 : sub);
            const bf16_t* kp = Kb + (size_t)(hrow0 + cres + DIL * sub) * HD + 8 * g;
            k[p][t][0] = *(const bf16x8*)kp; k[p][t][1] = *(const bf16x8*)(kp + 32); }
}
template <int DIL, bool FIRST>
__device__ __forceinline__ void nat_init_state(Grp& G, const bf16_t* MIX, const float* ml, size_t tok0, int h, int lane) {
    const int a = lane & 15, g = lane >> 4;
    if constexpr (FIRST) {
#pragma unroll
        for (int d = 0; d < 4; ++d) G.o[d] = (f32x4){0.f, 0.f, 0.f, 0.f};
        G.m = MFLOOR; G.l = 0.f;
    } else { const size_t tok = tok0 + DIL * a; const f32x2 st = *(const f32x2*)(ml + (tok * NH + h) * 2);
        G.m = st[0]; G.l = st[1] * 0.25f;
#pragma unroll
        for (int d2 = 0; d2 < 2; ++d2) { const u32x4 w = *(const u32x4*)(MIX + tok * D + h * HD + 16 * g + 8 * d2);
            G.o[2 * d2] = (f32x4){bflo(w.x), bfhi(w.x), bflo(w.y), bfhi(w.y)} * st[1]; G.o[2 * d2 + 1] = (f32x4){bflo(w.z), bfhi(w.z), bflo(w.w), bfhi(w.w)} * st[1]; } }
}
template <int DIL, bool LAST>
__device__ __forceinline__ void nat_finish(Grp& G, bf16_t* MIX, float* ml, float* ssqa, size_t tok0, int h, int lane) {
    const int a = lane & 15, g = lane >> 4; float l = G.l; l = xsum16(l); l = xsum32(l);
    const float inv = frcp(l); const size_t tok = tok0 + DIL * a; float ss = 0.f;
    if constexpr (LAST) {
#pragma unroll
        for (int d2 = 0; d2 < 2; ++d2) { u32x2 w[2];
#pragma unroll
            for (int k = 0; k < 2; ++k) { const f32x4 o = G.o[2 * d2 + k] * inv; ss += (o[0] * o[0] + o[1] * o[1]) + (o[2] * o[2] + o[3] * o[3]); w[k].x = cvt_pk_bf16(o[0], o[1]); w[k].y = cvt_pk_bf16(o[2], o[3]); }
            asm volatile("s_nop 1\n\tv_permlane16_swap_b32 %0, %2\n\tv_permlane16_swap_b32 %1, %3" : "+v"(w[0].x), "+v"(w[0].y), "+v"(w[1].x), "+v"(w[1].y));
            *(u32x4*)(MIX + tok * D + h * HD + 16 * (2 * d2 + (g & 1)) + 4 * (g & 2)) = (u32x4){w[0].x, w[0].y, w[1].x, w[1].y}; }
        ss = xsum16(ss); ss = xsum32(ss); if (g == 0) ssqa[tok * NH + h] = ss;
    } else {
#pragma unroll
        for (int d2 = 0; d2 < 2; ++d2) { const f32x4 o0 = G.o[2 * d2] * inv, o1 = G.o[2 * d2 + 1] * inv; u32x4 w;
            w.x = cvt_pk_bf16(o0[0], o0[1]); w.y = cvt_pk_bf16(o0[2], o0[3]); w.z = cvt_pk_bf16(o1[0], o1[1]); w.w = cvt_pk_bf16(o1[2], o1[3]);
            *(u32x4*)(MIX + tok * D + h * HD + 16 * g + 8 * d2) = w; }
        if (g == 0) *(f32x2*)(ml + (tok * NH + h) * 2) = (f32x2){G.m, l};
    }
}
template <int DIL, bool FIRST, bool LAST>
__device__ __forceinline__ void nat_pass(LAS unsigned char* lds, const bf16_t* Qb, const bf16_t* Kb, const bf16_t* Vb, bf16_t* MIX, float* ml, float* ssqa, int vcu, int G_, int dup, int wave, int lane_) {
    constexpr int Ls = SEQ / DIL, NCH = Ls / 256, NT = NB * NH * 16;
    const unsigned lds0 = (unsigned)(uintptr_t)lds;
    bf16x8 kf[5][2][2], qn[4];
    ATT_SYNC();
    if (vcu < NT * dup) { int ln = lane_; asm volatile("" : "+v"(ln)); const int L = vcu % NT, sub = L & 15, bh = L >> 4, cres = sub / NCH, l0 = 256 * (sub % NCH);
        nat_load_k<DIL>(kf, Kb, bh * SEQ, cres, l0 + 32 * wave - 64, ln);
        { const int a = ln & 15, g = ln >> 4; const bf16_t* qp = Qb + ((size_t)(bh * SEQ + cres + DIL * (l0 + 32 * wave)) + DIL * a) * HD + 8 * g;
          qn[0] = *(const bf16x8*)qp; qn[1] = *(const bf16x8*)(qp + 32); qn[2] = *(const bf16x8*)(qp + 16 * DIL * HD); qn[3] = *(const bf16x8*)(qp + 16 * DIL * HD + 32); }
        nat_stage_v<DIL>(lds0, (const char*)Vb, bh * SEQ, cres, l0 - 64, wave, ln); }
    asm volatile("s_waitcnt vmcnt(0)" ::: "memory");
    int it = 0;
#pragma nounroll
    for (int L0 = vcu; L0 < NT * dup; L0 += G_, ++it) {
        const int L = L0 % NT, sub = L & 15, bh = L >> 4, b = bh / NH, h = bh % NH, cres = sub / NCH, l0 = 256 * (sub % NCH);
        asm volatile("s_waitcnt vmcnt(16) lgkmcnt(0)" ::: "memory"); __builtin_amdgcn_s_barrier(); asm volatile("" ::: "memory");
        int ln = lane_; asm volatile("" : "+v"(ln));
        const bool has_next = L0 + G_ < NT * dup; const int Ln = (L0 + G_) % NT, subn = Ln & 15, bhn = Ln >> 4, cresn = subn / NCH, l0n = 256 * (subn % NCH);
        const LAS unsigned char* vbuf = lds + (it & 1) * NVB;
        const int a = ln & 15, g = ln >> 4, q = (ln >> 2) & 3, p2 = ln & 3;
        int vb[4];
#pragma unroll
        for (int db = 0; db < 4; ++db) vb[db] = vn_off(4 * g + q, 2 * db + (p2 >> 1)) + 8 * (p2 & 1);
        Grp GA, GB; const int pos0 = cres + DIL * (l0 + 32 * wave);
        const size_t tokA = (size_t)(b * SEQ + pos0);
        GA.q0 = qn[0]; GA.q1 = qn[1]; GB.q0 = qn[2]; GB.q1 = qn[3];
        nat_init_state<DIL, FIRST>(GA, MIX, ml, tokA, h, ln); nat_init_state<DIL, FIRST>(GB, MIX, ml, tokA + 16 * DIL, h, ln);
        if constexpr (!FIRST) asm volatile("s_waitcnt vmcnt(0)" ::: "memory");
        if (has_next) { nat_stage_v<DIL>(lds0 + (unsigned)(((it + 1) & 1) * NVB), (const char*)Vb, bhn * SEQ, cresn, l0n - 64, wave, ln);
            const bf16_t* qp = Qb + ((size_t)(bhn * SEQ + cresn + DIL * (l0n + 32 * wave)) + DIL * a) * HD + 8 * g;
            qn[0] = *(const bf16x8*)qp; qn[1] = *(const bf16x8*)(qp + 32); qn[2] = *(const bf16x8*)(qp + 16 * DIL * HD); qn[3] = *(const bf16x8*)(qp + 16 * DIL * HD + 32); }
        const int qs = l0 + 32 * wave + a;
#pragma unroll
        for (int p = 0; p < 5; ++p) { const int ks0 = l0 + 32 * wave - 64 + 32 * p; const bool act = (ks0 >= 0 && ks0 < Ls);
            f32x4 s0[2], s1[2];
            if (act) { qk_part(GA, kf[p], s0); qk_part(GB, kf[p], s1); ATT_SB(); }
            if (has_next) nat_load_k1<DIL>(kf[p], Kb, bhn * SEQ, cresn, l0n + 32 * wave - 64 + 32 * p, ln);
            if (act) { const int ql = l0 + 32 * wave; const bool full = (ks0 + 31 - ql <= 64) && (ql + 31 - ks0 <= 64);
#pragma nounroll
                for (int rep_ = 0; rep_ < D16_REP; ++rep_) {
                    f32x4 t0[2] = {s0[0], s0[1]}, t1[2] = {s1[0], s1[1]};
                    if (full) pair2n_post<true>(GA, GB, t0, t1, vbuf, 32 * wave + 32 * p, vb, ks0, qs, Ls, ln); else pair2n_post<false>(GA, GB, t0, t1, vbuf, 32 * wave + 32 * p, vb, ks0, qs, Ls, ln); } } }
        nat_finish<DIL, LAST>(GA, MIX, ml, ssqa, tokA, h, ln); nat_finish<DIL, LAST>(GB, MIX, ml, ssqa, tokA + 16 * DIL, h, ln);
    }
}
__device__ __forceinline__ void conv_unit(LAS unsigned char* lds, const bf16_t* Cb, bf16_t* MIX, const float* dw_w, const float* dw_b, const float* ln_g, const float* ln_b, const float* out_g,
                                          int b, int s0, int tid_, int wave, int lane_) {
    int tid = tid_, lane = lane_; asm volatile("" : "+v"(tid), "+v"(lane));
    LAS bf16_t* CT = (LAS bf16_t*)lds;
    LAS float* CO = (LAS float*)(lds + 49152);
    ATT_SYNC();
    for (int p = tid; p < 94 * 32; p += NWAVES * 64) { const int row = p >> 5, c = p & 31, s = s0 - 15 + row;
        u32x4 v = (u32x4){0u, 0u, 0u, 0u};
        if (s >= 0 && s < SEQ) v = *(const u32x4*)(Cb + (size_t)(b * SEQ + s) * CCH + c * 8);
        *(LAS u32x4*)(CT + row * CCH + c * 8) = v; }
    ATT_SYNC();
    { const int ch = tid & 255, half = tid >> 8; float v[62], w[CONVK];
#pragma unroll
      for (int k = 0; k < CONVK; ++k) w[k] = dw_w[k * CCH + ch];
#pragma unroll
      for (int i = 0; i < 62; ++i) v[i] = bf2f(CT[(32 * half + i) * CCH + ch]);
      const float bias = dw_b[ch];
#pragma unroll
      for (int p = 0; p < 32; ++p) { float acc = bias;
#pragma unroll
          for (int k = 0; k < CONVK; ++k) acc += v[p + k] * w[k];
          CO[(32 * half + p) * CCH + ch] = acc; } }
    ATT_SYNC();
    { const f32x4 g4 = *((const f32x4*)ln_g + lane), b4 = *((const f32x4*)ln_b + lane), og = *((const f32x4*)out_g + lane);
#pragma unroll
      for (int pp = 0; pp < 8; ++pp) { const int p = wave * 8 + pp; const f32x4 xv = *(const LAS f32x4*)(CO + p * CCH + 4 * lane);
          const float mean = wave_sum((xv[0] + xv[1]) + (xv[2] + xv[3])) * (1.f / CCH); const f32x4 dx = xv - mean;
          const float var = wave_sum((dx[0] * dx[0] + dx[1] * dx[1]) + (dx[2] * dx[2] + dx[3] * dx[3])) * (1.f / CCH); const float rstd = frsq(var + LN_EPS);
          f32x4 z;
#pragma unroll
          for (int i = 0; i < 4; ++i) { const float y = dx[i] * rstd * g4[i] + b4[i]; z[i] = y * frcp(1.f + __expf(-y)); }
          const float ms = wave_sum((z[0] * z[0] + z[1] * z[1]) + (z[2] * z[2] + z[3] * z[3])) * (1.f / CCH); const float rs = frsq(ms + NORM_EPS);
          u32x2 o; o.x = cvt_pk_bf16(z[0] * rs * og[0], z[1] * rs * og[1]); o.y = cvt_pk_bf16(z[2] * rs * og[2], z[3] * rs * og[3]);
          *(u32x2*)(MIX + (size_t)(b * SEQ + s0 + p) * D + AW + 4 * lane) = o; } }
}
}
namespace moe {
#define MOE_SYNC() do { asm volatile("s_waitcnt vmcnt(0) lgkmcnt(0)" ::: "memory"); __builtin_amdgcn_s_barrier(); asm volatile("" ::: "memory"); } while (0)
__device__ __forceinline__ void split_hi_lo(const f32x4& a, const f32x4& b, bf16x8& hi, bf16x8& lo) {
    u32x4 h, l; float r[8];
    h.x = cvt_pk_bf16(a[0], a[1]); h.y = cvt_pk_bf16(a[2], a[3]); h.z = cvt_pk_bf16(b[0], b[1]); h.w = cvt_pk_bf16(b[2], b[3]);
    r[0] = a[0] - bflo(h.x); r[1] = a[1] - bfhi(h.x); r[2] = a[2] - bflo(h.y); r[3] = a[3] - bfhi(h.y);
    r[4] = b[0] - bflo(h.z); r[5] = b[1] - bfhi(h.z); r[6] = b[2] - bflo(h.w); r[7] = b[3] - bfhi(h.w);
    l.x = cvt_pk_bf16(r[0], r[1]); l.y = cvt_pk_bf16(r[2], r[3]); l.z = cvt_pk_bf16(r[4], r[5]); l.w = cvt_pk_bf16(r[6], r[7]);
    hi = __builtin_bit_cast(bf16x8, h); lo = __builtin_bit_cast(bf16x8, l);
}
__device__ __forceinline__ void route_chunk(LAS unsigned char* lds, const bf16_t* x2, const float* ssq2, const bf16_t* WRF, const float* b_router, const float* b_group,
                                            int* tok_e, float* tok_gate, float* tok_rs, int* hist, int chunk, int tid, int wave, int lane) {
    LAS unsigned char* WB = lds;
    LAS float* LG = (LAS float*)(lds + 49152);
    LAS int* HS = (LAS int*)(lds + 49152 + 36864);
    const int tk = lane & 15, g = lane >> 4;
    f32x4 acc[2][3];
#pragma unroll
    for (int gi = 0; gi < 2; ++gi)
#pragma unroll
        for (int nt = 0; nt < 3; ++nt) acc[gi][nt] = (f32x4){0.f, 0.f, 0.f, 0.f};
    if (tid < 32) HS[tid] = 0;
    const bf16_t* xb = x2 + (size_t)(chunk * 256 + wave * 32 + tk) * D + 8 * g;
#define MOE_LBAR() do { asm volatile("s_waitcnt lgkmcnt(0)" ::: "memory"); __builtin_amdgcn_s_barrier(); asm volatile("" ::: "memory"); } while (0)
    bf16x8 xa0[8], xa1[8]; u32x4 wv[6];
#define MOE_LOADX(dst, kc, gi) do { _Pragma("unroll") for (int s_ = 0; s_ < 8; ++s_) dst[s_] = *(const bf16x8*)(xb + (size_t)(gi) * 16 * D + (kc) * 256 + s_ * 32); } while (0)
#define MOE_LOADW(kc) do { _Pragma("unroll") for (int i = 0; i < 6; ++i) wv[i] = *(const u32x4*)((const char*)WRF + (size_t)(kc) * 49152 + (tid + 512 * i) * 16); } while (0)
#define MOE_MMA(gi, xs) do { _Pragma("unroll") for (int s = 0; s < 8; ++s) { _Pragma("unroll") for (int nt = 0; nt < 3; ++nt) { const LAS unsigned char* bp = WB + ((s * 3 + nt) * 2) * 1024 + lane * 16; \
        const bf16x8 bh = *(const LAS bf16x8*)bp, bl = *(const LAS bf16x8*)(bp + 1024); \
        acc[gi][nt] = __builtin_amdgcn_mfma_f32_16x16x32_bf16(xs[s], bh, acc[gi][nt], 0, 0, 0); acc[gi][nt] = __builtin_amdgcn_mfma_f32_16x16x32_bf16(xs[s], bl, acc[gi][nt], 0, 0, 0); } } } while (0)
    MOE_SYNC();
    MOE_LOADX(xa0, 0, 0); MOE_LOADW(0);
#pragma nounroll
    for (int kc = 0; kc < 4; ++kc) { const int kn = kc < 3 ? kc + 1 : kc;
        MOE_LBAR();
#pragma unroll
        for (int i = 0; i < 6; ++i) *(LAS u32x4*)(WB + (tid + 512 * i) * 16) = wv[i];
        MOE_LOADW(kn); MOE_LOADX(xa1, kc, 1);
        MOE_LBAR();
        MOE_MMA(0, xa0);
        MOE_LOADX(xa0, kn, 0);
        MOE_MMA(1, xa1);
    }
#undef MOE_MMA
#undef MOE_LOADX
#undef MOE_LOADW
#pragma unroll
    for (int gi = 0; gi < 2; ++gi)
#pragma unroll
        for (int nt = 0; nt < 3; ++nt) { const int o = 16 * nt + tk;
            if (o < 36) {
#pragma unroll
                for (int r = 0; r < 4; ++r) LG[(wave * 32 + gi * 16 + 4 * g + r) * 36 + o] = acc[gi][nt][r]; } }
    MOE_SYNC();
    if (wave < 4) { const int tr = wave * 64 + lane, tg = chunk * 256 + tr; const LAS float* lg = LG + tr * 36;
        const f32x4* sp = (const f32x4*)(ssq2 + (size_t)tg * 16); const f32x4 st = (sp[0] + sp[1]) + (sp[2] + sp[3]);
        const float rs = frsq(((st[0] + st[1]) + (st[2] + st[3])) * (1.f / D) + NORM_EPS);
        tok_rs[tg] = rs;
        float gl[4];
#pragma unroll
        for (int j = 0; j < 4; ++j) gl[j] = lg[32 + j] * rs + b_group[j];
        float gm = gl[0]; int gi = 0;
#pragma unroll
        for (int j = 1; j < 4; ++j) { if (gl[j] > gm) { gm = gl[j]; gi = j; } }
        float den = 0.f;
#pragma unroll
        for (int j = 0; j < 4; ++j) den += __expf(gl[j] - gm);
        const float gp = 1.0f / den;
        float v0 = -3.0e38f, v1 = -3.0e38f; int i0 = 0, i1 = 0;
#pragma unroll
        for (int j = 0; j < 8; ++j) { const float v = lg[gi * 8 + j] * rs + b_router[gi * 8 + j];
            if (v > v0) { v1 = v0; i1 = i0; v0 = v; i0 = j; } else if (v > v1) { v1 = v; i1 = j; } }
        const float dd = __expf(v1 - v0), g0 = gp / (1.f + dd), g1 = gp * dd / (1.f + dd);
        const int e0 = gi * 8 + i0, e1 = gi * 8 + i1;
        __hip_atomic_fetch_add(HS + e0, 1, __ATOMIC_RELAXED, __HIP_MEMORY_SCOPE_WORKGROUP); __hip_atomic_fetch_add(HS + e1, 1, __ATOMIC_RELAXED, __HIP_MEMORY_SCOPE_WORKGROUP);
        tok_e[tg] = e0 | (e1 << 8); tok_gate[2 * tg] = g0; tok_gate[2 * tg + 1] = g1; }
    MOE_SYNC();
    if (tid < 32) hist[chunk * 32 + tid] = HS[tid];
}
__device__ __forceinline__ void slot_chunk(LAS unsigned char* lds, const int* hist, const int* tok_e, const float* tok_gate, const float* tok_rs, int* tok_slot, int* row_tok, float* slot_rs, float* slot_gate, int* etile,
                                           int chunk, int tid, int wave, int lane) {
    LAS int* CNT = (LAS int*)lds; LAS int* BASE = CNT + 32; LAS int* PST = CNT + 64; LAS int* WC = CNT + 128;
    MOE_SYNC();
    { LAS int* PT = CNT + 512;
      const int e = tid & 31, part = tid >> 5; int tot = 0, bs = 0;
#pragma unroll
      for (int j = 0; j < 16; ++j) { const int cc = part * 16 + j; const int hh = hist[cc * 32 + e]; bs += (cc < chunk) ? hh : 0; tot += hh; }
      PT[(part * 2 + 0) * 32 + e] = tot; PT[(part * 2 + 1) * 32 + e] = bs; }
    MOE_SYNC();
    if (tid < 32) { LAS int* PT = CNT + 512; int tot = 0, bs = 0;
#pragma unroll
        for (int part = 0; part < 16; ++part) { tot += PT[(part * 2 + 0) * 32 + tid]; bs += PT[(part * 2 + 1) * 32 + tid]; }
        CNT[tid] = tot; BASE[tid] = bs; }
    MOE_SYNC();
    if (tid == 0) { int ps = 0; for (int e = 0; e < 32; ++e) { PST[e] = ps; ps += ((CNT[e] + 255) >> 8) << 8; } PST[32] = ps; }
    MOE_SYNC();
    int ek[2] = {0, 0}, rank[2] = {0, 0}; const int t = chunk * 256 + (wave & 3) * 64 + lane;
    if (wave < 4) { const int ev = tok_e[t]; ek[0] = ev & 255; ek[1] = ev >> 8;
#pragma unroll
        for (int k = 0; k < 2; ++k)
#pragma nounroll
            for (int e = 0; e < 32; ++e) { const unsigned long long m = __ballot(ek[k] == e);
                if (ek[k] == e) rank[k] = __popcll(m & ((1ull << lane) - 1ull));
                if (lane == 0) WC[(k * 4 + wave) * 32 + e] = __popcll(m); } }
    MOE_SYNC();
    if (wave < 4) {
#pragma unroll
        for (int k = 0; k < 2; ++k) { int off = 0;
            for (int kw = 0; kw < k * 4 + wave; ++kw) off += WC[kw * 32 + ek[k]];
            const int slot = PST[ek[k]] + BASE[ek[k]] + off + rank[k];
            row_tok[slot] = t; slot_rs[slot] = tok_rs[t]; slot_gate[slot] = tok_gate[2 * t + k]; tok_slot[2 * t + k] = slot; } }
    if (chunk < 32) { const int e = chunk, c0 = PST[e] + CNT[e], n = PST[e + 1] - c0;
        for (int i = tid; i < n; i += NWAVES * 64) { row_tok[c0 + i] = 0; slot_rs[c0 + i] = 0.f; slot_gate[c0 + i] = 0.f; } }
    if (chunk == 0 && tid <= 32) etile[tid] = PST[tid] >> 8;
}
__device__ __forceinline__ void unpack8(const u32x4& w, float (&f)[8]) { f[0] = bflo(w.x); f[1] = bfhi(w.x); f[2] = bflo(w.y); f[3] = bfhi(w.y); f[4] = bflo(w.z); f[5] = bfhi(w.z); f[6] = bflo(w.w); f[7] = bfhi(w.w); }
__device__ __forceinline__ void final_row2(float* xo, const bf16_t* X2, const bf16_t* Y, const int (&sl)[4], const float* g, int t, int lane) {
    const int s00 = sl[0], s01 = sl[1], s10 = sl[2], s11 = sl[3];
    u32x4 xw[2][2], aw[2][2], bw[2][2];
#pragma unroll
    for (int r = 0; r < 2; ++r) { const int sa = r ? s10 : s00, sb = r ? s11 : s01;
#pragma unroll
        for (int c = 0; c < 2; ++c) { const size_t e = (size_t)c * 512 + 8 * lane;
            xw[r][c] = *(const u32x4*)(X2 + (size_t)(t + r) * D + e); aw[r][c] = *(const u32x4*)(Y + (size_t)sa * D + e); bw[r][c] = *(const u32x4*)(Y + (size_t)sb * D + e); } }
    f32x4 gg[2][2];
#pragma unroll
    for (int c = 0; c < 2; ++c) { gg[c][0] = *(const f32x4*)(g + c * 512 + 8 * lane); gg[c][1] = *(const f32x4*)(g + c * 512 + 8 * lane + 4); }
#pragma unroll
    for (int r = 0; r < 2; ++r) { float v[2][8]; float ss = 0.f;
#pragma unroll
        for (int c = 0; c < 2; ++c) { float x[8], a[8], b[8]; unpack8(xw[r][c], x); unpack8(aw[r][c], a); unpack8(bw[r][c], b);
#pragma unroll
            for (int i = 0; i < 8; ++i) { v[c][i] = x[i] + (a[i] + b[i]); ss += v[c][i] * v[c][i]; } }
        const float rs = frsq(wave_sum(ss) * (1.f / D) + NORM_EPS);
#pragma unroll
        for (int c = 0; c < 2; ++c) { float* o = xo + (size_t)(t + r) * D + c * 512 + 8 * lane;
            *(f32x4*)o = (f32x4){v[c][0], v[c][1], v[c][2], v[c][3]} * rs * gg[c][0]; *(f32x4*)(o + 4) = (f32x4){v[c][4], v[c][5], v[c][6], v[c][7]} * rs * gg[c][1]; } }
}
}
#ifndef MK_N_LAUNCHES
#define MK_N_LAUNCHES 1
#endif
constexpr int NPH = 11;
constexpr int N_LAUNCHES = MK_N_LAUNCHES;

#define ARG_IN(k) karg_ptr(8 * (k))
#define ARG_OUT ((float*)karg_ptr(8 * 27))
#define ARG_WS ((unsigned char*)karg_ptr(8 * 28))
#ifndef STAG_TICKS
#define STAG_TICKS 0
#endif
__device__ __forceinline__ void phase_stagger(int ticks) {
    if (STAG_TICKS > 0 && (blockIdx.x & 1)) { const unsigned long long t0 = __builtin_amdgcn_s_memrealtime(); while (__builtin_amdgcn_s_memrealtime() - t0 < (unsigned long long)ticks) __builtin_amdgcn_s_sleep(8); }
}
template <int LO, int HI>
__global__ void __launch_bounds__(NWAVES * 64, 2) mega_fwd(Args args) {
    extern __shared__ __attribute__((aligned(16))) unsigned char lds_raw[];
    Frame F;
    F.lds = (LAS unsigned char*)lds_raw;
    F.MISC = (volatile LAS unsigned*)(F.lds + LDSCTL_OFF);
    F.wave = __builtin_amdgcn_readfirstlane((int)threadIdx.x >> 6);
    F.G = gridDim.x; { const int bx = blockIdx.x; F.vcu = (F.G % 8 == 0) ? (bx % 8) * (F.G / 8) + bx / 8 : bx; }
    F.ws = ARG_WS; F.ctl = (unsigned*)(ARG_WS + WS_CTL);
    for (int u = threadIdx.x; u < (LDS_BYTES - LDSCTL_OFF) / 4; u += NWAVES * 64) ((LAS unsigned*)(F.lds + LDSCTL_OFF))[u] = 0u;
    __syncthreads();
    XcdBarrier bar; bar.bar = F.ctl + CW_BAR; bar.x = 0; bar.st = nullptr;
    if (HI - LO > 1) bar = xcd_barrier_post(F.ctl + CW_BAR, F.MISC + 8);
#define GRID_BAR() do { if (HI - LO > 1) xcd_barrier(bar); } while (0)
#ifndef PH_MASK
#define PH_MASK 0x7ff
#endif
#define IN(k) ((((PH_MASK) >> (k)) & 1) && LO <= (k) && (k) < HI)
#define BOTH(k) (IN(k) && IN((k) + 1))
#ifndef DUP_PHASE
#define DUP_PHASE -1
#endif
#define DUPF(k) ((k) == DUP_PHASE ? 2 : 1)
    const int gw = F.vcu * NWAVES + F.wave, NGW = F.G * NWAVES;
#define R1 ((bf16_t*)(ARG_WS + WS_R1))
#define R2 ((bf16_t*)(ARG_WS + WS_R2))
#define ssqa ((float*)(ARG_WS + WS_SSQA))
#define ssq1 ((float*)(ARG_WS + WS_SSQ1))
#define ssq2 ((float*)(ARG_WS + WS_SSQ2))
#define tok_e ((int*)(ARG_WS + WS_TOK + TK_E))
#define tok_gate ((float*)(ARG_WS + WS_TOK + TK_GATE))
#define tok_slot ((int*)(ARG_WS + WS_TOK + TK_SLOT))
#define tok_rs ((float*)(ARG_WS + WS_TOK + TK_RS))
#define row_tok ((int*)(ARG_WS + WS_TOK + TK_ROWTOK))
#define slot_rs ((float*)(ARG_WS + WS_TOK + TK_SLOTRS))
#define slot_gate ((float*)(ARG_WS + WS_TOK + TK_SLOTGATE))
#define hist ((int*)(ARG_WS + WS_HIST))
#define etile ((int*)(ARG_WS + WS_HIST + HIST_ETILE))
#define WR ((const bf16_t*)(ARG_WS + WS_HIST + HIST_WR))

    if (IN(0)) { p0_prologue(F); if (DUPF(0) == 2) { asm volatile("s_waitcnt vmcnt(0)" ::: "memory"); __syncthreads(); p0_prologue(F); } if (BOTH(0)) GRID_BAR(); }

    if (IN(1)) {
        phase_stagger(STAG_TICKS);
        { pg8::KvOrder S{(const char*)(ARG_WS + WS_MEMN), (const char*)(ARG_WS + WS_WXK), (const char*)(ARG_WS + WS_WXV), F.G, (int)blockIdx.x};
          pg8::EpiPlain<false> E{(bf16_t*)(ARG_WS + WS_KX), D, (bf16_t*)(ARG_WS + WS_VX), D, nullptr};
          pg8::gemm_phase<pg8::EpiPlain<false>, pg8::KvOrder, true, false>(F.lds, F.wave, D, D, D, S, E); }
        { pg8::GridOrder S; S.init(ARG_WS + WS_XB0, ARG_WS + WS_WIN, D, D, T, INW, F.G, (int)blockIdx.x); S.dup = DUPF(1);
          pg8::EpiU E{R2, (bf16_t*)(ARG_WS + WS_Q), (bf16_t*)(ARG_WS + WS_K), (bf16_t*)(ARG_WS + WS_V), (const float*)(ARG_WS + WS_ROPE), (const float*)(ARG_WS + WS_ROPE) + SEQ * 32, (const float*)(ARG_WS + WS_SSQ2)};
          pg8::gemm_phase<pg8::EpiU, pg8::GridOrder, false, false>(F.lds, F.wave, D, D, D, S, E); }
        if (BOTH(1)) GRID_BAR();
    }

    if (IN(2)) {
        { pg8::MnOrder S{(const char*)(ARG_WS + WS_KX), (const char*)(ARG_WS + WS_WXQ), (const char*)(ARG_WS + WS_WXO), (const char*)(ARG_WS + WS_VX), F.G, F.vcu, 1};
          pg8::EpiPlain<false> E{(bf16_t*)(ARG_WS + WS_MT), D, (bf16_t*)(ARG_WS + WS_NT), D, nullptr};
          pg8::gemm_phase<pg8::EpiPlain<false>, pg8::MnOrder, true, false>(F.lds, F.wave, D, D, XHD, S, E); }
#define ATT_ARGS F.lds, (const bf16_t*)(ARG_WS + WS_Q), (const bf16_t*)(ARG_WS + WS_K), (const bf16_t*)(ARG_WS + WS_V), R1, (float*)(ARG_WS + WS_SSQ1), ssqa, F.vcu, F.G
        att::nat_pass<16, true, false>(ATT_ARGS, DUPF(20), F.wave, lane_id());
        asm volatile("s_waitcnt vmcnt(0) lgkmcnt(0)" ::: "memory"); __syncthreads(); GRID_BAR();
        att::nat_pass<4, false, false>(ATT_ARGS, 1, F.wave, lane_id());
        asm volatile("s_waitcnt vmcnt(0) lgkmcnt(0)" ::: "memory"); __syncthreads(); GRID_BAR();
        att::nat_pass<1, false, true>(ATT_ARGS, 1, F.wave, lane_id());
        for (int L = F.vcu; L < NB * 64; L += F.G) { const int b = L >> 6, j = L & 63;
            att::conv_unit(F.lds, R2, R1, (const float*)ARG_IN(5), (const float*)ARG_IN(6), (const float*)ARG_IN(7), (const float*)ARG_IN(8), (const float*)ARG_IN(9), b, j * 64, F.wave * 64 + lane_id(), F.wave, lane_id()); }
        asm volatile("s_waitcnt vmcnt(0) lgkmcnt(0)" ::: "memory"); __syncthreads();
        if (BOTH(2)) GRID_BAR();
    }

    if (IN(3)) {
        pg8::GridOrder S; S.init(R1, ARG_WS + WS_WOUT, D, D, T, D, F.G, (int)blockIdx.x); S.dup = DUPF(3);
        pg8::EpiResid<true> E{(const bf16_t*)(ARG_WS + WS_XB0), R2, ssq1, ssqa};
        pg8::gemm_phase<pg8::EpiResid<true>, pg8::GridOrder, true, false>(F.lds, F.wave, D, D, D, S, E);
        if (BOTH(3)) GRID_BAR();
    }

    if (IN(4)) {
        pg8::BatchOrder S{(const char*)R2, (const char*)(ARG_WS + WS_MT), (T / 256) * 4, F.G, (int)blockIdx.x, DUPF(4)};
        pg8::EpiSoftmax E{(bf16_t*)(ARG_WS + WS_PM), ssq1};
        pg8::gemm_phase<pg8::EpiSoftmax, pg8::BatchOrder, true, false>(F.lds, F.wave, D, D, D, S, E);
        if (BOTH(4)) GRID_BAR();
    }

    if (IN(5)) {
        pg8::BatchOrder S{(const char*)(ARG_WS + WS_PM), (const char*)(ARG_WS + WS_NT), (T / 256) * 4, F.G, (int)blockIdx.x, 1};
        pg8::EpiResid<false> E{nullptr, R2, ssq2, nullptr};
        pg8::gemm_phase<pg8::EpiResid<false>, pg8::BatchOrder, true, false>(F.lds, F.wave, D, D, D, S, E);
        if (BOTH(5)) GRID_BAR();
    }

    if (IN(6)) {
        for (int c0_ = blockIdx.x; c0_ < (T / 256) * DUPF(6); c0_ += F.G) { const int c = c0_ % (T / 256);
            moe::route_chunk(F.lds, R2, ssq2, WR, (const float*)ARG_IN(22), (const float*)ARG_IN(20), tok_e, tok_gate, tok_rs, hist, c, F.wave * 64 + lane_id(), F.wave, lane_id()); }
        asm volatile("s_waitcnt vmcnt(0) lgkmcnt(0)" ::: "memory"); __syncthreads();
        if (BOTH(6)) GRID_BAR();
    }

    if (IN(7)) {
        for (int c1_ = blockIdx.x; c1_ < (T / 256) * DUPF(7); c1_ += F.G) { const int c = c1_ % (T / 256);
            moe::slot_chunk(F.lds, hist, tok_e, tok_gate, tok_rs, tok_slot, row_tok, slot_rs, slot_gate, etile, c, F.wave * 64 + lane_id(), F.wave, lane_id()); }
        asm volatile("s_waitcnt vmcnt(0) lgkmcnt(0)" ::: "memory"); __syncthreads();
        if (BOTH(7)) GRID_BAR();
    }

#define MOE_ETILE_TO_LDS() do { if (threadIdx.x < NE + 1) ((LAS int*)(F.lds + XCH_ETILE))[threadIdx.x] = etile[threadIdx.x]; asm volatile("s_waitcnt vmcnt(0) lgkmcnt(0)" ::: "memory"); __syncthreads(); } while (0)
    if (IN(8)) {
        MOE_ETILE_TO_LDS();
        pg8::MoeOrder<0> S{(const char*)R2, (const char*)(ARG_WS + WS_W13), row_tok, (const LAS int*)(F.lds + XCH_ETILE), F.G, (int)blockIdx.x, DUPF(8)};
        pg8::EpiMoe1 E{(bf16_t*)(ARG_WS + WS_HID), slot_rs};
        pg8::gemm_phase<pg8::EpiMoe1, pg8::MoeOrder<0>, true, true>(F.lds, F.wave, D, D, D, S, E);
        if (BOTH(8)) GRID_BAR();
    }

    if (IN(9)) {
        MOE_ETILE_TO_LDS();
        pg8::MoeOrder<1> S{(const char*)(ARG_WS + WS_HID), (const char*)(ARG_WS + WS_W2), row_tok, (const LAS int*)(F.lds + XCH_ETILE), F.G, (int)blockIdx.x, DUPF(9)};
        pg8::EpiMoe2 E{(bf16_t*)(ARG_WS + WS_Y), slot_gate};
        pg8::gemm_phase<pg8::EpiMoe2, pg8::MoeOrder<1>, true, false>(F.lds, F.wave, FF, FF, FF, S, E);
        if (BOTH(9)) GRID_BAR();
    }

    if (IN(10)) {
        int sl[4], sn[4]; { const int* sp = tok_slot + 2 * ((2 * gw) % T); sl[0] = sp[0]; sl[1] = sp[1]; sl[2] = sp[2]; sl[3] = sp[3]; }
        for (int t0_ = 2 * gw; t0_ < T * DUPF(10); t0_ += 2 * NGW) { const int t = t0_ % T, tn = (t0_ + 2 * NGW) % T;
            { const int* sp = tok_slot + 2 * tn; sn[0] = sp[0]; sn[1] = sp[1]; sn[2] = sp[2]; sn[3] = sp[3]; }
            moe::final_row2(ARG_OUT, R2, (const bf16_t*)(ARG_WS + WS_Y), sl, (const float*)ARG_IN(26), t, lane_id());
#pragma unroll
            for (int k = 0; k < 4; ++k) sl[k] = sn[k]; }
    }
#undef IN
#undef BOTH
}

typedef void (*kern_t)(Args);
template <int... I> struct PhList {};
extern "C" void kernel_launch(void* const* d_in, const int* in_sizes, int n_in, void* d_out, int out_size, void* d_ws, size_t ws_size, hipStream_t stream) {
    static int grid = 0;
#if MK_N_LAUNCHES == 1
    static const kern_t kerns[1] = {mega_fwd<0, NPH>};
#else
    static const kern_t kerns[NPH] = {mega_fwd<0, 1>, mega_fwd<1, 2>, mega_fwd<2, 3>, mega_fwd<3, 4>, mega_fwd<4, 5>, mega_fwd<5, 6>, mega_fwd<6, 7>, mega_fwd<7, 8>, mega_fwd<8, 9>, mega_fwd<9, 10>, mega_fwd<10, 11>};
#endif
    if (grid == 0) {
        if (n_in != 27 || in_sizes[0] != T * D || out_size != T * D || ws_size < WS_END) { fprintf(stderr, "kernel_launch: unexpected problem: n_in %d in0 %d out %d ARG_WS %zu (need %zu)\n", n_in, n_in > 0 ? in_sizes[0] : -1, out_size, ws_size, (size_t)WS_END); grid = -1; return; }
        int dev = 0, cus = 0, per_cu = 0;
        if (hipGetDevice(&dev) != hipSuccess || hipDeviceGetAttribute(&cus, hipDeviceAttributeMultiprocessorCount, dev) != hipSuccess) { grid = -1; return; }
        for (int li = 0; li < N_LAUNCHES; ++li)
            if (hipFuncSetAttribute((const void*)kerns[li], hipFuncAttributeMaxDynamicSharedMemorySize, LDS_BYTES) != hipSuccess) { fprintf(stderr, "kernel_launch: hipFuncSetAttribute failed\n"); grid = -1; return; }
        if (hipOccupancyMaxActiveBlocksPerMultiprocessor(&per_cu, (const void*)kerns[0], NWAVES * 64, LDS_BYTES) != hipSuccess || per_cu < 1) { fprintf(stderr, "kernel_launch: occupancy query says %d\n", per_cu); }
        (void)hipGetLastError();
        grid = cus;
    }
    if (grid < 0) return;
    if (hipMemsetAsync((char*)d_ws + WS_CTL, 0, CTL_ZERO_BYTES, stream) != hipSuccess) return;
    Args a{};
    for (int i = 0; i < 27; ++i) a.in[i] = d_in[i];
    a.out = (float*)d_out; a.ws = (unsigned char*)d_ws;
    for (int li = 0; li < N_LAUNCHES; ++li) {
        a.ph_lo = 0; a.ph_hi = 0; a.li = li; a.pad = 0;
        hipLaunchKernelGGL(kerns[li], dim3(grid), dim3(NWAVES * 64), LDS_BYTES, stream, a);
        const hipError_t le = hipPeekAtLastError();
        if (le != hipSuccess) { fprintf(stderr, "kernel_launch: launch %d failed: %s\n", li, hipGetErrorName(le)); break; }
    }
}
```

```cpp
#include <hip/hip_runtime.h>
#include <cstdio>
#include <cstdint>

#define GAS __attribute__((address_space(1)))
#define LAS __attribute__((address_space(3)))
typedef unsigned short bf16_t;
typedef short bf16x8 __attribute__((ext_vector_type(8)));
typedef short s16x4 __attribute__((ext_vector_type(4)));
typedef float f32x4 __attribute__((ext_vector_type(4)));
typedef float f32x2 __attribute__((ext_vector_type(2)));
typedef unsigned u32x4 __attribute__((ext_vector_type(4)));
typedef unsigned u32x2 __attribute__((ext_vector_type(2)));

constexpr int NB = 16, SEQ = 4096, T = NB * SEQ, D = 1024;
constexpr int CCH = 256, NH = 12, HD = 64, AW = NH * HD, INW = 2 * CCH + 3 * AW;
constexpr int MEML = 256, MROWS = NB * MEML, XH = 4, XHD = 256;
constexpr int NE = 32, EPG = 8, NG = 4, FF = 512;
constexpr int CONVK = 31;
constexpr int A_PAD = T * 2 + NE * 256;
constexpr float NORM_EPS = 1e-6f, LN_EPS = 1e-5f;
constexpr float LOG2E = 1.4426950408889634f;

constexpr size_t MiB = 1u << 20;
constexpr size_t WS_CTL = 0, CTL_ZERO_BYTES = 64 * 1024;
constexpr size_t WS_ROPE = 1 * MiB;
constexpr size_t WS_HIST = 2 * MiB;
constexpr size_t WS_SSQA = 4 * MiB;
constexpr size_t WS_SSQ1 = 8 * MiB;
constexpr size_t WS_SSQ2 = 12 * MiB;
constexpr size_t WS_WIN = 16 * MiB, WS_WOUT = 22 * MiB, WS_WXQ = 24 * MiB, WS_WXK = 26 * MiB, WS_WXV = 28 * MiB, WS_WXO = 30 * MiB;
constexpr size_t WS_W13 = 32 * MiB, WS_W2 = 96 * MiB;
constexpr size_t WS_MEMN = 128 * MiB, WS_KX = 136 * MiB, WS_VX = 144 * MiB;
constexpr size_t WS_TOK = 152 * MiB;
constexpr size_t WS_R1 = 160 * MiB;
constexpr size_t WS_R2 = 288 * MiB;
constexpr size_t WS_Q = 320 * MiB, WS_K = 416 * MiB, WS_V = 512 * MiB;
constexpr size_t WS_MT = 672 * MiB, WS_NT = 704 * MiB;
constexpr size_t WS_PM = 544 * MiB;
constexpr size_t WS_HID = 416 * MiB;
constexpr size_t WS_Y = 552 * MiB;
constexpr size_t WS_XB0 = 824 * MiB;
constexpr size_t WS_END = 952 * MiB;
constexpr size_t TK_E = 0;
constexpr size_t TK_GATE = 1 * MiB;
constexpr size_t TK_SLOT = 2 * MiB;
constexpr size_t TK_RS = 3 * MiB;
constexpr size_t TK_ROWTOK = 4 * MiB;
constexpr size_t TK_SLOTRS = 5 * MiB;
constexpr size_t TK_SLOTGATE = 6 * MiB;
constexpr size_t HIST_ETILE = 64 * 1024, HIST_WR = 128 * 1024;

constexpr int CW_BAR = 4096;

constexpr int NWAVES = 8;
constexpr int RING_BYTES = 131072;
constexpr int XCH_OFF = RING_BYTES;
constexpr int XCH_ETILE = XCH_OFF + 8192;
constexpr int XCH_ROWS = XCH_OFF + 8448;
constexpr int LDSCTL_OFF = RING_BYTES + 12288;
constexpr int LDS_BYTES = 147456;

#define LDS_WAIT() asm volatile("s_waitcnt lgkmcnt(0)" ::: "memory")
#define VM_WAIT() asm volatile("s_waitcnt vmcnt(0)" ::: "memory")
__device__ __forceinline__ unsigned f2bf(float f) { unsigned u = __builtin_bit_cast(unsigned, f); return (u + 0x7fffu + ((u >> 16) & 1u)) >> 16; }
__device__ __forceinline__ unsigned pk2(float lo, float hi) { return f2bf(lo) | (f2bf(hi) << 16); }
__device__ __forceinline__ float bf2f(unsigned short b) { return __builtin_bit_cast(float, (unsigned)b << 16); }
__device__ __forceinline__ float bflo(unsigned w) { return __builtin_bit_cast(float, w << 16); }
__device__ __forceinline__ float bfhi(unsigned w) { return __builtin_bit_cast(float, w & 0xffff0000u); }
typedef __bf16 bf16x2_t __attribute__((ext_vector_type(2)));
__device__ __forceinline__ unsigned cvt_pk_bf16(float lo, float hi) { const f32x2 v = {lo, hi}; return __builtin_bit_cast(unsigned, __builtin_convertvector(v, bf16x2_t)); }
#define WS_DPP(v, ctrl) __builtin_bit_cast(float, __builtin_amdgcn_update_dpp(0, __builtin_bit_cast(int, (v)), (ctrl), 0xf, 0xf, true))
__device__ __forceinline__ float frcp(float x) { return __builtin_amdgcn_rcpf(x); }
__device__ __forceinline__ float frsq(float x) { return __builtin_amdgcn_rsqf(x); }
__device__ __forceinline__ float lsum16(float v) { float a = v, b = v; asm volatile("s_nop 1\n\tv_permlane16_swap_b32 %0, %1" : "+v"(a), "+v"(b)); return a + b; }
__device__ __forceinline__ float lsum32(float v) { float a = v, b = v; asm volatile("s_nop 1\n\tv_permlane32_swap_b32 %0, %1" : "+v"(a), "+v"(b)); return a + b; }
__device__ __forceinline__ float wave_sum(float v) {
#pragma unroll
    for (int o = 1; o < 64; o <<= 1) v += __shfl_xor(v, o);
    return v;
}
__device__ __forceinline__ float wave_sum_dpp(float v) {
    v += WS_DPP(v, 0xB1); v += WS_DPP(v, 0x4E); v += WS_DPP(v, 0x141); v += WS_DPP(v, 0x140);
    v = lsum16(v); return lsum32(v);
}
__device__ __forceinline__ int lane_id() { return (int)__builtin_amdgcn_mbcnt_hi(~0u, __builtin_amdgcn_mbcnt_lo(~0u, 0u)); }
#define MK_N_LAUNCHES 1
#ifndef PG8_8PH
#define PG8_8PH 0
#endif
namespace pg8 {
constexpr int BM = 256, BK = 64, HALF = 128, HTB = HALF * BK * 2  , STAGE_BYTES = 8 * HTB, NXCD = 8, WGM = 8;

__host__ __device__ __forceinline__ int lds_byte(int r, int c) { const int st = (r >> 4) * 2 + (c >> 5), rr = r & 15, cc = c & 31, ob = rr * 64 + cc * 2; return st * 1024 + (ob ^ (((ob >> 9) & 1) << 5)); }
__host__ __device__ __forceinline__ void stage_rc(int b, int& R, int& C) { const int st = b / 1024, sb = b % 1024, swz = sb ^ (((sb >> 9) & 1) << 5); R = (st >> 1) * 16 + swz / 64; C = (st & 1) * 32 + (swz % 64) / 2; }
__host__ __device__ __forceinline__ int perm32(int rho) { const int n = rho >> 4, i = rho & 15; return 8 * (i >> 2) + 4 * n + (i & 3); }

struct Unit { const char* a; const char* b; const int* rows; int pm, pn, x0, x1; };

typedef f32x4 Acc[2][2][4][2];

__device__ __forceinline__ const char* uniform_ptr(const char* p) { const unsigned long long v = (unsigned long long)p;
    const unsigned lo = __builtin_amdgcn_readfirstlane((unsigned)v), hi = __builtin_amdgcn_readfirstlane((unsigned)(v >> 32)); return (const char*)(((unsigned long long)hi << 32) | lo); }
__device__ __forceinline__ void glds16_sv(const char* gbase, unsigned voff, unsigned lds_dst) { unsigned keep;
    asm volatile("s_mov_b32 %0, m0\n\ts_mov_b32 m0, %3\n\ts_nop 2\n\tglobal_load_lds_dwordx4 %1, %2\n\ts_mov_b32 m0, %0" : "=&s"(keep) : "v"(voff), "s"(gbase), "s"(lds_dst) : "memory"); }
template <class Epi, class Sched, bool ALIGN_EPI, bool GATHER>
__device__ __forceinline__ void gemm_phase(LAS unsigned char* lds, const int wave_, const int lda, const int ldb, const int K, const Sched& S, const Epi& E) {
    int lane_ = lane_id(); asm volatile("" : "+v"(lane_));
    const int wid = __builtin_amdgcn_readfirstlane(wave_), tid = wid * 64 + lane_, lane = tid & 63, wr = wid >> 2, wc = wid & 3, fr = lane & 15, fq = lane >> 4;
    const int nt = K / BK;
    int Rr[2], Cc[2];
    unsigned vA[2][2], vN[2][2], voffB[2];
#pragma unroll
    for (int i = 0; i < 2; ++i) { int R, C; stage_rc(tid * 16 + i * 8192, R, C); Rr[i] = R; Cc[i] = C; const int Rb = Epi::PERM ? ((R & ~31) + perm32(R & 31)) : R;
        voffB[i] = (unsigned)(Rb * ldb + C) * 2u; }
    const size_t kstep = (size_t)(BK * 2);
    const size_t hstepB = (size_t)HALF * ldb * 2, hstepA = (size_t)HALF * lda * 2;
    const unsigned ldsw = (unsigned)wid * 1024u, lds0 = (unsigned)(uintptr_t)lds;
    const int aoff = lds_byte(wr * 64 + fr, fq * 8), boff = lds_byte(wc * 32 + fr, fq * 8);
#define PG8_SA(b, h) (((b) * 2 + (h)) * HTB)
#define PG8_SB(b, h) ((4 + (b) * 2 + (h)) * HTB)
#define PG8_STAGE(bufoff, gbase, voff) do { _Pragma("unroll") for (int _i = 0; _i < 2; ++_i) glds16_sv((gbase), (voff)[_i], lds0 + (unsigned)(bufoff) + ldsw + _i * 8192u); } while (0)
#define PG8_LDA(dst, b, h) do { _Pragma("unroll") for (int m = 0; m < 4; ++m) _Pragma("unroll") for (int k = 0; k < 2; ++k) dst[m][k] = *(const LAS bf16x8*)(lds + PG8_SA(b, h) + aoff + m * 2048 + k * 1024); } while (0)
#define PG8_LDB(dst, b, h) do { _Pragma("unroll") for (int n = 0; n < 2; ++n) _Pragma("unroll") for (int k = 0; k < 2; ++k) dst[n][k] = *(const LAS bf16x8*)(lds + PG8_SB(b, h) + boff + n * 2048 + k * 1024); } while (0)
#define PG8_MMA(ai, bj, At, Bt) do { __builtin_amdgcn_s_setprio(1); _Pragma("unroll") for (int m = 0; m < 4; ++m) _Pragma("unroll") for (int n = 0; n < 2; ++n) _Pragma("unroll") for (int k = 0; k < 2; ++k) \
        acc[ai][bj][m][n] = __builtin_amdgcn_mfma_f32_16x16x32_bf16(Bt[n][k], At[m][k], acc[ai][bj][m][n], 0, 0, 0); __builtin_amdgcn_s_setprio(0); } while (0)
#define PG8_MMAQ(ai, bj, At, Bt) PG8_MMA(ai, bj, At, Bt)
#define PG8_WAIT_V(n) asm volatile("s_waitcnt vmcnt(" #n ")" ::: "memory")
#define PG8_WAIT_L(n) asm volatile("s_waitcnt lgkmcnt(" #n ")" ::: "memory")
#define PG8_BAR __builtin_amdgcn_s_barrier()
#define PG8_SCHED __builtin_amdgcn_sched_barrier(0)
#define PG8_VOFF(dst, u) do { _Pragma("unroll") for (int _h = 0; _h < 2; ++_h) _Pragma("unroll") for (int _i = 0; _i < 2; ++_i) { \
        if constexpr (GATHER) dst[_h][_i] = (unsigned)(u).rows[_h * HALF + Rr[_i]] * (unsigned)(lda * 2) + (unsigned)(Cc[_i] * 2); \
        else dst[_h][_i] = (unsigned)(Rr[_i] * lda + Cc[_i]) * 2u; } } while (0)
#define PG8_STAGE_A(bufoff, gbase, h, vv) do { if constexpr (GATHER) { PG8_STAGE(bufoff, gbase, vv[h]); } else { PG8_STAGE(bufoff, (gbase) + (h) * hstepA, vv[0]); } } while (0)
    Unit cur, nxt; int ui = 0;
    if (!S.next(0, cur)) return;
    Acc acc;
#pragma unroll
    for (int a = 0; a < 2; ++a)
#pragma unroll
        for (int b = 0; b < 2; ++b)
#pragma unroll
            for (int m = 0; m < 4; ++m)
#pragma unroll
                for (int n = 0; n < 2; ++n) acc[a][b][m][n] = (f32x4){0.f, 0.f, 0.f, 0.f};
    bf16x8 At[4][2], B0[2][2], B1[2][2];
    const char* cA = uniform_ptr(cur.a); const char* cB = uniform_ptr(cur.b);
    PG8_VOFF(vA, cur);
    if constexpr (GATHER) { asm volatile("s_waitcnt vmcnt(0)" ::: "memory"); }
#if PG8_8PH
    PG8_STAGE(PG8_SB(0, 0), cB, voffB); PG8_STAGE_A(PG8_SA(0, 0), cA, 0, vA); PG8_STAGE(PG8_SB(0, 1), cB + hstepB, voffB); PG8_STAGE_A(PG8_SA(0, 1), cA, 1, vA);
    if (wr == 1) PG8_BAR;
    PG8_WAIT_V(4); PG8_BAR;
    PG8_STAGE(PG8_SB(1, 0), cB + kstep, voffB); PG8_STAGE_A(PG8_SA(1, 0), cA + kstep, 0, vA); PG8_STAGE(PG8_SB(1, 1), cB + hstepB + kstep, voffB);
    PG8_WAIT_V(6); PG8_BAR;
#else
    PG8_STAGE(PG8_SB(0, 0), cB, voffB); PG8_STAGE(PG8_SB(0, 1), cB + hstepB, voffB); PG8_STAGE_A(PG8_SA(0, 0), cA, 0, vA); PG8_STAGE_A(PG8_SA(0, 1), cA, 1, vA);
    if (wr == 1) PG8_BAR;
    PG8_WAIT_V(2); PG8_BAR;
    PG8_STAGE(PG8_SB(1, 0), cB + kstep, voffB); PG8_STAGE_A(PG8_SA(1, 0), cA + kstep, 0, vA); PG8_STAGE(PG8_SB(1, 1), cB + hstepB + kstep, voffB);
    PG8_WAIT_V(6); PG8_BAR;
#endif
    for (;;) {
        const bool has_next = S.next(ui + 1, nxt);
        const char* nA = has_next ? uniform_ptr(nxt.a) : cA; const char* nB = has_next ? uniform_ptr(nxt.b) : cB;
        if constexpr (GATHER) {
            if (has_next && wid == 0) glds16_sv(uniform_ptr((const char*)nxt.rows), (unsigned)lane * 16u, lds0 + (unsigned)XCH_ROWS + (unsigned)((ui + 1) & 1) * 1024u);
#pragma unroll
            for (int h = 0; h < 2; ++h) { vN[h][0] = vA[h][0]; vN[h][1] = vA[h][1]; } }
#pragma nounroll
        for (int t = 0; t < nt; t += 2) {
            const bool last = (t == nt - 2);
            if constexpr (Epi::HAS_MID) { if (t == E.mid_t()) E.mid(acc, cur, wr, wc, fr, fq); }
            const char* a1 = cA + (size_t)(t + 1) * kstep;
            const char* a2 = last ? nA : cA + (size_t)(t + 2) * kstep; const char* b2 = last ? nB : cB + (size_t)(t + 2) * kstep;
            const char* a3 = a2 + kstep; const char* b3 = b2 + kstep;
            unsigned vW[2][2];
            if constexpr (GATHER) { if (last && has_next) { const LAS int* rtab = (const LAS int*)(lds + XCH_ROWS + ((ui + 1) & 1) * 1024);
#pragma unroll
                for (int h = 0; h < 2; ++h)
#pragma unroll
                    for (int i = 0; i < 2; ++i) vN[h][i] = (unsigned)rtab[h * HALF + Rr[i]] * (unsigned)(lda * 2) + (unsigned)(Cc[i] * 2); } }
#pragma unroll
            for (int h = 0; h < 2; ++h) { vW[h][0] = vA[h][0]; vW[h][1] = vA[h][1]; if constexpr (GATHER) { if (last) { vW[h][0] = vN[h][0]; vW[h][1] = vN[h][1]; } } }
#if PG8_8PH
            PG8_LDB(B0, 0, 0); PG8_SCHED; PG8_LDA(At, 0, 0); PG8_STAGE_A(PG8_SA(1, 1), a1, 1, vA);
            PG8_WAIT_L(8); PG8_BAR; PG8_WAIT_L(0); PG8_MMAQ(0, 0, At, B0); PG8_BAR; PG8_SCHED;
            PG8_LDB(B1, 0, 1); PG8_STAGE(PG8_SB(0, 0), b2, voffB);
            PG8_BAR; PG8_WAIT_L(0); PG8_MMAQ(0, 1, At, B1); PG8_BAR;
            PG8_LDA(At, 0, 1); PG8_STAGE_A(PG8_SA(0, 0), a2, 0, vW);
            PG8_BAR; PG8_WAIT_L(0); PG8_MMAQ(1, 0, At, B0); PG8_BAR; PG8_SCHED;
            PG8_STAGE(PG8_SB(0, 1), b2 + hstepB, voffB);
            PG8_WAIT_V(6); PG8_BAR; PG8_MMAQ(1, 1, At, B1); PG8_BAR;
            PG8_LDB(B0, 1, 0); PG8_SCHED; PG8_LDA(At, 1, 0); PG8_STAGE_A(PG8_SA(0, 1), a2, 1, vW);
            PG8_WAIT_L(8); PG8_BAR; PG8_WAIT_L(0); PG8_MMAQ(0, 0, At, B0); PG8_BAR; PG8_SCHED;
            PG8_LDB(B1, 1, 1); PG8_STAGE(PG8_SB(1, 0), b3, voffB);
            PG8_BAR; PG8_WAIT_L(0); PG8_MMAQ(0, 1, At, B1); PG8_BAR;
            PG8_LDA(At, 1, 1); PG8_STAGE_A(PG8_SA(1, 0), a3, 0, vW);
            PG8_BAR; PG8_WAIT_L(0); PG8_MMAQ(1, 0, At, B0); PG8_BAR; PG8_SCHED;
            PG8_STAGE(PG8_SB(1, 1), b3 + hstepB, voffB);
            PG8_WAIT_V(6); PG8_BAR; PG8_MMAQ(1, 1, At, B1); PG8_BAR;
#else
            PG8_LDB(B0, 0, 0); PG8_LDB(B1, 0, 1); PG8_SCHED; PG8_LDA(At, 0, 0); PG8_STAGE_A(PG8_SA(1, 1), a1, 1, vA);
            PG8_WAIT_V(8); PG8_WAIT_L(0); PG8_BAR; PG8_MMA(0, 0, At, B0); PG8_MMA(0, 1, At, B1); PG8_BAR; PG8_SCHED;
            PG8_LDA(At, 0, 1); PG8_STAGE(PG8_SB(0, 0), b2, voffB); PG8_STAGE(PG8_SB(0, 1), b2 + hstepB, voffB); PG8_STAGE_A(PG8_SA(0, 0), a2, 0, vW);
            PG8_WAIT_V(8); PG8_WAIT_L(0); PG8_BAR; PG8_MMA(1, 0, At, B0); PG8_MMA(1, 1, At, B1); PG8_BAR; PG8_SCHED;
            PG8_LDB(B0, 1, 0); PG8_LDB(B1, 1, 1); PG8_SCHED; PG8_LDA(At, 1, 0); PG8_STAGE_A(PG8_SA(0, 1), a2, 1, vW);
            PG8_WAIT_V(8); PG8_WAIT_L(0); PG8_BAR; PG8_MMA(0, 0, At, B0); PG8_MMA(0, 1, At, B1); PG8_BAR; PG8_SCHED;
            PG8_LDA(At, 1, 1); PG8_STAGE(PG8_SB(1, 0), b3, voffB); PG8_STAGE(PG8_SB(1, 1), b3 + hstepB, voffB); PG8_STAGE_A(PG8_SA(1, 0), a3, 0, vW);
            PG8_WAIT_V(8); PG8_WAIT_L(0); PG8_BAR; PG8_MMA(1, 0, At, B0); PG8_MMA(1, 1, At, B1); PG8_BAR; PG8_SCHED;
#endif
        }
        if constexpr (ALIGN_EPI) { if (wr == 0) PG8_BAR; }
        E(acc, cur, wr, wc, fr, fq, lds, wid, lane);
        if (!has_next) break;
#pragma unroll
        for (int a = 0; a < 2; ++a)
#pragma unroll
            for (int b = 0; b < 2; ++b)
#pragma unroll
                for (int m = 0; m < 4; ++m)
#pragma unroll
                    for (int n = 0; n < 2; ++n) acc[a][b][m][n] = (f32x4){0.f, 0.f, 0.f, 0.f};
        cur = nxt; cA = nA; cB = nB; ++ui;
        if constexpr (GATHER) {
#pragma unroll
            for (int h = 0; h < 2; ++h) { vA[h][0] = vN[h][0]; vA[h][1] = vN[h][1]; } }
        if constexpr (ALIGN_EPI) { if (wr == 1) PG8_BAR; }
    }
    PG8_WAIT_V(0);
    if constexpr (!ALIGN_EPI) { if (wr == 0) PG8_BAR; }
    PG8_BAR;
#undef PG8_SA
#undef PG8_SB
#undef PG8_STAGE
#undef PG8_LDA
#undef PG8_LDB
#undef PG8_MMA
#undef PG8_MMAQ
#undef PG8_WAIT_V
#undef PG8_WAIT_L
#undef PG8_BAR
#undef PG8_SCHED
#undef PG8_VOFF
#undef PG8_STAGE_A
}
}
#define XB_TMO      128
#define XB_XCNT(j)  (256  + 64 * (j))
#define XB_XSUB(j)  (1280 + 64 * (j))
#define XB_XGEN(j)  (2304 + 64 * (j))
#define XB_TOP      3328
#define XB_TOPGEN   3392
#define XCD_BAR_WORDS 3456
#define XB_SPIN_CAP (1u << 18)

__device__ __forceinline__ unsigned xb_ld(unsigned* p)              { return __hip_atomic_load(p, __ATOMIC_RELAXED, __HIP_MEMORY_SCOPE_AGENT); }
__device__ __forceinline__ unsigned xb_add(unsigned* p, unsigned v) { return __hip_atomic_fetch_add(p, v, __ATOMIC_RELAXED, __HIP_MEMORY_SCOPE_AGENT); }
__device__ __forceinline__ unsigned xb_xcc_id() { return (unsigned)__builtin_amdgcn_s_getreg((3 << 11) | 20) & 0xFu; }
#define XB_SPIN(cond, bar) do { unsigned _sp = 0; while (cond) { __builtin_amdgcn_s_sleep(1); \
    if ((++_sp & 255u) == 0u) { if (xb_ld(&(bar)[XB_TMO])) break; if (_sp > XB_SPIN_CAP) { atomicAdd(&(bar)[XB_TMO], 1u); break; } } } } while (0)

struct XcdBarrier {
    unsigned* bar; unsigned x;
    volatile LAS unsigned* st;
};

__device__ __forceinline__ XcdBarrier xcd_barrier_post(unsigned* bar, volatile LAS unsigned* st) {
    XcdBarrier b; b.bar = bar; b.x = xb_xcc_id(); b.st = st;
    if (threadIdx.x == 0) (void)xb_add(&bar[XB_XCNT(b.x)], 1u);
    return b;
}
__device__ __forceinline__ void xcd_barrier_complete(unsigned* bar, unsigned x, unsigned& nloc, unsigned& nx) {
    const unsigned G = gridDim.x * gridDim.y * gridDim.z;
    unsigned sum, cnt, mine, sp = 0u;
    for (;;) {
        sum = 0u; cnt = 0u; mine = 0u;
#pragma unroll
        for (unsigned j = 0; j < 16; ++j) { const unsigned c = xb_ld(&bar[XB_XCNT(j)]); sum += c; cnt += (c > 0u) ? 1u : 0u; mine = (j == x) ? c : mine; }
        if (sum == G) break;
        __builtin_amdgcn_s_sleep(1);
        if ((++sp & 255u) == 0u) { if (xb_ld(&bar[XB_TMO])) break; if (sp > XB_SPIN_CAP) { atomicAdd(&bar[XB_TMO], 1u); break; } }
    }
    nloc = mine > 0u ? mine : 1u; nx = cnt > 0u ? cnt : 1u;
}

__device__ __forceinline__ void xcd_barrier(const XcdBarrier& b) {
    asm volatile("s_waitcnt vmcnt(0)" ::: "memory");
    __syncthreads();
    if (threadIdx.x == 0) {
        unsigned* bar = b.bar;
        __builtin_amdgcn_s_waitcnt(0);
        unsigned nloc = b.st[0], nx = b.st[1];
        if (nloc == 0u) { xcd_barrier_complete(bar, b.x, nloc, nx); b.st[0] = nloc; b.st[1] = nx; }
        const unsigned old = xb_add(&bar[XB_XSUB(b.x)], 1u);
        const unsigned gen = old / nloc;
#ifndef XB_FLAT
#define XB_FLAT 1
#endif
#if XB_FLAT
        if (old + 1u == (gen + 1u) * nloc) {
            __builtin_amdgcn_fence(__ATOMIC_RELEASE, "agent");
            asm volatile("s_waitcnt vmcnt(0)" ::: "memory");
            (void)xb_add(&bar[XB_TOP], 1u);
        }
        XB_SPIN(xb_ld(&bar[XB_TOP]) < (gen + 1u) * nx, bar);
        __builtin_amdgcn_fence(__ATOMIC_ACQUIRE, "agent");
        asm volatile("s_waitcnt vmcnt(0)" ::: "memory");
#else
        if (old + 1u == (gen + 1u) * nloc) {
            __builtin_amdgcn_fence(__ATOMIC_RELEASE, "agent");
            asm volatile("s_waitcnt vmcnt(0)" ::: "memory");
            const unsigned og = xb_add(&bar[XB_TOP], 1u);
            const unsigned tg = og / nx;
            if (og + 1u == (tg + 1u) * nx) xb_add(&bar[XB_TOPGEN], 1u);
            else XB_SPIN(xb_ld(&bar[XB_TOPGEN]) == tg, bar);
            __builtin_amdgcn_fence(__ATOMIC_ACQUIRE, "agent");
            xb_add(&bar[XB_XGEN(b.x)], 1u);
            asm volatile("s_waitcnt vmcnt(0)" ::: "memory");
        } else {
            XB_SPIN(xb_ld(&bar[XB_XGEN(b.x)]) == gen, bar);
            __builtin_amdgcn_fence(__ATOMIC_ACQUIRE, "agent");
            asm volatile("s_waitcnt vmcnt(0)" ::: "memory");
        }
#endif
    }
    __syncthreads();
}


namespace pg8 {
#define EPI_NOMID static constexpr bool HAS_MID = false; __device__ __forceinline__ int mid_t() const { return -1; } __device__ __forceinline__ void mid(Acc&, const Unit&, int, int, int, int) const {}
#define RAW_BARRIER() do { asm volatile("s_waitcnt lgkmcnt(0)" ::: "memory"); __builtin_amdgcn_s_barrier(); asm volatile("" ::: "memory"); } while (0)

__device__ __forceinline__ u32x4 pack8(const f32x4& v0, const f32x4& v1) { u32x4 w; w.x = cvt_pk_bf16(v0[0], v0[1]); w.y = cvt_pk_bf16(v0[2], v0[3]); w.z = cvt_pk_bf16(v1[0], v1[1]); w.w = cvt_pk_bf16(v1[2], v1[3]); return w; }

struct GridOrder {
    const char* A; const char* Bt; int lda, ldb, nM, nN, nwg, G, c, dup;
    __device__ __forceinline__ void init(const void* A_, const void* Bt_, int lda_, int ldb_, int M, int N, int G_, int c_) { A = (const char*)A_; Bt = (const char*)Bt_; lda = lda_; ldb = ldb_; nM = M / BM; nN = N / BM; nwg = nM * nN; G = G_; c = c_; dup = 1; }
    __device__ __forceinline__ bool next(int i, Unit& u) const {
        const long L = (long)i * G + c; if (L >= (long)nwg * dup) return false;
        int wgid = (int)(L % nwg); { const int q = nwg / NXCD, r = nwg % NXCD, xcd = wgid % NXCD, off = wgid / NXCD; wgid = (xcd < r ? xcd * (q + 1) : r * (q + 1) + (xcd - r) * q) + off; }
        const int nig = WGM * nN, gid = wgid / nig, fm = gid * WGM, gsz = (nM - fm) < WGM ? (nM - fm) : WGM;
        u.pm = fm + ((wgid % nig) % gsz); u.pn = (wgid % nig) / gsz; u.x0 = 0; u.x1 = 0; u.rows = nullptr;
        u.a = A + (size_t)u.pm * BM * lda * 2; u.b = Bt + (size_t)u.pn * BM * ldb * 2; return true;
    }
};
struct KvOrder {
    const char* memn; const char* wk; const char* wv; int G, c;
    __device__ __forceinline__ bool next(int i, Unit& u) const {
        int L; if (G >= 2) { if (!(c & 1)) return false; L = (c >> 1) + i * (G >> 1); } else L = i * G + c;
        if (L >= 128) return false;
        const int l = L & 63; u.rows = nullptr; u.x1 = 0; u.x0 = L >> 6; u.pm = l >> 2; u.pn = l & 3;
        u.a = memn + (size_t)u.pm * BM * D * 2; u.b = (u.x0 ? wv : wk) + (size_t)u.pn * BM * D * 2;
        return true;
    }
};
struct MnOrder {
    const char* kx; const char* wq2; const char* wxoT; const char* vx; int G, c, dup;
    __device__ __forceinline__ bool next(int i, Unit& u) const {
        int L = i * G + c; if (L >= 512 * dup) return false;
        L &= 511; const int l = L & 255, bh = l >> 2, t4 = l & 3, b = bh >> 2, h = bh & 3; u.rows = nullptr; u.x1 = 0;
        if (L < 256) { u.x0 = 0; u.pm = b * 4 + h; u.pn = t4; u.a = kx + ((size_t)b * MEML * D + h * XHD) * 2; u.b = wq2 + ((size_t)t4 * BM * D + h * XHD) * 2; }
        else { u.x0 = 1; u.pm = b * 4 + t4; u.pn = h; u.a = wxoT + ((size_t)t4 * BM * D + h * XHD) * 2; u.b = vx + ((size_t)b * MEML * D + h * XHD) * 2; }
        return true;
    }
};
struct BatchOrder {
    const char* A; const char* Bt; int nwg, G, c, dup;
    __device__ __forceinline__ bool next(int i, Unit& u) const {
        const long L = (long)i * G + c; if (L >= (long)nwg * dup) return false;
        int wgid = (int)(L % nwg); { const int q = nwg / NXCD, r = nwg % NXCD, xcd = wgid % NXCD, off = wgid / NXCD; wgid = (xcd < r ? xcd * (q + 1) : r * (q + 1) + (xcd - r) * q) + off; }
        const int nN = 4, nM = T / BM, nig = WGM * nN, gid = wgid / nig, fm = gid * WGM, gsz = (nM - fm) < WGM ? (nM - fm) : WGM;
        u.pm = fm + ((wgid % nig) % gsz); u.pn = (wgid % nig) / gsz; u.x0 = 0; u.x1 = 0; u.rows = nullptr;
        u.a = A + (size_t)u.pm * BM * D * 2; u.b = Bt + ((size_t)(u.pm >> 4) * D + u.pn * BM) * D * 2; return true;
    }
};
template <int MODE> struct MoeOrder {
    const char* A; const char* W; const int* rowtok; const LAS int* etile; int G, c, dup;
    __device__ __forceinline__ bool next(int i, Unit& u) const {
        int L = i * G + c; const int ntile = __builtin_amdgcn_readfirstlane(etile[NE]);
        if (L >= ntile * 4 * dup) return false;
        L %= ntile * 4;
        const int rt = L >> 2, ct = L & 3; const int ln = lane_id();
        const int e = __popcll(__ballot(ln >= 1 && ln < NE && etile[ln & (NE - 1)] <= rt));
        u.pm = rt; u.pn = ct; u.x0 = e; u.x1 = 0;
        if (MODE == 0) { u.a = A; u.rows = rowtok + rt * BM; u.b = W + ((size_t)e * 1024 + ct * BM) * D * 2; }
        else { u.a = A + (size_t)rt * BM * FF * 2; u.rows = nullptr; u.b = W + ((size_t)e * 1024 + ct * BM) * FF * 2; }
        return true;
    }
};

struct EpiU {
    static constexpr bool PERM = true; EPI_NOMID
    bf16_t* Cb; bf16_t* Q; bf16_t* Kb; bf16_t* V; const float* ropec; const float* ropes; const float* rs0;
    __device__ __forceinline__ void operator()(Acc& acc, const Unit& u, int wr, int wc, int fr, int fq, LAS unsigned char*, int, int) const {
        const int row0 = u.pm * BM + wr * 64 + fr; float rsv[8];
#pragma unroll
        for (int st = 0; st < 8; ++st) rsv[st] = rs0[row0 + (st >> 2) * HALF + (st & 3) * 16];
        if (u.pn < 2) {
#pragma unroll
            for (int ai = 0; ai < 2; ++ai)
#pragma unroll
                for (int m = 0; m < 4; ++m) { const int row = row0 + ai * HALF + m * 16; f32x4 o[2];
#pragma unroll
                    for (int n = 0; n < 2; ++n)
#pragma unroll
                        for (int i = 0; i < 4; ++i) { const float a = acc[ai][0][m][n][i] * rsv[4 * ai + m], g = acc[ai][1][m][n][i] * rsv[4 * ai + m]; o[n][i] = a * frcp(1.f + __expf(-g)); }
                    *(u32x4*)(Cb + (size_t)row * CCH + u.pn * HALF + wc * 32 + fq * 8) = pack8(o[0], o[1]); }
        } else if (u.pn < 8) {
            const int sec = (u.pn - 2) / 3, tt = (u.pn - 2) % 3; bf16_t* dst = sec ? Kb : Q; const float sc = sec ? 1.f : 0.125f * LOG2E;
            const int hd = 4 * tt + wc;
            constexpr int EPI_PD = 3; f32x4 cs[8][2], sn[8][2];
#define EPIU_LOAD(st) do { const int s_ = (row0 + ((st) >> 2) * HALF + ((st) & 3) * 16) & (SEQ - 1); _Pragma("unroll") for (int n = 0; n < 2; ++n) { \
                cs[st][n] = *(const f32x4*)(ropec + s_ * 32 + fq * 8 + n * 4); sn[st][n] = *(const f32x4*)(ropes + s_ * 32 + fq * 8 + n * 4); } } while (0)
#pragma unroll
            for (int st = 0; st < EPI_PD; ++st) EPIU_LOAD(st);
#pragma unroll
            for (int st = 0; st < 8; ++st) { const int ai = st >> 2, m = st & 3; const int row = row0 + ai * HALF + m * 16; const int s = row & (SEQ - 1); f32x4 o1[2], o2[2];
                if (st + EPI_PD < 8) EPIU_LOAD(st + EPI_PD);
#pragma unroll
                for (int n = 0; n < 2; ++n) { const f32x4 x1 = acc[ai][0][m][n], x2 = acc[ai][1][m][n];
                    o1[n] = (x1 * cs[st][n] - x2 * sn[st][n]) * (sc * rsv[st]); o2[n] = (x1 * sn[st][n] + x2 * cs[st][n]) * (sc * rsv[st]); }
                bf16_t* p = dst + ((size_t)((row >> 12) * NH + hd) * SEQ + s) * HD + fq * 8;
                *(u32x4*)p = pack8(o1[0], o1[1]); *(u32x4*)(p + 32) = pack8(o2[0], o2[1]); }
#undef EPIU_LOAD
        } else {
            const int tt = u.pn - 8;
#pragma unroll
            for (int ai = 0; ai < 2; ++ai)
#pragma unroll
                for (int m = 0; m < 4; ++m) { const int row = row0 + ai * HALF + m * 16;
#pragma unroll
                    for (int bj = 0; bj < 2; ++bj) { const int col = tt * BM + bj * HALF + wc * 32 + fq * 8;
                        *(u32x4*)(V + ((size_t)((row >> 12) * NH + (col >> 6)) * SEQ + (row & (SEQ - 1))) * HD + (col & 63)) = pack8(acc[ai][bj][m][0] * rsv[4 * ai + m], acc[ai][bj][m][1] * rsv[4 * ai + m]); } }
        }
    }
};
template <bool ROWSCALE> struct EpiPlain {
    static constexpr bool PERM = true; EPI_NOMID
    bf16_t* O0; int ldc0; bf16_t* O1; int ldc1; const float* ssq16;
    __device__ __forceinline__ void operator()(Acc& acc, const Unit& u, int wr, int wc, int fr, int fq, LAS unsigned char*, int, int) const {
        bf16_t* O = u.x0 ? O1 : O0; const int ldc = u.x0 ? ldc1 : ldc0;
        const int row0 = u.pm * BM + wr * 64 + fr, col0 = u.pn * BM + wc * 32 + fq * 8;
#pragma unroll
        for (int ai = 0; ai < 2; ++ai)
#pragma unroll
            for (int m = 0; m < 4; ++m) { const int row = row0 + ai * HALF + m * 16; float rs = 1.f;
                if constexpr (ROWSCALE) { const f32x4* sp = (const f32x4*)(ssq16 + (size_t)row * 16); const f32x4 s0 = sp[0], s1 = sp[1], s2 = sp[2], s3 = sp[3];
                    const f32x4 st = (s0 + s1) + (s2 + s3); rs = frsq(((st[0] + st[1]) + (st[2] + st[3])) * (1.0f / D) + NORM_EPS); }
#pragma unroll
                for (int bj = 0; bj < 2; ++bj) *(u32x4*)(O + (size_t)row * ldc + col0 + bj * HALF) = pack8(acc[ai][bj][m][0] * rs, acc[ai][bj][m][1] * rs); }
    }
};
#ifndef RESID_PD
#define RESID_PD 4
#endif
template <bool MID> struct EpiResid {
    static constexpr bool PERM = true, HAS_MID = MID;
    const bf16_t* xsrc; bf16_t* XB; float* ssqp; const float* ssqa;
    __device__ __forceinline__ int mid_t() const { return AW / BK; }
    __device__ __forceinline__ void mid(Acc& acc, const Unit& u, int wr, int wc, int fr, int fq) const {
        const int row0 = u.pm * BM + wr * 64 + fr;
        f32x4 sq[2][4];
#pragma unroll
        for (int ai = 0; ai < 2; ++ai)
#pragma unroll
            for (int m = 0; m < 4; ++m) sq[ai][m] = *(const f32x4*)(ssqa + (size_t)(row0 + ai * HALF + m * 16) * NH + 4 * (fq < 3 ? fq : 2));
#pragma unroll
        for (int ai = 0; ai < 2; ++ai)
#pragma unroll
            for (int m = 0; m < 4; ++m) { const f32x4 st = sq[ai][m]; float t = (st[0] + st[1]) + (st[2] + st[3]); t = fq < 3 ? t : 0.f; t = lsum16(t); t = lsum32(t);
                const float r = frsq(t * (1.0f / AW) + NORM_EPS);
#pragma unroll
                for (int bj = 0; bj < 2; ++bj)
#pragma unroll
                    for (int n = 0; n < 2; ++n) acc[ai][bj][m][n] = acc[ai][bj][m][n] * r; }
    }
    __device__ __forceinline__ void operator()(Acc& acc, const Unit& u, int wr, int wc, int fr, int fq, LAS unsigned char*, int, int) const {
        const int row0 = u.pm * BM + wr * 64 + fr, col0 = u.pn * BM + wc * 32 + fq * 8;
        const bf16_t* src = MID ? xsrc : (const bf16_t*)XB; u32x4 xh[8][2];
#pragma unroll
        for (int st = 0; st < 8; ++st) { const size_t o_ = (size_t)(row0 + (st >> 2) * HALF + (st & 3) * 16) * D + col0;
#pragma unroll
            for (int bj = 0; bj < 2; ++bj) xh[st][bj] = *(const u32x4*)(src + o_ + bj * HALF); }
#pragma unroll
        for (int st = 0; st < 8; ++st) { const int ai = st >> 2, m = st & 3; const int row = row0 + ai * HALF + m * 16; float ss = 0.f;
#pragma unroll
            for (int bj = 0; bj < 2; ++bj) { const size_t o = (size_t)row * D + col0 + bj * HALF; const u32x4 xb = xh[st][bj];
                const f32x4 v0 = (f32x4){bflo(xb.x), bfhi(xb.x), bflo(xb.y), bfhi(xb.y)} + acc[ai][bj][m][0], v1 = (f32x4){bflo(xb.z), bfhi(xb.z), bflo(xb.w), bfhi(xb.w)} + acc[ai][bj][m][1];
                *(u32x4*)(XB + o) = pack8(v0, v1);
                ss += ((v0[0] * v0[0] + v0[1] * v0[1]) + (v0[2] * v0[2] + v0[3] * v0[3])) + ((v1[0] * v1[0] + v1[1] * v1[1]) + (v1[2] * v1[2] + v1[3] * v1[3])); }
            ss = lsum16(ss); ss = lsum32(ss);
            if (fq == 0) ssqp[(size_t)row * 16 + u.pn * 4 + wc] = ss; }
    }
};
struct EpiSoftmax {
    static constexpr bool PERM = true; EPI_NOMID
    bf16_t* PM; const float* ssq16;
    __device__ __forceinline__ void operator()(Acc& acc, const Unit& u, int wr, int wc, int fr, int fq, LAS unsigned char* lds, int, int) const {
        LAS float* MX = (LAS float*)(lds + XCH_OFF); LAS float* SM = (LAS float*)(lds + XCH_OFF + 4096);
        f32x4 sq[2][4];
#pragma unroll
        for (int ai = 0; ai < 2; ++ai)
#pragma unroll
            for (int m = 0; m < 4; ++m) sq[ai][m] = *(const f32x4*)(ssq16 + (size_t)(u.pm * BM + ai * HALF + wr * 64 + m * 16 + fr) * 16 + 4 * fq);
#pragma unroll
        for (int ai = 0; ai < 2; ++ai)
#pragma unroll
            for (int m = 0; m < 4; ++m) { const int rl = ai * HALF + wr * 64 + m * 16 + fr; float mx = -3.0e38f;
                const f32x4 st = sq[ai][m]; float t = (st[0] + st[1]) + (st[2] + st[3]); t = lsum16(t); t = lsum32(t);
                const float rs = frsq(t * (1.0f / D) + NORM_EPS);
#pragma unroll
                for (int bj = 0; bj < 2; ++bj)
#pragma unroll
                    for (int n = 0; n < 2; ++n) { const f32x4 v = acc[ai][bj][m][n] * rs; acc[ai][bj][m][n] = v; mx = fmaxf(mx, fmaxf(fmaxf(v[0], v[1]), fmaxf(v[2], v[3]))); }
                mx = fmaxf(mx, __shfl_xor(mx, 16)); mx = fmaxf(mx, __shfl_xor(mx, 32));
                if (fq == 0) MX[rl * 4 + wc] = mx; }
        RAW_BARRIER();
#pragma unroll
        for (int ai = 0; ai < 2; ++ai)
#pragma unroll
            for (int m = 0; m < 4; ++m) { const int rl = ai * HALF + wr * 64 + m * 16 + fr; const f32x4 mm = *(const LAS f32x4*)(MX + rl * 4);
                const float mx = fmaxf(fmaxf(mm[0], mm[1]), fmaxf(mm[2], mm[3])); float ss = 0.f;
#pragma unroll
                for (int bj = 0; bj < 2; ++bj)
#pragma unroll
                    for (int n = 0; n < 2; ++n) { f32x4 v = acc[ai][bj][m][n];
#pragma unroll
                        for (int i = 0; i < 4; ++i) { v[i] = __builtin_amdgcn_exp2f(v[i] - mx); ss += v[i]; }
                        acc[ai][bj][m][n] = v; }
                ss += __shfl_xor(ss, 16); ss += __shfl_xor(ss, 32);
                if (fq == 0) SM[rl * 4 + wc] = ss; }
        RAW_BARRIER();
        const int col0 = u.pn * BM + wc * 32 + fq * 8;
#pragma unroll
        for (int ai = 0; ai < 2; ++ai)
#pragma unroll
            for (int m = 0; m < 4; ++m) { const int rl = ai * HALF + wr * 64 + m * 16 + fr; const f32x4 s4 = *(const LAS f32x4*)(SM + rl * 4);
                const float inv = frcp((s4[0] + s4[1]) + (s4[2] + s4[3]));
#pragma unroll
                for (int bj = 0; bj < 2; ++bj) __builtin_nontemporal_store(pack8(acc[ai][bj][m][0] * inv, acc[ai][bj][m][1] * inv), (u32x4*)(PM + (size_t)(u.pm * BM + rl) * D + col0 + bj * HALF)); }
    }
};
struct EpiMoe1 {
    static constexpr bool PERM = true; EPI_NOMID
    bf16_t* HID; const float* slot_rs;
    __device__ __forceinline__ void operator()(Acc& acc, const Unit& u, int wr, int wc, int fr, int fq, LAS unsigned char*, int, int) const {
        const int row0 = u.pm * BM + wr * 64 + fr; float rsv[2][4];
#pragma unroll
        for (int ai = 0; ai < 2; ++ai)
#pragma unroll
            for (int m = 0; m < 4; ++m) rsv[ai][m] = slot_rs[row0 + ai * HALF + m * 16];
#pragma unroll
        for (int ai = 0; ai < 2; ++ai)
#pragma unroll
            for (int m = 0; m < 4; ++m) { const int row = row0 + ai * HALF + m * 16; const float rs = rsv[ai][m]; f32x4 o[2];
#pragma unroll
                for (int n = 0; n < 2; ++n)
#pragma unroll
                    for (int i = 0; i < 4; ++i) { const float a = acc[ai][0][m][n][i] * rs, b = acc[ai][1][m][n][i] * rs; o[n][i] = a * b * frcp(1.f + __expf(-a)); }
                *(u32x4*)(HID + (size_t)row * FF + u.pn * HALF + wc * 32 + fq * 8) = pack8(o[0], o[1]); }
    }
};
struct EpiMoe2 {
    static constexpr bool PERM = true; EPI_NOMID
    bf16_t* Y; const float* slot_gate;
    __device__ __forceinline__ void operator()(Acc& acc, const Unit& u, int wr, int wc, int fr, int fq, LAS unsigned char*, int, int) const {
        const int row0 = u.pm * BM + wr * 64 + fr, col0 = u.pn * BM + wc * 32 + fq * 8; float gv[2][4];
#pragma unroll
        for (int ai = 0; ai < 2; ++ai)
#pragma unroll
            for (int m = 0; m < 4; ++m) gv[ai][m] = slot_gate[row0 + ai * HALF + m * 16];
#pragma unroll
        for (int ai = 0; ai < 2; ++ai)
#pragma unroll
            for (int m = 0; m < 4; ++m) { const int row = row0 + ai * HALF + m * 16; const float g = gv[ai][m];
#pragma unroll
                for (int bj = 0; bj < 2; ++bj) __builtin_nontemporal_store(pack8(acc[ai][bj][m][0] * g, acc[ai][bj][m][1] * g), (u32x4*)(Y + (size_t)row * D + col0 + bj * HALF)); }
    }
};
}
struct Frame {
    LAS unsigned char* lds;
    volatile LAS unsigned* MISC;
    unsigned* ctl;
    unsigned char* ws;
    int wave, vcu, G;
};
struct Args { const void* in[27]; float* out; unsigned char* ws; int ph_lo, ph_hi, li, pad; };

__device__ __forceinline__ void tr_item(const float* W, int ldw, int srcrow0, int srccol0, bf16_t* WT, int dpitch, size_t drow0, int dk0, const float* gk, float sc, LAS float* scr, int lane) {
    f32x4 v[8]; const int n4 = lane & 7, kq = lane >> 3;
#pragma unroll
    for (int i = 0; i < 8; ++i) v[i] = __builtin_nontemporal_load((const f32x4*)(W + (size_t)(srcrow0 + kq + 8 * i) * ldw + srccol0 + 4 * n4));
#pragma unroll
    for (int i = 0; i < 8; ++i) { const int kk = kq + 8 * i; const float g = gk ? gk[kk] * sc : sc; LAS float* d = scr + kk * 33 + 4 * n4;
        d[0] = v[i][0] * g; d[1] = v[i][1] * g; d[2] = v[i][2] * g; d[3] = v[i][3] * g; }
    LDS_WAIT(); asm volatile("" ::: "memory");
    const int c = lane & 7;
#pragma unroll
    for (int j = 0; j < 4; ++j) { const int n = (lane >> 3) + 8 * j; const LAS float* s = scr + (8 * c) * 33 + n;
        u32x4 o; o.x = pk2(s[0 * 33], s[1 * 33]); o.y = pk2(s[2 * 33], s[3 * 33]); o.z = pk2(s[4 * 33], s[5 * 33]); o.w = pk2(s[6 * 33], s[7 * 33]);
        *(u32x4*)(WT + (drow0 + n) * dpitch + dk0 + 8 * c) = o; }
    LDS_WAIT(); asm volatile("" ::: "memory");
}
__device__ __forceinline__ void rms_row_to_bf16(const float* xrow, const float* g, bf16_t* orow, int lane) {
    const f32x4* xr = (const f32x4*)xrow + lane; const f32x4* gr = (const f32x4*)g + lane;
    f32x4 v[4]; float s = 0.f;
#pragma unroll
    for (int j = 0; j < 4; ++j) { v[j] = xr[64 * j]; s += (v[j][0] * v[j][0] + v[j][1] * v[j][1]) + (v[j][2] * v[j][2] + v[j][3] * v[j][3]); }
    const float rs = frsq(wave_sum(s) * (1.f / D) + NORM_EPS);
    u32x2* o8 = (u32x2*)orow + lane;
#pragma unroll
    for (int j = 0; j < 4; ++j) { const f32x4 gg = gr[64 * j]; u32x2 w; w.x = pk2(v[j][0] * rs * gg[0], v[j][1] * rs * gg[1]); w.y = pk2(v[j][2] * rs * gg[2], v[j][3] * rs * gg[3]); o8[64 * j] = w; }
}
__device__ __forceinline__ void x_row2_to_bf16(const float* xrow, bf16_t* orow, float* rs, int lane) {
    f32x4 v[2][2][2]; float ss[2] = {0.f, 0.f};
#pragma unroll
    for (int r = 0; r < 2; ++r)
#pragma unroll
        for (int c = 0; c < 2; ++c) { const float* p = xrow + (size_t)r * D + c * 512 + 8 * lane; v[r][c][0] = __builtin_nontemporal_load((const f32x4*)p); v[r][c][1] = __builtin_nontemporal_load((const f32x4*)(p + 4)); }
#pragma unroll
    for (int r = 0; r < 2; ++r)
#pragma unroll
        for (int c = 0; c < 2; ++c) { const f32x4 a = v[r][c][0], b = v[r][c][1]; u32x4 w;
            ss[r] += ((a[0] * a[0] + a[1] * a[1]) + (a[2] * a[2] + a[3] * a[3])) + ((b[0] * b[0] + b[1] * b[1]) + (b[2] * b[2] + b[3] * b[3]));
            w.x = pk2(a[0], a[1]); w.y = pk2(a[2], a[3]); w.z = pk2(b[0], b[1]); w.w = pk2(b[2], b[3]);
            *(u32x4*)(orow + (size_t)r * D + c * 512 + 8 * lane) = w; }
    const float r0 = frsq(wave_sum(ss[0]) * (1.f / D) + NORM_EPS), r1 = frsq(wave_sum(ss[1]) * (1.f / D) + NORM_EPS);
    if (lane == 0) *(f32x2*)rs = (f32x2){r0, r1};
}
__device__ __forceinline__ void rms_row2_to_bf16(const float* xrow, const float* g, bf16_t* orow, int lane) {
    f32x4 v[2][2][2]; float ss[2] = {0.f, 0.f};
#pragma unroll
    for (int r = 0; r < 2; ++r)
#pragma unroll
        for (int c = 0; c < 2; ++c) { const float* p = xrow + (size_t)r * D + c * 512 + 8 * lane; v[r][c][0] = *(const f32x4*)p; v[r][c][1] = *(const f32x4*)(p + 4); }
#pragma unroll
    for (int r = 0; r < 2; ++r)
#pragma unroll
        for (int c = 0; c < 2; ++c)
#pragma unroll
            for (int k = 0; k < 2; ++k) { const f32x4 x = v[r][c][k]; ss[r] += (x[0] * x[0] + x[1] * x[1]) + (x[2] * x[2] + x[3] * x[3]); }
    const float r0 = frsq(wave_sum(ss[0]) * (1.f / D) + NORM_EPS), r1 = frsq(wave_sum(ss[1]) * (1.f / D) + NORM_EPS);
#pragma unroll
    for (int c = 0; c < 2; ++c) { const f32x4 g0 = *(const f32x4*)(g + c * 512 + 8 * lane), g1 = *(const f32x4*)(g + c * 512 + 8 * lane + 4);
#pragma unroll
        for (int r = 0; r < 2; ++r) { const float rs = r ? r1 : r0; const f32x4 a = v[r][c][0] * rs * g0, b = v[r][c][1] * rs * g1; u32x4 w;
            w.x = pk2(a[0], a[1]); w.y = pk2(a[2], a[3]); w.z = pk2(b[0], b[1]); w.w = pk2(b[2], b[3]);
            *(u32x4*)(orow + (size_t)r * D + c * 512 + 8 * lane) = w; } }
}
__device__ __forceinline__ double rope_inv(int d) {
    const int q = d >> 3, r = d & 7;
    double b = 1.0;
    b = (r == 1) ? 0.7498942093324558273 : b; b = (r == 2) ? 0.56234132519034908039 : b; b = (r == 3) ? 0.42169650342858224857 : b; b = (r == 4) ? 0.3162277660168379332 : b;
    b = (r == 5) ? 0.23713737056616552617 : b; b = (r == 6) ? 0.17782794100389228012 : b; b = (r == 7) ? 0.13335214321633240257 : b;
    const double p = (q == 0) ? 1.0 : (q == 1) ? 0.1 : (q == 2) ? 0.01 : 0.001;
    return b * p;
}
__device__ __forceinline__ void sincos_d(double a, double& sn, double& cs) {
    const double k = __builtin_rint(a * 0.63661977236758134308);
    double y = __builtin_fma(-k, 1.57079632679489655800e+00, a); y = __builtin_fma(-k, 6.12323399573676603587e-17, y);
    const double y2 = y * y;
    double s = 1.0 / 6227020800.0; s = s * y2 - 1.0 / 39916800.0; s = s * y2 + 1.0 / 362880.0; s = s * y2 - 1.0 / 5040.0; s = s * y2 + 1.0 / 120.0; s = s * y2 - 1.0 / 6.0; s = s * y2 * y + y;
    double c = 1.0 / 479001600.0; c = c * y2 - 1.0 / 3628800.0; c = c * y2 + 1.0 / 40320.0; c = c * y2 - 1.0 / 720.0; c = c * y2 + 1.0 / 24.0; c = c * y2 - 0.5; c = c * y2 + 1.0;
    const int qd = ((int)k) & 3;
    sn = (qd == 0) ? s : (qd == 1) ? c : (qd == 2) ? -s : -c;
    cs = (qd == 0) ? c : (qd == 1) ? -s : (qd == 2) ? -c : s;
}
typedef const void* gen_cptr;
typedef __attribute__((address_space(4))) const char* cas_cptr;
typedef __attribute__((address_space(4))) const gen_cptr* cas_pptr;
__device__ __forceinline__ const void* karg_ptr(int byte_off) { cas_cptr p = (cas_cptr)__builtin_amdgcn_kernarg_segment_ptr(); asm volatile("" : "+s"(p)); return *(cas_pptr)(p + byte_off); }
__device__ __forceinline__ void p0_prologue(Frame& F) {
    const int lane = lane_id(), tid = F.wave * 64 + lane;
    const float* x = (const float*)karg_ptr(8 * 0); const float* mem = (const float*)karg_ptr(8 * 1); const int* positions = (const int*)karg_ptr(8 * 2);
    const float* mix_g = (const float*)karg_ptr(8 * 3); const float* w_in = (const float*)karg_ptr(8 * 4);
    const float* attn_out_g = (const float*)karg_ptr(8 * 10); const float* w_out = (const float*)karg_ptr(8 * 11);
    const float* xattn_g = (const float*)karg_ptr(8 * 12); const float* mem_g = (const float*)karg_ptr(8 * 13);
    const float* w_xq = (const float*)karg_ptr(8 * 14); const float* w_xk = (const float*)karg_ptr(8 * 15); const float* w_xv = (const float*)karg_ptr(8 * 16); const float* w_xo = (const float*)karg_ptr(8 * 17);
    const float* moe_g = (const float*)karg_ptr(8 * 18); const float* w_group = (const float*)karg_ptr(8 * 19); const float* w_router = (const float*)karg_ptr(8 * 21);
    const float* w1 = (const float*)karg_ptr(8 * 23); const float* w3 = (const float*)karg_ptr(8 * 24); const float* w2 = (const float*)karg_ptr(8 * 25);
    unsigned char* ws = F.ws;
    LAS float* scr = (LAS float*)(F.lds + F.wave * 16384);
    const int gw = F.vcu * NWAVES + F.wave, NGW = F.G * NWAVES;
    constexpr int I_IN = 16 * 88, I_SQ = 16 * 32, I_13 = NE * 16 * 32, I_2 = NE * 8 * 32;
    constexpr int NITEMS = I_IN + 5 * I_SQ + I_13 + I_2;
    for (int it = gw; it < NITEMS; it += NGW) {
        int r = it;
        if (r < I_IN) { const int kb = r / 88, nb = r % 88, n0 = 32 * nb, tile = n0 >> 8, j = n0 & 255; int src;
            if (tile < 2) src = (j < 128) ? 128 * tile + j : 256 + 128 * tile + (j - 128);
            else if (tile < 8) { const int sec = (tile - 2) / 3, tt = (tile - 2) % 3, jj = j & 127, hh = jj >> 5; src = 512 + 768 * sec + 256 * tt + 64 * hh + ((j < 128) ? 0 : 32); }
            else src = n0;
            tr_item(w_in, INW, 64 * kb, src, (bf16_t*)(ws + WS_WIN), D, (size_t)n0, 64 * kb, mix_g + 64 * kb, 1.f, scr, lane); continue; }
        r -= I_IN;
        if (r < I_SQ) { const int kb = r / 32, nb = r % 32, dk0 = 64 * kb; const bool at = dk0 < AW;
            tr_item(w_out, D, at ? CCH + dk0 : dk0 - AW, 32 * nb, (bf16_t*)(ws + WS_WOUT), D, (size_t)(32 * nb), dk0, at ? attn_out_g + dk0 : nullptr, 1.f, scr, lane); continue; }
        r -= I_SQ;
        if (r < 4 * I_SQ) { const int which = r / I_SQ, r2 = r % I_SQ, kb = r2 / 32, nb = r2 % 32;
            if (which == 0) {
                bf16_t* WQ2 = (bf16_t*)(ws + WS_WXQ); const int n4 = lane & 7, kq = lane >> 3;
#pragma unroll
                for (int i = 0; i < 8; ++i) { const int k = 64 * kb + kq + 8 * i; const f32x4 v = *(const f32x4*)(w_xq + (size_t)k * D + 32 * nb + 4 * n4); const float g = xattn_g[k] * (LOG2E / 16.f);
                    u32x2 o; o.x = pk2(v[0] * g, v[1] * g); o.y = pk2(v[2] * g, v[3] * g); *(u32x2*)(WQ2 + (size_t)k * D + 32 * nb + 4 * n4) = o; }
                continue; }
            const float* W = which == 1 ? w_xk : which == 2 ? w_xv : w_xo;
            bf16_t* WT = (bf16_t*)(ws + (which == 1 ? WS_WXK : which == 2 ? WS_WXV : WS_WXO));
            tr_item(W, D, 64 * kb, 32 * nb, WT, D, (size_t)(32 * nb), 64 * kb, nullptr, 1.f, scr, lane); continue; }
        r -= 4 * I_SQ;
        if (r < I_13) { const int e = r / 512, r2 = r % 512, kb = r2 / 32, nb = r2 % 32, n0 = 32 * nb, tt = n0 >> 8, j = n0 & 255;
            const float* W = ((j < 128) ? w1 : w3) + (size_t)e * D * FF;
            tr_item(W, FF, 64 * kb, 128 * tt + (j & 127), (bf16_t*)(ws + WS_W13), D, (size_t)e * 1024 + n0, 64 * kb, moe_g + 64 * kb, 1.f, scr, lane); continue; }
        r -= I_13;
        { const int e = r / 256, r2 = r % 256, kb = r2 / 32, nb = r2 % 32;
            tr_item(w2 + (size_t)e * FF * D, D, 64 * kb, 32 * nb, (bf16_t*)(ws + WS_W2), FF, (size_t)e * 1024 + 32 * nb, 64 * kb, nullptr, 1.f, scr, lane); }
    }
    { bf16_t* WRF = (bf16_t*)(ws + WS_HIST + HIST_WR);
      for (int i = blockIdx.x * 512 + tid; i < 4 * 8 * 3 * 2 * 64 * 8; i += F.G * 512) {
          const int j = i & 7, ln = (i >> 3) & 63, part = (i >> 9) & 1, blk = i >> 10, nt = blk % 3, s = (blk / 3) & 7, kc = blk / 24;
          const int k = 256 * kc + 32 * s + 8 * (ln >> 4) + j, o = 16 * nt + (ln & 15);
          float v = 0.f; if (o < 32) v = w_router[k * 32 + o] * moe_g[k]; else if (o < 36) v = w_group[k * 4 + (o - 32)] * moe_g[k];
          const unsigned hb = f2bf(v); const float hf = __builtin_bit_cast(float, hb << 16);
          WRF[i] = (bf16_t)(part ? f2bf(v - hf) : hb); } }
    { float* rc = (float*)(ws + WS_ROPE); float* rsn = rc + SEQ * 32;
      for (int i = blockIdx.x * 512 + tid; i < SEQ * 32; i += F.G * 512) { const int s = i >> 5, d = i & 31;
          const float inv = (float)rope_inv(d); const float ang = (float)positions[s] * inv; double sn, cs; sincos_d((double)fabsf(ang), sn, cs); if (ang < 0.f) sn = -sn;
          rc[i] = (float)cs; rsn[i] = (float)sn; } }
    for (int m = gw; m < MROWS; m += NGW) rms_row_to_bf16(mem + (size_t)m * D, mem_g, (bf16_t*)(ws + WS_MEMN) + (size_t)m * D, lane);
    for (int m = 2 * gw; m < T; m += 2 * NGW) x_row2_to_bf16(x + (size_t)m * D, (bf16_t*)(ws + WS_XB0) + (size_t)m * D, (float*)(ws + WS_SSQ2) + m, lane);
}
#ifndef D16_REP
#define D16_REP 1
#endif
namespace att {
typedef short v4i16_t __attribute__((ext_vector_type(4)));
constexpr float NEG = -1.0e30f, MFLOOR = -1.0e9f;

struct Grp { bf16x8 q0, q1; f32x4 o[4]; float m, l; };

__device__ __forceinline__ void swap16(float v, float& a, float& b) { a = v; b = v; asm volatile("s_nop 1\n\tv_permlane16_swap_b32 %0, %1" : "+v"(a), "+v"(b)); }
__device__ __forceinline__ void swap32(float v, float& a, float& b) { a = v; b = v; asm volatile("s_nop 1\n\tv_permlane32_swap_b32 %0, %1" : "+v"(a), "+v"(b)); }
__device__ __forceinline__ float xmax16(float v) { float a, b; swap16(v, a, b); return fmaxf(a, b); }
__device__ __forceinline__ float xmax32(float v) { float a, b; swap32(v, a, b); return fmaxf(a, b); }
__device__ __forceinline__ float xsum16(float v) { float a, b; swap16(v, a, b); return a + b; }
__device__ __forceinline__ float xsum32(float v) { float a, b; swap32(v, a, b); return a + b; }
__device__ __forceinline__ const LAS unsigned char* row_base(const LAS unsigned char* buf, int Rb) {
    return (const LAS unsigned char*)(uintptr_t)(unsigned)__builtin_amdgcn_readfirstlane((int)((unsigned)(uintptr_t)buf + (unsigned)(Rb * 128))); }
__device__ __forceinline__ float fmax3_nc(float a, float b, float c) { float r; asm("v_max3_f32 %0, %1, %2, %3" : "=v"(r) : "v"(a), "v"(b), "v"(c)); return r; }
__device__ __forceinline__ float fmax_nc(float a, float b) { float r; asm("v_max_f32_e32 %0, %1, %2" : "=v"(r) : "v"(a), "v"(b)); return r; }
__device__ __forceinline__ float fmax9_mfma(const f32x4& s0, const f32x4& s1, float m) { float r, t0, t1;
    asm("s_nop 11\n\tv_max3_f32 %1, %3, %4, %5\n\tv_max3_f32 %2, %6, %7, %8\n\tv_max3_f32 %0, %9, %10, %11\n\tv_max3_f32 %0, %0, %1, %2"
        : "=&v"(r), "=&v"(t0), "=&v"(t1) : "v"(s0[0]), "v"(s0[1]), "v"(s0[2]), "v"(s0[3]), "v"(s1[0]), "v"(s1[1]), "v"(s1[2]), "v"(s1[3]), "v"(m));
    return r; }
__device__ __forceinline__ void qk_part(const Grp& G, const bf16x8 (&k)[2][2], f32x4 (&s)[2]) {
#pragma unroll
    for (int t = 0; t < 2; ++t) { f32x4 z = (f32x4){0.f, 0.f, 0.f, 0.f};
        z = __builtin_amdgcn_mfma_f32_16x16x32_bf16(k[t][0], G.q0, z, 0, 0, 0); s[t] = __builtin_amdgcn_mfma_f32_16x16x32_bf16(k[t][1], G.q1, z, 0, 0, 0); }
}
template <bool FULL, bool INR>
__device__ __forceinline__ void sm_part(Grp& G, f32x4 (&s)[2], int ksub0, int qsub, int L, int lane, bf16x8& pb, float& alpha) {
    const int g = lane >> 4;
    if constexpr (!FULL) { const int d0 = ksub0 + 4 * g - qsub + 64, k0 = ksub0 + 4 * g;
#pragma unroll
        for (int t = 0; t < 2; ++t)
#pragma unroll
            for (int i = 0; i < 4; ++i) { bool ok = ((unsigned)(d0 + 16 * t + i) <= 128u); if constexpr (!INR) ok = ok && ((unsigned)(k0 + 16 * t + i) < (unsigned)L); s[t][i] = ok ? s[t][i] : NEG; } }
    float mx; if constexpr (FULL) mx = fmax9_mfma(s[0], s[1], G.m); else mx = fmax3_nc(fmax3_nc(s[0][0], s[0][1], s[0][2]), fmax3_nc(s[0][3], s[1][0], s[1][1]), fmax3_nc(s[1][2], s[1][3], G.m));
    { float a, b; swap16(mx, a, b); mx = fmax_nc(a, b); swap32(mx, a, b); mx = fmax_nc(a, b); }
    const float mn = mx; alpha = __builtin_amdgcn_exp2f(G.m - mn);
    G.m = mn; float p[2][4]; float ps = 0.f;
#pragma unroll
    for (int t = 0; t < 2; ++t)
#pragma unroll
        for (int i = 0; i < 4; ++i) { const float e = __builtin_amdgcn_exp2f(s[t][i] - mn); p[t][i] = e; ps += e; }
    G.l = G.l * alpha + ps;
    u32x4 pw; pw.x = cvt_pk_bf16(p[0][0], p[0][1]); pw.y = cvt_pk_bf16(p[0][2], p[0][3]); pw.z = cvt_pk_bf16(p[1][0], p[1][1]); pw.w = cvt_pk_bf16(p[1][2], p[1][3]);
    pb = __builtin_bit_cast(bf16x8, pw);
}
__device__ __forceinline__ void pv_part(Grp& G, const bf16x8 (&v)[4], const bf16x8& pb, float alpha) {
#pragma unroll
    for (int db = 0; db < 4; ++db) G.o[db] = __builtin_amdgcn_mfma_f32_16x16x32_bf16(v[db], pb, G.o[db] * alpha, 0, 0, 0);
}
#define ATT_SYNC() do { asm volatile("s_waitcnt vmcnt(0) lgkmcnt(0)" ::: "memory"); __builtin_amdgcn_s_barrier(); asm volatile("" ::: "memory"); } while (0)
#define ATT_SB() __builtin_amdgcn_sched_barrier(0)
constexpr int NVB = 49152;
__device__ __forceinline__ int vn_off(int row, int c) { return row * 128 + ((c ^ (((row >> 1) & 3) << 1)) << 4); }
template <int DIL>
__device__ __forceinline__ void nat_stage_v(unsigned ldsbuf, const char* Vg, int hrow0, int cres, int sub0, int wave, int lane) {
    constexpr int Ls = SEQ / DIL; const char* gb = pg8::uniform_ptr(Vg);
#pragma unroll
    for (int i = 0; i < 6; ++i) { const int blk = wave * 6 + i, row = 8 * blk + (lane >> 3), phys = lane & 7;
        const int c = phys ^ (((row >> 1) & 3) << 1);
        int sub = sub0 + row; sub = sub < 0 ? 0 : (sub > Ls - 1 ? Ls - 1 : sub);
        const unsigned voff = (unsigned)((hrow0 + cres + DIL * sub) * HD + c * 8) * 2u;
        pg8::glds16_sv(gb, voff, ldsbuf + (unsigned)blk * 1024u); __builtin_amdgcn_sched_barrier(0); }
}
template <int DIL>
__device__ __forceinline__ void nat_load_k1(bf16x8 (&k)[2][2], const bf16_t* Kb, int hrow0, int cres, int ksub, int lane) {
    constexpr int Ls = SEQ / DIL; const int key = lane & 15, g = lane >> 4;
#pragma unroll
    for (int t = 0; t < 2; ++t) { int sub = ksub + 16 * t + key; sub = sub < 0 ? 0 : (sub > Ls - 1 ? Ls - 1 : sub);
        const bf16_t* kp = Kb + (size_t)(hrow0 + cres + DIL * sub) * HD + 8 * g;
        k[t][0] = *(const bf16x8*)kp; k[t][1] = *(const bf16x8*)(kp + 32); }
}
template <bool FULL>
__device__ __forceinline__ void pair2n_post(Grp& GA, Grp& GB, f32x4 (&s0)[2], f32x4 (&s1)[2], const LAS unsigned char* vbuf, int Rb, const int (&vb)[4], int ks0, int qs, int Ls, int lane) {
    bf16x8 p0, p1; float a0, a1;
    bf16x8 v[4]; { const LAS unsigned char* rb = row_base(vbuf, Rb);
#pragma unroll
        for (int db = 0; db < 4; ++db) {
            const s16x4 v0 = __builtin_bit_cast(s16x4, __builtin_amdgcn_ds_read_tr16_b64_v4i16((LAS v4i16_t*)(rb + vb[db])));
            const s16x4 v1 = __builtin_bit_cast(s16x4, __builtin_amdgcn_ds_read_tr16_b64_v4i16((LAS v4i16_t*)(rb + 2048 + vb[db])));
            v[db] = (bf16x8){v0[0], v0[1], v0[2], v0[3], v1[0], v1[1], v1[2], v1[3]}; } }
    sm_part<FULL, true>(GA, s0, ks0, qs, Ls, lane, p0, a0); sm_part<FULL, true>(GB, s1, ks0, qs + 16, Ls, lane, p1, a1); ATT_SB();
    pv_part(GA, v, p0, a0); pv_part(GB, v, p1, a1); ATT_SB();
}
template <int DIL>
__device__ __forceinline__ void nat_load_k(bf16x8 (&k)[5][2][2], const bf16_t* Kb, int hrow0, int cres, int ksub_first, int lane) {
    constexpr int Ls = SEQ / DIL; const int key = lane & 15, g = lane >> 4;
#pragma unroll
    for (int p = 0; p < 5; ++p)
#pragma unroll
        for (int t = 0; t < 2; ++t) { int sub = ksub_first + 32 * p + 16 * t + key; sub = sub < 0 ? 0 : (sub > Ls - 1 ? Ls - 1 : sub);
            const bf16_t* kp = Kb + (size_t)(hrow0 + cres + DIL * sub) * HD + 8 * g;
            k[p][t][0] = *(const bf16x8*)kp; k[p][t][1] = *(const bf16x8*)(kp + 32); }
}
__device__ __forceinline__ size_t ml_index(size_t tok, int h) { const unsigned b = (unsigned)(tok >> 12), sp = (unsigned)tok & (SEQ - 1);
    const unsigned idx = (sp & ~63u) | ((sp & 3u) << 4) | ((sp >> 2) & 15u); return ((size_t)(b * NH + h) * SEQ + idx) * 2; }
template <int DIL, bool FIRST>
__device__ __forceinline__ void nat_init_state(Grp& G, const bf16_t* MIX, const float* ml, size_t tok0, int h, int lane) {
    const int a = lane & 15, g = lane >> 4;
    if constexpr (FIRST) {
#pragma unroll
        for (int d = 0; d < 4; ++d) G.o[d] = (f32x4){0.f, 0.f, 0.f, 0.f};
        G.m = MFLOOR; G.l = 0.f;
    } else { const size_t tok = tok0 + DIL * a; const f32x2 st = *(const f32x2*)(ml + ml_index(tok, h));
        G.m = st[0]; G.l = st[1] * 0.25f;
#pragma unroll
        for (int d2 = 0; d2 < 2; ++d2) { const u32x4 w = *(const u32x4*)(MIX + tok * D + h * HD + 16 * g + 8 * d2);
            G.o[2 * d2] = (f32x4){bflo(w.x), bfhi(w.x), bflo(w.y), bfhi(w.y)} * st[1]; G.o[2 * d2 + 1] = (f32x4){bflo(w.z), bfhi(w.z), bflo(w.w), bfhi(w.w)} * st[1]; } }
}
template <int DIL, bool LAST>
__device__ __forceinline__ void nat_finish(Grp& G, bf16_t* MIX, float* ml, float* ssqa, size_t tok0, int h, int lane) {
    const int a = lane & 15, g = lane >> 4; float l = G.l; l = xsum16(l); l = xsum32(l);
    const float inv = frcp(l); const size_t tok = tok0 + DIL * a; float ss = 0.f;
    if constexpr (LAST) {
#pragma unroll
        for (int d2 = 0; d2 < 2; ++d2) { u32x2 w[2];
#pragma unroll
            for (int k = 0; k < 2; ++k) { const f32x4 o = G.o[2 * d2 + k] * inv; ss += (o[0] * o[0] + o[1] * o[1]) + (o[2] * o[2] + o[3] * o[3]); w[k].x = cvt_pk_bf16(o[0], o[1]); w[k].y = cvt_pk_bf16(o[2], o[3]); }
            asm volatile("s_nop 1\n\tv_permlane16_swap_b32 %0, %2\n\tv_permlane16_swap_b32 %1, %3" : "+v"(w[0].x), "+v"(w[0].y), "+v"(w[1].x), "+v"(w[1].y));
            *(u32x4*)(MIX + tok * D + h * HD + 16 * (2 * d2 + (g & 1)) + 4 * (g & 2)) = (u32x4){w[0].x, w[0].y, w[1].x, w[1].y}; }
        ss = xsum16(ss); ss = xsum32(ss); if (g == 0) ssqa[tok * NH + h] = ss;
    } else {
#pragma unroll
        for (int d2 = 0; d2 < 2; ++d2) { const f32x4 o0 = G.o[2 * d2] * inv, o1 = G.o[2 * d2 + 1] * inv; u32x4 w;
            w.x = cvt_pk_bf16(o0[0], o0[1]); w.y = cvt_pk_bf16(o0[2], o0[3]); w.z = cvt_pk_bf16(o1[0], o1[1]); w.w = cvt_pk_bf16(o1[2], o1[3]);
            *(u32x4*)(MIX + tok * D + h * HD + 16 * g + 8 * d2) = w; }
        if (g == 0) *(f32x2*)(ml + ml_index(tok, h)) = (f32x2){G.m, l};
    }
}
template <int DIL, bool FIRST, bool LAST>
__device__ __forceinline__ void nat_pass(LAS unsigned char* lds, const bf16_t* Qb, const bf16_t* Kb, const bf16_t* Vb, bf16_t* MIX, float* ml, float* ssqa, int vcu, int G_, int dup, int wave, int lane_, const bool rev = false) {
    constexpr int Ls = SEQ / DIL, NCH = Ls / 256, NT = NB * NH * 16;
    const unsigned lds0 = (unsigned)(uintptr_t)lds;
    bf16x8 kf[5][2][2], qn[4];
    ATT_SYNC();
    if (vcu < NT * dup) { int ln = lane_; asm volatile("" : "+v"(ln)); const int L = rev ? NT - 1 - vcu % NT : vcu % NT, sub = L & 15, bh = L >> 4, cres = sub / NCH, l0 = 256 * (sub % NCH);
        nat_load_k<DIL>(kf, Kb, bh * SEQ, cres, l0 + 32 * wave - 64, ln);
        { const int a = ln & 15, g = ln >> 4; const bf16_t* qp = Qb + ((size_t)(bh * SEQ + cres + DIL * (l0 + 32 * wave)) + DIL * a) * HD + 8 * g;
          qn[0] = *(const bf16x8*)qp; qn[1] = *(const bf16x8*)(qp + 32); qn[2] = *(const bf16x8*)(qp + 16 * DIL * HD); qn[3] = *(const bf16x8*)(qp + 16 * DIL * HD + 32); }
        nat_stage_v<DIL>(lds0, (const char*)Vb, bh * SEQ, cres, l0 - 64, wave, ln); }
    asm volatile("s_waitcnt vmcnt(0)" ::: "memory");
    int it = 0;
#pragma nounroll
    for (int L0 = vcu; L0 < NT * dup; L0 += G_, ++it) {
        const int L = rev ? NT - 1 - L0 % NT : L0 % NT, sub = L & 15, bh = L >> 4, b = bh / NH, h = bh % NH, cres = sub / NCH, l0 = 256 * (sub % NCH);
        asm volatile("s_waitcnt vmcnt(16) lgkmcnt(0)" ::: "memory"); __builtin_amdgcn_s_barrier(); asm volatile("" ::: "memory");
        int ln = lane_; asm volatile("" : "+v"(ln));
        const bool has_next = L0 + G_ < NT * dup; const int Ln = rev ? NT - 1 - (L0 + G_) % NT : (L0 + G_) % NT, subn = Ln & 15, bhn = Ln >> 4, cresn = subn / NCH, l0n = 256 * (subn % NCH);
        const LAS unsigned char* vbuf = lds + (it & 1) * NVB;
        const int a = ln & 15, g = ln >> 4, q = (ln >> 2) & 3, p2 = ln & 3;
        int vb[4];
#pragma unroll
        for (int db = 0; db < 4; ++db) vb[db] = vn_off(4 * g + q, 2 * db + (p2 >> 1)) + 8 * (p2 & 1);
        Grp GA, GB; const int pos0 = cres + DIL * (l0 + 32 * wave);
        const size_t tokA = (size_t)(b * SEQ + pos0);
        GA.q0 = qn[0]; GA.q1 = qn[1]; GB.q0 = qn[2]; GB.q1 = qn[3];
        nat_init_state<DIL, FIRST>(GA, MIX, ml, tokA, h, ln); nat_init_state<DIL, FIRST>(GB, MIX, ml, tokA + 16 * DIL, h, ln);
        if constexpr (!FIRST) asm volatile("s_waitcnt vmcnt(0)" ::: "memory");
        if (has_next) { nat_stage_v<DIL>(lds0 + (unsigned)(((it + 1) & 1) * NVB), (const char*)Vb, bhn * SEQ, cresn, l0n - 64, wave, ln);
            const bf16_t* qp = Qb + ((size_t)(bhn * SEQ + cresn + DIL * (l0n + 32 * wave)) + DIL * a) * HD + 8 * g;
            qn[0] = *(const bf16x8*)qp; qn[1] = *(const bf16x8*)(qp + 32); qn[2] = *(const bf16x8*)(qp + 16 * DIL * HD); qn[3] = *(const bf16x8*)(qp + 16 * DIL * HD + 32); }
        const int qs = l0 + 32 * wave + a;
#pragma unroll
        for (int p = 0; p < 5; ++p) { const int ks0 = l0 + 32 * wave - 64 + 32 * p; const bool act = (ks0 >= 0 && ks0 < Ls);
            f32x4 s0[2], s1[2];
            if (act) { qk_part(GA, kf[p], s0); qk_part(GB, kf[p], s1); ATT_SB(); }
            if (has_next) nat_load_k1<DIL>(kf[p], Kb, bhn * SEQ, cresn, l0n + 32 * wave - 64 + 32 * p, ln);
            if (act) { const int ql = l0 + 32 * wave; const bool full = (ks0 + 31 - ql <= 64) && (ql + 31 - ks0 <= 64);
#pragma nounroll
                for (int rep_ = 0; rep_ < D16_REP; ++rep_) {
                    f32x4 t0[2] = {s0[0], s0[1]}, t1[2] = {s1[0], s1[1]};
                    if (full) pair2n_post<true>(GA, GB, t0, t1, vbuf, 32 * wave + 32 * p, vb, ks0, qs, Ls, ln); else pair2n_post<false>(GA, GB, t0, t1, vbuf, 32 * wave + 32 * p, vb, ks0, qs, Ls, ln); } } }
        nat_finish<DIL, LAST>(GA, MIX, ml, ssqa, tokA, h, ln); nat_finish<DIL, LAST>(GB, MIX, ml, ssqa, tokA + 16 * DIL, h, ln);
    }
}
__device__ __forceinline__ void conv_units(LAS unsigned char* lds, const bf16_t* Cb, bf16_t* MIX, const float* dw_w, const float* dw_b, const float* ln_g, const float* ln_b, const float* out_g,
                                           int vcu, int G_, int nunits, int tid_, int wave, int lane_) {
    int tid = tid_, lane = lane_; asm volatile("" : "+v"(tid), "+v"(lane));
    LAS bf16_t* CT = (LAS bf16_t*)lds;
    LAS float* CO = (LAS float*)(lds + 49152);
#define CONV_LBAR() do { asm volatile("s_waitcnt lgkmcnt(0)" ::: "memory"); __builtin_amdgcn_s_barrier(); asm volatile("" ::: "memory"); } while (0)
    if (vcu >= nunits) return;
    const int chp = tid & 127, qt = tid >> 7; f32x2 w[CONVK];
#pragma unroll
    for (int k = 0; k < CONVK; ++k) w[k] = *(const f32x2*)(dw_w + k * CCH + 2 * chp);
    const f32x2 bias = *(const f32x2*)(dw_b + 2 * chp);
    const f32x4 g4 = *((const f32x4*)ln_g + lane), b4 = *((const f32x4*)ln_b + lane), og = *((const f32x4*)out_g + lane);
    u32x4 pf[6];
#define CONV_FETCH(Lx) do { const int b_ = ((Lx) % (NB * 64)) >> 6, s0_ = (((Lx) % (NB * 64)) & 63) * 64; _Pragma("unroll") for (int i = 0; i < 6; ++i) { const int p = tid + 512 * i, row = p >> 5, c = p & 31, sq = s0_ - 15 + row; \
        pf[i] = (u32x4){0u, 0u, 0u, 0u}; if (p < 94 * 32 && sq >= 0 && sq < SEQ) pf[i] = *(const u32x4*)(Cb + (size_t)(b_ * SEQ + sq) * CCH + c * 8); } } while (0)
    CONV_FETCH(vcu);
    ATT_SYNC();
#pragma nounroll
    for (int L0 = vcu; L0 < nunits; L0 += G_) { const int L = L0 % (NB * 64), b = L >> 6, s0 = (L & 63) * 64;
        CONV_LBAR();
#pragma unroll
        for (int i = 0; i < 6; ++i) { const int p = tid + 512 * i; if (p < 94 * 32) *(LAS u32x4*)(CT + (p >> 5) * CCH + (p & 31) * 8) = pf[i]; }
        { const int Ln = L0 + G_ < nunits ? L0 + G_ : L0; CONV_FETCH(Ln); }
        CONV_LBAR();
        { f32x2 v[46];
#pragma unroll
          for (int i = 0; i < 46; ++i) { const unsigned u = *(const LAS unsigned*)(CT + (16 * qt + i) * CCH + 2 * chp); v[i] = (f32x2){bflo(u), bfhi(u)}; }
#pragma unroll
          for (int p = 0; p < 16; ++p) { f32x2 acc = bias;
#pragma unroll
              for (int k = 0; k < CONVK; ++k) acc = v[p + k] * w[k] + acc;
              *(LAS f32x2*)(CO + (16 * qt + p) * CCH + 2 * chp) = acc; } }
        CONV_LBAR();
#pragma unroll
        for (int pp = 0; pp < 8; ++pp) { const int p = wave * 8 + pp; const f32x4 xv = *(const LAS f32x4*)(CO + p * CCH + 4 * lane);
            const float mean = wave_sum_dpp((xv[0] + xv[1]) + (xv[2] + xv[3])) * (1.f / CCH); const f32x4 dx = xv - mean;
            const float var = wave_sum_dpp((dx[0] * dx[0] + dx[1] * dx[1]) + (dx[2] * dx[2] + dx[3] * dx[3])) * (1.f / CCH); const float rstd = frsq(var + LN_EPS);
            f32x4 z;
#pragma unroll
            for (int i = 0; i < 4; ++i) { const float y = dx[i] * rstd * g4[i] + b4[i]; z[i] = y * frcp(1.f + __expf(-y)); }
            const float ms = wave_sum_dpp((z[0] * z[0] + z[1] * z[1]) + (z[2] * z[2] + z[3] * z[3])) * (1.f / CCH); const float rs = frsq(ms + NORM_EPS);
            u32x2 o; o.x = cvt_pk_bf16(z[0] * rs * og[0], z[1] * rs * og[1]); o.y = cvt_pk_bf16(z[2] * rs * og[2], z[3] * rs * og[3]);
            *(u32x2*)(MIX + (size_t)(b * SEQ + s0 + p) * D + AW + 4 * lane) = o; }
    }
#undef CONV_FETCH
#undef CONV_LBAR
}
}
namespace moe {
#define MOE_SYNC() do { asm volatile("s_waitcnt vmcnt(0) lgkmcnt(0)" ::: "memory"); __builtin_amdgcn_s_barrier(); asm volatile("" ::: "memory"); } while (0)
__device__ __forceinline__ void split_hi_lo(const f32x4& a, const f32x4& b, bf16x8& hi, bf16x8& lo) {
    u32x4 h, l; float r[8];
    h.x = cvt_pk_bf16(a[0], a[1]); h.y = cvt_pk_bf16(a[2], a[3]); h.z = cvt_pk_bf16(b[0], b[1]); h.w = cvt_pk_bf16(b[2], b[3]);
    r[0] = a[0] - bflo(h.x); r[1] = a[1] - bfhi(h.x); r[2] = a[2] - bflo(h.y); r[3] = a[3] - bfhi(h.y);
    r[4] = b[0] - bflo(h.z); r[5] = b[1] - bfhi(h.z); r[6] = b[2] - bflo(h.w); r[7] = b[3] - bfhi(h.w);
    l.x = cvt_pk_bf16(r[0], r[1]); l.y = cvt_pk_bf16(r[2], r[3]); l.z = cvt_pk_bf16(r[4], r[5]); l.w = cvt_pk_bf16(r[6], r[7]);
    hi = __builtin_bit_cast(bf16x8, h); lo = __builtin_bit_cast(bf16x8, l);
}
__device__ __forceinline__ void route_chunk(LAS unsigned char* lds, const bf16_t* x2, const float* ssq2, const bf16_t* WRF, const float* b_router, const float* b_group,
                                            int* tok_e, float* tok_gate, float* tok_rs, int* hist, int chunk, int tid, int wave, int lane) {
    LAS unsigned char* WB = lds;
    LAS float* LG = (LAS float*)(lds + 49152);
    LAS int* HS = (LAS int*)(lds + 49152 + 36864);
    const int tk = lane & 15, g = lane >> 4;
    f32x4 acc[2][3];
#pragma unroll
    for (int gi = 0; gi < 2; ++gi)
#pragma unroll
        for (int nt = 0; nt < 3; ++nt) acc[gi][nt] = (f32x4){0.f, 0.f, 0.f, 0.f};
    if (tid < 32) HS[tid] = 0;
    const bf16_t* xb = x2 + (size_t)(chunk * 256 + wave * 32 + tk) * D + 8 * g;
#define MOE_LBAR() do { asm volatile("s_waitcnt lgkmcnt(0)" ::: "memory"); __builtin_amdgcn_s_barrier(); asm volatile("" ::: "memory"); } while (0)
    bf16x8 xa0[8], xa1[8]; u32x4 wv[6];
#define MOE_LOADX(dst, kc, gi) do { _Pragma("unroll") for (int s_ = 0; s_ < 8; ++s_) dst[s_] = *(const bf16x8*)(xb + (size_t)(gi) * 16 * D + (kc) * 256 + s_ * 32); } while (0)
#define MOE_LOADW(kc) do { _Pragma("unroll") for (int i = 0; i < 6; ++i) wv[i] = *(const u32x4*)((const char*)WRF + (size_t)(kc) * 49152 + (tid + 512 * i) * 16); } while (0)
#define MOE_MMA(gi, xs) do { _Pragma("unroll") for (int s = 0; s < 8; ++s) { _Pragma("unroll") for (int nt = 0; nt < 3; ++nt) { const LAS unsigned char* bp = WB + ((s * 3 + nt) * 2) * 1024 + lane * 16; \
        const bf16x8 bh = *(const LAS bf16x8*)bp, bl = *(const LAS bf16x8*)(bp + 1024); \
        acc[gi][nt] = __builtin_amdgcn_mfma_f32_16x16x32_bf16(xs[s], bh, acc[gi][nt], 0, 0, 0); acc[gi][nt] = __builtin_amdgcn_mfma_f32_16x16x32_bf16(xs[s], bl, acc[gi][nt], 0, 0, 0); } } } while (0)
    MOE_SYNC();
    MOE_LOADX(xa0, 0, 0); MOE_LOADW(0);
#pragma nounroll
    for (int kc = 0; kc < 4; ++kc) { const int kn = kc < 3 ? kc + 1 : kc;
        MOE_LBAR();
#pragma unroll
        for (int i = 0; i < 6; ++i) *(LAS u32x4*)(WB + (tid + 512 * i) * 16) = wv[i];
        MOE_LOADW(kn); MOE_LOADX(xa1, kc, 1);
        MOE_LBAR();
        MOE_MMA(0, xa0);
        MOE_LOADX(xa0, kn, 0);
        MOE_MMA(1, xa1);
    }
#undef MOE_MMA
#undef MOE_LOADX
#undef MOE_LOADW
#pragma unroll
    for (int gi = 0; gi < 2; ++gi)
#pragma unroll
        for (int nt = 0; nt < 3; ++nt) { const int o = 16 * nt + tk;
            if (o < 36) {
#pragma unroll
                for (int r = 0; r < 4; ++r) LG[(wave * 32 + gi * 16 + 4 * g + r) * 36 + o] = acc[gi][nt][r]; } }
    MOE_SYNC();
    if (wave < 4) { const int tr = wave * 64 + lane, tg = chunk * 256 + tr; const LAS float* lg = LG + tr * 36;
        const f32x4* sp = (const f32x4*)(ssq2 + (size_t)tg * 16); const f32x4 st = (sp[0] + sp[1]) + (sp[2] + sp[3]);
        const float rs = frsq(((st[0] + st[1]) + (st[2] + st[3])) * (1.f / D) + NORM_EPS);
        tok_rs[tg] = rs;
        float gl[4];
#pragma unroll
        for (int j = 0; j < 4; ++j) gl[j] = lg[32 + j] * rs + b_group[j];
        float gm = gl[0]; int gi = 0;
#pragma unroll
        for (int j = 1; j < 4; ++j) { if (gl[j] > gm) { gm = gl[j]; gi = j; } }
        float den = 0.f;
#pragma unroll
        for (int j = 0; j < 4; ++j) den += __expf(gl[j] - gm);
        const float gp = 1.0f / den;
        float v0 = -3.0e38f, v1 = -3.0e38f; int i0 = 0, i1 = 0;
#pragma unroll
        for (int j = 0; j < 8; ++j) { const float v = lg[gi * 8 + j] * rs + b_router[gi * 8 + j];
            if (v > v0) { v1 = v0; i1 = i0; v0 = v; i0 = j; } else if (v > v1) { v1 = v; i1 = j; } }
        const float dd = __expf(v1 - v0), g0 = gp / (1.f + dd), g1 = gp * dd / (1.f + dd);
        const int e0 = gi * 8 + i0, e1 = gi * 8 + i1;
        __hip_atomic_fetch_add(HS + e0, 1, __ATOMIC_RELAXED, __HIP_MEMORY_SCOPE_WORKGROUP); __hip_atomic_fetch_add(HS + e1, 1, __ATOMIC_RELAXED, __HIP_MEMORY_SCOPE_WORKGROUP);
        tok_e[tg] = e0 | (e1 << 8); tok_gate[2 * tg] = g0; tok_gate[2 * tg + 1] = g1; }
    MOE_SYNC();
    if (tid < 32) hist[chunk * 32 + tid] = HS[tid];
}
__device__ __forceinline__ void slot_chunk(LAS unsigned char* lds, const int* hist, const int* tok_e, const float* tok_gate, const float* tok_rs, int* tok_slot, int* row_tok, float* slot_rs, float* slot_gate, int* etile,
                                           int chunk, int tid, int wave, int lane) {
    LAS int* CNT = (LAS int*)lds; LAS int* BASE = CNT + 32; LAS int* PST = CNT + 64; LAS int* WC = CNT + 128;
    MOE_SYNC();
    { LAS int* PT = CNT + 512;
      const int e = tid & 31, part = tid >> 5; int tot = 0, bs = 0;
#pragma unroll
      for (int j = 0; j < 16; ++j) { const int cc = part * 16 + j; const int hh = hist[cc * 32 + e]; bs += (cc < chunk) ? hh : 0; tot += hh; }
      PT[(part * 2 + 0) * 32 + e] = tot; PT[(part * 2 + 1) * 32 + e] = bs; }
    MOE_SYNC();
    if (tid < 32) { LAS int* PT = CNT + 512; int tot = 0, bs = 0;
#pragma unroll
        for (int part = 0; part < 16; ++part) { tot += PT[(part * 2 + 0) * 32 + tid]; bs += PT[(part * 2 + 1) * 32 + tid]; }
        CNT[tid] = tot; BASE[tid] = bs; }
    MOE_SYNC();
    if (tid == 0) { int ps = 0; for (int e = 0; e < 32; ++e) { PST[e] = ps; ps += ((CNT[e] + 255) >> 8) << 8; } PST[32] = ps; }
    MOE_SYNC();
    int ek[2] = {0, 0}, rank[2] = {0, 0}; const int t = chunk * 256 + (wave & 3) * 64 + lane;
    if (wave < 4) { const int ev = tok_e[t]; ek[0] = ev & 255; ek[1] = ev >> 8;
#pragma unroll
        for (int k = 0; k < 2; ++k)
#pragma nounroll
            for (int e = 0; e < 32; ++e) { const unsigned long long m = __ballot(ek[k] == e);
                if (ek[k] == e) rank[k] = __popcll(m & ((1ull << lane) - 1ull));
                if (lane == 0) WC[(k * 4 + wave) * 32 + e] = __popcll(m); } }
    MOE_SYNC();
    if (wave < 4) {
#pragma unroll
        for (int k = 0; k < 2; ++k) { int off = 0;
            for (int kw = 0; kw < k * 4 + wave; ++kw) off += WC[kw * 32 + ek[k]];
            const int slot = PST[ek[k]] + BASE[ek[k]] + off + rank[k];
            row_tok[slot] = t; slot_rs[slot] = tok_rs[t]; slot_gate[slot] = tok_gate[2 * t + k]; tok_slot[2 * t + k] = slot; } }
    if (chunk < 32) { const int e = chunk, c0 = PST[e] + CNT[e], n = PST[e + 1] - c0;
        for (int i = tid; i < n; i += NWAVES * 64) { row_tok[c0 + i] = 0; slot_rs[c0 + i] = 0.f; slot_gate[c0 + i] = 0.f; } }
    if (chunk == 0 && tid <= 32) etile[tid] = PST[tid] >> 8;
}
__device__ __forceinline__ void unpack8(const u32x4& w, float (&f)[8]) { f[0] = bflo(w.x); f[1] = bfhi(w.x); f[2] = bflo(w.y); f[3] = bfhi(w.y); f[4] = bflo(w.z); f[5] = bfhi(w.z); f[6] = bflo(w.w); f[7] = bfhi(w.w); }
__device__ __forceinline__ void final_row2(float* xo, const bf16_t* X2, const bf16_t* Y, const int (&sl)[4], const float* g, int t, int lane) {
    const int s00 = sl[0], s01 = sl[1], s10 = sl[2], s11 = sl[3];
    u32x4 xw[2][2], aw[2][2], bw[2][2];
#pragma unroll
    for (int r = 0; r < 2; ++r) { const int sa = r ? s10 : s00, sb = r ? s11 : s01;
#pragma unroll
        for (int c = 0; c < 2; ++c) { const size_t e = (size_t)c * 512 + 8 * lane;
            xw[r][c] = *(const u32x4*)(X2 + (size_t)(t + r) * D + e); aw[r][c] = *(const u32x4*)(Y + (size_t)sa * D + e); bw[r][c] = *(const u32x4*)(Y + (size_t)sb * D + e); } }
    f32x4 gg[2][2];
#pragma unroll
    for (int c = 0; c < 2; ++c) { gg[c][0] = *(const f32x4*)(g + c * 512 + 8 * lane); gg[c][1] = *(const f32x4*)(g + c * 512 + 8 * lane + 4); }
#pragma unroll
    for (int r = 0; r < 2; ++r) { float v[2][8]; float ss = 0.f;
#pragma unroll
        for (int c = 0; c < 2; ++c) { float x[8], a[8], b[8]; unpack8(xw[r][c], x); unpack8(aw[r][c], a); unpack8(bw[r][c], b);
#pragma unroll
            for (int i = 0; i < 8; ++i) { v[c][i] = x[i] + (a[i] + b[i]); ss += v[c][i] * v[c][i]; } }
        const float rs = frsq(wave_sum(ss) * (1.f / D) + NORM_EPS);
#pragma unroll
        for (int c = 0; c < 2; ++c) { float* o = xo + (size_t)(t + r) * D + c * 512 + 8 * lane;
            *(f32x4*)o = (f32x4){v[c][0], v[c][1], v[c][2], v[c][3]} * rs * gg[c][0]; *(f32x4*)(o + 4) = (f32x4){v[c][4], v[c][5], v[c][6], v[c][7]} * rs * gg[c][1]; } }
}
}
#ifndef MK_N_LAUNCHES
#define MK_N_LAUNCHES 1
#endif
constexpr int NPH = 11;
constexpr int N_LAUNCHES = MK_N_LAUNCHES;

#define ARG_IN(k) karg_ptr(8 * (k))
#define ARG_OUT ((float*)karg_ptr(8 * 27))
#define ARG_WS ((unsigned char*)karg_ptr(8 * 28))
#ifndef STAG_TICKS
#define STAG_TICKS 0
#endif
__device__ __forceinline__ void phase_stagger(int ticks) {
    if (STAG_TICKS > 0 && (blockIdx.x & 1)) { const unsigned long long t0 = __builtin_amdgcn_s_memrealtime(); while (__builtin_amdgcn_s_memrealtime() - t0 < (unsigned long long)ticks) __builtin_amdgcn_s_sleep(8); }
}
template <int LO, int HI>
__global__ void __launch_bounds__(NWAVES * 64, 2) mega_fwd(Args args) {
    extern __shared__ __attribute__((aligned(16))) unsigned char lds_raw[];
    Frame F;
    F.lds = (LAS unsigned char*)lds_raw;
    F.MISC = (volatile LAS unsigned*)(F.lds + LDSCTL_OFF);
    F.wave = __builtin_amdgcn_readfirstlane((int)threadIdx.x >> 6);
    F.G = gridDim.x; { const int bx = blockIdx.x; F.vcu = (F.G % 8 == 0) ? (bx % 8) * (F.G / 8) + bx / 8 : bx; }
    F.ws = ARG_WS; F.ctl = (unsigned*)(ARG_WS + WS_CTL);
    for (int u = threadIdx.x; u < (LDS_BYTES - LDSCTL_OFF) / 4; u += NWAVES * 64) ((LAS unsigned*)(F.lds + LDSCTL_OFF))[u] = 0u;
    __syncthreads();
    XcdBarrier bar; bar.bar = F.ctl + CW_BAR; bar.x = 0; bar.st = nullptr;
    if (HI - LO > 1) bar = xcd_barrier_post(F.ctl + CW_BAR, F.MISC + 8);
#define GRID_BAR() do { if (HI - LO > 1) xcd_barrier(bar); } while (0)
#ifndef PH_MASK
#define PH_MASK 0x7ff
#endif
#define IN(k) ((((PH_MASK) >> (k)) & 1) && LO <= (k) && (k) < HI)
#define BOTH(k) (IN(k) && IN((k) + 1))
#ifndef DUP_PHASE
#define DUP_PHASE -1
#endif
#define DUPF(k) ((k) == DUP_PHASE ? 2 : 1)
    const int gw = F.vcu * NWAVES + F.wave, NGW = F.G * NWAVES;
#define R1 ((bf16_t*)(ARG_WS + WS_R1))
#define R2 ((bf16_t*)(ARG_WS + WS_R2))
#define XBP ((bf16_t*)(ARG_WS + WS_XB0))
#define ssqa ((float*)(ARG_WS + WS_SSQA))
#define ssq1 ((float*)(ARG_WS + WS_SSQ1))
#define ssq2 ((float*)(ARG_WS + WS_SSQ2))
#define tok_e ((int*)(ARG_WS + WS_TOK + TK_E))
#define tok_gate ((float*)(ARG_WS + WS_TOK + TK_GATE))
#define tok_slot ((int*)(ARG_WS + WS_TOK + TK_SLOT))
#define tok_rs ((float*)(ARG_WS + WS_TOK + TK_RS))
#define row_tok ((int*)(ARG_WS + WS_TOK + TK_ROWTOK))
#define slot_rs ((float*)(ARG_WS + WS_TOK + TK_SLOTRS))
#define slot_gate ((float*)(ARG_WS + WS_TOK + TK_SLOTGATE))
#define hist ((int*)(ARG_WS + WS_HIST))
#define etile ((int*)(ARG_WS + WS_HIST + HIST_ETILE))
#define WR ((const bf16_t*)(ARG_WS + WS_HIST + HIST_WR))

    if (IN(0)) { p0_prologue(F); if (DUPF(0) == 2) { asm volatile("s_waitcnt vmcnt(0)" ::: "memory"); __syncthreads(); p0_prologue(F); } if (BOTH(0)) GRID_BAR(); }

    if (IN(1)) {
        phase_stagger(STAG_TICKS);
        { pg8::KvOrder S{(const char*)(ARG_WS + WS_MEMN), (const char*)(ARG_WS + WS_WXK), (const char*)(ARG_WS + WS_WXV), F.G, (int)blockIdx.x};
          pg8::EpiPlain<false> E{(bf16_t*)(ARG_WS + WS_KX), D, (bf16_t*)(ARG_WS + WS_VX), D, nullptr};
          pg8::gemm_phase<pg8::EpiPlain<false>, pg8::KvOrder, true, false>(F.lds, F.wave, D, D, D, S, E); }
        { pg8::GridOrder S; S.init(ARG_WS + WS_XB0, ARG_WS + WS_WIN, D, D, T, INW, F.G, (int)blockIdx.x); S.dup = DUPF(1);
          pg8::EpiU E{R2, (bf16_t*)(ARG_WS + WS_Q), (bf16_t*)(ARG_WS + WS_K), (bf16_t*)(ARG_WS + WS_V), (const float*)(ARG_WS + WS_ROPE), (const float*)(ARG_WS + WS_ROPE) + SEQ * 32, (const float*)(ARG_WS + WS_SSQ2)};
          pg8::gemm_phase<pg8::EpiU, pg8::GridOrder, false, false>(F.lds, F.wave, D, D, D, S, E); }
        if (BOTH(1)) GRID_BAR();
    }

    if (IN(2)) {
        { pg8::MnOrder S{(const char*)(ARG_WS + WS_KX), (const char*)(ARG_WS + WS_WXQ), (const char*)(ARG_WS + WS_WXO), (const char*)(ARG_WS + WS_VX), F.G, F.vcu, 1};
          pg8::EpiPlain<false> E{(bf16_t*)(ARG_WS + WS_MT), D, (bf16_t*)(ARG_WS + WS_NT), D, nullptr};
          pg8::gemm_phase<pg8::EpiPlain<false>, pg8::MnOrder, true, false>(F.lds, F.wave, D, D, XHD, S, E); }
#define ATT_ARGS F.lds, (const bf16_t*)(ARG_WS + WS_Q), (const bf16_t*)(ARG_WS + WS_K), (const bf16_t*)(ARG_WS + WS_V), R1, (float*)(ARG_WS + WS_SSQ1), ssqa, F.vcu, F.G
        att::nat_pass<16, true, false>(ATT_ARGS, DUPF(20), F.wave, lane_id(), true);
        GRID_BAR();
        att::nat_pass<4, false, false>(ATT_ARGS, 1, F.wave, lane_id(), false);
        GRID_BAR();
        att::nat_pass<1, false, true>(ATT_ARGS, 1, F.wave, lane_id(), true);
        att::conv_units(F.lds, R2, R1, (const float*)ARG_IN(5), (const float*)ARG_IN(6), (const float*)ARG_IN(7), (const float*)ARG_IN(8), (const float*)ARG_IN(9), F.vcu, F.G, NB * 64 * DUPF(21), F.wave * 64 + lane_id(), F.wave, lane_id());
        if (BOTH(2)) GRID_BAR();
    }

    if (IN(3)) {
        pg8::GridOrder S; S.init(R1, ARG_WS + WS_WOUT, D, D, T, D, F.G, (int)blockIdx.x); S.dup = DUPF(3);
        pg8::EpiResid<true> E{(const bf16_t*)XBP, XBP, ssq1, ssqa};
        pg8::gemm_phase<pg8::EpiResid<true>, pg8::GridOrder, true, false>(F.lds, F.wave, D, D, D, S, E);
        if (BOTH(3)) GRID_BAR();
    }

    if (IN(4)) {
        pg8::BatchOrder S{(const char*)XBP, (const char*)(ARG_WS + WS_MT), (T / 256) * 4, F.G, (int)blockIdx.x, DUPF(4)};
        pg8::EpiSoftmax E{(bf16_t*)(ARG_WS + WS_PM), ssq1};
        pg8::gemm_phase<pg8::EpiSoftmax, pg8::BatchOrder, true, false>(F.lds, F.wave, D, D, D, S, E);
        if (BOTH(4)) GRID_BAR();
    }

    if (IN(5)) {
        pg8::BatchOrder S{(const char*)(ARG_WS + WS_PM), (const char*)(ARG_WS + WS_NT), (T / 256) * 4, F.G, (int)blockIdx.x, 1};
        pg8::EpiResid<false> E{nullptr, XBP, ssq2, nullptr};
        pg8::gemm_phase<pg8::EpiResid<false>, pg8::BatchOrder, true, false>(F.lds, F.wave, D, D, D, S, E);
        if (BOTH(5)) GRID_BAR();
    }

    if (IN(6)) {
        for (int c0_ = blockIdx.x; c0_ < (T / 256) * DUPF(6); c0_ += F.G) { const int c = c0_ % (T / 256);
            moe::route_chunk(F.lds, XBP, ssq2, WR, (const float*)ARG_IN(22), (const float*)ARG_IN(20), tok_e, tok_gate, tok_rs, hist, c, F.wave * 64 + lane_id(), F.wave, lane_id()); }
        if (BOTH(6)) GRID_BAR();
    }

    if (IN(7)) {
        for (int c1_ = blockIdx.x; c1_ < (T / 256) * DUPF(7); c1_ += F.G) { const int c = c1_ % (T / 256);
            moe::slot_chunk(F.lds, hist, tok_e, tok_gate, tok_rs, tok_slot, row_tok, slot_rs, slot_gate, etile, c, F.wave * 64 + lane_id(), F.wave, lane_id()); }
        if (BOTH(7)) GRID_BAR();
    }

#define MOE_ETILE_TO_LDS() do { if (threadIdx.x < NE + 1) ((LAS int*)(F.lds + XCH_ETILE))[threadIdx.x] = etile[threadIdx.x]; asm volatile("s_waitcnt vmcnt(0) lgkmcnt(0)" ::: "memory"); __syncthreads(); } while (0)
    if (IN(8)) {
        MOE_ETILE_TO_LDS();
        pg8::MoeOrder<0> S{(const char*)XBP, (const char*)(ARG_WS + WS_W13), row_tok, (const LAS int*)(F.lds + XCH_ETILE), F.G, (int)blockIdx.x, DUPF(8)};
        pg8::EpiMoe1 E{(bf16_t*)(ARG_WS + WS_HID), slot_rs};
        pg8::gemm_phase<pg8::EpiMoe1, pg8::MoeOrder<0>, true, true>(F.lds, F.wave, D, D, D, S, E);
        if (BOTH(8)) GRID_BAR();
    }

    if (IN(9)) {
        if (!IN(8)) MOE_ETILE_TO_LDS();
        pg8::MoeOrder<1> S{(const char*)(ARG_WS + WS_HID), (const char*)(ARG_WS + WS_W2), row_tok, (const LAS int*)(F.lds + XCH_ETILE), F.G, (int)blockIdx.x, DUPF(9)};
        pg8::EpiMoe2 E{(bf16_t*)(ARG_WS + WS_Y), slot_gate};
        pg8::gemm_phase<pg8::EpiMoe2, pg8::MoeOrder<1>, true, false>(F.lds, F.wave, FF, FF, FF, S, E);
        if (BOTH(9)) GRID_BAR();
    }

    if (IN(10)) {
        int sl[4], sn[4]; { const int* sp = tok_slot + 2 * ((2 * gw) % T); sl[0] = sp[0]; sl[1] = sp[1]; sl[2] = sp[2]; sl[3] = sp[3]; }
        for (int t0_ = 2 * gw; t0_ < T * DUPF(10); t0_ += 2 * NGW) { const int t = t0_ % T, tn = (t0_ + 2 * NGW) % T;
            { const int* sp = tok_slot + 2 * tn; sn[0] = sp[0]; sn[1] = sp[1]; sn[2] = sp[2]; sn[3] = sp[3]; }
            moe::final_row2(ARG_OUT, XBP, (const bf16_t*)(ARG_WS + WS_Y), sl, (const float*)ARG_IN(26), t, lane_id());
#pragma unroll
            for (int k = 0; k < 4; ++k) sl[k] = sn[k]; }
    }
#undef IN
#undef BOTH
}

typedef void (*kern_t)(Args);
template <int... I> struct PhList {};
extern "C" void kernel_launch(void* const* d_in, const int* in_sizes, int n_in, void* d_out, int out_size, void* d_ws, size_t ws_size, hipStream_t stream) {
    static int grid = 0;
#if MK_N_LAUNCHES == 1
    static const kern_t kerns[1] = {mega_fwd<0, NPH>};
#else
    static const kern_t kerns[NPH] = {mega_fwd<0, 1>, mega_fwd<1, 2>, mega_fwd<2, 3>, mega_fwd<3, 4>, mega_fwd<4, 5>, mega_fwd<5, 6>, mega_fwd<6, 7>, mega_fwd<7, 8>, mega_fwd<8, 9>, mega_fwd<9, 10>, mega_fwd<10, 11>};
#endif
    if (grid == 0) {
        if (n_in != 27 || in_sizes[0] != T * D || out_size != T * D || ws_size < WS_END) { fprintf(stderr, "kernel_launch: unexpected problem: n_in %d in0 %d out %d ARG_WS %zu (need %zu)\n", n_in, n_in > 0 ? in_sizes[0] : -1, out_size, ws_size, (size_t)WS_END); grid = -1; return; }
        int dev = 0, cus = 0, per_cu = 0;
        if (hipGetDevice(&dev) != hipSuccess || hipDeviceGetAttribute(&cus, hipDeviceAttributeMultiprocessorCount, dev) != hipSuccess) { grid = -1; return; }
        for (int li = 0; li < N_LAUNCHES; ++li)
            if (hipFuncSetAttribute((const void*)kerns[li], hipFuncAttributeMaxDynamicSharedMemorySize, LDS_BYTES) != hipSuccess) { fprintf(stderr, "kernel_launch: hipFuncSetAttribute failed\n"); grid = -1; return; }
        if (hipOccupancyMaxActiveBlocksPerMultiprocessor(&per_cu, (const void*)kerns[0], NWAVES * 64, LDS_BYTES) != hipSuccess || per_cu < 1) { fprintf(stderr, "kernel_launch: occupancy query says %d\n", per_cu); }
        (void)hipGetLastError();
        grid = cus;
    }
    if (grid < 0) return;
    if (hipMemsetAsync((char*)d_ws + WS_CTL, 0, CTL_ZERO_BYTES, stream) != hipSuccess) return;
    Args a{};
    for (int i = 0; i < 27; ++i) a.in[i] = d_in[i];
    a.out = (float*)d_out; a.ws = (unsigned char*)d_ws;
    for (int li = 0; li < N_LAUNCHES; ++li) {
        a.ph_lo = 0; a.ph_hi = 0; a.li = li; a.pad = 0;
        hipLaunchKernelGGL(kerns[li], dim3(grid), dim3(NWAVES * 64), LDS_BYTES, stream, a);
        const hipError_t le = hipPeekAtLastError();
        if (le != hipSuccess) { fprintf(stderr, "kernel_launch: launch %d failed: %s\n", li, hipGetErrorName(le)); break; }
    }
}
```
